# Optimizing an MI355X kernel written in HIP

```python
import jax, jax.numpy as jnp
from jax import lax
import numpy as np


D_MODEL = 1024
BATCH = 4
SEQ = 8192
DEPTH = 2

CHUNK = 64
Q_BLOCK = 128
P_DIM = 256
EPS = 1e-6
NEG_INF = -1e30
ROPE_THETA = 10000.0

MIX_WIDTH = D_MODEL
MLA_WIDTH = MIX_WIDTH // 2
FOX_WIDTH = MIX_WIDTH - MLA_WIDTH
MLA_V_DIM = 64
MLA_HEADS = MLA_WIDTH // MLA_V_DIM
MLA_NOPE_DIM = 64
MLA_ROPE_DIM = 32
MLA_QK_DIM = MLA_NOPE_DIM + MLA_ROPE_DIM
Q_LORA = D_MODEL // 4
KV_LORA = D_MODEL // 8
FOX_HEAD_DIM = 64
FOX_HEADS = FOX_WIDTH // FOX_HEAD_DIM

IN_SIZES = (Q_LORA, KV_LORA, MLA_ROPE_DIM, FOX_WIDTH, FOX_WIDTH, FOX_WIDTH, FOX_HEADS)
IN_COLS = sum(IN_SIZES)
IN_SPLITS = tuple(int(v) for v in np.cumsum(IN_SIZES)[:-1])

N_GROUPS = 4
EXPERTS_PER_GROUP = 8
N_EXPERTS = N_GROUPS * EXPERTS_PER_GROUP
TOP_K = 2
EXPERT_FF = D_MODEL // 4
EXPERT_BLOCK = 128

kernel_name = 'hybrid_mla_fox_hmoe_ple'


def rmsnorm(x, g):
    xf = x.astype(jnp.float32)
    y = xf * lax.rsqrt(jnp.mean(xf * xf, axis=-1, keepdims=True) + EPS)
    return (y * g.astype(jnp.float32)).astype(x.dtype)


def rope_tables(positions):
    inv_freq = ROPE_THETA ** (-jnp.arange(0, MLA_ROPE_DIM, 2, dtype=jnp.float32) / MLA_ROPE_DIM)
    ang = positions.astype(jnp.float32)[..., None] * inv_freq
    return jnp.cos(ang)[:, :, None, :], jnp.sin(ang)[:, :, None, :]


def apply_rope(x, cos, sin):
    half = MLA_ROPE_DIM // 2
    x1, x2 = x[..., :half], x[..., half:]
    out = jnp.concatenate([x1 * cos - x2 * sin, x2 * cos + x1 * sin], axis=-1)
    return out.astype(x.dtype)


def chunk_causal(q_idx, k_idx):
    return (k_idx // CHUNK) <= (q_idx // CHUNK)


def frame_causal(q_idx, k_idx):
    return k_idx <= q_idx


def blocked_attention(q, k, v, allowed, log_decay_cum=None):
    B, H, S, Dk = q.shape
    Dv = v.shape[-1]
    n_blocks = S // Q_BLOCK
    scale = Dk ** -0.5
    k_idx = jnp.arange(S, dtype=jnp.int32)

    def one_block(i):
        start = i * Q_BLOCK
        qb = lax.dynamic_slice_in_dim(q, start, Q_BLOCK, axis=2)
        q_idx = start + jnp.arange(Q_BLOCK, dtype=jnp.int32)
        s = jnp.einsum('bhqd,bhkd->bhqk', qb, k, preferred_element_type=jnp.float32) * scale
        if log_decay_cum is not None:
            f_q = lax.dynamic_slice_in_dim(log_decay_cum, start, Q_BLOCK, axis=2)
            s = s + f_q[..., :, None] - log_decay_cum[..., None, :]
        mask = allowed(q_idx[:, None], k_idx[None, :])
        s = jnp.where(mask, s, NEG_INF)
        w = jax.nn.softmax(s, axis=-1).astype(v.dtype)
        return jnp.einsum('bhqk,bhkd->bhqd', w, v)

    out = lax.map(one_block, jnp.arange(n_blocks, dtype=jnp.int32))
    return out.transpose(1, 2, 0, 3, 4).reshape(B, H, S, Dv)


def hybrid_mixer(h, cos, sin, w_in, g_q_lora, w_uq, g_kv_lora, w_ukv, g_mla_q, g_mla_k,
                 g_fox_q, g_fox_k, b_fox_f, g_out_mla, g_out_fox, w_out):
    B, S, _ = h.shape
    proj = h @ w_in
    q_c, kv_c, k_pe, fq, fk, fv, f_logit = jnp.split(proj, IN_SPLITS, axis=-1)

    q = (rmsnorm(q_c, g_q_lora) @ w_uq).reshape(B, S, MLA_HEADS, MLA_QK_DIM)
    kv = (rmsnorm(kv_c, g_kv_lora) @ w_ukv).reshape(B, S, MLA_HEADS, MLA_NOPE_DIM + MLA_V_DIM)
    k_nope, v_mla = kv[..., :MLA_NOPE_DIM], kv[..., MLA_NOPE_DIM:]
    k_pe_b = jnp.broadcast_to(k_pe[:, :, None, :], (B, S, MLA_HEADS, MLA_ROPE_DIM))
    k = jnp.concatenate([k_nope, k_pe_b], axis=-1)
    q = rmsnorm(q, g_mla_q)
    k = rmsnorm(k, g_mla_k)
    q = jnp.concatenate([q[..., :MLA_NOPE_DIM], apply_rope(q[..., MLA_NOPE_DIM:], cos, sin)], axis=-1)
    k = jnp.concatenate([k[..., :MLA_NOPE_DIM], apply_rope(k[..., MLA_NOPE_DIM:], cos, sin)], axis=-1)
    o_mla = blocked_attention(q.transpose(0, 2, 1, 3), k.transpose(0, 2, 1, 3),
                              v_mla.transpose(0, 2, 1, 3), chunk_causal)
    o_mla = o_mla.transpose(0, 2, 1, 3).reshape(B, S, MLA_WIDTH)

    fq = rmsnorm(fq.reshape(B, S, FOX_HEADS, FOX_HEAD_DIM), g_fox_q)
    fk = rmsnorm(fk.reshape(B, S, FOX_HEADS, FOX_HEAD_DIM), g_fox_k)
    fv = fv.reshape(B, S, FOX_HEADS, FOX_HEAD_DIM)
    log_f = jax.nn.log_sigmoid(f_logit.astype(jnp.float32) + b_fox_f.astype(jnp.float32))
    f_cum = jnp.cumsum(log_f, axis=1).transpose(0, 2, 1)
    o_fox = blocked_attention(fq.transpose(0, 2, 1, 3), fk.transpose(0, 2, 1, 3),
                              fv.transpose(0, 2, 1, 3), frame_causal, f_cum)
    o_fox = o_fox.transpose(0, 2, 1, 3).reshape(B, S, FOX_WIDTH)

    y = jnp.concatenate([rmsnorm(o_mla, g_out_mla), rmsnorm(o_fox, g_out_fox)], axis=-1)
    return y @ w_out


def hierarchical_moe(h, w_router_group, w_router_expert, w_exp_gate, w_exp_up, w_exp_down):
    B, S, D = h.shape
    N = B * S
    hf = h.reshape(N, D)
    p_group = jax.nn.softmax((hf @ w_router_group).astype(jnp.float32), axis=-1)
    g_idx = jnp.argmax(p_group, axis=-1).astype(jnp.int32)
    p_g = jnp.max(p_group, axis=-1)
    e_logits = (hf @ w_router_expert).astype(jnp.float32).reshape(N, N_GROUPS, EXPERTS_PER_GROUP)
    e_logits = jnp.take_along_axis(e_logits, g_idx[:, None, None], axis=1)[:, 0]
    p_exp = jax.nn.softmax(e_logits, axis=-1)
    top_p, top_i = lax.top_k(p_exp, TOP_K)
    gate = p_g[:, None] * top_p / jnp.sum(top_p, axis=-1, keepdims=True)
    expert_id = g_idx[:, None] * EXPERTS_PER_GROUP + top_i.astype(jnp.int32)

    A = N * TOP_K
    flat_e = expert_id.reshape(A)
    flat_g = gate.reshape(A)
    flat_tok = jnp.repeat(jnp.arange(N, dtype=jnp.int32), TOP_K)
    order = jnp.argsort(flat_e)
    e_sorted = flat_e[order]
    counts = jnp.zeros((N_EXPERTS,), jnp.int32).at[flat_e].add(1)
    padded = ((counts + EXPERT_BLOCK - 1) // EXPERT_BLOCK) * EXPERT_BLOCK
    pad_end = jnp.cumsum(padded)
    pad_start = pad_end - padded
    start = jnp.cumsum(counts) - counts
    dest = pad_start[e_sorted] + (jnp.arange(A, dtype=jnp.int32) - start[e_sorted])
    P = A + N_EXPERTS * EXPERT_BLOCK
    slot_tok = jnp.full((P,), N, jnp.int32).at[dest].set(flat_tok[order])
    slot_gate = jnp.zeros((P,), h.dtype).at[dest].set(flat_g[order].astype(h.dtype))
    n_blk = P // EXPERT_BLOCK
    blk_start = jnp.arange(n_blk, dtype=jnp.int32) * EXPERT_BLOCK
    blk_e = jnp.minimum(jnp.searchsorted(pad_end, blk_start, side='right'), N_EXPERTS - 1)

    h_pad = jnp.concatenate([hf, jnp.zeros((1, D), hf.dtype)], axis=0)
    xs = h_pad[slot_tok].reshape(n_blk, EXPERT_BLOCK, D)

    def expert_block(args):
        xb, e = args
        return (jax.nn.silu(xb @ w_exp_gate[e]) * (xb @ w_exp_up[e])) @ w_exp_down[e]

    ys = lax.map(expert_block, (xs, blk_e)).reshape(P, D)
    out = jnp.zeros((N + 1, D), h.dtype).at[slot_tok].add(ys * slot_gate[:, None])
    return out[:N].reshape(B, S, D)


def setup_inputs(seed: int = 0) -> dict:
    key = jax.random.key(seed)
    ks = jax.random.split(key, 27)
    f32 = jnp.float32

    def nrm(k, shape, fan_in):
        return jax.random.normal(k, shape, f32) * (fan_in ** -0.5)

    def gain(k, dim):
        return 1.0 + 0.05 * jax.random.normal(k, (DEPTH, dim), f32)

    x = jax.random.normal(ks[0], (BATCH, SEQ, D_MODEL), f32)
    p = jax.random.normal(ks[1], (DEPTH, BATCH, SEQ, P_DIM), f32)
    offsets = jax.random.randint(ks[2], (BATCH,), 0, 64, dtype=jnp.int32) * CHUNK
    positions = offsets[:, None] + jnp.arange(SEQ, dtype=jnp.int32)[None, :]
    return {
        'x': x,
        'p': p,
        'positions': positions,
        'g_attn_norm': gain(ks[3], D_MODEL),
        'w_in': nrm(ks[4], (DEPTH, D_MODEL, IN_COLS), D_MODEL),
        'g_q_lora': gain(ks[5], Q_LORA),
        'w_uq': nrm(ks[6], (DEPTH, Q_LORA, MLA_HEADS * MLA_QK_DIM), Q_LORA),
        'g_kv_lora': gain(ks[7], KV_LORA),
        'w_ukv': nrm(ks[8], (DEPTH, KV_LORA, MLA_HEADS * (MLA_NOPE_DIM + MLA_V_DIM)), KV_LORA),
        'g_mla_q': gain(ks[9], MLA_QK_DIM),
        'g_mla_k': gain(ks[10], MLA_QK_DIM),
        'g_fox_q': gain(ks[11], FOX_HEAD_DIM),
        'g_fox_k': gain(ks[12], FOX_HEAD_DIM),
        'b_fox_f': 2.0 + 0.5 * jax.random.normal(ks[13], (DEPTH, FOX_HEADS), f32),
        'g_out_mla': gain(ks[14], MLA_WIDTH),
        'g_out_fox': gain(ks[15], FOX_WIDTH),
        'w_out': nrm(ks[16], (DEPTH, MIX_WIDTH, D_MODEL), MIX_WIDTH),
        'g_ffn_norm': gain(ks[17], D_MODEL),
        'w_router_group': nrm(ks[18], (DEPTH, D_MODEL, N_GROUPS), D_MODEL),
        'w_router_expert': nrm(ks[19], (DEPTH, D_MODEL, N_EXPERTS), D_MODEL),
        'w_exp_gate': nrm(ks[20], (DEPTH, N_EXPERTS, D_MODEL, EXPERT_FF), D_MODEL),
        'w_exp_up': nrm(ks[21], (DEPTH, N_EXPERTS, D_MODEL, EXPERT_FF), D_MODEL),
        'w_exp_down': nrm(ks[22], (DEPTH, N_EXPERTS, EXPERT_FF, D_MODEL), EXPERT_FF),
        'g_ple_norm': gain(ks[23], D_MODEL),
        'w_ple_gate': nrm(ks[24], (DEPTH, D_MODEL, D_MODEL), D_MODEL),
        'w_ple_proj': nrm(ks[25], (DEPTH, P_DIM, D_MODEL), P_DIM),
        'g_ple_out': gain(ks[26], D_MODEL),
    }


def reference(x, p, positions, g_attn_norm, w_in, g_q_lora, w_uq, g_kv_lora, w_ukv, g_mla_q, g_mla_k,
              g_fox_q, g_fox_k, b_fox_f, g_out_mla, g_out_fox, w_out, g_ffn_norm, w_router_group,
              w_router_expert, w_exp_gate, w_exp_up, w_exp_down, g_ple_norm, w_ple_gate, w_ple_proj,
              g_ple_out):
    cos, sin = rope_tables(positions)
    for i in range(DEPTH):
        h = rmsnorm(x, g_attn_norm[i])
        x = x + hybrid_mixer(h, cos, sin, w_in[i], g_q_lora[i], w_uq[i], g_kv_lora[i], w_ukv[i],
                             g_mla_q[i], g_mla_k[i], g_fox_q[i], g_fox_k[i], b_fox_f[i],
                             g_out_mla[i], g_out_fox[i], w_out[i])
        h = rmsnorm(x, g_ffn_norm[i])
        x = x + hierarchical_moe(h, w_router_group[i], w_router_expert[i], w_exp_gate[i],
                                 w_exp_up[i], w_exp_down[i])
        ple = rmsnorm(p[i] @ w_ple_proj[i], g_ple_out[i])
        ple_gate = jax.nn.sigmoid(rmsnorm(x, g_ple_norm[i]) @ w_ple_gate[i])
        x = x + ple * ple_gate
    return x
```

```cpp
#include <hip/hip_runtime.h>
#include <stdint.h>

namespace {
constexpr int D = 1024, NB = 4, S = 8192, NTOK = NB * S, DEPTH = 2;
constexpr int INC = 1960;
constexpr int C_QC = 0, C_KVC = 256, C_KPE = 384, C_FQ = 416, C_FK = 928, C_FV = 1440, C_FL = 1952;
constexpr int NEXP = 32;
constexpr float EPS = 1e-6f;

__device__ __forceinline__ float wave_sum(float v) {
#pragma unroll
    for (int o = 32; o > 0; o >>= 1) v += __shfl_xor(v, o);
    return v;
}

__global__ __launch_bounds__(256) void k_rmsnorm(const float* in, long ld_in, const float* __restrict__ g, float* out, long ld_out, int ncols, int nrows) {
    const int row = blockIdx.x * 4 + (threadIdx.x >> 6), lane = threadIdx.x & 63;
    if (row >= nrows) return;
    const float* ip = in + (long)row * ld_in; float* op = out + (long)row * ld_out;
    float ss = 0.f;
    for (int c = lane; c < ncols; c += 64) { const float v = ip[c]; ss += v * v; }
    ss = wave_sum(ss);
    const float rinv = rsqrtf(ss / (float)ncols + EPS);
    for (int c = lane; c < ncols; c += 64) op[c] = ip[c] * rinv * g[c];
}

template <int EPI>
__global__ __launch_bounds__(256) void k_gemm(const float* __restrict__ A, int lda, const int* __restrict__ mapA, int shiftA,
                                              const float* __restrict__ Bm, int ldb, float* __restrict__ C, int ldc, const int* __restrict__ mapC,
                                              const int* __restrict__ Mptr, int M, int N, int K, long strideB, long strideMap, const float* __restrict__ gatev) {
    const int e = blockIdx.z;
    if (Mptr) M = Mptr[e];
    const int m0 = blockIdx.y * 64; if (m0 >= M) return;
    const int n0 = blockIdx.x * 64;
    Bm += (long)e * strideB; if (mapA) mapA += (long)e * strideMap; if (mapC) mapC += (long)e * strideMap;
    __shared__ float As[16][68]; __shared__ float Bs[16][68];
    const int tid = threadIdx.x, ty = tid >> 4, tx = tid & 15;
    const int ar = tid >> 2, ak = (tid & 3) * 4; const int arow = m0 + ar; const bool aval = arow < M;
    long aoff = 0; if (aval) { const int r = mapA ? (mapA[arow] >> shiftA) : arow; aoff = (long)r * lda; }
    const int bk = tid >> 4, bn = n0 + (tid & 15) * 4; const bool bval = bn < N;
    float acc[4][4];
#pragma unroll
    for (int i = 0; i < 4; ++i)
#pragma unroll
        for (int j = 0; j < 4; ++j) acc[i][j] = 0.f;
    for (int k0 = 0; k0 < K; k0 += 16) {
        const float4 av = aval ? *(const float4*)(A + aoff + k0 + ak) : make_float4(0.f, 0.f, 0.f, 0.f);
        const float4 bv = bval ? *(const float4*)(Bm + (long)(k0 + bk) * ldb + bn) : make_float4(0.f, 0.f, 0.f, 0.f);
        __syncthreads();
        As[ak + 0][ar] = av.x; As[ak + 1][ar] = av.y; As[ak + 2][ar] = av.z; As[ak + 3][ar] = av.w;
        *(float4*)&Bs[bk][(tid & 15) * 4] = bv;
        __syncthreads();
#pragma unroll
        for (int kk = 0; kk < 16; ++kk) {
            const float4 a = *(const float4*)&As[kk][ty * 4]; const float4 b = *(const float4*)&Bs[kk][tx * 4];
            const float aa[4] = {a.x, a.y, a.z, a.w}; const float bb[4] = {b.x, b.y, b.z, b.w};
#pragma unroll
            for (int i = 0; i < 4; ++i)
#pragma unroll
                for (int j = 0; j < 4; ++j) acc[i][j] += aa[i] * bb[j];
        }
    }
#pragma unroll
    for (int i = 0; i < 4; ++i) {
        const int row = m0 + ty * 4 + i; if (row >= M) continue;
        const int cr = mapC ? mapC[row] : row;
#pragma unroll
        for (int j = 0; j < 4; ++j) {
            const int col = n0 + tx * 4 + j; if (col >= N) continue;
            if (EPI == 0) C[(long)cr * ldc + col] = acc[i][j];
            else if (EPI == 1) atomicAdd(&C[(long)(cr >> 1) * ldc + col], acc[i][j] * gatev[cr]);
            else C[(long)cr * ldc + col] += acc[i][j];
        }
    }
}

__global__ void k_rope_table(const int* __restrict__ pos, float* __restrict__ cosT, float* __restrict__ sinT) {
    const int i = blockIdx.x * blockDim.x + threadIdx.x; if (i >= NTOK * 16) return;
    const int t = i >> 4, j = i & 15;
    const float inv_freq = (float)pow(10000.0, -(double)(2 * j) / 32.0);
    const float ang = (float)pos[t] * inv_freq;
    cosT[i] = (float)cos((double)ang); sinT[i] = (float)sin((double)ang);
}

__global__ __launch_bounds__(256) void k_mla_post(const float* __restrict__ qfull, const float* __restrict__ kvfull, const float* __restrict__ proj,
                                                  const float* __restrict__ cosT, const float* __restrict__ sinT, const float* __restrict__ gq, const float* __restrict__ gk,
                                                  float* __restrict__ Qm, float* __restrict__ Km, float* __restrict__ Vm, int nb, int tok0) {
    const int w = blockIdx.x * 4 + (threadIdx.x >> 6), lane = threadIdx.x & 63;
    if (w >= nb * 8) return;
    const int t = w >> 3, h = w & 7;
    const int j = lane & 15;
    const float c = cosT[(long)(tok0 + t) * 16 + j], s = sinT[(long)(tok0 + t) * 16 + j];
    {
        const float vn = qfull[(long)t * 768 + h * 96 + lane];
        const float vr = lane < 32 ? qfull[(long)t * 768 + h * 96 + 64 + lane] : 0.f;
        const float ss = wave_sum(vn * vn + vr * vr);
        const float rinv = rsqrtf(ss / 96.f + EPS);
        const float qn = vn * rinv * gq[lane];
        const float qr = lane < 32 ? vr * rinv * gq[64 + lane] : 0.f;
        const float other = __shfl_xor(qr, 16);
        const float ro = lane < 16 ? (qr * c - other * s) : (qr * c + other * s);
        Qm[(long)w * 96 + lane] = qn;
        if (lane < 32) Qm[(long)w * 96 + 64 + lane] = ro;
    }
    {
        const float vn = kvfull[(long)t * 1024 + h * 128 + lane];
        const float vr = lane < 32 ? proj[(long)t * INC + C_KPE + lane] : 0.f;
        const float ss = wave_sum(vn * vn + vr * vr);
        const float rinv = rsqrtf(ss / 96.f + EPS);
        const float kn = vn * rinv * gk[lane];
        const float kr = lane < 32 ? vr * rinv * gk[64 + lane] : 0.f;
        const float other = __shfl_xor(kr, 16);
        const float ro = lane < 16 ? (kr * c - other * s) : (kr * c + other * s);
        Km[(long)w * 96 + lane] = kn;
        if (lane < 32) Km[(long)w * 96 + 64 + lane] = ro;
        Vm[(long)w * 64 + lane] = kvfull[(long)t * 1024 + h * 128 + 64 + lane];
    }
}

__device__ __forceinline__ float log_sigmoid(float x) { return -(fmaxf(-x, 0.f) + log1pf(expf(-fabsf(x)))); }

__global__ __launch_bounds__(256) void k_fox_post(const float* __restrict__ proj, const float* __restrict__ gq, const float* __restrict__ gk, const float* __restrict__ bf,
                                                  float* __restrict__ Fq, float* __restrict__ Fk, float* __restrict__ Fv, float* __restrict__ logf, int nb) {
    const int w = blockIdx.x * 4 + (threadIdx.x >> 6), lane = threadIdx.x & 63;
    if (w >= nb * 8) return;
    const int t = w >> 3, h = w & 7;
    const float* pr = proj + (long)t * INC;
    const float q = pr[C_FQ + h * 64 + lane], k = pr[C_FK + h * 64 + lane], v = pr[C_FV + h * 64 + lane];
    const float sq = wave_sum(q * q), sk = wave_sum(k * k);
    Fq[(long)w * 64 + lane] = q * rsqrtf(sq / 64.f + EPS) * gq[lane];
    Fk[(long)w * 64 + lane] = k * rsqrtf(sk / 64.f + EPS) * gk[lane];
    Fv[(long)w * 64 + lane] = v;
    if (lane == 0) logf[w] = log_sigmoid(pr[C_FL + h] + bf[h]);
}

__global__ __launch_bounds__(64) void k_cumsum(const float* __restrict__ logf, float* __restrict__ fcum) {
    const int h = blockIdx.x, lane = threadIdx.x;
    constexpr int SEG = S / 64;
    double loc = 0.0;
    for (int i = 0; i < SEG; ++i) loc += (double)logf[(long)(lane * SEG + i) * 8 + h];
    double pre = loc;
#pragma unroll
    for (int o = 1; o < 64; o <<= 1) { const double n = __shfl_up(pre, o); if (lane >= o) pre += n; }
    double run = pre - loc;
    for (int i = 0; i < SEG; ++i) { run += (double)logf[(long)(lane * SEG + i) * 8 + h]; fcum[(long)(lane * SEG + i) * 8 + h] = (float)run; }
}

template <int DK, int MODE>
__global__ __launch_bounds__(256) void k_attn_naive(const float* __restrict__ Q, const float* __restrict__ Kt, const float* __restrict__ V, const float* __restrict__ fcum,
                                                    float* __restrict__ O, int coloff, float scale) {
    constexpr int LDQ = DK + 4;
    __shared__ float Qs[64][LDQ];
    __shared__ float Ks[32][LDQ];
    __shared__ float Vs[32][64];
    __shared__ float Ss[64][33];
    __shared__ float ms[64], ls[64], als[64], fqs[64], fks[32];
    const int h = blockIdx.y, q0 = blockIdx.x * 64, tid = threadIdx.x;
    for (int i = tid; i < 64 * (DK / 4); i += 256) { const int r = i / (DK / 4), c4 = i % (DK / 4);
        *(float4*)&Qs[r][c4 * 4] = *(const float4*)(Q + ((long)(q0 + r) * 8 + h) * DK + c4 * 4); }
    if (tid < 64) { ms[tid] = -1e30f; ls[tid] = 0.f; fqs[tid] = MODE == 1 ? fcum[(long)(q0 + tid) * 8 + h] : 0.f; }
    float o[4][4];
#pragma unroll
    for (int i = 0; i < 4; ++i)
#pragma unroll
        for (int j = 0; j < 4; ++j) o[i][j] = 0.f;
    const int oy = tid >> 4, ox = tid & 15, sy = tid >> 3, sx = tid & 7;
    const int nt = (q0 + 64) / 32;
    for (int t = 0; t < nt; ++t) {
        const int k0 = t * 32;
        __syncthreads();
        for (int i = tid; i < 32 * (DK / 4); i += 256) { const int r = i / (DK / 4), c4 = i % (DK / 4);
            *(float4*)&Ks[r][c4 * 4] = *(const float4*)(Kt + ((long)(k0 + r) * 8 + h) * DK + c4 * 4); }
        for (int i = tid; i < 32 * 16; i += 256) { const int r = i >> 4, c4 = i & 15;
            *(float4*)&Vs[r][c4 * 4] = *(const float4*)(V + ((long)(k0 + r) * 8 + h) * 64 + c4 * 4); }
        if (tid < 32) fks[tid] = MODE == 1 ? fcum[(long)(k0 + tid) * 8 + h] : 0.f;
        __syncthreads();
        float sc[2][4];
#pragma unroll
        for (int i = 0; i < 2; ++i)
#pragma unroll
            for (int j = 0; j < 4; ++j) sc[i][j] = 0.f;
#pragma unroll 4
        for (int d = 0; d < DK; d += 4) {
            const float4 qa = *(const float4*)&Qs[2 * sy][d], qb = *(const float4*)&Qs[2 * sy + 1][d];
#pragma unroll
            for (int j = 0; j < 4; ++j) { const float4 kk = *(const float4*)&Ks[4 * sx + j][d];
                sc[0][j] += qa.x * kk.x + qa.y * kk.y + qa.z * kk.z + qa.w * kk.w;
                sc[1][j] += qb.x * kk.x + qb.y * kk.y + qb.z * kk.z + qb.w * kk.w; }
        }
#pragma unroll
        for (int i = 0; i < 2; ++i)
#pragma unroll
            for (int j = 0; j < 4; ++j) { const int qi = q0 + 2 * sy + i, kj = k0 + 4 * sx + j;
                const bool ok = MODE == 0 ? ((kj >> 6) <= (qi >> 6)) : (kj <= qi);
                float v = sc[i][j] * scale; if (MODE == 1) v += fqs[2 * sy + i] - fks[4 * sx + j];
                Ss[2 * sy + i][4 * sx + j] = ok ? v : -1e30f; }
        __syncthreads();
        {   const int r = tid >> 2, part = tid & 3; float mx = -1e30f;
#pragma unroll
            for (int j = 0; j < 8; ++j) mx = fmaxf(mx, Ss[r][part * 8 + j]);
            mx = fmaxf(mx, __shfl_xor(mx, 1)); mx = fmaxf(mx, __shfl_xor(mx, 2));
            const float mo = ms[r], mn = fmaxf(mo, mx); float sum = 0.f;
#pragma unroll
            for (int j = 0; j < 8; ++j) { const float p = __expf(Ss[r][part * 8 + j] - mn); Ss[r][part * 8 + j] = p; sum += p; }
            sum += __shfl_xor(sum, 1); sum += __shfl_xor(sum, 2);
            const float al = __expf(mo - mn);
            __builtin_amdgcn_wave_barrier();
            if (part == 0) { als[r] = al; ls[r] = ls[r] * al + sum; ms[r] = mn; }
        }
        __syncthreads();
#pragma unroll
        for (int i = 0; i < 4; ++i) { const float a = als[4 * oy + i];
#pragma unroll
            for (int j = 0; j < 4; ++j) o[i][j] *= a; }
#pragma unroll 8
        for (int j = 0; j < 32; ++j) { const float4 v = *(const float4*)&Vs[j][4 * ox];
#pragma unroll
            for (int i = 0; i < 4; ++i) { const float p = Ss[4 * oy + i][j]; o[i][0] += p * v.x; o[i][1] += p * v.y; o[i][2] += p * v.z; o[i][3] += p * v.w; } }
    }
    __syncthreads();
#pragma unroll
    for (int i = 0; i < 4; ++i) { const float rl = 1.f / ls[4 * oy + i];
        float4 r = make_float4(o[i][0] * rl, o[i][1] * rl, o[i][2] * rl, o[i][3] * rl);
        *(float4*)(O + (long)(q0 + 4 * oy + i) * 1024 + coloff + h * 64 + 4 * ox) = r; }
}

__global__ __launch_bounds__(256) void k_router(const float* __restrict__ h2, const float* __restrict__ wg, const float* __restrict__ we,
                                                float* __restrict__ gate, int* __restrict__ cnt, int* __restrict__ list) {
    const int t = blockIdx.x * 4 + (threadIdx.x >> 6), lane = threadIdx.x & 63;
    if (t >= NTOK) return;
    const float* hp = h2 + (long)t * D;
    float hv[16];
#pragma unroll
    for (int i = 0; i < 16; ++i) hv[i] = hp[lane + 64 * i];
    float lg[4];
#pragma unroll
    for (int j = 0; j < 4; ++j) { float a = 0.f;
#pragma unroll
        for (int i = 0; i < 16; ++i) a += hv[i] * wg[(long)(lane + 64 * i) * 4 + j];
        lg[j] = wave_sum(a); }
    int g = 0; float gm = lg[0];
#pragma unroll
    for (int j = 1; j < 4; ++j) if (lg[j] > gm) { gm = lg[j]; g = j; }
    float gs = 0.f;
#pragma unroll
    for (int j = 0; j < 4; ++j) gs += expf(lg[j] - gm);
    const float pg = 1.f / gs;
    float le[8];
#pragma unroll
    for (int j = 0; j < 8; ++j) { float a = 0.f;
#pragma unroll
        for (int i = 0; i < 16; ++i) a += hv[i] * we[(long)(lane + 64 * i) * 32 + g * 8 + j];
        le[j] = wave_sum(a); }
    int i1 = 0; float m1 = le[0];
#pragma unroll
    for (int j = 1; j < 8; ++j) if (le[j] > m1) { m1 = le[j]; i1 = j; }
    int i2 = -1; float m2 = -3.0e38f;
#pragma unroll
    for (int j = 0; j < 8; ++j) if (j != i1 && le[j] > m2) { m2 = le[j]; i2 = j; }
    const float e2 = expf(m2 - m1); const float w1 = 1.f / (1.f + e2), w2 = e2 / (1.f + e2);
    if (lane == 0) {
        gate[2 * t] = pg * w1; gate[2 * t + 1] = pg * w2;
        const int ea = g * 8 + i1, eb = g * 8 + i2;
        const int pa = atomicAdd(&cnt[ea], 1); list[(long)ea * NTOK + pa] = 2 * t;
        const int pb = atomicAdd(&cnt[eb], 1); list[(long)eb * NTOK + pb] = 2 * t + 1;
    }
}

__global__ void k_silu_mul(float* __restrict__ g, const float* __restrict__ u, long n) {
    const long i = (long)blockIdx.x * blockDim.x + threadIdx.x; if (i >= n) return;
    const float a = g[i]; g[i] = a / (1.f + expf(-a)) * u[i];
}
__global__ void k_ple_final(float* __restrict__ x, const float* __restrict__ ple, const float* __restrict__ gl, long n) {
    const long i = (long)blockIdx.x * blockDim.x + threadIdx.x; if (i >= n) return;
    x[i] += ple[i] / (1.f + expf(-gl[i]));
}
}

extern "C" void kernel_launch(void* const* d_in, const int* in_sizes, int n_in, void* d_out, int out_size, void* d_ws, size_t ws_size, hipStream_t stream) {
    const float* x_in = (const float*)d_in[0]; const float* p_in = (const float*)d_in[1]; const int* pos = (const int*)d_in[2];
    auto F = [&](int i) { return (const float*)d_in[i]; };
    float* x = (float*)d_out;
    char* ws = (char*)d_ws;
    constexpr size_t MiB = 1u << 20;
    float* cosT = (float*)(ws + 0); float* sinT = (float*)(ws + 2 * MiB);
    int* cnt = (int*)(ws + 4 * MiB); float* gate = (float*)(ws + 5 * MiB); int* list = (int*)(ws + 6 * MiB);
    char* big = ws + 16 * MiB;
    float* hB = (float*)(big);
    float* proj = (float*)(big + 32 * MiB);
    float* qfull = (float*)(big + 96 * MiB);
    float* kvfull = (float*)(big + 120 * MiB);
    float* Qm = (float*)(big + 152 * MiB); float* Km = (float*)(big + 176 * MiB); float* Vm = (float*)(big + 200 * MiB);
    float* Fq = (float*)(big + 216 * MiB); float* Fk = (float*)(big + 232 * MiB); float* Fv = (float*)(big + 248 * MiB);
    float* logf = (float*)(big + 264 * MiB); float* fcum = (float*)(big + 265 * MiB);
    float* ob = (float*)(big + 266 * MiB);
    float* yb = (float*)(big + 298 * MiB);
    float* h2 = (float*)(big); float* Cg = (float*)(big + 128 * MiB); float* Cu = (float*)(big + 192 * MiB);
    float* pp = (float*)(big + 128 * MiB); float* gl = (float*)(big + 256 * MiB);

    hipMemcpyAsync(x, x_in, (size_t)NTOK * D * 4, hipMemcpyDeviceToDevice, stream);
    k_rope_table<<<(NTOK * 16 + 255) / 256, 256, 0, stream>>>(pos, cosT, sinT);
    for (int L = 0; L < DEPTH; ++L) {
        const float* g_attn = F(3) + L * D; const float* w_in = F(4) + (size_t)L * D * INC; const float* g_ql = F(5) + L * 256; const float* w_uq = F(6) + (size_t)L * 256 * 768;
        const float* g_kvl = F(7) + L * 128; const float* w_ukv = F(8) + (size_t)L * 128 * 1024; const float* g_mq = F(9) + L * 96; const float* g_mk = F(10) + L * 96;
        const float* g_fq = F(11) + L * 64; const float* g_fk = F(12) + L * 64; const float* b_ff = F(13) + L * 8; const float* g_om = F(14) + L * 512; const float* g_of = F(15) + L * 512;
        const float* w_out = F(16) + (size_t)L * D * D; const float* g_ffn = F(17) + L * D; const float* w_rg = F(18) + (size_t)L * D * 4; const float* w_re = F(19) + (size_t)L * D * 32;
        const float* w_eg = F(20) + (size_t)L * NEXP * D * 256; const float* w_eu = F(21) + (size_t)L * NEXP * D * 256; const float* w_ed = F(22) + (size_t)L * NEXP * 256 * D;
        const float* g_pn = F(23) + L * D; const float* w_pg = F(24) + (size_t)L * D * D; const float* w_pp = F(25) + (size_t)L * 256 * D; const float* g_po = F(26) + L * D;
        for (int b = 0; b < NB; ++b) {
            float* xb = x + (size_t)b * S * D;
            k_rmsnorm<<<S / 4, 256, 0, stream>>>(xb, D, g_attn, hB, D, D, S);
            k_gemm<0><<<dim3((INC + 63) / 64, S / 64, 1), 256, 0, stream>>>(hB, D, nullptr, 0, w_in, INC, proj, INC, nullptr, nullptr, S, INC, D, 0, 0, nullptr);
            k_rmsnorm<<<S / 4, 256, 0, stream>>>(proj + C_QC, INC, g_ql, proj + C_QC, INC, 256, S);
            k_rmsnorm<<<S / 4, 256, 0, stream>>>(proj + C_KVC, INC, g_kvl, proj + C_KVC, INC, 128, S);
            k_gemm<0><<<dim3(768 / 64, S / 64, 1), 256, 0, stream>>>(proj + C_QC, INC, nullptr, 0, w_uq, 768, qfull, 768, nullptr, nullptr, S, 768, 256, 0, 0, nullptr);
            k_gemm<0><<<dim3(1024 / 64, S / 64, 1), 256, 0, stream>>>(proj + C_KVC, INC, nullptr, 0, w_ukv, 1024, kvfull, 1024, nullptr, nullptr, S, 1024, 128, 0, 0, nullptr);
            k_mla_post<<<S * 8 / 4, 256, 0, stream>>>(qfull, kvfull, proj, cosT, sinT, g_mq, g_mk, Qm, Km, Vm, S, b * S);
            k_fox_post<<<S * 8 / 4, 256, 0, stream>>>(proj, g_fq, g_fk, b_ff, Fq, Fk, Fv, logf, S);
            k_cumsum<<<8, 64, 0, stream>>>(logf, fcum);
            k_attn_naive<96, 0><<<dim3(S / 64, 8), 256, 0, stream>>>(Qm, Km, Vm, nullptr, ob, 0, 0.10206207261596575f);
            k_attn_naive<64, 1><<<dim3(S / 64, 8), 256, 0, stream>>>(Fq, Fk, Fv, fcum, ob, 512, 0.125f);
            k_rmsnorm<<<S / 4, 256, 0, stream>>>(ob, D, g_om, yb, D, 512, S);
            k_rmsnorm<<<S / 4, 256, 0, stream>>>(ob + 512, D, g_of, yb + 512, D, 512, S);
            k_gemm<2><<<dim3(D / 64, S / 64, 1), 256, 0, stream>>>(yb, D, nullptr, 0, w_out, D, xb, D, nullptr, nullptr, S, D, D, 0, 0, nullptr);
        }
        k_rmsnorm<<<NTOK / 4, 256, 0, stream>>>(x, D, g_ffn, h2, D, D, NTOK);
        hipMemsetAsync(cnt, 0, NEXP * 4, stream);
        k_router<<<NTOK / 4, 256, 0, stream>>>(h2, w_rg, w_re, gate, cnt, list);
        k_gemm<0><<<dim3(256 / 64, NTOK / 64, NEXP), 256, 0, stream>>>(h2, D, list, 1, w_eg, 256, Cg, 256, list, cnt, 0, 256, D, (long)D * 256, NTOK, nullptr);
        k_gemm<0><<<dim3(256 / 64, NTOK / 64, NEXP), 256, 0, stream>>>(h2, D, list, 1, w_eu, 256, Cu, 256, list, cnt, 0, 256, D, (long)D * 256, NTOK, nullptr);
        k_silu_mul<<<(unsigned)(((long)2 * NTOK * 256 + 255) / 256), 256, 0, stream>>>(Cg, Cu, (long)2 * NTOK * 256);
        k_gemm<1><<<dim3(D / 64, NTOK / 64, NEXP), 256, 0, stream>>>(Cg, 256, list, 0, w_ed, D, x, D, list, cnt, 0, D, 256, (long)256 * D, NTOK, gate);
        k_gemm<0><<<dim3(D / 64, NTOK / 64, 1), 256, 0, stream>>>(p_in + (size_t)L * NTOK * 256, 256, nullptr, 0, w_pp, D, pp, D, nullptr, nullptr, NTOK, D, 256, 0, 0, nullptr);
        k_rmsnorm<<<NTOK / 4, 256, 0, stream>>>(pp, D, g_po, pp, D, D, NTOK);
        k_rmsnorm<<<NTOK / 4, 256, 0, stream>>>(x, D, g_pn, h2, D, D, NTOK);
        k_gemm<0><<<dim3(D / 64, NTOK / 64, 1), 256, 0, stream>>>(h2, D, nullptr, 0, w_pg, D, gl, D, nullptr, nullptr, NTOK, D, D, 0, 0, nullptr);
        k_ple_final<<<(unsigned)(((long)NTOK * D + 255) / 256), 256, 0, stream>>>(x, pp, gl, (long)NTOK * D);
    }
}
```

```cpp
#include <hip/hip_runtime.h>
#include <cstdio>
#include <cstdint>

#define LAS __attribute__((address_space(3)))
#define GAS __attribute__((address_space(1)))
typedef unsigned short bf16_t;
typedef short bf16x8 __attribute__((ext_vector_type(8)));
typedef short s16x4 __attribute__((ext_vector_type(4)));
typedef float f32x2 __attribute__((ext_vector_type(2)));
typedef float f32x4 __attribute__((ext_vector_type(4)));
typedef float f32x16 __attribute__((ext_vector_type(16)));
typedef unsigned u32x2 __attribute__((ext_vector_type(2)));
typedef unsigned u32x4 __attribute__((ext_vector_type(4)));

constexpr int DM = 1024, NB = 4, SEQ = 8192, NTOK = NB * SEQ, DEPTH = 2;
constexpr int INC = 1960, NEXP = 32;
constexpr int C_KVC = 256, C_KPE = 384, C_FQ = 416, C_FK = 928, C_FV = 1440, C_FL = 1952;
constexpr float EPS = 1e-6f;
constexpr float LOG2E = 1.4426950408889634f;
constexpr float C2_FOX = 0.125f * LOG2E;
constexpr float C2_MLA = 0.10206207261596575f * LOG2E;

__device__ __forceinline__ unsigned cvt_pk_bf16(float lo, float hi) { unsigned r; asm volatile("v_cvt_pk_bf16_f32 %0, %1, %2" : "=v"(r) : "v"(lo), "v"(hi)); return r; }
__device__ __forceinline__ float bf2f(unsigned short u) { return __uint_as_float((unsigned)u << 16); }
__device__ __forceinline__ float bflo(unsigned w) { return __uint_as_float(w << 16); }
__device__ __forceinline__ float bfhi(unsigned w) { return __uint_as_float(w & 0xffff0000u); }
__device__ __forceinline__ u32x4 pack8(const f32x4& a, const f32x4& b) { u32x4 w; w.x = cvt_pk_bf16(a[0], a[1]); w.y = cvt_pk_bf16(a[2], a[3]); w.z = cvt_pk_bf16(b[0], b[1]); w.w = cvt_pk_bf16(b[2], b[3]); return w; }
__device__ __forceinline__ float sum4sq(const f32x4& a) { return (a[0] * a[0] + a[1] * a[1]) + (a[2] * a[2] + a[3] * a[3]); }
__device__ __forceinline__ float red_fq(float s) { s += __shfl_xor(s, 16); s += __shfl_xor(s, 32); return s; }
__device__ __forceinline__ float sum16(const float* p) { const f32x4 a = *(const f32x4*)p, b = *(const f32x4*)(p + 4), c = *(const f32x4*)(p + 8), d = *(const f32x4*)(p + 12);
    return ((a[0] + a[1]) + (a[2] + a[3])) + ((b[0] + b[1]) + (b[2] + b[3])) + ((c[0] + c[1]) + (c[2] + c[3])) + ((d[0] + d[1]) + (d[2] + d[3])); }
__device__ __forceinline__ float sum8(const float* p) { const f32x4 a = *(const f32x4*)p, b = *(const f32x4*)(p + 4); return ((a[0] + a[1]) + (a[2] + a[3])) + ((b[0] + b[1]) + (b[2] + b[3])); }
__device__ __forceinline__ float log_sigmoid_f(float x) { return -(fmaxf(-x, 0.f) + log1pf(__expf(-fabsf(x)))); }

constexpr int NWAVES = 8;
constexpr size_t MiB = 1u << 20;
constexpr size_t WS_CTL = 0, CTL_ZERO_BYTES = 1 * MiB;
constexpr size_t WS_SSX0 = 1 * MiB, WS_SSX1 = 3 * MiB, WS_SSPP = 5 * MiB, WS_SSO = 7 * MiB, WS_SSX2 = 9 * MiB, WS_SSKPE = 10 * MiB, WS_SSQQ = 11 * MiB, WS_SSQKV = 12 * MiB,
                 WS_GATE = 13 * MiB, WS_LOGF = 14 * MiB, WS_F = 15 * MiB, WS_SSQN = 16 * MiB, WS_SSQR = 17 * MiB, WS_COS = 18 * MiB, WS_SIN = 20 * MiB, WS_LIST = 22 * MiB;
constexpr size_t WS_W = 28 * MiB, W_LAYER = 58 * MiB;
constexpr size_t WO_IN = 0, WO_UQ = 4 * MiB, WO_UKV = 4 * MiB + 512 * 1024, WO_OUT = 5 * MiB, WO_RT = 7 * MiB, WO_PG = 7 * MiB + 512 * 1024, WO_PP = 9 * MiB + 512 * 1024, WO_GU = 10 * MiB, WO_DN = 42 * MiB;
constexpr size_t WS_XBA = 144 * MiB, WS_XBB = 208 * MiB, WS_PBF = 272 * MiB, WS_MIX = 304 * MiB;
constexpr size_t WS_O = WS_XBA, WS_QRAW = WS_XBB;
constexpr size_t WS_QC = WS_MIX, WS_KVC = WS_MIX + 16 * MiB, WS_KPE = WS_MIX + 24 * MiB, WS_FQ = WS_MIX + 26 * MiB, WS_FK = WS_MIX + 58 * MiB, WS_FV = WS_MIX + 90 * MiB, WS_KMLA = WS_MIX + 122 * MiB, WS_VMLA = WS_MIX + 170 * MiB;
constexpr size_t WS_PP = WS_MIX, WS_HID = WS_MIX + 64 * MiB, WS_C1 = WS_MIX + 100 * MiB;
constexpr size_t WS_END = 512 * MiB;
static_assert(WS_VMLA + 32 * MiB <= WS_END && WS_C1 + 64 * MiB <= WS_END && WS_W + 2 * W_LAYER <= WS_XBA, "d_ws map");
constexpr int HID_ROWS = 2 * NTOK + NEXP * 256;
static_assert((size_t)HID_ROWS * 256 * 2 <= 36 * MiB, "hid");

namespace pg8 {
constexpr int BM = 256, BK = 64, HALF = 128, HTB = HALF * BK * 2, STAGE_BYTES = 8 * HTB, NXCD = 8, WGM = 8;
__host__ __device__ __forceinline__ int lds_byte(int r, int c) { const int st = (r >> 4) * 2 + (c >> 5), rr = r & 15, cc = c & 31, ob = rr * 64 + cc * 2; return st * 1024 + (ob ^ (((ob >> 9) & 1) << 5)); }
__host__ __device__ __forceinline__ void stage_rc(int b, int& R, int& C) { const int st = b / 1024, sb = b % 1024, swz = sb ^ (((sb >> 9) & 1) << 5); R = (st >> 1) * 16 + swz / 64; C = (st & 1) * 32 + (swz % 64) / 2; }
__host__ __device__ __forceinline__ int perm32(int rho) { const int n = rho >> 4, i = rho & 15; return 8 * (i >> 2) + 4 * n + (i & 3); }

struct Unit { int pm, pn, e, blk; };
struct Gemm { const bf16_t* A; const bf16_t* Bt; int K; };

struct StaticOrder {
    int nM, nN, nwg, G, c;
    __device__ void init(int M, int N, int G_, int c_) { nM = M / BM; nN = N / BM; nwg = nM * nN; G = G_; c = c_; }
    __device__ bool next(int i, Unit& u) const {
        const long L = (long)i * G + c; if (L >= nwg) return false;
        int wgid = (int)L; { const int q = nwg / NXCD, r = nwg % NXCD, xcd = wgid % NXCD, off = wgid / NXCD; wgid = (xcd < r ? xcd * (q + 1) : r * (q + 1) + (xcd - r) * q) + off; }
        const int nig = WGM * nN, gid = wgid / nig, fm = gid * WGM, gsz = (nM - fm) < WGM ? (nM - fm) : WGM;
        u.pm = fm + ((wgid % nig) % gsz); u.pn = (wgid % nig) / gsz; u.e = 0; u.blk = 0; return true;
    }
    __device__ __forceinline__ int arow(const Unit& u, int r) const { return u.pm * BM + r; }
};

template <int K, class Epi, class Sched, bool ALIGN_EPI>
__device__ __forceinline__ void gemm_phase(LAS unsigned char* lds, const Gemm g, const Sched& S, const Epi& E) {
    int tid_ = threadIdx.x; asm volatile("" : "+v"(tid_));
    const int tid = tid_, wid = __builtin_amdgcn_readfirstlane(tid >> 6), lane = tid & 63, wr = wid >> 2, wc = wid & 3, fr = lane & 15, fq = lane >> 4;
    int Kr = K; asm volatile("" : "+s"(Kr));
    const int nt = Kr / BK;
    unsigned voffB[2];
#pragma unroll
    for (int i = 0; i < 2; ++i) { int R_, C_; stage_rc(tid * 16 + i * 8192, R_, C_); const int Rb = (R_ & ~31) + perm32(R_ & 31); voffB[i] = (unsigned)(Rb * Kr + C_) * 2u; }
    const size_t kstep = (size_t)(BK * 2);
    const size_t hstep = (size_t)HALF * Kr * 2;
    const size_t tstep = 2 * hstep;
    const unsigned ldsw = (unsigned)wid * 1024u;
    const int aoff = lds_byte(wr * 64 + fr, fq * 8), boff = lds_byte(wc * 32 + fr, fq * 8);
#define PG8_SA(b, h) (((b) * 2 + (h)) * HTB)
#define PG8_SB(b, h) ((4 + (b) * 2 + (h)) * HTB)
#define PG8_STAGE(bufoff, gbase, voff) do { _Pragma("unroll") for (int _i = 0; _i < 2; ++_i) \
        __builtin_amdgcn_global_load_lds((const unsigned*)((const char*)(gbase) + (voff)[_i]), (LAS unsigned*)(lds + (bufoff) + ldsw + _i * 8192), 16, 0, 0); } while (0)
#define PG8_LDA(dst, b, h) do { _Pragma("unroll") for (int m = 0; m < 4; ++m) _Pragma("unroll") for (int k = 0; k < 2; ++k) dst[m][k] = *(const LAS bf16x8*)(lds + PG8_SA(b, h) + aoff + m * 2048 + k * 1024); } while (0)
#define PG8_LDB(dst, b, h) do { _Pragma("unroll") for (int n = 0; n < 2; ++n) _Pragma("unroll") for (int k = 0; k < 2; ++k) dst[n][k] = *(const LAS bf16x8*)(lds + PG8_SB(b, h) + boff + n * 2048 + k * 1024); } while (0)
#define PG8_MMA(ai, bj, At, Bt) do { __builtin_amdgcn_s_setprio(1); _Pragma("unroll") for (int m = 0; m < 4; ++m) _Pragma("unroll") for (int n = 0; n < 2; ++n) _Pragma("unroll") for (int k = 0; k < 2; ++k) \
        acc[ai][bj][m][n] = __builtin_amdgcn_mfma_f32_16x16x32_bf16(Bt[n][k], At[m][k], acc[ai][bj][m][n], 0, 0, 0); __builtin_amdgcn_s_setprio(0); } while (0)
#define PG8_WAIT_V(n) asm volatile("s_waitcnt vmcnt(" #n ")" ::: "memory")
#define PG8_WAIT_L(n) asm volatile("s_waitcnt lgkmcnt(" #n ")" ::: "memory")
#define PG8_BAR __builtin_amdgcn_s_barrier()
#define PG8_SCHED __builtin_amdgcn_sched_barrier(0)
#define PG8_AOFF(dst, u) do { int _t = tid; asm volatile("" : "+v"(_t)); _Pragma("unroll") for (int _i = 0; _i < 2; ++_i) { int _R, _C; stage_rc(_t * 16 + _i * 8192, _R, _C); _Pragma("unroll") for (int _h = 0; _h < 2; ++_h) dst[_h][_i] = ((unsigned)S.arow(u, _h * HALF + _R) * (unsigned)Kr + (unsigned)_C) * 2u; } } while (0)
    Unit cur, nxt; int ui = 0;
    if (!S.next(0, cur)) return;
    f32x4 acc[2][2][4][2];
#pragma unroll
    for (int a = 0; a < 2; ++a)
#pragma unroll
        for (int b = 0; b < 2; ++b)
#pragma unroll
            for (int m = 0; m < 4; ++m)
#pragma unroll
                for (int n = 0; n < 2; ++n) acc[a][b][m][n] = (f32x4){0.f, 0.f, 0.f, 0.f};
    bf16x8 At[4][2], B0[2][2], B1[2][2];
    unsigned ca[2][2], na[2][2];
    PG8_AOFF(ca, cur);
    const char* gA = (const char*)g.A;
    const char* cB = (const char*)g.Bt + (size_t)cur.pn * tstep;
    PG8_STAGE(PG8_SB(0, 0), cB, voffB); PG8_STAGE(PG8_SB(0, 1), cB + hstep, voffB); PG8_STAGE(PG8_SA(0, 0), gA, ca[0]); PG8_STAGE(PG8_SA(0, 1), gA, ca[1]);
    if (wr == 1) PG8_BAR;
    PG8_WAIT_V(2); PG8_BAR;
    PG8_STAGE(PG8_SB(1, 0), cB + kstep, voffB); PG8_STAGE(PG8_SA(1, 0), gA + kstep, ca[0]); PG8_STAGE(PG8_SB(1, 1), cB + hstep + kstep, voffB);
    PG8_WAIT_V(6); PG8_BAR;
    for (;;) {
        const bool has_next = S.next(ui + 1, nxt);
        if (has_next) { PG8_AOFF(na, nxt); } else {
#pragma unroll
            for (int _h = 0; _h < 2; ++_h)
#pragma unroll
                for (int _i = 0; _i < 2; ++_i) na[_h][_i] = ca[_h][_i]; }
        const char* nB = has_next ? (const char*)g.Bt + (size_t)nxt.pn * tstep : cB;
        for (int t = 0; t < nt; t += 2) {
            const bool last = (t == nt - 2);
            if constexpr (Epi::HAS_MID) { if (t == nt / 2) E.mid(acc, cur, wr, wc, fr, fq); }
            const char* a1 = gA + (size_t)(t + 1) * kstep;
            const char* a2 = last ? gA : gA + (size_t)(t + 2) * kstep; const char* b2 = last ? nB : cB + (size_t)(t + 2) * kstep;
            const char* a3 = a2 + kstep; const char* b3 = b2 + kstep;
            unsigned o2[2][2];
#pragma unroll
            for (int _h = 0; _h < 2; ++_h)
#pragma unroll
                for (int _i = 0; _i < 2; ++_i) o2[_h][_i] = last ? na[_h][_i] : ca[_h][_i];
            PG8_LDB(B0, 0, 0); PG8_LDB(B1, 0, 1); PG8_SCHED; PG8_LDA(At, 0, 0); PG8_STAGE(PG8_SA(1, 1), a1, ca[1]);
            PG8_WAIT_V(8); PG8_WAIT_L(0); PG8_BAR; PG8_MMA(0, 0, At, B0); PG8_MMA(0, 1, At, B1); PG8_BAR; PG8_SCHED;
            PG8_LDA(At, 0, 1); PG8_STAGE(PG8_SB(0, 0), b2, voffB); PG8_STAGE(PG8_SB(0, 1), b2 + hstep, voffB); PG8_STAGE(PG8_SA(0, 0), a2, o2[0]);
            PG8_WAIT_V(8); PG8_WAIT_L(0); PG8_BAR; PG8_MMA(1, 0, At, B0); PG8_MMA(1, 1, At, B1); PG8_BAR; PG8_SCHED;
            PG8_LDB(B0, 1, 0); PG8_LDB(B1, 1, 1); PG8_SCHED; PG8_LDA(At, 1, 0); PG8_STAGE(PG8_SA(0, 1), a2, o2[1]);
            PG8_WAIT_V(8); PG8_WAIT_L(0); PG8_BAR; PG8_MMA(0, 0, At, B0); PG8_MMA(0, 1, At, B1); PG8_BAR; PG8_SCHED;
            PG8_LDA(At, 1, 1); PG8_STAGE(PG8_SB(1, 0), b3, voffB); PG8_STAGE(PG8_SB(1, 1), b3 + hstep, voffB); PG8_STAGE(PG8_SA(1, 0), a3, o2[0]);
            PG8_WAIT_V(8); PG8_WAIT_L(0); PG8_BAR; PG8_MMA(1, 0, At, B0); PG8_MMA(1, 1, At, B1); PG8_BAR; PG8_SCHED;
        }
        if constexpr (ALIGN_EPI) { if (wr == 0) PG8_BAR; }
        E(acc, cur, wr, wc, fr, fq);
        if (!has_next) break;
#pragma unroll
        for (int a = 0; a < 2; ++a)
#pragma unroll
            for (int b = 0; b < 2; ++b)
#pragma unroll
                for (int m = 0; m < 4; ++m)
#pragma unroll
                    for (int n = 0; n < 2; ++n) acc[a][b][m][n] = (f32x4){0.f, 0.f, 0.f, 0.f};
        cur = nxt; cB = nB; ++ui;
#pragma unroll
        for (int _h = 0; _h < 2; ++_h)
#pragma unroll
            for (int _i = 0; _i < 2; ++_i) ca[_h][_i] = na[_h][_i];
        if constexpr (ALIGN_EPI) { if (wr == 1) PG8_BAR; }
    }
    PG8_WAIT_V(0);
    if constexpr (!ALIGN_EPI) { if (wr == 0) PG8_BAR; }
    PG8_BAR;
#undef PG8_SA
#undef PG8_SB
#undef PG8_STAGE
#undef PG8_LDA
#undef PG8_LDB
#undef PG8_MMA
#undef PG8_WAIT_V
#undef PG8_WAIT_L
#undef PG8_BAR
#undef PG8_SCHED
#undef PG8_AOFF
}
}
using pg8::Unit;
typedef f32x4 AccT[2][2][4][2];
#define EPI_ROWS(...) _Pragma("unroll") for (int ai = 0; ai < 2; ++ai) _Pragma("unroll") for (int m = 0; m < 4; ++m) { const int rl = ai * 128 + wr * 64 + m * 16 + fr; const int row = u.pm * 256 + rl; (void)row; __VA_ARGS__ asm volatile("" ::: "memory"); }

struct EpiInProj {
    static constexpr bool HAS_MID = false;
    unsigned char* ws; const float *bfox, *gfq, *gfk;
    __device__ __forceinline__ void mid(AccT&, const Unit&, int, int, int, int) const {}
    __device__ __forceinline__ void operator()(const AccT& acc, const Unit& u, int wr, int wc, int fr, int fq) const {
        const int pn = u.pn;
        const float* ssx = (const float*)(ws + WS_SSX0); bf16_t* Qc = (bf16_t*)(ws + WS_QC); bf16_t* Kvc = (bf16_t*)(ws + WS_KVC); bf16_t* Kpe = (bf16_t*)(ws + WS_KPE);
        float* ssq_q = (float*)(ws + WS_SSQQ); float* ssq_kv = (float*)(ws + WS_SSQKV); float* ss_kpe = (float*)(ws + WS_SSKPE); float* logf = (float*)(ws + WS_LOGF);
        if (pn == 0) {
            EPI_ROWS({ const float rinv = rsqrtf(sum16(ssx + (size_t)row * 16) * (1.f / 1024.f) + EPS); float s = 0.f;
_Pragma("unroll")
                for (int bj = 0; bj < 2; ++bj) { const f32x4 v0 = acc[ai][bj][m][0] * rinv, v1 = acc[ai][bj][m][1] * rinv; s += sum4sq(v0) + sum4sq(v1);
                    *(u32x4*)(Qc + (size_t)row * 256 + bj * 128 + wc * 32 + fq * 8) = pack8(v0, v1); }
                s = red_fq(s); if (fq == 0) ssq_q[(size_t)row * 4 + wc] = s; })
        } else if (pn == 1) {
            EPI_ROWS({ const float rinv = rsqrtf(sum16(ssx + (size_t)row * 16) * (1.f / 1024.f) + EPS);
                if (wc < 2) { float s = 0.f;
_Pragma("unroll")
                    for (int bj = 0; bj < 2; ++bj) { const f32x4 v0 = acc[ai][bj][m][0] * rinv, v1 = acc[ai][bj][m][1] * rinv; s += sum4sq(v0) + sum4sq(v1);
                        *(u32x4*)(Kvc + (size_t)row * 128 + wc * 64 + bj * 32 + fq * 8) = pack8(v0, v1); }
                    s = red_fq(s); if (fq == 0) ssq_kv[(size_t)row * 2 + wc] = s;
                } else if (wc == 2) { const f32x4 v0 = acc[ai][0][m][0] * rinv, v1 = acc[ai][0][m][1] * rinv; float s = sum4sq(v0) + sum4sq(v1);
                    *(u32x4*)(Kpe + (size_t)row * 32 + fq * 8) = pack8(v0, v1);
                    s = red_fq(s); if (fq == 0) ss_kpe[row] = s;
                } else { if (fq == 0) { const f32x4 v0 = acc[ai][0][m][0] * rinv, v1 = acc[ai][0][m][1] * rinv; const f32x4 b0 = *(const f32x4*)bfox, b1 = *(const f32x4*)(bfox + 4); f32x4 o0, o1;
_Pragma("unroll")
                        for (int i = 0; i < 4; ++i) { o0[i] = log_sigmoid_f(v0[i] + b0[i]); o1[i] = log_sigmoid_f(v1[i] + b1[i]); }
                        *(f32x4*)(logf + (size_t)row * 8) = o0; *(f32x4*)(logf + (size_t)row * 8 + 4) = o1; } } })
        } else {
            const int kind = (pn - 2) >> 1, head = 4 * ((pn - 2) & 1) + wc;
            bf16_t* dst = (bf16_t*)(ws + (kind == 0 ? WS_FQ : (kind == 1 ? WS_FK : WS_FV))); const float* g = kind == 0 ? gfq : gfk; const float osc = kind == 0 ? C2_FOX : 1.f;
            f32x4 g4[2][2];
_Pragma("unroll")
            for (int bj = 0; bj < 2; ++bj)
_Pragma("unroll")
                for (int n = 0; n < 2; ++n) g4[bj][n] = kind < 2 ? *(const f32x4*)(g + bj * 32 + fq * 8 + n * 4) * osc : (f32x4){1.f, 1.f, 1.f, 1.f};
            EPI_ROWS({ const float rinv = rsqrtf(sum16(ssx + (size_t)row * 16) * (1.f / 1024.f) + EPS); f32x4 v[2][2]; float s = 0.f;
_Pragma("unroll")
                for (int bj = 0; bj < 2; ++bj)
_Pragma("unroll")
                    for (int n = 0; n < 2; ++n) { v[bj][n] = acc[ai][bj][m][n] * rinv; s += sum4sq(v[bj][n]); }
                s = red_fq(s); const float hr = kind < 2 ? rsqrtf(s * (1.f / 64.f) + EPS) : 1.f;
_Pragma("unroll")
                for (int bj = 0; bj < 2; ++bj) *(u32x4*)(dst + (size_t)row * 512 + head * 64 + bj * 32 + fq * 8) = pack8(v[bj][0] * hr * g4[bj][0], v[bj][1] * hr * g4[bj][1]); })
        }
    }
};
struct EpiQUp {
    static constexpr bool HAS_MID = false;
    unsigned char* ws;
    __device__ __forceinline__ void mid(AccT&, const Unit&, int, int, int, int) const {}
    __device__ __forceinline__ void operator()(const AccT& acc, const Unit& u, int wr, int wc, int fr, int fq) const {
        const int pn = u.pn;
        const float* ssq_q = (const float*)(ws + WS_SSQQ); bf16_t* Qraw = (bf16_t*)(ws + WS_QRAW); float* ssq_qn = (float*)(ws + WS_SSQN); float* ssq_qr = (float*)(ws + WS_SSQR);
        EPI_ROWS({ const f32x4 sq = *(const f32x4*)(ssq_q + (size_t)row * 4); const float rinv = rsqrtf(((sq[0] + sq[1]) + (sq[2] + sq[3])) * (1.f / 256.f) + EPS);
            if (pn < 2) { const int head = 4 * pn + wc; float s = 0.f;
_Pragma("unroll")
                for (int bj = 0; bj < 2; ++bj) { const f32x4 v0 = acc[ai][bj][m][0] * rinv, v1 = acc[ai][bj][m][1] * rinv; s += sum4sq(v0) + sum4sq(v1);
                    *(u32x4*)(Qraw + (size_t)row * 768 + head * 96 + bj * 32 + fq * 8) = pack8(v0, v1); }
                s = red_fq(s); if (fq == 0) ssq_qn[(size_t)row * 8 + head] = s;
            } else {
_Pragma("unroll")
                for (int bj = 0; bj < 2; ++bj) { const int head = 4 * bj + wc; const f32x4 v0 = acc[ai][bj][m][0] * rinv, v1 = acc[ai][bj][m][1] * rinv; float s = sum4sq(v0) + sum4sq(v1);
                    *(u32x4*)(Qraw + (size_t)row * 768 + head * 96 + 64 + fq * 8) = pack8(v0, v1);
                    s = red_fq(s); if (fq == 0) ssq_qr[(size_t)row * 8 + head] = s; }
            } })
    }
};
struct EpiKvUp {
    static constexpr bool HAS_MID = false;
    unsigned char* ws; const float* gk;
    __device__ __forceinline__ void mid(AccT&, const Unit&, int, int, int, int) const {}
    __device__ __forceinline__ void operator()(const AccT& acc, const Unit& u, int wr, int wc, int fr, int fq) const {
        const int pn = u.pn;
        const float* ssq_kv = (const float*)(ws + WS_SSQKV); const float* ss_kpe = (const float*)(ws + WS_SSKPE); const bf16_t* Kpe = (const bf16_t*)(ws + WS_KPE);
        const float* cosT = (const float*)(ws + WS_COS); const float* sinT = (const float*)(ws + WS_SIN); bf16_t* Kmla = (bf16_t*)(ws + WS_KMLA); bf16_t* Vmla = (bf16_t*)(ws + WS_VMLA);
        if (pn < 2) {
            const int head = 4 * pn + wc;
            f32x4 g4[2][2];
_Pragma("unroll")
            for (int bj = 0; bj < 2; ++bj)
_Pragma("unroll")
                for (int n = 0; n < 2; ++n) g4[bj][n] = *(const f32x4*)(gk + bj * 32 + fq * 8 + n * 4);
            const f32x4 gr1 = *(const f32x4*)(gk + 64 + 4 * fq), gr2 = *(const f32x4*)(gk + 80 + 4 * fq);
            EPI_ROWS({ const f32x2 sk = *(const f32x2*)(ssq_kv + (size_t)row * 2); const float rinv = rsqrtf((sk[0] + sk[1]) * (1.f / 128.f) + EPS); f32x4 v[2][2]; float s = 0.f;
_Pragma("unroll")
                for (int bj = 0; bj < 2; ++bj)
_Pragma("unroll")
                    for (int n = 0; n < 2; ++n) { v[bj][n] = acc[ai][bj][m][n] * rinv; s += sum4sq(v[bj][n]); }
                s = red_fq(s) + ss_kpe[row]; const float hr = rsqrtf(s * (1.f / 96.f) + EPS);
                bf16_t* kd = Kmla + (size_t)row * 768 + head * 96;
_Pragma("unroll")
                for (int bj = 0; bj < 2; ++bj) *(u32x4*)(kd + bj * 32 + fq * 8) = pack8(v[bj][0] * hr * g4[bj][0], v[bj][1] * hr * g4[bj][1]);
                const u32x2 p1 = *(const u32x2*)(Kpe + (size_t)row * 32 + 4 * fq), p2 = *(const u32x2*)(Kpe + (size_t)row * 32 + 16 + 4 * fq);
                const f32x4 c = *(const f32x4*)(cosT + (size_t)row * 16 + 4 * fq), sn = *(const f32x4*)(sinT + (size_t)row * 16 + 4 * fq);
                const f32x4 x1 = (f32x4){bflo(p1.x), bfhi(p1.x), bflo(p1.y), bfhi(p1.y)} * hr * gr1, x2 = (f32x4){bflo(p2.x), bfhi(p2.x), bflo(p2.y), bfhi(p2.y)} * hr * gr2;
                const f32x4 o1 = x1 * c - x2 * sn, o2 = x2 * c + x1 * sn;
                u32x2 w1, w2; w1.x = cvt_pk_bf16(o1[0], o1[1]); w1.y = cvt_pk_bf16(o1[2], o1[3]); w2.x = cvt_pk_bf16(o2[0], o2[1]); w2.y = cvt_pk_bf16(o2[2], o2[3]);
                *(u32x2*)(kd + 64 + 4 * fq) = w1; *(u32x2*)(kd + 80 + 4 * fq) = w2; })
        } else {
            const int head = 4 * (pn - 2) + wc;
            EPI_ROWS({ const f32x2 sk = *(const f32x2*)(ssq_kv + (size_t)row * 2); const float rinv = rsqrtf((sk[0] + sk[1]) * (1.f / 128.f) + EPS);
_Pragma("unroll")
                for (int bj = 0; bj < 2; ++bj) *(u32x4*)(Vmla + (size_t)row * 512 + head * 64 + bj * 32 + fq * 8) = pack8(acc[ai][bj][m][0] * rinv, acc[ai][bj][m][1] * rinv); })
        }
    }
};
struct EpiOut {
    static constexpr bool HAS_MID = true;
    unsigned char* ws; const float* base; float* xout;
    __device__ __forceinline__ void mid(AccT& acc, const Unit& u, int wr, int wc, int fr, int fq) const {
        const float* sso = (const float*)(ws + WS_SSO);
        EPI_ROWS({ const float rm = rsqrtf(sum8(sso + (size_t)row * 16) * (1.f / 512.f) + EPS), rf = rsqrtf(sum8(sso + (size_t)row * 16 + 8) * (1.f / 512.f) + EPS); const float ratio = rm / rf;
_Pragma("unroll")
            for (int bj = 0; bj < 2; ++bj)
_Pragma("unroll")
                for (int n = 0; n < 2; ++n) acc[ai][bj][m][n] *= ratio; })
    }
    __device__ __forceinline__ void operator()(const AccT& acc, const Unit& u, int wr, int wc, int fr, int fq) const {
        const float* sso = (const float*)(ws + WS_SSO); bf16_t* xb = (bf16_t*)(ws + WS_XBB); float* ssx1 = (float*)(ws + WS_SSX1);
        EPI_ROWS({ const float rf = rsqrtf(sum8(sso + (size_t)row * 16 + 8) * (1.f / 512.f) + EPS); float s = 0.f;
_Pragma("unroll")
            for (int bj = 0; bj < 2; ++bj) { const size_t off = (size_t)row * 1024 + u.pn * 256 + bj * 128 + wc * 32 + fq * 8;
                const f32x4 v0 = *(const f32x4*)(base + off) + acc[ai][bj][m][0] * rf, v1 = *(const f32x4*)(base + off + 4) + acc[ai][bj][m][1] * rf; s += sum4sq(v0) + sum4sq(v1);
                *(f32x4*)(xout + off) = v0; *(f32x4*)(xout + off + 4) = v1; *(u32x4*)(xb + off) = pack8(v0, v1); }
            s = red_fq(s); if (fq == 0) ssx1[(size_t)row * 16 + u.pn * 4 + wc] = s; })
    }
};
struct EpiRouter {
    static constexpr bool HAS_MID = false;
    unsigned char* ws; unsigned* cnt;
    __device__ __forceinline__ void mid(AccT&, const Unit&, int, int, int, int) const {}
    __device__ __forceinline__ void operator()(const AccT& acc, const Unit& u, int wr, int wc, int fr, int fq) const {
        if (wc != 0) return;
        const float* ssx1 = (const float*)(ws + WS_SSX1); float* gate = (float*)(ws + WS_GATE); int* list = (int*)(ws + WS_LIST);
        EPI_ROWS({ const float rinv = rsqrtf(sum16(ssx1 + (size_t)row * 16) * (1.f / 1024.f) + EPS);
            const f32x4 gl = acc[ai][1][m][0] * rinv; int g = 0; float gm = gl[0];
_Pragma("unroll")
            for (int j = 1; j < 4; ++j) if (gl[j] > gm) { gm = gl[j]; g = j; }
            float gs = 0.f;
_Pragma("unroll")
            for (int j = 0; j < 4; ++j) gs += __expf(gl[j] - gm);
            float pg = 1.f / gs;
            g = __shfl(g, fr); pg = __shfl(pg, fr);
            if (fq == g) { float le[8];
_Pragma("unroll")
                for (int j = 0; j < 4; ++j) { le[j] = acc[ai][0][m][0][j] * rinv; le[4 + j] = acc[ai][0][m][1][j] * rinv; }
                int i1 = 0; float m1 = le[0];
_Pragma("unroll")
                for (int j = 1; j < 8; ++j) if (le[j] > m1) { m1 = le[j]; i1 = j; }
                int i2 = 0; float m2 = -3.0e38f;
_Pragma("unroll")
                for (int j = 0; j < 8; ++j) if (j != i1 && le[j] > m2) { m2 = le[j]; i2 = j; }
                const float e2 = __expf(m2 - m1), w1 = 1.f / (1.f + e2), w2 = e2 * w1;
                gate[2 * (size_t)row] = pg * w1; gate[2 * (size_t)row + 1] = pg * w2;
                const int ea = g * 8 + i1, eb = g * 8 + i2;
                const unsigned pa = __hip_atomic_fetch_add(cnt + ea, 1u, __ATOMIC_RELAXED, __HIP_MEMORY_SCOPE_AGENT); list[(size_t)ea * NTOK + pa] = 2 * row;
                const unsigned pb = __hip_atomic_fetch_add(cnt + eb, 1u, __ATOMIC_RELAXED, __HIP_MEMORY_SCOPE_AGENT); list[(size_t)eb * NTOK + pb] = 2 * row + 1; } })
    }
};
struct EpiPP {
    static constexpr bool HAS_MID = false;
    unsigned char* ws;
    __device__ __forceinline__ void mid(AccT&, const Unit&, int, int, int, int) const {}
    __device__ __forceinline__ void operator()(const AccT& acc, const Unit& u, int wr, int wc, int fr, int fq) const {
        bf16_t* pp = (bf16_t*)(ws + WS_PP); float* sspp = (float*)(ws + WS_SSPP);
        EPI_ROWS({ float s = 0.f;
_Pragma("unroll")
            for (int bj = 0; bj < 2; ++bj) { const f32x4 v0 = acc[ai][bj][m][0], v1 = acc[ai][bj][m][1]; s += sum4sq(v0) + sum4sq(v1);
                *(u32x4*)(pp + (size_t)row * 1024 + u.pn * 256 + bj * 128 + wc * 32 + fq * 8) = pack8(v0, v1); }
            s = red_fq(s); if (fq == 0) sspp[(size_t)row * 16 + u.pn * 4 + wc] = s; })
    }
};
struct EpiMoeUp {
    static constexpr bool HAS_MID = false;
    unsigned char* ws; const LAS unsigned* cntv; int npn;
    __device__ __forceinline__ void mid(AccT&, const Unit&, int, int, int, int) const {}
    __device__ __forceinline__ void operator()(const AccT& acc, const Unit& u, int wr, int wc, int fr, int fq) const {
        const int pnl = u.pn - u.e * npn; const int cnt = (int)cntv[u.e];
        const float* ssx1 = (const float*)(ws + WS_SSX1); const int* list = (const int*)(ws + WS_LIST); bf16_t* hid = (bf16_t*)(ws + WS_HID);
        EPI_ROWS({ const int li = u.blk * 256 + rl; const bool valid = li < cnt; float rinv = 0.f;
            if (valid) { const int tok = list[(size_t)u.e * NTOK + li] >> 1; rinv = rsqrtf(sum16(ssx1 + (size_t)tok * 16) * (1.f / 1024.f) + EPS); }
            f32x4 h[2];
_Pragma("unroll")
            for (int n = 0; n < 2; ++n) { const f32x4 gg = acc[ai][0][m][n] * rinv, uu = acc[ai][1][m][n] * rinv;
_Pragma("unroll")
                for (int i = 0; i < 4; ++i) h[n][i] = gg[i] * __builtin_amdgcn_rcpf(1.f + __expf(-gg[i])) * uu[i]; }
            *(u32x4*)(hid + (size_t)row * 256 + pnl * 128 + wc * 32 + fq * 8) = pack8(h[0], h[1]); })
    }
};
struct EpiMoeDown {
    static constexpr bool HAS_MID = false;
    unsigned char* ws; const LAS unsigned* cntv; float* x; int npn;
    __device__ __forceinline__ void mid(AccT&, const Unit&, int, int, int, int) const {}
    __device__ __forceinline__ void operator()(const AccT& acc, const Unit& u, int wr, int wc, int fr, int fq) const {
        const int pnl = u.pn - u.e * npn; const int cnt = (int)cntv[u.e];
        const int* list = (const int*)(ws + WS_LIST); const float* gate = (const float*)(ws + WS_GATE); bf16_t* c1 = (bf16_t*)(ws + WS_C1);
        EPI_ROWS({ const int li = u.blk * 256 + rl;
            if (li < cnt) { const int aid = list[(size_t)u.e * NTOK + li]; const int tok = aid >> 1; const float gt = gate[aid];
_Pragma("unroll")
                for (int bj = 0; bj < 2; ++bj) { const size_t off = (size_t)tok * 1024 + pnl * 256 + bj * 128 + wc * 32 + fq * 8; const f32x4 v0 = acc[ai][bj][m][0] * gt, v1 = acc[ai][bj][m][1] * gt;
                    if (aid & 1) *(u32x4*)(c1 + off) = pack8(v0, v1);
                    else { *(f32x4*)(x + off) = *(const f32x4*)(x + off) + v0; *(f32x4*)(x + off + 4) = *(const f32x4*)(x + off + 4) + v1; } } } })
    }
};
struct EpiPle {
    static constexpr bool HAS_MID = false;
    unsigned char* ws; const float* gpo; float* x;
    __device__ __forceinline__ void mid(AccT&, const Unit&, int, int, int, int) const {}
    __device__ __forceinline__ void operator()(const AccT& acc, const Unit& u, int wr, int wc, int fr, int fq) const {
        const float* ssx2 = (const float*)(ws + WS_SSX2); const float* sspp = (const float*)(ws + WS_SSPP); const bf16_t* pp = (const bf16_t*)(ws + WS_PP); bf16_t* xbn = (bf16_t*)(ws + WS_XBA); float* ssx0 = (float*)(ws + WS_SSX0);
        f32x4 g4[2][2];
_Pragma("unroll")
        for (int bj = 0; bj < 2; ++bj)
_Pragma("unroll")
            for (int n = 0; n < 2; ++n) g4[bj][n] = *(const f32x4*)(gpo + u.pn * 256 + bj * 128 + wc * 32 + fq * 8 + n * 4);
        EPI_ROWS({ const float r2 = rsqrtf(ssx2[row] * (1.f / 1024.f) + EPS), rp = rsqrtf(sum16(sspp + (size_t)row * 16) * (1.f / 1024.f) + EPS); float s = 0.f;
_Pragma("unroll")
            for (int bj = 0; bj < 2; ++bj) { const size_t off = (size_t)row * 1024 + u.pn * 256 + bj * 128 + wc * 32 + fq * 8;
                const u32x4 pw = *(const u32x4*)(pp + off); const f32x4 p0 = (f32x4){bflo(pw.x), bfhi(pw.x), bflo(pw.y), bfhi(pw.y)} * rp * g4[bj][0], p1 = (f32x4){bflo(pw.z), bfhi(pw.z), bflo(pw.w), bfhi(pw.w)} * rp * g4[bj][1];
                f32x4 v0 = *(const f32x4*)(x + off), v1 = *(const f32x4*)(x + off + 4);
_Pragma("unroll")
                for (int i = 0; i < 4; ++i) { v0[i] += p0[i] * __builtin_amdgcn_rcpf(1.f + __expf(-acc[ai][bj][m][0][i] * r2)); v1[i] += p1[i] * __builtin_amdgcn_rcpf(1.f + __expf(-acc[ai][bj][m][1][i] * r2)); }
                s += sum4sq(v0) + sum4sq(v1);
                *(f32x4*)(x + off) = v0; *(f32x4*)(x + off + 4) = v1; *(u32x4*)(xbn + off) = pack8(v0, v1); }
            s = red_fq(s); if (fq == 0) ssx0[(size_t)row * 16 + u.pn * 4 + wc] = s; })
    }
};

namespace att {
constexpr int KSLOT = 12288, VSLOT = 8192;
constexpr int L_K = 0, L_V = 3 * KSLOT, L_WS = L_V + 3 * VSLOT, L_OST = L_WS + 2048, L_G = L_OST + 32768, L_END = L_G + 32768;
static_assert(L_END <= 131072, "attention LDS map");
constexpr float SKIP_NATS = 64.f;
typedef LAS const char* lds_cptr;
typedef short v4i16_t __attribute__((ext_vector_type(4)));

__device__ __forceinline__ void glds16(const void* gsrc, unsigned lds_dst) { unsigned keep;
    asm volatile("s_mov_b32 %0, m0\n\ts_mov_b32 m0, %2\n\ts_nop 0\n\tglobal_load_lds_dwordx4 %1, off\n\ts_mov_b32 m0, %0" : "=&s"(keep) : "v"(gsrc), "s"(lds_dst) : "memory"); }
__device__ __forceinline__ int crow(int r, int hi) { return (r & 3) + 8 * (r >> 2) + 4 * hi; }
__device__ __forceinline__ s16x4 vtr(lds_cptr p) { return __builtin_bit_cast(s16x4, __builtin_amdgcn_ds_read_tr16_b64_v4i16((LAS v4i16_t*)p)); }
__device__ __forceinline__ float swapmax(float m) { auto rr = __builtin_amdgcn_permlane32_swap(__float_as_uint(m), __float_as_uint(m), false, false); return fmaxf(__uint_as_float(rr[0]), __uint_as_float(rr[1])); }
__device__ __forceinline__ float swapsum(float m) { auto rr = __builtin_amdgcn_permlane32_swap(__float_as_uint(m), __float_as_uint(m), false, false); return __uint_as_float(rr[0]) + __uint_as_float(rr[1]); }
__device__ __forceinline__ bf16x8 pk8(const f32x16& p, int b) { u32x4 w; w.x = cvt_pk_bf16(p[b], p[b + 1]); w.y = cvt_pk_bf16(p[b + 2], p[b + 3]); w.z = cvt_pk_bf16(p[b + 4], p[b + 5]); w.w = cvt_pk_bf16(p[b + 6], p[b + 7]); return __builtin_bit_cast(bf16x8, w); }

struct Args {
    const bf16_t *Qraw, *Kmla, *Vmla, *Fq, *Fk, *Fv; const float *ssq_qn, *ssq_qr, *gmq, *cosT, *sinT, *F, *gfq, *gfk; bf16_t* o; float* sso;
};

template <bool FOX>
__device__ __forceinline__ void attn_unit(const Args& A, int b, int h, int qb, LAS char* shm) {
    constexpr int DK = FOX ? 64 : 96, NQ = DK / 16, KP = FOX ? 512 : 768;
    int tid_ = threadIdx.x; asm volatile("" : "+v"(tid_));
    const int tid = tid_, lane = tid & 63, r32 = lane & 31, hi = lane >> 5; const int wid = __builtin_amdgcn_readfirstlane(tid >> 6);
    const long rowbase = (long)b * SEQ; const int q0 = qb * 256, qw = q0 + wid * 32;
    const unsigned lds0 = (unsigned)(uintptr_t)shm;
    LAS float* wsf = (LAS float*)(shm + L_WS) + wid * 64;
    LAS float* Gl = (LAS float*)(shm + L_G);
    const int NT = (q0 + 256) / 64; const int tw_last = qw >> 6;
    int t0 = 0;
    if constexpr (FOX) {
        float gq = fmaxf(fabsf(A.gfq[lane]), 0.f), gk = fabsf(A.gfk[lane]);
#pragma unroll
        for (int o = 32; o > 0; o >>= 1) { gq = fmaxf(gq, __shfl_xor(gq, o)); gk = fmaxf(gk, __shfl_xor(gk, o)); }
        const float margin = 2.f * (8.f * gq * gk) + SKIP_NATS;
        const float Fref = A.F[(rowbase + q0) * 8 + h];
        const int nfull = q0 / 64;
        bool keep0 = true, keep1 = true;
        if (lane < nfull) keep0 = (Fref - A.F[(rowbase + 64 * lane + 63) * 8 + h]) >= -margin;
        if (lane + 64 < nfull) keep1 = (Fref - A.F[(rowbase + 64 * (lane + 64) + 63) * 8 + h]) >= -margin;
        const unsigned long long k0 = __ballot(keep0), k1 = __ballot(keep1);
        t0 = k0 ? __builtin_ctzll(k0) : 64 + (k1 ? __builtin_ctzll(k1) : 0);
        t0 = __builtin_amdgcn_readfirstlane(t0);
        const int nk = q0 + 256 - 64 * t0;
        for (int j = tid; j < nk; j += 512) Gl[j] = (Fref - A.F[(rowbase + 64 * t0 + j) * 8 + h]) * LOG2E;
    }
    const bf16_t* Kg = (FOX ? A.Fk : A.Kmla) + rowbase * KP + h * DK + (long)lane * KP;
    const bf16_t* Vg = (FOX ? A.Fv : A.Vmla) + rowbase * 512 + h * 64 + (long)(16 * (wid & 3) + (lane >> 2)) * 512 + (wid >> 2) * 32 + (lane & 3) * 8;
    const unsigned kdst = lds0 + L_K + wid * 1024, vdst = lds0 + L_V + wid * 1024;
    const bool k2 = (!FOX) && wid < 4;
#define ISSUE(t, sl) do { glds16(Kg + (long)(t) * 64 * KP + wid * 8, (unsigned)__builtin_amdgcn_readfirstlane(kdst + (sl) * KSLOT)); \
        if (k2) glds16(Kg + (long)(t) * 64 * KP + (8 + wid) * 8, (unsigned)__builtin_amdgcn_readfirstlane(kdst + (sl) * KSLOT + 8192)); \
        glds16(Vg + (long)(t) * 64 * 512, (unsigned)__builtin_amdgcn_readfirstlane(vdst + (sl) * VSLOT)); } while (0)
    ISSUE(t0, 0);
    if (t0 + 1 < NT) ISSUE(t0 + 1, 1);
    bf16x8 qr[NQ];
    {
        const long row = rowbase + qw + r32;
        if constexpr (FOX) {
#pragma unroll
            for (int d0 = 0; d0 < NQ; ++d0) qr[d0] = *(const bf16x8*)(A.Fq + row * 512 + h * 64 + d0 * 16 + hi * 8);
        } else {
            const float ss = A.ssq_qn[row * 8 + h] + A.ssq_qr[row * 8 + h]; const float sc = rsqrtf(ss * (1.f / 96.f) + EPS) * C2_MLA;
            f32x4 qa[NQ][2];
#pragma unroll
            for (int d0 = 0; d0 < NQ; ++d0) { const u32x4 w = *(const u32x4*)(A.Qraw + row * 768 + h * 96 + d0 * 16 + hi * 8);
                const f32x4 g0 = *(const f32x4*)(A.gmq + d0 * 16 + hi * 8), g1 = *(const f32x4*)(A.gmq + d0 * 16 + hi * 8 + 4);
                qa[d0][0] = (f32x4){bflo(w.x), bfhi(w.x), bflo(w.y), bfhi(w.y)} * sc * g0; qa[d0][1] = (f32x4){bflo(w.z), bfhi(w.z), bflo(w.w), bfhi(w.w)} * sc * g1; }
#pragma unroll
            for (int e = 0; e < 2; ++e) { const f32x4 c = *(const f32x4*)(A.cosT + row * 16 + hi * 8 + e * 4), s = *(const f32x4*)(A.sinT + row * 16 + hi * 8 + e * 4);
                const f32x4 x1 = qa[4][e], x2 = qa[5][e]; qa[4][e] = x1 * c - x2 * s; qa[5][e] = x2 * c + x1 * s; }
#pragma unroll
            for (int d0 = 0; d0 < NQ; ++d0) qr[d0] = __builtin_bit_cast(bf16x8, pack8(qa[d0][0], qa[d0][1]));
        }
    }
    float mrun = -INFINITY, lrun = 0.f; f32x16 o[2]; o[0] = f32x16{}; o[1] = f32x16{};
    const lds_cptr shm3 = (lds_cptr)shm;
    const lds_cptr kp0 = shm3 + L_K + hi * 1024 + r32 * 16;
    const lds_cptr vp0 = shm3 + L_V + ((lane >> 4) & 1) * 32 + (lane & 3) * 8 + (4 * hi + ((lane & 15) >> 2)) * 64;
    int sl = 0;
    for (int t = t0; t < NT; ++t) {
        if (t + 1 < NT) { if (k2) asm volatile("s_waitcnt vmcnt(3) lgkmcnt(0)\n\ts_barrier" ::: "memory"); else asm volatile("s_waitcnt vmcnt(2) lgkmcnt(0)\n\ts_barrier" ::: "memory"); }
        else asm volatile("s_waitcnt vmcnt(0) lgkmcnt(0)\n\ts_barrier" ::: "memory");
        if (t + 2 < NT) { const int s2 = sl == 0 ? 2 : sl - 1; ISSUE(t + 2, s2); }
        if (t <= tw_last) {
            const lds_cptr kp = kp0 + sl * KSLOT;
            f32x16 p0 = f32x16{}, p1 = f32x16{};
#pragma unroll
            for (int d0 = 0; d0 < NQ; ++d0) { const bf16x8 b0 = *(const LAS bf16x8*)(kp + d0 * 2048), b1 = *(const LAS bf16x8*)(kp + d0 * 2048 + 512);
                p0 = __builtin_amdgcn_mfma_f32_32x32x16_bf16(b0, qr[d0], p0, 0, 0, 0); p1 = __builtin_amdgcn_mfma_f32_32x32x16_bf16(b1, qr[d0], p1, 0, 0, 0); }
            if constexpr (FOX) {
                const LAS float* Gt = Gl + (t - t0) * 64 + 4 * hi;
#pragma unroll
                for (int rq = 0; rq < 4; ++rq) { const f32x4 ga = *(const LAS f32x4*)(Gt + 8 * rq), gb = *(const LAS f32x4*)(Gt + 32 + 8 * rq);
#pragma unroll
                    for (int i = 0; i < 4; ++i) { p0[4 * rq + i] += ga[i]; p1[4 * rq + i] += gb[i]; } }
                if (64 * t + 63 > qw) { const int qrel = qw + r32 - 64 * t;
#pragma unroll
                    for (int r = 0; r < 16; ++r) { const int kv = crow(r, hi); if (kv > qrel) p0[r] = -INFINITY; if (kv + 32 > qrel) p1[r] = -INFINITY; } }
            }
            float mx = fmaxf(p0[0], p1[0]);
#pragma unroll
            for (int r = 1; r < 16; ++r) mx = fmaxf(mx, fmaxf(p0[r], p1[r]));
            mx = swapmax(mx);
            const float mnew = fmaxf(mrun, mx);
            if (__any(mnew > mrun)) {
                const float al = __builtin_amdgcn_exp2f(mrun - mnew); lrun *= al;
                if (hi == 0) wsf[r32] = al;
                asm volatile("s_waitcnt lgkmcnt(0)" ::: "memory");
#pragma unroll
                for (int rq = 0; rq < 4; ++rq) { const f32x4 af = *(const LAS f32x4*)(wsf + 8 * rq + 4 * hi);
#pragma unroll
                    for (int i = 0; i < 4; ++i) { o[0][4 * rq + i] *= af[i]; o[1][4 * rq + i] *= af[i]; } }
                mrun = mnew;
            }
            float sacc = 0.f;
#pragma unroll
            for (int r = 0; r < 16; ++r) { p0[r] = __builtin_amdgcn_exp2f(p0[r] - mrun); p1[r] = __builtin_amdgcn_exp2f(p1[r] - mrun); sacc += p0[r] + p1[r]; }
            lrun += sacc;
            const bf16x8 pa0 = pk8(p0, 0), pa1 = pk8(p0, 8), pa2 = pk8(p1, 0), pa3 = pk8(p1, 8);
            const lds_cptr vp = vp0 + sl * VSLOT;
#pragma unroll
            for (int d0 = 0; d0 < 2; ++d0) { s16x4 lo[4], hh[4];
#pragma unroll
                for (int ks = 0; ks < 4; ++ks) { lo[ks] = vtr(vp + d0 * 4096 + ks * 1024); hh[ks] = vtr(vp + d0 * 4096 + ks * 1024 + 512); }
#define PKV(k) (bf16x8){lo[k][0], lo[k][1], lo[k][2], lo[k][3], hh[k][0], hh[k][1], hh[k][2], hh[k][3]}
                o[d0] = __builtin_amdgcn_mfma_f32_32x32x16_bf16(pa0, PKV(0), o[d0], 0, 0, 0);
                o[d0] = __builtin_amdgcn_mfma_f32_32x32x16_bf16(pa1, PKV(1), o[d0], 0, 0, 0);
                o[d0] = __builtin_amdgcn_mfma_f32_32x32x16_bf16(pa2, PKV(2), o[d0], 0, 0, 0);
                o[d0] = __builtin_amdgcn_mfma_f32_32x32x16_bf16(pa3, PKV(3), o[d0], 0, 0, 0);
#undef PKV
            }
        }
        sl = sl == 2 ? 0 : sl + 1;
    }
#undef ISSUE
    lrun = swapsum(lrun);
    if (hi == 0) wsf[32 + r32] = lrun;
    asm volatile("s_waitcnt lgkmcnt(0)" ::: "memory");
    float rli[16];
#pragma unroll
    for (int rq = 0; rq < 4; ++rq) { const f32x4 lf = *(const LAS f32x4*)(wsf + 32 + 8 * rq + 4 * hi);
#pragma unroll
        for (int i = 0; i < 4; ++i) rli[4 * rq + i] = __builtin_amdgcn_rcpf(lf[i]); }
    const int hh = FOX ? 8 + h : h;
    bf16_t* Ow = A.o + (rowbase + qw) * 1024 + hh * 64;
    LAS bf16_t* stg = (LAS bf16_t*)(shm + L_OST) + wid * 2048;
#pragma unroll
    for (int r = 0; r < 16; ++r) { const int orow = crow(r, hi);
#pragma unroll
        for (int d0 = 0; d0 < 2; ++d0) { const float v = o[d0][r] * rli[r]; stg[orow * 64 + d0 * 32 + r32] = (bf16_t)(cvt_pk_bf16(v, 0.f) & 0xffffu); } }
    asm volatile("s_waitcnt lgkmcnt(0)" ::: "memory");
#pragma unroll
    for (int i = 0; i < 4; ++i) { const int row = i * 8 + (lane >> 3), ch = lane & 7; const u32x4 v = *(const LAS u32x4*)(stg + row * 64 + ch * 8);
        *(u32x4*)(Ow + (long)row * 1024 + ch * 8) = v;
        float s = 0.f; { const float a0 = bflo(v.x), a1 = bfhi(v.x), a2 = bflo(v.y), a3 = bfhi(v.y), a4 = bflo(v.z), a5 = bfhi(v.z), a6 = bflo(v.w), a7 = bfhi(v.w);
            s = ((a0 * a0 + a1 * a1) + (a2 * a2 + a3 * a3)) + ((a4 * a4 + a5 * a5) + (a6 * a6 + a7 * a7)); }
        s += __shfl_xor(s, 1); s += __shfl_xor(s, 2); s += __shfl_xor(s, 4);
        if (ch == 0) A.sso[(rowbase + qw + row) * 16 + hh] = s; }
    asm volatile("s_waitcnt lgkmcnt(0)\n\ts_barrier" ::: "memory");
}

__device__ __forceinline__ void attn_phase(const Args& A, int vcu, int G, LAS char* shm) {
    for (int v = vcu; v < 256; v += G) {
        const int bh = v >> 3, s = v & 7;
#pragma unroll 1
        for (int i = 0; i < 4; ++i) { const int qb = (i == 0) ? s : (i == 1) ? 15 - s : (i == 2) ? 16 + s : 31 - s; attn_unit<false>(A, bh >> 3, bh & 7, qb, shm); }
#pragma unroll 1
        for (int i = 0; i < 4; ++i) { const int qb = (i == 0) ? 31 - s : (i == 1) ? 16 + s : (i == 2) ? 15 - s : s; attn_unit<true>(A, bh >> 3, bh & 7, qb, shm); }
    }
}
}

constexpr int CW_TMO = 0, CW_BAR = 4096, CW_CNT = 200000;
constexpr int RING_BYTES = 131072, LDSCTL_OFF = RING_BYTES, LDS_BYTES = 147456;
constexpr int LC_MISC = 0, LC_PRE = 256, LC_CNT = 512;

typedef GAS unsigned gu32;
#define RLX_AGENT __ATOMIC_RELAXED, __HIP_MEMORY_SCOPE_AGENT

#define XB_TMO      128
#define XB_XCNT(j)  (256  + 64 * (j))
#define XB_XSUB(j)  (1280 + 64 * (j))
#define XB_XGEN(j)  (2304 + 64 * (j))
#define XB_TOP      3328
#define XB_TOPGEN   3392
#define XCD_BAR_WORDS 3456
#define XB_SPIN_CAP (1u << 18)
__device__ __forceinline__ unsigned xb_ld(unsigned* p)              { return __hip_atomic_load(p, __ATOMIC_RELAXED, __HIP_MEMORY_SCOPE_AGENT); }
__device__ __forceinline__ unsigned xb_add(unsigned* p, unsigned v) { return __hip_atomic_fetch_add(p, v, __ATOMIC_RELAXED, __HIP_MEMORY_SCOPE_AGENT); }
__device__ __forceinline__ unsigned xb_xcc_id() { return (unsigned)__builtin_amdgcn_s_getreg((3 << 11) | 20) & 0xFu; }
#define XB_SPIN(cond, bar) do { unsigned _sp = 0; while (cond) { __builtin_amdgcn_s_sleep(1); \
    if ((++_sp & 255u) == 0u) { if (xb_ld(&(bar)[XB_TMO])) break; if (_sp > XB_SPIN_CAP) { atomicAdd(&(bar)[XB_TMO], 1u); break; } } } } while (0)
struct XcdBarrier { unsigned* bar; unsigned x; volatile LAS unsigned* st; };
__device__ __forceinline__ XcdBarrier xcd_barrier_post(unsigned* bar, volatile LAS unsigned* st) {
    XcdBarrier b; b.bar = bar; b.x = xb_xcc_id(); b.st = st;
    if (threadIdx.x == 0) (void)xb_add(&bar[XB_XCNT(b.x)], 1u);
    return b;
}
__device__ __forceinline__ void xcd_barrier_complete(unsigned* bar, unsigned x, unsigned& nloc, unsigned& nx) {
    const unsigned G = gridDim.x * gridDim.y * gridDim.z;
    unsigned sum, cnt, mine, sp = 0u;
    for (;;) {
        sum = 0u; cnt = 0u; mine = 0u;
#pragma unroll
        for (unsigned j = 0; j < 16; ++j) { const unsigned c = xb_ld(&bar[XB_XCNT(j)]); sum += c; cnt += (c > 0u) ? 1u : 0u; mine = (j == x) ? c : mine; }
        if (sum == G) break;
        __builtin_amdgcn_s_sleep(1);
        if ((++sp & 255u) == 0u) { if (xb_ld(&bar[XB_TMO])) break; if (sp > XB_SPIN_CAP) { atomicAdd(&bar[XB_TMO], 1u); break; } }
    }
    nloc = mine > 0u ? mine : 1u; nx = cnt > 0u ? cnt : 1u;
}
__device__ __forceinline__ void xcd_barrier(const XcdBarrier& b) {
    asm volatile("s_waitcnt vmcnt(0)" ::: "memory");
    __syncthreads();
    if (threadIdx.x == 0) {
        unsigned* bar = b.bar;
        __builtin_amdgcn_s_waitcnt(0);
        unsigned nloc = b.st[0], nx = b.st[1];
        if (nloc == 0u) { xcd_barrier_complete(bar, b.x, nloc, nx); b.st[0] = nloc; b.st[1] = nx; }
        const unsigned old = xb_add(&bar[XB_XSUB(b.x)], 1u);
        const unsigned gen = old / nloc;
        if (old + 1u == (gen + 1u) * nloc) {
            __builtin_amdgcn_fence(__ATOMIC_RELEASE, "agent");
            asm volatile("s_waitcnt vmcnt(0)" ::: "memory");
            const unsigned og = xb_add(&bar[XB_TOP], 1u);
            const unsigned tg = og / nx;
            if (og + 1u == (tg + 1u) * nx) xb_add(&bar[XB_TOPGEN], 1u);
            else XB_SPIN(xb_ld(&bar[XB_TOPGEN]) == tg, bar);
            __builtin_amdgcn_fence(__ATOMIC_ACQUIRE, "agent");
            xb_add(&bar[XB_XGEN(b.x)], 1u);
            asm volatile("s_waitcnt vmcnt(0)" ::: "memory");
        } else {
            XB_SPIN(xb_ld(&bar[XB_XGEN(b.x)]) == gen, bar);
            __builtin_amdgcn_fence(__ATOMIC_ACQUIRE, "agent");
            asm volatile("s_waitcnt vmcnt(0)" ::: "memory");
        }
    }
    __syncthreads();
}

__device__ __forceinline__ float wave_sum(float v) {
#pragma unroll
    for (int o = 1; o < 64; o <<= 1) v += __shfl_xor(v, o);
    return v;
}
#define LDS_WAIT() asm volatile("s_waitcnt lgkmcnt(0)" ::: "memory")

__device__ __forceinline__ int maprow(int kind, int n) {
    switch (kind) {
    default: return n;
    case 1: {
        if (n < 256) return n;
        if (n < 384) { const int j = n - 256, q = j >> 5, c = j & 31; return 256 + (q & 1) * 128 + (q >> 1) * 32 + c; }
        if (n < 416) return 256 + 64 + (n - 384);
        if (n < 1952) { const int f = n - 416, k3 = f >> 9, r = f & 511, hd = r >> 6, d = r & 63; return (2 + 2 * k3 + (hd >> 2)) * 256 + (d >> 5) * 128 + (hd & 3) * 32 + (d & 31); }
        return 256 + 96 + (n - 1952); }
    case 2: { const int hd = n / 96, dd = n - hd * 96; if (dd < 64) return (hd >> 2) * 256 + (dd >> 5) * 128 + (hd & 3) * 32 + (dd & 31); return 512 + (hd >> 2) * 128 + (hd & 3) * 32 + (dd - 64); }
    case 3: { const int hd = n >> 7, dd = n & 127; if (dd < 64) return (hd >> 2) * 256 + (dd >> 5) * 128 + (hd & 3) * 32 + (dd & 31); const int d = dd - 64; return 512 + (hd >> 2) * 256 + (d >> 5) * 128 + (hd & 3) * 32 + (d & 31); }
    case 4: return (n >> 7) * 256 + (n & 127);
    case 5: return (n >> 7) * 256 + 128 + (n & 127);
    case 6: return 128 + n;
    }
}
__device__ __forceinline__ void conv_item(const float* W, int K, int Nsrc, bf16_t* WT, int kind, const float* s1, const float* s2, int split, LAS float* scr, int item, int lane) {
    const int nblk = (Nsrc + 31) / 32, kb = item / nblk, nb = item - kb * nblk, k0 = 64 * kb, n0 = 32 * nb;
    const bool nv = n0 + (lane & 31) < Nsrc;
#pragma unroll 8
    for (int i = 0; i < 32; ++i) { const int kk = 2 * i + (lane >> 5); scr[kk * 33 + (lane & 31)] = nv ? W[(size_t)(k0 + kk) * Nsrc + n0 + (lane & 31)] : 0.f; }
    LDS_WAIT(); asm volatile("" ::: "memory");
    const int c = lane & 7;
    float sc[8];
#pragma unroll
    for (int e = 0; e < 8; ++e) { const int k = k0 + 8 * c + e; sc[e] = s1 ? (k < split ? s1[k] : s2[k - split]) : 1.f; }
#pragma unroll
    for (int j = 0; j < 4; ++j) { const int n = (lane >> 3) + 8 * j; const LAS float* s = scr + (8 * c) * 33 + n;
        if (n0 + n < Nsrc) { u32x4 o; o.x = cvt_pk_bf16(s[0 * 33] * sc[0], s[1 * 33] * sc[1]); o.y = cvt_pk_bf16(s[2 * 33] * sc[2], s[3 * 33] * sc[3]); o.z = cvt_pk_bf16(s[4 * 33] * sc[4], s[5 * 33] * sc[5]); o.w = cvt_pk_bf16(s[6 * 33] * sc[6], s[7 * 33] * sc[7]);
            *(u32x4*)(WT + (size_t)maprow(kind, n0 + n) * K + k0 + 8 * c) = o; } }
    LDS_WAIT(); asm volatile("" ::: "memory");
}

struct KArgs { const void* in[27]; float* out; unsigned char* ws; int ph_lo, ph_hi, li, pad; };

constexpr int I_IN = 16 * 62, I_UQ = 4 * 24, I_UKV = 2 * 32, I_OUT = 16 * 32, I_RE = 16, I_RG = 16, I_GU = NEXP * 2 * 16 * 8, I_DN = NEXP * 4 * 32, I_PG = 16 * 32, I_PP = 4 * 32;
constexpr int I_LAYER = I_IN + I_UQ + I_UKV + I_OUT + I_RE + I_RG + I_GU + I_DN + I_PG + I_PP;

struct MoeOrder {
    const LAS int* pre; const LAS unsigned* cntl; const int* list; int npn, G, c; bool gather;
    __device__ __forceinline__ bool next(int i, Unit& u) const {
        const int L = i * G + c; const int TB = pre[32]; if (L >= TB * npn) return false;
        const int bg = L / npn, pl = L - bg * npn; int e = 0;
        for (int j = 1; j < 32; ++j) e += (pre[j] <= bg) ? 1 : 0;
        u.pm = bg; u.e = e; u.blk = bg - pre[e]; u.pn = e * npn + pl; return true;
    }
    __device__ __forceinline__ int arow(const Unit& u, int r) const {
        if (!gather) return u.pm * 256 + r;
        int li = u.blk * 256 + r; const int cn = (int)cntl[u.e]; li = li < cn ? li : cn - 1;
        return list[(size_t)u.e * NTOK + li] >> 1;
    }
};

#ifndef MK_CUTS
#define MK_CUTS {0, 19}
#endif
constexpr int NPHASE = 19;

__global__ void __launch_bounds__(NWAVES * 64, 2) mega_fwd(KArgs args) {
    extern __shared__ __attribute__((aligned(16))) unsigned char lds_raw[];
    LAS unsigned char* lds0 = (LAS unsigned char*)lds_raw;
    volatile LAS unsigned* MISC = (volatile LAS unsigned*)(lds0 + LDSCTL_OFF + LC_MISC);
    const int G = gridDim.x; const int bx = blockIdx.x; const int vcu = (G % 8 == 0) ? (bx % 8) * (G / 8) + bx / 8 : bx;
    for (int u = threadIdx.x; u < (LDS_BYTES - LDSCTL_OFF) / 4; u += NWAVES * 64) ((LAS unsigned*)(lds0 + LDSCTL_OFF))[u] = 0u;
    __syncthreads();
    (void)xcd_barrier_post((unsigned*)(args.ws + WS_CTL) + CW_BAR + args.li * XCD_BAR_WORDS, MISC + 8);
    const int lo = args.ph_lo, hi = args.ph_hi;
#ifndef PH_MASK
#define PH_MASK 0x3ff
#endif
#define PHM(k) ((PH_MASK >> (k)) & 1)
#define IN(k) (lo <= (k) && (k) < hi)
#define SEAM(k) do { if (IN(k) && IN((k) + 1)) { XcdBarrier bar_; bar_.bar = (unsigned*)(args.ws + WS_CTL) + CW_BAR + args.li * XCD_BAR_WORDS; bar_.x = xb_xcc_id(); bar_.st = (volatile LAS unsigned*)(lds0 + LDSCTL_OFF + LC_MISC) + 8; xcd_barrier(bar_); } } while (0)
    const int NGW = G * NWAVES, NGT = G * 512;
#define ssx0 ((float*)(wsp + WS_SSX0))
#define ssx1 ((float*)(wsp + WS_SSX1))
#define sspp ((float*)(wsp + WS_SSPP))
#define sso ((float*)(wsp + WS_SSO))
#define ssx2 ((float*)(wsp + WS_SSX2))
#define sskpe ((float*)(wsp + WS_SSKPE))
#define ssqq ((float*)(wsp + WS_SSQQ))
#define ssqkv ((float*)(wsp + WS_SSQKV))
#define gate ((float*)(wsp + WS_GATE))
#define logf ((float*)(wsp + WS_LOGF))
#define Fc ((float*)(wsp + WS_F))
#define ssqn ((float*)(wsp + WS_SSQN))
#define ssqr ((float*)(wsp + WS_SSQR))
#define cosT ((float*)(wsp + WS_COS))
#define sinT ((float*)(wsp + WS_SIN))
#define list ((int*)(wsp + WS_LIST))
#define xbA ((bf16_t*)(wsp + WS_XBA))
#define xbB ((bf16_t*)(wsp + WS_XBB))
#define pbf ((bf16_t*)(wsp + WS_PBF))
#define Qc ((bf16_t*)(wsp + WS_QC))
#define Kvc ((bf16_t*)(wsp + WS_KVC))
#define Kpe ((bf16_t*)(wsp + WS_KPE))
#define Fq ((bf16_t*)(wsp + WS_FQ))
#define Fk ((bf16_t*)(wsp + WS_FK))
#define Fv ((bf16_t*)(wsp + WS_FV))
#define Kmla ((bf16_t*)(wsp + WS_KMLA))
#define Vmla ((bf16_t*)(wsp + WS_VMLA))
#define Qraw ((bf16_t*)(wsp + WS_QRAW))
#define ob ((bf16_t*)(wsp + WS_O))
#define ppb ((bf16_t*)(wsp + WS_PP))
#define hid ((bf16_t*)(wsp + WS_HID))
#define c1 ((bf16_t*)(wsp + WS_C1))
#define ctl ((unsigned*)(wsp + WS_CTL))
#define Wl (wsp + WS_W + (size_t)L * W_LAYER)
#define PHASE_PTRS unsigned char* wsp = args.ws; asm volatile("" : "+s"(wsp)); const float* x_in = (const float*)args.in[0]; float* xo = args.out; (void)x_in; (void)xo; \
    int tid = threadIdx.x; asm volatile("" : "+v"(tid)); const int lane = tid & 63, wave = __builtin_amdgcn_readfirstlane(tid >> 6); (void)lane; (void)wave; \
    unsigned ldo_ = 0u; asm volatile("" : "+s"(ldo_)); LAS unsigned char* lds = lds0 + ldo_; LAS int* preL = (LAS int*)(lds + LDSCTL_OFF + LC_PRE); LAS unsigned* cntL = (LAS unsigned*)(lds + LDSCTL_OFF + LC_CNT); (void)preL; (void)cntL; \
    const int gw = vcu * NWAVES + wave, gt = vcu * 512 + tid; (void)gw; (void)gt
#define INF(i) ((const float*)args.in[i])

    if (PHM(0) && IN(0)) {
        PHASE_PTRS; unsigned char* ws = wsp;
        LAS float* scr = (LAS float*)(lds + wave * 16384);
        for (int it = gw; it < 2 * I_LAYER; it += NGW) {
            const int L = it >= I_LAYER ? 1 : 0; int r = it - L * I_LAYER;
            if (r < I_IN) { conv_item(INF(4) + (size_t)L * DM * INC, DM, INC, (bf16_t*)(Wl + WO_IN), 1, INF(3) + L * DM, nullptr, DM, scr, r, lane); continue; } r -= I_IN;
            if (r < I_UQ) { conv_item(INF(6) + (size_t)L * 256 * 768, 256, 768, (bf16_t*)(Wl + WO_UQ), 2, INF(5) + L * 256, nullptr, 256, scr, r, lane); continue; } r -= I_UQ;
            if (r < I_UKV) { conv_item(INF(8) + (size_t)L * 128 * 1024, 128, 1024, (bf16_t*)(Wl + WO_UKV), 3, INF(7) + L * 128, nullptr, 128, scr, r, lane); continue; } r -= I_UKV;
            if (r < I_OUT) { conv_item(INF(16) + (size_t)L * DM * DM, DM, DM, (bf16_t*)(Wl + WO_OUT), 0, INF(14) + L * 512, INF(15) + L * 512, 512, scr, r, lane); continue; } r -= I_OUT;
            if (r < I_RE) { conv_item(INF(19) + (size_t)L * DM * 32, DM, 32, (bf16_t*)(Wl + WO_RT), 0, INF(17) + L * DM, nullptr, DM, scr, r, lane); continue; } r -= I_RE;
            if (r < I_RG) { conv_item(INF(18) + (size_t)L * DM * 4, DM, 4, (bf16_t*)(Wl + WO_RT), 6, INF(17) + L * DM, nullptr, DM, scr, r, lane); continue; } r -= I_RG;
            if (r < I_GU) { const int e = r >> 8, mt = (r >> 7) & 1, ii = r & 127;
                conv_item(INF(mt ? 21 : 20) + ((size_t)L * NEXP + e) * DM * 256, DM, 256, (bf16_t*)(Wl + WO_GU) + (size_t)e * 512 * DM, mt ? 5 : 4, INF(17) + L * DM, nullptr, DM, scr, ii, lane); continue; } r -= I_GU;
            if (r < I_DN) { const int e = r >> 7, ii = r & 127;
                conv_item(INF(22) + ((size_t)L * NEXP + e) * 256 * DM, 256, DM, (bf16_t*)(Wl + WO_DN) + (size_t)e * DM * 256, 0, nullptr, nullptr, 0, scr, ii, lane); continue; } r -= I_DN;
            if (r < I_PG) { conv_item(INF(24) + (size_t)L * DM * DM, DM, DM, (bf16_t*)(Wl + WO_PG), 0, INF(23) + L * DM, nullptr, DM, scr, r, lane); continue; } r -= I_PG;
            conv_item(INF(25) + (size_t)L * 256 * DM, 256, DM, (bf16_t*)(Wl + WO_PP), 0, nullptr, nullptr, 0, scr, r, lane);
        }
        for (int it = gw; it < 2 * (88 + 220); it += NGW) {
            const int L = it >= 308 ? 1 : 0; int r = it - L * 308; bf16_t* dst;
            if (r < 88) { const int lr = r < 24 ? 104 + r : 192 + (r - 24); dst = (bf16_t*)(Wl + WO_IN) + (size_t)(256 + lr) * DM; }
            else { r -= 88; const int lr = r < 96 ? 32 + r : 132 + (r - 96); dst = (bf16_t*)(Wl + WO_RT) + (size_t)lr * DM; }
            *(u32x4*)(dst + lane * 8) = (u32x4){0u, 0u, 0u, 0u}; *(u32x4*)(dst + 512 + lane * 8) = (u32x4){0u, 0u, 0u, 0u};
        }
        for (int m = gw; m < NTOK; m += NGW) { const f32x4* xr = (const f32x4*)(x_in + (size_t)m * DM) + lane; float s = 0.f; u32x2* o8 = (u32x2*)(xbA + (size_t)m * DM) + lane;
#pragma unroll
            for (int j = 0; j < 4; ++j) { const f32x4 v = xr[64 * j]; s += sum4sq(v); u32x2 w; w.x = cvt_pk_bf16(v[0], v[1]); w.y = cvt_pk_bf16(v[2], v[3]); o8[64 * j] = w; }
            s = wave_sum(s); if (lane < 16) ssx0[(size_t)m * 16 + lane] = lane == 0 ? s : 0.f; }
        for (size_t i = gt; i < (size_t)DEPTH * NTOK * 256 / 8; i += NGT) { const f32x4 a = ((const f32x4*)INF(1))[2 * i], b = ((const f32x4*)INF(1))[2 * i + 1]; ((u32x4*)pbf)[i] = pack8(a, b); }
        for (int i = gt; i < NTOK * 16; i += NGT) { const int t = i >> 4, j = i & 15; const double inv = exp2(-(double)j * (13.287712379549449 / 16.0)); const double ang = (double)((const int*)args.in[2])[t] * inv;
            cosT[i] = (float)cos(ang); sinT[i] = (float)sin(ang); }
    }
    SEAM(0);

#pragma unroll 1
    for (int L = 0; L < DEPTH; ++L) {
        const int pb = 1 + 9 * L;
        if (PHM(1) && IN(pb + 0)) {
            PHASE_PTRS;
            pg8::Gemm g{xbA, (const bf16_t*)(Wl + WO_IN), DM}; pg8::StaticOrder S; S.init(NTOK, 2048, G, bx);
            EpiInProj E{wsp, INF(13) + L * 8, INF(11) + L * 64, INF(12) + L * 64};
            pg8::gemm_phase<DM, EpiInProj, pg8::StaticOrder, true>(lds, g, S, E);
        }
        SEAM(pb + 0);
        if (PHM(2) && IN(pb + 1)) {
            PHASE_PTRS;
            { pg8::Gemm g{Qc, (const bf16_t*)(Wl + WO_UQ), 256}; pg8::StaticOrder S; S.init(NTOK, 768, G, bx);
              EpiQUp E{wsp};
              pg8::gemm_phase<256, EpiQUp, pg8::StaticOrder, true>(lds, g, S, E); }
            { pg8::Gemm g{Kvc, (const bf16_t*)(Wl + WO_UKV), 128}; pg8::StaticOrder S; S.init(NTOK, 1024, G, bx);
              EpiKvUp E{wsp, INF(10) + L * 96};
              pg8::gemm_phase<128, EpiKvUp, pg8::StaticOrder, true>(lds, g, S, E); }
            for (int v = vcu; v < 32; v += G) {
                const int b = v >> 3, h = v & 7; LAS double* wt = (LAS double*)lds;
                const size_t base = ((size_t)b * SEQ + wave * 1024 + lane * 16) * 8 + h; float lv[16]; double loc = 0.0;
#pragma unroll
                for (int i = 0; i < 16; ++i) { lv[i] = logf[base + (size_t)i * 8]; loc += (double)lv[i]; }
                double pre = loc;
#pragma unroll
                for (int o = 1; o < 64; o <<= 1) { const double n = __shfl_up(pre, o); if (lane >= o) pre += n; }
                if (lane == 63) wt[wave] = pre;
                LDS_WAIT(); __syncthreads();
                double run = pre - loc;
                for (int w = 0; w < wave; ++w) run += wt[w];
#pragma unroll
                for (int i = 0; i < 16; ++i) { run += (double)lv[i]; Fc[base + (size_t)i * 8] = (float)run; }
                __syncthreads();
            }
        }
        SEAM(pb + 1);
        if (PHM(3) && IN(pb + 2)) {
            PHASE_PTRS;
            att::Args A{Qraw, Kmla, Vmla, Fq, Fk, Fv, ssqn, ssqr, INF(9) + L * 96, cosT, sinT, Fc, INF(11) + L * 64, INF(12) + L * 64, ob, sso};
            att::attn_phase(A, vcu, G, (LAS char*)lds);
        }
        SEAM(pb + 2);
        if (PHM(4) && IN(pb + 3)) {
            PHASE_PTRS;
            pg8::Gemm g{ob, (const bf16_t*)(Wl + WO_OUT), DM}; pg8::StaticOrder S; S.init(NTOK, DM, G, bx);
            EpiOut E{wsp, L == 0 ? x_in : (const float*)xo, xo};
            pg8::gemm_phase<DM, EpiOut, pg8::StaticOrder, true>(lds, g, S, E);
        }
        SEAM(pb + 3);
        if (PHM(5) && IN(pb + 4)) {
            PHASE_PTRS;
            { pg8::Gemm g{xbB, (const bf16_t*)(Wl + WO_RT), DM}; pg8::StaticOrder S; S.init(NTOK, 256, G, bx);
              EpiRouter E{wsp, ctl + CW_CNT + 64 * L};
              pg8::gemm_phase<DM, EpiRouter, pg8::StaticOrder, true>(lds, g, S, E); }
            { pg8::Gemm g{pbf + (size_t)L * NTOK * 256, (const bf16_t*)(Wl + WO_PP), 256}; pg8::StaticOrder S; S.init(NTOK, DM, G, bx);
              EpiPP E{wsp};
              pg8::gemm_phase<256, EpiPP, pg8::StaticOrder, true>(lds, g, S, E); }
        }
        SEAM(pb + 4);
        if ((PHM(6) && IN(pb + 5)) || (PHM(7) && IN(pb + 6))) {
            PHASE_PTRS;
            if (tid < 32) { const unsigned c = __hip_atomic_load(ctl + CW_CNT + 64 * L + tid, RLX_AGENT); cntL[tid] = c; }
            LDS_WAIT(); __syncthreads();
            if (tid == 0) { int run = 0; for (int e = 0; e < 32; ++e) { preL[e] = run; run += ((int)cntL[e] + 255) >> 8; } preL[32] = run; }
            LDS_WAIT(); __syncthreads();
        }
        if (PHM(6) && IN(pb + 5)) {
            PHASE_PTRS;
            pg8::Gemm g{xbB, (const bf16_t*)(Wl + WO_GU), DM}; MoeOrder S{preL, cntL, list, 2, G, bx, true};
            EpiMoeUp E{wsp, cntL, 2};
            pg8::gemm_phase<DM, EpiMoeUp, MoeOrder, true>(lds, g, S, E);
        }
        SEAM(pb + 5);
        if (PHM(7) && IN(pb + 6)) {
            PHASE_PTRS;
            pg8::Gemm g{hid, (const bf16_t*)(Wl + WO_DN), 256}; MoeOrder S{preL, cntL, list, 4, G, bx, false};
            EpiMoeDown E{wsp, cntL, xo, 4};
            pg8::gemm_phase<256, EpiMoeDown, MoeOrder, true>(lds, g, S, E);
        }
        SEAM(pb + 6);
        if (PHM(8) && IN(pb + 7)) {
            PHASE_PTRS;
            for (int m = gw; m < NTOK; m += NGW) { f32x4* xr = (f32x4*)(xo + (size_t)m * DM) + lane; const u32x2* cr = (const u32x2*)(c1 + (size_t)m * DM) + lane; u32x2* o8 = (u32x2*)(xbB + (size_t)m * DM) + lane; float s = 0.f;
#pragma unroll
                for (int j = 0; j < 4; ++j) { const u32x2 cw = cr[64 * j]; const f32x4 v = xr[64 * j] + (f32x4){bflo(cw.x), bfhi(cw.x), bflo(cw.y), bfhi(cw.y)}; s += sum4sq(v); xr[64 * j] = v;
                    u32x2 w; w.x = cvt_pk_bf16(v[0], v[1]); w.y = cvt_pk_bf16(v[2], v[3]); o8[64 * j] = w; }
                s = wave_sum(s); if (lane == 0) ssx2[m] = s; }
        }
        SEAM(pb + 7);
        if (PHM(9) && IN(pb + 8)) {
            PHASE_PTRS;
            pg8::Gemm g{xbB, (const bf16_t*)(Wl + WO_PG), DM}; pg8::StaticOrder S; S.init(NTOK, DM, G, bx);
            EpiPle E{wsp, INF(26) + L * DM, xo};
            pg8::gemm_phase<DM, EpiPle, pg8::StaticOrder, true>(lds, g, S, E);
        }
        if (L + 1 < DEPTH) SEAM(pb + 8);
    }
#undef IN
#undef SEAM
#undef INF
}

extern "C" void kernel_launch(void* const* d_in, const int* in_sizes, int n_in, void* d_out, int out_size, void* d_ws, size_t ws_size, hipStream_t stream) {
    static int grid = 0;
    if (grid == 0) {
        if (n_in != 27 || ws_size < WS_END) { fprintf(stderr, "kernel_launch: unexpected inputs (n_in %d, ws %zu)\n", n_in, ws_size); grid = -1; return; }
        int dev = 0, cus = 0, per_cu = 0;
        if (hipGetDevice(&dev) != hipSuccess || hipDeviceGetAttribute(&cus, hipDeviceAttributeMultiprocessorCount, dev) != hipSuccess) { grid = -1; return; }
        if (hipFuncSetAttribute((const void*)mega_fwd, hipFuncAttributeMaxDynamicSharedMemorySize, LDS_BYTES) != hipSuccess) { fprintf(stderr, "kernel_launch: hipFuncSetAttribute failed\n"); grid = -1; return; }
        if (hipOccupancyMaxActiveBlocksPerMultiprocessor(&per_cu, (const void*)mega_fwd, NWAVES * 64, LDS_BYTES) != hipSuccess || per_cu < 1) { fprintf(stderr, "kernel_launch: occupancy query says %d\n", per_cu); }
        (void)hipGetLastError();
        grid = cus;
    }
    if (grid < 0) return;
    if (hipMemsetAsync((char*)d_ws + WS_CTL, 0, CTL_ZERO_BYTES, stream) != hipSuccess) return;
    KArgs a{};
    for (int i = 0; i < 27; ++i) a.in[i] = d_in[i];
    a.out = (float*)d_out; a.ws = (unsigned char*)d_ws;
    const int cuts[] = MK_CUTS; const int nl = (int)(sizeof(cuts) / sizeof(int)) - 1;
    for (int li = 0; li < nl; ++li) {
        a.ph_lo = cuts[li]; a.ph_hi = cuts[li + 1]; a.li = li; a.pad = 0;
        hipLaunchKernelGGL(mega_fwd, dim3(grid), dim3(NWAVES * 64), LDS_BYTES, stream, a);
        if (hipPeekAtLastError() != hipSuccess) { fprintf(stderr, "kernel_launch: launch %d failed\n", li); break; }
    }
}
```

```cpp
#include <hip/hip_runtime.h>
#include <cstdio>
#include <cstdint>

#define LAS __attribute__((address_space(3)))
#define GAS __attribute__((address_space(1)))
typedef unsigned short bf16_t;
typedef short bf16x8 __attribute__((ext_vector_type(8)));
typedef short s16x4 __attribute__((ext_vector_type(4)));
typedef float f32x2 __attribute__((ext_vector_type(2)));
typedef float f32x4 __attribute__((ext_vector_type(4)));
typedef float f32x16 __attribute__((ext_vector_type(16)));
typedef unsigned u32x2 __attribute__((ext_vector_type(2)));
typedef unsigned u32x4 __attribute__((ext_vector_type(4)));

constexpr int DM = 1024, NB = 4, SEQ = 8192, NTOK = NB * SEQ, DEPTH = 2;
constexpr int INC = 1960, NEXP = 32;
constexpr int C_KVC = 256, C_KPE = 384, C_FQ = 416, C_FK = 928, C_FV = 1440, C_FL = 1952;
constexpr float EPS = 1e-6f;
constexpr float LOG2E = 1.4426950408889634f;
constexpr float C2_FOX = 0.125f * LOG2E;
constexpr float C2_MLA = 0.10206207261596575f * LOG2E;

__device__ __forceinline__ unsigned cvt_pk_bf16(float lo, float hi) { unsigned r; asm volatile("v_cvt_pk_bf16_f32 %0, %1, %2" : "=v"(r) : "v"(lo), "v"(hi)); return r; }
__device__ __forceinline__ float bf2f(unsigned short u) { return __uint_as_float((unsigned)u << 16); }
__device__ __forceinline__ float bflo(unsigned w) { return __uint_as_float(w << 16); }
__device__ __forceinline__ float bfhi(unsigned w) { return __uint_as_float(w & 0xffff0000u); }
__device__ __forceinline__ u32x4 pack8(const f32x4& a, const f32x4& b) { u32x4 w; w.x = cvt_pk_bf16(a[0], a[1]); w.y = cvt_pk_bf16(a[2], a[3]); w.z = cvt_pk_bf16(b[0], b[1]); w.w = cvt_pk_bf16(b[2], b[3]); return w; }
__device__ __forceinline__ float sum4sq(const f32x4& a) { return (a[0] * a[0] + a[1] * a[1]) + (a[2] * a[2] + a[3] * a[3]); }
__device__ __forceinline__ float red_fq(float s) { s += __shfl_xor(s, 16); s += __shfl_xor(s, 32); return s; }
__device__ __forceinline__ float sum16(const float* p) { const f32x4 a = *(const f32x4*)p, b = *(const f32x4*)(p + 4), c = *(const f32x4*)(p + 8), d = *(const f32x4*)(p + 12);
    return ((a[0] + a[1]) + (a[2] + a[3])) + ((b[0] + b[1]) + (b[2] + b[3])) + ((c[0] + c[1]) + (c[2] + c[3])) + ((d[0] + d[1]) + (d[2] + d[3])); }
__device__ __forceinline__ float sum8(const float* p) { const f32x4 a = *(const f32x4*)p, b = *(const f32x4*)(p + 4); return ((a[0] + a[1]) + (a[2] + a[3])) + ((b[0] + b[1]) + (b[2] + b[3])); }
__device__ __forceinline__ float log_sigmoid_f(float x) { return -(fmaxf(-x, 0.f) + log1pf(__expf(-fabsf(x)))); }

constexpr int NWAVES = 8;
constexpr size_t MiB = 1u << 20;
constexpr size_t WS_CTL = 0, CTL_ZERO_BYTES = 1 * MiB;
constexpr size_t WS_SSX0 = 1 * MiB, WS_SSX1 = 3 * MiB, WS_SSPP = 5 * MiB, WS_SSO = 7 * MiB, WS_SSX2 = 9 * MiB, WS_SSKPE = 10 * MiB, WS_SSQQ = 11 * MiB, WS_SSQKV = 12 * MiB,
                 WS_GATE = 13 * MiB, WS_LOGF = 14 * MiB, WS_F = 15 * MiB, WS_SSQN = 16 * MiB, WS_SSQR = 17 * MiB, WS_COS = 18 * MiB, WS_SIN = 20 * MiB, WS_LIST = 22 * MiB;
constexpr size_t WS_W = 28 * MiB, W_LAYER = 58 * MiB;
constexpr size_t WO_IN = 0, WO_UQ = 4 * MiB, WO_UKV = 4 * MiB + 512 * 1024, WO_OUT = 5 * MiB, WO_RT = 7 * MiB, WO_PG = 7 * MiB + 512 * 1024, WO_PP = 9 * MiB + 512 * 1024, WO_GU = 10 * MiB, WO_DN = 42 * MiB;
constexpr size_t WS_XBA = 144 * MiB, WS_XBB = 208 * MiB, WS_PBF = 272 * MiB, WS_MIX = 304 * MiB;
constexpr size_t WS_O = WS_XBA, WS_QRAW = WS_XBB;
constexpr size_t WS_QC = WS_MIX, WS_KVC = WS_MIX + 16 * MiB, WS_KPE = WS_MIX + 24 * MiB, WS_FQ = WS_MIX + 26 * MiB, WS_FK = WS_MIX + 58 * MiB, WS_FV = WS_MIX + 90 * MiB, WS_KMLA = WS_MIX + 122 * MiB, WS_VMLA = WS_MIX + 170 * MiB;
constexpr size_t WS_PP = WS_MIX, WS_HID = WS_MIX + 64 * MiB, WS_C1 = WS_MIX + 100 * MiB;
constexpr size_t WS_END = 512 * MiB;
static_assert(WS_VMLA + 32 * MiB <= WS_END && WS_C1 + 64 * MiB <= WS_END && WS_W + 2 * W_LAYER <= WS_XBA, "d_ws map");
constexpr int HID_ROWS = 2 * NTOK + NEXP * 256;
static_assert((size_t)HID_ROWS * 256 * 2 <= 36 * MiB, "hid");

namespace pg8 {
constexpr int TAB_OFF = 131072 + 1024;
constexpr int BM = 256, BK = 64, HALF = 128, HTB = HALF * BK * 2, STAGE_BYTES = 8 * HTB, NXCD = 8, WGM = 8;
__host__ __device__ __forceinline__ int lds_byte(int r, int c) { const int st = (r >> 4) * 2 + (c >> 5), rr = r & 15, cc = c & 31, ob = rr * 64 + cc * 2; return st * 1024 + (ob ^ (((ob >> 9) & 1) << 5)); }
__host__ __device__ __forceinline__ void stage_rc(int b, int& R, int& C) { const int st = b / 1024, sb = b % 1024, swz = sb ^ (((sb >> 9) & 1) << 5); R = (st >> 1) * 16 + swz / 64; C = (st & 1) * 32 + (swz % 64) / 2; }
__host__ __device__ __forceinline__ int perm32(int rho) { const int n = rho >> 4, i = rho & 15; return 8 * (i >> 2) + 4 * n + (i & 3); }

struct Unit { int pm, pn, e, blk; };
struct Gemm { const bf16_t* A; const bf16_t* Bt; int K; };

struct StaticOrder {
    int nM, nN, nwg, G, c;
    __device__ void init(int M, int N, int G_, int c_) { nM = M / BM; nN = N / BM; nwg = nM * nN; G = G_; c = c_; }
    __device__ bool next(int i, Unit& u) const {
        const long L = (long)i * G + c; if (L >= nwg) return false;
        int wgid = (int)L; { const int q = nwg / NXCD, r = nwg % NXCD, xcd = wgid % NXCD, off = wgid / NXCD; wgid = (xcd < r ? xcd * (q + 1) : r * (q + 1) + (xcd - r) * q) + off; }
        const int nig = WGM * nN, gid = wgid / nig, fm = gid * WGM, gsz = (nM - fm) < WGM ? (nM - fm) : WGM;
        u.pm = fm + ((wgid % nig) % gsz); u.pn = (wgid % nig) / gsz; u.e = 0; u.blk = 0; return true;
    }
    __device__ __forceinline__ int arow(const Unit& u, int r) const { return u.pm * BM + r; }
};

template <int K, class Epi, class Sched, bool ALIGN_EPI>
__device__ __forceinline__ void gemm_phase(LAS unsigned char* lds, const Gemm g, const Sched& S, const Epi& E) {
    LAS f32x2* const tab0 = (LAS f32x2*)(lds + TAB_OFF);
    int tid_ = threadIdx.x; asm volatile("" : "+v"(tid_));
    const int tid = tid_, wid = __builtin_amdgcn_readfirstlane(tid >> 6), lane = tid & 63, wr = wid >> 2, wc = wid & 3, fr = lane & 15, fq = lane >> 4;
    int Kr = K; asm volatile("" : "+s"(Kr));
    const int nt = Kr / BK;
    unsigned voffB[2];
#pragma unroll
    for (int i = 0; i < 2; ++i) { int R_, C_; stage_rc(tid * 16 + i * 8192, R_, C_); const int Rb = (R_ & ~31) + perm32(R_ & 31); voffB[i] = (unsigned)(Rb * Kr + C_) * 2u; }
    const size_t kstep = (size_t)(BK * 2);
    const size_t hstep = (size_t)HALF * Kr * 2;
    const size_t tstep = 2 * hstep;
    const unsigned ldsw = (unsigned)wid * 1024u;
    const int aoff = lds_byte(wr * 64 + fr, fq * 8), boff = lds_byte(wc * 32 + fr, fq * 8);
#define PG8_SA(b, h) (((b) * 2 + (h)) * HTB)
#define PG8_SB(b, h) ((4 + (b) * 2 + (h)) * HTB)
#define PG8_STAGE(bufoff, gbase, voff) do { _Pragma("unroll") for (int _i = 0; _i < 2; ++_i) \
        __builtin_amdgcn_global_load_lds((const unsigned*)((const char*)(gbase) + (voff)[_i]), (LAS unsigned*)(lds + (bufoff) + ldsw + _i * 8192), 16, 0, 0); } while (0)
#define PG8_LDA(dst, b, h) do { _Pragma("unroll") for (int m = 0; m < 4; ++m) _Pragma("unroll") for (int k = 0; k < 2; ++k) dst[m][k] = *(const LAS bf16x8*)(lds + PG8_SA(b, h) + aoff + m * 2048 + k * 1024); } while (0)
#define PG8_LDB(dst, b, h) do { _Pragma("unroll") for (int n = 0; n < 2; ++n) _Pragma("unroll") for (int k = 0; k < 2; ++k) dst[n][k] = *(const LAS bf16x8*)(lds + PG8_SB(b, h) + boff + n * 2048 + k * 1024); } while (0)
#define PG8_MMA(ai, bj, At, Bt) do { __builtin_amdgcn_s_setprio(1); _Pragma("unroll") for (int m = 0; m < 4; ++m) _Pragma("unroll") for (int n = 0; n < 2; ++n) _Pragma("unroll") for (int k = 0; k < 2; ++k) \
        acc[ai][bj][m][n] = __builtin_amdgcn_mfma_f32_16x16x32_bf16(Bt[n][k], At[m][k], acc[ai][bj][m][n], 0, 0, 0); __builtin_amdgcn_s_setprio(0); } while (0)
#define PG8_WAIT_V(n) asm volatile("s_waitcnt vmcnt(" #n ")" ::: "memory")
#define PG8_WAIT_L(n) asm volatile("s_waitcnt lgkmcnt(" #n ")" ::: "memory")
#define PG8_BAR __builtin_amdgcn_s_barrier()
#define PG8_SCHED __builtin_amdgcn_sched_barrier(0)
#define PG8_AOFF(dst, u) do { int _t = tid; asm volatile("" : "+v"(_t)); _Pragma("unroll") for (int _i = 0; _i < 2; ++_i) { int _R, _C; stage_rc(_t * 16 + _i * 8192, _R, _C); _Pragma("unroll") for (int _h = 0; _h < 2; ++_h) dst[_h][_i] = ((unsigned)S.arow(u, _h * HALF + _R) * (unsigned)Kr + (unsigned)_C) * 2u; } } while (0)
    Unit cur, nxt; int ui = 0;
    if (!S.next(0, cur)) return;
    f32x4 acc[2][2][4][2];
#pragma unroll
    for (int a = 0; a < 2; ++a)
#pragma unroll
        for (int b = 0; b < 2; ++b)
#pragma unroll
            for (int m = 0; m < 4; ++m)
#pragma unroll
                for (int n = 0; n < 2; ++n) acc[a][b][m][n] = (f32x4){0.f, 0.f, 0.f, 0.f};
    bf16x8 At[4][2], B0[2][2], B1[2][2];
    unsigned ca[2][2], na[2][2];
    PG8_AOFF(ca, cur);
    const char* gA = (const char*)g.A;
    const char* cB = (const char*)g.Bt + (size_t)cur.pn * tstep;
    PG8_STAGE(PG8_SB(0, 0), cB, voffB); PG8_STAGE(PG8_SB(0, 1), cB + hstep, voffB); PG8_STAGE(PG8_SA(0, 0), gA, ca[0]); PG8_STAGE(PG8_SA(0, 1), gA, ca[1]);
    if (wr == 1) PG8_BAR;
    PG8_WAIT_V(2); PG8_BAR;
    PG8_STAGE(PG8_SB(1, 0), cB + kstep, voffB); PG8_STAGE(PG8_SA(1, 0), gA + kstep, ca[0]); PG8_STAGE(PG8_SB(1, 1), cB + hstep + kstep, voffB);
    PG8_WAIT_V(6); PG8_BAR;
    for (;;) {
        const bool has_next = S.next(ui + 1, nxt);
        E.pre(cur, tab0 + (ui & 1) * 256, tid);
        if (has_next) { PG8_AOFF(na, nxt); } else {
#pragma unroll
            for (int _h = 0; _h < 2; ++_h)
#pragma unroll
                for (int _i = 0; _i < 2; ++_i) na[_h][_i] = ca[_h][_i]; }
        const char* nB = has_next ? (const char*)g.Bt + (size_t)nxt.pn * tstep : cB;
        for (int t = 0; t < nt; t += 2) {
            const bool last = (t == nt - 2);
            if constexpr (Epi::HAS_MID) { if (t == nt / 2) E.mid(acc, cur, wr, wc, fr, fq, tab0 + (ui & 1) * 256); }
            const char* a1 = gA + (size_t)(t + 1) * kstep;
            const char* a2 = last ? gA : gA + (size_t)(t + 2) * kstep; const char* b2 = last ? nB : cB + (size_t)(t + 2) * kstep;
            const char* a3 = a2 + kstep; const char* b3 = b2 + kstep;
            unsigned o2[2][2];
#pragma unroll
            for (int _h = 0; _h < 2; ++_h)
#pragma unroll
                for (int _i = 0; _i < 2; ++_i) o2[_h][_i] = last ? na[_h][_i] : ca[_h][_i];
            PG8_LDB(B0, 0, 0); PG8_LDB(B1, 0, 1); PG8_SCHED; PG8_LDA(At, 0, 0); PG8_STAGE(PG8_SA(1, 1), a1, ca[1]);
            PG8_WAIT_V(8); PG8_WAIT_L(0); PG8_BAR; PG8_MMA(0, 0, At, B0); PG8_MMA(0, 1, At, B1); PG8_BAR; PG8_SCHED;
            PG8_LDA(At, 0, 1); PG8_STAGE(PG8_SB(0, 0), b2, voffB); PG8_STAGE(PG8_SB(0, 1), b2 + hstep, voffB); PG8_STAGE(PG8_SA(0, 0), a2, o2[0]);
            PG8_WAIT_V(8); PG8_WAIT_L(0); PG8_BAR; PG8_MMA(1, 0, At, B0); PG8_MMA(1, 1, At, B1); PG8_BAR; PG8_SCHED;
            PG8_LDB(B0, 1, 0); PG8_LDB(B1, 1, 1); PG8_SCHED; PG8_LDA(At, 1, 0); PG8_STAGE(PG8_SA(0, 1), a2, o2[1]);
            PG8_WAIT_V(8); PG8_WAIT_L(0); PG8_BAR; PG8_MMA(0, 0, At, B0); PG8_MMA(0, 1, At, B1); PG8_BAR; PG8_SCHED;
            PG8_LDA(At, 1, 1); PG8_STAGE(PG8_SB(1, 0), b3, voffB); PG8_STAGE(PG8_SB(1, 1), b3 + hstep, voffB); PG8_STAGE(PG8_SA(1, 0), a3, o2[0]);
            PG8_WAIT_V(8); PG8_WAIT_L(0); PG8_BAR; PG8_MMA(1, 0, At, B0); PG8_MMA(1, 1, At, B1); PG8_BAR; PG8_SCHED;
        }
        if constexpr (ALIGN_EPI) { if (wr == 0) PG8_BAR; }
        E(acc, cur, wr, wc, fr, fq, tab0 + (ui & 1) * 256);
        if (!has_next) break;
#pragma unroll
        for (int a = 0; a < 2; ++a)
#pragma unroll
            for (int b = 0; b < 2; ++b)
#pragma unroll
                for (int m = 0; m < 4; ++m)
#pragma unroll
                    for (int n = 0; n < 2; ++n) acc[a][b][m][n] = (f32x4){0.f, 0.f, 0.f, 0.f};
        cur = nxt; cB = nB; ++ui;
#pragma unroll
        for (int _h = 0; _h < 2; ++_h)
#pragma unroll
            for (int _i = 0; _i < 2; ++_i) ca[_h][_i] = na[_h][_i];
        if constexpr (ALIGN_EPI) { if (wr == 1) PG8_BAR; }
    }
    PG8_WAIT_V(0);
    if constexpr (!ALIGN_EPI) { if (wr == 0) PG8_BAR; }
    PG8_BAR;
#undef PG8_SA
#undef PG8_SB
#undef PG8_STAGE
#undef PG8_LDA
#undef PG8_LDB
#undef PG8_MMA
#undef PG8_WAIT_V
#undef PG8_WAIT_L
#undef PG8_BAR
#undef PG8_SCHED
#undef PG8_AOFF
}
}
using pg8::Unit;
typedef f32x4 AccT[2][2][4][2];
#define EPI_ROWS(...) _Pragma("unroll") for (int ai = 0; ai < 2; ++ai) _Pragma("unroll") for (int m = 0; m < 4; ++m) { const int rl = ai * 128 + wr * 64 + m * 16 + fr; const int row = u.pm * 256 + rl; (void)row; __VA_ARGS__ if (m & 1) asm volatile("" ::: "memory"); }

struct EpiInProj {
    static constexpr bool HAS_MID = false;
    unsigned char* ws; const float *bfox, *gfq, *gfk;
    __device__ __forceinline__ void pre(const Unit& u, LAS f32x2* tab, int tid) const { if (tid < 256) { const float* ssx = (const float*)(ws + WS_SSX0); tab[tid] = (f32x2){rsqrtf(sum16(ssx + (size_t)(u.pm * 256 + tid) * 16) * (1.f / 1024.f) + EPS), 0.f}; } }
    __device__ __forceinline__ void mid(AccT&, const Unit&, int, int, int, int, const LAS f32x2*) const {}
    __device__ __forceinline__ void operator()(const AccT& acc, const Unit& u, int wr, int wc, int fr, int fq, const LAS f32x2* tab) const {
        asm volatile("" : "+v"(fr), "+v"(fq));
        const int pn = u.pn;
        const float* ssx = (const float*)(ws + WS_SSX0); bf16_t* Qc = (bf16_t*)(ws + WS_QC); bf16_t* Kvc = (bf16_t*)(ws + WS_KVC); bf16_t* Kpe = (bf16_t*)(ws + WS_KPE);
        float* ssq_q = (float*)(ws + WS_SSQQ); float* ssq_kv = (float*)(ws + WS_SSQKV); float* ss_kpe = (float*)(ws + WS_SSKPE); float* logf = (float*)(ws + WS_LOGF);
        if (pn == 0) {
            EPI_ROWS({ const float rinv = tab[rl].x; float s = 0.f;
_Pragma("unroll")
                for (int bj = 0; bj < 2; ++bj) { const f32x4 v0 = acc[ai][bj][m][0] * rinv, v1 = acc[ai][bj][m][1] * rinv; s += sum4sq(v0) + sum4sq(v1);
                    *(u32x4*)(Qc + (size_t)row * 256 + bj * 128 + wc * 32 + fq * 8) = pack8(v0, v1); }
                s = red_fq(s); if (fq == 0) ssq_q[(size_t)row * 4 + wc] = s; })
        } else if (pn == 1) {
            EPI_ROWS({ const float rinv = tab[rl].x;
                if (wc < 2) { float s = 0.f;
_Pragma("unroll")
                    for (int bj = 0; bj < 2; ++bj) { const f32x4 v0 = acc[ai][bj][m][0] * rinv, v1 = acc[ai][bj][m][1] * rinv; s += sum4sq(v0) + sum4sq(v1);
                        *(u32x4*)(Kvc + (size_t)row * 128 + wc * 64 + bj * 32 + fq * 8) = pack8(v0, v1); }
                    s = red_fq(s); if (fq == 0) ssq_kv[(size_t)row * 2 + wc] = s;
                } else if (wc == 2) { const f32x4 v0 = acc[ai][0][m][0] * rinv, v1 = acc[ai][0][m][1] * rinv; float s = sum4sq(v0) + sum4sq(v1);
                    *(u32x4*)(Kpe + (size_t)row * 32 + fq * 8) = pack8(v0, v1);
                    s = red_fq(s); if (fq == 0) ss_kpe[row] = s;
                } else { if (fq == 0) { const f32x4 v0 = acc[ai][0][m][0] * rinv, v1 = acc[ai][0][m][1] * rinv; const f32x4 b0 = *(const f32x4*)bfox, b1 = *(const f32x4*)(bfox + 4); f32x4 o0, o1;
_Pragma("unroll")
                        for (int i = 0; i < 4; ++i) { o0[i] = log_sigmoid_f(v0[i] + b0[i]); o1[i] = log_sigmoid_f(v1[i] + b1[i]); }
                        *(f32x4*)(logf + (size_t)row * 8) = o0; *(f32x4*)(logf + (size_t)row * 8 + 4) = o1; } } })
        } else {
            const int kind = (pn - 2) >> 1, head = 4 * ((pn - 2) & 1) + wc;
            bf16_t* dst = (bf16_t*)(ws + (kind == 0 ? WS_FQ : (kind == 1 ? WS_FK : WS_FV))); const float* g = kind == 0 ? gfq : gfk; const float osc = kind == 0 ? C2_FOX : 1.f;
            f32x4 g4[2][2];
_Pragma("unroll")
            for (int bj = 0; bj < 2; ++bj)
_Pragma("unroll")
                for (int n = 0; n < 2; ++n) g4[bj][n] = kind < 2 ? *(const f32x4*)(g + bj * 32 + fq * 8 + n * 4) * osc : (f32x4){1.f, 1.f, 1.f, 1.f};
            EPI_ROWS({ const float rinv = tab[rl].x; f32x4 v[2][2]; float s = 0.f;
_Pragma("unroll")
                for (int bj = 0; bj < 2; ++bj)
_Pragma("unroll")
                    for (int n = 0; n < 2; ++n) { v[bj][n] = acc[ai][bj][m][n] * rinv; s += sum4sq(v[bj][n]); }
                s = red_fq(s); const float hr = kind < 2 ? rsqrtf(s * (1.f / 64.f) + EPS) : 1.f;
_Pragma("unroll")
                for (int bj = 0; bj < 2; ++bj) *(u32x4*)(dst + (size_t)row * 512 + head * 64 + bj * 32 + fq * 8) = pack8(v[bj][0] * hr * g4[bj][0], v[bj][1] * hr * g4[bj][1]); })
        }
    }
};
struct EpiQUp {
    static constexpr bool HAS_MID = false;
    unsigned char* ws;
    __device__ __forceinline__ void pre(const Unit& u, LAS f32x2* tab, int tid) const { if (tid < 256) { const f32x4 sq = *(const f32x4*)((const float*)(ws + WS_SSQQ) + (size_t)(u.pm * 256 + tid) * 4); tab[tid] = (f32x2){rsqrtf(((sq[0] + sq[1]) + (sq[2] + sq[3])) * (1.f / 256.f) + EPS), 0.f}; } }
    __device__ __forceinline__ void mid(AccT&, const Unit&, int, int, int, int, const LAS f32x2*) const {}
    __device__ __forceinline__ void operator()(const AccT& acc, const Unit& u, int wr, int wc, int fr, int fq, const LAS f32x2* tab) const {
        asm volatile("" : "+v"(fr), "+v"(fq));
        const int pn = u.pn;
        const float* ssq_q = (const float*)(ws + WS_SSQQ); bf16_t* Qraw = (bf16_t*)(ws + WS_QRAW); float* ssq_qn = (float*)(ws + WS_SSQN); float* ssq_qr = (float*)(ws + WS_SSQR);
        EPI_ROWS({ const float rinv = tab[rl].x;
            if (pn < 2) { const int head = 4 * pn + wc; float s = 0.f;
_Pragma("unroll")
                for (int bj = 0; bj < 2; ++bj) { const f32x4 v0 = acc[ai][bj][m][0] * rinv, v1 = acc[ai][bj][m][1] * rinv; s += sum4sq(v0) + sum4sq(v1);
                    *(u32x4*)(Qraw + (size_t)row * 768 + head * 96 + bj * 32 + fq * 8) = pack8(v0, v1); }
                s = red_fq(s); if (fq == 0) ssq_qn[(size_t)row * 8 + head] = s;
            } else {
_Pragma("unroll")
                for (int bj = 0; bj < 2; ++bj) { const int head = 4 * bj + wc; const f32x4 v0 = acc[ai][bj][m][0] * rinv, v1 = acc[ai][bj][m][1] * rinv; float s = sum4sq(v0) + sum4sq(v1);
                    *(u32x4*)(Qraw + (size_t)row * 768 + head * 96 + 64 + fq * 8) = pack8(v0, v1);
                    s = red_fq(s); if (fq == 0) ssq_qr[(size_t)row * 8 + head] = s; }
            } })
    }
};
struct EpiKvUp {
    static constexpr bool HAS_MID = false;
    unsigned char* ws; const float* gk;
    __device__ __forceinline__ void pre(const Unit& u, LAS f32x2* tab, int tid) const { if (tid < 256) { const size_t r = (size_t)(u.pm * 256 + tid); const f32x2 sk = *(const f32x2*)((const float*)(ws + WS_SSQKV) + r * 2); tab[tid] = (f32x2){rsqrtf((sk[0] + sk[1]) * (1.f / 128.f) + EPS), ((const float*)(ws + WS_SSKPE))[r]}; } }
    __device__ __forceinline__ void mid(AccT&, const Unit&, int, int, int, int, const LAS f32x2*) const {}
    __device__ __forceinline__ void operator()(const AccT& acc, const Unit& u, int wr, int wc, int fr, int fq, const LAS f32x2* tab) const {
        asm volatile("" : "+v"(fr), "+v"(fq));
        const int pn = u.pn;
        const float* ssq_kv = (const float*)(ws + WS_SSQKV); const float* ss_kpe = (const float*)(ws + WS_SSKPE); const bf16_t* Kpe = (const bf16_t*)(ws + WS_KPE);
        const float* cosT = (const float*)(ws + WS_COS); const float* sinT = (const float*)(ws + WS_SIN); bf16_t* Kmla = (bf16_t*)(ws + WS_KMLA); bf16_t* Vmla = (bf16_t*)(ws + WS_VMLA);
        if (pn < 2) {
            const int head = 4 * pn + wc;
            f32x4 g4[2][2];
_Pragma("unroll")
            for (int bj = 0; bj < 2; ++bj)
_Pragma("unroll")
                for (int n = 0; n < 2; ++n) g4[bj][n] = *(const f32x4*)(gk + bj * 32 + fq * 8 + n * 4);
            const f32x4 gr1 = *(const f32x4*)(gk + 64 + 4 * fq), gr2 = *(const f32x4*)(gk + 80 + 4 * fq);
            EPI_ROWS({ const f32x2 tt = tab[rl]; const float rinv = tt.x; f32x4 v[2][2]; float s = 0.f;
_Pragma("unroll")
                for (int bj = 0; bj < 2; ++bj)
_Pragma("unroll")
                    for (int n = 0; n < 2; ++n) { v[bj][n] = acc[ai][bj][m][n] * rinv; s += sum4sq(v[bj][n]); }
                s = red_fq(s) + tt.y; const float hr = rsqrtf(s * (1.f / 96.f) + EPS);
                bf16_t* kd = Kmla + (size_t)row * 768 + head * 96;
_Pragma("unroll")
                for (int bj = 0; bj < 2; ++bj) *(u32x4*)(kd + bj * 32 + fq * 8) = pack8(v[bj][0] * hr * g4[bj][0], v[bj][1] * hr * g4[bj][1]);
                const u32x2 p1 = *(const u32x2*)(Kpe + (size_t)row * 32 + 4 * fq), p2 = *(const u32x2*)(Kpe + (size_t)row * 32 + 16 + 4 * fq);
                const f32x4 c = *(const f32x4*)(cosT + (size_t)row * 16 + 4 * fq), sn = *(const f32x4*)(sinT + (size_t)row * 16 + 4 * fq);
                const f32x4 x1 = (f32x4){bflo(p1.x), bfhi(p1.x), bflo(p1.y), bfhi(p1.y)} * hr * gr1, x2 = (f32x4){bflo(p2.x), bfhi(p2.x), bflo(p2.y), bfhi(p2.y)} * hr * gr2;
                const f32x4 o1 = x1 * c - x2 * sn, o2 = x2 * c + x1 * sn;
                u32x2 w1, w2; w1.x = cvt_pk_bf16(o1[0], o1[1]); w1.y = cvt_pk_bf16(o1[2], o1[3]); w2.x = cvt_pk_bf16(o2[0], o2[1]); w2.y = cvt_pk_bf16(o2[2], o2[3]);
                *(u32x2*)(kd + 64 + 4 * fq) = w1; *(u32x2*)(kd + 80 + 4 * fq) = w2; })
        } else {
            const int head = 4 * (pn - 2) + wc;
            EPI_ROWS({ const f32x2 tt = tab[rl]; const float rinv = tt.x;
_Pragma("unroll")
                for (int bj = 0; bj < 2; ++bj) *(u32x4*)(Vmla + (size_t)row * 512 + head * 64 + bj * 32 + fq * 8) = pack8(acc[ai][bj][m][0] * rinv, acc[ai][bj][m][1] * rinv); })
        }
    }
};
struct EpiOut {
    static constexpr bool HAS_MID = true;
    unsigned char* ws; const float* base;
    __device__ __forceinline__ void pre(const Unit& u, LAS f32x2* tab, int tid) const { if (tid < 256) { const float* sso = (const float*)(ws + WS_SSO) + (size_t)(u.pm * 256 + tid) * 16;
        const float rm = rsqrtf(sum8(sso) * (1.f / 512.f) + EPS), rf = rsqrtf(sum8(sso + 8) * (1.f / 512.f) + EPS); tab[tid] = (f32x2){rm / rf, rf}; } }
    __device__ __forceinline__ void mid(AccT& acc, const Unit& u, int wr, int wc, int fr, int fq, const LAS f32x2* tab) const {
        EPI_ROWS({ const float ratio = tab[rl].x;
_Pragma("unroll")
            for (int bj = 0; bj < 2; ++bj)
_Pragma("unroll")
                for (int n = 0; n < 2; ++n) acc[ai][bj][m][n] *= ratio; })
    }
    __device__ __forceinline__ void operator()(const AccT& acc, const Unit& u, int wr, int wc, int fr, int fq, const LAS f32x2* tab) const {
        asm volatile("" : "+v"(fr), "+v"(fq));
        bf16_t* xb = (bf16_t*)(ws + WS_XBB); const bf16_t* xa = (const bf16_t*)(ws + WS_XBA); float* ssx1 = (float*)(ws + WS_SSX1);
        EPI_ROWS({ const float rf = tab[rl].y; float s = 0.f;
_Pragma("unroll")
            for (int bj = 0; bj < 2; ++bj) { const size_t off = (size_t)row * 1024 + u.pn * 256 + bj * 128 + wc * 32 + fq * 8; f32x4 b0, b1;
                if (base) { b0 = *(const f32x4*)(base + off); b1 = *(const f32x4*)(base + off + 4); }
                else { const u32x4 w = *(const u32x4*)(xa + off); b0 = (f32x4){bflo(w.x), bfhi(w.x), bflo(w.y), bfhi(w.y)}; b1 = (f32x4){bflo(w.z), bfhi(w.z), bflo(w.w), bfhi(w.w)}; }
                const f32x4 v0 = b0 + acc[ai][bj][m][0] * rf, v1 = b1 + acc[ai][bj][m][1] * rf; s += sum4sq(v0) + sum4sq(v1);
                *(u32x4*)(xb + off) = pack8(v0, v1); }
            s = red_fq(s); if (fq == 0) ssx1[(size_t)row * 16 + u.pn * 4 + wc] = s; })
    }
};
struct EpiRouter {
    static constexpr bool HAS_MID = false;
    unsigned char* ws; unsigned* cnt;
    __device__ __forceinline__ void pre(const Unit& u, LAS f32x2* tab, int tid) const { if (tid < 256) { const float* ssx1 = (const float*)(ws + WS_SSX1); tab[tid] = (f32x2){rsqrtf(sum16(ssx1 + (size_t)(u.pm * 256 + tid) * 16) * (1.f / 1024.f) + EPS), 0.f}; } }
    __device__ __forceinline__ void mid(AccT&, const Unit&, int, int, int, int, const LAS f32x2*) const {}
    __device__ __forceinline__ void operator()(const AccT& acc, const Unit& u, int wr, int wc, int fr, int fq, const LAS f32x2* tab) const {
        asm volatile("" : "+v"(fr), "+v"(fq));
        if (wc != 0) return;
        float* gate = (float*)(ws + WS_GATE); int* list = (int*)(ws + WS_LIST);
        EPI_ROWS({ const float rinv = tab[rl].x;
            const f32x4 gl = acc[ai][1][m][0] * rinv; int g = 0; float gm = gl[0];
_Pragma("unroll")
            for (int j = 1; j < 4; ++j) if (gl[j] > gm) { gm = gl[j]; g = j; }
            float gs = 0.f;
_Pragma("unroll")
            for (int j = 0; j < 4; ++j) gs += __expf(gl[j] - gm);
            float pg = 1.f / gs;
            g = __shfl(g, fr); pg = __shfl(pg, fr);
            if (fq == g) { float le[8];
_Pragma("unroll")
                for (int j = 0; j < 4; ++j) { le[j] = acc[ai][0][m][0][j] * rinv; le[4 + j] = acc[ai][0][m][1][j] * rinv; }
                int i1 = 0; float m1 = le[0];
_Pragma("unroll")
                for (int j = 1; j < 8; ++j) if (le[j] > m1) { m1 = le[j]; i1 = j; }
                int i2 = 0; float m2 = -3.0e38f;
_Pragma("unroll")
                for (int j = 0; j < 8; ++j) if (j != i1 && le[j] > m2) { m2 = le[j]; i2 = j; }
                const float e2 = __expf(m2 - m1), w1 = 1.f / (1.f + e2), w2 = e2 * w1;
                gate[2 * (size_t)row] = pg * w1; gate[2 * (size_t)row + 1] = pg * w2;
                const int ea = g * 8 + i1, eb = g * 8 + i2;
                const unsigned pa = __hip_atomic_fetch_add(cnt + ea, 1u, __ATOMIC_RELAXED, __HIP_MEMORY_SCOPE_AGENT); list[(size_t)ea * NTOK + pa] = 2 * row;
                const unsigned pb = __hip_atomic_fetch_add(cnt + eb, 1u, __ATOMIC_RELAXED, __HIP_MEMORY_SCOPE_AGENT); list[(size_t)eb * NTOK + pb] = 2 * row + 1; } })
    }
};
struct EpiPP {
    static constexpr bool HAS_MID = false;
    unsigned char* ws;
    __device__ __forceinline__ void pre(const Unit&, LAS f32x2*, int) const {}
    __device__ __forceinline__ void mid(AccT&, const Unit&, int, int, int, int, const LAS f32x2*) const {}
    __device__ __forceinline__ void operator()(const AccT& acc, const Unit& u, int wr, int wc, int fr, int fq, const LAS f32x2* tab) const {
        asm volatile("" : "+v"(fr), "+v"(fq));
        bf16_t* pp = (bf16_t*)(ws + WS_PP); float* sspp = (float*)(ws + WS_SSPP);
        EPI_ROWS({ float s = 0.f;
_Pragma("unroll")
            for (int bj = 0; bj < 2; ++bj) { const f32x4 v0 = acc[ai][bj][m][0], v1 = acc[ai][bj][m][1]; s += sum4sq(v0) + sum4sq(v1);
                *(u32x4*)(pp + (size_t)row * 1024 + u.pn * 256 + bj * 128 + wc * 32 + fq * 8) = pack8(v0, v1); }
            s = red_fq(s); if (fq == 0) sspp[(size_t)row * 16 + u.pn * 4 + wc] = s; })
    }
};
struct EpiMoeUp {
    static constexpr bool HAS_MID = false;
    unsigned char* ws; const LAS unsigned* cntv; int npn;
    __device__ __forceinline__ void pre(const Unit& u, LAS f32x2* tab, int tid) const { if (tid < 256) { const int li = u.blk * 256 + tid; float rinv = 0.f;
        if (li < (int)cntv[u.e]) { const int tok = ((const int*)(ws + WS_LIST))[(size_t)u.e * NTOK + li] >> 1; rinv = rsqrtf(sum16((const float*)(ws + WS_SSX1) + (size_t)tok * 16) * (1.f / 1024.f) + EPS); }
        tab[tid] = (f32x2){rinv, 0.f}; } }
    __device__ __forceinline__ void mid(AccT&, const Unit&, int, int, int, int, const LAS f32x2*) const {}
    __device__ __forceinline__ void operator()(const AccT& acc, const Unit& u, int wr, int wc, int fr, int fq, const LAS f32x2* tab) const {
        asm volatile("" : "+v"(fr), "+v"(fq));
        const int pnl = u.pn - u.e * npn;
        bf16_t* hid = (bf16_t*)(ws + WS_HID);
        EPI_ROWS({ const float rinv = tab[rl].x;
            f32x4 h[2];
_Pragma("unroll")
            for (int n = 0; n < 2; ++n) { const f32x4 gg = acc[ai][0][m][n] * rinv, uu = acc[ai][1][m][n] * rinv;
_Pragma("unroll")
                for (int i = 0; i < 4; ++i) h[n][i] = gg[i] * __builtin_amdgcn_rcpf(1.f + __expf(-gg[i])) * uu[i]; }
            *(u32x4*)(hid + (size_t)row * 256 + pnl * 128 + wc * 32 + fq * 8) = pack8(h[0], h[1]); })
    }
};
struct EpiMoeDown {
    static constexpr bool HAS_MID = false;
    unsigned char* ws; const LAS unsigned* cntv; int npn;
    __device__ __forceinline__ void pre(const Unit& u, LAS f32x2* tab, int tid) const { if (tid < 256) { const int li = u.blk * 256 + tid; int aid = -1; float gt = 0.f;
        if (li < (int)cntv[u.e]) { aid = ((const int*)(ws + WS_LIST))[(size_t)u.e * NTOK + li]; gt = ((const float*)(ws + WS_GATE))[aid]; }
        tab[tid] = (f32x2){gt, __int_as_float(aid)}; } }
    __device__ __forceinline__ void mid(AccT&, const Unit&, int, int, int, int, const LAS f32x2*) const {}
    __device__ __forceinline__ void operator()(const AccT& acc, const Unit& u, int wr, int wc, int fr, int fq, const LAS f32x2* tab) const {
        asm volatile("" : "+v"(fr), "+v"(fq));
        const int pnl = u.pn - u.e * npn;
        bf16_t* c1 = (bf16_t*)(ws + WS_C1); bf16_t* xb = (bf16_t*)(ws + WS_XBB);
        EPI_ROWS({ const f32x2 tt = tab[rl]; const int aid = __float_as_int(tt.y);
            if (aid >= 0) { const int tok = aid >> 1; const float gt = tt.x;
_Pragma("unroll")
                for (int bj = 0; bj < 2; ++bj) { const size_t off = (size_t)tok * 1024 + pnl * 256 + bj * 128 + wc * 32 + fq * 8; const f32x4 v0 = acc[ai][bj][m][0] * gt, v1 = acc[ai][bj][m][1] * gt;
                    if (aid & 1) *(u32x4*)(c1 + off) = pack8(v0, v1);
                    else { const u32x4 w = *(const u32x4*)(xb + off); *(u32x4*)(xb + off) = pack8((f32x4){bflo(w.x), bfhi(w.x), bflo(w.y), bfhi(w.y)} + v0, (f32x4){bflo(w.z), bfhi(w.z), bflo(w.w), bfhi(w.w)} + v1); } } } })
    }
};
struct EpiPle {
    static constexpr bool HAS_MID = false;
    unsigned char* ws; const float* gpo; float* xout;
    __device__ __forceinline__ void pre(const Unit& u, LAS f32x2* tab, int tid) const { if (tid < 256) { const size_t r = (size_t)(u.pm * 256 + tid);
        tab[tid] = (f32x2){rsqrtf(((const float*)(ws + WS_SSX2))[r] * (1.f / 1024.f) + EPS), rsqrtf(sum16((const float*)(ws + WS_SSPP) + r * 16) * (1.f / 1024.f) + EPS)}; } }
    __device__ __forceinline__ void mid(AccT&, const Unit&, int, int, int, int, const LAS f32x2*) const {}
    __device__ __forceinline__ void operator()(const AccT& acc, const Unit& u, int wr, int wc, int fr, int fq, const LAS f32x2* tab) const {
        asm volatile("" : "+v"(fr), "+v"(fq));
        const bf16_t* pp = (const bf16_t*)(ws + WS_PP); bf16_t* xbn = (bf16_t*)(ws + WS_XBA); const bf16_t* xb = (const bf16_t*)(ws + WS_XBB); float* ssx0 = (float*)(ws + WS_SSX0);
        f32x4 g4[2][2];
_Pragma("unroll")
        for (int bj = 0; bj < 2; ++bj)
_Pragma("unroll")
            for (int n = 0; n < 2; ++n) g4[bj][n] = *(const f32x4*)(gpo + u.pn * 256 + bj * 128 + wc * 32 + fq * 8 + n * 4);
        EPI_ROWS({ const f32x2 tt = tab[rl]; const float r2 = tt.x, rp = tt.y; float s = 0.f;
_Pragma("unroll")
            for (int bj = 0; bj < 2; ++bj) { const size_t off = (size_t)row * 1024 + u.pn * 256 + bj * 128 + wc * 32 + fq * 8;
                const u32x4 pw = *(const u32x4*)(pp + off); const f32x4 p0 = (f32x4){bflo(pw.x), bfhi(pw.x), bflo(pw.y), bfhi(pw.y)} * rp * g4[bj][0], p1 = (f32x4){bflo(pw.z), bfhi(pw.z), bflo(pw.w), bfhi(pw.w)} * rp * g4[bj][1];
                const u32x4 xw = *(const u32x4*)(xb + off); f32x4 v0 = (f32x4){bflo(xw.x), bfhi(xw.x), bflo(xw.y), bfhi(xw.y)}, v1 = (f32x4){bflo(xw.z), bfhi(xw.z), bflo(xw.w), bfhi(xw.w)};
_Pragma("unroll")
                for (int i = 0; i < 4; ++i) { v0[i] += p0[i] * __builtin_amdgcn_rcpf(1.f + __expf(-acc[ai][bj][m][0][i] * r2)); v1[i] += p1[i] * __builtin_amdgcn_rcpf(1.f + __expf(-acc[ai][bj][m][1][i] * r2)); }
                s += sum4sq(v0) + sum4sq(v1);
                if (xout) { *(f32x4*)(xout + off) = v0; *(f32x4*)(xout + off + 4) = v1; } else *(u32x4*)(xbn + off) = pack8(v0, v1); }
            s = red_fq(s); if (fq == 0 && !xout) ssx0[(size_t)row * 16 + u.pn * 4 + wc] = s; })
    }
};

struct EpiNull {
    static constexpr bool HAS_MID = false;
    float* sink;
    __device__ __forceinline__ void pre(const Unit&, LAS f32x2*, int) const {}
    __device__ __forceinline__ void mid(AccT&, const Unit&, int, int, int, int, const LAS f32x2*) const {}
    __device__ __forceinline__ void operator()(const AccT& acc, const Unit& u, int wr, int wc, int fr, int fq, const LAS f32x2* tab) const {
        f32x4 s = (f32x4){0.f, 0.f, 0.f, 0.f};
        EPI_ROWS({ s += (acc[ai][0][m][0] + acc[ai][0][m][1]) + (acc[ai][1][m][0] + acc[ai][1][m][1]); })
        if (s[0] + s[1] + s[2] + s[3] == 1.2345678e33f) sink[0] = s[0];
    }
};

namespace att {
constexpr int KSLOT = 12288, VSLOT = 8192;
constexpr int L_K = 0, L_V = 3 * KSLOT, L_WS = L_V + 3 * VSLOT, L_OST = L_WS + 2048, L_G = L_OST + 32768, L_END = L_G + 32768;
static_assert(L_END <= 131072, "attention LDS map");
constexpr float SKIP_NATS = 40.f;
typedef LAS const char* lds_cptr;
typedef short v4i16_t __attribute__((ext_vector_type(4)));

__device__ __forceinline__ void glds16(const void* gsrc, unsigned lds_dst) { unsigned keep;
    asm volatile("s_mov_b32 %0, m0\n\ts_mov_b32 m0, %2\n\ts_nop 0\n\tglobal_load_lds_dwordx4 %1, off\n\ts_mov_b32 m0, %0" : "=&s"(keep) : "v"(gsrc), "s"(lds_dst) : "memory"); }
__device__ __forceinline__ int crow(int r, int hi) { return (r & 3) + 8 * (r >> 2) + 4 * hi; }
__device__ __forceinline__ s16x4 vtr(lds_cptr p) { return __builtin_bit_cast(s16x4, __builtin_amdgcn_ds_read_tr16_b64_v4i16((LAS v4i16_t*)p)); }
__device__ __forceinline__ float swapmax(float m) { auto rr = __builtin_amdgcn_permlane32_swap(__float_as_uint(m), __float_as_uint(m), false, false); return fmaxf(__uint_as_float(rr[0]), __uint_as_float(rr[1])); }
__device__ __forceinline__ float swapsum(float m) { auto rr = __builtin_amdgcn_permlane32_swap(__float_as_uint(m), __float_as_uint(m), false, false); return __uint_as_float(rr[0]) + __uint_as_float(rr[1]); }
__device__ __forceinline__ bf16x8 pk8(const f32x16& p, int b) { u32x4 w; w.x = cvt_pk_bf16(p[b], p[b + 1]); w.y = cvt_pk_bf16(p[b + 2], p[b + 3]); w.z = cvt_pk_bf16(p[b + 4], p[b + 5]); w.w = cvt_pk_bf16(p[b + 6], p[b + 7]); return __builtin_bit_cast(bf16x8, w); }

struct Args {
    const bf16_t *Qraw, *Kmla, *Vmla, *Fq, *Fk, *Fv; const float *ssq_qn, *ssq_qr, *gmq, *cosT, *sinT, *F, *gfq, *gfk; bf16_t* o; float* sso;
};

template <bool FOX>
__device__ __forceinline__ void attn_unit(const Args& A, int b, int h, int qb, LAS char* shm) {
    constexpr int DK = FOX ? 64 : 96, NQ = DK / 16, KP = FOX ? 512 : 768;
    int tid_ = threadIdx.x; asm volatile("" : "+v"(tid_));
    const int tid = tid_, lane = tid & 63, r32 = lane & 31, hi = lane >> 5; const int wid = __builtin_amdgcn_readfirstlane(tid >> 6);
    const long rowbase = (long)b * SEQ; const int q0 = qb * 256, qw = q0 + wid * 32;
    const unsigned lds0 = (unsigned)(uintptr_t)shm;
    LAS float* wsf = (LAS float*)(shm + L_WS) + wid * 64;
    LAS float* Gl = (LAS float*)(shm + L_G);
    const int NT = (q0 + 256) / 64; const int tw_last = qw >> 6;
    int t0 = 0;
    if constexpr (FOX) {
        float gq = fmaxf(fabsf(A.gfq[lane]), 0.f), gk = fabsf(A.gfk[lane]);
#pragma unroll
        for (int o = 32; o > 0; o >>= 1) { gq = fmaxf(gq, __shfl_xor(gq, o)); gk = fmaxf(gk, __shfl_xor(gk, o)); }
        const float margin = 2.f * (8.f * gq * gk) + SKIP_NATS;
        const float Fref = A.F[(rowbase + q0) * 8 + h];
        const int nfull = q0 / 64;
        bool keep0 = true, keep1 = true;
        if (lane < nfull) keep0 = (Fref - A.F[(rowbase + 64 * lane + 63) * 8 + h]) >= -margin;
        if (lane + 64 < nfull) keep1 = (Fref - A.F[(rowbase + 64 * (lane + 64) + 63) * 8 + h]) >= -margin;
        const unsigned long long k0 = __ballot(keep0), k1 = __ballot(keep1);
        t0 = k0 ? __builtin_ctzll(k0) : 64 + (k1 ? __builtin_ctzll(k1) : 0);
        t0 = __builtin_amdgcn_readfirstlane(t0);
        const int nk = q0 + 256 - 64 * t0;
        for (int j = tid; j < nk; j += 512) Gl[j] = (Fref - A.F[(rowbase + 64 * t0 + j) * 8 + h]) * LOG2E;
    }
    const bf16_t* Kg = (FOX ? A.Fk : A.Kmla) + rowbase * KP + h * DK + (long)lane * KP;
    const bf16_t* Vg = (FOX ? A.Fv : A.Vmla) + rowbase * 512 + h * 64 + (long)(16 * (wid & 3) + (lane >> 2)) * 512 + (wid >> 2) * 32 + (lane & 3) * 8;
    const unsigned kdst = lds0 + L_K + wid * 1024, vdst = lds0 + L_V + wid * 1024;
    const bool k2 = (!FOX) && wid < 4;
#define ISSUE(t, sl) do { glds16(Kg + (long)(t) * 64 * KP + wid * 8, (unsigned)__builtin_amdgcn_readfirstlane(kdst + (sl) * KSLOT)); \
        if (k2) glds16(Kg + (long)(t) * 64 * KP + (8 + wid) * 8, (unsigned)__builtin_amdgcn_readfirstlane(kdst + (sl) * KSLOT + 8192)); \
        glds16(Vg + (long)(t) * 64 * 512, (unsigned)__builtin_amdgcn_readfirstlane(vdst + (sl) * VSLOT)); } while (0)
    ISSUE(t0, 0);
    if (t0 + 1 < NT) ISSUE(t0 + 1, 1);
    bf16x8 qr[NQ];
    {
        const long row = rowbase + qw + r32;
        if constexpr (FOX) {
#pragma unroll
            for (int d0 = 0; d0 < NQ; ++d0) qr[d0] = *(const bf16x8*)(A.Fq + row * 512 + h * 64 + d0 * 16 + hi * 8);
        } else {
            const float ss = A.ssq_qn[row * 8 + h] + A.ssq_qr[row * 8 + h]; const float sc = rsqrtf(ss * (1.f / 96.f) + EPS) * C2_MLA;
            f32x4 qa[NQ][2];
#pragma unroll
            for (int d0 = 0; d0 < NQ; ++d0) { const u32x4 w = *(const u32x4*)(A.Qraw + row * 768 + h * 96 + d0 * 16 + hi * 8);
                const f32x4 g0 = *(const f32x4*)(A.gmq + d0 * 16 + hi * 8), g1 = *(const f32x4*)(A.gmq + d0 * 16 + hi * 8 + 4);
                qa[d0][0] = (f32x4){bflo(w.x), bfhi(w.x), bflo(w.y), bfhi(w.y)} * sc * g0; qa[d0][1] = (f32x4){bflo(w.z), bfhi(w.z), bflo(w.w), bfhi(w.w)} * sc * g1; }
#pragma unroll
            for (int e = 0; e < 2; ++e) { const f32x4 c = *(const f32x4*)(A.cosT + row * 16 + hi * 8 + e * 4), s = *(const f32x4*)(A.sinT + row * 16 + hi * 8 + e * 4);
                const f32x4 x1 = qa[4][e], x2 = qa[5][e]; qa[4][e] = x1 * c - x2 * s; qa[5][e] = x2 * c + x1 * s; }
#pragma unroll
            for (int d0 = 0; d0 < NQ; ++d0) qr[d0] = __builtin_bit_cast(bf16x8, pack8(qa[d0][0], qa[d0][1]));
        }
    }
    float mrun = -INFINITY, lrun = 0.f; f32x16 o[2]; o[0] = f32x16{}; o[1] = f32x16{};
    const lds_cptr shm3 = (lds_cptr)shm;
    const lds_cptr kp0 = shm3 + L_K + hi * 1024 + r32 * 16;
    const lds_cptr vp0 = shm3 + L_V + ((lane >> 4) & 1) * 32 + (lane & 3) * 8 + (4 * hi + ((lane & 15) >> 2)) * 64;
    int sl = 0;
    for (int t = t0; t < NT; ++t) {
        if (t + 1 < NT) { if (k2) asm volatile("s_waitcnt vmcnt(3) lgkmcnt(0)\n\ts_barrier" ::: "memory"); else asm volatile("s_waitcnt vmcnt(2) lgkmcnt(0)\n\ts_barrier" ::: "memory"); }
        else asm volatile("s_waitcnt vmcnt(0) lgkmcnt(0)\n\ts_barrier" ::: "memory");
        if (t + 2 < NT) { const int s2 = sl == 0 ? 2 : sl - 1; ISSUE(t + 2, s2); }
        if (t <= tw_last) {
            const lds_cptr kp = kp0 + sl * KSLOT;
            f32x16 p0 = f32x16{}, p1 = f32x16{};
#pragma unroll
            for (int d0 = 0; d0 < NQ; ++d0) { const bf16x8 b0 = *(const LAS bf16x8*)(kp + d0 * 2048), b1 = *(const LAS bf16x8*)(kp + d0 * 2048 + 512);
                p0 = __builtin_amdgcn_mfma_f32_32x32x16_bf16(b0, qr[d0], p0, 0, 0, 0); p1 = __builtin_amdgcn_mfma_f32_32x32x16_bf16(b1, qr[d0], p1, 0, 0, 0); }
            if constexpr (FOX) {
                const LAS float* Gt = Gl + (t - t0) * 64 + 4 * hi;
#pragma unroll
                for (int rq = 0; rq < 4; ++rq) { const f32x4 ga = *(const LAS f32x4*)(Gt + 8 * rq), gb = *(const LAS f32x4*)(Gt + 32 + 8 * rq);
#pragma unroll
                    for (int i = 0; i < 4; ++i) { p0[4 * rq + i] += ga[i]; p1[4 * rq + i] += gb[i]; } }
                if (64 * t + 63 > qw) { const int qrel = qw + r32 - 64 * t;
#pragma unroll
                    for (int r = 0; r < 16; ++r) { const int kv = crow(r, hi); if (kv > qrel) p0[r] = -INFINITY; if (kv + 32 > qrel) p1[r] = -INFINITY; } }
            }
            float mx = fmaxf(p0[0], p1[0]);
#pragma unroll
            for (int r = 1; r < 16; ++r) mx = fmaxf(mx, fmaxf(p0[r], p1[r]));
            mx = swapmax(mx);
            const float mnew = fmaxf(mrun, mx);
            if (__any(mnew > mrun)) {
                const float al = __builtin_amdgcn_exp2f(mrun - mnew); lrun *= al;
                if (hi == 0) wsf[r32] = al;
                asm volatile("s_waitcnt lgkmcnt(0)" ::: "memory");
#pragma unroll
                for (int rq = 0; rq < 4; ++rq) { const f32x4 af = *(const LAS f32x4*)(wsf + 8 * rq + 4 * hi);
#pragma unroll
                    for (int i = 0; i < 4; ++i) { o[0][4 * rq + i] *= af[i]; o[1][4 * rq + i] *= af[i]; } }
                mrun = mnew;
            }
            float sacc = 0.f;
#pragma unroll
            for (int r = 0; r < 16; ++r) { p0[r] = __builtin_amdgcn_exp2f(p0[r] - mrun); p1[r] = __builtin_amdgcn_exp2f(p1[r] - mrun); sacc += p0[r] + p1[r]; }
            lrun += sacc;
            const bf16x8 pa0 = pk8(p0, 0), pa1 = pk8(p0, 8), pa2 = pk8(p1, 0), pa3 = pk8(p1, 8);
            const lds_cptr vp = vp0 + sl * VSLOT;
#pragma unroll
            for (int d0 = 0; d0 < 2; ++d0) { s16x4 lo[4], hh[4];
#pragma unroll
                for (int ks = 0; ks < 4; ++ks) { lo[ks] = vtr(vp + d0 * 4096 + ks * 1024); hh[ks] = vtr(vp + d0 * 4096 + ks * 1024 + 512); }
#define PKV(k) (bf16x8){lo[k][0], lo[k][1], lo[k][2], lo[k][3], hh[k][0], hh[k][1], hh[k][2], hh[k][3]}
                o[d0] = __builtin_amdgcn_mfma_f32_32x32x16_bf16(pa0, PKV(0), o[d0], 0, 0, 0);
                o[d0] = __builtin_amdgcn_mfma_f32_32x32x16_bf16(pa1, PKV(1), o[d0], 0, 0, 0);
                o[d0] = __builtin_amdgcn_mfma_f32_32x32x16_bf16(pa2, PKV(2), o[d0], 0, 0, 0);
                o[d0] = __builtin_amdgcn_mfma_f32_32x32x16_bf16(pa3, PKV(3), o[d0], 0, 0, 0);
#undef PKV
            }
        }
        sl = sl == 2 ? 0 : sl + 1;
    }
#undef ISSUE
    lrun = swapsum(lrun);
    if (hi == 0) wsf[32 + r32] = lrun;
    asm volatile("s_waitcnt lgkmcnt(0)" ::: "memory");
    float rli[16];
#pragma unroll
    for (int rq = 0; rq < 4; ++rq) { const f32x4 lf = *(const LAS f32x4*)(wsf + 32 + 8 * rq + 4 * hi);
#pragma unroll
        for (int i = 0; i < 4; ++i) rli[4 * rq + i] = __builtin_amdgcn_rcpf(lf[i]); }
    const int hh = FOX ? 8 + h : h;
    bf16_t* Ow = A.o + (rowbase + qw) * 1024 + hh * 64;
    LAS bf16_t* stg = (LAS bf16_t*)(shm + L_OST) + wid * 2048;
#pragma unroll
    for (int r = 0; r < 16; ++r) { const int orow = crow(r, hi);
#pragma unroll
        for (int d0 = 0; d0 < 2; ++d0) { const float v = o[d0][r] * rli[r]; stg[orow * 64 + d0 * 32 + r32] = (bf16_t)(cvt_pk_bf16(v, 0.f) & 0xffffu); } }
    asm volatile("s_waitcnt lgkmcnt(0)" ::: "memory");
#pragma unroll
    for (int i = 0; i < 4; ++i) { const int row = i * 8 + (lane >> 3), ch = lane & 7; const u32x4 v = *(const LAS u32x4*)(stg + row * 64 + ch * 8);
        *(u32x4*)(Ow + (long)row * 1024 + ch * 8) = v;
        float s = 0.f; { const float a0 = bflo(v.x), a1 = bfhi(v.x), a2 = bflo(v.y), a3 = bfhi(v.y), a4 = bflo(v.z), a5 = bfhi(v.z), a6 = bflo(v.w), a7 = bfhi(v.w);
            s = ((a0 * a0 + a1 * a1) + (a2 * a2 + a3 * a3)) + ((a4 * a4 + a5 * a5) + (a6 * a6 + a7 * a7)); }
        s += __shfl_xor(s, 1); s += __shfl_xor(s, 2); s += __shfl_xor(s, 4);
        if (ch == 0) A.sso[(rowbase + qw + row) * 16 + hh] = s; }
    asm volatile("s_waitcnt lgkmcnt(0)\n\ts_barrier" ::: "memory");
}

__device__ __forceinline__ void attn_phase(const Args& A, int vcu, int G, LAS char* shm, int repm, int repf) {
    for (int v = vcu; v < 256; v += G) {
        const int bh = v >> 3, s = v & 7;
#pragma unroll 1
        for (int i = 0; i < 4 * repm; ++i) { const int ii = i & 3; const int qb = (ii == 0) ? s : (ii == 1) ? 15 - s : (ii == 2) ? 16 + s : 31 - s; attn_unit<false>(A, bh >> 3, bh & 7, qb, shm); }
#pragma unroll 1
        for (int i = 0; i < 4 * repf; ++i) { const int ii = i & 3; const int qb = (ii == 0) ? 31 - s : (ii == 1) ? 16 + s : (ii == 2) ? 15 - s : s; attn_unit<true>(A, bh >> 3, bh & 7, qb, shm); }
    }
}
}

constexpr int CW_TMO = 0, CW_BAR = 4096, CW_CNT = 200000;
constexpr int RING_BYTES = 131072, LDSCTL_OFF = RING_BYTES, LDS_BYTES = 147456;
constexpr int LC_MISC = 0, LC_PRE = 256, LC_CNT = 512;

typedef GAS unsigned gu32;
#define RLX_AGENT __ATOMIC_RELAXED, __HIP_MEMORY_SCOPE_AGENT

#define XB_TMO      128
#define XB_XCNT(j)  (256  + 64 * (j))
#define XB_XSUB(j)  (1280 + 64 * (j))
#define XB_XGEN(j)  (2304 + 64 * (j))
#define XB_TOP      3328
#define XB_TOPGEN   3392
#define XCD_BAR_WORDS 3456
#define XB_SPIN_CAP (1u << 18)
__device__ __forceinline__ unsigned xb_ld(unsigned* p)              { return __hip_atomic_load(p, __ATOMIC_RELAXED, __HIP_MEMORY_SCOPE_AGENT); }
__device__ __forceinline__ unsigned xb_add(unsigned* p, unsigned v) { return __hip_atomic_fetch_add(p, v, __ATOMIC_RELAXED, __HIP_MEMORY_SCOPE_AGENT); }
__device__ __forceinline__ unsigned xb_xcc_id() { return (unsigned)__builtin_amdgcn_s_getreg((3 << 11) | 20) & 0xFu; }
#define XB_SPIN(cond, bar) do { unsigned _sp = 0; while (cond) { __builtin_amdgcn_s_sleep(1); \
    if ((++_sp & 255u) == 0u) { if (xb_ld(&(bar)[XB_TMO])) break; if (_sp > XB_SPIN_CAP) { atomicAdd(&(bar)[XB_TMO], 1u); break; } } } } while (0)
struct XcdBarrier { unsigned* bar; unsigned x; volatile LAS unsigned* st; };
__device__ __forceinline__ XcdBarrier xcd_barrier_post(unsigned* bar, volatile LAS unsigned* st) {
    XcdBarrier b; b.bar = bar; b.x = xb_xcc_id(); b.st = st;
    if (threadIdx.x == 0) (void)xb_add(&bar[XB_XCNT(b.x)], 1u);
    return b;
}
__device__ __forceinline__ void xcd_barrier_complete(unsigned* bar, unsigned x, unsigned& nloc, unsigned& nx) {
    const unsigned G = gridDim.x * gridDim.y * gridDim.z;
    unsigned sum, cnt, mine, sp = 0u;
    for (;;) {
        sum = 0u; cnt = 0u; mine = 0u;
#pragma unroll
        for (unsigned j = 0; j < 16; ++j) { const unsigned c = xb_ld(&bar[XB_XCNT(j)]); sum += c; cnt += (c > 0u) ? 1u : 0u; mine = (j == x) ? c : mine; }
        if (sum == G) break;
        __builtin_amdgcn_s_sleep(1);
        if ((++sp & 255u) == 0u) { if (xb_ld(&bar[XB_TMO])) break; if (sp > XB_SPIN_CAP) { atomicAdd(&bar[XB_TMO], 1u); break; } }
    }
    nloc = mine > 0u ? mine : 1u; nx = cnt > 0u ? cnt : 1u;
}
__device__ __forceinline__ void xcd_barrier(const XcdBarrier& b) {
    asm volatile("s_waitcnt vmcnt(0)" ::: "memory");
    __syncthreads();
    if (threadIdx.x == 0) {
        unsigned* bar = b.bar;
        __builtin_amdgcn_s_waitcnt(0);
        unsigned nloc = b.st[0], nx = b.st[1];
        if (nloc == 0u) { xcd_barrier_complete(bar, b.x, nloc, nx); b.st[0] = nloc; b.st[1] = nx; }
        const unsigned old = xb_add(&bar[XB_XSUB(b.x)], 1u);
        const unsigned gen = old / nloc;
        if (old + 1u == (gen + 1u) * nloc) {
            __builtin_amdgcn_fence(__ATOMIC_RELEASE, "agent");
            asm volatile("s_waitcnt vmcnt(0)" ::: "memory");
            const unsigned og = xb_add(&bar[XB_TOP], 1u);
            const unsigned tg = og / nx;
            if (og + 1u == (tg + 1u) * nx) xb_add(&bar[XB_TOPGEN], 1u);
            else XB_SPIN(xb_ld(&bar[XB_TOPGEN]) == tg, bar);
            __builtin_amdgcn_fence(__ATOMIC_ACQUIRE, "agent");
            xb_add(&bar[XB_XGEN(b.x)], 1u);
            asm volatile("s_waitcnt vmcnt(0)" ::: "memory");
        } else {
            XB_SPIN(xb_ld(&bar[XB_XGEN(b.x)]) == gen, bar);
            __builtin_amdgcn_fence(__ATOMIC_ACQUIRE, "agent");
            asm volatile("s_waitcnt vmcnt(0)" ::: "memory");
        }
    }
    __syncthreads();
}

__device__ __forceinline__ float wave_sum(float v) {
#pragma unroll
    for (int o = 1; o < 64; o <<= 1) v += __shfl_xor(v, o);
    return v;
}
#define LDS_WAIT() asm volatile("s_waitcnt lgkmcnt(0)" ::: "memory")

__device__ __forceinline__ int maprow(int kind, int n) {
    switch (kind) {
    default: return n;
    case 1: {
        if (n < 256) return n;
        if (n < 384) { const int j = n - 256, q = j >> 5, c = j & 31; return 256 + (q & 1) * 128 + (q >> 1) * 32 + c; }
        if (n < 416) return 256 + 64 + (n - 384);
        if (n < 1952) { const int f = n - 416, k3 = f >> 9, r = f & 511, hd = r >> 6, d = r & 63; return (2 + 2 * k3 + (hd >> 2)) * 256 + (d >> 5) * 128 + (hd & 3) * 32 + (d & 31); }
        return 256 + 96 + (n - 1952); }
    case 2: { const int hd = n / 96, dd = n - hd * 96; if (dd < 64) return (hd >> 2) * 256 + (dd >> 5) * 128 + (hd & 3) * 32 + (dd & 31); return 512 + (hd >> 2) * 128 + (hd & 3) * 32 + (dd - 64); }
    case 3: { const int hd = n >> 7, dd = n & 127; if (dd < 64) return (hd >> 2) * 256 + (dd >> 5) * 128 + (hd & 3) * 32 + (dd & 31); const int d = dd - 64; return 512 + (hd >> 2) * 256 + (d >> 5) * 128 + (hd & 3) * 32 + (d & 31); }
    case 4: return (n >> 7) * 256 + (n & 127);
    case 5: return (n >> 7) * 256 + 128 + (n & 127);
    case 6: return 128 + n;
    }
}
__device__ __forceinline__ void conv_item(const float* W, int K, int Nsrc, bf16_t* WT, int kind, const float* s1, const float* s2, int split, LAS float* scr, int item, int lane) {
    const int nblk = (Nsrc + 31) / 32, kb = item / nblk, nb = item - kb * nblk, k0 = 64 * kb, n0 = 32 * nb;
    const bool nv = n0 + (lane & 31) < Nsrc;
#pragma unroll 8
    for (int i = 0; i < 32; ++i) { const int kk = 2 * i + (lane >> 5); scr[kk * 33 + (lane & 31)] = nv ? W[(size_t)(k0 + kk) * Nsrc + n0 + (lane & 31)] : 0.f; }
    LDS_WAIT(); asm volatile("" ::: "memory");
    const int c = lane & 7;
    float sc[8];
#pragma unroll
    for (int e = 0; e < 8; ++e) { const int k = k0 + 8 * c + e; sc[e] = s1 ? (k < split ? s1[k] : s2[k - split]) : 1.f; }
#pragma unroll
    for (int j = 0; j < 4; ++j) { const int n = (lane >> 3) + 8 * j; const LAS float* s = scr + (8 * c) * 33 + n;
        if (n0 + n < Nsrc) { u32x4 o; o.x = cvt_pk_bf16(s[0 * 33] * sc[0], s[1 * 33] * sc[1]); o.y = cvt_pk_bf16(s[2 * 33] * sc[2], s[3 * 33] * sc[3]); o.z = cvt_pk_bf16(s[4 * 33] * sc[4], s[5 * 33] * sc[5]); o.w = cvt_pk_bf16(s[6 * 33] * sc[6], s[7 * 33] * sc[7]);
            *(u32x4*)(WT + (size_t)maprow(kind, n0 + n) * K + k0 + 8 * c) = o; } }
    LDS_WAIT(); asm volatile("" ::: "memory");
}

struct KArgs { const void* in[27]; float* out; unsigned char* ws; int ph_lo, ph_hi, li, pad; };

constexpr int I_IN = 16 * 62, I_UQ = 4 * 24, I_UKV = 2 * 32, I_OUT = 16 * 32, I_RE = 16, I_RG = 16, I_GU = NEXP * 2 * 16 * 8, I_DN = NEXP * 4 * 32, I_PG = 16 * 32, I_PP = 4 * 32;
constexpr int I_LAYER = I_IN + I_UQ + I_UKV + I_OUT + I_RE + I_RG + I_GU + I_DN + I_PG + I_PP;

struct MoeOrder {
    const LAS int* pre; const LAS unsigned* cntl; const int* list; int npn, G, c; bool gather;
    __device__ __forceinline__ bool next(int i, Unit& u) const {
        const int L = i * G + c; const int TB = pre[32]; if (L >= TB * npn) return false;
        const int bg = L / npn, pl = L - bg * npn; int e = 0;
        for (int j = 1; j < 32; ++j) e += (pre[j] <= bg) ? 1 : 0;
        u.pm = bg; u.e = e; u.blk = bg - pre[e]; u.pn = e * npn + pl; return true;
    }
    __device__ __forceinline__ int arow(const Unit& u, int r) const {
        if (!gather) return u.pm * 256 + r;
        int li = u.blk * 256 + r; const int cn = (int)cntl[u.e]; li = li < cn ? li : cn - 1;
        return list[(size_t)u.e * NTOK + li] >> 1;
    }
};

#ifndef MK_CUTS
#define MK_CUTS {0, 19}
#endif
constexpr int NPHASE = 19;

__global__ void __launch_bounds__(NWAVES * 64, 2) mega_fwd(KArgs args) {
    extern __shared__ __attribute__((aligned(16))) unsigned char lds_raw[];
    LAS unsigned char* lds0 = (LAS unsigned char*)lds_raw;
    volatile LAS unsigned* MISC = (volatile LAS unsigned*)(lds0 + LDSCTL_OFF + LC_MISC);
    const int G = gridDim.x; const int bx = blockIdx.x; const int vcu = (G % 8 == 0) ? (bx % 8) * (G / 8) + bx / 8 : bx;
    for (int u = threadIdx.x; u < (LDS_BYTES - LDSCTL_OFF) / 4; u += NWAVES * 64) ((LAS unsigned*)(lds0 + LDSCTL_OFF))[u] = 0u;
    __syncthreads();
    (void)xcd_barrier_post((unsigned*)(args.ws + WS_CTL) + CW_BAR + args.li * XCD_BAR_WORDS, MISC + 8);
    const int lo = args.ph_lo, hi = args.ph_hi;
#ifndef PH_MASK
#define PH_MASK 0x3ff
#endif
#define PHM(k) ((PH_MASK >> (k)) & 1)
#ifndef DUP_MASK
#define DUP_MASK 0
#endif
#define NREP(k) (((DUP_MASK >> (k)) & 1) ? 2 : 1)
#ifndef NULL_MASK
#define NULL_MASK 0
#endif
#define NULLP(k) ((NULL_MASK >> (k)) & 1)
#define IN(k) (lo <= (k) && (k) < hi)
#define SEAM(k) do { if (IN(k) && IN((k) + 1)) { XcdBarrier bar_; bar_.bar = (unsigned*)(args.ws + WS_CTL) + CW_BAR + args.li * XCD_BAR_WORDS; bar_.x = xb_xcc_id(); bar_.st = (volatile LAS unsigned*)(lds0 + LDSCTL_OFF + LC_MISC) + 8; xcd_barrier(bar_); } } while (0)
    const int NGW = G * NWAVES, NGT = G * 512;
#define ssx0 ((float*)(wsp + WS_SSX0))
#define ssx1 ((float*)(wsp + WS_SSX1))
#define sspp ((float*)(wsp + WS_SSPP))
#define sso ((float*)(wsp + WS_SSO))
#define ssx2 ((float*)(wsp + WS_SSX2))
#define sskpe ((float*)(wsp + WS_SSKPE))
#define ssqq ((float*)(wsp + WS_SSQQ))
#define ssqkv ((float*)(wsp + WS_SSQKV))
#define gate ((float*)(wsp + WS_GATE))
#define logf ((float*)(wsp + WS_LOGF))
#define Fc ((float*)(wsp + WS_F))
#define ssqn ((float*)(wsp + WS_SSQN))
#define ssqr ((float*)(wsp + WS_SSQR))
#define cosT ((float*)(wsp + WS_COS))
#define sinT ((float*)(wsp + WS_SIN))
#define list ((int*)(wsp + WS_LIST))
#define xbA ((bf16_t*)(wsp + WS_XBA))
#define xbB ((bf16_t*)(wsp + WS_XBB))
#define pbf ((bf16_t*)(wsp + WS_PBF))
#define Qc ((bf16_t*)(wsp + WS_QC))
#define Kvc ((bf16_t*)(wsp + WS_KVC))
#define Kpe ((bf16_t*)(wsp + WS_KPE))
#define Fq ((bf16_t*)(wsp + WS_FQ))
#define Fk ((bf16_t*)(wsp + WS_FK))
#define Fv ((bf16_t*)(wsp + WS_FV))
#define Kmla ((bf16_t*)(wsp + WS_KMLA))
#define Vmla ((bf16_t*)(wsp + WS_VMLA))
#define Qraw ((bf16_t*)(wsp + WS_QRAW))
#define ob ((bf16_t*)xo)
#define ppb ((bf16_t*)(wsp + WS_PP))
#define hid ((bf16_t*)(wsp + WS_HID))
#define c1 ((bf16_t*)(wsp + WS_C1))
#define ctl ((unsigned*)(wsp + WS_CTL))
#define Wl (wsp + WS_W + (size_t)L * W_LAYER)
#define PHASE_PTRS unsigned char* wsp = args.ws; asm volatile("" : "+s"(wsp)); const float* x_in = (const float*)args.in[0]; float* xo = args.out; (void)x_in; (void)xo; \
    int tid = threadIdx.x; asm volatile("" : "+v"(tid)); const int lane = tid & 63, wave = __builtin_amdgcn_readfirstlane(tid >> 6); (void)lane; (void)wave; \
    unsigned ldo_ = 0u; asm volatile("" : "+s"(ldo_)); LAS unsigned char* lds = lds0 + ldo_; LAS int* preL = (LAS int*)(lds + LDSCTL_OFF + LC_PRE); LAS unsigned* cntL = (LAS unsigned*)(lds + LDSCTL_OFF + LC_CNT); (void)preL; (void)cntL; \
    const int gw = vcu * NWAVES + wave, gt = vcu * 512 + tid; (void)gw; (void)gt
#define INF(i) ((const float*)args.in[i])

    if (PHM(0) && IN(0)) {
        PHASE_PTRS; unsigned char* ws = wsp;
        LAS float* scr = (LAS float*)(lds + wave * 16384);
        for (int rep_ = 0; rep_ < NREP(0); ++rep_) {
        for (int it = gw; it < 2 * I_LAYER; it += NGW) {
            const int L = it >= I_LAYER ? 1 : 0; int r = it - L * I_LAYER;
            if (r < I_IN) { conv_item(INF(4) + (size_t)L * DM * INC, DM, INC, (bf16_t*)(Wl + WO_IN), 1, INF(3) + L * DM, nullptr, DM, scr, r, lane); continue; } r -= I_IN;
            if (r < I_UQ) { conv_item(INF(6) + (size_t)L * 256 * 768, 256, 768, (bf16_t*)(Wl + WO_UQ), 2, INF(5) + L * 256, nullptr, 256, scr, r, lane); continue; } r -= I_UQ;
            if (r < I_UKV) { conv_item(INF(8) + (size_t)L * 128 * 1024, 128, 1024, (bf16_t*)(Wl + WO_UKV), 3, INF(7) + L * 128, nullptr, 128, scr, r, lane); continue; } r -= I_UKV;
            if (r < I_OUT) { conv_item(INF(16) + (size_t)L * DM * DM, DM, DM, (bf16_t*)(Wl + WO_OUT), 0, INF(14) + L * 512, INF(15) + L * 512, 512, scr, r, lane); continue; } r -= I_OUT;
            if (r < I_RE) { conv_item(INF(19) + (size_t)L * DM * 32, DM, 32, (bf16_t*)(Wl + WO_RT), 0, INF(17) + L * DM, nullptr, DM, scr, r, lane); continue; } r -= I_RE;
            if (r < I_RG) { conv_item(INF(18) + (size_t)L * DM * 4, DM, 4, (bf16_t*)(Wl + WO_RT), 6, INF(17) + L * DM, nullptr, DM, scr, r, lane); continue; } r -= I_RG;
            if (r < I_GU) { const int e = r >> 8, mt = (r >> 7) & 1, ii = r & 127;
                conv_item(INF(mt ? 21 : 20) + ((size_t)L * NEXP + e) * DM * 256, DM, 256, (bf16_t*)(Wl + WO_GU) + (size_t)e * 512 * DM, mt ? 5 : 4, INF(17) + L * DM, nullptr, DM, scr, ii, lane); continue; } r -= I_GU;
            if (r < I_DN) { const int e = r >> 7, ii = r & 127;
                conv_item(INF(22) + ((size_t)L * NEXP + e) * 256 * DM, 256, DM, (bf16_t*)(Wl + WO_DN) + (size_t)e * DM * 256, 0, nullptr, nullptr, 0, scr, ii, lane); continue; } r -= I_DN;
            if (r < I_PG) { conv_item(INF(24) + (size_t)L * DM * DM, DM, DM, (bf16_t*)(Wl + WO_PG), 0, INF(23) + L * DM, nullptr, DM, scr, r, lane); continue; } r -= I_PG;
            conv_item(INF(25) + (size_t)L * 256 * DM, 256, DM, (bf16_t*)(Wl + WO_PP), 0, nullptr, nullptr, 0, scr, r, lane);
        }
        for (int it = gw; it < 2 * (88 + 220); it += NGW) {
            const int L = it >= 308 ? 1 : 0; int r = it - L * 308; bf16_t* dst;
            if (r < 88) { const int lr = r < 24 ? 104 + r : 192 + (r - 24); dst = (bf16_t*)(Wl + WO_IN) + (size_t)(256 + lr) * DM; }
            else { r -= 88; const int lr = r < 96 ? 32 + r : 132 + (r - 96); dst = (bf16_t*)(Wl + WO_RT) + (size_t)lr * DM; }
            *(u32x4*)(dst + lane * 8) = (u32x4){0u, 0u, 0u, 0u}; *(u32x4*)(dst + 512 + lane * 8) = (u32x4){0u, 0u, 0u, 0u};
        }
        for (int m = gw; m < NTOK; m += NGW) { const f32x4* xr = (const f32x4*)(x_in + (size_t)m * DM) + lane; float s = 0.f; u32x2* o8 = (u32x2*)(xbA + (size_t)m * DM) + lane;
#pragma unroll
            for (int j = 0; j < 4; ++j) { const f32x4 v = xr[64 * j]; s += sum4sq(v); u32x2 w; w.x = cvt_pk_bf16(v[0], v[1]); w.y = cvt_pk_bf16(v[2], v[3]); o8[64 * j] = w; }
            s = wave_sum(s); if (lane < 16) ssx0[(size_t)m * 16 + lane] = lane == 0 ? s : 0.f; }
        for (size_t i = gt; i < (size_t)DEPTH * NTOK * 256 / 8; i += NGT) { const f32x4 a = ((const f32x4*)INF(1))[2 * i], b = ((const f32x4*)INF(1))[2 * i + 1]; ((u32x4*)pbf)[i] = pack8(a, b); }
        for (int i = gt; i < NTOK * 16; i += NGT) { const int t = i >> 4, j = i & 15; const double inv = exp2(-(double)j * (13.287712379549449 / 16.0)); const double ang = (double)((const int*)args.in[2])[t] * inv;
            cosT[i] = (float)cos(ang); sinT[i] = (float)sin(ang); }
        }
    }
    SEAM(0);

#pragma unroll 1
    for (int L = 0; L < DEPTH; ++L) {
        const int pb = 1 + 9 * L;
        if (PHM(1) && IN(pb + 0)) {
            PHASE_PTRS;
            pg8::Gemm g{xbA, (const bf16_t*)(Wl + WO_IN), DM}; pg8::StaticOrder S; S.init(NTOK, 2048, G, bx);
            EpiInProj E{wsp, INF(13) + L * 8, INF(11) + L * 64, INF(12) + L * 64};
            for (int rep_ = 0; rep_ < NREP(1); ++rep_) pg8::gemm_phase<DM, EpiInProj, pg8::StaticOrder, true>(lds, g, S, E);
            if (NULLP(1)) { EpiNull EN{(float*)(wsp + WS_SSX2)}; pg8::gemm_phase<DM, EpiNull, pg8::StaticOrder, true>(lds, g, S, EN); }
        }
        SEAM(pb + 0);
        if (PHM(2) && IN(pb + 1)) {
            PHASE_PTRS;
            { pg8::Gemm g{Qc, (const bf16_t*)(Wl + WO_UQ), 256}; pg8::StaticOrder S; S.init(NTOK, 768, G, bx);
              EpiQUp E{wsp};
              for (int rep_ = 0; rep_ < NREP(2); ++rep_) pg8::gemm_phase<256, EpiQUp, pg8::StaticOrder, true>(lds, g, S, E); }
            { pg8::Gemm g{Kvc, (const bf16_t*)(Wl + WO_UKV), 128}; pg8::StaticOrder S; S.init(NTOK, 1024, G, bx);
              EpiKvUp E{wsp, INF(10) + L * 96};
              for (int rep_ = 0; rep_ < NREP(2); ++rep_) pg8::gemm_phase<128, EpiKvUp, pg8::StaticOrder, true>(lds, g, S, E); }
            for (int v = vcu; v < 32; v += G) {
                const int b = v >> 3, h = v & 7; LAS double* wt = (LAS double*)lds;
                const size_t base = ((size_t)b * SEQ + wave * 1024 + lane * 16) * 8 + h; float lv[16]; double loc = 0.0;
#pragma unroll
                for (int i = 0; i < 16; ++i) { lv[i] = logf[base + (size_t)i * 8]; loc += (double)lv[i]; }
                double pre = loc;
#pragma unroll
                for (int o = 1; o < 64; o <<= 1) { const double n = __shfl_up(pre, o); if (lane >= o) pre += n; }
                if (lane == 63) wt[wave] = pre;
                LDS_WAIT(); __syncthreads();
                double run = pre - loc;
                for (int w = 0; w < wave; ++w) run += wt[w];
#pragma unroll
                for (int i = 0; i < 16; ++i) { run += (double)lv[i]; Fc[base + (size_t)i * 8] = (float)run; }
                __syncthreads();
            }
        }
        SEAM(pb + 1);
        if (PHM(3) && IN(pb + 2)) {
            PHASE_PTRS;
            att::Args A{Qraw, Kmla, Vmla, Fq, Fk, Fv, ssqn, ssqr, INF(9) + L * 96, cosT, sinT, Fc, INF(11) + L * 64, INF(12) + L * 64, ob, sso};
            att::attn_phase(A, vcu, G, (LAS char*)lds, NREP(10), NREP(11));
        }
        SEAM(pb + 2);
        if (PHM(4) && IN(pb + 3)) {
            PHASE_PTRS;
            pg8::Gemm g{ob, (const bf16_t*)(Wl + WO_OUT), DM}; pg8::StaticOrder S; S.init(NTOK, DM, G, bx);
            EpiOut E{wsp, L == 0 ? x_in : (const float*)nullptr};
            for (int rep_ = 0; rep_ < (L == 0 ? NREP(4) : 1); ++rep_) pg8::gemm_phase<DM, EpiOut, pg8::StaticOrder, true>(lds, g, S, E);
            if (NULLP(4)) { EpiNull EN{(float*)(wsp + WS_SSX2)}; pg8::gemm_phase<DM, EpiNull, pg8::StaticOrder, true>(lds, g, S, EN); }
        }
        SEAM(pb + 3);
        if (PHM(5) && IN(pb + 4)) {
            PHASE_PTRS;
            { pg8::Gemm g{xbB, (const bf16_t*)(Wl + WO_RT), DM}; pg8::StaticOrder S; S.init(NTOK, 256, G, bx);
              EpiRouter E{wsp, ctl + CW_CNT + 64 * L};
              pg8::gemm_phase<DM, EpiRouter, pg8::StaticOrder, true>(lds, g, S, E); }
            { pg8::Gemm g{pbf + (size_t)L * NTOK * 256, (const bf16_t*)(Wl + WO_PP), 256}; pg8::StaticOrder S; S.init(NTOK, DM, G, bx);
              EpiPP E{wsp};
              for (int rep_ = 0; rep_ < NREP(5); ++rep_) pg8::gemm_phase<256, EpiPP, pg8::StaticOrder, true>(lds, g, S, E); }
        }
        SEAM(pb + 4);
        if ((PHM(6) && IN(pb + 5)) || (PHM(7) && IN(pb + 6))) {
            PHASE_PTRS;
            if (tid < 32) { const unsigned c = __hip_atomic_load(ctl + CW_CNT + 64 * L + tid, RLX_AGENT); cntL[tid] = c; }
            LDS_WAIT(); __syncthreads();
            if (tid == 0) { int run = 0; for (int e = 0; e < 32; ++e) { preL[e] = run; run += ((int)cntL[e] + 255) >> 8; } preL[32] = run; }
            LDS_WAIT(); __syncthreads();
        }
        if (PHM(6) && IN(pb + 5)) {
            PHASE_PTRS;
            pg8::Gemm g{xbB, (const bf16_t*)(Wl + WO_GU), DM}; MoeOrder S{preL, cntL, list, 2, G, bx, true};
            EpiMoeUp E{wsp, cntL, 2};
            for (int rep_ = 0; rep_ < NREP(6); ++rep_) pg8::gemm_phase<DM, EpiMoeUp, MoeOrder, true>(lds, g, S, E);
        }
        SEAM(pb + 5);
        if (PHM(7) && IN(pb + 6)) {
            PHASE_PTRS;
            pg8::Gemm g{hid, (const bf16_t*)(Wl + WO_DN), 256}; MoeOrder S{preL, cntL, list, 4, G, bx, false};
            EpiMoeDown E{wsp, cntL, 4};
            pg8::gemm_phase<256, EpiMoeDown, MoeOrder, true>(lds, g, S, E);
        }
        SEAM(pb + 6);
        if (PHM(8) && IN(pb + 7)) {
            PHASE_PTRS;
            for (int m = gw; m < NTOK; m += NGW) { const u32x4* cr = (const u32x4*)(c1 + (size_t)m * DM) + lane; u32x4* xr = (u32x4*)(xbB + (size_t)m * DM) + lane; float s = 0.f;
#pragma unroll
                for (int j = 0; j < 2; ++j) { const u32x4 cw = cr[64 * j], xw = xr[64 * j];
                    const f32x4 v0 = (f32x4){bflo(xw.x), bfhi(xw.x), bflo(xw.y), bfhi(xw.y)} + (f32x4){bflo(cw.x), bfhi(cw.x), bflo(cw.y), bfhi(cw.y)}, v1 = (f32x4){bflo(xw.z), bfhi(xw.z), bflo(xw.w), bfhi(xw.w)} + (f32x4){bflo(cw.z), bfhi(cw.z), bflo(cw.w), bfhi(cw.w)};
                    s += sum4sq(v0) + sum4sq(v1); xr[64 * j] = pack8(v0, v1); }
                s = wave_sum(s); if (lane == 0) ssx2[m] = s; }
        }
        SEAM(pb + 7);
        if (PHM(9) && IN(pb + 8)) {
            PHASE_PTRS;
            pg8::Gemm g{xbB, (const bf16_t*)(Wl + WO_PG), DM}; pg8::StaticOrder S; S.init(NTOK, DM, G, bx);
            EpiPle E{wsp, INF(26) + L * DM, L + 1 == DEPTH ? xo : (float*)nullptr};
            pg8::gemm_phase<DM, EpiPle, pg8::StaticOrder, true>(lds, g, S, E);
        }
        if (L + 1 < DEPTH) SEAM(pb + 8);
    }
#undef IN
#undef SEAM
#undef INF
}

extern "C" void kernel_launch(void* const* d_in, const int* in_sizes, int n_in, void* d_out, int out_size, void* d_ws, size_t ws_size, hipStream_t stream) {
    static int grid = 0;
    if (grid == 0) {
        if (n_in != 27 || ws_size < WS_END) { fprintf(stderr, "kernel_launch: unexpected inputs (n_in %d, ws %zu)\n", n_in, ws_size); grid = -1; return; }
        int dev = 0, cus = 0, per_cu = 0;
        if (hipGetDevice(&dev) != hipSuccess || hipDeviceGetAttribute(&cus, hipDeviceAttributeMultiprocessorCount, dev) != hipSuccess) { grid = -1; return; }
        if (hipFuncSetAttribute((const void*)mega_fwd, hipFuncAttributeMaxDynamicSharedMemorySize, LDS_BYTES) != hipSuccess) { fprintf(stderr, "kernel_launch: hipFuncSetAttribute failed\n"); grid = -1; return; }
        if (hipOccupancyMaxActiveBlocksPerMultiprocessor(&per_cu, (const void*)mega_fwd, NWAVES * 64, LDS_BYTES) != hipSuccess || per_cu < 1) { fprintf(stderr, "kernel_launch: occupancy query says %d\n", per_cu); }
        (void)hipGetLastError();
        grid = cus;
    }
    if (grid < 0) return;
    if (hipMemsetAsync((char*)d_ws + WS_CTL, 0, CTL_ZERO_BYTES, stream) != hipSuccess) return;
    KArgs a{};
    for (int i = 0; i < 27; ++i) a.in[i] = d_in[i];
    a.out = (float*)d_out; a.ws = (unsigned char*)d_ws;
    const int cuts[] = MK_CUTS; const int nl = (int)(sizeof(cuts) / sizeof(int)) - 1;
    for (int li = 0; li < nl; ++li) {
        a.ph_lo = cuts[li]; a.ph_hi = cuts[li + 1]; a.li = li; a.pad = 0;
        hipLaunchKernelGGL(mega_fwd, dim3(grid), dim3(NWAVES * 64), LDS_BYTES, stream, a);
        if (hipPeekAtLastError() != hipSuccess) { fprintf(stderr, "kernel_launch: launch %d failed\n", li); break; }
    }
}
```

```cpp
#include <hip/hip_runtime.h>
#include <cstdio>
#include <cstdint>

#define LAS __attribute__((address_space(3)))
#define GAS __attribute__((address_space(1)))
typedef unsigned short bf16_t;
typedef short bf16x8 __attribute__((ext_vector_type(8)));
typedef short s16x4 __attribute__((ext_vector_type(4)));
typedef float f32x2 __attribute__((ext_vector_type(2)));
typedef float f32x4 __attribute__((ext_vector_type(4)));
typedef float f32x16 __attribute__((ext_vector_type(16)));
typedef unsigned u32x2 __attribute__((ext_vector_type(2)));
typedef unsigned u32x4 __attribute__((ext_vector_type(4)));

constexpr int DM = 1024, NB = 4, SEQ = 8192, NTOK = NB * SEQ, DEPTH = 2;
constexpr int INC = 1960, NEXP = 32;
constexpr int C_KVC = 256, C_KPE = 384, C_FQ = 416, C_FK = 928, C_FV = 1440, C_FL = 1952;
constexpr float EPS = 1e-6f;
constexpr float LOG2E = 1.4426950408889634f;
constexpr float C2_FOX = 0.125f * LOG2E;
constexpr float C2_MLA = 0.10206207261596575f * LOG2E;

__device__ __forceinline__ unsigned cvt_pk_bf16(float lo, float hi) { unsigned r; asm volatile("v_cvt_pk_bf16_f32 %0, %1, %2" : "=v"(r) : "v"(lo), "v"(hi)); return r; }
__device__ __forceinline__ float bf2f(unsigned short u) { return __uint_as_float((unsigned)u << 16); }
__device__ __forceinline__ float bflo(unsigned w) { return __uint_as_float(w << 16); }
__device__ __forceinline__ float bfhi(unsigned w) { return __uint_as_float(w & 0xffff0000u); }
__device__ __forceinline__ u32x4 pack8(const f32x4& a, const f32x4& b) { u32x4 w; w.x = cvt_pk_bf16(a[0], a[1]); w.y = cvt_pk_bf16(a[2], a[3]); w.z = cvt_pk_bf16(b[0], b[1]); w.w = cvt_pk_bf16(b[2], b[3]); return w; }
__device__ __forceinline__ float sum4sq(const f32x4& a) { return (a[0] * a[0] + a[1] * a[1]) + (a[2] * a[2] + a[3] * a[3]); }
__device__ __forceinline__ float red_fq(float s) { s += __shfl_xor(s, 16); s += __shfl_xor(s, 32); return s; }
__device__ __forceinline__ float sum16(const float* p) { const f32x4 a = *(const f32x4*)p, b = *(const f32x4*)(p + 4), c = *(const f32x4*)(p + 8), d = *(const f32x4*)(p + 12);
    return ((a[0] + a[1]) + (a[2] + a[3])) + ((b[0] + b[1]) + (b[2] + b[3])) + ((c[0] + c[1]) + (c[2] + c[3])) + ((d[0] + d[1]) + (d[2] + d[3])); }
__device__ __forceinline__ float sum8(const float* p) { const f32x4 a = *(const f32x4*)p, b = *(const f32x4*)(p + 4); return ((a[0] + a[1]) + (a[2] + a[3])) + ((b[0] + b[1]) + (b[2] + b[3])); }
__device__ __forceinline__ float log_sigmoid_f(float x) { return -(fmaxf(-x, 0.f) + log1pf(__expf(-fabsf(x)))); }

constexpr int NWAVES = 8;
constexpr size_t MiB = 1u << 20;
constexpr size_t WS_CTL = 0, CTL_ZERO_BYTES = 1 * MiB;
constexpr size_t WS_SSX0 = 1 * MiB, WS_SSX1 = 3 * MiB, WS_SSPP = 5 * MiB, WS_SSO = 7 * MiB, WS_SSX2 = 9 * MiB, WS_SSKPE = 10 * MiB, WS_SSQQ = 11 * MiB, WS_SSQKV = 12 * MiB,
                 WS_GATE = 13 * MiB, WS_LOGF = 14 * MiB, WS_F = 15 * MiB, WS_SSQN = 16 * MiB, WS_SSQR = 17 * MiB, WS_COS = 18 * MiB, WS_SIN = 20 * MiB, WS_LIST = 22 * MiB;
constexpr size_t WS_W = 28 * MiB, W_LAYER = 58 * MiB;
constexpr size_t WO_IN = 0, WO_UQ = 4 * MiB, WO_UKV = 4 * MiB + 512 * 1024, WO_OUT = 5 * MiB, WO_RT = 7 * MiB, WO_PG = 7 * MiB + 512 * 1024, WO_PP = 9 * MiB + 512 * 1024, WO_GU = 10 * MiB, WO_DN = 42 * MiB;
constexpr size_t WS_XBA = 144 * MiB, WS_XBB = 208 * MiB, WS_PBF = 272 * MiB, WS_MIX = 304 * MiB;
constexpr size_t WS_O = WS_XBA, WS_QRAW = WS_XBB;
constexpr size_t WS_QC = WS_MIX, WS_KVC = WS_MIX + 16 * MiB, WS_KPE = WS_MIX + 24 * MiB, WS_FQ = WS_MIX + 26 * MiB, WS_FK = WS_MIX + 58 * MiB, WS_FV = WS_MIX + 90 * MiB, WS_KMLA = WS_MIX + 122 * MiB, WS_VMLA = WS_MIX + 170 * MiB;
constexpr size_t WS_PP = WS_MIX, WS_HID = WS_MIX + 64 * MiB, WS_C1 = WS_MIX + 100 * MiB;
constexpr size_t WS_END = 512 * MiB;
static_assert(WS_VMLA + 32 * MiB <= WS_END && WS_C1 + 64 * MiB <= WS_END && WS_W + 2 * W_LAYER <= WS_XBA, "d_ws map");
constexpr int HID_ROWS = 2 * NTOK + NEXP * 256;
static_assert((size_t)HID_ROWS * 256 * 2 <= 36 * MiB, "hid");

namespace pg8 {
constexpr int TAB_OFF = 131072 + 1024;
constexpr int BM = 256, BK = 64, HALF = 128, HTB = HALF * BK * 2, STAGE_BYTES = 8 * HTB, NXCD = 8, WGM = 8;
__host__ __device__ __forceinline__ int lds_byte(int r, int c) { const int st = (r >> 4) * 2 + (c >> 5), rr = r & 15, cc = c & 31, ob = rr * 64 + cc * 2; return st * 1024 + (ob ^ (((ob >> 9) & 1) << 5)); }
__host__ __device__ __forceinline__ void stage_rc(int b, int& R, int& C) { const int st = b / 1024, sb = b % 1024, swz = sb ^ (((sb >> 9) & 1) << 5); R = (st >> 1) * 16 + swz / 64; C = (st & 1) * 32 + (swz % 64) / 2; }
__host__ __device__ __forceinline__ int perm32(int rho) { const int n = rho >> 4, i = rho & 15; return 8 * (i >> 2) + 4 * n + (i & 3); }

struct Unit { int pm, pn, e, blk; };
struct Gemm { const bf16_t* A; const bf16_t* Bt; int K; };

struct StaticOrder {
    int nM, nN, nwg, G, c;
    __device__ void init(int M, int N, int G_, int c_) { nM = M / BM; nN = N / BM; nwg = nM * nN; G = G_; c = c_; }
    __device__ bool next(int i, Unit& u) const {
        const long L = (long)i * G + c; if (L >= nwg) return false;
        int wgid = (int)L; { const int q = nwg / NXCD, r = nwg % NXCD, xcd = wgid % NXCD, off = wgid / NXCD; wgid = (xcd < r ? xcd * (q + 1) : r * (q + 1) + (xcd - r) * q) + off; }
        const int nig = WGM * nN, gid = wgid / nig, fm = gid * WGM, gsz = (nM - fm) < WGM ? (nM - fm) : WGM;
        u.pm = fm + ((wgid % nig) % gsz); u.pn = (wgid % nig) / gsz; u.e = 0; u.blk = 0; return true;
    }
    __device__ __forceinline__ int arow(const Unit& u, int r) const { return u.pm * BM + r; }
};

template <int K, class Epi, class Sched, bool ALIGN_EPI>
__device__ __forceinline__ void gemm_phase(LAS unsigned char* lds, const Gemm g, const Sched& S, const Epi& E) {
    LAS f32x2* const tab0 = (LAS f32x2*)(lds + TAB_OFF);
    int tid_ = threadIdx.x; asm volatile("" : "+v"(tid_));
    const int tid = tid_, wid = __builtin_amdgcn_readfirstlane(tid >> 6), lane = tid & 63, wr = wid >> 2, wc = wid & 3, fr = lane & 15, fq = lane >> 4;
    int Kr = K; asm volatile("" : "+s"(Kr));
    const int nt = Kr / BK;
    unsigned voffB[2];
#pragma unroll
    for (int i = 0; i < 2; ++i) { int R_, C_; stage_rc(tid * 16 + i * 8192, R_, C_); const int Rb = (R_ & ~31) + perm32(R_ & 31); voffB[i] = (unsigned)(Rb * Kr + C_) * 2u; }
    const size_t kstep = (size_t)(BK * 2);
    const size_t hstep = (size_t)HALF * Kr * 2;
    const size_t tstep = 2 * hstep;
    const unsigned ldsw = (unsigned)wid * 1024u;
    const int aoff = lds_byte(wr * 64 + fr, fq * 8), boff = lds_byte(wc * 32 + fr, fq * 8);
#define PG8_SA(b, h) (((b) * 2 + (h)) * HTB)
#define PG8_SB(b, h) ((4 + (b) * 2 + (h)) * HTB)
#define PG8_STAGE(bufoff, gbase, voff) do { _Pragma("unroll") for (int _i = 0; _i < 2; ++_i) \
        __builtin_amdgcn_global_load_lds((const unsigned*)((const char*)(gbase) + (voff)[_i]), (LAS unsigned*)(lds + (bufoff) + ldsw + _i * 8192), 16, 0, 0); } while (0)
#define PG8_LDA(dst, b, h) do { _Pragma("unroll") for (int m = 0; m < 4; ++m) _Pragma("unroll") for (int k = 0; k < 2; ++k) dst[m][k] = *(const LAS bf16x8*)(lds + PG8_SA(b, h) + aoff + m * 2048 + k * 1024); } while (0)
#define PG8_LDB(dst, b, h) do { _Pragma("unroll") for (int n = 0; n < 2; ++n) _Pragma("unroll") for (int k = 0; k < 2; ++k) dst[n][k] = *(const LAS bf16x8*)(lds + PG8_SB(b, h) + boff + n * 2048 + k * 1024); } while (0)
#define PG8_MMA(ai, bj, At, Bt) do { __builtin_amdgcn_s_setprio(1); _Pragma("unroll") for (int m = 0; m < 4; ++m) _Pragma("unroll") for (int n = 0; n < 2; ++n) _Pragma("unroll") for (int k = 0; k < 2; ++k) \
        acc[ai][bj][m][n] = __builtin_amdgcn_mfma_f32_16x16x32_bf16(Bt[n][k], At[m][k], acc[ai][bj][m][n], 0, 0, 0); __builtin_amdgcn_s_setprio(0); } while (0)
#define PG8_WAIT_V(n) asm volatile("s_waitcnt vmcnt(" #n ")" ::: "memory")
#define PG8_WAIT_L(n) asm volatile("s_waitcnt lgkmcnt(" #n ")" ::: "memory")
#define PG8_BAR __builtin_amdgcn_s_barrier()
#define PG8_SCHED __builtin_amdgcn_sched_barrier(0)
#define PG8_AOFF(dst, u) do { int _t = tid; asm volatile("" : "+v"(_t)); _Pragma("unroll") for (int _i = 0; _i < 2; ++_i) { int _R, _C; stage_rc(_t * 16 + _i * 8192, _R, _C); _Pragma("unroll") for (int _h = 0; _h < 2; ++_h) dst[_h][_i] = ((unsigned)S.arow(u, _h * HALF + _R) * (unsigned)Kr + (unsigned)_C) * 2u; } } while (0)
    Unit cur, nxt; int ui = 0;
    if (!S.next(0, cur)) return;
    f32x4 acc[2][2][4][2];
#pragma unroll
    for (int a = 0; a < 2; ++a)
#pragma unroll
        for (int b = 0; b < 2; ++b)
#pragma unroll
            for (int m = 0; m < 4; ++m)
#pragma unroll
                for (int n = 0; n < 2; ++n) acc[a][b][m][n] = (f32x4){0.f, 0.f, 0.f, 0.f};
    bf16x8 At[4][2], B0[2][2], B1[2][2];
    unsigned ca[2][2], na[2][2];
    PG8_AOFF(ca, cur);
    const char* gA = (const char*)g.A;
    const char* cB = (const char*)g.Bt + (size_t)cur.pn * tstep;
    PG8_STAGE(PG8_SB(0, 0), cB, voffB); PG8_STAGE(PG8_SB(0, 1), cB + hstep, voffB); PG8_STAGE(PG8_SA(0, 0), gA, ca[0]); PG8_STAGE(PG8_SA(0, 1), gA, ca[1]);
    if (wr == 1) PG8_BAR;
    PG8_WAIT_V(2); PG8_BAR;
    PG8_STAGE(PG8_SB(1, 0), cB + kstep, voffB); PG8_STAGE(PG8_SA(1, 0), gA + kstep, ca[0]); PG8_STAGE(PG8_SB(1, 1), cB + hstep + kstep, voffB);
    PG8_WAIT_V(6); PG8_BAR;
    for (;;) {
        const bool has_next = S.next(ui + 1, nxt);
        E.pre(cur, tab0 + (ui & 1) * 256, tid);
        if (has_next) { PG8_AOFF(na, nxt); } else {
#pragma unroll
            for (int _h = 0; _h < 2; ++_h)
#pragma unroll
                for (int _i = 0; _i < 2; ++_i) na[_h][_i] = ca[_h][_i]; }
        const char* nB = has_next ? (const char*)g.Bt + (size_t)nxt.pn * tstep : cB;
        for (int t = 0; t < nt; t += 2) {
            const bool last = (t == nt - 2);
            if constexpr (Epi::HAS_MID) { if (t == nt / 2) E.mid(acc, cur, wr, wc, fr, fq, tab0 + (ui & 1) * 256); }
            const char* a1 = gA + (size_t)(t + 1) * kstep;
            const char* a2 = last ? gA : gA + (size_t)(t + 2) * kstep; const char* b2 = last ? nB : cB + (size_t)(t + 2) * kstep;
            const char* a3 = a2 + kstep; const char* b3 = b2 + kstep;
            unsigned o2[2][2];
#pragma unroll
            for (int _h = 0; _h < 2; ++_h)
#pragma unroll
                for (int _i = 0; _i < 2; ++_i) o2[_h][_i] = last ? na[_h][_i] : ca[_h][_i];
            PG8_LDB(B0, 0, 0); PG8_LDB(B1, 0, 1); PG8_SCHED; PG8_LDA(At, 0, 0); PG8_STAGE(PG8_SA(1, 1), a1, ca[1]);
            PG8_WAIT_V(8); PG8_WAIT_L(0); PG8_BAR; PG8_MMA(0, 0, At, B0); PG8_MMA(0, 1, At, B1); PG8_BAR; PG8_SCHED;
            PG8_LDA(At, 0, 1); PG8_STAGE(PG8_SB(0, 0), b2, voffB); PG8_STAGE(PG8_SB(0, 1), b2 + hstep, voffB); PG8_STAGE(PG8_SA(0, 0), a2, o2[0]);
            PG8_WAIT_V(8); PG8_WAIT_L(0); PG8_BAR; PG8_MMA(1, 0, At, B0); PG8_MMA(1, 1, At, B1); PG8_BAR; PG8_SCHED;
            PG8_LDB(B0, 1, 0); PG8_LDB(B1, 1, 1); PG8_SCHED; PG8_LDA(At, 1, 0); PG8_STAGE(PG8_SA(0, 1), a2, o2[1]);
            PG8_WAIT_V(8); PG8_WAIT_L(0); PG8_BAR; PG8_MMA(0, 0, At, B0); PG8_MMA(0, 1, At, B1); PG8_BAR; PG8_SCHED;
            PG8_LDA(At, 1, 1); PG8_STAGE(PG8_SB(1, 0), b3, voffB); PG8_STAGE(PG8_SB(1, 1), b3 + hstep, voffB); PG8_STAGE(PG8_SA(1, 0), a3, o2[0]);
            PG8_WAIT_V(8); PG8_WAIT_L(0); PG8_BAR; PG8_MMA(1, 0, At, B0); PG8_MMA(1, 1, At, B1); PG8_BAR; PG8_SCHED;
        }
        if constexpr (ALIGN_EPI) { if (wr == 0) PG8_BAR; }
        E(acc, cur, wr, wc, fr, fq, tab0 + (ui & 1) * 256);
        if (!has_next) break;
#pragma unroll
        for (int a = 0; a < 2; ++a)
#pragma unroll
            for (int b = 0; b < 2; ++b)
#pragma unroll
                for (int m = 0; m < 4; ++m)
#pragma unroll
                    for (int n = 0; n < 2; ++n) acc[a][b][m][n] = (f32x4){0.f, 0.f, 0.f, 0.f};
        cur = nxt; cB = nB; ++ui;
#pragma unroll
        for (int _h = 0; _h < 2; ++_h)
#pragma unroll
            for (int _i = 0; _i < 2; ++_i) ca[_h][_i] = na[_h][_i];
        if constexpr (ALIGN_EPI) { if (wr == 1) PG8_BAR; }
    }
    PG8_WAIT_V(0);
    if constexpr (!ALIGN_EPI) { if (wr == 0) PG8_BAR; }
    PG8_BAR;
#undef PG8_SA
#undef PG8_SB
#undef PG8_STAGE
#undef PG8_LDA
#undef PG8_LDB
#undef PG8_MMA
#undef PG8_WAIT_V
#undef PG8_WAIT_L
#undef PG8_BAR
#undef PG8_SCHED
#undef PG8_AOFF
}
}
using pg8::Unit;
typedef f32x4 AccT[2][2][4][2];
#define EPI_ROWS(...) _Pragma("unroll") for (int ai = 0; ai < 2; ++ai) _Pragma("unroll") for (int m = 0; m < 4; ++m) { const int rl = ai * 128 + wr * 64 + m * 16 + fr; const int row = u.pm * 256 + rl; (void)row; __VA_ARGS__ if (m & 1) asm volatile("" ::: "memory"); }

struct EpiInProj {
    static constexpr bool HAS_MID = false;
    unsigned char* ws; const float *bfox, *gfq, *gfk;
    __device__ __forceinline__ void pre(const Unit& u, LAS f32x2* tab, int tid) const { if (tid < 256) { const float* ssx = (const float*)(ws + WS_SSX0); tab[tid] = (f32x2){rsqrtf(sum16(ssx + (size_t)(u.pm * 256 + tid) * 16) * (1.f / 1024.f) + EPS), 0.f}; } }
    __device__ __forceinline__ void mid(AccT&, const Unit&, int, int, int, int, const LAS f32x2*) const {}
    __device__ __forceinline__ void operator()(const AccT& acc, const Unit& u, int wr, int wc, int fr, int fq, const LAS f32x2* tab) const {
        asm volatile("" : "+v"(fr), "+v"(fq));
        const int pn = u.pn;
        const float* ssx = (const float*)(ws + WS_SSX0); bf16_t* Qc = (bf16_t*)(ws + WS_QC); bf16_t* Kvc = (bf16_t*)(ws + WS_KVC); bf16_t* Kpe = (bf16_t*)(ws + WS_KPE);
        float* ssq_q = (float*)(ws + WS_SSQQ); float* ssq_kv = (float*)(ws + WS_SSQKV); float* ss_kpe = (float*)(ws + WS_SSKPE); float* logf = (float*)(ws + WS_LOGF);
        if (pn == 0) {
            EPI_ROWS({ const float rinv = tab[rl].x; float s = 0.f;
_Pragma("unroll")
                for (int bj = 0; bj < 2; ++bj) { const f32x4 v0 = acc[ai][bj][m][0] * rinv, v1 = acc[ai][bj][m][1] * rinv; s += sum4sq(v0) + sum4sq(v1);
                    *(u32x4*)(Qc + (size_t)row * 256 + bj * 128 + wc * 32 + fq * 8) = pack8(v0, v1); }
                s = red_fq(s); if (fq == 0) ssq_q[(size_t)row * 4 + wc] = s; })
        } else if (pn == 1) {
            EPI_ROWS({ const float rinv = tab[rl].x;
                if (wc < 2) { float s = 0.f;
_Pragma("unroll")
                    for (int bj = 0; bj < 2; ++bj) { const f32x4 v0 = acc[ai][bj][m][0] * rinv, v1 = acc[ai][bj][m][1] * rinv; s += sum4sq(v0) + sum4sq(v1);
                        *(u32x4*)(Kvc + (size_t)row * 128 + wc * 64 + bj * 32 + fq * 8) = pack8(v0, v1); }
                    s = red_fq(s); if (fq == 0) ssq_kv[(size_t)row * 2 + wc] = s;
                } else if (wc == 2) { const f32x4 v0 = acc[ai][0][m][0] * rinv, v1 = acc[ai][0][m][1] * rinv; float s = sum4sq(v0) + sum4sq(v1);
                    *(u32x4*)(Kpe + (size_t)row * 32 + fq * 8) = pack8(v0, v1);
                    s = red_fq(s); if (fq == 0) ss_kpe[row] = s;
                } else { if (fq == 0) { const f32x4 v0 = acc[ai][0][m][0] * rinv, v1 = acc[ai][0][m][1] * rinv; const f32x4 b0 = *(const f32x4*)bfox, b1 = *(const f32x4*)(bfox + 4); f32x4 o0, o1;
_Pragma("unroll")
                        for (int i = 0; i < 4; ++i) { o0[i] = log_sigmoid_f(v0[i] + b0[i]); o1[i] = log_sigmoid_f(v1[i] + b1[i]); }
                        *(f32x4*)(logf + (size_t)row * 8) = o0; *(f32x4*)(logf + (size_t)row * 8 + 4) = o1; } } })
        } else {
            const int kind = (pn - 2) >> 1, head = 4 * ((pn - 2) & 1) + wc;
            bf16_t* dst = (bf16_t*)(ws + (kind == 0 ? WS_FQ : (kind == 1 ? WS_FK : WS_FV))); const float* g = kind == 0 ? gfq : gfk; const float osc = kind == 0 ? C2_FOX : 1.f;
            f32x4 g4[2][2];
_Pragma("unroll")
            for (int bj = 0; bj < 2; ++bj)
_Pragma("unroll")
                for (int n = 0; n < 2; ++n) g4[bj][n] = kind < 2 ? *(const f32x4*)(g + bj * 32 + fq * 8 + n * 4) * osc : (f32x4){1.f, 1.f, 1.f, 1.f};
            EPI_ROWS({ const float rinv = tab[rl].x; f32x4 v[2][2]; float s = 0.f;
_Pragma("unroll")
                for (int bj = 0; bj < 2; ++bj)
_Pragma("unroll")
                    for (int n = 0; n < 2; ++n) { v[bj][n] = acc[ai][bj][m][n] * rinv; s += sum4sq(v[bj][n]); }
                s = red_fq(s); const float hr = kind < 2 ? rsqrtf(s * (1.f / 64.f) + EPS) : 1.f;
_Pragma("unroll")
                for (int bj = 0; bj < 2; ++bj) { const int bb = row >> 13, tl = (row >> 6) & 127, r = row & 63; const size_t tb = ((size_t)(bb * 8 + head) * 128 + tl) * 4096;
                    const size_t off = kind == 0 ? (size_t)row * 512 + head * 64 + bj * 32 + fq * 8 : (kind == 1 ? tb + (4 * bj + fq) * 512 + r * 8 : tb + (bj * 4 + (r >> 4)) * 512 + (r & 15) * 32 + fq * 8);
                    *(u32x4*)(dst + off) = pack8(v[bj][0] * hr * g4[bj][0], v[bj][1] * hr * g4[bj][1]); } })
        }
    }
};
struct EpiQUp {
    static constexpr bool HAS_MID = false;
    unsigned char* ws;
    __device__ __forceinline__ void pre(const Unit& u, LAS f32x2* tab, int tid) const { if (tid < 256) { const f32x4 sq = *(const f32x4*)((const float*)(ws + WS_SSQQ) + (size_t)(u.pm * 256 + tid) * 4); tab[tid] = (f32x2){rsqrtf(((sq[0] + sq[1]) + (sq[2] + sq[3])) * (1.f / 256.f) + EPS), 0.f}; } }
    __device__ __forceinline__ void mid(AccT&, const Unit&, int, int, int, int, const LAS f32x2*) const {}
    __device__ __forceinline__ void operator()(const AccT& acc, const Unit& u, int wr, int wc, int fr, int fq, const LAS f32x2* tab) const {
        asm volatile("" : "+v"(fr), "+v"(fq));
        const int pn = u.pn;
        const float* ssq_q = (const float*)(ws + WS_SSQQ); bf16_t* Qraw = (bf16_t*)(ws + WS_QRAW); float* ssq_qn = (float*)(ws + WS_SSQN); float* ssq_qr = (float*)(ws + WS_SSQR);
        EPI_ROWS({ const float rinv = tab[rl].x;
            if (pn < 2) { const int head = 4 * pn + wc; float s = 0.f;
_Pragma("unroll")
                for (int bj = 0; bj < 2; ++bj) { const f32x4 v0 = acc[ai][bj][m][0] * rinv, v1 = acc[ai][bj][m][1] * rinv; s += sum4sq(v0) + sum4sq(v1);
                    *(u32x4*)(Qraw + (size_t)row * 768 + head * 96 + bj * 32 + fq * 8) = pack8(v0, v1); }
                s = red_fq(s); if (fq == 0) ssq_qn[(size_t)row * 8 + head] = s;
            } else {
_Pragma("unroll")
                for (int bj = 0; bj < 2; ++bj) { const int head = 4 * bj + wc; const f32x4 v0 = acc[ai][bj][m][0] * rinv, v1 = acc[ai][bj][m][1] * rinv; float s = sum4sq(v0) + sum4sq(v1);
                    *(u32x4*)(Qraw + (size_t)row * 768 + head * 96 + 64 + fq * 8) = pack8(v0, v1);
                    s = red_fq(s); if (fq == 0) ssq_qr[(size_t)row * 8 + head] = s; }
            } })
    }
};
struct EpiKvUp {
    static constexpr bool HAS_MID = false;
    unsigned char* ws; const float* gk;
    __device__ __forceinline__ void pre(const Unit& u, LAS f32x2* tab, int tid) const { if (tid < 256) { const size_t r = (size_t)(u.pm * 256 + tid); const f32x2 sk = *(const f32x2*)((const float*)(ws + WS_SSQKV) + r * 2); tab[tid] = (f32x2){rsqrtf((sk[0] + sk[1]) * (1.f / 128.f) + EPS), ((const float*)(ws + WS_SSKPE))[r]}; } }
    __device__ __forceinline__ void mid(AccT&, const Unit&, int, int, int, int, const LAS f32x2*) const {}
    __device__ __forceinline__ void operator()(const AccT& acc, const Unit& u, int wr, int wc, int fr, int fq, const LAS f32x2* tab) const {
        asm volatile("" : "+v"(fr), "+v"(fq));
        const int pn = u.pn;
        const float* ssq_kv = (const float*)(ws + WS_SSQKV); const float* ss_kpe = (const float*)(ws + WS_SSKPE); const bf16_t* Kpe = (const bf16_t*)(ws + WS_KPE);
        const float* cosT = (const float*)(ws + WS_COS); const float* sinT = (const float*)(ws + WS_SIN); bf16_t* Kmla = (bf16_t*)(ws + WS_KMLA); bf16_t* Vmla = (bf16_t*)(ws + WS_VMLA);
        if (pn < 2) {
            const int head = 4 * pn + wc;
            f32x4 g4[2][2];
_Pragma("unroll")
            for (int bj = 0; bj < 2; ++bj)
_Pragma("unroll")
                for (int n = 0; n < 2; ++n) g4[bj][n] = *(const f32x4*)(gk + bj * 32 + fq * 8 + n * 4);
            const f32x4 gr1 = *(const f32x4*)(gk + 64 + 4 * fq), gr2 = *(const f32x4*)(gk + 80 + 4 * fq);
            EPI_ROWS({ const f32x2 tt = tab[rl]; const float rinv = tt.x; f32x4 v[2][2]; float s = 0.f;
_Pragma("unroll")
                for (int bj = 0; bj < 2; ++bj)
_Pragma("unroll")
                    for (int n = 0; n < 2; ++n) { v[bj][n] = acc[ai][bj][m][n] * rinv; s += sum4sq(v[bj][n]); }
                s = red_fq(s) + tt.y; const float hr = rsqrtf(s * (1.f / 96.f) + EPS);
                const int bb = row >> 13, tl = (row >> 6) & 127, r = row & 63; bf16_t* kd = Kmla + ((size_t)(bb * 8 + head) * 128 + tl) * 6144 + r * 8;
_Pragma("unroll")
                for (int bj = 0; bj < 2; ++bj) *(u32x4*)(kd + (4 * bj + fq) * 512) = pack8(v[bj][0] * hr * g4[bj][0], v[bj][1] * hr * g4[bj][1]);
                const u32x2 p1 = *(const u32x2*)(Kpe + (size_t)row * 32 + 4 * fq), p2 = *(const u32x2*)(Kpe + (size_t)row * 32 + 16 + 4 * fq);
                const f32x4 c = *(const f32x4*)(cosT + (size_t)row * 16 + 4 * fq), sn = *(const f32x4*)(sinT + (size_t)row * 16 + 4 * fq);
                const f32x4 x1 = (f32x4){bflo(p1.x), bfhi(p1.x), bflo(p1.y), bfhi(p1.y)} * hr * gr1, x2 = (f32x4){bflo(p2.x), bfhi(p2.x), bflo(p2.y), bfhi(p2.y)} * hr * gr2;
                const f32x4 o1 = x1 * c - x2 * sn, o2 = x2 * c + x1 * sn;
                u32x2 w1, w2; w1.x = cvt_pk_bf16(o1[0], o1[1]); w1.y = cvt_pk_bf16(o1[2], o1[3]); w2.x = cvt_pk_bf16(o2[0], o2[1]); w2.y = cvt_pk_bf16(o2[2], o2[3]);
                *(u32x2*)(kd + (8 + (fq >> 1)) * 512 + 4 * (fq & 1)) = w1; *(u32x2*)(kd + (10 + (fq >> 1)) * 512 + 4 * (fq & 1)) = w2; })
        } else {
            const int head = 4 * (pn - 2) + wc;
            EPI_ROWS({ const f32x2 tt = tab[rl]; const float rinv = tt.x;
_Pragma("unroll")
                for (int bj = 0; bj < 2; ++bj) { const int bb = row >> 13, tl = (row >> 6) & 127, r = row & 63;
                    *(u32x4*)(Vmla + ((size_t)(bb * 8 + head) * 128 + tl) * 4096 + (bj * 4 + (r >> 4)) * 512 + (r & 15) * 32 + fq * 8) = pack8(acc[ai][bj][m][0] * rinv, acc[ai][bj][m][1] * rinv); } })
        }
    }
};
struct EpiOut {
    static constexpr bool HAS_MID = true;
    unsigned char* ws; const float* base;
    __device__ __forceinline__ void pre(const Unit& u, LAS f32x2* tab, int tid) const { if (tid < 256) { const float* sso = (const float*)(ws + WS_SSO) + (size_t)(u.pm * 256 + tid) * 16;
        const float rm = rsqrtf(sum8(sso) * (1.f / 512.f) + EPS), rf = rsqrtf(sum8(sso + 8) * (1.f / 512.f) + EPS); tab[tid] = (f32x2){rm / rf, rf}; } }
    __device__ __forceinline__ void mid(AccT& acc, const Unit& u, int wr, int wc, int fr, int fq, const LAS f32x2* tab) const {
        EPI_ROWS({ const float ratio = tab[rl].x;
_Pragma("unroll")
            for (int bj = 0; bj < 2; ++bj)
_Pragma("unroll")
                for (int n = 0; n < 2; ++n) acc[ai][bj][m][n] *= ratio; })
    }
    __device__ __forceinline__ void operator()(const AccT& acc, const Unit& u, int wr, int wc, int fr, int fq, const LAS f32x2* tab) const {
        asm volatile("" : "+v"(fr), "+v"(fq));
        bf16_t* xb = (bf16_t*)(ws + WS_XBB); const bf16_t* xa = (const bf16_t*)(ws + WS_XBA); float* ssx1 = (float*)(ws + WS_SSX1);
        EPI_ROWS({ const float rf = tab[rl].y; float s = 0.f;
_Pragma("unroll")
            for (int bj = 0; bj < 2; ++bj) { const size_t off = (size_t)row * 1024 + u.pn * 256 + bj * 128 + wc * 32 + fq * 8; f32x4 b0, b1;
                if (base) { b0 = *(const f32x4*)(base + off); b1 = *(const f32x4*)(base + off + 4); }
                else { const u32x4 w = *(const u32x4*)(xa + off); b0 = (f32x4){bflo(w.x), bfhi(w.x), bflo(w.y), bfhi(w.y)}; b1 = (f32x4){bflo(w.z), bfhi(w.z), bflo(w.w), bfhi(w.w)}; }
                const f32x4 v0 = b0 + acc[ai][bj][m][0] * rf, v1 = b1 + acc[ai][bj][m][1] * rf; s += sum4sq(v0) + sum4sq(v1);
                *(u32x4*)(xb + off) = pack8(v0, v1); }
            s = red_fq(s); if (fq == 0) ssx1[(size_t)row * 16 + u.pn * 4 + wc] = s; })
    }
};
struct EpiRouter {
    static constexpr bool HAS_MID = false;
    unsigned char* ws; unsigned* cnt;
    __device__ __forceinline__ void pre(const Unit& u, LAS f32x2* tab, int tid) const { if (tid < 256) { const float* ssx1 = (const float*)(ws + WS_SSX1); tab[tid] = (f32x2){rsqrtf(sum16(ssx1 + (size_t)(u.pm * 256 + tid) * 16) * (1.f / 1024.f) + EPS), 0.f}; } }
    __device__ __forceinline__ void mid(AccT&, const Unit&, int, int, int, int, const LAS f32x2*) const {}
    __device__ __forceinline__ void operator()(const AccT& acc, const Unit& u, int wr, int wc, int fr, int fq, const LAS f32x2* tab) const {
        asm volatile("" : "+v"(fr), "+v"(fq));
        if (wc != 0) return;
        float* gate = (float*)(ws + WS_GATE); int* list = (int*)(ws + WS_LIST);
        EPI_ROWS({ const float rinv = tab[rl].x;
            const f32x4 gl = acc[ai][1][m][0] * rinv; int g = 0; float gm = gl[0];
_Pragma("unroll")
            for (int j = 1; j < 4; ++j) if (gl[j] > gm) { gm = gl[j]; g = j; }
            float gs = 0.f;
_Pragma("unroll")
            for (int j = 0; j < 4; ++j) gs += __expf(gl[j] - gm);
            float pg = 1.f / gs;
            g = __shfl(g, fr); pg = __shfl(pg, fr);
            if (fq == g) { float le[8];
_Pragma("unroll")
                for (int j = 0; j < 4; ++j) { le[j] = acc[ai][0][m][0][j] * rinv; le[4 + j] = acc[ai][0][m][1][j] * rinv; }
                int i1 = 0; float m1 = le[0];
_Pragma("unroll")
                for (int j = 1; j < 8; ++j) if (le[j] > m1) { m1 = le[j]; i1 = j; }
                int i2 = 0; float m2 = -3.0e38f;
_Pragma("unroll")
                for (int j = 0; j < 8; ++j) if (j != i1 && le[j] > m2) { m2 = le[j]; i2 = j; }
                const float e2 = __expf(m2 - m1), w1 = 1.f / (1.f + e2), w2 = e2 * w1;
                gate[2 * (size_t)row] = pg * w1; gate[2 * (size_t)row + 1] = pg * w2;
                const int ea = g * 8 + i1, eb = g * 8 + i2;
                const unsigned pa = __hip_atomic_fetch_add(cnt + ea, 1u, __ATOMIC_RELAXED, __HIP_MEMORY_SCOPE_AGENT); list[(size_t)ea * NTOK + pa] = 2 * row;
                const unsigned pb = __hip_atomic_fetch_add(cnt + eb, 1u, __ATOMIC_RELAXED, __HIP_MEMORY_SCOPE_AGENT); list[(size_t)eb * NTOK + pb] = 2 * row + 1; } })
    }
};
struct EpiPP {
    static constexpr bool HAS_MID = false;
    unsigned char* ws;
    __device__ __forceinline__ void pre(const Unit&, LAS f32x2*, int) const {}
    __device__ __forceinline__ void mid(AccT&, const Unit&, int, int, int, int, const LAS f32x2*) const {}
    __device__ __forceinline__ void operator()(const AccT& acc, const Unit& u, int wr, int wc, int fr, int fq, const LAS f32x2* tab) const {
        asm volatile("" : "+v"(fr), "+v"(fq));
        bf16_t* pp = (bf16_t*)(ws + WS_PP); float* sspp = (float*)(ws + WS_SSPP);
        EPI_ROWS({ float s = 0.f;
_Pragma("unroll")
            for (int bj = 0; bj < 2; ++bj) { const f32x4 v0 = acc[ai][bj][m][0], v1 = acc[ai][bj][m][1]; s += sum4sq(v0) + sum4sq(v1);
                *(u32x4*)(pp + (size_t)row * 1024 + u.pn * 256 + bj * 128 + wc * 32 + fq * 8) = pack8(v0, v1); }
            s = red_fq(s); if (fq == 0) sspp[(size_t)row * 16 + u.pn * 4 + wc] = s; })
    }
};
struct EpiMoeUp {
    static constexpr bool HAS_MID = false;
    unsigned char* ws; const LAS unsigned* cntv; int npn;
    __device__ __forceinline__ void pre(const Unit& u, LAS f32x2* tab, int tid) const { if (tid < 256) { const int li = u.blk * 256 + tid; float rinv = 0.f;
        if (li < (int)cntv[u.e]) { const int tok = ((const int*)(ws + WS_LIST))[(size_t)u.e * NTOK + li] >> 1; rinv = rsqrtf(sum16((const float*)(ws + WS_SSX1) + (size_t)tok * 16) * (1.f / 1024.f) + EPS); }
        tab[tid] = (f32x2){rinv, 0.f}; } }
    __device__ __forceinline__ void mid(AccT&, const Unit&, int, int, int, int, const LAS f32x2*) const {}
    __device__ __forceinline__ void operator()(const AccT& acc, const Unit& u, int wr, int wc, int fr, int fq, const LAS f32x2* tab) const {
        asm volatile("" : "+v"(fr), "+v"(fq));
        const int pnl = u.pn - u.e * npn;
        bf16_t* hid = (bf16_t*)(ws + WS_HID);
        EPI_ROWS({ const float rinv = tab[rl].x;
            f32x4 h[2];
_Pragma("unroll")
            for (int n = 0; n < 2; ++n) { const f32x4 gg = acc[ai][0][m][n] * rinv, uu = acc[ai][1][m][n] * rinv;
_Pragma("unroll")
                for (int i = 0; i < 4; ++i) h[n][i] = gg[i] * __builtin_amdgcn_rcpf(1.f + __expf(-gg[i])) * uu[i]; }
            *(u32x4*)(hid + (size_t)row * 256 + pnl * 128 + wc * 32 + fq * 8) = pack8(h[0], h[1]); })
    }
};
struct EpiMoeDown {
    static constexpr bool HAS_MID = false;
    unsigned char* ws; const LAS unsigned* cntv; int npn;
    __device__ __forceinline__ void pre(const Unit& u, LAS f32x2* tab, int tid) const { if (tid < 256) { const int li = u.blk * 256 + tid; int aid = -1; float gt = 0.f;
        if (li < (int)cntv[u.e]) { aid = ((const int*)(ws + WS_LIST))[(size_t)u.e * NTOK + li]; gt = ((const float*)(ws + WS_GATE))[aid]; }
        tab[tid] = (f32x2){gt, __int_as_float(aid)}; } }
    __device__ __forceinline__ void mid(AccT&, const Unit&, int, int, int, int, const LAS f32x2*) const {}
    __device__ __forceinline__ void operator()(const AccT& acc, const Unit& u, int wr, int wc, int fr, int fq, const LAS f32x2* tab) const {
        asm volatile("" : "+v"(fr), "+v"(fq));
        const int pnl = u.pn - u.e * npn;
        bf16_t* c1 = (bf16_t*)(ws + WS_C1); bf16_t* xb = (bf16_t*)(ws + WS_XBB);
        EPI_ROWS({ const f32x2 tt = tab[rl]; const int aid = __float_as_int(tt.y);
            if (aid >= 0) { const int tok = aid >> 1; const float gt = tt.x;
_Pragma("unroll")
                for (int bj = 0; bj < 2; ++bj) { const size_t off = (size_t)tok * 1024 + pnl * 256 + bj * 128 + wc * 32 + fq * 8; const f32x4 v0 = acc[ai][bj][m][0] * gt, v1 = acc[ai][bj][m][1] * gt;
                    if (aid & 1) *(u32x4*)(c1 + off) = pack8(v0, v1);
                    else { const u32x4 w = *(const u32x4*)(xb + off); *(u32x4*)(xb + off) = pack8((f32x4){bflo(w.x), bfhi(w.x), bflo(w.y), bfhi(w.y)} + v0, (f32x4){bflo(w.z), bfhi(w.z), bflo(w.w), bfhi(w.w)} + v1); } } } })
    }
};
struct EpiPle {
    static constexpr bool HAS_MID = false;
    unsigned char* ws; const float* gpo; float* xout;
    __device__ __forceinline__ void pre(const Unit& u, LAS f32x2* tab, int tid) const { if (tid < 256) { const size_t r = (size_t)(u.pm * 256 + tid);
        tab[tid] = (f32x2){rsqrtf(((const float*)(ws + WS_SSX2))[r] * (1.f / 1024.f) + EPS), rsqrtf(sum16((const float*)(ws + WS_SSPP) + r * 16) * (1.f / 1024.f) + EPS)}; } }
    __device__ __forceinline__ void mid(AccT&, const Unit&, int, int, int, int, const LAS f32x2*) const {}
    __device__ __forceinline__ void operator()(const AccT& acc, const Unit& u, int wr, int wc, int fr, int fq, const LAS f32x2* tab) const {
        asm volatile("" : "+v"(fr), "+v"(fq));
        const bf16_t* pp = (const bf16_t*)(ws + WS_PP); bf16_t* xbn = (bf16_t*)(ws + WS_XBA); const bf16_t* xb = (const bf16_t*)(ws + WS_XBB); float* ssx0 = (float*)(ws + WS_SSX0);
        f32x4 g4[2][2];
_Pragma("unroll")
        for (int bj = 0; bj < 2; ++bj)
_Pragma("unroll")
            for (int n = 0; n < 2; ++n) g4[bj][n] = *(const f32x4*)(gpo + u.pn * 256 + bj * 128 + wc * 32 + fq * 8 + n * 4);
        EPI_ROWS({ const f32x2 tt = tab[rl]; const float r2 = tt.x, rp = tt.y; float s = 0.f;
_Pragma("unroll")
            for (int bj = 0; bj < 2; ++bj) { const size_t off = (size_t)row * 1024 + u.pn * 256 + bj * 128 + wc * 32 + fq * 8;
                const u32x4 pw = *(const u32x4*)(pp + off); const f32x4 p0 = (f32x4){bflo(pw.x), bfhi(pw.x), bflo(pw.y), bfhi(pw.y)} * rp * g4[bj][0], p1 = (f32x4){bflo(pw.z), bfhi(pw.z), bflo(pw.w), bfhi(pw.w)} * rp * g4[bj][1];
                const u32x4 xw = *(const u32x4*)(xb + off); f32x4 v0 = (f32x4){bflo(xw.x), bfhi(xw.x), bflo(xw.y), bfhi(xw.y)}, v1 = (f32x4){bflo(xw.z), bfhi(xw.z), bflo(xw.w), bfhi(xw.w)};
_Pragma("unroll")
                for (int i = 0; i < 4; ++i) { v0[i] += p0[i] * __builtin_amdgcn_rcpf(1.f + __expf(-acc[ai][bj][m][0][i] * r2)); v1[i] += p1[i] * __builtin_amdgcn_rcpf(1.f + __expf(-acc[ai][bj][m][1][i] * r2)); }
                s += sum4sq(v0) + sum4sq(v1);
#ifdef DIAG_SEL
                if (xout) { const float dsc_ = 1.f + sqrtf(((const float*)(ws + WS_CTL))[250000 + DIAG_SEL] * DIAG_SCALE); v0 *= dsc_; v1 *= dsc_; }
#endif
                if (xout) { *(f32x4*)(xout + off) = v0; *(f32x4*)(xout + off + 4) = v1; } else *(u32x4*)(xbn + off) = pack8(v0, v1); }
            s = red_fq(s); if (fq == 0 && !xout) ssx0[(size_t)row * 16 + u.pn * 4 + wc] = s; })
    }
};

struct EpiNull {
    static constexpr bool HAS_MID = false;
    float* sink;
    __device__ __forceinline__ void pre(const Unit&, LAS f32x2*, int) const {}
    __device__ __forceinline__ void mid(AccT&, const Unit&, int, int, int, int, const LAS f32x2*) const {}
    __device__ __forceinline__ void operator()(const AccT& acc, const Unit& u, int wr, int wc, int fr, int fq, const LAS f32x2* tab) const {
        f32x4 s = (f32x4){0.f, 0.f, 0.f, 0.f};
        EPI_ROWS({ s += (acc[ai][0][m][0] + acc[ai][0][m][1]) + (acc[ai][1][m][0] + acc[ai][1][m][1]); })
        if (s[0] + s[1] + s[2] + s[3] == 1.2345678e33f) sink[0] = s[0];
    }
};

namespace att {
constexpr int NS = 5, VSLOT = 8192;
template <bool FOX> struct Lay { static constexpr int KSLOT = FOX ? 8192 : 12288, L_K = 0, L_V = NS * KSLOT, L_WS = L_V + NS * VSLOT, L_G = L_WS + 2048, L_END = L_G + (FOX ? 32768 : 0), L_OST = 0; };
static_assert(Lay<true>::L_END <= 131072 && Lay<false>::L_END <= 131072 && NS * 8192 >= 32768, "attention LDS map");
constexpr float SKIP_NATS = 40.f;
typedef LAS const char* lds_cptr;
typedef short v4i16_t __attribute__((ext_vector_type(4)));

__device__ __forceinline__ void glds16(const void* gsrc, unsigned lds_dst) { unsigned keep;
    asm volatile("s_mov_b32 %0, m0\n\ts_mov_b32 m0, %2\n\ts_nop 0\n\tglobal_load_lds_dwordx4 %1, off\n\ts_mov_b32 m0, %0" : "=&s"(keep) : "v"(gsrc), "s"(lds_dst) : "memory"); }
__device__ __forceinline__ int crow(int r, int hi) { return (r & 3) + 8 * (r >> 2) + 4 * hi; }
__device__ __forceinline__ s16x4 vtr(lds_cptr p) { return __builtin_bit_cast(s16x4, __builtin_amdgcn_ds_read_tr16_b64_v4i16((LAS v4i16_t*)p)); }
__device__ __forceinline__ float swapmax(float m) { auto rr = __builtin_amdgcn_permlane32_swap(__float_as_uint(m), __float_as_uint(m), false, false); return fmaxf(__uint_as_float(rr[0]), __uint_as_float(rr[1])); }
__device__ __forceinline__ float swapsum(float m) { auto rr = __builtin_amdgcn_permlane32_swap(__float_as_uint(m), __float_as_uint(m), false, false); return __uint_as_float(rr[0]) + __uint_as_float(rr[1]); }
__device__ __forceinline__ bf16x8 pk8(const f32x16& p, int b) { u32x4 w; w.x = cvt_pk_bf16(p[b], p[b + 1]); w.y = cvt_pk_bf16(p[b + 2], p[b + 3]); w.z = cvt_pk_bf16(p[b + 4], p[b + 5]); w.w = cvt_pk_bf16(p[b + 6], p[b + 7]); return __builtin_bit_cast(bf16x8, w); }

struct Args {
    const bf16_t *Qraw, *Kmla, *Vmla, *Fq, *Fk, *Fv; const float *ssq_qn, *ssq_qr, *gmq, *cosT, *sinT, *F, *gfq, *gfk; bf16_t* o; float* sso;
};

#ifdef DIAG_SEL
#define STAMP(k) do { if (dg) { const unsigned long long t_ = __builtin_amdgcn_s_memrealtime(); dg[k] += (float)(t_ - tprev_) * 0.01f; tprev_ = t_; } } while (0)
#else
#define STAMP(k) do {} while (0)
#endif
template <bool FOX>
__device__ __forceinline__ void attn_unit(const Args& A, int b, int h, int qb, LAS char* shm, LAS float* dg) {
#ifdef DIAG_SEL
    unsigned long long tprev_ = __builtin_amdgcn_s_memrealtime();
#endif
    constexpr int DK = FOX ? 64 : 96, NQ = DK / 16, KP = FOX ? 512 : 768;
    constexpr int KSLOT = Lay<FOX>::KSLOT, L_K = Lay<FOX>::L_K, L_V = Lay<FOX>::L_V, L_WS = Lay<FOX>::L_WS, L_G = Lay<FOX>::L_G, L_OST = Lay<FOX>::L_OST;
    int tid_ = threadIdx.x; asm volatile("" : "+v"(tid_));
    const int tid = tid_, lane = tid & 63, r32 = lane & 31, hi = lane >> 5; const int wid = __builtin_amdgcn_readfirstlane(tid >> 6);
    const long rowbase = (long)b * SEQ; const int q0 = qb * 256, qw = q0 + wid * 32;
    const unsigned lds0 = (unsigned)(uintptr_t)shm;
    LAS float* wsf = (LAS float*)(shm + L_WS) + wid * 64;
    LAS float* Gl = (LAS float*)(shm + L_G);
    const int NT = (q0 + 256) / 64; const int tw_last = qw >> 6;
    int t0 = 0;
    if constexpr (FOX) {
        float gq = fmaxf(fabsf(A.gfq[lane]), 0.f), gk = fabsf(A.gfk[lane]);
#pragma unroll
        for (int o = 32; o > 0; o >>= 1) { gq = fmaxf(gq, __shfl_xor(gq, o)); gk = fmaxf(gk, __shfl_xor(gk, o)); }
        const float margin = 2.f * (8.f * gq * gk) + SKIP_NATS;
        const float Fref = A.F[(rowbase + q0) * 8 + h];
        const int nfull = q0 / 64;
        bool keep0 = true, keep1 = true;
        if (lane < nfull) keep0 = (Fref - A.F[(rowbase + 64 * lane + 63) * 8 + h]) >= -margin;
        if (lane + 64 < nfull) keep1 = (Fref - A.F[(rowbase + 64 * (lane + 64) + 63) * 8 + h]) >= -margin;
        const unsigned long long k0 = __ballot(keep0), k1 = __ballot(keep1);
        t0 = k0 ? __builtin_ctzll(k0) : 64 + (k1 ? __builtin_ctzll(k1) : 0);
        t0 = __builtin_amdgcn_readfirstlane(t0);
        const int nk = q0 + 256 - 64 * t0;
        for (int j = tid; j < nk; j += 512) Gl[j] = (Fref - A.F[(rowbase + 64 * t0 + j) * 8 + h]) * LOG2E;
    }
    const bf16_t* Kg = (FOX ? A.Fk : A.Kmla) + (long)(b * 8 + h) * 128 * (KSLOT / 2) + wid * 512 + lane * 8;
    const bf16_t* Vg = (FOX ? A.Fv : A.Vmla) + (long)(b * 8 + h) * 128 * 4096 + wid * 512 + lane * 8;
    const unsigned kdst = lds0 + L_K + wid * 1024, vdst = lds0 + L_V + wid * 1024;
    const bool k2 = (!FOX) && wid < 4;
#define ISSUE_K(t, sl) do { glds16(Kg + (long)(t) * (KSLOT / 2), (unsigned)__builtin_amdgcn_readfirstlane(kdst + (sl) * KSLOT)); \
        if (k2) glds16(Kg + (long)(t) * (KSLOT / 2) + 4096, (unsigned)__builtin_amdgcn_readfirstlane(kdst + (sl) * KSLOT + 8192)); } while (0)
#define ISSUE_V(t, sl) glds16(Vg + (long)(t) * 4096, (unsigned)__builtin_amdgcn_readfirstlane(vdst + (sl) * VSLOT))
    const int nti = NT - t0;
    ISSUE_K(t0, 0); ISSUE_K(t0 + 1, 1); ISSUE_V(t0, 0); ISSUE_K(t0 + 2, 2); ISSUE_V(t0 + 1, 1); ISSUE_K(t0 + 3, 3); ISSUE_V(t0 + 2, 2);
    bf16x8 qr[NQ];
    {
        const long row = rowbase + qw + r32;
        if constexpr (FOX) {
#pragma unroll
            for (int d0 = 0; d0 < NQ; ++d0) qr[d0] = *(const bf16x8*)(A.Fq + row * 512 + h * 64 + d0 * 16 + hi * 8);
        } else {
            const float ss = A.ssq_qn[row * 8 + h] + A.ssq_qr[row * 8 + h]; const float sc = rsqrtf(ss * (1.f / 96.f) + EPS) * C2_MLA;
            f32x4 qa[NQ][2];
#pragma unroll
            for (int d0 = 0; d0 < NQ; ++d0) { const u32x4 w = *(const u32x4*)(A.Qraw + row * 768 + h * 96 + d0 * 16 + hi * 8);
                const f32x4 g0 = *(const f32x4*)(A.gmq + d0 * 16 + hi * 8), g1 = *(const f32x4*)(A.gmq + d0 * 16 + hi * 8 + 4);
                qa[d0][0] = (f32x4){bflo(w.x), bfhi(w.x), bflo(w.y), bfhi(w.y)} * sc * g0; qa[d0][1] = (f32x4){bflo(w.z), bfhi(w.z), bflo(w.w), bfhi(w.w)} * sc * g1; }
#pragma unroll
            for (int e = 0; e < 2; ++e) { const f32x4 c = *(const f32x4*)(A.cosT + row * 16 + hi * 8 + e * 4), s = *(const f32x4*)(A.sinT + row * 16 + hi * 8 + e * 4);
                const f32x4 x1 = qa[4][e], x2 = qa[5][e]; qa[4][e] = x1 * c - x2 * s; qa[5][e] = x2 * c + x1 * s; }
#pragma unroll
            for (int d0 = 0; d0 < NQ; ++d0) qr[d0] = __builtin_bit_cast(bf16x8, pack8(qa[d0][0], qa[d0][1]));
        }
    }
    float mrun = -INFINITY, lrun = 0.f; f32x16 o[2]; o[0] = f32x16{}; o[1] = f32x16{};
    const lds_cptr shm3 = (lds_cptr)shm;
    const lds_cptr kp0 = shm3 + L_K + hi * 1024 + r32 * 16;
    const lds_cptr vp0 = shm3 + L_V + ((lane >> 4) & 1) * 32 + (lane & 3) * 8 + (4 * hi + ((lane & 15) >> 2)) * 64;
    bf16x8 pa0, pa1, pa2, pa3; f32x16 p0, p1; bf16x8 kf[2 * NQ]; s16x4 vlo[8], vhi[8];
    const int grp = wid >> 2;
    const int nK = k2 ? 2 : 1;
#define WV_(k) case k: asm volatile("s_waitcnt vmcnt(" #k ")" ::: "memory"); break;
#define WAITV(n) do { switch (n) { WV_(0) WV_(1) WV_(2) WV_(3) WV_(4) WV_(5) WV_(6) WV_(7) WV_(8) default: asm volatile("s_waitcnt vmcnt(9)" ::: "memory"); break; } } while (0)
#define ALLOW2(j) (((j) + 2 < nti ? nK : 0) + ((j) + 1 < nti ? 1 : 0) + ((j) + 3 < nti ? nK : 0) + ((j) + 2 < nti ? 1 : 0))
#define ALLOW(j) (((j) + 2 < nti ? nK : 0) + ((j) + 1 < nti ? 1 : 0) + ((j) + 3 < nti ? nK : 0) + ((j) + 2 < nti ? 1 : 0) + ((j) + 4 < nti ? nK : 0) + ((j) + 3 < nti ? 1 : 0))
#define LBAR() asm volatile("s_waitcnt lgkmcnt(0)\n\ts_barrier" ::: "memory")
#define KREAD(rel) { const lds_cptr kp = kp0 + ((rel) % NS) * KSLOT; \
        _Pragma("unroll") for (int d0 = 0; d0 < NQ; ++d0) { kf[2 * d0] = *(const LAS bf16x8*)(kp + d0 * 2048); kf[2 * d0 + 1] = *(const LAS bf16x8*)(kp + d0 * 2048 + 512); } }
#define VREAD(rel) { const lds_cptr vp = vp0 + ((rel) % NS) * VSLOT; \
        _Pragma("unroll") for (int i = 0; i < 8; ++i) { vlo[i] = vtr(vp + (i >> 2) * 4096 + (i & 3) * 1024); vhi[i] = vtr(vp + (i >> 2) * 4096 + (i & 3) * 1024 + 512); } }
#define SFENCE() __builtin_amdgcn_sched_barrier(0)
#define QKMM(rel) do { const float cb = (t0 + (rel) > tw_last) ? -INFINITY : 0.f; \
        _Pragma("unroll") for (int r = 0; r < 16; ++r) { p0[r] = cb; p1[r] = cb; } \
        _Pragma("unroll") for (int d0 = 0; d0 < NQ; ++d0) { p0 = __builtin_amdgcn_mfma_f32_32x32x16_bf16(kf[2 * d0], qr[d0], p0, 0, 0, 0); p1 = __builtin_amdgcn_mfma_f32_32x32x16_bf16(kf[2 * d0 + 1], qr[d0], p1, 0, 0, 0); } } while (0)
#define PVMM() do { \
        o[0] = __builtin_amdgcn_mfma_f32_32x32x16_bf16(pa0, PKV(0), o[0], 0, 0, 0); o[1] = __builtin_amdgcn_mfma_f32_32x32x16_bf16(pa0, PKV(4), o[1], 0, 0, 0); \
        o[0] = __builtin_amdgcn_mfma_f32_32x32x16_bf16(pa1, PKV(1), o[0], 0, 0, 0); o[1] = __builtin_amdgcn_mfma_f32_32x32x16_bf16(pa1, PKV(5), o[1], 0, 0, 0); \
        o[0] = __builtin_amdgcn_mfma_f32_32x32x16_bf16(pa2, PKV(2), o[0], 0, 0, 0); o[1] = __builtin_amdgcn_mfma_f32_32x32x16_bf16(pa2, PKV(6), o[1], 0, 0, 0); \
        o[0] = __builtin_amdgcn_mfma_f32_32x32x16_bf16(pa3, PKV(3), o[0], 0, 0, 0); o[1] = __builtin_amdgcn_mfma_f32_32x32x16_bf16(pa3, PKV(7), o[1], 0, 0, 0); } while (0)
#define PKV(k) (bf16x8){vlo[k][0], vlo[k][1], vlo[k][2], vlo[k][3], vhi[k][0], vhi[k][1], vhi[k][2], vhi[k][3]}
#define MX3(a, b, c) __builtin_fmaxf(__builtin_fmaxf((a), (b)), (c))
#define SOFTMAX(rel) do { const int t = t0 + (rel); \
        if constexpr (FOX) { const LAS float* Gt = Gl + (rel) * 64 + 4 * hi; \
            _Pragma("unroll") for (int rq = 0; rq < 4; ++rq) { const f32x4 ga = *(const LAS f32x4*)(Gt + 8 * rq), gb = *(const LAS f32x4*)(Gt + 32 + 8 * rq); \
                _Pragma("unroll") for (int i = 0; i < 4; ++i) { p0[4 * rq + i] += ga[i]; p1[4 * rq + i] += gb[i]; } } \
            if (64 * t + 63 > qw) { const int qrel = qw + r32 - 64 * t; \
                _Pragma("unroll") for (int r = 0; r < 16; ++r) { const int kv = crow(r, hi); p0[r] = kv > qrel ? -INFINITY : p0[r]; p1[r] = kv + 32 > qrel ? -INFINITY : p1[r]; } } } \
        float ma = MX3(p0[0], p0[1], p1[0]), mb = MX3(p0[2], p0[3], p1[1]); ma = MX3(ma, p1[2], p1[3]); \
        _Pragma("unroll") for (int r = 4; r < 16; r += 4) { ma = MX3(ma, p0[r], p0[r + 1]); mb = MX3(mb, p0[r + 2], p0[r + 3]); ma = MX3(ma, p1[r], p1[r + 1]); mb = MX3(mb, p1[r + 2], p1[r + 3]); } \
        const float mnew = fmaxf(mrun, swapmax(fmaxf(ma, mb))); \
        if (__any(mnew > mrun)) { const float al = __builtin_amdgcn_exp2f(mrun - mnew); lrun *= al; if (hi == 0) wsf[r32] = al; \
            asm volatile("s_waitcnt lgkmcnt(0)" ::: "memory"); \
            _Pragma("unroll") for (int rq = 0; rq < 4; ++rq) { const f32x4 af = *(const LAS f32x4*)(wsf + 8 * rq + 4 * hi); \
                _Pragma("unroll") for (int i = 0; i < 4; ++i) { o[0][4 * rq + i] *= af[i]; o[1][4 * rq + i] *= af[i]; } } \
            mrun = mnew; } \
        float sa = 0.f, sb = 0.f; \
        _Pragma("unroll") for (int r = 0; r < 16; ++r) { p0[r] = __builtin_amdgcn_exp2f(p0[r] - mrun); p1[r] = __builtin_amdgcn_exp2f(p1[r] - mrun); sa += p0[r]; sb += p1[r]; } \
        lrun += sa + sb; \
        pa0 = pk8(p0, 0); pa1 = pk8(p0, 8); pa2 = pk8(p1, 0); pa3 = pk8(p1, 8); } while (0)
    STAMP(0);
    WAITV(2 * nK + 2);
    STAMP(1);
    if (grp == 1) LBAR();
    LBAR();
    { KREAD(0); SFENCE(); QKMM(0); SFENCE(); }
    if (4 < nti) ISSUE_K(t0 + 4, 4);
    ISSUE_V(t0 + 3, 3);
    LBAR();
    { VREAD(0); KREAD(1); SFENCE(); }
    SOFTMAX(0);
    WAITV(ALLOW2(1));
    LBAR();
#pragma unroll 1
    for (int j = 1; j < nti; ++j) {
        PVMM(); QKMM(j); SFENCE();
        if (j + 4 < nti) ISSUE_K(t0 + j + 4, (j + 4) % NS);
        if (j + 3 < nti) ISSUE_V(t0 + j + 3, (j + 3) % NS);
        STAMP(5);
        LBAR();
        STAMP(6);
        { VREAD(j); KREAD(j + 1); SFENCE(); }
        SOFTMAX(j);
        WAITV(ALLOW2(j + 1));
        STAMP(7);
        LBAR();
        STAMP(14);
    }
    PVMM();
    LBAR();
    LBAR();
    if (grp == 0) LBAR();
    STAMP(2);
#undef ISSUE_K
#undef ISSUE_V
#undef WAITV
#undef WV_
#undef ALLOW
#undef ALLOW2
#undef LBAR
#undef KREAD
#undef VREAD
#undef SFENCE
#undef QKMM
#undef PVMM
#undef PKV
#undef MX3
#undef SOFTMAX
    lrun = swapsum(lrun);
    if (hi == 0) wsf[32 + r32] = lrun;
    asm volatile("s_waitcnt lgkmcnt(0)" ::: "memory");
    float rli[16];
#pragma unroll
    for (int rq = 0; rq < 4; ++rq) { const f32x4 lf = *(const LAS f32x4*)(wsf + 32 + 8 * rq + 4 * hi);
#pragma unroll
        for (int i = 0; i < 4; ++i) rli[4 * rq + i] = __builtin_amdgcn_rcpf(lf[i]); }
    const int hh = FOX ? 8 + h : h;
    bf16_t* Ow = A.o + (rowbase + qw) * 1024 + hh * 64;
    LAS bf16_t* stg = (LAS bf16_t*)(shm + L_OST) + wid * 2048;
#pragma unroll
    for (int r = 0; r < 16; ++r) { const int orow = crow(r, hi);
#pragma unroll
        for (int d0 = 0; d0 < 2; ++d0) { const float v = o[d0][r] * rli[r]; stg[orow * 64 + d0 * 32 + r32] = (bf16_t)(cvt_pk_bf16(v, 0.f) & 0xffffu); } }
    asm volatile("s_waitcnt lgkmcnt(0)" ::: "memory");
#pragma unroll
    for (int i = 0; i < 4; ++i) { const int row = i * 8 + (lane >> 3), ch = lane & 7; const u32x4 v = *(const LAS u32x4*)(stg + row * 64 + ch * 8);
        *(u32x4*)(Ow + (long)row * 1024 + ch * 8) = v;
        float s = 0.f; { const float a0 = bflo(v.x), a1 = bfhi(v.x), a2 = bflo(v.y), a3 = bfhi(v.y), a4 = bflo(v.z), a5 = bfhi(v.z), a6 = bflo(v.w), a7 = bfhi(v.w);
            s = ((a0 * a0 + a1 * a1) + (a2 * a2 + a3 * a3)) + ((a4 * a4 + a5 * a5) + (a6 * a6 + a7 * a7)); }
        s += __shfl_xor(s, 1); s += __shfl_xor(s, 2); s += __shfl_xor(s, 4);
        if (ch == 0) A.sso[(rowbase + qw + row) * 16 + hh] = s; }
    asm volatile("s_waitcnt lgkmcnt(0)\n\ts_barrier" ::: "memory");
    STAMP(3);
#ifdef DIAG_SEL
    if (dg) dg[4] += (float)NT - (float)t0;
#endif
}

__device__ __forceinline__ void attn_phase(const Args& A, int vcu, int G, LAS char* shm, int repm, int repf, LAS float* dg) {
    for (int v = vcu; v < 256; v += G) {
        const int bh = v >> 3, s = v & 7;
#pragma unroll 1
        for (int i = 0; i < 4 * repm; ++i) { const int ii = i & 3; const int qb = (ii == 0) ? s : (ii == 1) ? 15 - s : (ii == 2) ? 16 + s : 31 - s; attn_unit<false>(A, bh >> 3, bh & 7, qb, shm, dg); }
#pragma unroll 1
        for (int i = 0; i < 4 * repf; ++i) { const int ii = i & 3; const int qb = (ii == 0) ? 31 - s : (ii == 1) ? 16 + s : (ii == 2) ? 15 - s : s; attn_unit<true>(A, bh >> 3, bh & 7, qb, shm, dg ? dg + 8 : dg); }
    }
}
}

constexpr int CW_TMO = 0, CW_BAR = 4096, CW_CNT = 200000;
constexpr int RING_BYTES = 131072, LDSCTL_OFF = RING_BYTES, LDS_BYTES = 147456;
constexpr int LC_MISC = 0, LC_PRE = 256, LC_CNT = 512;

typedef GAS unsigned gu32;
#define RLX_AGENT __ATOMIC_RELAXED, __HIP_MEMORY_SCOPE_AGENT

#define XB_TMO      128
#define XB_XCNT(j)  (256  + 64 * (j))
#define XB_XSUB(j)  (1280 + 64 * (j))
#define XB_XGEN(j)  (2304 + 64 * (j))
#define XB_TOP      3328
#define XB_TOPGEN   3392
#define XCD_BAR_WORDS 3456
#define XB_SPIN_CAP (1u << 18)
__device__ __forceinline__ unsigned xb_ld(unsigned* p)              { return __hip_atomic_load(p, __ATOMIC_RELAXED, __HIP_MEMORY_SCOPE_AGENT); }
__device__ __forceinline__ unsigned xb_add(unsigned* p, unsigned v) { return __hip_atomic_fetch_add(p, v, __ATOMIC_RELAXED, __HIP_MEMORY_SCOPE_AGENT); }
__device__ __forceinline__ unsigned xb_xcc_id() { return (unsigned)__builtin_amdgcn_s_getreg((3 << 11) | 20) & 0xFu; }
#define XB_SPIN(cond, bar) do { unsigned _sp = 0; while (cond) { __builtin_amdgcn_s_sleep(1); \
    if ((++_sp & 255u) == 0u) { if (xb_ld(&(bar)[XB_TMO])) break; if (_sp > XB_SPIN_CAP) { atomicAdd(&(bar)[XB_TMO], 1u); break; } } } } while (0)
struct XcdBarrier { unsigned* bar; unsigned x; volatile LAS unsigned* st; };
__device__ __forceinline__ XcdBarrier xcd_barrier_post(unsigned* bar, volatile LAS unsigned* st) {
    XcdBarrier b; b.bar = bar; b.x = xb_xcc_id(); b.st = st;
    if (threadIdx.x == 0) (void)xb_add(&bar[XB_XCNT(b.x)], 1u);
    return b;
}
__device__ __forceinline__ void xcd_barrier_complete(unsigned* bar, unsigned x, unsigned& nloc, unsigned& nx) {
    const unsigned G = gridDim.x * gridDim.y * gridDim.z;
    unsigned sum, cnt, mine, sp = 0u;
    for (;;) {
        sum = 0u; cnt = 0u; mine = 0u;
#pragma unroll
        for (unsigned j = 0; j < 16; ++j) { const unsigned c = xb_ld(&bar[XB_XCNT(j)]); sum += c; cnt += (c > 0u) ? 1u : 0u; mine = (j == x) ? c : mine; }
        if (sum == G) break;
        __builtin_amdgcn_s_sleep(1);
        if ((++sp & 255u) == 0u) { if (xb_ld(&bar[XB_TMO])) break; if (sp > XB_SPIN_CAP) { atomicAdd(&bar[XB_TMO], 1u); break; } }
    }
    nloc = mine > 0u ? mine : 1u; nx = cnt > 0u ? cnt : 1u;
}
__device__ __forceinline__ void xcd_barrier(const XcdBarrier& b) {
    asm volatile("s_waitcnt vmcnt(0)" ::: "memory");
    __syncthreads();
    if (threadIdx.x == 0) {
        unsigned* bar = b.bar;
        __builtin_amdgcn_s_waitcnt(0);
        unsigned nloc = b.st[0], nx = b.st[1];
        if (nloc == 0u) { xcd_barrier_complete(bar, b.x, nloc, nx); b.st[0] = nloc; b.st[1] = nx; }
        const unsigned old = xb_add(&bar[XB_XSUB(b.x)], 1u);
        const unsigned gen = old / nloc;
        if (old + 1u == (gen + 1u) * nloc) {
            __builtin_amdgcn_fence(__ATOMIC_RELEASE, "agent");
            asm volatile("s_waitcnt vmcnt(0)" ::: "memory");
            const unsigned og = xb_add(&bar[XB_TOP], 1u);
            const unsigned tg = og / nx;
            if (og + 1u == (tg + 1u) * nx) xb_add(&bar[XB_TOPGEN], 1u);
            else XB_SPIN(xb_ld(&bar[XB_TOPGEN]) == tg, bar);
            __builtin_amdgcn_fence(__ATOMIC_ACQUIRE, "agent");
            xb_add(&bar[XB_XGEN(b.x)], 1u);
            asm volatile("s_waitcnt vmcnt(0)" ::: "memory");
        } else {
            XB_SPIN(xb_ld(&bar[XB_XGEN(b.x)]) == gen, bar);
            __builtin_amdgcn_fence(__ATOMIC_ACQUIRE, "agent");
            asm volatile("s_waitcnt vmcnt(0)" ::: "memory");
        }
    }
    __syncthreads();
}

__device__ __forceinline__ float wave_sum(float v) {
#pragma unroll
    for (int o = 1; o < 64; o <<= 1) v += __shfl_xor(v, o);
    return v;
}
#define LDS_WAIT() asm volatile("s_waitcnt lgkmcnt(0)" ::: "memory")

__device__ __forceinline__ int maprow(int kind, int n) {
    switch (kind) {
    default: return n;
    case 1: {
        if (n < 256) return n;
        if (n < 384) { const int j = n - 256, q = j >> 5, c = j & 31; return 256 + (q & 1) * 128 + (q >> 1) * 32 + c; }
        if (n < 416) return 256 + 64 + (n - 384);
        if (n < 1952) { const int f = n - 416, k3 = f >> 9, r = f & 511, hd = r >> 6, d = r & 63; return (2 + 2 * k3 + (hd >> 2)) * 256 + (d >> 5) * 128 + (hd & 3) * 32 + (d & 31); }
        return 256 + 96 + (n - 1952); }
    case 2: { const int hd = n / 96, dd = n - hd * 96; if (dd < 64) return (hd >> 2) * 256 + (dd >> 5) * 128 + (hd & 3) * 32 + (dd & 31); return 512 + (hd >> 2) * 128 + (hd & 3) * 32 + (dd - 64); }
    case 3: { const int hd = n >> 7, dd = n & 127; if (dd < 64) return (hd >> 2) * 256 + (dd >> 5) * 128 + (hd & 3) * 32 + (dd & 31); const int d = dd - 64; return 512 + (hd >> 2) * 256 + (d >> 5) * 128 + (hd & 3) * 32 + (d & 31); }
    case 4: return (n >> 7) * 256 + (n & 127);
    case 5: return (n >> 7) * 256 + 128 + (n & 127);
    case 6: return 128 + n;
    }
}
__device__ __forceinline__ void conv_item(const float* W, int K, int Nsrc, bf16_t* WT, int kind, const float* s1, const float* s2, int split, LAS float* scr, int item, int lane) {
    const int nblk = (Nsrc + 31) / 32, kb = item / nblk, nb = item - kb * nblk, k0 = 64 * kb, n0 = 32 * nb;
    const bool nv = n0 + (lane & 31) < Nsrc;
#pragma unroll 8
    for (int i = 0; i < 32; ++i) { const int kk = 2 * i + (lane >> 5); scr[kk * 33 + (lane & 31)] = nv ? W[(size_t)(k0 + kk) * Nsrc + n0 + (lane & 31)] : 0.f; }
    LDS_WAIT(); asm volatile("" ::: "memory");
    const int c = lane & 7;
    float sc[8];
#pragma unroll
    for (int e = 0; e < 8; ++e) { const int k = k0 + 8 * c + e; sc[e] = s1 ? (k < split ? s1[k] : s2[k - split]) : 1.f; }
#pragma unroll
    for (int j = 0; j < 4; ++j) { const int n = (lane >> 3) + 8 * j; const LAS float* s = scr + (8 * c) * 33 + n;
        if (n0 + n < Nsrc) { u32x4 o; o.x = cvt_pk_bf16(s[0 * 33] * sc[0], s[1 * 33] * sc[1]); o.y = cvt_pk_bf16(s[2 * 33] * sc[2], s[3 * 33] * sc[3]); o.z = cvt_pk_bf16(s[4 * 33] * sc[4], s[5 * 33] * sc[5]); o.w = cvt_pk_bf16(s[6 * 33] * sc[6], s[7 * 33] * sc[7]);
            *(u32x4*)(WT + (size_t)maprow(kind, n0 + n) * K + k0 + 8 * c) = o; } }
    LDS_WAIT(); asm volatile("" ::: "memory");
}

struct KArgs { const void* in[27]; float* out; unsigned char* ws; int ph_lo, ph_hi, li, pad; };

constexpr int I_IN = 16 * 62, I_UQ = 4 * 24, I_UKV = 2 * 32, I_OUT = 16 * 32, I_RE = 16, I_RG = 16, I_GU = NEXP * 2 * 16 * 8, I_DN = NEXP * 4 * 32, I_PG = 16 * 32, I_PP = 4 * 32;
constexpr int I_LAYER = I_IN + I_UQ + I_UKV + I_OUT + I_RE + I_RG + I_GU + I_DN + I_PG + I_PP;

struct MoeOrder {
    const LAS int* pre; const LAS unsigned* cntl; const int* list; int npn, G, c; bool gather;
    __device__ __forceinline__ bool next(int i, Unit& u) const {
        const int L = i * G + c; const int TB = pre[32]; if (L >= TB * npn) return false;
        const int bg = L / npn, pl = L - bg * npn; int e = 0;
        for (int j = 1; j < 32; ++j) e += (pre[j] <= bg) ? 1 : 0;
        u.pm = bg; u.e = e; u.blk = bg - pre[e]; u.pn = e * npn + pl; return true;
    }
    __device__ __forceinline__ int arow(const Unit& u, int r) const {
        if (!gather) return u.pm * 256 + r;
        int li = u.blk * 256 + r; const int cn = (int)cntl[u.e]; li = li < cn ? li : cn - 1;
        return list[(size_t)u.e * NTOK + li] >> 1;
    }
};

#ifndef MK_CUTS
#define MK_CUTS {0, 19}
#endif
constexpr int NPHASE = 19;

__global__ void __launch_bounds__(NWAVES * 64, 2) mega_fwd(KArgs args) {
    extern __shared__ __attribute__((aligned(16))) unsigned char lds_raw[];
    LAS unsigned char* lds0 = (LAS unsigned char*)lds_raw;
    volatile LAS unsigned* MISC = (volatile LAS unsigned*)(lds0 + LDSCTL_OFF + LC_MISC);
    const int G = gridDim.x; const int bx = blockIdx.x; const int vcu = (G % 8 == 0) ? (bx % 8) * (G / 8) + bx / 8 : bx;
    for (int u = threadIdx.x; u < (LDS_BYTES - LDSCTL_OFF) / 4; u += NWAVES * 64) ((LAS unsigned*)(lds0 + LDSCTL_OFF))[u] = 0u;
    __syncthreads();
    (void)xcd_barrier_post((unsigned*)(args.ws + WS_CTL) + CW_BAR + args.li * XCD_BAR_WORDS, MISC + 8);
    const int lo = args.ph_lo, hi = args.ph_hi;
#ifndef PH_MASK
#define PH_MASK 0x3ff
#endif
#define PHM(k) ((PH_MASK >> (k)) & 1)
#ifndef DUP_MASK
#define DUP_MASK 0
#endif
#define NREP(k) (((DUP_MASK >> (k)) & 1) ? 2 : 1)
#ifndef NULL_MASK
#define NULL_MASK 0
#endif
#define NULLP(k) ((NULL_MASK >> (k)) & 1)
#define IN(k) (lo <= (k) && (k) < hi)
#define SEAM(k) do { if (IN(k) && IN((k) + 1)) { XcdBarrier bar_; bar_.bar = (unsigned*)(args.ws + WS_CTL) + CW_BAR + args.li * XCD_BAR_WORDS; bar_.x = xb_xcc_id(); bar_.st = (volatile LAS unsigned*)(lds0 + LDSCTL_OFF + LC_MISC) + 8; xcd_barrier(bar_); } } while (0)
    const int NGW = G * NWAVES, NGT = G * 512;
#define ssx0 ((float*)(wsp + WS_SSX0))
#define ssx1 ((float*)(wsp + WS_SSX1))
#define sspp ((float*)(wsp + WS_SSPP))
#define sso ((float*)(wsp + WS_SSO))
#define ssx2 ((float*)(wsp + WS_SSX2))
#define sskpe ((float*)(wsp + WS_SSKPE))
#define ssqq ((float*)(wsp + WS_SSQQ))
#define ssqkv ((float*)(wsp + WS_SSQKV))
#define gate ((float*)(wsp + WS_GATE))
#define logf ((float*)(wsp + WS_LOGF))
#define Fc ((float*)(wsp + WS_F))
#define ssqn ((float*)(wsp + WS_SSQN))
#define ssqr ((float*)(wsp + WS_SSQR))
#define cosT ((float*)(wsp + WS_COS))
#define sinT ((float*)(wsp + WS_SIN))
#define list ((int*)(wsp + WS_LIST))
#define xbA ((bf16_t*)(wsp + WS_XBA))
#define xbB ((bf16_t*)(wsp + WS_XBB))
#define pbf ((bf16_t*)(wsp + WS_PBF))
#define Qc ((bf16_t*)(wsp + WS_QC))
#define Kvc ((bf16_t*)(wsp + WS_KVC))
#define Kpe ((bf16_t*)(wsp + WS_KPE))
#define Fq ((bf16_t*)(wsp + WS_FQ))
#define Fk ((bf16_t*)(wsp + WS_FK))
#define Fv ((bf16_t*)(wsp + WS_FV))
#define Kmla ((bf16_t*)(wsp + WS_KMLA))
#define Vmla ((bf16_t*)(wsp + WS_VMLA))
#define Qraw ((bf16_t*)(wsp + WS_QRAW))
#define ob ((bf16_t*)xo)
#define ppb ((bf16_t*)(wsp + WS_PP))
#define hid ((bf16_t*)(wsp + WS_HID))
#define c1 ((bf16_t*)(wsp + WS_C1))
#define ctl ((unsigned*)(wsp + WS_CTL))
#define Wl (wsp + WS_W + (size_t)L * W_LAYER)
#define PHASE_PTRS unsigned char* wsp = args.ws; asm volatile("" : "+s"(wsp)); const float* x_in = (const float*)args.in[0]; float* xo = args.out; (void)x_in; (void)xo; \
    int tid = threadIdx.x; asm volatile("" : "+v"(tid)); const int lane = tid & 63, wave = __builtin_amdgcn_readfirstlane(tid >> 6); (void)lane; (void)wave; \
    unsigned ldo_ = 0u; asm volatile("" : "+s"(ldo_)); LAS unsigned char* lds = lds0 + ldo_; LAS int* preL = (LAS int*)(lds + LDSCTL_OFF + LC_PRE); LAS unsigned* cntL = (LAS unsigned*)(lds + LDSCTL_OFF + LC_CNT); (void)preL; (void)cntL; \
    const int gw = vcu * NWAVES + wave, gt = vcu * 512 + tid; (void)gw; (void)gt
#define INF(i) ((const float*)args.in[i])

    if (PHM(0) && IN(0)) {
        PHASE_PTRS; unsigned char* ws = wsp;
        LAS float* scr = (LAS float*)(lds + wave * 16384);
        for (int rep_ = 0; rep_ < NREP(0); ++rep_) {
        for (int it = gw; it < 2 * I_LAYER; it += NGW) {
            const int L = it >= I_LAYER ? 1 : 0; int r = it - L * I_LAYER;
            if (r < I_IN) { conv_item(INF(4) + (size_t)L * DM * INC, DM, INC, (bf16_t*)(Wl + WO_IN), 1, INF(3) + L * DM, nullptr, DM, scr, r, lane); continue; } r -= I_IN;
            if (r < I_UQ) { conv_item(INF(6) + (size_t)L * 256 * 768, 256, 768, (bf16_t*)(Wl + WO_UQ), 2, INF(5) + L * 256, nullptr, 256, scr, r, lane); continue; } r -= I_UQ;
            if (r < I_UKV) { conv_item(INF(8) + (size_t)L * 128 * 1024, 128, 1024, (bf16_t*)(Wl + WO_UKV), 3, INF(7) + L * 128, nullptr, 128, scr, r, lane); continue; } r -= I_UKV;
            if (r < I_OUT) { conv_item(INF(16) + (size_t)L * DM * DM, DM, DM, (bf16_t*)(Wl + WO_OUT), 0, INF(14) + L * 512, INF(15) + L * 512, 512, scr, r, lane); continue; } r -= I_OUT;
            if (r < I_RE) { conv_item(INF(19) + (size_t)L * DM * 32, DM, 32, (bf16_t*)(Wl + WO_RT), 0, INF(17) + L * DM, nullptr, DM, scr, r, lane); continue; } r -= I_RE;
            if (r < I_RG) { conv_item(INF(18) + (size_t)L * DM * 4, DM, 4, (bf16_t*)(Wl + WO_RT), 6, INF(17) + L * DM, nullptr, DM, scr, r, lane); continue; } r -= I_RG;
            if (r < I_GU) { const int e = r >> 8, mt = (r >> 7) & 1, ii = r & 127;
                conv_item(INF(mt ? 21 : 20) + ((size_t)L * NEXP + e) * DM * 256, DM, 256, (bf16_t*)(Wl + WO_GU) + (size_t)e * 512 * DM, mt ? 5 : 4, INF(17) + L * DM, nullptr, DM, scr, ii, lane); continue; } r -= I_GU;
            if (r < I_DN) { const int e = r >> 7, ii = r & 127;
                conv_item(INF(22) + ((size_t)L * NEXP + e) * 256 * DM, 256, DM, (bf16_t*)(Wl + WO_DN) + (size_t)e * DM * 256, 0, nullptr, nullptr, 0, scr, ii, lane); continue; } r -= I_DN;
            if (r < I_PG) { conv_item(INF(24) + (size_t)L * DM * DM, DM, DM, (bf16_t*)(Wl + WO_PG), 0, INF(23) + L * DM, nullptr, DM, scr, r, lane); continue; } r -= I_PG;
            conv_item(INF(25) + (size_t)L * 256 * DM, 256, DM, (bf16_t*)(Wl + WO_PP), 0, nullptr, nullptr, 0, scr, r, lane);
        }
        for (int it = gw; it < 2 * (88 + 220); it += NGW) {
            const int L = it >= 308 ? 1 : 0; int r = it - L * 308; bf16_t* dst;
            if (r < 88) { const int lr = r < 24 ? 104 + r : 192 + (r - 24); dst = (bf16_t*)(Wl + WO_IN) + (size_t)(256 + lr) * DM; }
            else { r -= 88; const int lr = r < 96 ? 32 + r : 132 + (r - 96); dst = (bf16_t*)(Wl + WO_RT) + (size_t)lr * DM; }
            *(u32x4*)(dst + lane * 8) = (u32x4){0u, 0u, 0u, 0u}; *(u32x4*)(dst + 512 + lane * 8) = (u32x4){0u, 0u, 0u, 0u};
        }
        for (int m = gw; m < NTOK; m += NGW) { const f32x4* xr = (const f32x4*)(x_in + (size_t)m * DM) + lane; float s = 0.f; u32x2* o8 = (u32x2*)(xbA + (size_t)m * DM) + lane;
#pragma unroll
            for (int j = 0; j < 4; ++j) { const f32x4 v = xr[64 * j]; s += sum4sq(v); u32x2 w; w.x = cvt_pk_bf16(v[0], v[1]); w.y = cvt_pk_bf16(v[2], v[3]); o8[64 * j] = w; }
            s = wave_sum(s); if (lane < 16) ssx0[(size_t)m * 16 + lane] = lane == 0 ? s : 0.f; }
        for (size_t i = gt; i < (size_t)DEPTH * NTOK * 256 / 8; i += NGT) { const f32x4 a = ((const f32x4*)INF(1))[2 * i], b = ((const f32x4*)INF(1))[2 * i + 1]; ((u32x4*)pbf)[i] = pack8(a, b); }
        for (int i = gt; i < NTOK * 16; i += NGT) { const int t = i >> 4, j = i & 15; const double inv = exp2(-(double)j * (13.287712379549449 / 16.0)); const double ang = (double)((const int*)args.in[2])[t] * inv;
            cosT[i] = (float)cos(ang); sinT[i] = (float)sin(ang); }
        }
    }
    SEAM(0);

#pragma unroll 1
    for (int L = 0; L < DEPTH; ++L) {
        const int pb = 1 + 9 * L;
        if (PHM(1) && IN(pb + 0)) {
            PHASE_PTRS;
            pg8::Gemm g{xbA, (const bf16_t*)(Wl + WO_IN), DM}; pg8::StaticOrder S; S.init(NTOK, 2048, G, bx);
            EpiInProj E{wsp, INF(13) + L * 8, INF(11) + L * 64, INF(12) + L * 64};
            for (int rep_ = 0; rep_ < NREP(1); ++rep_) pg8::gemm_phase<DM, EpiInProj, pg8::StaticOrder, true>(lds, g, S, E);
            if (NULLP(1)) { EpiNull EN{(float*)(wsp + WS_SSX2)}; pg8::gemm_phase<DM, EpiNull, pg8::StaticOrder, true>(lds, g, S, EN); }
        }
        SEAM(pb + 0);
        if (PHM(2) && IN(pb + 1)) {
            PHASE_PTRS;
            { pg8::Gemm g{Qc, (const bf16_t*)(Wl + WO_UQ), 256}; pg8::StaticOrder S; S.init(NTOK, 768, G, bx);
              EpiQUp E{wsp};
              for (int rep_ = 0; rep_ < NREP(2); ++rep_) pg8::gemm_phase<256, EpiQUp, pg8::StaticOrder, true>(lds, g, S, E); }
            { pg8::Gemm g{Kvc, (const bf16_t*)(Wl + WO_UKV), 128}; pg8::StaticOrder S; S.init(NTOK, 1024, G, bx);
              EpiKvUp E{wsp, INF(10) + L * 96};
              for (int rep_ = 0; rep_ < NREP(2); ++rep_) pg8::gemm_phase<128, EpiKvUp, pg8::StaticOrder, true>(lds, g, S, E); }
            for (int v = vcu; v < 32; v += G) {
                const int b = v >> 3, h = v & 7; LAS double* wt = (LAS double*)lds;
                const size_t base = ((size_t)b * SEQ + wave * 1024 + lane * 16) * 8 + h; float lv[16]; double loc = 0.0;
#pragma unroll
                for (int i = 0; i < 16; ++i) { lv[i] = logf[base + (size_t)i * 8]; loc += (double)lv[i]; }
                double pre = loc;
#pragma unroll
                for (int o = 1; o < 64; o <<= 1) { const double n = __shfl_up(pre, o); if (lane >= o) pre += n; }
                if (lane == 63) wt[wave] = pre;
                LDS_WAIT(); __syncthreads();
                double run = pre - loc;
                for (int w = 0; w < wave; ++w) run += wt[w];
#pragma unroll
                for (int i = 0; i < 16; ++i) { run += (double)lv[i]; Fc[base + (size_t)i * 8] = (float)run; }
                __syncthreads();
            }
        }
        SEAM(pb + 1);
        if (PHM(3) && IN(pb + 2)) {
            PHASE_PTRS;
            att::Args A{Qraw, Kmla, Vmla, Fq, Fk, Fv, ssqn, ssqr, INF(9) + L * 96, cosT, sinT, Fc, INF(11) + L * 64, INF(12) + L * 64, ob, sso};
#ifdef DIAG_SEL
            LAS float* dg = (L == 0 && blockIdx.x == DIAG_BLOCK && tid == 0) ? (LAS float*)(lds0 + LDSCTL_OFF + 8192) : (LAS float*)nullptr;
            if (dg) for (int k = 0; k < 16; ++k) dg[k] = 0.f;
            att::attn_phase(A, vcu, G, (LAS char*)lds, NREP(10), NREP(11), dg);
            if (dg) { float* dw = (float*)(wsp + WS_CTL) + 250000; for (int k = 0; k < 16; ++k) dw[k] = dg[k]; }
#else
            att::attn_phase(A, vcu, G, (LAS char*)lds, NREP(10), NREP(11), (LAS float*)nullptr);
#endif
        }
        SEAM(pb + 2);
        if (PHM(4) && IN(pb + 3)) {
            PHASE_PTRS;
            pg8::Gemm g{ob, (const bf16_t*)(Wl + WO_OUT), DM}; pg8::StaticOrder S; S.init(NTOK, DM, G, bx);
            EpiOut E{wsp, L == 0 ? x_in : (const float*)nullptr};
            for (int rep_ = 0; rep_ < (L == 0 ? NREP(4) : 1); ++rep_) pg8::gemm_phase<DM, EpiOut, pg8::StaticOrder, true>(lds, g, S, E);
            if (NULLP(4)) { EpiNull EN{(float*)(wsp + WS_SSX2)}; pg8::gemm_phase<DM, EpiNull, pg8::StaticOrder, true>(lds, g, S, EN); }
        }
        SEAM(pb + 3);
        if (PHM(5) && IN(pb + 4)) {
            PHASE_PTRS;
            { pg8::Gemm g{xbB, (const bf16_t*)(Wl + WO_RT), DM}; pg8::StaticOrder S; S.init(NTOK, 256, G, bx);
              EpiRouter E{wsp, ctl + CW_CNT + 64 * L};
              pg8::gemm_phase<DM, EpiRouter, pg8::StaticOrder, true>(lds, g, S, E); }
            { pg8::Gemm g{pbf + (size_t)L * NTOK * 256, (const bf16_t*)(Wl + WO_PP), 256}; pg8::StaticOrder S; S.init(NTOK, DM, G, bx);
              EpiPP E{wsp};
              for (int rep_ = 0; rep_ < NREP(5); ++rep_) pg8::gemm_phase<256, EpiPP, pg8::StaticOrder, true>(lds, g, S, E); }
        }
        SEAM(pb + 4);
        if ((PHM(6) && IN(pb + 5)) || (PHM(7) && IN(pb + 6))) {
            PHASE_PTRS;
            if (tid < 32) { const unsigned c = __hip_atomic_load(ctl + CW_CNT + 64 * L + tid, RLX_AGENT); cntL[tid] = c; }
            LDS_WAIT(); __syncthreads();
            if (tid == 0) { int run = 0; for (int e = 0; e < 32; ++e) { preL[e] = run; run += ((int)cntL[e] + 255) >> 8; } preL[32] = run; }
            LDS_WAIT(); __syncthreads();
        }
        if (PHM(6) && IN(pb + 5)) {
            PHASE_PTRS;
            pg8::Gemm g{xbB, (const bf16_t*)(Wl + WO_GU), DM}; MoeOrder S{preL, cntL, list, 2, G, bx, true};
            EpiMoeUp E{wsp, cntL, 2};
            for (int rep_ = 0; rep_ < NREP(6); ++rep_) pg8::gemm_phase<DM, EpiMoeUp, MoeOrder, true>(lds, g, S, E);
        }
        SEAM(pb + 5);
        if (PHM(7) && IN(pb + 6)) {
            PHASE_PTRS;
            pg8::Gemm g{hid, (const bf16_t*)(Wl + WO_DN), 256}; MoeOrder S{preL, cntL, list, 4, G, bx, false};
            EpiMoeDown E{wsp, cntL, 4};
            pg8::gemm_phase<256, EpiMoeDown, MoeOrder, true>(lds, g, S, E);
        }
        SEAM(pb + 6);
        if (PHM(8) && IN(pb + 7)) {
            PHASE_PTRS;
            for (int m = gw; m < NTOK; m += NGW) { const u32x4* cr = (const u32x4*)(c1 + (size_t)m * DM) + lane; u32x4* xr = (u32x4*)(xbB + (size_t)m * DM) + lane; float s = 0.f;
#pragma unroll
                for (int j = 0; j < 2; ++j) { const u32x4 cw = cr[64 * j], xw = xr[64 * j];
                    const f32x4 v0 = (f32x4){bflo(xw.x), bfhi(xw.x), bflo(xw.y), bfhi(xw.y)} + (f32x4){bflo(cw.x), bfhi(cw.x), bflo(cw.y), bfhi(cw.y)}, v1 = (f32x4){bflo(xw.z), bfhi(xw.z), bflo(xw.w), bfhi(xw.w)} + (f32x4){bflo(cw.z), bfhi(cw.z), bflo(cw.w), bfhi(cw.w)};
                    s += sum4sq(v0) + sum4sq(v1); xr[64 * j] = pack8(v0, v1); }
                s = wave_sum(s); if (lane == 0) ssx2[m] = s; }
        }
        SEAM(pb + 7);
        if (PHM(9) && IN(pb + 8)) {
            PHASE_PTRS;
            pg8::Gemm g{xbB, (const bf16_t*)(Wl + WO_PG), DM}; pg8::StaticOrder S; S.init(NTOK, DM, G, bx);
            EpiPle E{wsp, INF(26) + L * DM, L + 1 == DEPTH ? xo : (float*)nullptr};
            pg8::gemm_phase<DM, EpiPle, pg8::StaticOrder, true>(lds, g, S, E);
        }
        if (L + 1 < DEPTH) SEAM(pb + 8);
    }
#undef IN
#undef SEAM
#undef INF
}

extern "C" void kernel_launch(void* const* d_in, const int* in_sizes, int n_in, void* d_out, int out_size, void* d_ws, size_t ws_size, hipStream_t stream) {
    static int grid = 0;
    if (grid == 0) {
        if (n_in != 27 || ws_size < WS_END) { fprintf(stderr, "kernel_launch: unexpected inputs (n_in %d, ws %zu)\n", n_in, ws_size); grid = -1; return; }
        int dev = 0, cus = 0, per_cu = 0;
        if (hipGetDevice(&dev) != hipSuccess || hipDeviceGetAttribute(&cus, hipDeviceAttributeMultiprocessorCount, dev) != hipSuccess) { grid = -1; return; }
        if (hipFuncSetAttribute((const void*)mega_fwd, hipFuncAttributeMaxDynamicSharedMemorySize, LDS_BYTES) != hipSuccess) { fprintf(stderr, "kernel_launch: hipFuncSetAttribute failed\n"); grid = -1; return; }
        if (hipOccupancyMaxActiveBlocksPerMultiprocessor(&per_cu, (const void*)mega_fwd, NWAVES * 64, LDS_BYTES) != hipSuccess || per_cu < 1) { fprintf(stderr, "kernel_launch: occupancy query says %d\n", per_cu); }
        (void)hipGetLastError();
        grid = cus;
    }
    if (grid < 0) return;
    if (hipMemsetAsync((char*)d_ws + WS_CTL, 0, CTL_ZERO_BYTES, stream) != hipSuccess) return;
    KArgs a{};
    for (int i = 0; i < 27; ++i) a.in[i] = d_in[i];
    a.out = (float*)d_out; a.ws = (unsigned char*)d_ws;
    const int cuts[] = MK_CUTS; const int nl = (int)(sizeof(cuts) / sizeof(int)) - 1;
    for (int li = 0; li < nl; ++li) {
        a.ph_lo = cuts[li]; a.ph_hi = cuts[li + 1]; a.li = li; a.pad = 0;
        hipLaunchKernelGGL(mega_fwd, dim3(grid), dim3(NWAVES * 64), LDS_BYTES, stream, a);
        if (hipPeekAtLastError() != hipSuccess) { fprintf(stderr, "kernel_launch: launch %d failed\n", li); break; }
    }
}
```

```cpp
#include <hip/hip_runtime.h>
#include <cstdio>
#include <cstdint>

#define LAS __attribute__((address_space(3)))
#define GAS __attribute__((address_space(1)))
typedef unsigned short bf16_t;
typedef short bf16x8 __attribute__((ext_vector_type(8)));
typedef short s16x4 __attribute__((ext_vector_type(4)));
typedef float f32x2 __attribute__((ext_vector_type(2)));
typedef float f32x4 __attribute__((ext_vector_type(4)));
typedef float f32x16 __attribute__((ext_vector_type(16)));
typedef unsigned u32x2 __attribute__((ext_vector_type(2)));
typedef unsigned u32x4 __attribute__((ext_vector_type(4)));

constexpr int DM = 1024, NB = 4, SEQ = 8192, NTOK = NB * SEQ, DEPTH = 2;
constexpr int INC = 1960, NEXP = 32;
constexpr int C_KVC = 256, C_KPE = 384, C_FQ = 416, C_FK = 928, C_FV = 1440, C_FL = 1952;
constexpr float EPS = 1e-6f;
constexpr float LOG2E = 1.4426950408889634f;
constexpr float C2_FOX = 0.125f * LOG2E;
constexpr float C2_MLA = 0.10206207261596575f * LOG2E;

__device__ __forceinline__ unsigned cvt_pk_bf16(float lo, float hi) { unsigned r; asm volatile("v_cvt_pk_bf16_f32 %0, %1, %2" : "=v"(r) : "v"(lo), "v"(hi)); return r; }
__device__ __forceinline__ float bf2f(unsigned short u) { return __uint_as_float((unsigned)u << 16); }
__device__ __forceinline__ float bflo(unsigned w) { return __uint_as_float(w << 16); }
__device__ __forceinline__ float bfhi(unsigned w) { return __uint_as_float(w & 0xffff0000u); }
__device__ __forceinline__ u32x4 pack8(const f32x4& a, const f32x4& b) { u32x4 w; w.x = cvt_pk_bf16(a[0], a[1]); w.y = cvt_pk_bf16(a[2], a[3]); w.z = cvt_pk_bf16(b[0], b[1]); w.w = cvt_pk_bf16(b[2], b[3]); return w; }
__device__ __forceinline__ float sum4sq(const f32x4& a) { return (a[0] * a[0] + a[1] * a[1]) + (a[2] * a[2] + a[3] * a[3]); }
__device__ __forceinline__ float red_fq(float s) { s += __shfl_xor(s, 16); s += __shfl_xor(s, 32); return s; }
__device__ __forceinline__ float sum16(const float* p) { const f32x4 a = *(const f32x4*)p, b = *(const f32x4*)(p + 4), c = *(const f32x4*)(p + 8), d = *(const f32x4*)(p + 12);
    return ((a[0] + a[1]) + (a[2] + a[3])) + ((b[0] + b[1]) + (b[2] + b[3])) + ((c[0] + c[1]) + (c[2] + c[3])) + ((d[0] + d[1]) + (d[2] + d[3])); }
__device__ __forceinline__ float sum8(const float* p) { const f32x4 a = *(const f32x4*)p, b = *(const f32x4*)(p + 4); return ((a[0] + a[1]) + (a[2] + a[3])) + ((b[0] + b[1]) + (b[2] + b[3])); }
__device__ __forceinline__ float log_sigmoid_f(float x) { return -(fmaxf(-x, 0.f) + log1pf(__expf(-fabsf(x)))); }

constexpr int NWAVES = 8;
constexpr size_t MiB = 1u << 20;
constexpr size_t WS_CTL = 0, CTL_ZERO_BYTES = 1 * MiB;
constexpr size_t WS_SSX0 = 1 * MiB, WS_SSX1 = 3 * MiB, WS_SSPP = 5 * MiB, WS_SSO = 7 * MiB, WS_SSX2 = 9 * MiB, WS_SSKPE = 10 * MiB, WS_SSQQ = 11 * MiB, WS_SSQKV = 12 * MiB,
                 WS_GATE = 13 * MiB, WS_LOGF = 14 * MiB, WS_F = 15 * MiB, WS_SSQN = 16 * MiB, WS_SSQR = 17 * MiB, WS_COS = 18 * MiB, WS_SIN = 20 * MiB, WS_LIST = 22 * MiB;
constexpr size_t WS_W = 28 * MiB, W_LAYER = 58 * MiB;
constexpr size_t WO_IN = 0, WO_UQ = 4 * MiB, WO_UKV = 4 * MiB + 512 * 1024, WO_OUT = 5 * MiB, WO_RT = 7 * MiB, WO_PG = 7 * MiB + 512 * 1024, WO_PP = 9 * MiB + 512 * 1024, WO_GU = 10 * MiB, WO_DN = 42 * MiB;
constexpr size_t WS_XBA = 144 * MiB, WS_XBB = 208 * MiB, WS_PBF = 272 * MiB, WS_MIX = 304 * MiB;
constexpr size_t WS_O = WS_XBA, WS_QRAW = WS_XBB;
constexpr size_t WS_QC = WS_MIX, WS_KVC = WS_MIX + 16 * MiB, WS_KPE = WS_MIX + 24 * MiB, WS_FQ = WS_MIX + 26 * MiB, WS_FK = WS_MIX + 58 * MiB, WS_FV = WS_MIX + 90 * MiB, WS_KMLA = WS_MIX + 122 * MiB, WS_VMLA = WS_MIX + 170 * MiB;
constexpr size_t WS_PP = WS_MIX, WS_HID = WS_MIX + 64 * MiB, WS_C1 = WS_MIX + 100 * MiB;
constexpr size_t WS_END = 512 * MiB;
static_assert(WS_VMLA + 32 * MiB <= WS_END && WS_C1 + 64 * MiB <= WS_END && WS_W + 2 * W_LAYER <= WS_XBA, "d_ws map");
constexpr int HID_ROWS = 2 * NTOK + NEXP * 256;
static_assert((size_t)HID_ROWS * 256 * 2 <= 36 * MiB, "hid");

namespace pg8 {
constexpr int TAB_OFF = 131072 + 1024;
constexpr int BM = 256, BK = 64, HALF = 128, HTB = HALF * BK * 2, STAGE_BYTES = 8 * HTB, NXCD = 8, WGM = 8;
__host__ __device__ __forceinline__ int lds_byte(int r, int c) { const int st = (r >> 4) * 2 + (c >> 5), rr = r & 15, cc = c & 31, ob = rr * 64 + cc * 2; return st * 1024 + (ob ^ (((ob >> 9) & 1) << 5)); }
__host__ __device__ __forceinline__ void stage_rc(int b, int& R, int& C) { const int st = b / 1024, sb = b % 1024, swz = sb ^ (((sb >> 9) & 1) << 5); R = (st >> 1) * 16 + swz / 64; C = (st & 1) * 32 + (swz % 64) / 2; }
__host__ __device__ __forceinline__ int perm32(int rho) { const int n = rho >> 4, i = rho & 15; return 8 * (i >> 2) + 4 * n + (i & 3); }

struct Unit { int pm, pn, e, blk; };
struct Gemm { const bf16_t* A; const bf16_t* Bt; int K; };

struct StaticOrder {
    int nM, nN, nwg, G, c;
    __device__ void init(int M, int N, int G_, int c_) { nM = M / BM; nN = N / BM; nwg = nM * nN; G = G_; c = c_; }
    __device__ bool next(int i, Unit& u) const {
        const long L = (long)i * G + c; if (L >= nwg) return false;
        int wgid = (int)L; { const int q = nwg / NXCD, r = nwg % NXCD, xcd = wgid % NXCD, off = wgid / NXCD; wgid = (xcd < r ? xcd * (q + 1) : r * (q + 1) + (xcd - r) * q) + off; }
        const int nig = WGM * nN, gid = wgid / nig, fm = gid * WGM, gsz = (nM - fm) < WGM ? (nM - fm) : WGM;
        u.pm = fm + ((wgid % nig) % gsz); u.pn = (wgid % nig) / gsz; u.e = 0; u.blk = 0; return true;
    }
    __device__ __forceinline__ int arow(const Unit& u, int r) const { return u.pm * BM + r; }
};

template <int K, class Epi, class Sched, bool ALIGN_EPI>
__device__ __forceinline__ void gemm_phase(LAS unsigned char* lds, const Gemm g, const Sched& S, const Epi& E) {
    LAS f32x2* const tab0 = (LAS f32x2*)(lds + TAB_OFF);
    int tid_ = threadIdx.x; asm volatile("" : "+v"(tid_));
    const int tid = tid_, wid = __builtin_amdgcn_readfirstlane(tid >> 6), lane = tid & 63, wr = wid >> 2, wc = wid & 3, fr = lane & 15, fq = lane >> 4;
    int Kr = K; asm volatile("" : "+s"(Kr));
    const int nt = Kr / BK;
    unsigned voffB[2];
#pragma unroll
    for (int i = 0; i < 2; ++i) { int R_, C_; stage_rc(tid * 16 + i * 8192, R_, C_); const int Rb = (R_ & ~31) + perm32(R_ & 31); voffB[i] = (unsigned)(Rb * Kr + C_) * 2u; }
    const size_t kstep = (size_t)(BK * 2);
    const size_t hstep = (size_t)HALF * Kr * 2;
    const size_t tstep = 2 * hstep;
    const unsigned ldsw = (unsigned)wid * 1024u;
    const int aoff = lds_byte(wr * 64 + fr, fq * 8), boff = lds_byte(wc * 32 + fr, fq * 8);
#define PG8_SA(b, h) (((b) * 2 + (h)) * HTB)
#define PG8_SB(b, h) ((4 + (b) * 2 + (h)) * HTB)
#define PG8_STAGE(bufoff, gbase, voff) do { _Pragma("unroll") for (int _i = 0; _i < 2; ++_i) \
        __builtin_amdgcn_global_load_lds((const unsigned*)((const char*)(gbase) + (voff)[_i]), (LAS unsigned*)(lds + (bufoff) + ldsw + _i * 8192), 16, 0, 0); } while (0)
#define PG8_LDA(dst, b, h) do { _Pragma("unroll") for (int m = 0; m < 4; ++m) _Pragma("unroll") for (int k = 0; k < 2; ++k) dst[m][k] = *(const LAS bf16x8*)(lds + PG8_SA(b, h) + aoff + m * 2048 + k * 1024); } while (0)
#define PG8_LDB(dst, b, h) do { _Pragma("unroll") for (int n = 0; n < 2; ++n) _Pragma("unroll") for (int k = 0; k < 2; ++k) dst[n][k] = *(const LAS bf16x8*)(lds + PG8_SB(b, h) + boff + n * 2048 + k * 1024); } while (0)
#define PG8_MMA(ai, bj, At, Bt) do { __builtin_amdgcn_s_setprio(1); _Pragma("unroll") for (int m = 0; m < 4; ++m) _Pragma("unroll") for (int n = 0; n < 2; ++n) _Pragma("unroll") for (int k = 0; k < 2; ++k) \
        acc[ai][bj][m][n] = __builtin_amdgcn_mfma_f32_16x16x32_bf16(Bt[n][k], At[m][k], acc[ai][bj][m][n], 0, 0, 0); __builtin_amdgcn_s_setprio(0); } while (0)
#define PG8_WAIT_V(n) asm volatile("s_waitcnt vmcnt(" #n ")" ::: "memory")
#define PG8_WAIT_L(n) asm volatile("s_waitcnt lgkmcnt(" #n ")" ::: "memory")
#define PG8_BAR __builtin_amdgcn_s_barrier()
#define PG8_SCHED __builtin_amdgcn_sched_barrier(0)
#define PG8_AOFF(dst, u) do { int _t = tid; asm volatile("" : "+v"(_t)); _Pragma("unroll") for (int _i = 0; _i < 2; ++_i) { int _R, _C; stage_rc(_t * 16 + _i * 8192, _R, _C); _Pragma("unroll") for (int _h = 0; _h < 2; ++_h) dst[_h][_i] = ((unsigned)S.arow(u, _h * HALF + _R) * (unsigned)Kr + (unsigned)_C) * 2u; } } while (0)
    Unit cur, nxt; int ui = 0;
    if (!S.next(0, cur)) return;
    f32x4 acc[2][2][4][2];
#pragma unroll
    for (int a = 0; a < 2; ++a)
#pragma unroll
        for (int b = 0; b < 2; ++b)
#pragma unroll
            for (int m = 0; m < 4; ++m)
#pragma unroll
                for (int n = 0; n < 2; ++n) acc[a][b][m][n] = (f32x4){0.f, 0.f, 0.f, 0.f};
    bf16x8 At[4][2], B0[2][2], B1[2][2];
    unsigned ca[2][2], na[2][2];
    PG8_AOFF(ca, cur);
    const char* gA = (const char*)g.A;
    const char* cB = (const char*)g.Bt + (size_t)cur.pn * tstep;
    PG8_STAGE(PG8_SB(0, 0), cB, voffB); PG8_STAGE(PG8_SB(0, 1), cB + hstep, voffB); PG8_STAGE(PG8_SA(0, 0), gA, ca[0]); PG8_STAGE(PG8_SA(0, 1), gA, ca[1]);
    if (wr == 1) PG8_BAR;
    PG8_WAIT_V(2); PG8_BAR;
    PG8_STAGE(PG8_SB(1, 0), cB + kstep, voffB); PG8_STAGE(PG8_SA(1, 0), gA + kstep, ca[0]); PG8_STAGE(PG8_SB(1, 1), cB + hstep + kstep, voffB);
    PG8_WAIT_V(6); PG8_BAR;
    for (;;) {
        const bool has_next = S.next(ui + 1, nxt);
        E.pre(cur, tab0 + (ui & 1) * 256, tid);
        if (has_next) { PG8_AOFF(na, nxt); } else {
#pragma unroll
            for (int _h = 0; _h < 2; ++_h)
#pragma unroll
                for (int _i = 0; _i < 2; ++_i) na[_h][_i] = ca[_h][_i]; }
        const char* nB = has_next ? (const char*)g.Bt + (size_t)nxt.pn * tstep : cB;
        for (int t = 0; t < nt; t += 2) {
            const bool last = (t == nt - 2);
            if constexpr (Epi::HAS_MID) { if (t == nt / 2) E.mid(acc, cur, wr, wc, fr, fq, tab0 + (ui & 1) * 256); }
            const char* a1 = gA + (size_t)(t + 1) * kstep;
            const char* a2 = last ? gA : gA + (size_t)(t + 2) * kstep; const char* b2 = last ? nB : cB + (size_t)(t + 2) * kstep;
            const char* a3 = a2 + kstep; const char* b3 = b2 + kstep;
            unsigned o2[2][2];
#pragma unroll
            for (int _h = 0; _h < 2; ++_h)
#pragma unroll
                for (int _i = 0; _i < 2; ++_i) o2[_h][_i] = last ? na[_h][_i] : ca[_h][_i];
            PG8_LDB(B0, 0, 0); PG8_LDB(B1, 0, 1); PG8_SCHED; PG8_LDA(At, 0, 0); PG8_STAGE(PG8_SA(1, 1), a1, ca[1]);
            PG8_WAIT_V(8); PG8_WAIT_L(0); PG8_BAR; PG8_MMA(0, 0, At, B0); PG8_MMA(0, 1, At, B1); PG8_BAR; PG8_SCHED;
            PG8_LDA(At, 0, 1); PG8_STAGE(PG8_SB(0, 0), b2, voffB); PG8_STAGE(PG8_SB(0, 1), b2 + hstep, voffB); PG8_STAGE(PG8_SA(0, 0), a2, o2[0]);
            PG8_WAIT_V(8); PG8_WAIT_L(0); PG8_BAR; PG8_MMA(1, 0, At, B0); PG8_MMA(1, 1, At, B1); PG8_BAR; PG8_SCHED;
            PG8_LDB(B0, 1, 0); PG8_LDB(B1, 1, 1); PG8_SCHED; PG8_LDA(At, 1, 0); PG8_STAGE(PG8_SA(0, 1), a2, o2[1]);
            PG8_WAIT_V(8); PG8_WAIT_L(0); PG8_BAR; PG8_MMA(0, 0, At, B0); PG8_MMA(0, 1, At, B1); PG8_BAR; PG8_SCHED;
            PG8_LDA(At, 1, 1); PG8_STAGE(PG8_SB(1, 0), b3, voffB); PG8_STAGE(PG8_SB(1, 1), b3 + hstep, voffB); PG8_STAGE(PG8_SA(1, 0), a3, o2[0]);
            PG8_WAIT_V(8); PG8_WAIT_L(0); PG8_BAR; PG8_MMA(1, 0, At, B0); PG8_MMA(1, 1, At, B1); PG8_BAR; PG8_SCHED;
        }
        if constexpr (ALIGN_EPI) { if (wr == 0) PG8_BAR; }
        E(acc, cur, wr, wc, fr, fq, tab0 + (ui & 1) * 256);
        if (!has_next) break;
#pragma unroll
        for (int a = 0; a < 2; ++a)
#pragma unroll
            for (int b = 0; b < 2; ++b)
#pragma unroll
                for (int m = 0; m < 4; ++m)
#pragma unroll
                    for (int n = 0; n < 2; ++n) acc[a][b][m][n] = (f32x4){0.f, 0.f, 0.f, 0.f};
        cur = nxt; cB = nB; ++ui;
#pragma unroll
        for (int _h = 0; _h < 2; ++_h)
#pragma unroll
            for (int _i = 0; _i < 2; ++_i) ca[_h][_i] = na[_h][_i];
        if constexpr (ALIGN_EPI) { if (wr == 1) PG8_BAR; }
    }
    PG8_WAIT_V(0);
    if constexpr (!ALIGN_EPI) { if (wr == 0) PG8_BAR; }
    PG8_BAR;
#undef PG8_SA
#undef PG8_SB
#undef PG8_STAGE
#undef PG8_LDA
#undef PG8_LDB
#undef PG8_MMA
#undef PG8_WAIT_V
#undef PG8_WAIT_L
#undef PG8_BAR
#undef PG8_SCHED
#undef PG8_AOFF
}
}
using pg8::Unit;
typedef f32x4 AccT[2][2][4][2];
#define EPI_ROWS(...) _Pragma("unroll") for (int ai = 0; ai < 2; ++ai) _Pragma("unroll") for (int m = 0; m < 4; ++m) { const int rl = ai * 128 + wr * 64 + m * 16 + fr; const int row = u.pm * 256 + rl; (void)row; __VA_ARGS__ if (m & 1) asm volatile("" ::: "memory"); }

struct EpiInProj {
    static constexpr bool HAS_MID = false;
    unsigned char* ws; const float *bfox, *gfq, *gfk;
    __device__ __forceinline__ void pre(const Unit& u, LAS f32x2* tab, int tid) const { if (tid < 256) { const float* ssx = (const float*)(ws + WS_SSX0); tab[tid] = (f32x2){rsqrtf(sum16(ssx + (size_t)(u.pm * 256 + tid) * 16) * (1.f / 1024.f) + EPS), 0.f}; } }
    __device__ __forceinline__ void mid(AccT&, const Unit&, int, int, int, int, const LAS f32x2*) const {}
    __device__ __forceinline__ void operator()(const AccT& acc, const Unit& u, int wr, int wc, int fr, int fq, const LAS f32x2* tab) const {
        asm volatile("" : "+v"(fr), "+v"(fq));
        const int pn = u.pn;
        const float* ssx = (const float*)(ws + WS_SSX0); bf16_t* Qc = (bf16_t*)(ws + WS_QC); bf16_t* Kvc = (bf16_t*)(ws + WS_KVC); bf16_t* Kpe = (bf16_t*)(ws + WS_KPE);
        float* ssq_q = (float*)(ws + WS_SSQQ); float* ssq_kv = (float*)(ws + WS_SSQKV); float* ss_kpe = (float*)(ws + WS_SSKPE); float* logf = (float*)(ws + WS_LOGF);
        if (pn == 0) {
            EPI_ROWS({ const float rinv = tab[rl].x; float s = 0.f;
_Pragma("unroll")
                for (int bj = 0; bj < 2; ++bj) { const f32x4 v0 = acc[ai][bj][m][0] * rinv, v1 = acc[ai][bj][m][1] * rinv; s += sum4sq(v0) + sum4sq(v1);
                    *(u32x4*)(Qc + (size_t)row * 256 + bj * 128 + wc * 32 + fq * 8) = pack8(v0, v1); }
                s = red_fq(s); if (fq == 0) ssq_q[(size_t)row * 4 + wc] = s; })
        } else if (pn == 1) {
            EPI_ROWS({ const float rinv = tab[rl].x;
                if (wc < 2) { float s = 0.f;
_Pragma("unroll")
                    for (int bj = 0; bj < 2; ++bj) { const f32x4 v0 = acc[ai][bj][m][0] * rinv, v1 = acc[ai][bj][m][1] * rinv; s += sum4sq(v0) + sum4sq(v1);
                        *(u32x4*)(Kvc + (size_t)row * 128 + wc * 64 + bj * 32 + fq * 8) = pack8(v0, v1); }
                    s = red_fq(s); if (fq == 0) ssq_kv[(size_t)row * 2 + wc] = s;
                } else if (wc == 2) { const f32x4 v0 = acc[ai][0][m][0] * rinv, v1 = acc[ai][0][m][1] * rinv; float s = sum4sq(v0) + sum4sq(v1);
                    *(u32x4*)(Kpe + (size_t)row * 32 + fq * 8) = pack8(v0, v1);
                    s = red_fq(s); if (fq == 0) ss_kpe[row] = s;
                } else { if (fq == 0) { const f32x4 v0 = acc[ai][0][m][0] * rinv, v1 = acc[ai][0][m][1] * rinv; const f32x4 b0 = *(const f32x4*)bfox, b1 = *(const f32x4*)(bfox + 4); f32x4 o0, o1;
_Pragma("unroll")
                        for (int i = 0; i < 4; ++i) { o0[i] = log_sigmoid_f(v0[i] + b0[i]); o1[i] = log_sigmoid_f(v1[i] + b1[i]); }
                        *(f32x4*)(logf + (size_t)row * 8) = o0; *(f32x4*)(logf + (size_t)row * 8 + 4) = o1; } } })
        } else {
            const int kind = (pn - 2) >> 1, head = 4 * ((pn - 2) & 1) + wc;
            bf16_t* dst = (bf16_t*)(ws + (kind == 0 ? WS_FQ : (kind == 1 ? WS_FK : WS_FV))); const float* g = kind == 0 ? gfq : gfk; const float osc = kind == 0 ? C2_FOX : 1.f;
            f32x4 g4[2][2];
_Pragma("unroll")
            for (int bj = 0; bj < 2; ++bj)
_Pragma("unroll")
                for (int n = 0; n < 2; ++n) g4[bj][n] = kind < 2 ? *(const f32x4*)(g + bj * 32 + fq * 8 + n * 4) * osc : (f32x4){1.f, 1.f, 1.f, 1.f};
            EPI_ROWS({ const float rinv = tab[rl].x; f32x4 v[2][2]; float s = 0.f;
_Pragma("unroll")
                for (int bj = 0; bj < 2; ++bj)
_Pragma("unroll")
                    for (int n = 0; n < 2; ++n) { v[bj][n] = acc[ai][bj][m][n] * rinv; s += sum4sq(v[bj][n]); }
                s = red_fq(s); const float hr = kind < 2 ? rsqrtf(s * (1.f / 64.f) + EPS) : 1.f;
_Pragma("unroll")
                for (int bj = 0; bj < 2; ++bj) { const int bb = row >> 13, tl = (row >> 6) & 127, r = row & 63; const size_t tb = ((size_t)(bb * 8 + head) * 128 + tl) * 4096;
                    const size_t off = kind == 0 ? (size_t)row * 512 + head * 64 + bj * 32 + fq * 8 : (kind == 1 ? tb + (4 * bj + fq) * 512 + r * 8 : tb + (bj * 4 + (r >> 4)) * 512 + (r & 15) * 32 + fq * 8);
                    *(u32x4*)(dst + off) = pack8(v[bj][0] * hr * g4[bj][0], v[bj][1] * hr * g4[bj][1]); } })
        }
    }
};
struct EpiQUp {
    static constexpr bool HAS_MID = false;
    unsigned char* ws;
    __device__ __forceinline__ void pre(const Unit& u, LAS f32x2* tab, int tid) const { if (tid < 256) { const f32x4 sq = *(const f32x4*)((const float*)(ws + WS_SSQQ) + (size_t)(u.pm * 256 + tid) * 4); tab[tid] = (f32x2){rsqrtf(((sq[0] + sq[1]) + (sq[2] + sq[3])) * (1.f / 256.f) + EPS), 0.f}; } }
    __device__ __forceinline__ void mid(AccT&, const Unit&, int, int, int, int, const LAS f32x2*) const {}
    __device__ __forceinline__ void operator()(const AccT& acc, const Unit& u, int wr, int wc, int fr, int fq, const LAS f32x2* tab) const {
        asm volatile("" : "+v"(fr), "+v"(fq));
        const int pn = u.pn;
        const float* ssq_q = (const float*)(ws + WS_SSQQ); bf16_t* Qraw = (bf16_t*)(ws + WS_QRAW); float* ssq_qn = (float*)(ws + WS_SSQN); float* ssq_qr = (float*)(ws + WS_SSQR);
        EPI_ROWS({ const float rinv = tab[rl].x;
            if (pn < 2) { const int head = 4 * pn + wc; float s = 0.f;
_Pragma("unroll")
                for (int bj = 0; bj < 2; ++bj) { const f32x4 v0 = acc[ai][bj][m][0] * rinv, v1 = acc[ai][bj][m][1] * rinv; s += sum4sq(v0) + sum4sq(v1);
                    *(u32x4*)(Qraw + (size_t)row * 768 + head * 96 + bj * 32 + fq * 8) = pack8(v0, v1); }
                s = red_fq(s); if (fq == 0) ssq_qn[(size_t)row * 8 + head] = s;
            } else {
_Pragma("unroll")
                for (int bj = 0; bj < 2; ++bj) { const int head = 4 * bj + wc; const f32x4 v0 = acc[ai][bj][m][0] * rinv, v1 = acc[ai][bj][m][1] * rinv; float s = sum4sq(v0) + sum4sq(v1);
                    *(u32x4*)(Qraw + (size_t)row * 768 + head * 96 + 64 + fq * 8) = pack8(v0, v1);
                    s = red_fq(s); if (fq == 0) ssq_qr[(size_t)row * 8 + head] = s; }
            } })
    }
};
struct EpiKvUp {
    static constexpr bool HAS_MID = false;
    unsigned char* ws; const float* gk;
    __device__ __forceinline__ void pre(const Unit& u, LAS f32x2* tab, int tid) const { if (tid < 256) { const size_t r = (size_t)(u.pm * 256 + tid); const f32x2 sk = *(const f32x2*)((const float*)(ws + WS_SSQKV) + r * 2); tab[tid] = (f32x2){rsqrtf((sk[0] + sk[1]) * (1.f / 128.f) + EPS), ((const float*)(ws + WS_SSKPE))[r]}; } }
    __device__ __forceinline__ void mid(AccT&, const Unit&, int, int, int, int, const LAS f32x2*) const {}
    __device__ __forceinline__ void operator()(const AccT& acc, const Unit& u, int wr, int wc, int fr, int fq, const LAS f32x2* tab) const {
        asm volatile("" : "+v"(fr), "+v"(fq));
        const int pn = u.pn;
        const float* ssq_kv = (const float*)(ws + WS_SSQKV); const float* ss_kpe = (const float*)(ws + WS_SSKPE); const bf16_t* Kpe = (const bf16_t*)(ws + WS_KPE);
        const float* cosT = (const float*)(ws + WS_COS); const float* sinT = (const float*)(ws + WS_SIN); bf16_t* Kmla = (bf16_t*)(ws + WS_KMLA); bf16_t* Vmla = (bf16_t*)(ws + WS_VMLA);
        if (pn < 2) {
            const int head = 4 * pn + wc;
            f32x4 g4[2][2];
_Pragma("unroll")
            for (int bj = 0; bj < 2; ++bj)
_Pragma("unroll")
                for (int n = 0; n < 2; ++n) g4[bj][n] = *(const f32x4*)(gk + bj * 32 + fq * 8 + n * 4);
            const f32x4 gr1 = *(const f32x4*)(gk + 64 + 4 * fq), gr2 = *(const f32x4*)(gk + 80 + 4 * fq);
            EPI_ROWS({ const f32x2 tt = tab[rl]; const float rinv = tt.x; f32x4 v[2][2]; float s = 0.f;
_Pragma("unroll")
                for (int bj = 0; bj < 2; ++bj)
_Pragma("unroll")
                    for (int n = 0; n < 2; ++n) { v[bj][n] = acc[ai][bj][m][n] * rinv; s += sum4sq(v[bj][n]); }
                s = red_fq(s) + tt.y; const float hr = rsqrtf(s * (1.f / 96.f) + EPS);
                const int bb = row >> 13, tl = (row >> 6) & 127, r = row & 63; bf16_t* kd = Kmla + ((size_t)(bb * 8 + head) * 128 + tl) * 6144 + r * 8;
_Pragma("unroll")
                for (int bj = 0; bj < 2; ++bj) *(u32x4*)(kd + (4 * bj + fq) * 512) = pack8(v[bj][0] * hr * g4[bj][0], v[bj][1] * hr * g4[bj][1]);
                const u32x2 p1 = *(const u32x2*)(Kpe + (size_t)row * 32 + 4 * fq), p2 = *(const u32x2*)(Kpe + (size_t)row * 32 + 16 + 4 * fq);
                const f32x4 c = *(const f32x4*)(cosT + (size_t)row * 16 + 4 * fq), sn = *(const f32x4*)(sinT + (size_t)row * 16 + 4 * fq);
                const f32x4 x1 = (f32x4){bflo(p1.x), bfhi(p1.x), bflo(p1.y), bfhi(p1.y)} * hr * gr1, x2 = (f32x4){bflo(p2.x), bfhi(p2.x), bflo(p2.y), bfhi(p2.y)} * hr * gr2;
                const f32x4 o1 = x1 * c - x2 * sn, o2 = x2 * c + x1 * sn;
                u32x2 w1, w2; w1.x = cvt_pk_bf16(o1[0], o1[1]); w1.y = cvt_pk_bf16(o1[2], o1[3]); w2.x = cvt_pk_bf16(o2[0], o2[1]); w2.y = cvt_pk_bf16(o2[2], o2[3]);
                *(u32x2*)(kd + (8 + (fq >> 1)) * 512 + 4 * (fq & 1)) = w1; *(u32x2*)(kd + (10 + (fq >> 1)) * 512 + 4 * (fq & 1)) = w2; })
        } else {
            const int head = 4 * (pn - 2) + wc;
            EPI_ROWS({ const f32x2 tt = tab[rl]; const float rinv = tt.x;
_Pragma("unroll")
                for (int bj = 0; bj < 2; ++bj) { const int bb = row >> 13, tl = (row >> 6) & 127, r = row & 63;
                    *(u32x4*)(Vmla + ((size_t)(bb * 8 + head) * 128 + tl) * 4096 + (bj * 4 + (r >> 4)) * 512 + (r & 15) * 32 + fq * 8) = pack8(acc[ai][bj][m][0] * rinv, acc[ai][bj][m][1] * rinv); } })
        }
    }
};
struct EpiOut {
    static constexpr bool HAS_MID = true;
    unsigned char* ws; const float* base;
    __device__ __forceinline__ void pre(const Unit& u, LAS f32x2* tab, int tid) const { if (tid < 256) { const float* sso = (const float*)(ws + WS_SSO) + (size_t)(u.pm * 256 + tid) * 16;
        const float rm = rsqrtf(sum8(sso) * (1.f / 512.f) + EPS), rf = rsqrtf(sum8(sso + 8) * (1.f / 512.f) + EPS); tab[tid] = (f32x2){rm / rf, rf}; } }
    __device__ __forceinline__ void mid(AccT& acc, const Unit& u, int wr, int wc, int fr, int fq, const LAS f32x2* tab) const {
        EPI_ROWS({ const float ratio = tab[rl].x;
_Pragma("unroll")
            for (int bj = 0; bj < 2; ++bj)
_Pragma("unroll")
                for (int n = 0; n < 2; ++n) acc[ai][bj][m][n] *= ratio; })
    }
    __device__ __forceinline__ void operator()(const AccT& acc, const Unit& u, int wr, int wc, int fr, int fq, const LAS f32x2* tab) const {
        asm volatile("" : "+v"(fr), "+v"(fq));
        bf16_t* xb = (bf16_t*)(ws + WS_XBB); const bf16_t* xa = (const bf16_t*)(ws + WS_XBA); float* ssx1 = (float*)(ws + WS_SSX1);
        EPI_ROWS({ const float rf = tab[rl].y; float s = 0.f;
_Pragma("unroll")
            for (int bj = 0; bj < 2; ++bj) { const size_t off = (size_t)row * 1024 + u.pn * 256 + bj * 128 + wc * 32 + fq * 8; f32x4 b0, b1;
                if (base) { b0 = *(const f32x4*)(base + off); b1 = *(const f32x4*)(base + off + 4); }
                else { const u32x4 w = *(const u32x4*)(xa + off); b0 = (f32x4){bflo(w.x), bfhi(w.x), bflo(w.y), bfhi(w.y)}; b1 = (f32x4){bflo(w.z), bfhi(w.z), bflo(w.w), bfhi(w.w)}; }
                const f32x4 v0 = b0 + acc[ai][bj][m][0] * rf, v1 = b1 + acc[ai][bj][m][1] * rf; s += sum4sq(v0) + sum4sq(v1);
                *(u32x4*)(xb + off) = pack8(v0, v1); }
            s = red_fq(s); if (fq == 0) ssx1[(size_t)row * 16 + u.pn * 4 + wc] = s; })
    }
};
struct EpiRouter {
    static constexpr bool HAS_MID = false;
    unsigned char* ws; unsigned* cnt;
    __device__ __forceinline__ void pre(const Unit& u, LAS f32x2* tab, int tid) const { if (tid < 256) { const float* ssx1 = (const float*)(ws + WS_SSX1); tab[tid] = (f32x2){rsqrtf(sum16(ssx1 + (size_t)(u.pm * 256 + tid) * 16) * (1.f / 1024.f) + EPS), 0.f}; } }
    __device__ __forceinline__ void mid(AccT&, const Unit&, int, int, int, int, const LAS f32x2*) const {}
    __device__ __forceinline__ void operator()(const AccT& acc, const Unit& u, int wr, int wc, int fr, int fq, const LAS f32x2* tab) const {
        asm volatile("" : "+v"(fr), "+v"(fq));
        if (wc != 0) return;
        float* gate = (float*)(ws + WS_GATE); int* list = (int*)(ws + WS_LIST);
        EPI_ROWS({ const float rinv = tab[rl].x;
            const f32x4 gl = acc[ai][1][m][0] * rinv; int g = 0; float gm = gl[0];
_Pragma("unroll")
            for (int j = 1; j < 4; ++j) if (gl[j] > gm) { gm = gl[j]; g = j; }
            float gs = 0.f;
_Pragma("unroll")
            for (int j = 0; j < 4; ++j) gs += __expf(gl[j] - gm);
            float pg = 1.f / gs;
            g = __shfl(g, fr); pg = __shfl(pg, fr);
            if (fq == g) { float le[8];
_Pragma("unroll")
                for (int j = 0; j < 4; ++j) { le[j] = acc[ai][0][m][0][j] * rinv; le[4 + j] = acc[ai][0][m][1][j] * rinv; }
                int i1 = 0; float m1 = le[0];
_Pragma("unroll")
                for (int j = 1; j < 8; ++j) if (le[j] > m1) { m1 = le[j]; i1 = j; }
                int i2 = 0; float m2 = -3.0e38f;
_Pragma("unroll")
                for (int j = 0; j < 8; ++j) if (j != i1 && le[j] > m2) { m2 = le[j]; i2 = j; }
                const float e2 = __expf(m2 - m1), w1 = 1.f / (1.f + e2), w2 = e2 * w1;
                gate[2 * (size_t)row] = pg * w1; gate[2 * (size_t)row + 1] = pg * w2;
                const int ea = g * 8 + i1, eb = g * 8 + i2;
                const unsigned pa = __hip_atomic_fetch_add(cnt + ea, 1u, __ATOMIC_RELAXED, __HIP_MEMORY_SCOPE_AGENT); list[(size_t)ea * NTOK + pa] = 2 * row;
                const unsigned pb = __hip_atomic_fetch_add(cnt + eb, 1u, __ATOMIC_RELAXED, __HIP_MEMORY_SCOPE_AGENT); list[(size_t)eb * NTOK + pb] = 2 * row + 1; } })
    }
};
struct EpiPP {
    static constexpr bool HAS_MID = false;
    unsigned char* ws;
    __device__ __forceinline__ void pre(const Unit&, LAS f32x2*, int) const {}
    __device__ __forceinline__ void mid(AccT&, const Unit&, int, int, int, int, const LAS f32x2*) const {}
    __device__ __forceinline__ void operator()(const AccT& acc, const Unit& u, int wr, int wc, int fr, int fq, const LAS f32x2* tab) const {
        asm volatile("" : "+v"(fr), "+v"(fq));
        bf16_t* pp = (bf16_t*)(ws + WS_PP); float* sspp = (float*)(ws + WS_SSPP);
        EPI_ROWS({ float s = 0.f;
_Pragma("unroll")
            for (int bj = 0; bj < 2; ++bj) { const f32x4 v0 = acc[ai][bj][m][0], v1 = acc[ai][bj][m][1]; s += sum4sq(v0) + sum4sq(v1);
                *(u32x4*)(pp + (size_t)row * 1024 + u.pn * 256 + bj * 128 + wc * 32 + fq * 8) = pack8(v0, v1); }
            s = red_fq(s); if (fq == 0) sspp[(size_t)row * 16 + u.pn * 4 + wc] = s; })
    }
};
struct EpiMoeUp {
    static constexpr bool HAS_MID = false;
    unsigned char* ws; const LAS unsigned* cntv; int npn;
    __device__ __forceinline__ void pre(const Unit& u, LAS f32x2* tab, int tid) const { if (tid < 256) { const int li = u.blk * 256 + tid; float rinv = 0.f;
        if (li < (int)cntv[u.e]) { const int tok = ((const int*)(ws + WS_LIST))[(size_t)u.e * NTOK + li] >> 1; rinv = rsqrtf(sum16((const float*)(ws + WS_SSX1) + (size_t)tok * 16) * (1.f / 1024.f) + EPS); }
        tab[tid] = (f32x2){rinv, 0.f}; } }
    __device__ __forceinline__ void mid(AccT&, const Unit&, int, int, int, int, const LAS f32x2*) const {}
    __device__ __forceinline__ void operator()(const AccT& acc, const Unit& u, int wr, int wc, int fr, int fq, const LAS f32x2* tab) const {
        asm volatile("" : "+v"(fr), "+v"(fq));
        const int pnl = u.pn - u.e * npn;
        bf16_t* hid = (bf16_t*)(ws + WS_HID);
        EPI_ROWS({ const float rinv = tab[rl].x;
            f32x4 h[2];
_Pragma("unroll")
            for (int n = 0; n < 2; ++n) { const f32x4 gg = acc[ai][0][m][n] * rinv, uu = acc[ai][1][m][n] * rinv;
_Pragma("unroll")
                for (int i = 0; i < 4; ++i) h[n][i] = gg[i] * __builtin_amdgcn_rcpf(1.f + __expf(-gg[i])) * uu[i]; }
            *(u32x4*)(hid + (size_t)row * 256 + pnl * 128 + wc * 32 + fq * 8) = pack8(h[0], h[1]); })
    }
};
struct EpiMoeDown {
    static constexpr bool HAS_MID = false;
    unsigned char* ws; const LAS unsigned* cntv; int npn;
    __device__ __forceinline__ void pre(const Unit& u, LAS f32x2* tab, int tid) const { if (tid < 256) { const int li = u.blk * 256 + tid; int aid = -1; float gt = 0.f;
        if (li < (int)cntv[u.e]) { aid = ((const int*)(ws + WS_LIST))[(size_t)u.e * NTOK + li]; gt = ((const float*)(ws + WS_GATE))[aid]; }
        tab[tid] = (f32x2){gt, __int_as_float(aid)}; } }
    __device__ __forceinline__ void mid(AccT&, const Unit&, int, int, int, int, const LAS f32x2*) const {}
    __device__ __forceinline__ void operator()(const AccT& acc, const Unit& u, int wr, int wc, int fr, int fq, const LAS f32x2* tab) const {
        asm volatile("" : "+v"(fr), "+v"(fq));
        const int pnl = u.pn - u.e * npn;
        bf16_t* c1 = (bf16_t*)(ws + WS_C1); bf16_t* xb = (bf16_t*)(ws + WS_XBB);
        EPI_ROWS({ const f32x2 tt = tab[rl]; const int aid = __float_as_int(tt.y);
            if (aid >= 0) { const int tok = aid >> 1; const float gt = tt.x;
_Pragma("unroll")
                for (int bj = 0; bj < 2; ++bj) { const size_t off = (size_t)tok * 1024 + pnl * 256 + bj * 128 + wc * 32 + fq * 8; const f32x4 v0 = acc[ai][bj][m][0] * gt, v1 = acc[ai][bj][m][1] * gt;
                    if (aid & 1) *(u32x4*)(c1 + off) = pack8(v0, v1);
                    else { const u32x4 w = *(const u32x4*)(xb + off); *(u32x4*)(xb + off) = pack8((f32x4){bflo(w.x), bfhi(w.x), bflo(w.y), bfhi(w.y)} + v0, (f32x4){bflo(w.z), bfhi(w.z), bflo(w.w), bfhi(w.w)} + v1); } } } })
    }
};
struct EpiPle {
    static constexpr bool HAS_MID = false;
    unsigned char* ws; const float* gpo; float* xout;
    __device__ __forceinline__ void pre(const Unit& u, LAS f32x2* tab, int tid) const { if (tid < 256) { const size_t r = (size_t)(u.pm * 256 + tid);
        tab[tid] = (f32x2){rsqrtf(((const float*)(ws + WS_SSX2))[r] * (1.f / 1024.f) + EPS), rsqrtf(sum16((const float*)(ws + WS_SSPP) + r * 16) * (1.f / 1024.f) + EPS)}; } }
    __device__ __forceinline__ void mid(AccT&, const Unit&, int, int, int, int, const LAS f32x2*) const {}
    __device__ __forceinline__ void operator()(const AccT& acc, const Unit& u, int wr, int wc, int fr, int fq, const LAS f32x2* tab) const {
        asm volatile("" : "+v"(fr), "+v"(fq));
        const bf16_t* pp = (const bf16_t*)(ws + WS_PP); bf16_t* xbn = (bf16_t*)(ws + WS_XBA); const bf16_t* xb = (const bf16_t*)(ws + WS_XBB); float* ssx0 = (float*)(ws + WS_SSX0);
        f32x4 g4[2][2];
_Pragma("unroll")
        for (int bj = 0; bj < 2; ++bj)
_Pragma("unroll")
            for (int n = 0; n < 2; ++n) g4[bj][n] = *(const f32x4*)(gpo + u.pn * 256 + bj * 128 + wc * 32 + fq * 8 + n * 4);
        EPI_ROWS({ const f32x2 tt = tab[rl]; const float r2 = tt.x, rp = tt.y; float s = 0.f;
_Pragma("unroll")
            for (int bj = 0; bj < 2; ++bj) { const size_t off = (size_t)row * 1024 + u.pn * 256 + bj * 128 + wc * 32 + fq * 8;
                const u32x4 pw = *(const u32x4*)(pp + off); const f32x4 p0 = (f32x4){bflo(pw.x), bfhi(pw.x), bflo(pw.y), bfhi(pw.y)} * rp * g4[bj][0], p1 = (f32x4){bflo(pw.z), bfhi(pw.z), bflo(pw.w), bfhi(pw.w)} * rp * g4[bj][1];
                const u32x4 xw = *(const u32x4*)(xb + off); f32x4 v0 = (f32x4){bflo(xw.x), bfhi(xw.x), bflo(xw.y), bfhi(xw.y)}, v1 = (f32x4){bflo(xw.z), bfhi(xw.z), bflo(xw.w), bfhi(xw.w)};
_Pragma("unroll")
                for (int i = 0; i < 4; ++i) { v0[i] += p0[i] * __builtin_amdgcn_rcpf(1.f + __expf(-acc[ai][bj][m][0][i] * r2)); v1[i] += p1[i] * __builtin_amdgcn_rcpf(1.f + __expf(-acc[ai][bj][m][1][i] * r2)); }
                s += sum4sq(v0) + sum4sq(v1);
#ifdef DIAG_SEL
                if (xout) { const float dsc_ = 1.f + sqrtf(((const float*)(ws + WS_CTL))[250000 + DIAG_SEL] * DIAG_SCALE); v0 *= dsc_; v1 *= dsc_; }
#endif
                if (xout) { *(f32x4*)(xout + off) = v0; *(f32x4*)(xout + off + 4) = v1; } else *(u32x4*)(xbn + off) = pack8(v0, v1); }
            s = red_fq(s); if (fq == 0 && !xout) ssx0[(size_t)row * 16 + u.pn * 4 + wc] = s; })
    }
};

struct EpiNull {
    static constexpr bool HAS_MID = false;
    float* sink;
    __device__ __forceinline__ void pre(const Unit&, LAS f32x2*, int) const {}
    __device__ __forceinline__ void mid(AccT&, const Unit&, int, int, int, int, const LAS f32x2*) const {}
    __device__ __forceinline__ void operator()(const AccT& acc, const Unit& u, int wr, int wc, int fr, int fq, const LAS f32x2* tab) const {
        f32x4 s = (f32x4){0.f, 0.f, 0.f, 0.f};
        EPI_ROWS({ s += (acc[ai][0][m][0] + acc[ai][0][m][1]) + (acc[ai][1][m][0] + acc[ai][1][m][1]); })
        if (s[0] + s[1] + s[2] + s[3] == 1.2345678e33f) sink[0] = s[0];
    }
};

namespace att {
constexpr int NS = 4, VSLOT = 8192;
template <bool FOX> struct Lay { static constexpr int KSLOT = FOX ? 8192 : 12288, L_K = 0, L_V = NS * KSLOT, L_WS = L_V + NS * VSLOT, L_G = L_WS + 2048, L_END = L_G + (FOX ? 32768 : 0), L_OST = 0; };
static_assert(Lay<true>::L_END <= 131072 && Lay<false>::L_END <= 131072 && NS * 8192 >= 32768, "attention LDS map");
constexpr float SKIP_NATS = 40.f;
typedef LAS const char* lds_cptr;
typedef short v4i16_t __attribute__((ext_vector_type(4)));

__device__ __forceinline__ void glds16(const void* gsrc, unsigned lds_dst) { unsigned keep;
    asm volatile("s_mov_b32 %0, m0\n\ts_mov_b32 m0, %2\n\ts_nop 0\n\tglobal_load_lds_dwordx4 %1, off\n\ts_mov_b32 m0, %0" : "=&s"(keep) : "v"(gsrc), "s"(lds_dst) : "memory"); }
__device__ __forceinline__ int crow(int r, int hi) { return (r & 3) + 8 * (r >> 2) + 4 * hi; }
__device__ __forceinline__ s16x4 vtr(lds_cptr p) { return __builtin_bit_cast(s16x4, __builtin_amdgcn_ds_read_tr16_b64_v4i16((LAS v4i16_t*)p)); }
__device__ __forceinline__ float swapmax(float m) { auto rr = __builtin_amdgcn_permlane32_swap(__float_as_uint(m), __float_as_uint(m), false, false); return fmaxf(__uint_as_float(rr[0]), __uint_as_float(rr[1])); }
__device__ __forceinline__ float swapsum(float m) { auto rr = __builtin_amdgcn_permlane32_swap(__float_as_uint(m), __float_as_uint(m), false, false); return __uint_as_float(rr[0]) + __uint_as_float(rr[1]); }
__device__ __forceinline__ bf16x8 pk8(const f32x16& p, int b) { u32x4 w; w.x = cvt_pk_bf16(p[b], p[b + 1]); w.y = cvt_pk_bf16(p[b + 2], p[b + 3]); w.z = cvt_pk_bf16(p[b + 4], p[b + 5]); w.w = cvt_pk_bf16(p[b + 6], p[b + 7]); return __builtin_bit_cast(bf16x8, w); }

struct Args {
    const bf16_t *Qraw, *Kmla, *Vmla, *Fq, *Fk, *Fv; const float *ssq_qn, *ssq_qr, *gmq, *cosT, *sinT, *F, *gfq, *gfk; bf16_t* o; float* sso;
};

#ifdef DIAG_SEL
#define STAMP(k) do { if (dg) { const unsigned long long t_ = __builtin_amdgcn_s_memrealtime(); dg[k] += (float)(t_ - tprev_) * 0.01f; tprev_ = t_; } } while (0)
#else
#define STAMP(k) do {} while (0)
#endif
template <bool FOX>
__device__ __forceinline__ void attn_unit(const Args& A, int b, int h, int qb, LAS char* shm, LAS float* dg) {
#ifdef DIAG_SEL
    unsigned long long tprev_ = __builtin_amdgcn_s_memrealtime();
#endif
    constexpr int DK = FOX ? 64 : 96, NQ = DK / 16, KP = FOX ? 512 : 768;
    constexpr int KSLOT = Lay<FOX>::KSLOT, L_K = Lay<FOX>::L_K, L_V = Lay<FOX>::L_V, L_WS = Lay<FOX>::L_WS, L_G = Lay<FOX>::L_G, L_OST = Lay<FOX>::L_OST;
    int tid_ = threadIdx.x; asm volatile("" : "+v"(tid_));
    const int tid = tid_, lane = tid & 63, r32 = lane & 31, hi = lane >> 5; const int wid = __builtin_amdgcn_readfirstlane(tid >> 6);
    const long rowbase = (long)b * SEQ; const int q0 = qb * 256, qw = q0 + wid * 32;
    const unsigned lds0 = (unsigned)(uintptr_t)shm;
    LAS float* wsf = (LAS float*)(shm + L_WS) + wid * 64;
    LAS float* Gl = (LAS float*)(shm + L_G);
    const int NT = (q0 + 256) / 64; const int tw_last = qw >> 6;
    int t0 = 0;
    if constexpr (FOX) {
        float gq = fmaxf(fabsf(A.gfq[lane]), 0.f), gk = fabsf(A.gfk[lane]);
#pragma unroll
        for (int o = 32; o > 0; o >>= 1) { gq = fmaxf(gq, __shfl_xor(gq, o)); gk = fmaxf(gk, __shfl_xor(gk, o)); }
        const float margin = 2.f * (8.f * gq * gk) + SKIP_NATS;
        const float Fref = A.F[(rowbase + q0) * 8 + h];
        const int nfull = q0 / 64;
        bool keep0 = true, keep1 = true;
        if (lane < nfull) keep0 = (Fref - A.F[(rowbase + 64 * lane + 63) * 8 + h]) >= -margin;
        if (lane + 64 < nfull) keep1 = (Fref - A.F[(rowbase + 64 * (lane + 64) + 63) * 8 + h]) >= -margin;
        const unsigned long long k0 = __ballot(keep0), k1 = __ballot(keep1);
        t0 = k0 ? __builtin_ctzll(k0) : 64 + (k1 ? __builtin_ctzll(k1) : 0);
        t0 = __builtin_amdgcn_readfirstlane(t0);
        const int nk = q0 + 256 - 64 * t0;
        for (int j = tid; j < nk; j += 512) Gl[j] = (Fref - A.F[(rowbase + 64 * t0 + j) * 8 + h]) * LOG2E;
    }
    const bf16_t* Kg = (FOX ? A.Fk : A.Kmla) + (long)(b * 8 + h) * 128 * (KSLOT / 2) + wid * 512 + lane * 8;
    const bf16_t* Vg = (FOX ? A.Fv : A.Vmla) + (long)(b * 8 + h) * 128 * 4096 + wid * 512 + lane * 8;
    const unsigned kdst = lds0 + L_K + wid * 1024, vdst = lds0 + L_V + wid * 1024;
    const bool k2 = (!FOX) && wid < 4;
#define ISSUE_K(t, sl) do { glds16(Kg + (long)(t) * (KSLOT / 2), (unsigned)__builtin_amdgcn_readfirstlane(kdst + (sl) * KSLOT)); \
        if (k2) glds16(Kg + (long)(t) * (KSLOT / 2) + 4096, (unsigned)__builtin_amdgcn_readfirstlane(kdst + (sl) * KSLOT + 8192)); } while (0)
#define ISSUE_V(t, sl) glds16(Vg + (long)(t) * 4096, (unsigned)__builtin_amdgcn_readfirstlane(vdst + (sl) * VSLOT))
    const int nti = NT - t0;
    ISSUE_K(t0, 0); ISSUE_K(t0 + 1, 1); ISSUE_K(t0 + 2, 2); ISSUE_V(t0, 0); ISSUE_K(t0 + 3, 3); ISSUE_V(t0 + 1, 1);
    bf16x8 qr[NQ];
    {
        const long row = rowbase + qw + r32;
        if constexpr (FOX) {
#pragma unroll
            for (int d0 = 0; d0 < NQ; ++d0) qr[d0] = *(const bf16x8*)(A.Fq + row * 512 + h * 64 + d0 * 16 + hi * 8);
        } else {
            const float ss = A.ssq_qn[row * 8 + h] + A.ssq_qr[row * 8 + h]; const float sc = rsqrtf(ss * (1.f / 96.f) + EPS) * C2_MLA;
            f32x4 qa[NQ][2];
#pragma unroll
            for (int d0 = 0; d0 < NQ; ++d0) { const u32x4 w = *(const u32x4*)(A.Qraw + row * 768 + h * 96 + d0 * 16 + hi * 8);
                const f32x4 g0 = *(const f32x4*)(A.gmq + d0 * 16 + hi * 8), g1 = *(const f32x4*)(A.gmq + d0 * 16 + hi * 8 + 4);
                qa[d0][0] = (f32x4){bflo(w.x), bfhi(w.x), bflo(w.y), bfhi(w.y)} * sc * g0; qa[d0][1] = (f32x4){bflo(w.z), bfhi(w.z), bflo(w.w), bfhi(w.w)} * sc * g1; }
#pragma unroll
            for (int e = 0; e < 2; ++e) { const f32x4 c = *(const f32x4*)(A.cosT + row * 16 + hi * 8 + e * 4), s = *(const f32x4*)(A.sinT + row * 16 + hi * 8 + e * 4);
                const f32x4 x1 = qa[4][e], x2 = qa[5][e]; qa[4][e] = x1 * c - x2 * s; qa[5][e] = x2 * c + x1 * s; }
#pragma unroll
            for (int d0 = 0; d0 < NQ; ++d0) qr[d0] = __builtin_bit_cast(bf16x8, pack8(qa[d0][0], qa[d0][1]));
        }
    }
    constexpr float THR = 8.f;
    float mhat = 0.f, lrun = 0.f; f32x16 o[2]; o[0] = f32x16{}; o[1] = f32x16{};
    const lds_cptr shm3 = (lds_cptr)shm;
    const lds_cptr kp0 = shm3 + L_K + hi * 1024 + r32 * 16;
    const lds_cptr vp0 = shm3 + L_V + ((lane >> 4) & 1) * 32 + (lane & 3) * 8 + (4 * hi + ((lane & 15) >> 2)) * 64;
    bf16x8 pa0, pa1, pa2, pa3; f32x16 pp0, pp1, c0, c1; bf16x8 kf[2 * NQ]; s16x4 vlo[8], vhi[8];
    const int nK = k2 ? 2 : 1;
#define WV_(k) case k: asm volatile("s_waitcnt vmcnt(" #k ")" ::: "memory"); break;
#define WAITV(n) do { switch (n) { WV_(0) WV_(1) WV_(2) WV_(3) WV_(4) WV_(5) default: asm volatile("s_waitcnt vmcnt(6)" ::: "memory"); break; } } while (0)
#define LBAR() asm volatile("s_waitcnt lgkmcnt(0)\n\ts_barrier" ::: "memory")
#define SGB(mask, n) __builtin_amdgcn_sched_group_barrier(mask, n, 0)
#define SFENCE() __builtin_amdgcn_sched_barrier(0)
#define KREAD(rel) { const lds_cptr kp = kp0 + ((rel) % NS) * KSLOT; \
        _Pragma("unroll") for (int d0 = 0; d0 < NQ; ++d0) { kf[2 * d0] = *(const LAS bf16x8*)(kp + d0 * 2048); kf[2 * d0 + 1] = *(const LAS bf16x8*)(kp + d0 * 2048 + 512); } }
#define VREAD(rel) { const lds_cptr vp = vp0 + ((rel) % NS) * VSLOT; \
        _Pragma("unroll") for (int i = 0; i < 8; ++i) { vlo[i] = vtr(vp + (i >> 2) * 4096 + (i & 3) * 1024); vhi[i] = vtr(vp + (i >> 2) * 4096 + (i & 3) * 1024 + 512); } }
#define PKV(k) (bf16x8){vlo[k][0], vlo[k][1], vlo[k][2], vlo[k][3], vhi[k][0], vhi[k][1], vhi[k][2], vhi[k][3]}
#define QKMM(rel) do { const float cb = (t0 + (rel) > tw_last) ? -INFINITY : -mhat; \
        _Pragma("unroll") for (int r = 0; r < 16; ++r) { c0[r] = cb; c1[r] = cb; } \
        _Pragma("unroll") for (int d0 = 0; d0 < NQ; ++d0) { c0 = __builtin_amdgcn_mfma_f32_32x32x16_bf16(kf[2 * d0], qr[d0], c0, 0, 0, 0); c1 = __builtin_amdgcn_mfma_f32_32x32x16_bf16(kf[2 * d0 + 1], qr[d0], c1, 0, 0, 0); } } while (0)
#define PVMM() do { \
        o[0] = __builtin_amdgcn_mfma_f32_32x32x16_bf16(pa0, PKV(0), o[0], 0, 0, 0); o[1] = __builtin_amdgcn_mfma_f32_32x32x16_bf16(pa0, PKV(4), o[1], 0, 0, 0); \
        o[0] = __builtin_amdgcn_mfma_f32_32x32x16_bf16(pa1, PKV(1), o[0], 0, 0, 0); o[1] = __builtin_amdgcn_mfma_f32_32x32x16_bf16(pa1, PKV(5), o[1], 0, 0, 0); \
        o[0] = __builtin_amdgcn_mfma_f32_32x32x16_bf16(pa2, PKV(2), o[0], 0, 0, 0); o[1] = __builtin_amdgcn_mfma_f32_32x32x16_bf16(pa2, PKV(6), o[1], 0, 0, 0); \
        o[0] = __builtin_amdgcn_mfma_f32_32x32x16_bf16(pa3, PKV(3), o[0], 0, 0, 0); o[1] = __builtin_amdgcn_mfma_f32_32x32x16_bf16(pa3, PKV(7), o[1], 0, 0, 0); } while (0)
#define SUMPACK() do { float sa = pp0[0] + pp0[1], sb = pp1[0] + pp1[1]; \
        _Pragma("unroll") for (int r = 2; r < 16; r += 2) { sa += pp0[r] + pp0[r + 1]; sb += pp1[r] + pp1[r + 1]; } \
        lrun += sa + sb; pa0 = pk8(pp0, 0); pa1 = pk8(pp0, 8); pa2 = pk8(pp1, 0); pa3 = pk8(pp1, 8); } while (0)
#define MX3(a, b, c) __builtin_fmaxf(__builtin_fmaxf((a), (b)), (c))
#define BIASMASK(rel) do { if constexpr (FOX) { const int tt_ = t0 + (rel); const LAS float* Gt = Gl + (rel) * 64 + 4 * hi; \
            _Pragma("unroll") for (int rq = 0; rq < 4; ++rq) { const f32x4 ga = *(const LAS f32x4*)(Gt + 8 * rq), gb = *(const LAS f32x4*)(Gt + 32 + 8 * rq); \
                _Pragma("unroll") for (int i = 0; i < 4; ++i) { c0[4 * rq + i] += ga[i]; c1[4 * rq + i] += gb[i]; } } \
            if (64 * tt_ + 63 > qw) { const int qrel = qw + r32 - 64 * tt_; \
                _Pragma("unroll") for (int r = 0; r < 16; ++r) { const int kv = crow(r, hi); c0[r] = kv > qrel ? -INFINITY : c0[r]; c1[r] = kv + 32 > qrel ? -INFINITY : c1[r]; } } } } while (0)
#define ROWMAX(dst) do { float ma = MX3(c0[0], c0[1], c1[0]), mb = MX3(c0[2], c0[3], c1[1]); ma = MX3(ma, c1[2], c1[3]); \
        _Pragma("unroll") for (int r = 4; r < 16; r += 4) { ma = MX3(ma, c0[r], c0[r + 1]); mb = MX3(mb, c0[r + 2], c0[r + 3]); ma = MX3(ma, c1[r], c1[r + 1]); mb = MX3(mb, c1[r + 2], c1[r + 3]); } \
        dst = swapmax(fmaxf(ma, mb)); } while (0)
    WAITV(2 * nK + 2);
    LBAR();
    ISSUE_V(t0 + 2, 2);
    KREAD(0); SFENCE();
    QKMM(0);
    BIASMASK(0);
    { float rm; ROWMAX(rm); mhat = rm;
#pragma unroll
        for (int r = 0; r < 16; ++r) { pp0[r] = __builtin_amdgcn_exp2f(c0[r] - rm); pp1[r] = __builtin_amdgcn_exp2f(c1[r] - rm); } }
    KREAD(1);
    WAITV(nK + 2);
    LBAR();
#pragma unroll 1
    for (int t = 1; t < nti; ++t) {
        if (t == 1 && 4 < nti) ISSUE_K(t0 + 4, 0);
        if (t + 4 < nti) ISSUE_K(t0 + t + 4, t % NS);
        if (t + 2 < nti) ISSUE_V(t0 + t + 2, (t + 2) % NS);
        SFENCE();
        QKMM(t); VREAD(t - 1); SUMPACK();
        if constexpr (FOX) { SGB(0x008, 1); SGB(0x100, 2); SGB(0x002, 6); SGB(0x008, 1); SGB(0x100, 2); SGB(0x002, 6); SGB(0x008, 1); SGB(0x100, 2); SGB(0x002, 6); SGB(0x008, 1); SGB(0x100, 2); SGB(0x002, 6);
                             SGB(0x008, 1); SGB(0x100, 2); SGB(0x002, 6); SGB(0x008, 1); SGB(0x100, 2); SGB(0x002, 6); SGB(0x008, 1); SGB(0x100, 2); SGB(0x002, 6); SGB(0x008, 1); SGB(0x100, 2); SGB(0x002, 6); }
        else { SGB(0x008, 1); SGB(0x100, 2); SGB(0x002, 4); SGB(0x008, 1); SGB(0x100, 2); SGB(0x002, 4); SGB(0x008, 1); SGB(0x100, 2); SGB(0x002, 4); SGB(0x008, 1); SGB(0x100, 2); SGB(0x002, 4);
               SGB(0x008, 1); SGB(0x100, 2); SGB(0x002, 4); SGB(0x008, 1); SGB(0x100, 2); SGB(0x002, 4); SGB(0x008, 1); SGB(0x100, 2); SGB(0x002, 4); SGB(0x008, 1); SGB(0x100, 2); SGB(0x002, 4);
               SGB(0x008, 1); SGB(0x002, 4); SGB(0x008, 1); SGB(0x002, 4); SGB(0x008, 1); SGB(0x002, 4); SGB(0x008, 1); SGB(0x002, 4); }
        SFENCE();
        BIASMASK(t);
        float rm; ROWMAX(rm);
        bool resc = false;
        if (__any(rm > THR)) { const float dl = fmaxf(rm, 0.f); mhat += dl;
#pragma unroll
            for (int r = 0; r < 16; ++r) { c0[r] -= dl; c1[r] -= dl; }
            const float f = __builtin_amdgcn_exp2f(-dl); lrun *= f; if (hi == 0) wsf[r32] = f; resc = true; }
        SFENCE();
        PVMM();
#pragma unroll
        for (int r = 0; r < 16; ++r) { pp0[r] = __builtin_amdgcn_exp2f(c0[r]); pp1[r] = __builtin_amdgcn_exp2f(c1[r]); }
        KREAD(t + 1);
        if constexpr (FOX) { SGB(0x008, 1); SGB(0x100, 1); SGB(0x002, 4); SGB(0x008, 1); SGB(0x100, 1); SGB(0x002, 4); SGB(0x008, 1); SGB(0x100, 1); SGB(0x002, 4); SGB(0x008, 1); SGB(0x100, 1); SGB(0x002, 4);
                             SGB(0x008, 1); SGB(0x100, 1); SGB(0x002, 4); SGB(0x008, 1); SGB(0x100, 1); SGB(0x002, 4); SGB(0x008, 1); SGB(0x100, 1); SGB(0x002, 4); SGB(0x008, 1); SGB(0x100, 1); SGB(0x002, 4); }
        else { SGB(0x008, 1); SGB(0x100, 2); SGB(0x002, 4); SGB(0x008, 1); SGB(0x100, 2); SGB(0x002, 4); SGB(0x008, 1); SGB(0x100, 2); SGB(0x002, 4); SGB(0x008, 1); SGB(0x100, 2); SGB(0x002, 4);
               SGB(0x008, 1); SGB(0x100, 1); SGB(0x002, 4); SGB(0x008, 1); SGB(0x100, 1); SGB(0x002, 4); SGB(0x008, 1); SGB(0x100, 1); SGB(0x002, 4); SGB(0x008, 1); SGB(0x100, 1); SGB(0x002, 4); }
        SFENCE();
        if (resc) { asm volatile("s_waitcnt lgkmcnt(0)" ::: "memory");
#pragma unroll
            for (int rq = 0; rq < 4; ++rq) { const f32x4 af = *(const LAS f32x4*)(wsf + 8 * rq + 4 * hi);
#pragma unroll
                for (int i = 0; i < 4; ++i) { o[0][4 * rq + i] *= af[i]; o[1][4 * rq + i] *= af[i]; } } }
        WAITV(((t + 3 < nti ? nK : 0) + (t + 1 < nti ? 1 : 0)) + ((t + 4 < nti ? nK : 0) + (t + 2 < nti ? 1 : 0)));
        LBAR();
    }
    VREAD(nti - 1); SUMPACK(); SFENCE(); PVMM();
#undef ISSUE_K
#undef ISSUE_V
#undef WAITV
#undef WV_
#undef LBAR
#undef SGB
#undef SFENCE
#undef KREAD
#undef VREAD
#undef PKV
#undef QKMM
#undef PVMM
#undef SUMPACK
#undef MX3
#undef BIASMASK
#undef ROWMAX
    STAMP(2);
    lrun = swapsum(lrun);
    if (hi == 0) wsf[32 + r32] = lrun;
    asm volatile("s_waitcnt lgkmcnt(0)" ::: "memory");
    float rli[16];
#pragma unroll
    for (int rq = 0; rq < 4; ++rq) { const f32x4 lf = *(const LAS f32x4*)(wsf + 32 + 8 * rq + 4 * hi);
#pragma unroll
        for (int i = 0; i < 4; ++i) rli[4 * rq + i] = __builtin_amdgcn_rcpf(lf[i]); }
    const int hh = FOX ? 8 + h : h;
    bf16_t* Ow = A.o + (rowbase + qw) * 1024 + hh * 64;
    LAS bf16_t* stg = (LAS bf16_t*)(shm + L_OST) + wid * 2048;
#pragma unroll
    for (int r = 0; r < 16; ++r) { const int orow = crow(r, hi);
#pragma unroll
        for (int d0 = 0; d0 < 2; ++d0) { const float v = o[d0][r] * rli[r]; stg[orow * 64 + d0 * 32 + r32] = (bf16_t)(cvt_pk_bf16(v, 0.f) & 0xffffu); } }
    asm volatile("s_waitcnt lgkmcnt(0)" ::: "memory");
#pragma unroll
    for (int i = 0; i < 4; ++i) { const int row = i * 8 + (lane >> 3), ch = lane & 7; const u32x4 v = *(const LAS u32x4*)(stg + row * 64 + ch * 8);
        *(u32x4*)(Ow + (long)row * 1024 + ch * 8) = v;
        float s = 0.f; { const float a0 = bflo(v.x), a1 = bfhi(v.x), a2 = bflo(v.y), a3 = bfhi(v.y), a4 = bflo(v.z), a5 = bfhi(v.z), a6 = bflo(v.w), a7 = bfhi(v.w);
            s = ((a0 * a0 + a1 * a1) + (a2 * a2 + a3 * a3)) + ((a4 * a4 + a5 * a5) + (a6 * a6 + a7 * a7)); }
        s += __shfl_xor(s, 1); s += __shfl_xor(s, 2); s += __shfl_xor(s, 4);
        if (ch == 0) A.sso[(rowbase + qw + row) * 16 + hh] = s; }
    asm volatile("s_waitcnt lgkmcnt(0)\n\ts_barrier" ::: "memory");
    STAMP(3);
#ifdef DIAG_SEL
    if (dg) dg[4] += (float)NT - (float)t0;
#endif
}

__device__ __forceinline__ void attn_phase(const Args& A, int vcu, int G, LAS char* shm, int repm, int repf, LAS float* dg) {
    for (int v = vcu; v < 256; v += G) {
        const int bh = v >> 3, s = v & 7;
#pragma unroll 1
        for (int i = 0; i < 4 * repm; ++i) { const int ii = i & 3; const int qb = (ii == 0) ? s : (ii == 1) ? 15 - s : (ii == 2) ? 16 + s : 31 - s; attn_unit<false>(A, bh >> 3, bh & 7, qb, shm, dg); }
#pragma unroll 1
        for (int i = 0; i < 4 * repf; ++i) { const int ii = i & 3; const int qb = (ii == 0) ? 31 - s : (ii == 1) ? 16 + s : (ii == 2) ? 15 - s : s; attn_unit<true>(A, bh >> 3, bh & 7, qb, shm, dg ? dg + 8 : dg); }
    }
}
}

constexpr int CW_TMO = 0, CW_BAR = 4096, CW_CNT = 200000;
constexpr int RING_BYTES = 131072, LDSCTL_OFF = RING_BYTES, LDS_BYTES = 147456;
constexpr int LC_MISC = 0, LC_PRE = 256, LC_CNT = 512;

typedef GAS unsigned gu32;
#define RLX_AGENT __ATOMIC_RELAXED, __HIP_MEMORY_SCOPE_AGENT

#define XB_TMO      128
#define XB_XCNT(j)  (256  + 64 * (j))
#define XB_XSUB(j)  (1280 + 64 * (j))
#define XB_XGEN(j)  (2304 + 64 * (j))
#define XB_TOP      3328
#define XB_TOPGEN   3392
#define XCD_BAR_WORDS 3456
#define XB_SPIN_CAP (1u << 18)
__device__ __forceinline__ unsigned xb_ld(unsigned* p)              { return __hip_atomic_load(p, __ATOMIC_RELAXED, __HIP_MEMORY_SCOPE_AGENT); }
__device__ __forceinline__ unsigned xb_add(unsigned* p, unsigned v) { return __hip_atomic_fetch_add(p, v, __ATOMIC_RELAXED, __HIP_MEMORY_SCOPE_AGENT); }
__device__ __forceinline__ unsigned xb_xcc_id() { return (unsigned)__builtin_amdgcn_s_getreg((3 << 11) | 20) & 0xFu; }
#define XB_SPIN(cond, bar) do { unsigned _sp = 0; while (cond) { __builtin_amdgcn_s_sleep(1); \
    if ((++_sp & 255u) == 0u) { if (xb_ld(&(bar)[XB_TMO])) break; if (_sp > XB_SPIN_CAP) { atomicAdd(&(bar)[XB_TMO], 1u); break; } } } } while (0)
struct XcdBarrier { unsigned* bar; unsigned x; volatile LAS unsigned* st; };
__device__ __forceinline__ XcdBarrier xcd_barrier_post(unsigned* bar, volatile LAS unsigned* st) {
    XcdBarrier b; b.bar = bar; b.x = xb_xcc_id(); b.st = st;
    if (threadIdx.x == 0) (void)xb_add(&bar[XB_XCNT(b.x)], 1u);
    return b;
}
__device__ __forceinline__ void xcd_barrier_complete(unsigned* bar, unsigned x, unsigned& nloc, unsigned& nx) {
    const unsigned G = gridDim.x * gridDim.y * gridDim.z;
    unsigned sum, cnt, mine, sp = 0u;
    for (;;) {
        sum = 0u; cnt = 0u; mine = 0u;
#pragma unroll
        for (unsigned j = 0; j < 16; ++j) { const unsigned c = xb_ld(&bar[XB_XCNT(j)]); sum += c; cnt += (c > 0u) ? 1u : 0u; mine = (j == x) ? c : mine; }
        if (sum == G) break;
        __builtin_amdgcn_s_sleep(1);
        if ((++sp & 255u) == 0u) { if (xb_ld(&bar[XB_TMO])) break; if (sp > XB_SPIN_CAP) { atomicAdd(&bar[XB_TMO], 1u); break; } }
    }
    nloc = mine > 0u ? mine : 1u; nx = cnt > 0u ? cnt : 1u;
}
__device__ __forceinline__ void xcd_barrier(const XcdBarrier& b) {
    asm volatile("s_waitcnt vmcnt(0)" ::: "memory");
    __syncthreads();
    if (threadIdx.x == 0) {
        unsigned* bar = b.bar;
        __builtin_amdgcn_s_waitcnt(0);
        unsigned nloc = b.st[0], nx = b.st[1];
        if (nloc == 0u) { xcd_barrier_complete(bar, b.x, nloc, nx); b.st[0] = nloc; b.st[1] = nx; }
        const unsigned old = xb_add(&bar[XB_XSUB(b.x)], 1u);
        const unsigned gen = old / nloc;
        if (old + 1u == (gen + 1u) * nloc) {
            __builtin_amdgcn_fence(__ATOMIC_RELEASE, "agent");
            asm volatile("s_waitcnt vmcnt(0)" ::: "memory");
            const unsigned og = xb_add(&bar[XB_TOP], 1u);
            const unsigned tg = og / nx;
            if (og + 1u == (tg + 1u) * nx) xb_add(&bar[XB_TOPGEN], 1u);
            else XB_SPIN(xb_ld(&bar[XB_TOPGEN]) == tg, bar);
            __builtin_amdgcn_fence(__ATOMIC_ACQUIRE, "agent");
            xb_add(&bar[XB_XGEN(b.x)], 1u);
            asm volatile("s_waitcnt vmcnt(0)" ::: "memory");
        } else {
            XB_SPIN(xb_ld(&bar[XB_XGEN(b.x)]) == gen, bar);
            __builtin_amdgcn_fence(__ATOMIC_ACQUIRE, "agent");
            asm volatile("s_waitcnt vmcnt(0)" ::: "memory");
        }
    }
    __syncthreads();
}

__device__ __forceinline__ float wave_sum(float v) {
#pragma unroll
    for (int o = 1; o < 64; o <<= 1) v += __shfl_xor(v, o);
    return v;
}
#define LDS_WAIT() asm volatile("s_waitcnt lgkmcnt(0)" ::: "memory")

__device__ __forceinline__ int maprow(int kind, int n) {
    switch (kind) {
    default: return n;
    case 1: {
        if (n < 256) return n;
        if (n < 384) { const int j = n - 256, q = j >> 5, c = j & 31; return 256 + (q & 1) * 128 + (q >> 1) * 32 + c; }
        if (n < 416) return 256 + 64 + (n - 384);
        if (n < 1952) { const int f = n - 416, k3 = f >> 9, r = f & 511, hd = r >> 6, d = r & 63; return (2 + 2 * k3 + (hd >> 2)) * 256 + (d >> 5) * 128 + (hd & 3) * 32 + (d & 31); }
        return 256 + 96 + (n - 1952); }
    case 2: { const int hd = n / 96, dd = n - hd * 96; if (dd < 64) return (hd >> 2) * 256 + (dd >> 5) * 128 + (hd & 3) * 32 + (dd & 31); return 512 + (hd >> 2) * 128 + (hd & 3) * 32 + (dd - 64); }
    case 3: { const int hd = n >> 7, dd = n & 127; if (dd < 64) return (hd >> 2) * 256 + (dd >> 5) * 128 + (hd & 3) * 32 + (dd & 31); const int d = dd - 64; return 512 + (hd >> 2) * 256 + (d >> 5) * 128 + (hd & 3) * 32 + (d & 31); }
    case 4: return (n >> 7) * 256 + (n & 127);
    case 5: return (n >> 7) * 256 + 128 + (n & 127);
    case 6: return 128 + n;
    }
}
__device__ __forceinline__ void conv_item(const float* W, int K, int Nsrc, bf16_t* WT, int kind, const float* s1, const float* s2, int split, LAS float* scr, int item, int lane) {
    const int nblk = (Nsrc + 31) / 32, kb = item / nblk, nb = item - kb * nblk, k0 = 64 * kb, n0 = 32 * nb;
    const bool nv = n0 + (lane & 31) < Nsrc;
#pragma unroll 8
    for (int i = 0; i < 32; ++i) { const int kk = 2 * i + (lane >> 5); scr[kk * 33 + (lane & 31)] = nv ? W[(size_t)(k0 + kk) * Nsrc + n0 + (lane & 31)] : 0.f; }
    LDS_WAIT(); asm volatile("" ::: "memory");
    const int c = lane & 7;
    float sc[8];
#pragma unroll
    for (int e = 0; e < 8; ++e) { const int k = k0 + 8 * c + e; sc[e] = s1 ? (k < split ? s1[k] : s2[k - split]) : 1.f; }
#pragma unroll
    for (int j = 0; j < 4; ++j) { const int n = (lane >> 3) + 8 * j; const LAS float* s = scr + (8 * c) * 33 + n;
        if (n0 + n < Nsrc) { u32x4 o; o.x = cvt_pk_bf16(s[0 * 33] * sc[0], s[1 * 33] * sc[1]); o.y = cvt_pk_bf16(s[2 * 33] * sc[2], s[3 * 33] * sc[3]); o.z = cvt_pk_bf16(s[4 * 33] * sc[4], s[5 * 33] * sc[5]); o.w = cvt_pk_bf16(s[6 * 33] * sc[6], s[7 * 33] * sc[7]);
            *(u32x4*)(WT + (size_t)maprow(kind, n0 + n) * K + k0 + 8 * c) = o; } }
    LDS_WAIT(); asm volatile("" ::: "memory");
}

struct KArgs { const void* in[27]; float* out; unsigned char* ws; int ph_lo, ph_hi, li, pad; };

constexpr int I_IN = 16 * 62, I_UQ = 4 * 24, I_UKV = 2 * 32, I_OUT = 16 * 32, I_RE = 16, I_RG = 16, I_GU = NEXP * 2 * 16 * 8, I_DN = NEXP * 4 * 32, I_PG = 16 * 32, I_PP = 4 * 32;
constexpr int I_LAYER = I_IN + I_UQ + I_UKV + I_OUT + I_RE + I_RG + I_GU + I_DN + I_PG + I_PP;

struct MoeOrder {
    const LAS int* pre; const LAS unsigned* cntl; const int* list; int npn, G, c; bool gather;
    __device__ __forceinline__ bool next(int i, Unit& u) const {
        const int L = i * G + c; const int TB = pre[32]; if (L >= TB * npn) return false;
        const int bg = L / npn, pl = L - bg * npn; int e = 0;
        for (int j = 1; j < 32; ++j) e += (pre[j] <= bg) ? 1 : 0;
        u.pm = bg; u.e = e; u.blk = bg - pre[e]; u.pn = e * npn + pl; return true;
    }
    __device__ __forceinline__ int arow(const Unit& u, int r) const {
        if (!gather) return u.pm * 256 + r;
        int li = u.blk * 256 + r; const int cn = (int)cntl[u.e]; li = li < cn ? li : cn - 1;
        return list[(size_t)u.e * NTOK + li] >> 1;
    }
};

#ifndef MK_CUTS
#define MK_CUTS {0, 19}
#endif
constexpr int NPHASE = 19;

__global__ void __launch_bounds__(NWAVES * 64, 2) mega_fwd(KArgs args) {
    extern __shared__ __attribute__((aligned(16))) unsigned char lds_raw[];
    LAS unsigned char* lds0 = (LAS unsigned char*)lds_raw;
    volatile LAS unsigned* MISC = (volatile LAS unsigned*)(lds0 + LDSCTL_OFF + LC_MISC);
    const int G = gridDim.x; const int bx = blockIdx.x; const int vcu = (G % 8 == 0) ? (bx % 8) * (G / 8) + bx / 8 : bx;
    for (int u = threadIdx.x; u < (LDS_BYTES - LDSCTL_OFF) / 4; u += NWAVES * 64) ((LAS unsigned*)(lds0 + LDSCTL_OFF))[u] = 0u;
    __syncthreads();
    (void)xcd_barrier_post((unsigned*)(args.ws + WS_CTL) + CW_BAR + args.li * XCD_BAR_WORDS, MISC + 8);
    const int lo = args.ph_lo, hi = args.ph_hi;
#ifndef PH_MASK
#define PH_MASK 0x3ff
#endif
#define PHM(k) ((PH_MASK >> (k)) & 1)
#ifndef DUP_MASK
#define DUP_MASK 0
#endif
#define NREP(k) (((DUP_MASK >> (k)) & 1) ? 2 : 1)
#ifndef NULL_MASK
#define NULL_MASK 0
#endif
#define NULLP(k) ((NULL_MASK >> (k)) & 1)
#define IN(k) (lo <= (k) && (k) < hi)
#define SEAM(k) do { if (IN(k) && IN((k) + 1)) { XcdBarrier bar_; bar_.bar = (unsigned*)(args.ws + WS_CTL) + CW_BAR + args.li * XCD_BAR_WORDS; bar_.x = xb_xcc_id(); bar_.st = (volatile LAS unsigned*)(lds0 + LDSCTL_OFF + LC_MISC) + 8; xcd_barrier(bar_); } } while (0)
    const int NGW = G * NWAVES, NGT = G * 512;
#define ssx0 ((float*)(wsp + WS_SSX0))
#define ssx1 ((float*)(wsp + WS_SSX1))
#define sspp ((float*)(wsp + WS_SSPP))
#define sso ((float*)(wsp + WS_SSO))
#define ssx2 ((float*)(wsp + WS_SSX2))
#define sskpe ((float*)(wsp + WS_SSKPE))
#define ssqq ((float*)(wsp + WS_SSQQ))
#define ssqkv ((float*)(wsp + WS_SSQKV))
#define gate ((float*)(wsp + WS_GATE))
#define logf ((float*)(wsp + WS_LOGF))
#define Fc ((float*)(wsp + WS_F))
#define ssqn ((float*)(wsp + WS_SSQN))
#define ssqr ((float*)(wsp + WS_SSQR))
#define cosT ((float*)(wsp + WS_COS))
#define sinT ((float*)(wsp + WS_SIN))
#define list ((int*)(wsp + WS_LIST))
#define xbA ((bf16_t*)(wsp + WS_XBA))
#define xbB ((bf16_t*)(wsp + WS_XBB))
#define pbf ((bf16_t*)(wsp + WS_PBF))
#define Qc ((bf16_t*)(wsp + WS_QC))
#define Kvc ((bf16_t*)(wsp + WS_KVC))
#define Kpe ((bf16_t*)(wsp + WS_KPE))
#define Fq ((bf16_t*)(wsp + WS_FQ))
#define Fk ((bf16_t*)(wsp + WS_FK))
#define Fv ((bf16_t*)(wsp + WS_FV))
#define Kmla ((bf16_t*)(wsp + WS_KMLA))
#define Vmla ((bf16_t*)(wsp + WS_VMLA))
#define Qraw ((bf16_t*)(wsp + WS_QRAW))
#define ob ((bf16_t*)xo)
#define ppb ((bf16_t*)(wsp + WS_PP))
#define hid ((bf16_t*)(wsp + WS_HID))
#define c1 ((bf16_t*)(wsp + WS_C1))
#define ctl ((unsigned*)(wsp + WS_CTL))
#define Wl (wsp + WS_W + (size_t)L * W_LAYER)
#define PHASE_PTRS unsigned char* wsp = args.ws; asm volatile("" : "+s"(wsp)); const float* x_in = (const float*)args.in[0]; float* xo = args.out; (void)x_in; (void)xo; \
    int tid = threadIdx.x; asm volatile("" : "+v"(tid)); const int lane = tid & 63, wave = __builtin_amdgcn_readfirstlane(tid >> 6); (void)lane; (void)wave; \
    unsigned ldo_ = 0u; asm volatile("" : "+s"(ldo_)); LAS unsigned char* lds = lds0 + ldo_; LAS int* preL = (LAS int*)(lds + LDSCTL_OFF + LC_PRE); LAS unsigned* cntL = (LAS unsigned*)(lds + LDSCTL_OFF + LC_CNT); (void)preL; (void)cntL; \
    const int gw = vcu * NWAVES + wave, gt = vcu * 512 + tid; (void)gw; (void)gt
#define INF(i) ((const float*)args.in[i])

    if (PHM(0) && IN(0)) {
        PHASE_PTRS; unsigned char* ws = wsp;
        LAS float* scr = (LAS float*)(lds + wave * 16384);
        for (int rep_ = 0; rep_ < NREP(0); ++rep_) {
        for (int it = gw; it < 2 * I_LAYER; it += NGW) {
            const int L = it >= I_LAYER ? 1 : 0; int r = it - L * I_LAYER;
            if (r < I_IN) { conv_item(INF(4) + (size_t)L * DM * INC, DM, INC, (bf16_t*)(Wl + WO_IN), 1, INF(3) + L * DM, nullptr, DM, scr, r, lane); continue; } r -= I_IN;
            if (r < I_UQ) { conv_item(INF(6) + (size_t)L * 256 * 768, 256, 768, (bf16_t*)(Wl + WO_UQ), 2, INF(5) + L * 256, nullptr, 256, scr, r, lane); continue; } r -= I_UQ;
            if (r < I_UKV) { conv_item(INF(8) + (size_t)L * 128 * 1024, 128, 1024, (bf16_t*)(Wl + WO_UKV), 3, INF(7) + L * 128, nullptr, 128, scr, r, lane); continue; } r -= I_UKV;
            if (r < I_OUT) { conv_item(INF(16) + (size_t)L * DM * DM, DM, DM, (bf16_t*)(Wl + WO_OUT), 0, INF(14) + L * 512, INF(15) + L * 512, 512, scr, r, lane); continue; } r -= I_OUT;
            if (r < I_RE) { conv_item(INF(19) + (size_t)L * DM * 32, DM, 32, (bf16_t*)(Wl + WO_RT), 0, INF(17) + L * DM, nullptr, DM, scr, r, lane); continue; } r -= I_RE;
            if (r < I_RG) { conv_item(INF(18) + (size_t)L * DM * 4, DM, 4, (bf16_t*)(Wl + WO_RT), 6, INF(17) + L * DM, nullptr, DM, scr, r, lane); continue; } r -= I_RG;
            if (r < I_GU) { const int e = r >> 8, mt = (r >> 7) & 1, ii = r & 127;
                conv_item(INF(mt ? 21 : 20) + ((size_t)L * NEXP + e) * DM * 256, DM, 256, (bf16_t*)(Wl + WO_GU) + (size_t)e * 512 * DM, mt ? 5 : 4, INF(17) + L * DM, nullptr, DM, scr, ii, lane); continue; } r -= I_GU;
            if (r < I_DN) { const int e = r >> 7, ii = r & 127;
                conv_item(INF(22) + ((size_t)L * NEXP + e) * 256 * DM, 256, DM, (bf16_t*)(Wl + WO_DN) + (size_t)e * DM * 256, 0, nullptr, nullptr, 0, scr, ii, lane); continue; } r -= I_DN;
            if (r < I_PG) { conv_item(INF(24) + (size_t)L * DM * DM, DM, DM, (bf16_t*)(Wl + WO_PG), 0, INF(23) + L * DM, nullptr, DM, scr, r, lane); continue; } r -= I_PG;
            conv_item(INF(25) + (size_t)L * 256 * DM, 256, DM, (bf16_t*)(Wl + WO_PP), 0, nullptr, nullptr, 0, scr, r, lane);
        }
        for (int it = gw; it < 2 * (88 + 220); it += NGW) {
            const int L = it >= 308 ? 1 : 0; int r = it - L * 308; bf16_t* dst;
            if (r < 88) { const int lr = r < 24 ? 104 + r : 192 + (r - 24); dst = (bf16_t*)(Wl + WO_IN) + (size_t)(256 + lr) * DM; }
            else { r -= 88; const int lr = r < 96 ? 32 + r : 132 + (r - 96); dst = (bf16_t*)(Wl + WO_RT) + (size_t)lr * DM; }
            *(u32x4*)(dst + lane * 8) = (u32x4){0u, 0u, 0u, 0u}; *(u32x4*)(dst + 512 + lane * 8) = (u32x4){0u, 0u, 0u, 0u};
        }
        for (int m = gw; m < NTOK; m += NGW) { const f32x4* xr = (const f32x4*)(x_in + (size_t)m * DM) + lane; float s = 0.f; u32x2* o8 = (u32x2*)(xbA + (size_t)m * DM) + lane;
#pragma unroll
            for (int j = 0; j < 4; ++j) { const f32x4 v = xr[64 * j]; s += sum4sq(v); u32x2 w; w.x = cvt_pk_bf16(v[0], v[1]); w.y = cvt_pk_bf16(v[2], v[3]); o8[64 * j] = w; }
            s = wave_sum(s); if (lane < 16) ssx0[(size_t)m * 16 + lane] = lane == 0 ? s : 0.f; }
        for (size_t i = gt; i < (size_t)DEPTH * NTOK * 256 / 8; i += NGT) { const f32x4 a = ((const f32x4*)INF(1))[2 * i], b = ((const f32x4*)INF(1))[2 * i + 1]; ((u32x4*)pbf)[i] = pack8(a, b); }
        for (int i = gt; i < NTOK * 16; i += NGT) { const int t = i >> 4, j = i & 15; const double inv = exp2(-(double)j * (13.287712379549449 / 16.0)); const double ang = (double)((const int*)args.in[2])[t] * inv;
            cosT[i] = (float)cos(ang); sinT[i] = (float)sin(ang); }
        }
    }
    SEAM(0);

#pragma unroll 1
    for (int L = 0; L < DEPTH; ++L) {
        const int pb = 1 + 9 * L;
        if (PHM(1) && IN(pb + 0)) {
            PHASE_PTRS;
            pg8::Gemm g{xbA, (const bf16_t*)(Wl + WO_IN), DM}; pg8::StaticOrder S; S.init(NTOK, 2048, G, bx);
            EpiInProj E{wsp, INF(13) + L * 8, INF(11) + L * 64, INF(12) + L * 64};
            for (int rep_ = 0; rep_ < NREP(1); ++rep_) pg8::gemm_phase<DM, EpiInProj, pg8::StaticOrder, true>(lds, g, S, E);
            if (NULLP(1)) { EpiNull EN{(float*)(wsp + WS_SSX2)}; pg8::gemm_phase<DM, EpiNull, pg8::StaticOrder, true>(lds, g, S, EN); }
        }
        SEAM(pb + 0);
        if (PHM(2) && IN(pb + 1)) {
            PHASE_PTRS;
            { pg8::Gemm g{Qc, (const bf16_t*)(Wl + WO_UQ), 256}; pg8::StaticOrder S; S.init(NTOK, 768, G, bx);
              EpiQUp E{wsp};
              for (int rep_ = 0; rep_ < NREP(2); ++rep_) pg8::gemm_phase<256, EpiQUp, pg8::StaticOrder, true>(lds, g, S, E); }
            { pg8::Gemm g{Kvc, (const bf16_t*)(Wl + WO_UKV), 128}; pg8::StaticOrder S; S.init(NTOK, 1024, G, bx);
              EpiKvUp E{wsp, INF(10) + L * 96};
              for (int rep_ = 0; rep_ < NREP(2); ++rep_) pg8::gemm_phase<128, EpiKvUp, pg8::StaticOrder, true>(lds, g, S, E); }
            for (int v = vcu; v < 32; v += G) {
                const int b = v >> 3, h = v & 7; LAS double* wt = (LAS double*)lds;
                const size_t base = ((size_t)b * SEQ + wave * 1024 + lane * 16) * 8 + h; float lv[16]; double loc = 0.0;
#pragma unroll
                for (int i = 0; i < 16; ++i) { lv[i] = logf[base + (size_t)i * 8]; loc += (double)lv[i]; }
                double pre = loc;
#pragma unroll
                for (int o = 1; o < 64; o <<= 1) { const double n = __shfl_up(pre, o); if (lane >= o) pre += n; }
                if (lane == 63) wt[wave] = pre;
                LDS_WAIT(); __syncthreads();
                double run = pre - loc;
                for (int w = 0; w < wave; ++w) run += wt[w];
#pragma unroll
                for (int i = 0; i < 16; ++i) { run += (double)lv[i]; Fc[base + (size_t)i * 8] = (float)run; }
                __syncthreads();
            }
        }
        SEAM(pb + 1);
        if (PHM(3) && IN(pb + 2)) {
            PHASE_PTRS;
            att::Args A{Qraw, Kmla, Vmla, Fq, Fk, Fv, ssqn, ssqr, INF(9) + L * 96, cosT, sinT, Fc, INF(11) + L * 64, INF(12) + L * 64, ob, sso};
#ifdef DIAG_SEL
            LAS float* dg = (L == 0 && blockIdx.x == DIAG_BLOCK && tid == 0) ? (LAS float*)(lds0 + LDSCTL_OFF + 8192) : (LAS float*)nullptr;
            if (dg) for (int k = 0; k < 16; ++k) dg[k] = 0.f;
            att::attn_phase(A, vcu, G, (LAS char*)lds, NREP(10), NREP(11), dg);
            if (dg) { float* dw = (float*)(wsp + WS_CTL) + 250000; for (int k = 0; k < 16; ++k) dw[k] = dg[k]; }
#else
            att::attn_phase(A, vcu, G, (LAS char*)lds, NREP(10), NREP(11), (LAS float*)nullptr);
#endif
        }
        SEAM(pb + 2);
        if (PHM(4) && IN(pb + 3)) {
            PHASE_PTRS;
            pg8::Gemm g{ob, (const bf16_t*)(Wl + WO_OUT), DM}; pg8::StaticOrder S; S.init(NTOK, DM, G, bx);
            EpiOut E{wsp, L == 0 ? x_in : (const float*)nullptr};
            for (int rep_ = 0; rep_ < (L == 0 ? NREP(4) : 1); ++rep_) pg8::gemm_phase<DM, EpiOut, pg8::StaticOrder, true>(lds, g, S, E);
            if (NULLP(4)) { EpiNull EN{(float*)(wsp + WS_SSX2)}; pg8::gemm_phase<DM, EpiNull, pg8::StaticOrder, true>(lds, g, S, EN); }
        }
        SEAM(pb + 3);
        if (PHM(5) && IN(pb + 4)) {
            PHASE_PTRS;
            { pg8::Gemm g{xbB, (const bf16_t*)(Wl + WO_RT), DM}; pg8::StaticOrder S; S.init(NTOK, 256, G, bx);
              EpiRouter E{wsp, ctl + CW_CNT + 64 * L};
              pg8::gemm_phase<DM, EpiRouter, pg8::StaticOrder, true>(lds, g, S, E); }
            { pg8::Gemm g{pbf + (size_t)L * NTOK * 256, (const bf16_t*)(Wl + WO_PP), 256}; pg8::StaticOrder S; S.init(NTOK, DM, G, bx);
              EpiPP E{wsp};
              for (int rep_ = 0; rep_ < NREP(5); ++rep_) pg8::gemm_phase<256, EpiPP, pg8::StaticOrder, true>(lds, g, S, E); }
        }
        SEAM(pb + 4);
        if ((PHM(6) && IN(pb + 5)) || (PHM(7) && IN(pb + 6))) {
            PHASE_PTRS;
            if (tid < 32) { const unsigned c = __hip_atomic_load(ctl + CW_CNT + 64 * L + tid, RLX_AGENT); cntL[tid] = c; }
            LDS_WAIT(); __syncthreads();
            if (tid == 0) { int run = 0; for (int e = 0; e < 32; ++e) { preL[e] = run; run += ((int)cntL[e] + 255) >> 8; } preL[32] = run; }
            LDS_WAIT(); __syncthreads();
        }
        if (PHM(6) && IN(pb + 5)) {
            PHASE_PTRS;
            pg8::Gemm g{xbB, (const bf16_t*)(Wl + WO_GU), DM}; MoeOrder S{preL, cntL, list, 2, G, bx, true};
            EpiMoeUp E{wsp, cntL, 2};
            for (int rep_ = 0; rep_ < NREP(6); ++rep_) pg8::gemm_phase<DM, EpiMoeUp, MoeOrder, true>(lds, g, S, E);
        }
        SEAM(pb + 5);
        if (PHM(7) && IN(pb + 6)) {
            PHASE_PTRS;
            pg8::Gemm g{hid, (const bf16_t*)(Wl + WO_DN), 256}; MoeOrder S{preL, cntL, list, 4, G, bx, false};
            EpiMoeDown E{wsp, cntL, 4};
            pg8::gemm_phase<256, EpiMoeDown, MoeOrder, true>(lds, g, S, E);
        }
        SEAM(pb + 6);
        if (PHM(8) && IN(pb + 7)) {
            PHASE_PTRS;
            for (int m = gw; m < NTOK; m += NGW) { const u32x4* cr = (const u32x4*)(c1 + (size_t)m * DM) + lane; u32x4* xr = (u32x4*)(xbB + (size_t)m * DM) + lane; float s = 0.f;
#pragma unroll
                for (int j = 0; j < 2; ++j) { const u32x4 cw = cr[64 * j], xw = xr[64 * j];
                    const f32x4 v0 = (f32x4){bflo(xw.x), bfhi(xw.x), bflo(xw.y), bfhi(xw.y)} + (f32x4){bflo(cw.x), bfhi(cw.x), bflo(cw.y), bfhi(cw.y)}, v1 = (f32x4){bflo(xw.z), bfhi(xw.z), bflo(xw.w), bfhi(xw.w)} + (f32x4){bflo(cw.z), bfhi(cw.z), bflo(cw.w), bfhi(cw.w)};
                    s += sum4sq(v0) + sum4sq(v1); xr[64 * j] = pack8(v0, v1); }
                s = wave_sum(s); if (lane == 0) ssx2[m] = s; }
        }
        SEAM(pb + 7);
        if (PHM(9) && IN(pb + 8)) {
            PHASE_PTRS;
            pg8::Gemm g{xbB, (const bf16_t*)(Wl + WO_PG), DM}; pg8::StaticOrder S; S.init(NTOK, DM, G, bx);
            EpiPle E{wsp, INF(26) + L * DM, L + 1 == DEPTH ? xo : (float*)nullptr};
            pg8::gemm_phase<DM, EpiPle, pg8::StaticOrder, true>(lds, g, S, E);
        }
        if (L + 1 < DEPTH) SEAM(pb + 8);
    }
#undef IN
#undef SEAM
#undef INF
}

extern "C" void kernel_launch(void* const* d_in, const int* in_sizes, int n_in, void* d_out, int out_size, void* d_ws, size_t ws_size, hipStream_t stream) {
    static int grid = 0;
    if (grid == 0) {
        if (n_in != 27 || ws_size < WS_END) { fprintf(stderr, "kernel_launch: unexpected inputs (n_in %d, ws %zu)\n", n_in, ws_size); grid = -1; return; }
        int dev = 0, cus = 0, per_cu = 0;
        if (hipGetDevice(&dev) != hipSuccess || hipDeviceGetAttribute(&cus, hipDeviceAttributeMultiprocessorCount, dev) != hipSuccess) { grid = -1; return; }
        if (hipFuncSetAttribute((const void*)mega_fwd, hipFuncAttributeMaxDynamicSharedMemorySize, LDS_BYTES) != hipSuccess) { fprintf(stderr, "kernel_launch: hipFuncSetAttribute failed\n"); grid = -1; return; }
        if (hipOccupancyMaxActiveBlocksPerMultiprocessor(&per_cu, (const void*)mega_fwd, NWAVES * 64, LDS_BYTES) != hipSuccess || per_cu < 1) { fprintf(stderr, "kernel_launch: occupancy query says %d\n", per_cu); }
        (void)hipGetLastError();
        grid = cus;
    }
    if (grid < 0) return;
    if (hipMemsetAsync((char*)d_ws + WS_CTL, 0, CTL_ZERO_BYTES, stream) != hipSuccess) return;
    KArgs a{};
    for (int i = 0; i < 27; ++i) a.in[i] = d_in[i];
    a.out = (float*)d_out; a.ws = (unsigned char*)d_ws;
    const int cuts[] = MK_CUTS; const int nl = (int)(sizeof(cuts) / sizeof(int)) - 1;
    for (int li = 0; li < nl; ++li) {
        a.ph_lo = cuts[li]; a.ph_hi = cuts[li + 1]; a.li = li; a.pad = 0;
        hipLaunchKernelGGL(mega_fwd, dim3(grid), dim3(NWAVES * 64), LDS_BYTES, stream, a);
        if (hipPeekAtLastError() != hipSuccess) { fprintf(stderr, "kernel_launch: launch %d failed\n", li); break; }
    }
}
```

```cpp
#include <hip/hip_runtime.h>
#include <cstdio>
#include <cstdint>

#define LAS __attribute__((address_space(3)))
#define GAS __attribute__((address_space(1)))
typedef unsigned short bf16_t;
typedef short bf16x8 __attribute__((ext_vector_type(8)));
typedef short s16x4 __attribute__((ext_vector_type(4)));
typedef float f32x2 __attribute__((ext_vector_type(2)));
typedef float f32x4 __attribute__((ext_vector_type(4)));
typedef float f32x16 __attribute__((ext_vector_type(16)));
typedef unsigned u32x2 __attribute__((ext_vector_type(2)));
typedef unsigned u32x4 __attribute__((ext_vector_type(4)));

constexpr int DM = 1024, NB = 4, SEQ = 8192, NTOK = NB * SEQ, DEPTH = 2;
constexpr int INC = 1960, NEXP = 32;
constexpr int C_KVC = 256, C_KPE = 384, C_FQ = 416, C_FK = 928, C_FV = 1440, C_FL = 1952;
constexpr float EPS = 1e-6f;
constexpr float LOG2E = 1.4426950408889634f;
constexpr float C2_FOX = 0.125f * LOG2E;
constexpr float C2_MLA = 0.10206207261596575f * LOG2E;

__device__ __forceinline__ unsigned cvt_pk_bf16(float lo, float hi) { unsigned r; asm volatile("v_cvt_pk_bf16_f32 %0, %1, %2" : "=v"(r) : "v"(lo), "v"(hi)); return r; }
__device__ __forceinline__ float bf2f(unsigned short u) { return __uint_as_float((unsigned)u << 16); }
__device__ __forceinline__ float bflo(unsigned w) { return __uint_as_float(w << 16); }
__device__ __forceinline__ float bfhi(unsigned w) { return __uint_as_float(w & 0xffff0000u); }
__device__ __forceinline__ u32x4 pack8(const f32x4& a, const f32x4& b) { u32x4 w; w.x = cvt_pk_bf16(a[0], a[1]); w.y = cvt_pk_bf16(a[2], a[3]); w.z = cvt_pk_bf16(b[0], b[1]); w.w = cvt_pk_bf16(b[2], b[3]); return w; }
__device__ __forceinline__ float sum4sq(const f32x4& a) { return (a[0] * a[0] + a[1] * a[1]) + (a[2] * a[2] + a[3] * a[3]); }
__device__ __forceinline__ float red_fq(float s) { s += __shfl_xor(s, 16); s += __shfl_xor(s, 32); return s; }
__device__ __forceinline__ float sum16(const float* p) { const f32x4 a = *(const f32x4*)p, b = *(const f32x4*)(p + 4), c = *(const f32x4*)(p + 8), d = *(const f32x4*)(p + 12);
    return ((a[0] + a[1]) + (a[2] + a[3])) + ((b[0] + b[1]) + (b[2] + b[3])) + ((c[0] + c[1]) + (c[2] + c[3])) + ((d[0] + d[1]) + (d[2] + d[3])); }
__device__ __forceinline__ float sum8(const float* p) { const f32x4 a = *(const f32x4*)p, b = *(const f32x4*)(p + 4); return ((a[0] + a[1]) + (a[2] + a[3])) + ((b[0] + b[1]) + (b[2] + b[3])); }
__device__ __forceinline__ float log_sigmoid_f(float x) { return -(fmaxf(-x, 0.f) + log1pf(__expf(-fabsf(x)))); }

constexpr int NWAVES = 8;
constexpr size_t MiB = 1u << 20;
constexpr size_t WS_CTL = 0, CTL_ZERO_BYTES = 1 * MiB;
constexpr size_t WS_SSX0 = 1 * MiB, WS_SSX1 = 3 * MiB, WS_SSPP = 5 * MiB, WS_SSO = 7 * MiB, WS_SSX2 = 9 * MiB, WS_SSKPE = 10 * MiB, WS_SSQQ = 11 * MiB, WS_SSQKV = 12 * MiB,
                 WS_GATE = 13 * MiB, WS_LOGF = 14 * MiB, WS_F = 15 * MiB, WS_SSQN = 16 * MiB, WS_SSQR = 17 * MiB, WS_COS = 18 * MiB, WS_SIN = 20 * MiB, WS_LIST = 22 * MiB;
constexpr size_t WS_W = 28 * MiB, W_LAYER = 58 * MiB;
constexpr size_t WO_IN = 0, WO_UQ = 4 * MiB, WO_UKV = 4 * MiB + 512 * 1024, WO_OUT = 5 * MiB, WO_RT = 7 * MiB, WO_PG = 7 * MiB + 512 * 1024, WO_PP = 9 * MiB + 512 * 1024, WO_GU = 10 * MiB, WO_DN = 42 * MiB;
constexpr size_t WS_XBA = 144 * MiB, WS_XBB = 208 * MiB, WS_PBF = 272 * MiB, WS_MIX = 304 * MiB;
constexpr size_t WS_O = WS_XBA, WS_QRAW = WS_XBB;
constexpr size_t WS_QC = WS_MIX, WS_KVC = WS_MIX + 16 * MiB, WS_KPE = WS_MIX + 24 * MiB, WS_FQ = WS_MIX + 26 * MiB, WS_FK = WS_MIX + 58 * MiB, WS_FV = WS_MIX + 90 * MiB, WS_KMLA = WS_MIX + 122 * MiB, WS_VMLA = WS_MIX + 170 * MiB;
constexpr size_t WS_PP = WS_MIX, WS_HID = WS_MIX + 64 * MiB, WS_C1 = WS_MIX + 100 * MiB;
constexpr size_t WS_END = 512 * MiB;
static_assert(WS_VMLA + 32 * MiB <= WS_END && WS_C1 + 64 * MiB <= WS_END && WS_W + 2 * W_LAYER <= WS_XBA, "d_ws map");
constexpr int HID_ROWS = 2 * NTOK + NEXP * 256;
static_assert((size_t)HID_ROWS * 256 * 2 <= 36 * MiB, "hid");

constexpr int NSUB = 16, SUBCAP = 2048;
__device__ __forceinline__ int list_at(const int* list, const LAS int* subo, int e, int li) {
    const LAS int* so = subo + e * (NSUB + 1); int sidx = 0;
#pragma unroll
    for (int k = 1; k < NSUB; ++k) sidx += (so[k] <= li) ? 1 : 0;
    return list[(size_t)(e * NSUB + sidx) * SUBCAP + (li - so[sidx])];
}
namespace pg8 {
constexpr int TAB_OFF = 131072 + 1024;
constexpr int BM = 256, BK = 64, HALF = 128, HTB = HALF * BK * 2, STAGE_BYTES = 8 * HTB, NXCD = 8, WGM = 8;
__host__ __device__ __forceinline__ int lds_byte(int r, int c) { const int st = (r >> 4) * 2 + (c >> 5), rr = r & 15, cc = c & 31, ob = rr * 64 + cc * 2; return st * 1024 + (ob ^ (((ob >> 9) & 1) << 5)); }
__host__ __device__ __forceinline__ void stage_rc(int b, int& R, int& C) { const int st = b / 1024, sb = b % 1024, swz = sb ^ (((sb >> 9) & 1) << 5); R = (st >> 1) * 16 + swz / 64; C = (st & 1) * 32 + (swz % 64) / 2; }
__host__ __device__ __forceinline__ int perm32(int rho) { const int n = rho >> 4, i = rho & 15; return 8 * (i >> 2) + 4 * n + (i & 3); }

struct Unit { int pm, pn, e, blk; };
struct Gemm { const bf16_t* A; const bf16_t* Bt; int K; };

struct StaticOrder {
    int nM, nN, nwg, G, c;
    __device__ void init(int M, int N, int G_, int c_) { nM = M / BM; nN = N / BM; nwg = nM * nN; G = G_; c = c_; }
    __device__ bool next(int i, Unit& u) const {
        const long L = (long)i * G + c; if (L >= nwg) return false;
        int wgid = (int)L; { const int q = nwg / NXCD, r = nwg % NXCD, xcd = wgid % NXCD, off = wgid / NXCD; wgid = (xcd < r ? xcd * (q + 1) : r * (q + 1) + (xcd - r) * q) + off; }
        const int nig = WGM * nN, gid = wgid / nig, fm = gid * WGM, gsz = (nM - fm) < WGM ? (nM - fm) : WGM;
        u.pm = fm + ((wgid % nig) % gsz); u.pn = (wgid % nig) / gsz; u.e = 0; u.blk = 0; return true;
    }
    __device__ __forceinline__ int arow(const Unit& u, int r) const { return u.pm * BM + r; }
};

template <int K, class Epi, class Sched, bool ALIGN_EPI>
__device__ __forceinline__ void gemm_phase(LAS unsigned char* lds, const Gemm g, const Sched& S, const Epi& E) {
    LAS f32x2* const tab0 = (LAS f32x2*)(lds + TAB_OFF);
    int tid_ = threadIdx.x; asm volatile("" : "+v"(tid_));
    const int tid = tid_, wid = __builtin_amdgcn_readfirstlane(tid >> 6), lane = tid & 63, wr = wid >> 2, wc = wid & 3, fr = lane & 15, fq = lane >> 4;
    int Kr = K; asm volatile("" : "+s"(Kr));
    const int nt = Kr / BK;
    unsigned voffB[2];
#pragma unroll
    for (int i = 0; i < 2; ++i) { int R_, C_; stage_rc(tid * 16 + i * 8192, R_, C_); const int Rb = (R_ & ~31) + perm32(R_ & 31); voffB[i] = (unsigned)(Rb * Kr + C_) * 2u; }
    const size_t kstep = (size_t)(BK * 2);
    const size_t hstep = (size_t)HALF * Kr * 2;
    const size_t tstep = 2 * hstep;
    const unsigned ldsw = (unsigned)wid * 1024u;
    const int aoff = lds_byte(wr * 64 + fr, fq * 8), boff = lds_byte(wc * 32 + fr, fq * 8);
#define PG8_SA(b, h) (((b) * 2 + (h)) * HTB)
#define PG8_SB(b, h) ((4 + (b) * 2 + (h)) * HTB)
#define PG8_STAGE(bufoff, gbase, voff) do { _Pragma("unroll") for (int _i = 0; _i < 2; ++_i) \
        __builtin_amdgcn_global_load_lds((const unsigned*)((const char*)(gbase) + (voff)[_i]), (LAS unsigned*)(lds + (bufoff) + ldsw + _i * 8192), 16, 0, 0); } while (0)
#define PG8_LDA(dst, b, h) do { _Pragma("unroll") for (int m = 0; m < 4; ++m) _Pragma("unroll") for (int k = 0; k < 2; ++k) dst[m][k] = *(const LAS bf16x8*)(lds + PG8_SA(b, h) + aoff + m * 2048 + k * 1024); } while (0)
#define PG8_LDB(dst, b, h) do { _Pragma("unroll") for (int n = 0; n < 2; ++n) _Pragma("unroll") for (int k = 0; k < 2; ++k) dst[n][k] = *(const LAS bf16x8*)(lds + PG8_SB(b, h) + boff + n * 2048 + k * 1024); } while (0)
#define PG8_MMA(ai, bj, At, Bt) do { __builtin_amdgcn_s_setprio(1); _Pragma("unroll") for (int m = 0; m < 4; ++m) _Pragma("unroll") for (int n = 0; n < 2; ++n) _Pragma("unroll") for (int k = 0; k < 2; ++k) \
        acc[ai][bj][m][n] = __builtin_amdgcn_mfma_f32_16x16x32_bf16(Bt[n][k], At[m][k], acc[ai][bj][m][n], 0, 0, 0); __builtin_amdgcn_s_setprio(0); } while (0)
#define PG8_WAIT_V(n) asm volatile("s_waitcnt vmcnt(" #n ")" ::: "memory")
#define PG8_WAIT_L(n) asm volatile("s_waitcnt lgkmcnt(" #n ")" ::: "memory")
#define PG8_BAR __builtin_amdgcn_s_barrier()
#define PG8_SCHED __builtin_amdgcn_sched_barrier(0)
#define PG8_AOFF(dst, u) do { int _t = tid; asm volatile("" : "+v"(_t)); _Pragma("unroll") for (int _i = 0; _i < 2; ++_i) { int _R, _C; stage_rc(_t * 16 + _i * 8192, _R, _C); _Pragma("unroll") for (int _h = 0; _h < 2; ++_h) dst[_h][_i] = ((unsigned)S.arow(u, _h * HALF + _R) * (unsigned)Kr + (unsigned)_C) * 2u; } } while (0)
    Unit cur, nxt; int ui = 0;
    if (!S.next(0, cur)) return;
    f32x4 acc[2][2][4][2];
#pragma unroll
    for (int a = 0; a < 2; ++a)
#pragma unroll
        for (int b = 0; b < 2; ++b)
#pragma unroll
            for (int m = 0; m < 4; ++m)
#pragma unroll
                for (int n = 0; n < 2; ++n) acc[a][b][m][n] = (f32x4){0.f, 0.f, 0.f, 0.f};
    bf16x8 At[4][2], B0[2][2], B1[2][2];
    unsigned ca[2][2], na[2][2];
    PG8_AOFF(ca, cur);
    const char* gA = (const char*)g.A;
    const char* cB = (const char*)g.Bt + (size_t)cur.pn * tstep;
    PG8_STAGE(PG8_SB(0, 0), cB, voffB); PG8_STAGE(PG8_SB(0, 1), cB + hstep, voffB); PG8_STAGE(PG8_SA(0, 0), gA, ca[0]); PG8_STAGE(PG8_SA(0, 1), gA, ca[1]);
    if (wr == 1) PG8_BAR;
    PG8_WAIT_V(2); PG8_BAR;
    PG8_STAGE(PG8_SB(1, 0), cB + kstep, voffB); PG8_STAGE(PG8_SA(1, 0), gA + kstep, ca[0]); PG8_STAGE(PG8_SB(1, 1), cB + hstep + kstep, voffB);
    PG8_WAIT_V(6); PG8_BAR;
    for (;;) {
        const bool has_next = S.next(ui + 1, nxt);
        E.pre(cur, tab0 + (ui & 1) * 256, tid);
        if (has_next) { PG8_AOFF(na, nxt); } else {
#pragma unroll
            for (int _h = 0; _h < 2; ++_h)
#pragma unroll
                for (int _i = 0; _i < 2; ++_i) na[_h][_i] = ca[_h][_i]; }
        const char* nB = has_next ? (const char*)g.Bt + (size_t)nxt.pn * tstep : cB;
        for (int t = 0; t < nt; t += 2) {
            const bool last = (t == nt - 2);
            if constexpr (Epi::HAS_MID) { if (t == nt / 2) E.mid(acc, cur, wr, wc, fr, fq, tab0 + (ui & 1) * 256); }
            const char* a1 = gA + (size_t)(t + 1) * kstep;
            const char* a2 = last ? gA : gA + (size_t)(t + 2) * kstep; const char* b2 = last ? nB : cB + (size_t)(t + 2) * kstep;
            const char* a3 = a2 + kstep; const char* b3 = b2 + kstep;
            unsigned o2[2][2];
#pragma unroll
            for (int _h = 0; _h < 2; ++_h)
#pragma unroll
                for (int _i = 0; _i < 2; ++_i) o2[_h][_i] = last ? na[_h][_i] : ca[_h][_i];
            PG8_LDB(B0, 0, 0); PG8_LDB(B1, 0, 1); PG8_SCHED; PG8_LDA(At, 0, 0); PG8_STAGE(PG8_SA(1, 1), a1, ca[1]);
            PG8_WAIT_V(8); PG8_WAIT_L(0); PG8_BAR; PG8_MMA(0, 0, At, B0); PG8_MMA(0, 1, At, B1); PG8_BAR; PG8_SCHED;
            PG8_LDA(At, 0, 1); PG8_STAGE(PG8_SB(0, 0), b2, voffB); PG8_STAGE(PG8_SB(0, 1), b2 + hstep, voffB); PG8_STAGE(PG8_SA(0, 0), a2, o2[0]);
            PG8_WAIT_V(8); PG8_WAIT_L(0); PG8_BAR; PG8_MMA(1, 0, At, B0); PG8_MMA(1, 1, At, B1); PG8_BAR; PG8_SCHED;
            PG8_LDB(B0, 1, 0); PG8_LDB(B1, 1, 1); PG8_SCHED; PG8_LDA(At, 1, 0); PG8_STAGE(PG8_SA(0, 1), a2, o2[1]);
            PG8_WAIT_V(8); PG8_WAIT_L(0); PG8_BAR; PG8_MMA(0, 0, At, B0); PG8_MMA(0, 1, At, B1); PG8_BAR; PG8_SCHED;
            PG8_LDA(At, 1, 1); PG8_STAGE(PG8_SB(1, 0), b3, voffB); PG8_STAGE(PG8_SB(1, 1), b3 + hstep, voffB); PG8_STAGE(PG8_SA(1, 0), a3, o2[0]);
            PG8_WAIT_V(8); PG8_WAIT_L(0); PG8_BAR; PG8_MMA(1, 0, At, B0); PG8_MMA(1, 1, At, B1); PG8_BAR; PG8_SCHED;
        }
        if constexpr (ALIGN_EPI) { if (wr == 0) PG8_BAR; }
        E(acc, cur, wr, wc, fr, fq, tab0 + (ui & 1) * 256);
        if (!has_next) break;
#pragma unroll
        for (int a = 0; a < 2; ++a)
#pragma unroll
            for (int b = 0; b < 2; ++b)
#pragma unroll
                for (int m = 0; m < 4; ++m)
#pragma unroll
                    for (int n = 0; n < 2; ++n) acc[a][b][m][n] = (f32x4){0.f, 0.f, 0.f, 0.f};
        cur = nxt; cB = nB; ++ui;
#pragma unroll
        for (int _h = 0; _h < 2; ++_h)
#pragma unroll
            for (int _i = 0; _i < 2; ++_i) ca[_h][_i] = na[_h][_i];
        if constexpr (ALIGN_EPI) { if (wr == 1) PG8_BAR; }
    }
    PG8_WAIT_V(0);
    if constexpr (!ALIGN_EPI) { if (wr == 0) PG8_BAR; }
    PG8_BAR;
#undef PG8_SA
#undef PG8_SB
#undef PG8_STAGE
#undef PG8_LDA
#undef PG8_LDB
#undef PG8_MMA
#undef PG8_WAIT_V
#undef PG8_WAIT_L
#undef PG8_BAR
#undef PG8_SCHED
#undef PG8_AOFF
}
}
using pg8::Unit;
typedef f32x4 AccT[2][2][4][2];
#define EPI_ROWS(...) _Pragma("unroll") for (int ai = 0; ai < 2; ++ai) _Pragma("unroll") for (int m = 0; m < 4; ++m) { const int rl = ai * 128 + wr * 64 + m * 16 + fr; const int row = u.pm * 256 + rl; (void)row; __VA_ARGS__ if (m & 1) asm volatile("" ::: "memory"); }

struct EpiInProj {
    static constexpr bool HAS_MID = false;
    unsigned char* ws; const float *bfox, *gfq, *gfk;
    __device__ __forceinline__ void pre(const Unit& u, LAS f32x2* tab, int tid) const { if (tid < 256) { const float* ssx = (const float*)(ws + WS_SSX0); tab[tid] = (f32x2){rsqrtf(sum16(ssx + (size_t)(u.pm * 256 + tid) * 16) * (1.f / 1024.f) + EPS), 0.f}; } }
    __device__ __forceinline__ void mid(AccT&, const Unit&, int, int, int, int, const LAS f32x2*) const {}
    __device__ __forceinline__ void operator()(const AccT& acc, const Unit& u, int wr, int wc, int fr, int fq, const LAS f32x2* tab) const {
        asm volatile("" : "+v"(fr), "+v"(fq));
        const int pn = u.pn;
        const float* ssx = (const float*)(ws + WS_SSX0); bf16_t* Qc = (bf16_t*)(ws + WS_QC); bf16_t* Kvc = (bf16_t*)(ws + WS_KVC); bf16_t* Kpe = (bf16_t*)(ws + WS_KPE);
        float* ssq_q = (float*)(ws + WS_SSQQ); float* ssq_kv = (float*)(ws + WS_SSQKV); float* ss_kpe = (float*)(ws + WS_SSKPE); float* logf = (float*)(ws + WS_LOGF);
        if (pn == 0) {
            EPI_ROWS({ const float rinv = tab[rl].x; float s = 0.f;
_Pragma("unroll")
                for (int bj = 0; bj < 2; ++bj) { const f32x4 v0 = acc[ai][bj][m][0] * rinv, v1 = acc[ai][bj][m][1] * rinv; s += sum4sq(v0) + sum4sq(v1);
                    *(u32x4*)(Qc + (size_t)row * 256 + bj * 128 + wc * 32 + fq * 8) = pack8(v0, v1); }
                s = red_fq(s); if (fq == 0) ssq_q[(size_t)row * 4 + wc] = s; })
        } else if (pn == 1) {
            EPI_ROWS({ const float rinv = tab[rl].x;
                if (wc < 2) { float s = 0.f;
_Pragma("unroll")
                    for (int bj = 0; bj < 2; ++bj) { const f32x4 v0 = acc[ai][bj][m][0] * rinv, v1 = acc[ai][bj][m][1] * rinv; s += sum4sq(v0) + sum4sq(v1);
                        *(u32x4*)(Kvc + (size_t)row * 128 + wc * 64 + bj * 32 + fq * 8) = pack8(v0, v1); }
                    s = red_fq(s); if (fq == 0) ssq_kv[(size_t)row * 2 + wc] = s;
                } else if (wc == 2) { const f32x4 v0 = acc[ai][0][m][0] * rinv, v1 = acc[ai][0][m][1] * rinv; float s = sum4sq(v0) + sum4sq(v1);
                    *(u32x4*)(Kpe + (size_t)row * 32 + fq * 8) = pack8(v0, v1);
                    s = red_fq(s); if (fq == 0) ss_kpe[row] = s;
                } else { if (fq == 0) { const f32x4 v0 = acc[ai][0][m][0] * rinv, v1 = acc[ai][0][m][1] * rinv; const f32x4 b0 = *(const f32x4*)bfox, b1 = *(const f32x4*)(bfox + 4); f32x4 o0, o1;
_Pragma("unroll")
                        for (int i = 0; i < 4; ++i) { o0[i] = log_sigmoid_f(v0[i] + b0[i]); o1[i] = log_sigmoid_f(v1[i] + b1[i]); }
                        *(f32x4*)(logf + (size_t)row * 8) = o0; *(f32x4*)(logf + (size_t)row * 8 + 4) = o1; } } })
        } else {
            const int kind = (pn - 2) >> 1, head = 4 * ((pn - 2) & 1) + wc;
            bf16_t* dst = (bf16_t*)(ws + (kind == 0 ? WS_FQ : (kind == 1 ? WS_FK : WS_FV))); const float* g = kind == 0 ? gfq : gfk; const float osc = kind == 0 ? C2_FOX : 1.f;
            f32x4 g4[2][2];
_Pragma("unroll")
            for (int bj = 0; bj < 2; ++bj)
_Pragma("unroll")
                for (int n = 0; n < 2; ++n) g4[bj][n] = kind < 2 ? *(const f32x4*)(g + bj * 32 + fq * 8 + n * 4) * osc : (f32x4){1.f, 1.f, 1.f, 1.f};
            EPI_ROWS({ const float rinv = tab[rl].x; f32x4 v[2][2]; float s = 0.f;
_Pragma("unroll")
                for (int bj = 0; bj < 2; ++bj)
_Pragma("unroll")
                    for (int n = 0; n < 2; ++n) { v[bj][n] = acc[ai][bj][m][n] * rinv; s += sum4sq(v[bj][n]); }
                s = red_fq(s); const float hr = kind < 2 ? rsqrtf(s * (1.f / 64.f) + EPS) : 1.f;
_Pragma("unroll")
                for (int bj = 0; bj < 2; ++bj) { const int bb = row >> 13, tl = (row >> 6) & 127, r = row & 63; const size_t tb = ((size_t)(bb * 8 + head) * 128 + tl) * 4096;
                    const size_t off = kind == 0 ? (size_t)row * 512 + head * 64 + bj * 32 + fq * 8 : (kind == 1 ? tb + (4 * bj + fq) * 512 + r * 8 : tb + (bj * 4 + (r >> 4)) * 512 + (r & 15) * 32 + fq * 8);
                    *(u32x4*)(dst + off) = pack8(v[bj][0] * hr * g4[bj][0], v[bj][1] * hr * g4[bj][1]); } })
        }
    }
};
struct EpiQUp {
    static constexpr bool HAS_MID = false;
    unsigned char* ws;
    __device__ __forceinline__ void pre(const Unit& u, LAS f32x2* tab, int tid) const { if (tid < 256) { const f32x4 sq = *(const f32x4*)((const float*)(ws + WS_SSQQ) + (size_t)(u.pm * 256 + tid) * 4); tab[tid] = (f32x2){rsqrtf(((sq[0] + sq[1]) + (sq[2] + sq[3])) * (1.f / 256.f) + EPS), 0.f}; } }
    __device__ __forceinline__ void mid(AccT&, const Unit&, int, int, int, int, const LAS f32x2*) const {}
    __device__ __forceinline__ void operator()(const AccT& acc, const Unit& u, int wr, int wc, int fr, int fq, const LAS f32x2* tab) const {
        asm volatile("" : "+v"(fr), "+v"(fq));
        const int pn = u.pn;
        const float* ssq_q = (const float*)(ws + WS_SSQQ); bf16_t* Qraw = (bf16_t*)(ws + WS_QRAW); float* ssq_qn = (float*)(ws + WS_SSQN); float* ssq_qr = (float*)(ws + WS_SSQR);
        EPI_ROWS({ const float rinv = tab[rl].x;
            if (pn < 2) { const int head = 4 * pn + wc; float s = 0.f;
_Pragma("unroll")
                for (int bj = 0; bj < 2; ++bj) { const f32x4 v0 = acc[ai][bj][m][0] * rinv, v1 = acc[ai][bj][m][1] * rinv; s += sum4sq(v0) + sum4sq(v1);
                    *(u32x4*)(Qraw + (size_t)row * 768 + head * 96 + bj * 32 + fq * 8) = pack8(v0, v1); }
                s = red_fq(s); if (fq == 0) ssq_qn[(size_t)row * 8 + head] = s;
            } else {
_Pragma("unroll")
                for (int bj = 0; bj < 2; ++bj) { const int head = 4 * bj + wc; const f32x4 v0 = acc[ai][bj][m][0] * rinv, v1 = acc[ai][bj][m][1] * rinv; float s = sum4sq(v0) + sum4sq(v1);
                    *(u32x4*)(Qraw + (size_t)row * 768 + head * 96 + 64 + fq * 8) = pack8(v0, v1);
                    s = red_fq(s); if (fq == 0) ssq_qr[(size_t)row * 8 + head] = s; }
            } })
    }
};
struct EpiKvUp {
    static constexpr bool HAS_MID = false;
    unsigned char* ws; const float* gk;
    __device__ __forceinline__ void pre(const Unit& u, LAS f32x2* tab, int tid) const { if (tid < 256) { const size_t r = (size_t)(u.pm * 256 + tid); const f32x2 sk = *(const f32x2*)((const float*)(ws + WS_SSQKV) + r * 2); tab[tid] = (f32x2){rsqrtf((sk[0] + sk[1]) * (1.f / 128.f) + EPS), ((const float*)(ws + WS_SSKPE))[r]}; } }
    __device__ __forceinline__ void mid(AccT&, const Unit&, int, int, int, int, const LAS f32x2*) const {}
    __device__ __forceinline__ void operator()(const AccT& acc, const Unit& u, int wr, int wc, int fr, int fq, const LAS f32x2* tab) const {
        asm volatile("" : "+v"(fr), "+v"(fq));
        const int pn = u.pn;
        const float* ssq_kv = (const float*)(ws + WS_SSQKV); const float* ss_kpe = (const float*)(ws + WS_SSKPE); const bf16_t* Kpe = (const bf16_t*)(ws + WS_KPE);
        const float* cosT = (const float*)(ws + WS_COS); const float* sinT = (const float*)(ws + WS_SIN); bf16_t* Kmla = (bf16_t*)(ws + WS_KMLA); bf16_t* Vmla = (bf16_t*)(ws + WS_VMLA);
        if (pn < 2) {
            const int head = 4 * pn + wc;
            f32x4 g4[2][2];
_Pragma("unroll")
            for (int bj = 0; bj < 2; ++bj)
_Pragma("unroll")
                for (int n = 0; n < 2; ++n) g4[bj][n] = *(const f32x4*)(gk + bj * 32 + fq * 8 + n * 4);
            const f32x4 gr1 = *(const f32x4*)(gk + 64 + 4 * fq), gr2 = *(const f32x4*)(gk + 80 + 4 * fq);
            EPI_ROWS({ const f32x2 tt = tab[rl]; const float rinv = tt.x; f32x4 v[2][2]; float s = 0.f;
_Pragma("unroll")
                for (int bj = 0; bj < 2; ++bj)
_Pragma("unroll")
                    for (int n = 0; n < 2; ++n) { v[bj][n] = acc[ai][bj][m][n] * rinv; s += sum4sq(v[bj][n]); }
                s = red_fq(s) + tt.y; const float hr = rsqrtf(s * (1.f / 96.f) + EPS);
                const int bb = row >> 13, tl = (row >> 6) & 127, r = row & 63; bf16_t* kd = Kmla + ((size_t)(bb * 8 + head) * 128 + tl) * 6144 + r * 8;
_Pragma("unroll")
                for (int bj = 0; bj < 2; ++bj) *(u32x4*)(kd + (4 * bj + fq) * 512) = pack8(v[bj][0] * hr * g4[bj][0], v[bj][1] * hr * g4[bj][1]);
                const u32x2 p1 = *(const u32x2*)(Kpe + (size_t)row * 32 + 4 * fq), p2 = *(const u32x2*)(Kpe + (size_t)row * 32 + 16 + 4 * fq);
                const f32x4 c = *(const f32x4*)(cosT + (size_t)row * 16 + 4 * fq), sn = *(const f32x4*)(sinT + (size_t)row * 16 + 4 * fq);
                const f32x4 x1 = (f32x4){bflo(p1.x), bfhi(p1.x), bflo(p1.y), bfhi(p1.y)} * hr * gr1, x2 = (f32x4){bflo(p2.x), bfhi(p2.x), bflo(p2.y), bfhi(p2.y)} * hr * gr2;
                const f32x4 o1 = x1 * c - x2 * sn, o2 = x2 * c + x1 * sn;
                u32x2 w1, w2; w1.x = cvt_pk_bf16(o1[0], o1[1]); w1.y = cvt_pk_bf16(o1[2], o1[3]); w2.x = cvt_pk_bf16(o2[0], o2[1]); w2.y = cvt_pk_bf16(o2[2], o2[3]);
                *(u32x2*)(kd + (8 + (fq >> 1)) * 512 + 4 * (fq & 1)) = w1; *(u32x2*)(kd + (10 + (fq >> 1)) * 512 + 4 * (fq & 1)) = w2; })
        } else {
            const int head = 4 * (pn - 2) + wc;
            EPI_ROWS({ const f32x2 tt = tab[rl]; const float rinv = tt.x;
_Pragma("unroll")
                for (int bj = 0; bj < 2; ++bj) { const int bb = row >> 13, tl = (row >> 6) & 127, r = row & 63;
                    *(u32x4*)(Vmla + ((size_t)(bb * 8 + head) * 128 + tl) * 4096 + (bj * 4 + (r >> 4)) * 512 + (r & 15) * 32 + fq * 8) = pack8(acc[ai][bj][m][0] * rinv, acc[ai][bj][m][1] * rinv); } })
        }
    }
};
struct EpiOut {
    static constexpr bool HAS_MID = true;
    unsigned char* ws; const float* base;
    __device__ __forceinline__ void pre(const Unit& u, LAS f32x2* tab, int tid) const { if (tid < 256) { const float* sso = (const float*)(ws + WS_SSO) + (size_t)(u.pm * 256 + tid) * 16;
        const float rm = rsqrtf(sum8(sso) * (1.f / 512.f) + EPS), rf = rsqrtf(sum8(sso + 8) * (1.f / 512.f) + EPS); tab[tid] = (f32x2){rm / rf, rf}; } }
    __device__ __forceinline__ void mid(AccT& acc, const Unit& u, int wr, int wc, int fr, int fq, const LAS f32x2* tab) const {
        EPI_ROWS({ const float ratio = tab[rl].x;
_Pragma("unroll")
            for (int bj = 0; bj < 2; ++bj)
_Pragma("unroll")
                for (int n = 0; n < 2; ++n) acc[ai][bj][m][n] *= ratio; })
    }
    __device__ __forceinline__ void operator()(const AccT& acc, const Unit& u, int wr, int wc, int fr, int fq, const LAS f32x2* tab) const {
        asm volatile("" : "+v"(fr), "+v"(fq));
        bf16_t* xb = (bf16_t*)(ws + WS_XBB); const bf16_t* xa = (const bf16_t*)(ws + WS_XBA); float* ssx1 = (float*)(ws + WS_SSX1);
        EPI_ROWS({ const float rf = tab[rl].y; float s = 0.f;
_Pragma("unroll")
            for (int bj = 0; bj < 2; ++bj) { const size_t off = (size_t)row * 1024 + u.pn * 256 + bj * 128 + wc * 32 + fq * 8; f32x4 b0, b1;
                if (base) { b0 = *(const f32x4*)(base + off); b1 = *(const f32x4*)(base + off + 4); }
                else { const u32x4 w = *(const u32x4*)(xa + off); b0 = (f32x4){bflo(w.x), bfhi(w.x), bflo(w.y), bfhi(w.y)}; b1 = (f32x4){bflo(w.z), bfhi(w.z), bflo(w.w), bfhi(w.w)}; }
                const f32x4 v0 = b0 + acc[ai][bj][m][0] * rf, v1 = b1 + acc[ai][bj][m][1] * rf; s += sum4sq(v0) + sum4sq(v1);
                *(u32x4*)(xb + off) = pack8(v0, v1); }
            s = red_fq(s); if (fq == 0) ssx1[(size_t)row * 16 + u.pn * 4 + wc] = s; })
    }
};
struct EpiRouter {
    static constexpr bool HAS_MID = false;
    unsigned char* ws; unsigned* cnt;
    __device__ __forceinline__ void pre(const Unit& u, LAS f32x2* tab, int tid) const { if (tid < 256) { const float* ssx1 = (const float*)(ws + WS_SSX1); tab[tid] = (f32x2){rsqrtf(sum16(ssx1 + (size_t)(u.pm * 256 + tid) * 16) * (1.f / 1024.f) + EPS), 0.f}; } }
    __device__ __forceinline__ void mid(AccT&, const Unit&, int, int, int, int, const LAS f32x2*) const {}
    __device__ __forceinline__ void operator()(const AccT& acc, const Unit& u, int wr, int wc, int fr, int fq, const LAS f32x2* tab) const {
        asm volatile("" : "+v"(fr), "+v"(fq));
        if (wc != 0) return;
        float* gate = (float*)(ws + WS_GATE); int* list = (int*)(ws + WS_LIST);
        EPI_ROWS({ const float rinv = tab[rl].x;
            const f32x4 gl = acc[ai][1][m][0] * rinv; int g = 0; float gm = gl[0];
_Pragma("unroll")
            for (int j = 1; j < 4; ++j) if (gl[j] > gm) { gm = gl[j]; g = j; }
            float gs = 0.f;
_Pragma("unroll")
            for (int j = 0; j < 4; ++j) gs += __expf(gl[j] - gm);
            float pg = 1.f / gs;
            g = __shfl(g, fr); pg = __shfl(pg, fr);
            if (fq == g) { float le[8];
_Pragma("unroll")
                for (int j = 0; j < 4; ++j) { le[j] = acc[ai][0][m][0][j] * rinv; le[4 + j] = acc[ai][0][m][1][j] * rinv; }
                int i1 = 0; float m1 = le[0];
_Pragma("unroll")
                for (int j = 1; j < 8; ++j) if (le[j] > m1) { m1 = le[j]; i1 = j; }
                int i2 = 0; float m2 = -3.0e38f;
_Pragma("unroll")
                for (int j = 0; j < 8; ++j) if (j != i1 && le[j] > m2) { m2 = le[j]; i2 = j; }
                const float e2 = __expf(m2 - m1), w1 = 1.f / (1.f + e2), w2 = e2 * w1;
                gate[2 * (size_t)row] = pg * w1; gate[2 * (size_t)row + 1] = pg * w2;
                const int ea = g * 8 + i1, eb = g * 8 + i2;
                const int sl = u.pm & (NSUB - 1);
                const unsigned pa = __hip_atomic_fetch_add(cnt + ea * NSUB + sl, 1u, __ATOMIC_RELAXED, __HIP_MEMORY_SCOPE_AGENT); list[(size_t)(ea * NSUB + sl) * SUBCAP + pa] = 2 * row;
                const unsigned pb = __hip_atomic_fetch_add(cnt + eb * NSUB + sl, 1u, __ATOMIC_RELAXED, __HIP_MEMORY_SCOPE_AGENT); list[(size_t)(eb * NSUB + sl) * SUBCAP + pb] = 2 * row + 1; } })
    }
};
struct EpiPP {
    static constexpr bool HAS_MID = false;
    unsigned char* ws;
    __device__ __forceinline__ void pre(const Unit&, LAS f32x2*, int) const {}
    __device__ __forceinline__ void mid(AccT&, const Unit&, int, int, int, int, const LAS f32x2*) const {}
    __device__ __forceinline__ void operator()(const AccT& acc, const Unit& u, int wr, int wc, int fr, int fq, const LAS f32x2* tab) const {
        asm volatile("" : "+v"(fr), "+v"(fq));
        bf16_t* pp = (bf16_t*)(ws + WS_PP); float* sspp = (float*)(ws + WS_SSPP);
        EPI_ROWS({ float s = 0.f;
_Pragma("unroll")
            for (int bj = 0; bj < 2; ++bj) { const f32x4 v0 = acc[ai][bj][m][0], v1 = acc[ai][bj][m][1]; s += sum4sq(v0) + sum4sq(v1);
                *(u32x4*)(pp + (size_t)row * 1024 + u.pn * 256 + bj * 128 + wc * 32 + fq * 8) = pack8(v0, v1); }
            s = red_fq(s); if (fq == 0) sspp[(size_t)row * 16 + u.pn * 4 + wc] = s; })
    }
};
struct EpiMoeUp {
    static constexpr bool HAS_MID = false;
    unsigned char* ws; const LAS unsigned* cntv; const LAS int* subo; int npn;
    __device__ __forceinline__ void pre(const Unit& u, LAS f32x2* tab, int tid) const { if (tid < 256) { const int li = u.blk * 256 + tid; float rinv = 0.f;
        if (li < (int)cntv[u.e]) { const int tok = list_at((const int*)(ws + WS_LIST), subo, u.e, li) >> 1; rinv = rsqrtf(sum16((const float*)(ws + WS_SSX1) + (size_t)tok * 16) * (1.f / 1024.f) + EPS); }
        tab[tid] = (f32x2){rinv, 0.f}; } }
    __device__ __forceinline__ void mid(AccT&, const Unit&, int, int, int, int, const LAS f32x2*) const {}
    __device__ __forceinline__ void operator()(const AccT& acc, const Unit& u, int wr, int wc, int fr, int fq, const LAS f32x2* tab) const {
        asm volatile("" : "+v"(fr), "+v"(fq));
        const int pnl = u.pn - u.e * npn;
        bf16_t* hid = (bf16_t*)(ws + WS_HID);
        EPI_ROWS({ const float rinv = tab[rl].x;
            f32x4 h[2];
_Pragma("unroll")
            for (int n = 0; n < 2; ++n) { const f32x4 gg = acc[ai][0][m][n] * rinv, uu = acc[ai][1][m][n] * rinv;
_Pragma("unroll")
                for (int i = 0; i < 4; ++i) h[n][i] = gg[i] * __builtin_amdgcn_rcpf(1.f + __expf(-gg[i])) * uu[i]; }
            *(u32x4*)(hid + (size_t)row * 256 + pnl * 128 + wc * 32 + fq * 8) = pack8(h[0], h[1]); })
    }
};
struct EpiMoeDown {
    static constexpr bool HAS_MID = false;
    unsigned char* ws; const LAS unsigned* cntv; const LAS int* subo; int npn;
    __device__ __forceinline__ void pre(const Unit& u, LAS f32x2* tab, int tid) const { if (tid < 256) { const int li = u.blk * 256 + tid; int aid = -1; float gt = 0.f;
        if (li < (int)cntv[u.e]) { aid = list_at((const int*)(ws + WS_LIST), subo, u.e, li); gt = ((const float*)(ws + WS_GATE))[aid]; }
        tab[tid] = (f32x2){gt, __int_as_float(aid)}; } }
    __device__ __forceinline__ void mid(AccT&, const Unit&, int, int, int, int, const LAS f32x2*) const {}
    __device__ __forceinline__ void operator()(const AccT& acc, const Unit& u, int wr, int wc, int fr, int fq, const LAS f32x2* tab) const {
        asm volatile("" : "+v"(fr), "+v"(fq));
        const int pnl = u.pn - u.e * npn;
        bf16_t* c1 = (bf16_t*)(ws + WS_C1); bf16_t* xb = (bf16_t*)(ws + WS_XBB);
        EPI_ROWS({ const f32x2 tt = tab[rl]; const int aid = __float_as_int(tt.y);
            if (aid >= 0) { const int tok = aid >> 1; const float gt = tt.x;
_Pragma("unroll")
                for (int bj = 0; bj < 2; ++bj) { const size_t off = (size_t)tok * 1024 + pnl * 256 + bj * 128 + wc * 32 + fq * 8; const f32x4 v0 = acc[ai][bj][m][0] * gt, v1 = acc[ai][bj][m][1] * gt;
                    if (aid & 1) *(u32x4*)(c1 + off) = pack8(v0, v1);
                    else { const u32x4 w = *(const u32x4*)(xb + off); *(u32x4*)(xb + off) = pack8((f32x4){bflo(w.x), bfhi(w.x), bflo(w.y), bfhi(w.y)} + v0, (f32x4){bflo(w.z), bfhi(w.z), bflo(w.w), bfhi(w.w)} + v1); } } } })
    }
};
struct EpiPle {
    static constexpr bool HAS_MID = false;
    unsigned char* ws; const float* gpo; float* xout;
    __device__ __forceinline__ void pre(const Unit& u, LAS f32x2* tab, int tid) const { if (tid < 256) { const size_t r = (size_t)(u.pm * 256 + tid);
        tab[tid] = (f32x2){rsqrtf(((const float*)(ws + WS_SSX2))[r] * (1.f / 1024.f) + EPS), rsqrtf(sum16((const float*)(ws + WS_SSPP) + r * 16) * (1.f / 1024.f) + EPS)}; } }
    __device__ __forceinline__ void mid(AccT&, const Unit&, int, int, int, int, const LAS f32x2*) const {}
    __device__ __forceinline__ void operator()(const AccT& acc, const Unit& u, int wr, int wc, int fr, int fq, const LAS f32x2* tab) const {
        asm volatile("" : "+v"(fr), "+v"(fq));
        const bf16_t* pp = (const bf16_t*)(ws + WS_PP); bf16_t* xbn = (bf16_t*)(ws + WS_XBA); const bf16_t* xb = (const bf16_t*)(ws + WS_XBB); float* ssx0 = (float*)(ws + WS_SSX0);
        f32x4 g4[2][2];
_Pragma("unroll")
        for (int bj = 0; bj < 2; ++bj)
_Pragma("unroll")
            for (int n = 0; n < 2; ++n) g4[bj][n] = *(const f32x4*)(gpo + u.pn * 256 + bj * 128 + wc * 32 + fq * 8 + n * 4);
        EPI_ROWS({ const f32x2 tt = tab[rl]; const float r2 = tt.x, rp = tt.y; float s = 0.f;
_Pragma("unroll")
            for (int bj = 0; bj < 2; ++bj) { const size_t off = (size_t)row * 1024 + u.pn * 256 + bj * 128 + wc * 32 + fq * 8;
                const u32x4 pw = *(const u32x4*)(pp + off); const f32x4 p0 = (f32x4){bflo(pw.x), bfhi(pw.x), bflo(pw.y), bfhi(pw.y)} * rp * g4[bj][0], p1 = (f32x4){bflo(pw.z), bfhi(pw.z), bflo(pw.w), bfhi(pw.w)} * rp * g4[bj][1];
                const u32x4 xw = *(const u32x4*)(xb + off); f32x4 v0 = (f32x4){bflo(xw.x), bfhi(xw.x), bflo(xw.y), bfhi(xw.y)}, v1 = (f32x4){bflo(xw.z), bfhi(xw.z), bflo(xw.w), bfhi(xw.w)};
_Pragma("unroll")
                for (int i = 0; i < 4; ++i) { v0[i] += p0[i] * __builtin_amdgcn_rcpf(1.f + __expf(-acc[ai][bj][m][0][i] * r2)); v1[i] += p1[i] * __builtin_amdgcn_rcpf(1.f + __expf(-acc[ai][bj][m][1][i] * r2)); }
                s += sum4sq(v0) + sum4sq(v1);
#ifdef DIAG_SEL
                if (xout) { const float dsc_ = 1.f + sqrtf(((const float*)(ws + WS_CTL))[250000 + DIAG_SEL] * DIAG_SCALE); v0 *= dsc_; v1 *= dsc_; }
#endif
                if (xout) { *(f32x4*)(xout + off) = v0; *(f32x4*)(xout + off + 4) = v1; } else *(u32x4*)(xbn + off) = pack8(v0, v1); }
            s = red_fq(s); if (fq == 0 && !xout) ssx0[(size_t)row * 16 + u.pn * 4 + wc] = s; })
    }
};

struct EpiNull {
    static constexpr bool HAS_MID = false;
    float* sink;
    __device__ __forceinline__ void pre(const Unit&, LAS f32x2*, int) const {}
    __device__ __forceinline__ void mid(AccT&, const Unit&, int, int, int, int, const LAS f32x2*) const {}
    __device__ __forceinline__ void operator()(const AccT& acc, const Unit& u, int wr, int wc, int fr, int fq, const LAS f32x2* tab) const {
        f32x4 s = (f32x4){0.f, 0.f, 0.f, 0.f};
        EPI_ROWS({ s += (acc[ai][0][m][0] + acc[ai][0][m][1]) + (acc[ai][1][m][0] + acc[ai][1][m][1]); })
        if (s[0] + s[1] + s[2] + s[3] == 1.2345678e33f) sink[0] = s[0];
    }
};

namespace att {
constexpr int NS = 4, VSLOT = 8192;
template <bool FOX> struct Lay { static constexpr int KSLOT = FOX ? 8192 : 12288, L_K = 0, L_V = NS * KSLOT, L_WS = L_V + NS * VSLOT, L_G = L_WS + 2048, L_END = L_G + (FOX ? 32768 : 0), L_OST = 0; };
static_assert(Lay<true>::L_END <= 131072 && Lay<false>::L_END <= 131072 && NS * 8192 >= 32768, "attention LDS map");
constexpr float SKIP_NATS = 40.f;
typedef LAS const char* lds_cptr;
typedef short v4i16_t __attribute__((ext_vector_type(4)));

__device__ __forceinline__ void glds16(const void* gsrc, unsigned lds_dst) { unsigned keep;
    asm volatile("s_mov_b32 %0, m0\n\ts_mov_b32 m0, %2\n\ts_nop 0\n\tglobal_load_lds_dwordx4 %1, off\n\ts_mov_b32 m0, %0" : "=&s"(keep) : "v"(gsrc), "s"(lds_dst) : "memory"); }
__device__ __forceinline__ int crow(int r, int hi) { return (r & 3) + 8 * (r >> 2) + 4 * hi; }
__device__ __forceinline__ s16x4 vtr(lds_cptr p) { return __builtin_bit_cast(s16x4, __builtin_amdgcn_ds_read_tr16_b64_v4i16((LAS v4i16_t*)p)); }
__device__ __forceinline__ float swapmax(float m) { auto rr = __builtin_amdgcn_permlane32_swap(__float_as_uint(m), __float_as_uint(m), false, false); return fmaxf(__uint_as_float(rr[0]), __uint_as_float(rr[1])); }
__device__ __forceinline__ float swapsum(float m) { auto rr = __builtin_amdgcn_permlane32_swap(__float_as_uint(m), __float_as_uint(m), false, false); return __uint_as_float(rr[0]) + __uint_as_float(rr[1]); }
__device__ __forceinline__ bf16x8 pk8(const f32x16& p, int b) { u32x4 w; w.x = cvt_pk_bf16(p[b], p[b + 1]); w.y = cvt_pk_bf16(p[b + 2], p[b + 3]); w.z = cvt_pk_bf16(p[b + 4], p[b + 5]); w.w = cvt_pk_bf16(p[b + 6], p[b + 7]); return __builtin_bit_cast(bf16x8, w); }

struct Args {
    const bf16_t *Qraw, *Kmla, *Vmla, *Fq, *Fk, *Fv; const float *ssq_qn, *ssq_qr, *gmq, *cosT, *sinT, *F, *gfq, *gfk; bf16_t* o; float* sso;
};

#ifdef DIAG_SEL
#define STAMP(k) do { if (dg) { const unsigned long long t_ = __builtin_amdgcn_s_memrealtime(); dg[k] += (float)(t_ - tprev_) * 0.01f; tprev_ = t_; } } while (0)
#else
#define STAMP(k) do {} while (0)
#endif
template <bool FOX>
__device__ __forceinline__ void attn_unit(const Args& A, int b, int h, int qb, LAS char* shm, LAS float* dg) {
#ifdef DIAG_SEL
    unsigned long long tprev_ = __builtin_amdgcn_s_memrealtime();
#endif
    constexpr int DK = FOX ? 64 : 96, NQ = DK / 16, KP = FOX ? 512 : 768;
    constexpr int KSLOT = Lay<FOX>::KSLOT, L_K = Lay<FOX>::L_K, L_V = Lay<FOX>::L_V, L_WS = Lay<FOX>::L_WS, L_G = Lay<FOX>::L_G, L_OST = Lay<FOX>::L_OST;
    int tid_ = threadIdx.x; asm volatile("" : "+v"(tid_));
    const int tid = tid_, lane = tid & 63, r32 = lane & 31, hi = lane >> 5; const int wid = __builtin_amdgcn_readfirstlane(tid >> 6);
    const long rowbase = (long)b * SEQ; const int q0 = qb * 256, qw = q0 + wid * 32;
    const unsigned lds0 = (unsigned)(uintptr_t)shm;
    LAS float* wsf = (LAS float*)(shm + L_WS) + wid * 64;
    LAS float* Gl = (LAS float*)(shm + L_G);
    const int NT = (q0 + 256) / 64; const int tw_last = qw >> 6;
    int t0 = 0;
    if constexpr (FOX) {
        float gq = fmaxf(fabsf(A.gfq[lane]), 0.f), gk = fabsf(A.gfk[lane]);
#pragma unroll
        for (int o = 32; o > 0; o >>= 1) { gq = fmaxf(gq, __shfl_xor(gq, o)); gk = fmaxf(gk, __shfl_xor(gk, o)); }
        const float margin = 2.f * (8.f * gq * gk) + SKIP_NATS;
        const float Fref = A.F[(rowbase + q0) * 8 + h];
        const int nfull = q0 / 64;
        bool keep0 = true, keep1 = true;
        if (lane < nfull) keep0 = (Fref - A.F[(rowbase + 64 * lane + 63) * 8 + h]) >= -margin;
        if (lane + 64 < nfull) keep1 = (Fref - A.F[(rowbase + 64 * (lane + 64) + 63) * 8 + h]) >= -margin;
        const unsigned long long k0 = __ballot(keep0), k1 = __ballot(keep1);
        t0 = k0 ? __builtin_ctzll(k0) : 64 + (k1 ? __builtin_ctzll(k1) : 0);
        t0 = __builtin_amdgcn_readfirstlane(t0);
        const int nk = q0 + 256 - 64 * t0;
        for (int j = tid; j < nk; j += 512) Gl[j] = (Fref - A.F[(rowbase + 64 * t0 + j) * 8 + h]) * LOG2E;
    }
    const bf16_t* Kg = (FOX ? A.Fk : A.Kmla) + (long)(b * 8 + h) * 128 * (KSLOT / 2) + wid * 512 + lane * 8;
    const bf16_t* Vg = (FOX ? A.Fv : A.Vmla) + (long)(b * 8 + h) * 128 * 4096 + wid * 512 + lane * 8;
    const unsigned kdst = lds0 + L_K + wid * 1024, vdst = lds0 + L_V + wid * 1024;
    const bool k2 = (!FOX) && wid < 4;
#define ISSUE_K(t, sl) do { glds16(Kg + (long)(t) * (KSLOT / 2), (unsigned)__builtin_amdgcn_readfirstlane(kdst + (sl) * KSLOT)); \
        if (k2) glds16(Kg + (long)(t) * (KSLOT / 2) + 4096, (unsigned)__builtin_amdgcn_readfirstlane(kdst + (sl) * KSLOT + 8192)); } while (0)
#define ISSUE_V(t, sl) glds16(Vg + (long)(t) * 4096, (unsigned)__builtin_amdgcn_readfirstlane(vdst + (sl) * VSLOT))
    const int nti = NT - t0;
    ISSUE_K(t0, 0); ISSUE_K(t0 + 1, 1); ISSUE_K(t0 + 2, 2); ISSUE_V(t0, 0); ISSUE_K(t0 + 3, 3); ISSUE_V(t0 + 1, 1);
    bf16x8 qr[NQ];
    {
        const long row = rowbase + qw + r32;
        if constexpr (FOX) {
#pragma unroll
            for (int d0 = 0; d0 < NQ; ++d0) qr[d0] = *(const bf16x8*)(A.Fq + row * 512 + h * 64 + d0 * 16 + hi * 8);
        } else {
            const float ss = A.ssq_qn[row * 8 + h] + A.ssq_qr[row * 8 + h]; const float sc = rsqrtf(ss * (1.f / 96.f) + EPS) * C2_MLA;
            f32x4 qa[NQ][2];
#pragma unroll
            for (int d0 = 0; d0 < NQ; ++d0) { const u32x4 w = *(const u32x4*)(A.Qraw + row * 768 + h * 96 + d0 * 16 + hi * 8);
                const f32x4 g0 = *(const f32x4*)(A.gmq + d0 * 16 + hi * 8), g1 = *(const f32x4*)(A.gmq + d0 * 16 + hi * 8 + 4);
                qa[d0][0] = (f32x4){bflo(w.x), bfhi(w.x), bflo(w.y), bfhi(w.y)} * sc * g0; qa[d0][1] = (f32x4){bflo(w.z), bfhi(w.z), bflo(w.w), bfhi(w.w)} * sc * g1; }
#pragma unroll
            for (int e = 0; e < 2; ++e) { const f32x4 c = *(const f32x4*)(A.cosT + row * 16 + hi * 8 + e * 4), s = *(const f32x4*)(A.sinT + row * 16 + hi * 8 + e * 4);
                const f32x4 x1 = qa[4][e], x2 = qa[5][e]; qa[4][e] = x1 * c - x2 * s; qa[5][e] = x2 * c + x1 * s; }
#pragma unroll
            for (int d0 = 0; d0 < NQ; ++d0) qr[d0] = __builtin_bit_cast(bf16x8, pack8(qa[d0][0], qa[d0][1]));
        }
    }
    constexpr float THR = 8.f;
    float mhat = 0.f, lrun = 0.f; f32x16 o[2]; o[0] = f32x16{}; o[1] = f32x16{};
    const lds_cptr shm3 = (lds_cptr)shm;
    const lds_cptr kp0 = shm3 + L_K + hi * 1024 + r32 * 16;
    const lds_cptr vp0 = shm3 + L_V + ((lane >> 4) & 1) * 32 + (lane & 3) * 8 + (4 * hi + ((lane & 15) >> 2)) * 64;
    u32x4 pw[4]; f32x16 pp0, pp1, c0, c1; bf16x8 kf[2 * NQ]; s16x4 vlo[8], vhi[8];
    const int nK = k2 ? 2 : 1;
#define WV_(k) case k: asm volatile("s_waitcnt vmcnt(" #k ")" ::: "memory"); break;
#define WAITV(n) do { switch (n) { WV_(0) WV_(1) WV_(2) WV_(3) WV_(4) WV_(5) default: asm volatile("s_waitcnt vmcnt(6)" ::: "memory"); break; } } while (0)
#define LBAR() asm volatile("s_waitcnt lgkmcnt(0)\n\ts_barrier" ::: "memory")
#define SGB(mask, n) __builtin_amdgcn_sched_group_barrier(mask, n, 0)
#define SFENCE() __builtin_amdgcn_sched_barrier(0)
#define KREAD(rel) { const lds_cptr kp = kp0 + ((rel) % NS) * KSLOT; \
        _Pragma("unroll") for (int d0 = 0; d0 < NQ; ++d0) { kf[2 * d0] = *(const LAS bf16x8*)(kp + d0 * 2048); kf[2 * d0 + 1] = *(const LAS bf16x8*)(kp + d0 * 2048 + 512); } }
#define VREAD(rel) { const lds_cptr vp = vp0 + ((rel) % NS) * VSLOT; \
        _Pragma("unroll") for (int i = 0; i < 8; ++i) { vlo[i] = vtr(vp + (i >> 2) * 4096 + (i & 3) * 1024); vhi[i] = vtr(vp + (i >> 2) * 4096 + (i & 3) * 1024 + 512); } }
#define PKV(k) (bf16x8){vlo[k][0], vlo[k][1], vlo[k][2], vlo[k][3], vhi[k][0], vhi[k][1], vhi[k][2], vhi[k][3]}
#define QKMM(rel) do { const float cb = (t0 + (rel) > tw_last) ? -INFINITY : -mhat; \
        _Pragma("unroll") for (int r = 0; r < 16; ++r) { c0[r] = cb; c1[r] = cb; } \
        _Pragma("unroll") for (int d0 = 0; d0 < NQ; ++d0) { c0 = __builtin_amdgcn_mfma_f32_32x32x16_bf16(kf[2 * d0], qr[d0], c0, 0, 0, 0); c1 = __builtin_amdgcn_mfma_f32_32x32x16_bf16(kf[2 * d0 + 1], qr[d0], c1, 0, 0, 0); } } while (0)
#define PVMM() do { \
        o[0] = __builtin_amdgcn_mfma_f32_32x32x16_bf16(__builtin_bit_cast(bf16x8, pw[0]), PKV(0), o[0], 0, 0, 0); o[1] = __builtin_amdgcn_mfma_f32_32x32x16_bf16(__builtin_bit_cast(bf16x8, pw[0]), PKV(4), o[1], 0, 0, 0); \
        o[0] = __builtin_amdgcn_mfma_f32_32x32x16_bf16(__builtin_bit_cast(bf16x8, pw[1]), PKV(1), o[0], 0, 0, 0); o[1] = __builtin_amdgcn_mfma_f32_32x32x16_bf16(__builtin_bit_cast(bf16x8, pw[1]), PKV(5), o[1], 0, 0, 0); \
        o[0] = __builtin_amdgcn_mfma_f32_32x32x16_bf16(__builtin_bit_cast(bf16x8, pw[2]), PKV(2), o[0], 0, 0, 0); o[1] = __builtin_amdgcn_mfma_f32_32x32x16_bf16(__builtin_bit_cast(bf16x8, pw[2]), PKV(6), o[1], 0, 0, 0); \
        o[0] = __builtin_amdgcn_mfma_f32_32x32x16_bf16(__builtin_bit_cast(bf16x8, pw[3]), PKV(3), o[0], 0, 0, 0); o[1] = __builtin_amdgcn_mfma_f32_32x32x16_bf16(__builtin_bit_cast(bf16x8, pw[3]), PKV(7), o[1], 0, 0, 0); } while (0)
#define SUMPACK() do { float sa = pp0[0] + pp0[1], sb = pp1[0] + pp1[1]; \
        _Pragma("unroll") for (int r = 2; r < 16; r += 2) { sa += pp0[r] + pp0[r + 1]; sb += pp1[r] + pp1[r + 1]; } \
        lrun += sa + sb; pw[0] = __builtin_bit_cast(u32x4, pk8(pp0, 0)); pw[1] = __builtin_bit_cast(u32x4, pk8(pp0, 8)); pw[2] = __builtin_bit_cast(u32x4, pk8(pp1, 0)); pw[3] = __builtin_bit_cast(u32x4, pk8(pp1, 8)); } while (0)
#define MX3(a, b, c) __builtin_fmaxf(__builtin_fmaxf((a), (b)), (c))
#define BIASMASK(rel) do { if constexpr (FOX) { const int tt_ = t0 + (rel); const LAS float* Gt = Gl + (rel) * 64 + 4 * hi; \
            _Pragma("unroll") for (int rq = 0; rq < 4; ++rq) { const f32x4 ga = *(const LAS f32x4*)(Gt + 8 * rq), gb = *(const LAS f32x4*)(Gt + 32 + 8 * rq); \
                _Pragma("unroll") for (int i = 0; i < 4; ++i) { c0[4 * rq + i] += ga[i]; c1[4 * rq + i] += gb[i]; } } \
            if (64 * tt_ + 63 > qw) { const int qrel = qw + r32 - 64 * tt_; \
                _Pragma("unroll") for (int r = 0; r < 16; ++r) { const int kv = crow(r, hi); c0[r] = kv > qrel ? -INFINITY : c0[r]; c1[r] = kv + 32 > qrel ? -INFINITY : c1[r]; } } } } while (0)
#define ROWMAX(dst) do { float ma = MX3(c0[0], c0[1], c1[0]), mb = MX3(c0[2], c0[3], c1[1]); ma = MX3(ma, c1[2], c1[3]); \
        _Pragma("unroll") for (int r = 4; r < 16; r += 4) { ma = MX3(ma, c0[r], c0[r + 1]); mb = MX3(mb, c0[r + 2], c0[r + 3]); ma = MX3(ma, c1[r], c1[r + 1]); mb = MX3(mb, c1[r + 2], c1[r + 3]); } \
        dst = swapmax(fmaxf(ma, mb)); } while (0)
    WAITV(2 * nK + 2);
    LBAR();
    ISSUE_V(t0 + 2, 2);
    KREAD(0); SFENCE();
    QKMM(0);
    BIASMASK(0);
    { float rm; ROWMAX(rm); mhat = rm;
#pragma unroll
        for (int r = 0; r < 16; ++r) { pp0[r] = __builtin_amdgcn_exp2f(c0[r] - rm); pp1[r] = __builtin_amdgcn_exp2f(c1[r] - rm); } }
    KREAD(1);
    WAITV(nK + 2);
    LBAR();
#pragma unroll 1
    for (int t = 1; t < nti; ++t) {
        if (t == 1 && 4 < nti) ISSUE_K(t0 + 4, 0);
        if (t + 4 < nti) ISSUE_K(t0 + t + 4, t % NS);
        if (t + 2 < nti) ISSUE_V(t0 + t + 2, (t + 2) % NS);
        SFENCE();
        { const float cb = (t0 + t > tw_last) ? -INFINITY : -mhat;
#pragma unroll
          for (int r = 0; r < 16; ++r) { c0[r] = cb; c1[r] = cb; }
          const lds_cptr vp = vp0 + ((t - 1) % NS) * VSLOT; float sa = 0.f, sb = 0.f;
#pragma unroll
          for (int g = 0; g < 2 * NQ; ++g) {
              if (g & 1) c1 = __builtin_amdgcn_mfma_f32_32x32x16_bf16(kf[g], qr[g >> 1], c1, 0, 0, 0); else c0 = __builtin_amdgcn_mfma_f32_32x32x16_bf16(kf[g], qr[g >> 1], c0, 0, 0, 0);
              if (g < 8) { const int i = (g >> 1) + 4 * (g & 1); vlo[i] = vtr(vp + (i >> 2) * 4096 + (i & 3) * 1024); vhi[i] = vtr(vp + (i >> 2) * 4096 + (i & 3) * 1024 + 512);
                  if (g < 4) { sa += pp0[4 * g]; sb += pp0[4 * g + 1]; sa += pp0[4 * g + 2]; sb += pp0[4 * g + 3]; } else { sa += pp1[4 * g - 16]; sb += pp1[4 * g - 15]; sa += pp1[4 * g - 14]; sb += pp1[4 * g - 13]; }
                  asm volatile("" : "+v"(sa), "+v"(sb)); }
              { constexpr int G0 = FOX ? 0 : 4; if (g >= G0) { const int q = 2 * (g - G0);
#pragma unroll
                  for (int k = 0; k < 2; ++k) { const int w = q + k; const unsigned pkd = w < 8 ? cvt_pk_bf16(pp0[2 * w], pp0[2 * w + 1]) : cvt_pk_bf16(pp1[2 * w - 16], pp1[2 * w - 15]); pw[w >> 2][w & 3] = pkd; } } }
              SFENCE();
          }
          lrun += sa + sb; }
        BIASMASK(t);
        float rm; ROWMAX(rm);
        bool resc = false;
        if (__any(rm > THR)) { const float dl = fmaxf(rm, 0.f); mhat += dl;
#pragma unroll
            for (int r = 0; r < 16; ++r) { c0[r] -= dl; c1[r] -= dl; }
            const float f = __builtin_amdgcn_exp2f(-dl); lrun *= f; if (hi == 0) wsf[r32] = f; resc = true; }
        SFENCE();
        { const lds_cptr kp = kp0 + ((t + 1) % NS) * KSLOT;
#pragma unroll
          for (int g = 0; g < 8; ++g) { const int i = (g >> 1) + 4 * (g & 1);
              const bf16x8 vf = (bf16x8){vlo[i][0], vlo[i][1], vlo[i][2], vlo[i][3], vhi[i][0], vhi[i][1], vhi[i][2], vhi[i][3]};
              o[g & 1] = __builtin_amdgcn_mfma_f32_32x32x16_bf16(__builtin_bit_cast(bf16x8, pw[g >> 1]), vf, o[g & 1], 0, 0, 0);
              if (g < 4) {
#pragma unroll
                  for (int k = 0; k < 4; ++k) pp0[4 * g + k] = __builtin_amdgcn_exp2f(c0[4 * g + k]);
                  asm volatile("" : "+v"(pp0)); }
              else {
#pragma unroll
                  for (int k = 0; k < 4; ++k) pp1[4 * g - 16 + k] = __builtin_amdgcn_exp2f(c1[4 * g - 16 + k]);
                  asm volatile("" : "+v"(pp1)); }
              { constexpr int G0 = FOX ? 2 : 1; const int j = g - G0; if (j >= 0 && j < NQ) { kf[2 * j] = *(const LAS bf16x8*)(kp + j * 2048); kf[2 * j + 1] = *(const LAS bf16x8*)(kp + j * 2048 + 512); } }
              SFENCE();
          } }
        if (resc) { asm volatile("s_waitcnt lgkmcnt(0)" ::: "memory");
#pragma unroll
            for (int rq = 0; rq < 4; ++rq) { const f32x4 af = *(const LAS f32x4*)(wsf + 8 * rq + 4 * hi);
#pragma unroll
                for (int i = 0; i < 4; ++i) { o[0][4 * rq + i] *= af[i]; o[1][4 * rq + i] *= af[i]; } } }
        WAITV(((t + 3 < nti ? nK : 0) + (t + 1 < nti ? 1 : 0)) + ((t + 4 < nti ? nK : 0) + (t + 2 < nti ? 1 : 0)));
        LBAR();
    }
    VREAD(nti - 1); SUMPACK(); SFENCE(); PVMM();
#undef ISSUE_K
#undef ISSUE_V
#undef WAITV
#undef WV_
#undef LBAR
#undef SGB
#undef SFENCE
#undef KREAD
#undef VREAD
#undef PKV
#undef QKMM
#undef PVMM
#undef SUMPACK
#undef MX3
#undef BIASMASK
#undef ROWMAX
    STAMP(2);
    lrun = swapsum(lrun);
    if (hi == 0) wsf[32 + r32] = lrun;
    asm volatile("s_waitcnt lgkmcnt(0)" ::: "memory");
    float rli[16];
#pragma unroll
    for (int rq = 0; rq < 4; ++rq) { const f32x4 lf = *(const LAS f32x4*)(wsf + 32 + 8 * rq + 4 * hi);
#pragma unroll
        for (int i = 0; i < 4; ++i) rli[4 * rq + i] = __builtin_amdgcn_rcpf(lf[i]); }
    const int hh = FOX ? 8 + h : h;
    bf16_t* Ow = A.o + (rowbase + qw) * 1024 + hh * 64;
    LAS bf16_t* stg = (LAS bf16_t*)(shm + L_OST) + wid * 2048;
#pragma unroll
    for (int r = 0; r < 16; ++r) { const int orow = crow(r, hi);
#pragma unroll
        for (int d0 = 0; d0 < 2; ++d0) { const float v = o[d0][r] * rli[r]; stg[orow * 64 + d0 * 32 + r32] = (bf16_t)(cvt_pk_bf16(v, 0.f) & 0xffffu); } }
    asm volatile("s_waitcnt lgkmcnt(0)" ::: "memory");
#pragma unroll
    for (int i = 0; i < 4; ++i) { const int row = i * 8 + (lane >> 3), ch = lane & 7; const u32x4 v = *(const LAS u32x4*)(stg + row * 64 + ch * 8);
        *(u32x4*)(Ow + (long)row * 1024 + ch * 8) = v;
        float s = 0.f; { const float a0 = bflo(v.x), a1 = bfhi(v.x), a2 = bflo(v.y), a3 = bfhi(v.y), a4 = bflo(v.z), a5 = bfhi(v.z), a6 = bflo(v.w), a7 = bfhi(v.w);
            s = ((a0 * a0 + a1 * a1) + (a2 * a2 + a3 * a3)) + ((a4 * a4 + a5 * a5) + (a6 * a6 + a7 * a7)); }
        s += __shfl_xor(s, 1); s += __shfl_xor(s, 2); s += __shfl_xor(s, 4);
        if (ch == 0) A.sso[(rowbase + qw + row) * 16 + hh] = s; }
    asm volatile("s_waitcnt lgkmcnt(0)\n\ts_barrier" ::: "memory");
    STAMP(3);
#ifdef DIAG_SEL
    if (dg) dg[4] += (float)NT - (float)t0;
#endif
}

__device__ __forceinline__ void attn_phase(const Args& A, int vcu, int G, LAS char* shm, int repm, int repf, LAS float* dg, unsigned* qctr, const float* bfox, LAS int* qs  ) {
    const int tid = threadIdx.x;
    for (int v = vcu; v < 256; v += G) {
        const int bh = v >> 3, s = v & 7;
#pragma unroll 1
        for (int i = 0; i < 4 * repm; ++i) { const int ii = i & 3; const int qb = (ii == 0) ? s : (ii == 1) ? 15 - s : (ii == 2) ? 16 + s : 31 - s; attn_unit<false>(A, bh >> 3, bh & 7, qb, shm, dg); }
    }
    if (tid < 8) { const float mine = bfox[tid]; int rank = 0;
#pragma unroll
        for (int k = 0; k < 8; ++k) { const float o = bfox[k]; rank += (o > mine || (o == mine && k < tid)) ? 1 : 0; }
        qs[rank] = tid; }
    if (tid == 0) qs[8] = (int)__hip_atomic_fetch_add(qctr, 1u, __ATOMIC_RELAXED, __HIP_MEMORY_SCOPE_AGENT);
    asm volatile("s_waitcnt vmcnt(0) lgkmcnt(0)" ::: "memory"); __syncthreads();
#pragma unroll 1
    for (;;) {
        const int idx = qs[8];
        if (idx >= 1024 * repf) break;
        const int id = idx & 1023, h = qs[id >> 7], rem = id & 127, qb = 31 - (rem >> 2), b = rem & 3;
        unsigned nxt = 0u;
        __syncthreads();
        if (tid == 0) nxt = __hip_atomic_fetch_add(qctr, 1u, __ATOMIC_RELAXED, __HIP_MEMORY_SCOPE_AGENT);
        attn_unit<true>(A, b, h, qb, shm, dg ? dg + 8 : dg);
        if (tid == 0) qs[8] = (int)nxt;
        asm volatile("s_waitcnt vmcnt(0) lgkmcnt(0)" ::: "memory"); __syncthreads();
    }
}
}

constexpr int CW_TMO = 0, CW_BAR = 4096, CW_CNT = 200000;
constexpr int RING_BYTES = 131072, LDSCTL_OFF = RING_BYTES, LDS_BYTES = 147456;
constexpr int CW_FQ = 210000;
constexpr int LC_QS = 7424;
constexpr int LC_SUBO = 5120;
constexpr int LC_MISC = 0, LC_PRE = 256, LC_CNT = 512;

typedef GAS unsigned gu32;
#define RLX_AGENT __ATOMIC_RELAXED, __HIP_MEMORY_SCOPE_AGENT

#define XB_TMO      128
#define XB_XCNT(j)  (256  + 64 * (j))
#define XB_XSUB(j)  (1280 + 64 * (j))
#define XB_XGEN(j)  (2304 + 64 * (j))
#define XB_TOP      3328
#define XB_TOPGEN   3392
#define XCD_BAR_WORDS 3456
#define XB_SPIN_CAP (1u << 18)
__device__ __forceinline__ unsigned xb_ld(unsigned* p)              { return __hip_atomic_load(p, __ATOMIC_RELAXED, __HIP_MEMORY_SCOPE_AGENT); }
__device__ __forceinline__ unsigned xb_add(unsigned* p, unsigned v) { return __hip_atomic_fetch_add(p, v, __ATOMIC_RELAXED, __HIP_MEMORY_SCOPE_AGENT); }
__device__ __forceinline__ unsigned xb_xcc_id() { return (unsigned)__builtin_amdgcn_s_getreg((3 << 11) | 20) & 0xFu; }
#define XB_SPIN(cond, bar) do { unsigned _sp = 0; while (cond) { __builtin_amdgcn_s_sleep(1); \
    if ((++_sp & 255u) == 0u) { if (xb_ld(&(bar)[XB_TMO])) break; if (_sp > XB_SPIN_CAP) { atomicAdd(&(bar)[XB_TMO], 1u); break; } } } } while (0)
struct XcdBarrier { unsigned* bar; unsigned x; volatile LAS unsigned* st; };
__device__ __forceinline__ XcdBarrier xcd_barrier_post(unsigned* bar, volatile LAS unsigned* st) {
    XcdBarrier b; b.bar = bar; b.x = xb_xcc_id(); b.st = st;
    if (threadIdx.x == 0) (void)xb_add(&bar[XB_XCNT(b.x)], 1u);
    return b;
}
__device__ __forceinline__ void xcd_barrier_complete(unsigned* bar, unsigned x, unsigned& nloc, unsigned& nx) {
    const unsigned G = gridDim.x * gridDim.y * gridDim.z;
    unsigned sum, cnt, mine, sp = 0u;
    for (;;) {
        sum = 0u; cnt = 0u; mine = 0u;
#pragma unroll
        for (unsigned j = 0; j < 16; ++j) { const unsigned c = xb_ld(&bar[XB_XCNT(j)]); sum += c; cnt += (c > 0u) ? 1u : 0u; mine = (j == x) ? c : mine; }
        if (sum == G) break;
        __builtin_amdgcn_s_sleep(1);
        if ((++sp & 255u) == 0u) { if (xb_ld(&bar[XB_TMO])) break; if (sp > XB_SPIN_CAP) { atomicAdd(&bar[XB_TMO], 1u); break; } }
    }
    nloc = mine > 0u ? mine : 1u; nx = cnt > 0u ? cnt : 1u;
}
__device__ __forceinline__ void xcd_barrier(const XcdBarrier& b) {
    asm volatile("s_waitcnt vmcnt(0)" ::: "memory");
    __syncthreads();
    if (threadIdx.x == 0) {
        unsigned* bar = b.bar;
        __builtin_amdgcn_s_waitcnt(0);
        unsigned nloc = b.st[0], nx = b.st[1];
        if (nloc == 0u) { xcd_barrier_complete(bar, b.x, nloc, nx); b.st[0] = nloc; b.st[1] = nx; }
        const unsigned old = xb_add(&bar[XB_XSUB(b.x)], 1u);
        const unsigned gen = old / nloc;
        if (old + 1u == (gen + 1u) * nloc) {
            __builtin_amdgcn_fence(__ATOMIC_RELEASE, "agent");
            asm volatile("s_waitcnt vmcnt(0)" ::: "memory");
            const unsigned og = xb_add(&bar[XB_TOP], 1u);
            const unsigned tg = og / nx;
            if (og + 1u == (tg + 1u) * nx) xb_add(&bar[XB_TOPGEN], 1u);
            else XB_SPIN(xb_ld(&bar[XB_TOPGEN]) == tg, bar);
            __builtin_amdgcn_fence(__ATOMIC_ACQUIRE, "agent");
            xb_add(&bar[XB_XGEN(b.x)], 1u);
            asm volatile("s_waitcnt vmcnt(0)" ::: "memory");
        } else {
            XB_SPIN(xb_ld(&bar[XB_XGEN(b.x)]) == gen, bar);
            __builtin_amdgcn_fence(__ATOMIC_ACQUIRE, "agent");
            asm volatile("s_waitcnt vmcnt(0)" ::: "memory");
        }
    }
    __syncthreads();
}

__device__ __forceinline__ float wave_sum(float v) {
#pragma unroll
    for (int o = 1; o < 64; o <<= 1) v += __shfl_xor(v, o);
    return v;
}
#define LDS_WAIT() asm volatile("s_waitcnt lgkmcnt(0)" ::: "memory")

__device__ __forceinline__ int maprow(int kind, int n) {
    switch (kind) {
    default: return n;
    case 1: {
        if (n < 256) return n;
        if (n < 384) { const int j = n - 256, q = j >> 5, c = j & 31; return 256 + (q & 1) * 128 + (q >> 1) * 32 + c; }
        if (n < 416) return 256 + 64 + (n - 384);
        if (n < 1952) { const int f = n - 416, k3 = f >> 9, r = f & 511, hd = r >> 6, d = r & 63; return (2 + 2 * k3 + (hd >> 2)) * 256 + (d >> 5) * 128 + (hd & 3) * 32 + (d & 31); }
        return 256 + 96 + (n - 1952); }
    case 2: { const int hd = n / 96, dd = n - hd * 96; if (dd < 64) return (hd >> 2) * 256 + (dd >> 5) * 128 + (hd & 3) * 32 + (dd & 31); return 512 + (hd >> 2) * 128 + (hd & 3) * 32 + (dd - 64); }
    case 3: { const int hd = n >> 7, dd = n & 127; if (dd < 64) return (hd >> 2) * 256 + (dd >> 5) * 128 + (hd & 3) * 32 + (dd & 31); const int d = dd - 64; return 512 + (hd >> 2) * 256 + (d >> 5) * 128 + (hd & 3) * 32 + (d & 31); }
    case 4: return (n >> 7) * 256 + (n & 127);
    case 5: return (n >> 7) * 256 + 128 + (n & 127);
    case 6: return 128 + n;
    }
}
__device__ __forceinline__ void conv_item(const float* W, int K, int Nsrc, bf16_t* WT, int kind, const float* s1, const float* s2, int split, LAS float* scr, int item, int lane) {
    const int nblk = (Nsrc + 31) / 32, kb = item / nblk, nb = item - kb * nblk, k0 = 64 * kb, n0 = 32 * nb;
    const bool nv = n0 + (lane & 31) < Nsrc;
#pragma unroll 8
    for (int i = 0; i < 32; ++i) { const int kk = 2 * i + (lane >> 5); scr[kk * 33 + (lane & 31)] = nv ? W[(size_t)(k0 + kk) * Nsrc + n0 + (lane & 31)] : 0.f; }
    LDS_WAIT(); asm volatile("" ::: "memory");
    const int c = lane & 7;
    float sc[8];
#pragma unroll
    for (int e = 0; e < 8; ++e) { const int k = k0 + 8 * c + e; sc[e] = s1 ? (k < split ? s1[k] : s2[k - split]) : 1.f; }
#pragma unroll
    for (int j = 0; j < 4; ++j) { const int n = (lane >> 3) + 8 * j; const LAS float* s = scr + (8 * c) * 33 + n;
        if (n0 + n < Nsrc) { u32x4 o; o.x = cvt_pk_bf16(s[0 * 33] * sc[0], s[1 * 33] * sc[1]); o.y = cvt_pk_bf16(s[2 * 33] * sc[2], s[3 * 33] * sc[3]); o.z = cvt_pk_bf16(s[4 * 33] * sc[4], s[5 * 33] * sc[5]); o.w = cvt_pk_bf16(s[6 * 33] * sc[6], s[7 * 33] * sc[7]);
            *(u32x4*)(WT + (size_t)maprow(kind, n0 + n) * K + k0 + 8 * c) = o; } }
    LDS_WAIT(); asm volatile("" ::: "memory");
}

struct KArgs { const void* in[27]; float* out; unsigned char* ws; int ph_lo, ph_hi, li, pad; };

constexpr int I_IN = 16 * 62, I_UQ = 4 * 24, I_UKV = 2 * 32, I_OUT = 16 * 32, I_RE = 16, I_RG = 16, I_GU = NEXP * 2 * 16 * 8, I_DN = NEXP * 4 * 32, I_PG = 16 * 32, I_PP = 4 * 32;
constexpr int I_LAYER = I_IN + I_UQ + I_UKV + I_OUT + I_RE + I_RG + I_GU + I_DN + I_PG + I_PP;

struct MoeOrder {
    const LAS int* pre; const LAS unsigned* cntl; const LAS int* subo; const int* list; int npn, G, c; bool gather;
    __device__ __forceinline__ bool next(int i, Unit& u) const {
        const int L = i * G + c; const int TB = pre[32]; if (L >= TB * npn) return false;
        const int bg = L / npn, pl = L - bg * npn; int e = 0;
        for (int j = 1; j < 32; ++j) e += (pre[j] <= bg) ? 1 : 0;
        u.pm = bg; u.e = e; u.blk = bg - pre[e]; u.pn = e * npn + pl; return true;
    }
    __device__ __forceinline__ int arow(const Unit& u, int r) const {
        if (!gather) return u.pm * 256 + r;
        int li = u.blk * 256 + r; const int cn = (int)cntl[u.e]; li = li < cn ? li : cn - 1;
        return list_at(list, subo, u.e, li) >> 1;
    }
};

#ifndef MK_CUTS
#define MK_CUTS {0, 19}
#endif
constexpr int NPHASE = 19;

__global__ void __launch_bounds__(NWAVES * 64, 2) mega_fwd(KArgs args) {
    extern __shared__ __attribute__((aligned(16))) unsigned char lds_raw[];
    LAS unsigned char* lds0 = (LAS unsigned char*)lds_raw;
    volatile LAS unsigned* MISC = (volatile LAS unsigned*)(lds0 + LDSCTL_OFF + LC_MISC);
    const int G = gridDim.x; const int bx = blockIdx.x; const int vcu = (G % 8 == 0) ? (bx % 8) * (G / 8) + bx / 8 : bx;
    for (int u = threadIdx.x; u < (LDS_BYTES - LDSCTL_OFF) / 4; u += NWAVES * 64) ((LAS unsigned*)(lds0 + LDSCTL_OFF))[u] = 0u;
    __syncthreads();
    (void)xcd_barrier_post((unsigned*)(args.ws + WS_CTL) + CW_BAR + args.li * XCD_BAR_WORDS, MISC + 8);
    const int lo = args.ph_lo, hi = args.ph_hi;
#ifndef PH_MASK
#define PH_MASK 0x3ff
#endif
#define PHM(k) ((PH_MASK >> (k)) & 1)
#ifndef DUP_MASK
#define DUP_MASK 0
#endif
#define NREP(k) (((DUP_MASK >> (k)) & 1) ? 2 : 1)
#ifndef NULL_MASK
#define NULL_MASK 0
#endif
#define NULLP(k) ((NULL_MASK >> (k)) & 1)
#define IN(k) (lo <= (k) && (k) < hi)
#ifdef DIAG_SEL
#define PSTAMP(k) do { if (blockIdx.x == DIAG_BLOCK && threadIdx.x == 0 && (k) < 10) { volatile LAS unsigned long long* tp_ = (volatile LAS unsigned long long*)(lds0 + LDSCTL_OFF + 8320); const unsigned long long t_ = __builtin_amdgcn_s_memrealtime(); ((float*)(args.ws + WS_CTL))[250016 + (k)] = (float)(t_ - *tp_) * 0.01f; *tp_ = t_; } } while (0)
#else
#define PSTAMP(k) do {} while (0)
#endif
#define SEAM(k) do { if (IN(k) && IN((k) + 1)) { XcdBarrier bar_; bar_.bar = (unsigned*)(args.ws + WS_CTL) + CW_BAR + args.li * XCD_BAR_WORDS; bar_.x = xb_xcc_id(); bar_.st = (volatile LAS unsigned*)(lds0 + LDSCTL_OFF + LC_MISC) + 8; xcd_barrier(bar_); } PSTAMP(k); } while (0)
    const int NGW = G * NWAVES, NGT = G * 512;
#ifdef DIAG_SEL
    if (threadIdx.x == 0) *(volatile LAS unsigned long long*)(lds0 + LDSCTL_OFF + 8320) = __builtin_amdgcn_s_memrealtime();
#endif
#define ssx0 ((float*)(wsp + WS_SSX0))
#define ssx1 ((float*)(wsp + WS_SSX1))
#define sspp ((float*)(wsp + WS_SSPP))
#define sso ((float*)(wsp + WS_SSO))
#define ssx2 ((float*)(wsp + WS_SSX2))
#define sskpe ((float*)(wsp + WS_SSKPE))
#define ssqq ((float*)(wsp + WS_SSQQ))
#define ssqkv ((float*)(wsp + WS_SSQKV))
#define gate ((float*)(wsp + WS_GATE))
#define logf ((float*)(wsp + WS_LOGF))
#define Fc ((float*)(wsp + WS_F))
#define ssqn ((float*)(wsp + WS_SSQN))
#define ssqr ((float*)(wsp + WS_SSQR))
#define cosT ((float*)(wsp + WS_COS))
#define sinT ((float*)(wsp + WS_SIN))
#define list ((int*)(wsp + WS_LIST))
#define xbA ((bf16_t*)(wsp + WS_XBA))
#define xbB ((bf16_t*)(wsp + WS_XBB))
#define pbf ((bf16_t*)(wsp + WS_PBF))
#define Qc ((bf16_t*)(wsp + WS_QC))
#define Kvc ((bf16_t*)(wsp + WS_KVC))
#define Kpe ((bf16_t*)(wsp + WS_KPE))
#define Fq ((bf16_t*)(wsp + WS_FQ))
#define Fk ((bf16_t*)(wsp + WS_FK))
#define Fv ((bf16_t*)(wsp + WS_FV))
#define Kmla ((bf16_t*)(wsp + WS_KMLA))
#define Vmla ((bf16_t*)(wsp + WS_VMLA))
#define Qraw ((bf16_t*)(wsp + WS_QRAW))
#define ob ((bf16_t*)xo)
#define ppb ((bf16_t*)(wsp + WS_PP))
#define hid ((bf16_t*)(wsp + WS_HID))
#define c1 ((bf16_t*)(wsp + WS_C1))
#define ctl ((unsigned*)(wsp + WS_CTL))
#define Wl (wsp + WS_W + (size_t)L * W_LAYER)
#define PHASE_PTRS unsigned char* wsp = args.ws; asm volatile("" : "+s"(wsp)); const float* x_in = (const float*)args.in[0]; float* xo = args.out; (void)x_in; (void)xo; \
    int tid = threadIdx.x; asm volatile("" : "+v"(tid)); const int lane = tid & 63, wave = __builtin_amdgcn_readfirstlane(tid >> 6); (void)lane; (void)wave; \
    unsigned ldo_ = 0u; asm volatile("" : "+s"(ldo_)); LAS unsigned char* lds = lds0 + ldo_; LAS int* preL = (LAS int*)(lds + LDSCTL_OFF + LC_PRE); LAS unsigned* cntL = (LAS unsigned*)(lds + LDSCTL_OFF + LC_CNT); LAS int* suboL = (LAS int*)(lds + LDSCTL_OFF + LC_SUBO); (void)preL; (void)cntL; (void)suboL; \
    const int gw = vcu * NWAVES + wave, gt = vcu * 512 + tid; (void)gw; (void)gt
#define INF(i) ((const float*)args.in[i])

    if (PHM(0) && IN(0)) {
        PHASE_PTRS; unsigned char* ws = wsp;
        LAS float* scr = (LAS float*)(lds + wave * 16384);
        for (int rep_ = 0; rep_ < NREP(0); ++rep_) {
        for (int it = gw; it < 2 * I_LAYER; it += NGW) {
            const int L = it >= I_LAYER ? 1 : 0; int r = it - L * I_LAYER;
            if (r < I_IN) { conv_item(INF(4) + (size_t)L * DM * INC, DM, INC, (bf16_t*)(Wl + WO_IN), 1, INF(3) + L * DM, nullptr, DM, scr, r, lane); continue; } r -= I_IN;
            if (r < I_UQ) { conv_item(INF(6) + (size_t)L * 256 * 768, 256, 768, (bf16_t*)(Wl + WO_UQ), 2, INF(5) + L * 256, nullptr, 256, scr, r, lane); continue; } r -= I_UQ;
            if (r < I_UKV) { conv_item(INF(8) + (size_t)L * 128 * 1024, 128, 1024, (bf16_t*)(Wl + WO_UKV), 3, INF(7) + L * 128, nullptr, 128, scr, r, lane); continue; } r -= I_UKV;
            if (r < I_OUT) { conv_item(INF(16) + (size_t)L * DM * DM, DM, DM, (bf16_t*)(Wl + WO_OUT), 0, INF(14) + L * 512, INF(15) + L * 512, 512, scr, r, lane); continue; } r -= I_OUT;
            if (r < I_RE) { conv_item(INF(19) + (size_t)L * DM * 32, DM, 32, (bf16_t*)(Wl + WO_RT), 0, INF(17) + L * DM, nullptr, DM, scr, r, lane); continue; } r -= I_RE;
            if (r < I_RG) { conv_item(INF(18) + (size_t)L * DM * 4, DM, 4, (bf16_t*)(Wl + WO_RT), 6, INF(17) + L * DM, nullptr, DM, scr, r, lane); continue; } r -= I_RG;
            if (r < I_GU) { const int e = r >> 8, mt = (r >> 7) & 1, ii = r & 127;
                conv_item(INF(mt ? 21 : 20) + ((size_t)L * NEXP + e) * DM * 256, DM, 256, (bf16_t*)(Wl + WO_GU) + (size_t)e * 512 * DM, mt ? 5 : 4, INF(17) + L * DM, nullptr, DM, scr, ii, lane); continue; } r -= I_GU;
            if (r < I_DN) { const int e = r >> 7, ii = r & 127;
                conv_item(INF(22) + ((size_t)L * NEXP + e) * 256 * DM, 256, DM, (bf16_t*)(Wl + WO_DN) + (size_t)e * DM * 256, 0, nullptr, nullptr, 0, scr, ii, lane); continue; } r -= I_DN;
            if (r < I_PG) { conv_item(INF(24) + (size_t)L * DM * DM, DM, DM, (bf16_t*)(Wl + WO_PG), 0, INF(23) + L * DM, nullptr, DM, scr, r, lane); continue; } r -= I_PG;
            conv_item(INF(25) + (size_t)L * 256 * DM, 256, DM, (bf16_t*)(Wl + WO_PP), 0, nullptr, nullptr, 0, scr, r, lane);
        }
        for (int it = gw; it < 2 * (88 + 220); it += NGW) {
            const int L = it >= 308 ? 1 : 0; int r = it - L * 308; bf16_t* dst;
            if (r < 88) { const int lr = r < 24 ? 104 + r : 192 + (r - 24); dst = (bf16_t*)(Wl + WO_IN) + (size_t)(256 + lr) * DM; }
            else { r -= 88; const int lr = r < 96 ? 32 + r : 132 + (r - 96); dst = (bf16_t*)(Wl + WO_RT) + (size_t)lr * DM; }
            *(u32x4*)(dst + lane * 8) = (u32x4){0u, 0u, 0u, 0u}; *(u32x4*)(dst + 512 + lane * 8) = (u32x4){0u, 0u, 0u, 0u};
        }
        for (int m = gw; m < NTOK; m += NGW) { const f32x4* xr = (const f32x4*)(x_in + (size_t)m * DM) + lane; float s = 0.f; u32x2* o8 = (u32x2*)(xbA + (size_t)m * DM) + lane;
#pragma unroll
            for (int j = 0; j < 4; ++j) { const f32x4 v = xr[64 * j]; s += sum4sq(v); u32x2 w; w.x = cvt_pk_bf16(v[0], v[1]); w.y = cvt_pk_bf16(v[2], v[3]); o8[64 * j] = w; }
            s = wave_sum(s); if (lane < 16) ssx0[(size_t)m * 16 + lane] = lane == 0 ? s : 0.f; }
        for (size_t i = gt; i < (size_t)DEPTH * NTOK * 256 / 8; i += NGT) { const f32x4 a = ((const f32x4*)INF(1))[2 * i], b = ((const f32x4*)INF(1))[2 * i + 1]; ((u32x4*)pbf)[i] = pack8(a, b); }
        for (int i = gt; i < NTOK * 16; i += NGT) { const int t = i >> 4, j = i & 15; const double inv = exp2(-(double)j * (13.287712379549449 / 16.0)); const double ang = (double)((const int*)args.in[2])[t] * inv;
            cosT[i] = (float)cos(ang); sinT[i] = (float)sin(ang); }
        }
    }
    SEAM(0);

#pragma unroll 1
    for (int L = 0; L < DEPTH; ++L) {
        const int pb = 1 + 9 * L;
        if (PHM(1) && IN(pb + 0)) {
            PHASE_PTRS;
            pg8::Gemm g{xbA, (const bf16_t*)(Wl + WO_IN), DM}; pg8::StaticOrder S; S.init(NTOK, 2048, G, bx);
            EpiInProj E{wsp, INF(13) + L * 8, INF(11) + L * 64, INF(12) + L * 64};
            for (int rep_ = 0; rep_ < NREP(1); ++rep_) pg8::gemm_phase<DM, EpiInProj, pg8::StaticOrder, true>(lds, g, S, E);
            if (NULLP(1)) { EpiNull EN{(float*)(wsp + WS_SSX2)}; pg8::gemm_phase<DM, EpiNull, pg8::StaticOrder, true>(lds, g, S, EN); }
        }
        SEAM(pb + 0);
        if (PHM(2) && IN(pb + 1)) {
            PHASE_PTRS;
            { pg8::Gemm g{Qc, (const bf16_t*)(Wl + WO_UQ), 256}; pg8::StaticOrder S; S.init(NTOK, 768, G, bx);
              EpiQUp E{wsp};
              for (int rep_ = 0; rep_ < NREP(2); ++rep_) pg8::gemm_phase<256, EpiQUp, pg8::StaticOrder, true>(lds, g, S, E); }
            { pg8::Gemm g{Kvc, (const bf16_t*)(Wl + WO_UKV), 128}; pg8::StaticOrder S; S.init(NTOK, 1024, G, bx);
              EpiKvUp E{wsp, INF(10) + L * 96};
              for (int rep_ = 0; rep_ < NREP(2); ++rep_) pg8::gemm_phase<128, EpiKvUp, pg8::StaticOrder, true>(lds, g, S, E); }
            for (int v = vcu; v < 32; v += G) {
                const int b = v >> 3, h = v & 7; LAS double* wt = (LAS double*)lds;
                const size_t base = ((size_t)b * SEQ + wave * 1024 + lane * 16) * 8 + h; float lv[16]; double loc = 0.0;
#pragma unroll
                for (int i = 0; i < 16; ++i) { lv[i] = logf[base + (size_t)i * 8]; loc += (double)lv[i]; }
                double pre = loc;
#pragma unroll
                for (int o = 1; o < 64; o <<= 1) { const double n = __shfl_up(pre, o); if (lane >= o) pre += n; }
                if (lane == 63) wt[wave] = pre;
                LDS_WAIT(); __syncthreads();
                double run = pre - loc;
                for (int w = 0; w < wave; ++w) run += wt[w];
#pragma unroll
                for (int i = 0; i < 16; ++i) { run += (double)lv[i]; Fc[base + (size_t)i * 8] = (float)run; }
                __syncthreads();
            }
        }
        SEAM(pb + 1);
        if (PHM(3) && IN(pb + 2)) {
            PHASE_PTRS;
            att::Args A{Qraw, Kmla, Vmla, Fq, Fk, Fv, ssqn, ssqr, INF(9) + L * 96, cosT, sinT, Fc, INF(11) + L * 64, INF(12) + L * 64, ob, sso};
#ifdef DIAG_SEL
            LAS float* dg = (L == 0 && blockIdx.x == DIAG_BLOCK && tid == 0) ? (LAS float*)(lds0 + LDSCTL_OFF + 8192) : (LAS float*)nullptr;
            if (dg) for (int k = 0; k < 16; ++k) dg[k] = 0.f;
            att::attn_phase(A, vcu, G, (LAS char*)lds, NREP(10), NREP(11), dg, ctl + CW_FQ + 64 * L, INF(13) + L * 8, (LAS int*)(lds + LDSCTL_OFF + LC_QS));
            if (dg) { float* dw = (float*)(wsp + WS_CTL) + 250000; for (int k = 0; k < 16; ++k) dw[k] = dg[k]; }
#else
            att::attn_phase(A, vcu, G, (LAS char*)lds, NREP(10), NREP(11), (LAS float*)nullptr, ctl + CW_FQ + 64 * L, INF(13) + L * 8, (LAS int*)(lds + LDSCTL_OFF + LC_QS));
#endif
        }
        SEAM(pb + 2);
        if (PHM(4) && IN(pb + 3)) {
            PHASE_PTRS;
            pg8::Gemm g{ob, (const bf16_t*)(Wl + WO_OUT), DM}; pg8::StaticOrder S; S.init(NTOK, DM, G, bx);
            EpiOut E{wsp, L == 0 ? x_in : (const float*)nullptr};
            for (int rep_ = 0; rep_ < (L == 0 ? NREP(4) : 1); ++rep_) pg8::gemm_phase<DM, EpiOut, pg8::StaticOrder, true>(lds, g, S, E);
            if (NULLP(4)) { EpiNull EN{(float*)(wsp + WS_SSX2)}; pg8::gemm_phase<DM, EpiNull, pg8::StaticOrder, true>(lds, g, S, EN); }
        }
        SEAM(pb + 3);
        if (PHM(5) && IN(pb + 4)) {
            PHASE_PTRS;
            { pg8::Gemm g{xbB, (const bf16_t*)(Wl + WO_RT), DM}; pg8::StaticOrder S; S.init(NTOK, 256, G, bx);
              EpiRouter E{wsp, ctl + CW_CNT + 1024 * L};
              pg8::gemm_phase<DM, EpiRouter, pg8::StaticOrder, true>(lds, g, S, E); }
            { pg8::Gemm g{pbf + (size_t)L * NTOK * 256, (const bf16_t*)(Wl + WO_PP), 256}; pg8::StaticOrder S; S.init(NTOK, DM, G, bx);
              EpiPP E{wsp};
              for (int rep_ = 0; rep_ < NREP(5); ++rep_) pg8::gemm_phase<256, EpiPP, pg8::StaticOrder, true>(lds, g, S, E); }
        }
        SEAM(pb + 4);
        if ((PHM(6) && IN(pb + 5)) || (PHM(7) && IN(pb + 6))) {
            PHASE_PTRS;
            { const int e = tid >> 4, sb = tid & 15; const unsigned c = __hip_atomic_load(ctl + CW_CNT + 1024 * L + tid, RLX_AGENT); suboL[e * (NSUB + 1) + sb + 1] = (int)c; }
            LDS_WAIT(); __syncthreads();
            if (tid < 32) { int run = 0; suboL[tid * (NSUB + 1)] = 0; for (int k = 1; k <= NSUB; ++k) { run += suboL[tid * (NSUB + 1) + k]; suboL[tid * (NSUB + 1) + k] = run; } cntL[tid] = (unsigned)run; }
            LDS_WAIT(); __syncthreads();
            if (tid == 0) { int run = 0; for (int e = 0; e < 32; ++e) { preL[e] = run; run += ((int)cntL[e] + 255) >> 8; } preL[32] = run; }
            LDS_WAIT(); __syncthreads();
        }
        if (PHM(6) && IN(pb + 5)) {
            PHASE_PTRS;
            pg8::Gemm g{xbB, (const bf16_t*)(Wl + WO_GU), DM}; MoeOrder S{preL, cntL, suboL, list, 2, G, bx, true};
            EpiMoeUp E{wsp, cntL, suboL, 2};
            for (int rep_ = 0; rep_ < NREP(6); ++rep_) pg8::gemm_phase<DM, EpiMoeUp, MoeOrder, true>(lds, g, S, E);
        }
        SEAM(pb + 5);
        if (PHM(7) && IN(pb + 6)) {
            PHASE_PTRS;
            pg8::Gemm g{hid, (const bf16_t*)(Wl + WO_DN), 256}; MoeOrder S{preL, cntL, suboL, list, 4, G, bx, false};
            EpiMoeDown E{wsp, cntL, suboL, 4};
            pg8::gemm_phase<256, EpiMoeDown, MoeOrder, true>(lds, g, S, E);
        }
        SEAM(pb + 6);
        if (PHM(8) && IN(pb + 7)) {
            PHASE_PTRS;
            for (int m = gw; m < NTOK; m += NGW) { const u32x4* cr = (const u32x4*)(c1 + (size_t)m * DM) + lane; u32x4* xr = (u32x4*)(xbB + (size_t)m * DM) + lane; float s = 0.f;
#pragma unroll
                for (int j = 0; j < 2; ++j) { const u32x4 cw = cr[64 * j], xw = xr[64 * j];
                    const f32x4 v0 = (f32x4){bflo(xw.x), bfhi(xw.x), bflo(xw.y), bfhi(xw.y)} + (f32x4){bflo(cw.x), bfhi(cw.x), bflo(cw.y), bfhi(cw.y)}, v1 = (f32x4){bflo(xw.z), bfhi(xw.z), bflo(xw.w), bfhi(xw.w)} + (f32x4){bflo(cw.z), bfhi(cw.z), bflo(cw.w), bfhi(cw.w)};
                    s += sum4sq(v0) + sum4sq(v1); xr[64 * j] = pack8(v0, v1); }
                s = wave_sum(s); if (lane == 0) ssx2[m] = s; }
        }
        SEAM(pb + 7);
        if (PHM(9) && IN(pb + 8)) {
            PHASE_PTRS;
            pg8::Gemm g{xbB, (const bf16_t*)(Wl + WO_PG), DM}; pg8::StaticOrder S; S.init(NTOK, DM, G, bx);
            EpiPle E{wsp, INF(26) + L * DM, L + 1 == DEPTH ? xo : (float*)nullptr};
            pg8::gemm_phase<DM, EpiPle, pg8::StaticOrder, true>(lds, g, S, E);
        }
        if (L + 1 < DEPTH) SEAM(pb + 8);
    }
#undef IN
#undef SEAM
#undef INF
}

extern "C" void kernel_launch(void* const* d_in, const int* in_sizes, int n_in, void* d_out, int out_size, void* d_ws, size_t ws_size, hipStream_t stream) {
    static int grid = 0;
    if (grid == 0) {
        if (n_in != 27 || ws_size < WS_END) { fprintf(stderr, "kernel_launch: unexpected inputs (n_in %d, ws %zu)\n", n_in, ws_size); grid = -1; return; }
        int dev = 0, cus = 0, per_cu = 0;
        if (hipGetDevice(&dev) != hipSuccess || hipDeviceGetAttribute(&cus, hipDeviceAttributeMultiprocessorCount, dev) != hipSuccess) { grid = -1; return; }
        if (hipFuncSetAttribute((const void*)mega_fwd, hipFuncAttributeMaxDynamicSharedMemorySize, LDS_BYTES) != hipSuccess) { fprintf(stderr, "kernel_launch: hipFuncSetAttribute failed\n"); grid = -1; return; }
        if (hipOccupancyMaxActiveBlocksPerMultiprocessor(&per_cu, (const void*)mega_fwd, NWAVES * 64, LDS_BYTES) != hipSuccess || per_cu < 1) { fprintf(stderr, "kernel_launch: occupancy query says %d\n", per_cu); }
        (void)hipGetLastError();
        grid = cus;
    }
    if (grid < 0) return;
    if (hipMemsetAsync((char*)d_ws + WS_CTL, 0, CTL_ZERO_BYTES, stream) != hipSuccess) return;
    KArgs a{};
    for (int i = 0; i < 27; ++i) a.in[i] = d_in[i];
    a.out = (float*)d_out; a.ws = (unsigned char*)d_ws;
    const int cuts[] = MK_CUTS; const int nl = (int)(sizeof(cuts) / sizeof(int)) - 1;
    for (int li = 0; li < nl; ++li) {
        a.ph_lo = cuts[li]; a.ph_hi = cuts[li + 1]; a.li = li; a.pad = 0;
        hipLaunchKernelGGL(mega_fwd, dim3(grid), dim3(NWAVES * 64), LDS_BYTES, stream, a);
        if (hipPeekAtLastError() != hipSuccess) { fprintf(stderr, "kernel_launch: launch %d failed\n", li); break; }
    }
}
```

```cpp
#include <hip/hip_runtime.h>
#include <cstdio>
#include <cstdint>

#define LAS __attribute__((address_space(3)))
#define GAS __attribute__((address_space(1)))
typedef unsigned short bf16_t;
typedef short bf16x8 __attribute__((ext_vector_type(8)));
typedef short s16x4 __attribute__((ext_vector_type(4)));
typedef float f32x2 __attribute__((ext_vector_type(2)));
typedef float f32x4 __attribute__((ext_vector_type(4)));
typedef float f32x16 __attribute__((ext_vector_type(16)));
typedef unsigned u32x2 __attribute__((ext_vector_type(2)));
typedef unsigned u32x4 __attribute__((ext_vector_type(4)));

constexpr int DM = 1024, NB = 4, SEQ = 8192, NTOK = NB * SEQ, DEPTH = 2;
constexpr int INC = 1960, NEXP = 32;
constexpr int C_KVC = 256, C_KPE = 384, C_FQ = 416, C_FK = 928, C_FV = 1440, C_FL = 1952;
constexpr float EPS = 1e-6f;
constexpr float LOG2E = 1.4426950408889634f;
constexpr float C2_FOX = 0.125f * LOG2E;
constexpr float C2_MLA = 0.10206207261596575f * LOG2E;

__device__ __forceinline__ unsigned cvt_pk_bf16(float lo, float hi) { unsigned r; asm volatile("v_cvt_pk_bf16_f32 %0, %1, %2" : "=v"(r) : "v"(lo), "v"(hi)); return r; }
__device__ __forceinline__ float bf2f(unsigned short u) { return __uint_as_float((unsigned)u << 16); }
__device__ __forceinline__ float bflo(unsigned w) { return __uint_as_float(w << 16); }
__device__ __forceinline__ float bfhi(unsigned w) { return __uint_as_float(w & 0xffff0000u); }
__device__ __forceinline__ u32x4 pack8(const f32x4& a, const f32x4& b) { u32x4 w; w.x = cvt_pk_bf16(a[0], a[1]); w.y = cvt_pk_bf16(a[2], a[3]); w.z = cvt_pk_bf16(b[0], b[1]); w.w = cvt_pk_bf16(b[2], b[3]); return w; }

__device__ __forceinline__ void st16(void* p, const u32x4& v) { asm volatile("global_store_dwordx4 %0, %1, off sc1" :: "v"(p), "v"(v) : "memory"); }
__device__ __forceinline__ void st8(void* p, const u32x2& v) { asm volatile("global_store_dwordx2 %0, %1, off sc1" :: "v"(p), "v"(v) : "memory"); }
__device__ __forceinline__ void st16f(void* p, const f32x4& v) { asm volatile("global_store_dwordx4 %0, %1, off sc1" :: "v"(p), "v"(v) : "memory"); }
__device__ __forceinline__ float sum4sq(const f32x4& a) { return (a[0] * a[0] + a[1] * a[1]) + (a[2] * a[2] + a[3] * a[3]); }
__device__ __forceinline__ float red_fq(float s) { s += __shfl_xor(s, 16); s += __shfl_xor(s, 32); return s; }
__device__ __forceinline__ float sum16(const float* p) { const f32x4 a = *(const f32x4*)p, b = *(const f32x4*)(p + 4), c = *(const f32x4*)(p + 8), d = *(const f32x4*)(p + 12);
    return ((a[0] + a[1]) + (a[2] + a[3])) + ((b[0] + b[1]) + (b[2] + b[3])) + ((c[0] + c[1]) + (c[2] + c[3])) + ((d[0] + d[1]) + (d[2] + d[3])); }
__device__ __forceinline__ float sum8(const float* p) { const f32x4 a = *(const f32x4*)p, b = *(const f32x4*)(p + 4); return ((a[0] + a[1]) + (a[2] + a[3])) + ((b[0] + b[1]) + (b[2] + b[3])); }
__device__ __forceinline__ float log_sigmoid_f(float x) { return -(fmaxf(-x, 0.f) + log1pf(__expf(-fabsf(x)))); }

constexpr int NWAVES = 8;
constexpr size_t MiB = 1u << 20;
constexpr size_t WS_CTL = 0, CTL_ZERO_BYTES = 1 * MiB;
constexpr size_t WS_SSX0 = 1 * MiB, WS_SSX1 = 3 * MiB, WS_SSPP = 5 * MiB, WS_SSO = 7 * MiB, WS_SSX2 = 9 * MiB, WS_SSKPE = 10 * MiB, WS_SSQQ = 11 * MiB, WS_SSQKV = 12 * MiB,
                 WS_GATE = 13 * MiB, WS_LOGF = 14 * MiB, WS_F = 15 * MiB, WS_SSQN = 16 * MiB, WS_SSQR = 17 * MiB, WS_COS = 18 * MiB, WS_SIN = 20 * MiB, WS_LIST = 22 * MiB;
constexpr size_t WS_W = 28 * MiB, W_LAYER = 58 * MiB;
constexpr size_t WO_IN = 0, WO_UQ = 4 * MiB, WO_UKV = 4 * MiB + 512 * 1024, WO_OUT = 5 * MiB, WO_RT = 7 * MiB, WO_PG = 7 * MiB + 512 * 1024, WO_PP = 9 * MiB + 512 * 1024, WO_GU = 10 * MiB, WO_DN = 42 * MiB;
constexpr size_t WS_XBA = 144 * MiB, WS_XBB = 208 * MiB, WS_PBF = 272 * MiB, WS_MIX = 304 * MiB;
constexpr size_t WS_O = WS_XBA, WS_QRAW = WS_XBB;
constexpr size_t WS_QC = WS_MIX, WS_KVC = WS_MIX + 16 * MiB, WS_KPE = WS_MIX + 24 * MiB, WS_FQ = WS_MIX + 26 * MiB, WS_FK = WS_MIX + 58 * MiB, WS_FV = WS_MIX + 90 * MiB, WS_KMLA = WS_MIX + 122 * MiB, WS_VMLA = WS_MIX + 170 * MiB;
constexpr size_t WS_PP = WS_MIX, WS_HID = WS_MIX + 64 * MiB, WS_C1 = WS_MIX + 100 * MiB;
constexpr size_t WS_END = 512 * MiB;
static_assert(WS_VMLA + 32 * MiB <= WS_END && WS_C1 + 64 * MiB <= WS_END && WS_W + 2 * W_LAYER <= WS_XBA, "d_ws map");
constexpr int HID_ROWS = 2 * NTOK + NEXP * 256;
static_assert((size_t)HID_ROWS * 256 * 2 <= 36 * MiB, "hid");

constexpr int NSUB = 16, SUBCAP = 2048;
__device__ __forceinline__ int list_at(const int* list, const LAS int* subo, int e, int li) {
    const LAS int* so = subo + e * (NSUB + 1); int sidx = 0;
#pragma unroll
    for (int k = 1; k < NSUB; ++k) sidx += (so[k] <= li) ? 1 : 0;
    return list[(size_t)(e * NSUB + sidx) * SUBCAP + (li - so[sidx])];
}
namespace pg8 {
constexpr int TAB_OFF = 131072 + 1024;
constexpr int BM = 256, BK = 64, HALF = 128, HTB = HALF * BK * 2, STAGE_BYTES = 8 * HTB, NXCD = 8, WGM = 8;
__host__ __device__ __forceinline__ int lds_byte(int r, int c) { const int st = (r >> 4) * 2 + (c >> 5), rr = r & 15, cc = c & 31, ob = rr * 64 + cc * 2; return st * 1024 + (ob ^ (((ob >> 9) & 1) << 5)); }
__host__ __device__ __forceinline__ void stage_rc(int b, int& R, int& C) { const int st = b / 1024, sb = b % 1024, swz = sb ^ (((sb >> 9) & 1) << 5); R = (st >> 1) * 16 + swz / 64; C = (st & 1) * 32 + (swz % 64) / 2; }
__host__ __device__ __forceinline__ int perm32(int rho) { const int n = rho >> 4, i = rho & 15; return 8 * (i >> 2) + 4 * n + (i & 3); }

struct Unit { int pm, pn, e, blk; };
struct Gemm { const bf16_t* A; const bf16_t* Bt; int K; };

struct StaticOrder {
    int nM, nN, nwg, G, c;
    __device__ void init(int M, int N, int G_, int c_) { nM = M / BM; nN = N / BM; nwg = nM * nN; G = G_; c = c_; }
    __device__ bool next(int i, Unit& u) const {
        const long L = (long)i * G + c; if (L >= nwg) return false;
        int wgid = (int)L; { const int q = nwg / NXCD, r = nwg % NXCD, xcd = wgid % NXCD, off = wgid / NXCD; wgid = (xcd < r ? xcd * (q + 1) : r * (q + 1) + (xcd - r) * q) + off; }
        const int nig = WGM * nN, gid = wgid / nig, fm = gid * WGM, gsz = (nM - fm) < WGM ? (nM - fm) : WGM;
        u.pm = fm + ((wgid % nig) % gsz); u.pn = (wgid % nig) / gsz; u.e = 0; u.blk = 0; return true;
    }
    __device__ __forceinline__ int arow(const Unit& u, int r) const { return u.pm * BM + r; }
};

template <int K, class Epi, class Sched, bool ALIGN_EPI>
__device__ __forceinline__ void gemm_phase(LAS unsigned char* lds, const Gemm g, const Sched& S, const Epi& E) {
    LAS f32x2* const tab0 = (LAS f32x2*)(lds + TAB_OFF);
    int tid_ = threadIdx.x; asm volatile("" : "+v"(tid_));
    const int tid = tid_, wid = __builtin_amdgcn_readfirstlane(tid >> 6), lane = tid & 63, wr = wid >> 2, wc = wid & 3, fr = lane & 15, fq = lane >> 4;
    int Kr = K; asm volatile("" : "+s"(Kr));
    const int nt = Kr / BK;
    unsigned voffB[2];
#pragma unroll
    for (int i = 0; i < 2; ++i) { int R_, C_; stage_rc(tid * 16 + i * 8192, R_, C_); const int Rb = (R_ & ~31) + perm32(R_ & 31); voffB[i] = (unsigned)(Rb * Kr + C_) * 2u; }
    const size_t kstep = (size_t)(BK * 2);
    const size_t hstep = (size_t)HALF * Kr * 2;
    const size_t tstep = 2 * hstep;
    const unsigned ldsw = (unsigned)wid * 1024u;
    const int aoff = lds_byte(wr * 64 + fr, fq * 8), boff = lds_byte(wc * 32 + fr, fq * 8);
#define PG8_SA(b, h) (((b) * 2 + (h)) * HTB)
#define PG8_SB(b, h) ((4 + (b) * 2 + (h)) * HTB)
#define PG8_STAGE(bufoff, gbase, voff) do { _Pragma("unroll") for (int _i = 0; _i < 2; ++_i) \
        __builtin_amdgcn_global_load_lds((const unsigned*)((const char*)(gbase) + (voff)[_i]), (LAS unsigned*)(lds + (bufoff) + ldsw + _i * 8192), 16, 0, 0); } while (0)
#define PG8_LDA(dst, b, h) do { _Pragma("unroll") for (int m = 0; m < 4; ++m) _Pragma("unroll") for (int k = 0; k < 2; ++k) dst[m][k] = *(const LAS bf16x8*)(lds + PG8_SA(b, h) + aoff + m * 2048 + k * 1024); } while (0)
#define PG8_LDB(dst, b, h) do { _Pragma("unroll") for (int n = 0; n < 2; ++n) _Pragma("unroll") for (int k = 0; k < 2; ++k) dst[n][k] = *(const LAS bf16x8*)(lds + PG8_SB(b, h) + boff + n * 2048 + k * 1024); } while (0)
#define PG8_MMA(ai, bj, At, Bt) do { __builtin_amdgcn_s_setprio(1); _Pragma("unroll") for (int m = 0; m < 4; ++m) _Pragma("unroll") for (int n = 0; n < 2; ++n) _Pragma("unroll") for (int k = 0; k < 2; ++k) \
        acc[ai][bj][m][n] = __builtin_amdgcn_mfma_f32_16x16x32_bf16(Bt[n][k], At[m][k], acc[ai][bj][m][n], 0, 0, 0); __builtin_amdgcn_s_setprio(0); } while (0)
#define PG8_WAIT_V(n) asm volatile("s_waitcnt vmcnt(" #n ")" ::: "memory")
#define PG8_WAIT_L(n) asm volatile("s_waitcnt lgkmcnt(" #n ")" ::: "memory")
#define PG8_BAR __builtin_amdgcn_s_barrier()
#define PG8_SCHED __builtin_amdgcn_sched_barrier(0)
#define PG8_AOFF(dst, u) do { int _t = tid; asm volatile("" : "+v"(_t)); _Pragma("unroll") for (int _i = 0; _i < 2; ++_i) { int _R, _C; stage_rc(_t * 16 + _i * 8192, _R, _C); _Pragma("unroll") for (int _h = 0; _h < 2; ++_h) dst[_h][_i] = ((unsigned)S.arow(u, _h * HALF + _R) * (unsigned)Kr + (unsigned)_C) * 2u; } } while (0)
    Unit cur, nxt; int ui = 0;
    if (!S.next(0, cur)) return;
    f32x4 acc[2][2][4][2];
#pragma unroll
    for (int a = 0; a < 2; ++a)
#pragma unroll
        for (int b = 0; b < 2; ++b)
#pragma unroll
            for (int m = 0; m < 4; ++m)
#pragma unroll
                for (int n = 0; n < 2; ++n) acc[a][b][m][n] = (f32x4){0.f, 0.f, 0.f, 0.f};
    bf16x8 At[4][2], B0[2][2], B1[2][2];
    unsigned ca[2][2], na[2][2];
    PG8_AOFF(ca, cur);
    const char* gA = (const char*)g.A;
    const char* cB = (const char*)g.Bt + (size_t)cur.pn * tstep;
    PG8_STAGE(PG8_SB(0, 0), cB, voffB); PG8_STAGE(PG8_SB(0, 1), cB + hstep, voffB); PG8_STAGE(PG8_SA(0, 0), gA, ca[0]); PG8_STAGE(PG8_SA(0, 1), gA, ca[1]);
    if (wr == 1) PG8_BAR;
    PG8_WAIT_V(2); PG8_BAR;
    PG8_STAGE(PG8_SB(1, 0), cB + kstep, voffB); PG8_STAGE(PG8_SA(1, 0), gA + kstep, ca[0]); PG8_STAGE(PG8_SB(1, 1), cB + hstep + kstep, voffB);
    PG8_WAIT_V(6); PG8_BAR;
    for (;;) {
        const bool has_next = S.next(ui + 1, nxt);
        E.pre(cur, tab0 + (ui & 1) * 256, tid);
        if (has_next) { PG8_AOFF(na, nxt); } else {
#pragma unroll
            for (int _h = 0; _h < 2; ++_h)
#pragma unroll
                for (int _i = 0; _i < 2; ++_i) na[_h][_i] = ca[_h][_i]; }
        const char* nB = has_next ? (const char*)g.Bt + (size_t)nxt.pn * tstep : cB;
        for (int t = 0; t < nt; t += 2) {
            const bool last = (t == nt - 2);
            if constexpr (Epi::HAS_MID) { if (t == nt / 2) E.mid(acc, cur, wr, wc, fr, fq, tab0 + (ui & 1) * 256); }
            const char* a1 = gA + (size_t)(t + 1) * kstep;
            const char* a2 = last ? gA : gA + (size_t)(t + 2) * kstep; const char* b2 = last ? nB : cB + (size_t)(t + 2) * kstep;
            const char* a3 = a2 + kstep; const char* b3 = b2 + kstep;
            unsigned o2[2][2];
#pragma unroll
            for (int _h = 0; _h < 2; ++_h)
#pragma unroll
                for (int _i = 0; _i < 2; ++_i) o2[_h][_i] = last ? na[_h][_i] : ca[_h][_i];
            PG8_LDB(B0, 0, 0); PG8_LDB(B1, 0, 1); PG8_SCHED; PG8_LDA(At, 0, 0); PG8_STAGE(PG8_SA(1, 1), a1, ca[1]);
            PG8_WAIT_V(8); PG8_WAIT_L(0); PG8_BAR; PG8_MMA(0, 0, At, B0); PG8_MMA(0, 1, At, B1); PG8_BAR; PG8_SCHED;
            PG8_LDA(At, 0, 1); PG8_STAGE(PG8_SB(0, 0), b2, voffB); PG8_STAGE(PG8_SB(0, 1), b2 + hstep, voffB); PG8_STAGE(PG8_SA(0, 0), a2, o2[0]);
            PG8_WAIT_V(8); PG8_WAIT_L(0); PG8_BAR; PG8_MMA(1, 0, At, B0); PG8_MMA(1, 1, At, B1); PG8_BAR; PG8_SCHED;
            PG8_LDB(B0, 1, 0); PG8_LDB(B1, 1, 1); PG8_SCHED; PG8_LDA(At, 1, 0); PG8_STAGE(PG8_SA(0, 1), a2, o2[1]);
            PG8_WAIT_V(8); PG8_WAIT_L(0); PG8_BAR; PG8_MMA(0, 0, At, B0); PG8_MMA(0, 1, At, B1); PG8_BAR; PG8_SCHED;
            PG8_LDA(At, 1, 1); PG8_STAGE(PG8_SB(1, 0), b3, voffB); PG8_STAGE(PG8_SB(1, 1), b3 + hstep, voffB); PG8_STAGE(PG8_SA(1, 0), a3, o2[0]);
            PG8_WAIT_V(8); PG8_WAIT_L(0); PG8_BAR; PG8_MMA(1, 0, At, B0); PG8_MMA(1, 1, At, B1); PG8_BAR; PG8_SCHED;
        }
        if constexpr (ALIGN_EPI) { if (wr == 0) PG8_BAR; }
        E(acc, cur, wr, wc, fr, fq, tab0 + (ui & 1) * 256);
        if (!has_next) break;
#pragma unroll
        for (int a = 0; a < 2; ++a)
#pragma unroll
            for (int b = 0; b < 2; ++b)
#pragma unroll
                for (int m = 0; m < 4; ++m)
#pragma unroll
                    for (int n = 0; n < 2; ++n) acc[a][b][m][n] = (f32x4){0.f, 0.f, 0.f, 0.f};
        cur = nxt; cB = nB; ++ui;
#pragma unroll
        for (int _h = 0; _h < 2; ++_h)
#pragma unroll
            for (int _i = 0; _i < 2; ++_i) ca[_h][_i] = na[_h][_i];
        if constexpr (ALIGN_EPI) { if (wr == 1) PG8_BAR; }
    }
    PG8_WAIT_V(0);
    if constexpr (!ALIGN_EPI) { if (wr == 0) PG8_BAR; }
    PG8_BAR;
#undef PG8_SA
#undef PG8_SB
#undef PG8_STAGE
#undef PG8_LDA
#undef PG8_LDB
#undef PG8_MMA
#undef PG8_WAIT_V
#undef PG8_WAIT_L
#undef PG8_BAR
#undef PG8_SCHED
#undef PG8_AOFF
}
}
using pg8::Unit;
typedef f32x4 AccT[2][2][4][2];
#define EPI_ROWS8(...) _Pragma("unroll") for (int ai = 0; ai < 2; ++ai) _Pragma("unroll") for (int m = 0; m < 4; ++m) { const int rl = ai * 128 + wr * 64 + m * 16 + fr; const int row = u.pm * 256 + rl; (void)row; __VA_ARGS__ }
#define EPI_ROWS4(...) _Pragma("unroll") for (int ai = 0; ai < 2; ++ai) _Pragma("unroll") for (int m = 0; m < 4; ++m) { const int rl = ai * 128 + wr * 64 + m * 16 + fr; const int row = u.pm * 256 + rl; (void)row; __VA_ARGS__ if (m == 3) asm volatile("" ::: "memory"); }
#define EPI_ROWS(...) _Pragma("unroll") for (int ai = 0; ai < 2; ++ai) _Pragma("unroll") for (int m = 0; m < 4; ++m) { const int rl = ai * 128 + wr * 64 + m * 16 + fr; const int row = u.pm * 256 + rl; (void)row; __VA_ARGS__ if (m & 1) asm volatile("" ::: "memory"); }

struct EpiInProj {
    static constexpr bool HAS_MID = false;
    unsigned char* ws; const float *bfox, *gfq, *gfk;
    __device__ __forceinline__ void pre(const Unit& u, LAS f32x2* tab, int tid) const { if (tid < 256) { const float* ssx = (const float*)(ws + WS_SSX0); tab[tid] = (f32x2){rsqrtf(sum16(ssx + (size_t)(u.pm * 256 + tid) * 16) * (1.f / 1024.f) + EPS), 0.f}; } }
    __device__ __forceinline__ void mid(AccT&, const Unit&, int, int, int, int, const LAS f32x2*) const {}
    __device__ __forceinline__ void operator()(const AccT& acc, const Unit& u, int wr, int wc, int fr, int fq, const LAS f32x2* tab) const {
        asm volatile("" : "+v"(fr), "+v"(fq));
        const int pn = u.pn;
        const float* ssx = (const float*)(ws + WS_SSX0); bf16_t* Qc = (bf16_t*)(ws + WS_QC); bf16_t* Kvc = (bf16_t*)(ws + WS_KVC); bf16_t* Kpe = (bf16_t*)(ws + WS_KPE);
        float* ssq_q = (float*)(ws + WS_SSQQ); float* ssq_kv = (float*)(ws + WS_SSQKV); float* ss_kpe = (float*)(ws + WS_SSKPE); float* logf = (float*)(ws + WS_LOGF);
        if (pn == 0) {
            EPI_ROWS({ const float rinv = tab[rl].x; float s = 0.f;
_Pragma("unroll")
                for (int bj = 0; bj < 2; ++bj) { const f32x4 v0 = acc[ai][bj][m][0] * rinv, v1 = acc[ai][bj][m][1] * rinv; s += sum4sq(v0) + sum4sq(v1);
                    *(u32x4*)(Qc + (size_t)row * 256 + bj * 128 + wc * 32 + fq * 8) = pack8(v0, v1); }
                s = red_fq(s); if (fq == 0) ssq_q[(size_t)row * 4 + wc] = s; })
        } else if (pn == 1) {
            EPI_ROWS({ const float rinv = tab[rl].x;
                if (wc < 2) { float s = 0.f;
_Pragma("unroll")
                    for (int bj = 0; bj < 2; ++bj) { const f32x4 v0 = acc[ai][bj][m][0] * rinv, v1 = acc[ai][bj][m][1] * rinv; s += sum4sq(v0) + sum4sq(v1);
                        *(u32x4*)(Kvc + (size_t)row * 128 + wc * 64 + bj * 32 + fq * 8) = pack8(v0, v1); }
                    s = red_fq(s); if (fq == 0) ssq_kv[(size_t)row * 2 + wc] = s;
                } else if (wc == 2) { const f32x4 v0 = acc[ai][0][m][0] * rinv, v1 = acc[ai][0][m][1] * rinv; float s = sum4sq(v0) + sum4sq(v1);
                    *(u32x4*)(Kpe + (size_t)row * 32 + fq * 8) = pack8(v0, v1);
                    s = red_fq(s); if (fq == 0) ss_kpe[row] = s;
                } else { if (fq == 0) { const f32x4 v0 = acc[ai][0][m][0] * rinv, v1 = acc[ai][0][m][1] * rinv; const f32x4 b0 = *(const f32x4*)bfox, b1 = *(const f32x4*)(bfox + 4); f32x4 o0, o1;
_Pragma("unroll")
                        for (int i = 0; i < 4; ++i) { o0[i] = log_sigmoid_f(v0[i] + b0[i]); o1[i] = log_sigmoid_f(v1[i] + b1[i]); }
                        *(f32x4*)(logf + (size_t)row * 8) = o0; *(f32x4*)(logf + (size_t)row * 8 + 4) = o1; } } })
        } else {
            const int kind = (pn - 2) >> 1, head = 4 * ((pn - 2) & 1) + wc;
            bf16_t* dst = (bf16_t*)(ws + (kind == 0 ? WS_FQ : (kind == 1 ? WS_FK : WS_FV))); const float* g = kind == 0 ? gfq : gfk; const float osc = kind == 0 ? C2_FOX : 1.f;
            f32x4 g4[2][2];
_Pragma("unroll")
            for (int bj = 0; bj < 2; ++bj)
_Pragma("unroll")
                for (int n = 0; n < 2; ++n) g4[bj][n] = kind < 2 ? *(const f32x4*)(g + bj * 32 + fq * 8 + n * 4) * osc : (f32x4){1.f, 1.f, 1.f, 1.f};
            EPI_ROWS({ const float rinv = tab[rl].x; f32x4 v[2][2]; float s = 0.f;
_Pragma("unroll")
                for (int bj = 0; bj < 2; ++bj)
_Pragma("unroll")
                    for (int n = 0; n < 2; ++n) { v[bj][n] = acc[ai][bj][m][n] * rinv; s += sum4sq(v[bj][n]); }
                s = red_fq(s); const float hr = kind < 2 ? rsqrtf(s * (1.f / 64.f) + EPS) : 1.f;
_Pragma("unroll")
                for (int bj = 0; bj < 2; ++bj) { const int bb = row >> 13, tl = (row >> 6) & 127, r = row & 63; const size_t tb = ((size_t)(bb * 8 + head) * 128 + tl) * 4096;
                    const size_t off = kind == 0 ? (size_t)row * 512 + head * 64 + bj * 32 + fq * 8 : (kind == 1 ? tb + (4 * bj + fq) * 512 + r * 8 : tb + (bj * 4 + (r >> 4)) * 512 + (r & 15) * 32 + fq * 8);
                    *(u32x4*)(dst + off) = pack8(v[bj][0] * hr * g4[bj][0], v[bj][1] * hr * g4[bj][1]); } })
        }
    }
};
struct EpiQUp {
    static constexpr bool HAS_MID = false;
    unsigned char* ws;
    __device__ __forceinline__ void pre(const Unit& u, LAS f32x2* tab, int tid) const { if (tid < 256) { const f32x4 sq = *(const f32x4*)((const float*)(ws + WS_SSQQ) + (size_t)(u.pm * 256 + tid) * 4); tab[tid] = (f32x2){rsqrtf(((sq[0] + sq[1]) + (sq[2] + sq[3])) * (1.f / 256.f) + EPS), 0.f}; } }
    __device__ __forceinline__ void mid(AccT&, const Unit&, int, int, int, int, const LAS f32x2*) const {}
    __device__ __forceinline__ void operator()(const AccT& acc, const Unit& u, int wr, int wc, int fr, int fq, const LAS f32x2* tab) const {
        asm volatile("" : "+v"(fr), "+v"(fq));
        const int pn = u.pn;
        const float* ssq_q = (const float*)(ws + WS_SSQQ); bf16_t* Qraw = (bf16_t*)(ws + WS_QRAW); float* ssq_qn = (float*)(ws + WS_SSQN); float* ssq_qr = (float*)(ws + WS_SSQR);
        EPI_ROWS({ const float rinv = tab[rl].x;
            if (pn < 2) { const int head = 4 * pn + wc; float s = 0.f;
_Pragma("unroll")
                for (int bj = 0; bj < 2; ++bj) { const f32x4 v0 = acc[ai][bj][m][0] * rinv, v1 = acc[ai][bj][m][1] * rinv; s += sum4sq(v0) + sum4sq(v1);
                    *(u32x4*)(Qraw + (size_t)row * 768 + head * 96 + bj * 32 + fq * 8) = pack8(v0, v1); }
                s = red_fq(s); if (fq == 0) ssq_qn[(size_t)row * 8 + head] = s;
            } else {
_Pragma("unroll")
                for (int bj = 0; bj < 2; ++bj) { const int head = 4 * bj + wc; const f32x4 v0 = acc[ai][bj][m][0] * rinv, v1 = acc[ai][bj][m][1] * rinv; float s = sum4sq(v0) + sum4sq(v1);
                    *(u32x4*)(Qraw + (size_t)row * 768 + head * 96 + 64 + fq * 8) = pack8(v0, v1);
                    s = red_fq(s); if (fq == 0) ssq_qr[(size_t)row * 8 + head] = s; }
            } })
    }
};
struct EpiKvUp {
    static constexpr bool HAS_MID = false;
    unsigned char* ws; const float* gk;
    __device__ __forceinline__ void pre(const Unit& u, LAS f32x2* tab, int tid) const { if (tid < 256) { const size_t r = (size_t)(u.pm * 256 + tid); const f32x2 sk = *(const f32x2*)((const float*)(ws + WS_SSQKV) + r * 2); tab[tid] = (f32x2){rsqrtf((sk[0] + sk[1]) * (1.f / 128.f) + EPS), ((const float*)(ws + WS_SSKPE))[r]}; } }
    __device__ __forceinline__ void mid(AccT&, const Unit&, int, int, int, int, const LAS f32x2*) const {}
    __device__ __forceinline__ void operator()(const AccT& acc, const Unit& u, int wr, int wc, int fr, int fq, const LAS f32x2* tab) const {
        asm volatile("" : "+v"(fr), "+v"(fq));
        const int pn = u.pn;
        const float* ssq_kv = (const float*)(ws + WS_SSQKV); const float* ss_kpe = (const float*)(ws + WS_SSKPE); const bf16_t* Kpe = (const bf16_t*)(ws + WS_KPE);
        const float* cosT = (const float*)(ws + WS_COS); const float* sinT = (const float*)(ws + WS_SIN); bf16_t* Kmla = (bf16_t*)(ws + WS_KMLA); bf16_t* Vmla = (bf16_t*)(ws + WS_VMLA);
        if (pn < 2) {
            const int head = 4 * pn + wc;
            f32x4 g4[2][2];
_Pragma("unroll")
            for (int bj = 0; bj < 2; ++bj)
_Pragma("unroll")
                for (int n = 0; n < 2; ++n) g4[bj][n] = *(const f32x4*)(gk + bj * 32 + fq * 8 + n * 4);
            const f32x4 gr1 = *(const f32x4*)(gk + 64 + 4 * fq), gr2 = *(const f32x4*)(gk + 80 + 4 * fq);
            EPI_ROWS4({ const f32x2 tt = tab[rl]; const float rinv = tt.x; f32x4 v[2][2]; float s = 0.f;
_Pragma("unroll")
                for (int bj = 0; bj < 2; ++bj)
_Pragma("unroll")
                    for (int n = 0; n < 2; ++n) { v[bj][n] = acc[ai][bj][m][n] * rinv; s += sum4sq(v[bj][n]); }
                s = red_fq(s) + tt.y; const float hr = rsqrtf(s * (1.f / 96.f) + EPS);
                const int bb = row >> 13, tl = (row >> 6) & 127, r = row & 63; bf16_t* kd = Kmla + ((size_t)(bb * 8 + head) * 128 + tl) * 6144 + r * 8;
_Pragma("unroll")
                for (int bj = 0; bj < 2; ++bj) *(u32x4*)(kd + (4 * bj + fq) * 512) = pack8(v[bj][0] * hr * g4[bj][0], v[bj][1] * hr * g4[bj][1]);
                const u32x2 p1 = *(const u32x2*)(Kpe + (size_t)row * 32 + 4 * fq), p2 = *(const u32x2*)(Kpe + (size_t)row * 32 + 16 + 4 * fq);
                const f32x4 c = *(const f32x4*)(cosT + (size_t)row * 16 + 4 * fq), sn = *(const f32x4*)(sinT + (size_t)row * 16 + 4 * fq);
                const f32x4 x1 = (f32x4){bflo(p1.x), bfhi(p1.x), bflo(p1.y), bfhi(p1.y)} * hr * gr1, x2 = (f32x4){bflo(p2.x), bfhi(p2.x), bflo(p2.y), bfhi(p2.y)} * hr * gr2;
                const f32x4 o1 = x1 * c - x2 * sn, o2 = x2 * c + x1 * sn;
                u32x2 w1, w2; w1.x = cvt_pk_bf16(o1[0], o1[1]); w1.y = cvt_pk_bf16(o1[2], o1[3]); w2.x = cvt_pk_bf16(o2[0], o2[1]); w2.y = cvt_pk_bf16(o2[2], o2[3]);
                *(u32x2*)(kd + (8 + (fq >> 1)) * 512 + 4 * (fq & 1)) = w1; *(u32x2*)(kd + (10 + (fq >> 1)) * 512 + 4 * (fq & 1)) = w2; })
        } else {
            const int head = 4 * (pn - 2) + wc;
            EPI_ROWS({ const f32x2 tt = tab[rl]; const float rinv = tt.x;
_Pragma("unroll")
                for (int bj = 0; bj < 2; ++bj) { const int bb = row >> 13, tl = (row >> 6) & 127, r = row & 63;
                    *(u32x4*)(Vmla + ((size_t)(bb * 8 + head) * 128 + tl) * 4096 + (bj * 4 + (r >> 4)) * 512 + (r & 15) * 32 + fq * 8) = pack8(acc[ai][bj][m][0] * rinv, acc[ai][bj][m][1] * rinv); } })
        }
    }
};
struct EpiOut {
    static constexpr bool HAS_MID = true;
    unsigned char* ws; const float* base;
    __device__ __forceinline__ void pre(const Unit& u, LAS f32x2* tab, int tid) const { if (tid < 256) { const float* sso = (const float*)(ws + WS_SSO) + (size_t)(u.pm * 256 + tid) * 16;
        const float rm = rsqrtf(sum8(sso) * (1.f / 512.f) + EPS), rf = rsqrtf(sum8(sso + 8) * (1.f / 512.f) + EPS); tab[tid] = (f32x2){rm / rf, rf}; } }
    __device__ __forceinline__ void mid(AccT& acc, const Unit& u, int wr, int wc, int fr, int fq, const LAS f32x2* tab) const {
        EPI_ROWS({ const float ratio = tab[rl].x;
_Pragma("unroll")
            for (int bj = 0; bj < 2; ++bj)
_Pragma("unroll")
                for (int n = 0; n < 2; ++n) acc[ai][bj][m][n] *= ratio; })
    }
    __device__ __forceinline__ void operator()(const AccT& acc, const Unit& u, int wr, int wc, int fr, int fq, const LAS f32x2* tab) const {
        asm volatile("" : "+v"(fr), "+v"(fq));
        bf16_t* xb = (bf16_t*)(ws + WS_XBB); const bf16_t* xa = (const bf16_t*)(ws + WS_XBA); float* ssx1 = (float*)(ws + WS_SSX1);
        EPI_ROWS8({ const float rf = tab[rl].y; float s = 0.f;
_Pragma("unroll")
            for (int bj = 0; bj < 2; ++bj) { const size_t off = (size_t)row * 1024 + u.pn * 256 + bj * 128 + wc * 32 + fq * 8; f32x4 b0, b1;
                { const u32x4 w = *(const u32x4*)(xa + off); b0 = (f32x4){bflo(w.x), bfhi(w.x), bflo(w.y), bfhi(w.y)}; b1 = (f32x4){bflo(w.z), bfhi(w.z), bflo(w.w), bfhi(w.w)}; }
                const f32x4 v0 = b0 + acc[ai][bj][m][0] * rf, v1 = b1 + acc[ai][bj][m][1] * rf; s += sum4sq(v0) + sum4sq(v1);
                *(u32x4*)(xb + off) = pack8(v0, v1); }
            s = red_fq(s); if (fq == 0) ssx1[(size_t)row * 16 + u.pn * 4 + wc] = s; })
    }
};
struct EpiRouter {
    static constexpr bool HAS_MID = false;
    unsigned char* ws; unsigned* cnt;
    __device__ __forceinline__ void pre(const Unit& u, LAS f32x2* tab, int tid) const { if (tid < 256) { const float* ssx1 = (const float*)(ws + WS_SSX1); tab[tid] = (f32x2){rsqrtf(sum16(ssx1 + (size_t)(u.pm * 256 + tid) * 16) * (1.f / 1024.f) + EPS), 0.f}; } }
    __device__ __forceinline__ void mid(AccT&, const Unit&, int, int, int, int, const LAS f32x2*) const {}
    __device__ __forceinline__ void operator()(const AccT& acc, const Unit& u, int wr, int wc, int fr, int fq, const LAS f32x2* tab) const {
        asm volatile("" : "+v"(fr), "+v"(fq));
        if (wc != 0) return;
        float* gate = (float*)(ws + WS_GATE); int* list = (int*)(ws + WS_LIST);
        EPI_ROWS({ const float rinv = tab[rl].x;
            const f32x4 gl = acc[ai][1][m][0] * rinv; int g = 0; float gm = gl[0];
_Pragma("unroll")
            for (int j = 1; j < 4; ++j) if (gl[j] > gm) { gm = gl[j]; g = j; }
            float gs = 0.f;
_Pragma("unroll")
            for (int j = 0; j < 4; ++j) gs += __expf(gl[j] - gm);
            float pg = 1.f / gs;
            g = __shfl(g, fr); pg = __shfl(pg, fr);
            if (fq == g) { float le[8];
_Pragma("unroll")
                for (int j = 0; j < 4; ++j) { le[j] = acc[ai][0][m][0][j] * rinv; le[4 + j] = acc[ai][0][m][1][j] * rinv; }
                int i1 = 0; float m1 = le[0];
_Pragma("unroll")
                for (int j = 1; j < 8; ++j) if (le[j] > m1) { m1 = le[j]; i1 = j; }
                int i2 = 0; float m2 = -3.0e38f;
_Pragma("unroll")
                for (int j = 0; j < 8; ++j) if (j != i1 && le[j] > m2) { m2 = le[j]; i2 = j; }
                const float e2 = __expf(m2 - m1), w1 = 1.f / (1.f + e2), w2 = e2 * w1;
                gate[2 * (size_t)row] = pg * w1; gate[2 * (size_t)row + 1] = pg * w2;
                const int ea = g * 8 + i1, eb = g * 8 + i2;
                const int sl = u.pm & (NSUB - 1);
                const unsigned pa = __hip_atomic_fetch_add(cnt + ea * NSUB + sl, 1u, __ATOMIC_RELAXED, __HIP_MEMORY_SCOPE_AGENT); list[(size_t)(ea * NSUB + sl) * SUBCAP + pa] = 2 * row;
                const unsigned pb = __hip_atomic_fetch_add(cnt + eb * NSUB + sl, 1u, __ATOMIC_RELAXED, __HIP_MEMORY_SCOPE_AGENT); list[(size_t)(eb * NSUB + sl) * SUBCAP + pb] = 2 * row + 1; } })
    }
};
struct EpiPP {
    static constexpr bool HAS_MID = false;
    unsigned char* ws;
    __device__ __forceinline__ void pre(const Unit&, LAS f32x2*, int) const {}
    __device__ __forceinline__ void mid(AccT&, const Unit&, int, int, int, int, const LAS f32x2*) const {}
    __device__ __forceinline__ void operator()(const AccT& acc, const Unit& u, int wr, int wc, int fr, int fq, const LAS f32x2* tab) const {
        asm volatile("" : "+v"(fr), "+v"(fq));
        bf16_t* pp = (bf16_t*)(ws + WS_PP); float* sspp = (float*)(ws + WS_SSPP);
        EPI_ROWS({ float s = 0.f;
_Pragma("unroll")
            for (int bj = 0; bj < 2; ++bj) { const f32x4 v0 = acc[ai][bj][m][0], v1 = acc[ai][bj][m][1]; s += sum4sq(v0) + sum4sq(v1);
                *(u32x4*)(pp + (size_t)row * 1024 + u.pn * 256 + bj * 128 + wc * 32 + fq * 8) = pack8(v0, v1); }
            s = red_fq(s); if (fq == 0) sspp[(size_t)row * 16 + u.pn * 4 + wc] = s; })
    }
};
struct EpiMoeUp {
    static constexpr bool HAS_MID = false;
    unsigned char* ws; const LAS unsigned* cntv; const LAS int* subo; int npn;
    __device__ __forceinline__ void pre(const Unit& u, LAS f32x2* tab, int tid) const { if (tid < 256) { const int li = u.blk * 256 + tid; float rinv = 0.f;
        if (li < (int)cntv[u.e]) { const int tok = list_at((const int*)(ws + WS_LIST), subo, u.e, li) >> 1; rinv = rsqrtf(sum16((const float*)(ws + WS_SSX1) + (size_t)tok * 16) * (1.f / 1024.f) + EPS); }
        tab[tid] = (f32x2){rinv, 0.f}; } }
    __device__ __forceinline__ void mid(AccT&, const Unit&, int, int, int, int, const LAS f32x2*) const {}
    __device__ __forceinline__ void operator()(const AccT& acc, const Unit& u, int wr, int wc, int fr, int fq, const LAS f32x2* tab) const {
        asm volatile("" : "+v"(fr), "+v"(fq));
        const int pnl = u.pn - u.e * npn;
        bf16_t* hid = (bf16_t*)(ws + WS_HID);
        EPI_ROWS({ const float rinv = tab[rl].x;
            f32x4 h[2];
_Pragma("unroll")
            for (int n = 0; n < 2; ++n) { const f32x4 gg = acc[ai][0][m][n] * rinv, uu = acc[ai][1][m][n] * rinv;
_Pragma("unroll")
                for (int i = 0; i < 4; ++i) h[n][i] = gg[i] * __builtin_amdgcn_rcpf(1.f + __expf(-gg[i])) * uu[i]; }
            *(u32x4*)(hid + (size_t)row * 256 + pnl * 128 + wc * 32 + fq * 8) = pack8(h[0], h[1]); })
    }
};
struct EpiMoeDown {
    static constexpr bool HAS_MID = false;
    unsigned char* ws; const LAS unsigned* cntv; const LAS int* subo; int npn;
    __device__ __forceinline__ void pre(const Unit& u, LAS f32x2* tab, int tid) const { if (tid < 256) { const int li = u.blk * 256 + tid; int aid = -1; float gt = 0.f;
        if (li < (int)cntv[u.e]) { aid = list_at((const int*)(ws + WS_LIST), subo, u.e, li); gt = ((const float*)(ws + WS_GATE))[aid]; }
        tab[tid] = (f32x2){gt, __int_as_float(aid)}; } }
    __device__ __forceinline__ void mid(AccT&, const Unit&, int, int, int, int, const LAS f32x2*) const {}
    __device__ __forceinline__ void operator()(const AccT& acc, const Unit& u, int wr, int wc, int fr, int fq, const LAS f32x2* tab) const {
        asm volatile("" : "+v"(fr), "+v"(fq));
        const int pnl = u.pn - u.e * npn;
        bf16_t* c1 = (bf16_t*)(ws + WS_C1); bf16_t* xb = (bf16_t*)(ws + WS_XBB);
        EPI_ROWS8({ const f32x2 tt = tab[rl]; const int aid = __float_as_int(tt.y);
            if (aid >= 0) { const int tok = aid >> 1; const float gt = tt.x;
_Pragma("unroll")
                for (int bj = 0; bj < 2; ++bj) { const size_t off = (size_t)tok * 1024 + pnl * 256 + bj * 128 + wc * 32 + fq * 8; const f32x4 v0 = acc[ai][bj][m][0] * gt, v1 = acc[ai][bj][m][1] * gt;
                    if (aid & 1) *(u32x4*)(c1 + off) = pack8(v0, v1);
                    else { const u32x4 w = *(const u32x4*)(xb + off); *(u32x4*)(xb + off) = pack8((f32x4){bflo(w.x), bfhi(w.x), bflo(w.y), bfhi(w.y)} + v0, (f32x4){bflo(w.z), bfhi(w.z), bflo(w.w), bfhi(w.w)} + v1); } } } })
    }
};
struct EpiPle {
    static constexpr bool HAS_MID = false;
    unsigned char* ws; const float* gpo; float* xout;
    __device__ __forceinline__ void pre(const Unit& u, LAS f32x2* tab, int tid) const { if (tid < 256) { const size_t r = (size_t)(u.pm * 256 + tid);
        tab[tid] = (f32x2){rsqrtf(((const float*)(ws + WS_SSX2))[r] * (1.f / 1024.f) + EPS), rsqrtf(sum16((const float*)(ws + WS_SSPP) + r * 16) * (1.f / 1024.f) + EPS)}; } }
    __device__ __forceinline__ void mid(AccT&, const Unit&, int, int, int, int, const LAS f32x2*) const {}
    __device__ __forceinline__ void operator()(const AccT& acc, const Unit& u, int wr, int wc, int fr, int fq, const LAS f32x2* tab) const {
        asm volatile("" : "+v"(fr), "+v"(fq));
        const bf16_t* pp = (const bf16_t*)(ws + WS_PP); bf16_t* xbn = (bf16_t*)(ws + WS_XBA); const bf16_t* xb = (const bf16_t*)(ws + WS_XBB); float* ssx0 = (float*)(ws + WS_SSX0);
        f32x4 g4[2][2];
_Pragma("unroll")
        for (int bj = 0; bj < 2; ++bj)
_Pragma("unroll")
            for (int n = 0; n < 2; ++n) g4[bj][n] = *(const f32x4*)(gpo + u.pn * 256 + bj * 128 + wc * 32 + fq * 8 + n * 4);
        EPI_ROWS4({ const f32x2 tt = tab[rl]; const float r2 = tt.x, rp = tt.y; float s = 0.f;
_Pragma("unroll")
            for (int bj = 0; bj < 2; ++bj) { const size_t off = (size_t)row * 1024 + u.pn * 256 + bj * 128 + wc * 32 + fq * 8;
                const u32x4 pw = *(const u32x4*)(pp + off); const f32x4 p0 = (f32x4){bflo(pw.x), bfhi(pw.x), bflo(pw.y), bfhi(pw.y)} * rp * g4[bj][0], p1 = (f32x4){bflo(pw.z), bfhi(pw.z), bflo(pw.w), bfhi(pw.w)} * rp * g4[bj][1];
                const u32x4 xw = *(const u32x4*)(xb + off); f32x4 v0 = (f32x4){bflo(xw.x), bfhi(xw.x), bflo(xw.y), bfhi(xw.y)}, v1 = (f32x4){bflo(xw.z), bfhi(xw.z), bflo(xw.w), bfhi(xw.w)};
_Pragma("unroll")
                for (int i = 0; i < 4; ++i) { v0[i] += p0[i] * __builtin_amdgcn_rcpf(1.f + __expf(-acc[ai][bj][m][0][i] * r2)); v1[i] += p1[i] * __builtin_amdgcn_rcpf(1.f + __expf(-acc[ai][bj][m][1][i] * r2)); }
                s += sum4sq(v0) + sum4sq(v1);
#ifdef DIAG_SEL
                if (xout) { const float dv_ = (DIAG_SEL >= 80 && DIAG_SEL < 96) ? (float)(((const int*)(ws + WS_CTL))[250000 + DIAG_SEL] & 1023) : ((const float*)(ws + WS_CTL))[250000 + DIAG_SEL]; const float dsc_ = 1.f + sqrtf(dv_ * DIAG_SCALE); v0 *= dsc_; v1 *= dsc_; }
#endif
                if (xout) { *(f32x4*)(xout + off) = v0; *(f32x4*)(xout + off + 4) = v1; } else *(u32x4*)(xbn + off) = pack8(v0, v1); }
            s = red_fq(s); if (fq == 0 && !xout) ssx0[(size_t)row * 16 + u.pn * 4 + wc] = s; })
    }
};

struct EpiNull {
    static constexpr bool HAS_MID = false;
    float* sink;
    __device__ __forceinline__ void pre(const Unit&, LAS f32x2*, int) const {}
    __device__ __forceinline__ void mid(AccT&, const Unit&, int, int, int, int, const LAS f32x2*) const {}
    __device__ __forceinline__ void operator()(const AccT& acc, const Unit& u, int wr, int wc, int fr, int fq, const LAS f32x2* tab) const {
        f32x4 s = (f32x4){0.f, 0.f, 0.f, 0.f};
        EPI_ROWS({ s += (acc[ai][0][m][0] + acc[ai][0][m][1]) + (acc[ai][1][m][0] + acc[ai][1][m][1]); })
        if (s[0] + s[1] + s[2] + s[3] == 1.2345678e33f) sink[0] = s[0];
    }
};

namespace att {
constexpr int NS = 4, VSLOT = 8192;
template <bool FOX> struct Lay { static constexpr int KSLOT = FOX ? 8192 : 12288, L_K = 0, L_V = NS * KSLOT, L_WS = L_V + NS * VSLOT, L_G = L_WS + 2048, L_END = L_G + (FOX ? 32768 : 0), L_OST = 0; };
static_assert(Lay<true>::L_END <= 131072 && Lay<false>::L_END <= 131072 && NS * 8192 >= 32768, "attention LDS map");
constexpr float SKIP_NATS = 40.f;
typedef LAS const char* lds_cptr;
typedef short v4i16_t __attribute__((ext_vector_type(4)));

__device__ __forceinline__ void glds16(const void* gsrc, unsigned lds_dst) { unsigned keep;
    asm volatile("s_mov_b32 %0, m0\n\ts_mov_b32 m0, %2\n\ts_nop 0\n\tglobal_load_lds_dwordx4 %1, off\n\ts_mov_b32 m0, %0" : "=&s"(keep) : "v"(gsrc), "s"(lds_dst) : "memory"); }
__device__ __forceinline__ int crow(int r, int hi) { return (r & 3) + 8 * (r >> 2) + 4 * hi; }
__device__ __forceinline__ s16x4 vtr(lds_cptr p) { return __builtin_bit_cast(s16x4, __builtin_amdgcn_ds_read_tr16_b64_v4i16((LAS v4i16_t*)p)); }
__device__ __forceinline__ float swapmax(float m) { auto rr = __builtin_amdgcn_permlane32_swap(__float_as_uint(m), __float_as_uint(m), false, false); return fmaxf(__uint_as_float(rr[0]), __uint_as_float(rr[1])); }
__device__ __forceinline__ float swapsum(float m) { auto rr = __builtin_amdgcn_permlane32_swap(__float_as_uint(m), __float_as_uint(m), false, false); return __uint_as_float(rr[0]) + __uint_as_float(rr[1]); }
__device__ __forceinline__ bf16x8 pk8(const f32x16& p, int b) { u32x4 w; w.x = cvt_pk_bf16(p[b], p[b + 1]); w.y = cvt_pk_bf16(p[b + 2], p[b + 3]); w.z = cvt_pk_bf16(p[b + 4], p[b + 5]); w.w = cvt_pk_bf16(p[b + 6], p[b + 7]); return __builtin_bit_cast(bf16x8, w); }

struct Args {
    const bf16_t *Qraw, *Kmla, *Vmla, *Fq, *Fk, *Fv; const float *ssq_qn, *ssq_qr, *gmq, *cosT, *sinT, *F, *gfq, *gfk; bf16_t* o; float* sso;
};

#ifdef DIAG_SEL
#define STAMP(k) do { if (dg) { const unsigned long long t_ = __builtin_amdgcn_s_memrealtime(); dg[k] += (float)(t_ - tprev_) * 0.01f; tprev_ = t_; } } while (0)
#else
#define STAMP(k) do {} while (0)
#endif
template <bool FOX>
__device__ __forceinline__ void attn_unit(const Args& A, int b, int h, int qb, LAS char* shm, LAS float* dg) {
#ifdef DIAG_SEL
    unsigned long long tprev_ = __builtin_amdgcn_s_memrealtime();
#endif
    constexpr int DK = FOX ? 64 : 96, NQ = DK / 16, KP = FOX ? 512 : 768;
    constexpr int KSLOT = Lay<FOX>::KSLOT, L_K = Lay<FOX>::L_K, L_V = Lay<FOX>::L_V, L_WS = Lay<FOX>::L_WS, L_G = Lay<FOX>::L_G, L_OST = Lay<FOX>::L_OST;
    int tid_ = threadIdx.x; asm volatile("" : "+v"(tid_));
    const int tid = tid_, lane = tid & 63, r32 = lane & 31, hi = lane >> 5; const int wid = __builtin_amdgcn_readfirstlane(tid >> 6);
    const long rowbase = (long)b * SEQ; const int q0 = qb * 256, qw = q0 + wid * 32;
    const unsigned lds0 = (unsigned)(uintptr_t)shm;
    LAS float* wsf = (LAS float*)(shm + L_WS) + wid * 64;
    LAS float* Gl = (LAS float*)(shm + L_G);
    const int NT = (q0 + 256) / 64; const int tw_last = qw >> 6;
    int t0 = 0;
    if constexpr (FOX) {
        float gq = fmaxf(fabsf(A.gfq[lane]), 0.f), gk = fabsf(A.gfk[lane]);
#pragma unroll
        for (int o = 32; o > 0; o >>= 1) { gq = fmaxf(gq, __shfl_xor(gq, o)); gk = fmaxf(gk, __shfl_xor(gk, o)); }
        const float margin = 2.f * (8.f * gq * gk) + SKIP_NATS;
        const float Fref = A.F[(rowbase + q0) * 8 + h];
        const int nfull = q0 / 64;
        bool keep0 = true, keep1 = true;
        if (lane < nfull) keep0 = (Fref - A.F[(rowbase + 64 * lane + 63) * 8 + h]) >= -margin;
        if (lane + 64 < nfull) keep1 = (Fref - A.F[(rowbase + 64 * (lane + 64) + 63) * 8 + h]) >= -margin;
        const unsigned long long k0 = __ballot(keep0), k1 = __ballot(keep1);
        t0 = k0 ? __builtin_ctzll(k0) : 64 + (k1 ? __builtin_ctzll(k1) : 0);
        t0 = __builtin_amdgcn_readfirstlane(t0);
        const int nk = q0 + 256 - 64 * t0;
        for (int j = tid; j < nk; j += 512) Gl[j] = (Fref - A.F[(rowbase + 64 * t0 + j) * 8 + h]) * LOG2E;
    }
    const bf16_t* Kg = (FOX ? A.Fk : A.Kmla) + (long)(b * 8 + h) * 128 * (KSLOT / 2) + wid * 512 + lane * 8;
    const bf16_t* Vg = (FOX ? A.Fv : A.Vmla) + (long)(b * 8 + h) * 128 * 4096 + wid * 512 + lane * 8;
    const unsigned kdst = lds0 + L_K + wid * 1024, vdst = lds0 + L_V + wid * 1024;
    const bool k2 = (!FOX) && wid < 4;
#define ISSUE_K(t, sl) do { glds16(Kg + (long)(t) * (KSLOT / 2), (unsigned)__builtin_amdgcn_readfirstlane(kdst + (sl) * KSLOT)); \
        if (k2) glds16(Kg + (long)(t) * (KSLOT / 2) + 4096, (unsigned)__builtin_amdgcn_readfirstlane(kdst + (sl) * KSLOT + 8192)); } while (0)
#define ISSUE_V(t, sl) glds16(Vg + (long)(t) * 4096, (unsigned)__builtin_amdgcn_readfirstlane(vdst + (sl) * VSLOT))
    const int nti = NT - t0;
    ISSUE_K(t0, 0); ISSUE_K(t0 + 1, 1); ISSUE_K(t0 + 2, 2); ISSUE_V(t0, 0); ISSUE_K(t0 + 3, 3); ISSUE_V(t0 + 1, 1);
    bf16x8 qr[NQ];
    {
        const long row = rowbase + qw + r32;
        if constexpr (FOX) {
#pragma unroll
            for (int d0 = 0; d0 < NQ; ++d0) qr[d0] = *(const bf16x8*)(A.Fq + row * 512 + h * 64 + d0 * 16 + hi * 8);
        } else {
            const float ss = A.ssq_qn[row * 8 + h] + A.ssq_qr[row * 8 + h]; const float sc = rsqrtf(ss * (1.f / 96.f) + EPS) * C2_MLA;
            f32x4 qa[NQ][2];
#pragma unroll
            for (int d0 = 0; d0 < NQ; ++d0) { const u32x4 w = *(const u32x4*)(A.Qraw + row * 768 + h * 96 + d0 * 16 + hi * 8);
                const f32x4 g0 = *(const f32x4*)(A.gmq + d0 * 16 + hi * 8), g1 = *(const f32x4*)(A.gmq + d0 * 16 + hi * 8 + 4);
                qa[d0][0] = (f32x4){bflo(w.x), bfhi(w.x), bflo(w.y), bfhi(w.y)} * sc * g0; qa[d0][1] = (f32x4){bflo(w.z), bfhi(w.z), bflo(w.w), bfhi(w.w)} * sc * g1; }
#pragma unroll
            for (int e = 0; e < 2; ++e) { const f32x4 c = *(const f32x4*)(A.cosT + row * 16 + hi * 8 + e * 4), s = *(const f32x4*)(A.sinT + row * 16 + hi * 8 + e * 4);
                const f32x4 x1 = qa[4][e], x2 = qa[5][e]; qa[4][e] = x1 * c - x2 * s; qa[5][e] = x2 * c + x1 * s; }
#pragma unroll
            for (int d0 = 0; d0 < NQ; ++d0) qr[d0] = __builtin_bit_cast(bf16x8, pack8(qa[d0][0], qa[d0][1]));
        }
    }
    constexpr float THR = 8.f;
    float mhat = 0.f, lrun = 0.f; f32x16 o[2]; o[0] = f32x16{}; o[1] = f32x16{};
    const lds_cptr shm3 = (lds_cptr)shm;
    const lds_cptr kp0 = shm3 + L_K + hi * 1024 + r32 * 16;
    const lds_cptr vp0 = shm3 + L_V + ((lane >> 4) & 1) * 32 + (lane & 3) * 8 + (4 * hi + ((lane & 15) >> 2)) * 64;
    u32x4 pw[4]; f32x16 pp0, pp1, c0, c1; bf16x8 kf[2 * NQ]; s16x4 vlo[8], vhi[8];
    const int nK = k2 ? 2 : 1;
#define WV_(k) case k: asm volatile("s_waitcnt vmcnt(" #k ")" ::: "memory"); break;
#define WAITV(n) do { switch (n) { WV_(0) WV_(1) WV_(2) WV_(3) WV_(4) WV_(5) default: asm volatile("s_waitcnt vmcnt(6)" ::: "memory"); break; } } while (0)
#define LBAR() asm volatile("s_waitcnt lgkmcnt(0)\n\ts_barrier" ::: "memory")
#define SGB(mask, n) __builtin_amdgcn_sched_group_barrier(mask, n, 0)
#define SFENCE() __builtin_amdgcn_sched_barrier(0)
#define KREAD(rel) { const lds_cptr kp = kp0 + ((rel) % NS) * KSLOT; \
        _Pragma("unroll") for (int d0 = 0; d0 < NQ; ++d0) { kf[2 * d0] = *(const LAS bf16x8*)(kp + d0 * 2048); kf[2 * d0 + 1] = *(const LAS bf16x8*)(kp + d0 * 2048 + 512); } }
#define VREAD(rel) { const lds_cptr vp = vp0 + ((rel) % NS) * VSLOT; \
        _Pragma("unroll") for (int i = 0; i < 8; ++i) { vlo[i] = vtr(vp + (i >> 2) * 4096 + (i & 3) * 1024); vhi[i] = vtr(vp + (i >> 2) * 4096 + (i & 3) * 1024 + 512); } }
#define PKV(k) (bf16x8){vlo[k][0], vlo[k][1], vlo[k][2], vlo[k][3], vhi[k][0], vhi[k][1], vhi[k][2], vhi[k][3]}
#define QKMM(rel) do { const float cb = (t0 + (rel) > tw_last) ? -INFINITY : -mhat; \
        _Pragma("unroll") for (int r = 0; r < 16; ++r) { c0[r] = cb; c1[r] = cb; } \
        _Pragma("unroll") for (int d0 = 0; d0 < NQ; ++d0) { c0 = __builtin_amdgcn_mfma_f32_32x32x16_bf16(kf[2 * d0], qr[d0], c0, 0, 0, 0); c1 = __builtin_amdgcn_mfma_f32_32x32x16_bf16(kf[2 * d0 + 1], qr[d0], c1, 0, 0, 0); } } while (0)
#define PVMM() do { \
        o[0] = __builtin_amdgcn_mfma_f32_32x32x16_bf16(__builtin_bit_cast(bf16x8, pw[0]), PKV(0), o[0], 0, 0, 0); o[1] = __builtin_amdgcn_mfma_f32_32x32x16_bf16(__builtin_bit_cast(bf16x8, pw[0]), PKV(4), o[1], 0, 0, 0); \
        o[0] = __builtin_amdgcn_mfma_f32_32x32x16_bf16(__builtin_bit_cast(bf16x8, pw[1]), PKV(1), o[0], 0, 0, 0); o[1] = __builtin_amdgcn_mfma_f32_32x32x16_bf16(__builtin_bit_cast(bf16x8, pw[1]), PKV(5), o[1], 0, 0, 0); \
        o[0] = __builtin_amdgcn_mfma_f32_32x32x16_bf16(__builtin_bit_cast(bf16x8, pw[2]), PKV(2), o[0], 0, 0, 0); o[1] = __builtin_amdgcn_mfma_f32_32x32x16_bf16(__builtin_bit_cast(bf16x8, pw[2]), PKV(6), o[1], 0, 0, 0); \
        o[0] = __builtin_amdgcn_mfma_f32_32x32x16_bf16(__builtin_bit_cast(bf16x8, pw[3]), PKV(3), o[0], 0, 0, 0); o[1] = __builtin_amdgcn_mfma_f32_32x32x16_bf16(__builtin_bit_cast(bf16x8, pw[3]), PKV(7), o[1], 0, 0, 0); } while (0)
#define SUMPACK() do { float sa = pp0[0] + pp0[1], sb = pp1[0] + pp1[1]; \
        _Pragma("unroll") for (int r = 2; r < 16; r += 2) { sa += pp0[r] + pp0[r + 1]; sb += pp1[r] + pp1[r + 1]; } \
        lrun += sa + sb; pw[0] = __builtin_bit_cast(u32x4, pk8(pp0, 0)); pw[1] = __builtin_bit_cast(u32x4, pk8(pp0, 8)); pw[2] = __builtin_bit_cast(u32x4, pk8(pp1, 0)); pw[3] = __builtin_bit_cast(u32x4, pk8(pp1, 8)); } while (0)
#define MX3(a, b, c) __builtin_fmaxf(__builtin_fmaxf((a), (b)), (c))
#define BIASMASK(rel) do { if constexpr (FOX) { const int tt_ = t0 + (rel); const LAS float* Gt = Gl + (rel) * 64 + 4 * hi; \
            _Pragma("unroll") for (int rq = 0; rq < 4; ++rq) { const f32x4 ga = *(const LAS f32x4*)(Gt + 8 * rq), gb = *(const LAS f32x4*)(Gt + 32 + 8 * rq); \
                _Pragma("unroll") for (int i = 0; i < 4; ++i) { c0[4 * rq + i] += ga[i]; c1[4 * rq + i] += gb[i]; } } \
            if (64 * tt_ + 63 > qw) { const int qrel = qw + r32 - 64 * tt_; \
                _Pragma("unroll") for (int r = 0; r < 16; ++r) { const int kv = crow(r, hi); c0[r] = kv > qrel ? -INFINITY : c0[r]; c1[r] = kv + 32 > qrel ? -INFINITY : c1[r]; } } } } while (0)
#define ROWMAX(dst) do { float ma = MX3(c0[0], c0[1], c1[0]), mb = MX3(c0[2], c0[3], c1[1]); ma = MX3(ma, c1[2], c1[3]); \
        _Pragma("unroll") for (int r = 4; r < 16; r += 4) { ma = MX3(ma, c0[r], c0[r + 1]); mb = MX3(mb, c0[r + 2], c0[r + 3]); ma = MX3(ma, c1[r], c1[r + 1]); mb = MX3(mb, c1[r + 2], c1[r + 3]); } \
        dst = swapmax(fmaxf(ma, mb)); } while (0)
    WAITV(2 * nK + 2);
    LBAR();
    ISSUE_V(t0 + 2, 2);
    KREAD(0); SFENCE();
    QKMM(0);
    BIASMASK(0);
    { float rm; ROWMAX(rm); mhat = rm;
#pragma unroll
        for (int r = 0; r < 16; ++r) { pp0[r] = __builtin_amdgcn_exp2f(c0[r] - rm); pp1[r] = __builtin_amdgcn_exp2f(c1[r] - rm); } }
    KREAD(1);
    WAITV(nK + 2);
    LBAR();
#pragma unroll 1
    for (int t = 1; t < nti; ++t) {
        if (t == 1 && 4 < nti) ISSUE_K(t0 + 4, 0);
        if (t + 4 < nti) ISSUE_K(t0 + t + 4, t % NS);
        if (t + 2 < nti) ISSUE_V(t0 + t + 2, (t + 2) % NS);
        SFENCE();
        { const float cb = (t0 + t > tw_last) ? -INFINITY : -mhat;
#pragma unroll
          for (int r = 0; r < 16; ++r) { c0[r] = cb; c1[r] = cb; }
          const lds_cptr vp = vp0 + ((t - 1) % NS) * VSLOT; float sa = 0.f, sb = 0.f;
#pragma unroll
          for (int g = 0; g < 2 * NQ; ++g) {
              if (g & 1) c1 = __builtin_amdgcn_mfma_f32_32x32x16_bf16(kf[g], qr[g >> 1], c1, 0, 0, 0); else c0 = __builtin_amdgcn_mfma_f32_32x32x16_bf16(kf[g], qr[g >> 1], c0, 0, 0, 0);
              if (g < 8) { const int i = (g >> 1) + 4 * (g & 1); vlo[i] = vtr(vp + (i >> 2) * 4096 + (i & 3) * 1024); vhi[i] = vtr(vp + (i >> 2) * 4096 + (i & 3) * 1024 + 512);
                  if (g < 4) { sa += pp0[4 * g]; sb += pp0[4 * g + 1]; sa += pp0[4 * g + 2]; sb += pp0[4 * g + 3]; } else { sa += pp1[4 * g - 16]; sb += pp1[4 * g - 15]; sa += pp1[4 * g - 14]; sb += pp1[4 * g - 13]; }
                  asm volatile("" : "+v"(sa), "+v"(sb)); }
              { constexpr int G0 = FOX ? 0 : 4; if (g >= G0) { const int q = 2 * (g - G0);
#pragma unroll
                  for (int k = 0; k < 2; ++k) { const int w = q + k; const unsigned pkd = w < 8 ? cvt_pk_bf16(pp0[2 * w], pp0[2 * w + 1]) : cvt_pk_bf16(pp1[2 * w - 16], pp1[2 * w - 15]); pw[w >> 2][w & 3] = pkd; } } }
              SFENCE();
          }
          lrun += sa + sb; }
        BIASMASK(t);
        float rm; ROWMAX(rm);
        bool resc = false;
        if (__any(rm > THR)) { const float dl = fmaxf(rm, 0.f); mhat += dl;
#pragma unroll
            for (int r = 0; r < 16; ++r) { c0[r] -= dl; c1[r] -= dl; }
            const float f = __builtin_amdgcn_exp2f(-dl); lrun *= f; if (hi == 0) wsf[r32] = f; resc = true; }
        SFENCE();
        { const lds_cptr kp = kp0 + ((t + 1) % NS) * KSLOT;
#pragma unroll
          for (int g = 0; g < 8; ++g) { const int i = (g >> 1) + 4 * (g & 1);
              const bf16x8 vf = (bf16x8){vlo[i][0], vlo[i][1], vlo[i][2], vlo[i][3], vhi[i][0], vhi[i][1], vhi[i][2], vhi[i][3]};
              o[g & 1] = __builtin_amdgcn_mfma_f32_32x32x16_bf16(__builtin_bit_cast(bf16x8, pw[g >> 1]), vf, o[g & 1], 0, 0, 0);
              if (g < 4) {
#pragma unroll
                  for (int k = 0; k < 4; ++k) pp0[4 * g + k] = __builtin_amdgcn_exp2f(c0[4 * g + k]);
                  asm volatile("" : "+v"(pp0)); }
              else {
#pragma unroll
                  for (int k = 0; k < 4; ++k) pp1[4 * g - 16 + k] = __builtin_amdgcn_exp2f(c1[4 * g - 16 + k]);
                  asm volatile("" : "+v"(pp1)); }
              { constexpr int G0 = FOX ? 2 : 1; const int j = g - G0; if (j >= 0 && j < NQ) { kf[2 * j] = *(const LAS bf16x8*)(kp + j * 2048); kf[2 * j + 1] = *(const LAS bf16x8*)(kp + j * 2048 + 512); } }
              SFENCE();
          } }
        if (resc) { asm volatile("s_waitcnt lgkmcnt(0)" ::: "memory");
#pragma unroll
            for (int rq = 0; rq < 4; ++rq) { const f32x4 af = *(const LAS f32x4*)(wsf + 8 * rq + 4 * hi);
#pragma unroll
                for (int i = 0; i < 4; ++i) { o[0][4 * rq + i] *= af[i]; o[1][4 * rq + i] *= af[i]; } } }
        WAITV(((t + 3 < nti ? nK : 0) + (t + 1 < nti ? 1 : 0)) + ((t + 4 < nti ? nK : 0) + (t + 2 < nti ? 1 : 0)));
        LBAR();
    }
    VREAD(nti - 1); SUMPACK(); SFENCE(); PVMM();
#undef ISSUE_K
#undef ISSUE_V
#undef WAITV
#undef WV_
#undef LBAR
#undef SGB
#undef SFENCE
#undef KREAD
#undef VREAD
#undef PKV
#undef QKMM
#undef PVMM
#undef SUMPACK
#undef MX3
#undef BIASMASK
#undef ROWMAX
    STAMP(2);
    lrun = swapsum(lrun);
    if (hi == 0) wsf[32 + r32] = lrun;
    asm volatile("s_waitcnt lgkmcnt(0)" ::: "memory");
    float rli[16];
#pragma unroll
    for (int rq = 0; rq < 4; ++rq) { const f32x4 lf = *(const LAS f32x4*)(wsf + 32 + 8 * rq + 4 * hi);
#pragma unroll
        for (int i = 0; i < 4; ++i) rli[4 * rq + i] = __builtin_amdgcn_rcpf(lf[i]); }
    const int hh = FOX ? 8 + h : h;
    bf16_t* Ow = A.o + (rowbase + qw) * 1024 + hh * 64;
    LAS bf16_t* stg = (LAS bf16_t*)(shm + L_OST) + wid * 2048;
#pragma unroll
    for (int r = 0; r < 16; ++r) { const int orow = crow(r, hi);
#pragma unroll
        for (int d0 = 0; d0 < 2; ++d0) { const float v = o[d0][r] * rli[r]; stg[orow * 64 + d0 * 32 + r32] = (bf16_t)(cvt_pk_bf16(v, 0.f) & 0xffffu); } }
    asm volatile("s_waitcnt lgkmcnt(0)" ::: "memory");
#pragma unroll
    for (int i = 0; i < 4; ++i) { const int row = i * 8 + (lane >> 3), ch = lane & 7; const u32x4 v = *(const LAS u32x4*)(stg + row * 64 + ch * 8);
        *(u32x4*)(Ow + (long)row * 1024 + ch * 8) = v;
        float s = 0.f; { const float a0 = bflo(v.x), a1 = bfhi(v.x), a2 = bflo(v.y), a3 = bfhi(v.y), a4 = bflo(v.z), a5 = bfhi(v.z), a6 = bflo(v.w), a7 = bfhi(v.w);
            s = ((a0 * a0 + a1 * a1) + (a2 * a2 + a3 * a3)) + ((a4 * a4 + a5 * a5) + (a6 * a6 + a7 * a7)); }
        s += __shfl_xor(s, 1); s += __shfl_xor(s, 2); s += __shfl_xor(s, 4);
        if (ch == 0) A.sso[(rowbase + qw + row) * 16 + hh] = s; }
    asm volatile("s_waitcnt lgkmcnt(0)\n\ts_barrier" ::: "memory");
    STAMP(3);
#ifdef DIAG_SEL
    if (dg) dg[4] += (float)NT - (float)t0;
#endif
}

__device__ __forceinline__ void attn_phase(const Args& A, int vcu, int G, LAS char* shm, int repm, int repf, LAS float* dg, unsigned* qctr, const float* bfox, LAS int* qs  ) {
    const int tid = threadIdx.x;
    for (int v = vcu; v < 256; v += G) {
        const int bh = v >> 3, s = v & 7;
#pragma unroll 1
        for (int i = 0; i < 4 * repm; ++i) { const int ii = i & 3; const int qb = (ii == 0) ? s : (ii == 1) ? 15 - s : (ii == 2) ? 16 + s : 31 - s; attn_unit<false>(A, bh >> 3, bh & 7, qb, shm, dg); }
    }
    if (tid < 8) { const float mine = bfox[tid]; int rank = 0;
#pragma unroll
        for (int k = 0; k < 8; ++k) { const float o = bfox[k]; rank += (o > mine || (o == mine && k < tid)) ? 1 : 0; }
        qs[rank] = tid; }
    if (tid == 0) qs[8] = (int)__hip_atomic_fetch_add(qctr, 1u, __ATOMIC_RELAXED, __HIP_MEMORY_SCOPE_AGENT);
    asm volatile("s_waitcnt vmcnt(0) lgkmcnt(0)" ::: "memory"); __syncthreads();
#pragma unroll 1
    for (;;) {
        const int idx = qs[8];
        if (idx >= 1024 * repf) break;
        const int id = idx & 1023, h = qs[id >> 7], rem = id & 127, qb = 31 - (rem >> 2), b = rem & 3;
        unsigned nxt = 0u;
        __syncthreads();
        if (tid == 0) nxt = __hip_atomic_fetch_add(qctr, 1u, __ATOMIC_RELAXED, __HIP_MEMORY_SCOPE_AGENT);
        attn_unit<true>(A, b, h, qb, shm, dg ? dg + 8 : dg);
        if (tid == 0) qs[8] = (int)nxt;
        asm volatile("s_waitcnt vmcnt(0) lgkmcnt(0)" ::: "memory"); __syncthreads();
    }
}
}

constexpr int CW_TMO = 0, CW_BAR = 4096, CW_CNT = 200000;
constexpr int RING_BYTES = 131072, LDSCTL_OFF = RING_BYTES, LDS_BYTES = 147456;
constexpr int CW_FQ = 210000;
constexpr int LC_QS = 7424;
constexpr int LC_SUBO = 5120;
constexpr int LC_MISC = 0, LC_PRE = 256, LC_CNT = 512;

typedef GAS unsigned gu32;
#define RLX_AGENT __ATOMIC_RELAXED, __HIP_MEMORY_SCOPE_AGENT

#define XB_TMO      128
#define XB_XCNT(j)  (256  + 64 * (j))
#define XB_XSUB(j)  (1280 + 64 * (j))
#define XB_XGEN(j)  (2304 + 64 * (j))
#define XB_TOP      3328
#define XB_TOPGEN   3392
#define XCD_BAR_WORDS 3456
#define XB_SPIN_CAP (1u << 18)
__device__ __forceinline__ unsigned xb_ld(unsigned* p)              { return __hip_atomic_load(p, __ATOMIC_RELAXED, __HIP_MEMORY_SCOPE_AGENT); }
__device__ __forceinline__ unsigned xb_add(unsigned* p, unsigned v) { return __hip_atomic_fetch_add(p, v, __ATOMIC_RELAXED, __HIP_MEMORY_SCOPE_AGENT); }
__device__ __forceinline__ unsigned xb_xcc_id() { return (unsigned)__builtin_amdgcn_s_getreg((3 << 11) | 20) & 0xFu; }
#define XB_SPIN(cond, bar) do { unsigned _sp = 0; while (cond) { __builtin_amdgcn_s_sleep(1); \
    if ((++_sp & 255u) == 0u) { if (xb_ld(&(bar)[XB_TMO])) break; if (_sp > XB_SPIN_CAP) { atomicAdd(&(bar)[XB_TMO], 1u); break; } } } } while (0)
struct XcdBarrier { unsigned* bar; unsigned x; volatile LAS unsigned* st; };
__device__ __forceinline__ XcdBarrier xcd_barrier_post(unsigned* bar, volatile LAS unsigned* st) {
    XcdBarrier b; b.bar = bar; b.x = xb_xcc_id(); b.st = st;
    if (threadIdx.x == 0) (void)xb_add(&bar[XB_XCNT(b.x)], 1u);
    return b;
}
__device__ __forceinline__ void xcd_barrier_complete(unsigned* bar, unsigned x, unsigned& nloc, unsigned& nx) {
    const unsigned G = gridDim.x * gridDim.y * gridDim.z;
    unsigned sum, cnt, mine, sp = 0u;
    for (;;) {
        sum = 0u; cnt = 0u; mine = 0u;
#pragma unroll
        for (unsigned j = 0; j < 16; ++j) { const unsigned c = xb_ld(&bar[XB_XCNT(j)]); sum += c; cnt += (c > 0u) ? 1u : 0u; mine = (j == x) ? c : mine; }
        if (sum == G) break;
        __builtin_amdgcn_s_sleep(1);
        if ((++sp & 255u) == 0u) { if (xb_ld(&bar[XB_TMO])) break; if (sp > XB_SPIN_CAP) { atomicAdd(&bar[XB_TMO], 1u); break; } }
    }
    nloc = mine > 0u ? mine : 1u; nx = cnt > 0u ? cnt : 1u;
}
__device__ __forceinline__ void xcd_barrier(const XcdBarrier& b) {
    asm volatile("s_waitcnt vmcnt(0)" ::: "memory");
    __syncthreads();
    if (threadIdx.x == 0) {
        unsigned* bar = b.bar;
        __builtin_amdgcn_s_waitcnt(0);
        unsigned nloc = b.st[0], nx = b.st[1];
        if (nloc == 0u) { xcd_barrier_complete(bar, b.x, nloc, nx); b.st[0] = nloc; b.st[1] = nx; }
        const unsigned old = xb_add(&bar[XB_XSUB(b.x)], 1u);
        const unsigned gen = old / nloc;
        if (old + 1u == (gen + 1u) * nloc) {
            __builtin_amdgcn_fence(__ATOMIC_RELEASE, "agent");
            asm volatile("s_waitcnt vmcnt(0)" ::: "memory");
            const unsigned og = xb_add(&bar[XB_TOP], 1u);
            const unsigned tg = og / nx;
            if (og + 1u == (tg + 1u) * nx) xb_add(&bar[XB_TOPGEN], 1u);
            else XB_SPIN(xb_ld(&bar[XB_TOPGEN]) == tg, bar);
            __builtin_amdgcn_fence(__ATOMIC_ACQUIRE, "agent");
            xb_add(&bar[XB_XGEN(b.x)], 1u);
            asm volatile("s_waitcnt vmcnt(0)" ::: "memory");
        } else {
            XB_SPIN(xb_ld(&bar[XB_XGEN(b.x)]) == gen, bar);
            __builtin_amdgcn_fence(__ATOMIC_ACQUIRE, "agent");
            asm volatile("s_waitcnt vmcnt(0)" ::: "memory");
        }
    }
    __syncthreads();
}

__device__ __forceinline__ float wave_sum(float v) {
#pragma unroll
    for (int o = 1; o < 64; o <<= 1) v += __shfl_xor(v, o);
    return v;
}
#define LDS_WAIT() asm volatile("s_waitcnt lgkmcnt(0)" ::: "memory")

__device__ __forceinline__ int maprow(int kind, int n) {
    switch (kind) {
    default: return n;
    case 1: {
        if (n < 256) return n;
        if (n < 384) { const int j = n - 256, q = j >> 5, c = j & 31; return 256 + (q & 1) * 128 + (q >> 1) * 32 + c; }
        if (n < 416) return 256 + 64 + (n - 384);
        if (n < 1952) { const int f = n - 416, k3 = f >> 9, r = f & 511, hd = r >> 6, d = r & 63; return (2 + 2 * k3 + (hd >> 2)) * 256 + (d >> 5) * 128 + (hd & 3) * 32 + (d & 31); }
        return 256 + 96 + (n - 1952); }
    case 2: { const int hd = n / 96, dd = n - hd * 96; if (dd < 64) return (hd >> 2) * 256 + (dd >> 5) * 128 + (hd & 3) * 32 + (dd & 31); return 512 + (hd >> 2) * 128 + (hd & 3) * 32 + (dd - 64); }
    case 3: { const int hd = n >> 7, dd = n & 127; if (dd < 64) return (hd >> 2) * 256 + (dd >> 5) * 128 + (hd & 3) * 32 + (dd & 31); const int d = dd - 64; return 512 + (hd >> 2) * 256 + (d >> 5) * 128 + (hd & 3) * 32 + (d & 31); }
    case 4: return (n >> 7) * 256 + (n & 127);
    case 5: return (n >> 7) * 256 + 128 + (n & 127);
    case 6: return 128 + n;
    }
}
__device__ __forceinline__ void conv_item(const float* W, int K, int Nsrc, bf16_t* WT, int kind, const float* s1, const float* s2, int split, LAS float* scr, int item, int lane) {
    const int nblk = (Nsrc + 31) / 32, kb = item / nblk, nb = item - kb * nblk, k0 = 64 * kb, n0 = 32 * nb;
    const bool nv = n0 + (lane & 31) < Nsrc;
#pragma unroll 8
    for (int i = 0; i < 32; ++i) { const int kk = 2 * i + (lane >> 5); scr[kk * 33 + (lane & 31)] = nv ? W[(size_t)(k0 + kk) * Nsrc + n0 + (lane & 31)] : 0.f; }
    LDS_WAIT(); asm volatile("" ::: "memory");
    const int c = lane & 7;
    float sc[8];
#pragma unroll
    for (int e = 0; e < 8; ++e) { const int k = k0 + 8 * c + e; sc[e] = s1 ? (k < split ? s1[k] : s2[k - split]) : 1.f; }
#pragma unroll
    for (int j = 0; j < 4; ++j) { const int n = (lane >> 3) + 8 * j; const LAS float* s = scr + (8 * c) * 33 + n;
        if (n0 + n < Nsrc) { u32x4 o; o.x = cvt_pk_bf16(s[0 * 33] * sc[0], s[1 * 33] * sc[1]); o.y = cvt_pk_bf16(s[2 * 33] * sc[2], s[3 * 33] * sc[3]); o.z = cvt_pk_bf16(s[4 * 33] * sc[4], s[5 * 33] * sc[5]); o.w = cvt_pk_bf16(s[6 * 33] * sc[6], s[7 * 33] * sc[7]);
            *(u32x4*)(WT + (size_t)maprow(kind, n0 + n) * K + k0 + 8 * c) = o; } }
    LDS_WAIT(); asm volatile("" ::: "memory");
}

struct KArgs { const void* in[27]; float* out; unsigned char* ws; int ph_lo, ph_hi, li, pad; };

constexpr int I_IN = 16 * 62, I_UQ = 4 * 24, I_UKV = 2 * 32, I_OUT = 16 * 32, I_RE = 16, I_RG = 16, I_GU = NEXP * 2 * 16 * 8, I_DN = NEXP * 4 * 32, I_PG = 16 * 32, I_PP = 4 * 32;
constexpr int I_LAYER = I_IN + I_UQ + I_UKV + I_OUT + I_RE + I_RG + I_GU + I_DN + I_PG + I_PP;

struct PPOrder {
    int c, G;
    __device__ __forceinline__ bool next(int i, Unit& u) const {
        int L;
        if (G == 256) { if (c < 128) { if (i > 0) return false; L = c; } else { if (i > 2) return false; L = 128 + (c - 128) * 3 + i; } }
        else { L = i * G + c; if (L >= 512) return false; }
        u.pm = L >> 2; u.pn = L & 3; u.e = 0; u.blk = 0; return true;
    }
    __device__ __forceinline__ int arow(const Unit& u, int r) const { return u.pm * 256 + r; }
};

struct MoeOrder {
    const LAS int* pre; const LAS unsigned* cntl; const LAS int* subo; const int* list; int npn, G, c; bool gather;
    __device__ __forceinline__ bool next(int i, Unit& u) const {
        const int L = i * G + c; const int TB = pre[32]; if (L >= TB * npn) return false;
        const int bg = L / npn, pl = L - bg * npn; int e = 0;
        for (int j = 1; j < 32; ++j) e += (pre[j] <= bg) ? 1 : 0;
        u.pm = bg; u.e = e; u.blk = bg - pre[e]; u.pn = e * npn + pl; return true;
    }
    __device__ __forceinline__ int arow(const Unit& u, int r) const {
        if (!gather) return u.pm * 256 + r;
        int li = u.blk * 256 + r; const int cn = (int)cntl[u.e]; li = li < cn ? li : cn - 1;
        return list_at(list, subo, u.e, li) >> 1;
    }
};

#ifndef MK_CUTS
#define MK_CUTS {0, 19}
#endif
constexpr int NPHASE = 19;

__global__ void __launch_bounds__(NWAVES * 64, 2) mega_fwd(KArgs args) {
    extern __shared__ __attribute__((aligned(16))) unsigned char lds_raw[];
    LAS unsigned char* lds0 = (LAS unsigned char*)lds_raw;
    volatile LAS unsigned* MISC = (volatile LAS unsigned*)(lds0 + LDSCTL_OFF + LC_MISC);
    const int G = gridDim.x; const int bx = blockIdx.x; const int vcu = (G % 8 == 0) ? (bx % 8) * (G / 8) + bx / 8 : bx;
    for (int u = threadIdx.x; u < (LDS_BYTES - LDSCTL_OFF) / 4; u += NWAVES * 64) ((LAS unsigned*)(lds0 + LDSCTL_OFF))[u] = 0u;
    __syncthreads();
    (void)xcd_barrier_post((unsigned*)(args.ws + WS_CTL) + CW_BAR + args.li * XCD_BAR_WORDS, MISC + 8);
    const int lo = args.ph_lo, hi = args.ph_hi;
#ifndef PH_MASK
#define PH_MASK 0x3ff
#endif
#define PHM(k) ((PH_MASK >> (k)) & 1)
#ifndef DUP_MASK
#define DUP_MASK 0
#endif
#define NREP(k) (((DUP_MASK >> (k)) & 1) ? 2 : 1)
#ifndef NULL_MASK
#define NULL_MASK 0
#endif
#define NULLP(k) ((NULL_MASK >> (k)) & 1)
#define IN(k) (lo <= (k) && (k) < hi)
#ifdef DIAG_SEL
#define PSTAMP(k) do { int ti_ = threadIdx.x; asm volatile("" : "+v"(ti_)); if (ti_ == 0) *(volatile LAS unsigned long long*)(lds0 + LDSCTL_OFF + 8336) = __builtin_amdgcn_s_memrealtime(); if (blockIdx.x == DIAG_BLOCK && ti_ == 0 && (k) < 10) { volatile LAS unsigned long long* tp_ = (volatile LAS unsigned long long*)(lds0 + LDSCTL_OFF + 8320); const unsigned long long t_ = __builtin_amdgcn_s_memrealtime(); ((float*)(args.ws + WS_CTL))[250016 + (k)] = (float)(t_ - *tp_) * 0.01f; *tp_ = t_; } } while (0)
#else
#define PSTAMP(k) do {} while (0)
#endif
#ifdef DIAG_SEL
#define ASTAMP(k) do { int ti_ = threadIdx.x; asm volatile("" : "+v"(ti_)); if (blockIdx.x == DIAG_BLOCK && ti_ == 0 && (k) < 10) { volatile LAS unsigned long long* tp_ = (volatile LAS unsigned long long*)(lds0 + LDSCTL_OFF + 8320); ((float*)(args.ws + WS_CTL))[250048 + (k)] = (float)(__builtin_amdgcn_s_memrealtime() - *tp_) * 0.01f; } \
    if (ti_ == 0 && (k) < 10) { volatile LAS unsigned long long* tq_ = (volatile LAS unsigned long long*)(lds0 + LDSCTL_OFF + 8336); const float av_ = (float)(__builtin_amdgcn_s_memrealtime() - *tq_) * 0.01f; atomicMax((int*)(args.ws + WS_CTL) + 250064 + (k), __float_as_int(av_)); atomicMax((int*)(args.ws + WS_CTL) + 250080 + (k), (int)av_ * 1024 + (int)blockIdx.x); } } while (0)
#else
#define ASTAMP(k) do {} while (0)
#endif
#define SEAM(k) do { ASTAMP(k); if (IN(k) && IN((k) + 1)) { XcdBarrier bar_; bar_.bar = (unsigned*)(args.ws + WS_CTL) + CW_BAR + args.li * XCD_BAR_WORDS; bar_.x = xb_xcc_id(); bar_.st = (volatile LAS unsigned*)(lds0 + LDSCTL_OFF + LC_MISC) + 8; xcd_barrier(bar_); } PSTAMP(k); } while (0)
    const int NGW = G * NWAVES, NGT = G * 512;
#ifdef DIAG_SEL
    if (threadIdx.x == 0) *(volatile LAS unsigned long long*)(lds0 + LDSCTL_OFF + 8320) = __builtin_amdgcn_s_memrealtime();
#endif
#define ssx0 ((float*)(wsp + WS_SSX0))
#define ssx1 ((float*)(wsp + WS_SSX1))
#define sspp ((float*)(wsp + WS_SSPP))
#define sso ((float*)(wsp + WS_SSO))
#define ssx2 ((float*)(wsp + WS_SSX2))
#define sskpe ((float*)(wsp + WS_SSKPE))
#define ssqq ((float*)(wsp + WS_SSQQ))
#define ssqkv ((float*)(wsp + WS_SSQKV))
#define gate ((float*)(wsp + WS_GATE))
#define logf ((float*)(wsp + WS_LOGF))
#define Fc ((float*)(wsp + WS_F))
#define ssqn ((float*)(wsp + WS_SSQN))
#define ssqr ((float*)(wsp + WS_SSQR))
#define cosT ((float*)(wsp + WS_COS))
#define sinT ((float*)(wsp + WS_SIN))
#define list ((int*)(wsp + WS_LIST))
#define xbA ((bf16_t*)(wsp + WS_XBA))
#define xbB ((bf16_t*)(wsp + WS_XBB))
#define pbf ((bf16_t*)(wsp + WS_PBF))
#define Qc ((bf16_t*)(wsp + WS_QC))
#define Kvc ((bf16_t*)(wsp + WS_KVC))
#define Kpe ((bf16_t*)(wsp + WS_KPE))
#define Fq ((bf16_t*)(wsp + WS_FQ))
#define Fk ((bf16_t*)(wsp + WS_FK))
#define Fv ((bf16_t*)(wsp + WS_FV))
#define Kmla ((bf16_t*)(wsp + WS_KMLA))
#define Vmla ((bf16_t*)(wsp + WS_VMLA))
#define Qraw ((bf16_t*)(wsp + WS_QRAW))
#define ob ((bf16_t*)xo)
#define ppb ((bf16_t*)(wsp + WS_PP))
#define hid ((bf16_t*)(wsp + WS_HID))
#define c1 ((bf16_t*)(wsp + WS_C1))
#define ctl ((unsigned*)(wsp + WS_CTL))
#define Wl (wsp + WS_W + (size_t)L * W_LAYER)
#define PHASE_PTRS unsigned char* wsp = args.ws; asm volatile("" : "+s"(wsp)); const float* x_in = (const float*)args.in[0]; float* xo = args.out; (void)x_in; (void)xo; \
    int tid = threadIdx.x; asm volatile("" : "+v"(tid)); const int lane = tid & 63, wave = __builtin_amdgcn_readfirstlane(tid >> 6); (void)lane; (void)wave; \
    unsigned ldo_ = 0u; asm volatile("" : "+s"(ldo_)); LAS unsigned char* lds = lds0 + ldo_; LAS int* preL = (LAS int*)(lds + LDSCTL_OFF + LC_PRE); LAS unsigned* cntL = (LAS unsigned*)(lds + LDSCTL_OFF + LC_CNT); LAS int* suboL = (LAS int*)(lds + LDSCTL_OFF + LC_SUBO); (void)preL; (void)cntL; (void)suboL; \
    const int gw = vcu * NWAVES + wave, gt = vcu * 512 + tid; (void)gw; (void)gt
#define INF(i) ((const float*)args.in[i])

    if (PHM(0) && IN(0)) {
        PHASE_PTRS; unsigned char* ws = wsp;
        LAS float* scr = (LAS float*)(lds + wave * 16384);
        for (int rep_ = 0; rep_ < NREP(0); ++rep_) {
        for (int it = gw; it < 2 * I_LAYER; it += NGW) {
            const int L = it >= I_LAYER ? 1 : 0; int r = it - L * I_LAYER;
            if (r < I_IN) { conv_item(INF(4) + (size_t)L * DM * INC, DM, INC, (bf16_t*)(Wl + WO_IN), 1, INF(3) + L * DM, nullptr, DM, scr, r, lane); continue; } r -= I_IN;
            if (r < I_UQ) { conv_item(INF(6) + (size_t)L * 256 * 768, 256, 768, (bf16_t*)(Wl + WO_UQ), 2, INF(5) + L * 256, nullptr, 256, scr, r, lane); continue; } r -= I_UQ;
            if (r < I_UKV) { conv_item(INF(8) + (size_t)L * 128 * 1024, 128, 1024, (bf16_t*)(Wl + WO_UKV), 3, INF(7) + L * 128, nullptr, 128, scr, r, lane); continue; } r -= I_UKV;
            if (r < I_OUT) { conv_item(INF(16) + (size_t)L * DM * DM, DM, DM, (bf16_t*)(Wl + WO_OUT), 0, INF(14) + L * 512, INF(15) + L * 512, 512, scr, r, lane); continue; } r -= I_OUT;
            if (r < I_RE) { conv_item(INF(19) + (size_t)L * DM * 32, DM, 32, (bf16_t*)(Wl + WO_RT), 0, INF(17) + L * DM, nullptr, DM, scr, r, lane); continue; } r -= I_RE;
            if (r < I_RG) { conv_item(INF(18) + (size_t)L * DM * 4, DM, 4, (bf16_t*)(Wl + WO_RT), 6, INF(17) + L * DM, nullptr, DM, scr, r, lane); continue; } r -= I_RG;
            if (r < I_GU) { const int e = r >> 8, mt = (r >> 7) & 1, ii = r & 127;
                conv_item(INF(mt ? 21 : 20) + ((size_t)L * NEXP + e) * DM * 256, DM, 256, (bf16_t*)(Wl + WO_GU) + (size_t)e * 512 * DM, mt ? 5 : 4, INF(17) + L * DM, nullptr, DM, scr, ii, lane); continue; } r -= I_GU;
            if (r < I_DN) { const int e = r >> 7, ii = r & 127;
                conv_item(INF(22) + ((size_t)L * NEXP + e) * 256 * DM, 256, DM, (bf16_t*)(Wl + WO_DN) + (size_t)e * DM * 256, 0, nullptr, nullptr, 0, scr, ii, lane); continue; } r -= I_DN;
            if (r < I_PG) { conv_item(INF(24) + (size_t)L * DM * DM, DM, DM, (bf16_t*)(Wl + WO_PG), 0, INF(23) + L * DM, nullptr, DM, scr, r, lane); continue; } r -= I_PG;
            conv_item(INF(25) + (size_t)L * 256 * DM, 256, DM, (bf16_t*)(Wl + WO_PP), 0, nullptr, nullptr, 0, scr, r, lane);
        }
        for (int it = gw; it < 2 * (88 + 220); it += NGW) {
            const int L = it >= 308 ? 1 : 0; int r = it - L * 308; bf16_t* dst;
            if (r < 88) { const int lr = r < 24 ? 104 + r : 192 + (r - 24); dst = (bf16_t*)(Wl + WO_IN) + (size_t)(256 + lr) * DM; }
            else { r -= 88; const int lr = r < 96 ? 32 + r : 132 + (r - 96); dst = (bf16_t*)(Wl + WO_RT) + (size_t)lr * DM; }
            *(u32x4*)(dst + lane * 8) = (u32x4){0u, 0u, 0u, 0u}; *(u32x4*)(dst + 512 + lane * 8) = (u32x4){0u, 0u, 0u, 0u};
        }
        for (int m = gw; m < NTOK; m += NGW) { const f32x4* xr = (const f32x4*)(x_in + (size_t)m * DM) + lane; float s = 0.f; u32x2* o8 = (u32x2*)(xbA + (size_t)m * DM) + lane;
#pragma unroll
            for (int j = 0; j < 4; ++j) { const f32x4 v = xr[64 * j]; s += sum4sq(v); u32x2 w; w.x = cvt_pk_bf16(v[0], v[1]); w.y = cvt_pk_bf16(v[2], v[3]); o8[64 * j] = w; }
            s = wave_sum(s); if (lane < 16) ssx0[(size_t)m * 16 + lane] = lane == 0 ? s : 0.f; }
        for (size_t i = gt; i < (size_t)DEPTH * NTOK * 256 / 8; i += NGT) { const f32x4 a = ((const f32x4*)INF(1))[2 * i], b = ((const f32x4*)INF(1))[2 * i + 1]; ((u32x4*)pbf)[i] = pack8(a, b); }
        for (int i = gt; i < NTOK * 16; i += NGT) { const int t = i >> 4, j = i & 15; const double inv = exp2(-(double)j * (13.287712379549449 / 16.0)); const double ang = (double)((const int*)args.in[2])[t] * inv;
            cosT[i] = (float)cos(ang); sinT[i] = (float)sin(ang); }
        }
    }
    SEAM(0);

#pragma unroll 1
    for (int L = 0; L < DEPTH; ++L) {
        const int pb = 1 + 9 * L;
        if (PHM(1) && IN(pb + 0)) {
            PHASE_PTRS;
            pg8::Gemm g{xbA, (const bf16_t*)(Wl + WO_IN), DM}; pg8::StaticOrder S; S.init(NTOK, 2048, G, bx);
            EpiInProj E{wsp, INF(13) + L * 8, INF(11) + L * 64, INF(12) + L * 64};
            for (int rep_ = 0; rep_ < NREP(1); ++rep_) pg8::gemm_phase<DM, EpiInProj, pg8::StaticOrder, true>(lds, g, S, E);
            if (NULLP(1)) { EpiNull EN{(float*)(wsp + WS_SSX2)}; pg8::gemm_phase<DM, EpiNull, pg8::StaticOrder, true>(lds, g, S, EN); }
        }
        SEAM(pb + 0);
        if (PHM(2) && IN(pb + 1)) {
            PHASE_PTRS;
            { pg8::Gemm g{Qc, (const bf16_t*)(Wl + WO_UQ), 256}; pg8::StaticOrder S; S.init(NTOK, 768, G, bx);
              EpiQUp E{wsp};
              for (int rep_ = 0; rep_ < NREP(2); ++rep_) pg8::gemm_phase<256, EpiQUp, pg8::StaticOrder, true>(lds, g, S, E); }
            { pg8::Gemm g{Kvc, (const bf16_t*)(Wl + WO_UKV), 128}; pg8::StaticOrder S; S.init(NTOK, 1024, G, bx);
              EpiKvUp E{wsp, INF(10) + L * 96};
              for (int rep_ = 0; rep_ < NREP(2); ++rep_) pg8::gemm_phase<128, EpiKvUp, pg8::StaticOrder, true>(lds, g, S, E); }
            for (int v = vcu; v < 32; v += G) {
                const int b = v >> 3, h = v & 7; LAS double* wt = (LAS double*)lds;
                const size_t base = ((size_t)b * SEQ + wave * 1024 + lane * 16) * 8 + h; float lv[16]; double loc = 0.0;
#pragma unroll
                for (int i = 0; i < 16; ++i) { lv[i] = logf[base + (size_t)i * 8]; loc += (double)lv[i]; }
                double pre = loc;
#pragma unroll
                for (int o = 1; o < 64; o <<= 1) { const double n = __shfl_up(pre, o); if (lane >= o) pre += n; }
                if (lane == 63) wt[wave] = pre;
                LDS_WAIT(); __syncthreads();
                double run = pre - loc;
                for (int w = 0; w < wave; ++w) run += wt[w];
#pragma unroll
                for (int i = 0; i < 16; ++i) { run += (double)lv[i]; Fc[base + (size_t)i * 8] = (float)run; }
                __syncthreads();
            }
        }
        SEAM(pb + 1);
        if (PHM(3) && IN(pb + 2)) {
            PHASE_PTRS;
            att::Args A{Qraw, Kmla, Vmla, Fq, Fk, Fv, ssqn, ssqr, INF(9) + L * 96, cosT, sinT, Fc, INF(11) + L * 64, INF(12) + L * 64, ob, sso};
#ifdef DIAG_SEL
            LAS float* dg = (L == 0 && blockIdx.x == DIAG_BLOCK && tid == 0) ? (LAS float*)(lds0 + LDSCTL_OFF + 8192) : (LAS float*)nullptr;
            if (dg) for (int k = 0; k < 16; ++k) dg[k] = 0.f;
            att::attn_phase(A, vcu, G, (LAS char*)lds, NREP(10), NREP(11), dg, ctl + CW_FQ + 64 * L, INF(13) + L * 8, (LAS int*)(lds + LDSCTL_OFF + LC_QS));
            if (dg) { float* dw = (float*)(wsp + WS_CTL) + 250000; for (int k = 0; k < 16; ++k) dw[k] = dg[k]; }
#else
            att::attn_phase(A, vcu, G, (LAS char*)lds, NREP(10), NREP(11), (LAS float*)nullptr, ctl + CW_FQ + 64 * L, INF(13) + L * 8, (LAS int*)(lds + LDSCTL_OFF + LC_QS));
#endif
        }
        SEAM(pb + 2);
        if (PHM(4) && IN(pb + 3)) {
            PHASE_PTRS;
            pg8::Gemm g{ob, (const bf16_t*)(Wl + WO_OUT), DM}; pg8::StaticOrder S; S.init(NTOK, DM, G, bx);
            EpiOut E{wsp, (const float*)nullptr};
            for (int rep_ = 0; rep_ < (L == 0 ? NREP(4) : 1); ++rep_) pg8::gemm_phase<DM, EpiOut, pg8::StaticOrder, true>(lds, g, S, E);
            if (NULLP(4)) { EpiNull EN{(float*)(wsp + WS_SSX2)}; pg8::gemm_phase<DM, EpiNull, pg8::StaticOrder, true>(lds, g, S, EN); }
        }
        SEAM(pb + 3);
        if (PHM(5) && IN(pb + 4)) {
            PHASE_PTRS;
            { pg8::Gemm g{xbB, (const bf16_t*)(Wl + WO_RT), DM}; pg8::StaticOrder S; S.init(NTOK, 256, G, bx);
              EpiRouter E{wsp, ctl + CW_CNT + 1024 * L};
              pg8::gemm_phase<DM, EpiRouter, pg8::StaticOrder, true>(lds, g, S, E); }
            { pg8::Gemm g{pbf + (size_t)L * NTOK * 256, (const bf16_t*)(Wl + WO_PP), 256}; PPOrder S{bx, G};
              EpiPP E{wsp};
              for (int rep_ = 0; rep_ < NREP(5); ++rep_) pg8::gemm_phase<256, EpiPP, PPOrder, true>(lds, g, S, E); }
        }
        SEAM(pb + 4);
        if ((PHM(6) && IN(pb + 5)) || (PHM(7) && IN(pb + 6))) {
            PHASE_PTRS;
            { const int e = tid >> 4, sb = tid & 15; const unsigned c = __hip_atomic_load(ctl + CW_CNT + 1024 * L + tid, RLX_AGENT); suboL[e * (NSUB + 1) + sb + 1] = (int)c; }
            LDS_WAIT(); __syncthreads();
            if (tid < 32) { int run = 0; suboL[tid * (NSUB + 1)] = 0; for (int k = 1; k <= NSUB; ++k) { run += suboL[tid * (NSUB + 1) + k]; suboL[tid * (NSUB + 1) + k] = run; } cntL[tid] = (unsigned)run; }
            LDS_WAIT(); __syncthreads();
            if (tid == 0) { int run = 0; for (int e = 0; e < 32; ++e) { preL[e] = run; run += ((int)cntL[e] + 255) >> 8; } preL[32] = run; }
            LDS_WAIT(); __syncthreads();
        }
        if (PHM(6) && IN(pb + 5)) {
            PHASE_PTRS;
            pg8::Gemm g{xbB, (const bf16_t*)(Wl + WO_GU), DM}; MoeOrder S{preL, cntL, suboL, list, 2, G, bx, true};
            EpiMoeUp E{wsp, cntL, suboL, 2};
            for (int rep_ = 0; rep_ < NREP(6); ++rep_) pg8::gemm_phase<DM, EpiMoeUp, MoeOrder, true>(lds, g, S, E);
        }
        SEAM(pb + 5);
        if (PHM(7) && IN(pb + 6)) {
            PHASE_PTRS;
            pg8::Gemm g{hid, (const bf16_t*)(Wl + WO_DN), 256}; MoeOrder S{preL, cntL, suboL, list, 4, G, bx, false};
            EpiMoeDown E{wsp, cntL, suboL, 4};
            pg8::gemm_phase<256, EpiMoeDown, MoeOrder, true>(lds, g, S, E);
        }
        SEAM(pb + 6);
        if (PHM(8) && IN(pb + 7)) {
            PHASE_PTRS;
            for (int m = gw; m < NTOK; m += NGW) { const u32x4* cr = (const u32x4*)(c1 + (size_t)m * DM) + lane; u32x4* xr = (u32x4*)(xbB + (size_t)m * DM) + lane; float s = 0.f;
#pragma unroll
                for (int j = 0; j < 2; ++j) { const u32x4 cw = cr[64 * j], xw = xr[64 * j];
                    const f32x4 v0 = (f32x4){bflo(xw.x), bfhi(xw.x), bflo(xw.y), bfhi(xw.y)} + (f32x4){bflo(cw.x), bfhi(cw.x), bflo(cw.y), bfhi(cw.y)}, v1 = (f32x4){bflo(xw.z), bfhi(xw.z), bflo(xw.w), bfhi(xw.w)} + (f32x4){bflo(cw.z), bfhi(cw.z), bflo(cw.w), bfhi(cw.w)};
                    s += sum4sq(v0) + sum4sq(v1); xr[64 * j] = pack8(v0, v1); }
                s = wave_sum(s); if (lane == 0) ssx2[m] = s; }
        }
        SEAM(pb + 7);
        if (PHM(9) && IN(pb + 8)) {
            PHASE_PTRS;
            pg8::Gemm g{xbB, (const bf16_t*)(Wl + WO_PG), DM}; pg8::StaticOrder S; S.init(NTOK, DM, G, bx);
            EpiPle E{wsp, INF(26) + L * DM, L + 1 == DEPTH ? xo : (float*)nullptr};
            pg8::gemm_phase<DM, EpiPle, pg8::StaticOrder, true>(lds, g, S, E);
        }
        if (L + 1 < DEPTH) SEAM(pb + 8);
    }
#undef IN
#undef SEAM
#undef INF
}

extern "C" void kernel_launch(void* const* d_in, const int* in_sizes, int n_in, void* d_out, int out_size, void* d_ws, size_t ws_size, hipStream_t stream) {
    static int grid = 0;
    if (grid == 0) {
        if (n_in != 27 || ws_size < WS_END) { fprintf(stderr, "kernel_launch: unexpected inputs (n_in %d, ws %zu)\n", n_in, ws_size); grid = -1; return; }
        int dev = 0, cus = 0, per_cu = 0;
        if (hipGetDevice(&dev) != hipSuccess || hipDeviceGetAttribute(&cus, hipDeviceAttributeMultiprocessorCount, dev) != hipSuccess) { grid = -1; return; }
        if (hipFuncSetAttribute((const void*)mega_fwd, hipFuncAttributeMaxDynamicSharedMemorySize, LDS_BYTES) != hipSuccess) { fprintf(stderr, "kernel_launch: hipFuncSetAttribute failed\n"); grid = -1; return; }
        if (hipOccupancyMaxActiveBlocksPerMultiprocessor(&per_cu, (const void*)mega_fwd, NWAVES * 64, LDS_BYTES) != hipSuccess || per_cu < 1) { fprintf(stderr, "kernel_launch: occupancy query says %d\n", per_cu); }
        (void)hipGetLastError();
        grid = cus;
    }
    if (grid < 0) return;
    if (hipMemsetAsync((char*)d_ws + WS_CTL, 0, CTL_ZERO_BYTES, stream) != hipSuccess) return;
    KArgs a{};
    for (int i = 0; i < 27; ++i) a.in[i] = d_in[i];
    a.out = (float*)d_out; a.ws = (unsigned char*)d_ws;
    const int cuts[] = MK_CUTS; const int nl = (int)(sizeof(cuts) / sizeof(int)) - 1;
    for (int li = 0; li < nl; ++li) {
        a.ph_lo = cuts[li]; a.ph_hi = cuts[li + 1]; a.li = li; a.pad = 0;
        hipLaunchKernelGGL(mega_fwd, dim3(grid), dim3(NWAVES * 64), LDS_BYTES, stream, a);
        if (hipPeekAtLastError() != hipSuccess) { fprintf(stderr, "kernel_launch: launch %d failed\n", li); break; }
    }
}
```

```cpp
#include <hip/hip_runtime.h>
#include <cstdio>
#include <cstdint>

#define LAS __attribute__((address_space(3)))
#define GAS __attribute__((address_space(1)))
typedef unsigned short bf16_t;
typedef short bf16x8 __attribute__((ext_vector_type(8)));
typedef short s16x4 __attribute__((ext_vector_type(4)));
typedef float f32x2 __attribute__((ext_vector_type(2)));
typedef float f32x4 __attribute__((ext_vector_type(4)));
typedef float f32x16 __attribute__((ext_vector_type(16)));
typedef unsigned u32x2 __attribute__((ext_vector_type(2)));
typedef unsigned u32x4 __attribute__((ext_vector_type(4)));

constexpr int DM = 1024, NB = 4, SEQ = 8192, NTOK = NB * SEQ, DEPTH = 2;
constexpr int INC = 1960, NEXP = 32;
constexpr int C_KVC = 256, C_KPE = 384, C_FQ = 416, C_FK = 928, C_FV = 1440, C_FL = 1952;
constexpr float EPS = 1e-6f;
constexpr float LOG2E = 1.4426950408889634f;
constexpr float C2_FOX = 0.125f * LOG2E;
constexpr float C2_MLA = 0.10206207261596575f * LOG2E;

__device__ __forceinline__ unsigned cvt_pk_bf16(float lo, float hi) { unsigned r; asm volatile("v_cvt_pk_bf16_f32 %0, %1, %2" : "=v"(r) : "v"(lo), "v"(hi)); return r; }
__device__ __forceinline__ float bf2f(unsigned short u) { return __uint_as_float((unsigned)u << 16); }
__device__ __forceinline__ float bflo(unsigned w) { return __uint_as_float(w << 16); }
__device__ __forceinline__ float bfhi(unsigned w) { return __uint_as_float(w & 0xffff0000u); }
__device__ __forceinline__ u32x4 pack8(const f32x4& a, const f32x4& b) { u32x4 w; w.x = cvt_pk_bf16(a[0], a[1]); w.y = cvt_pk_bf16(a[2], a[3]); w.z = cvt_pk_bf16(b[0], b[1]); w.w = cvt_pk_bf16(b[2], b[3]); return w; }

__device__ __forceinline__ void st16(void* p, const u32x4& v) { asm volatile("global_store_dwordx4 %0, %1, off sc1" :: "v"(p), "v"(v) : "memory"); }
__device__ __forceinline__ void st8(void* p, const u32x2& v) { asm volatile("global_store_dwordx2 %0, %1, off sc1" :: "v"(p), "v"(v) : "memory"); }
__device__ __forceinline__ void st16f(void* p, const f32x4& v) { asm volatile("global_store_dwordx4 %0, %1, off sc1" :: "v"(p), "v"(v) : "memory"); }
__device__ __forceinline__ float sum4sq(const f32x4& a) { return (a[0] * a[0] + a[1] * a[1]) + (a[2] * a[2] + a[3] * a[3]); }
__device__ __forceinline__ float red_fq(float s) { s += __shfl_xor(s, 16); s += __shfl_xor(s, 32); return s; }
__device__ __forceinline__ float sum16(const float* p) { const f32x4 a = *(const f32x4*)p, b = *(const f32x4*)(p + 4), c = *(const f32x4*)(p + 8), d = *(const f32x4*)(p + 12);
    return ((a[0] + a[1]) + (a[2] + a[3])) + ((b[0] + b[1]) + (b[2] + b[3])) + ((c[0] + c[1]) + (c[2] + c[3])) + ((d[0] + d[1]) + (d[2] + d[3])); }
__device__ __forceinline__ float sum8(const float* p) { const f32x4 a = *(const f32x4*)p, b = *(const f32x4*)(p + 4); return ((a[0] + a[1]) + (a[2] + a[3])) + ((b[0] + b[1]) + (b[2] + b[3])); }
__device__ __forceinline__ float log_sigmoid_f(float x) { return -(fmaxf(-x, 0.f) + log1pf(__expf(-fabsf(x)))); }

constexpr int NWAVES = 8;
constexpr size_t MiB = 1u << 20;
constexpr size_t WS_CTL = 0, CTL_ZERO_BYTES = 1 * MiB;
constexpr size_t WS_SSX0 = 1 * MiB, WS_SSX1 = 3 * MiB, WS_SSPP = 5 * MiB, WS_SSO = 7 * MiB, WS_SSX2 = 9 * MiB, WS_SSKPE = 10 * MiB, WS_SSQQ = 11 * MiB, WS_SSQKV = 12 * MiB,
                 WS_GATE = 13 * MiB, WS_LOGF = 14 * MiB, WS_F = 15 * MiB, WS_SSQN = 16 * MiB, WS_SSQR = 17 * MiB, WS_COS = 18 * MiB, WS_SIN = 20 * MiB, WS_LIST = 22 * MiB;
constexpr size_t WS_W = 28 * MiB, W_LAYER = 58 * MiB;
constexpr size_t WO_IN = 0, WO_UQ = 4 * MiB, WO_UKV = 4 * MiB + 512 * 1024, WO_OUT = 5 * MiB, WO_RT = 7 * MiB, WO_PG = 7 * MiB + 512 * 1024, WO_PP = 9 * MiB + 512 * 1024, WO_GU = 10 * MiB, WO_DN = 42 * MiB;
constexpr size_t WS_XBA = 144 * MiB, WS_XBB = 208 * MiB, WS_PBF = 272 * MiB, WS_MIX = 304 * MiB;
constexpr size_t WS_O = WS_XBA, WS_QRAW = WS_XBB;
constexpr size_t WS_QC = WS_MIX, WS_KVC = WS_MIX + 16 * MiB, WS_KPE = WS_MIX + 24 * MiB, WS_FQ = WS_MIX + 26 * MiB, WS_FK = WS_MIX + 58 * MiB, WS_FV = WS_MIX + 90 * MiB, WS_KMLA = WS_MIX + 122 * MiB, WS_VMLA = WS_MIX + 170 * MiB;
constexpr size_t WS_PP = WS_MIX, WS_HID = WS_MIX + 64 * MiB, WS_C1 = WS_MIX + 100 * MiB;
constexpr size_t WS_END = 512 * MiB;
static_assert(WS_VMLA + 32 * MiB <= WS_END && WS_C1 + 64 * MiB <= WS_END && WS_W + 2 * W_LAYER <= WS_XBA, "d_ws map");
constexpr int HID_ROWS = 2 * NTOK + NEXP * 256;
static_assert((size_t)HID_ROWS * 256 * 2 <= 36 * MiB, "hid");

constexpr int NSUB = 16, SUBCAP = 2048;
__device__ __forceinline__ int list_at(const int* list, const LAS int* subo, int e, int li) {
    const LAS int* so = subo + e * (NSUB + 1); int sidx = 0;
#pragma unroll
    for (int k = 1; k < NSUB; ++k) sidx += (so[k] <= li) ? 1 : 0;
    return list[(size_t)(e * NSUB + sidx) * SUBCAP + (li - so[sidx])];
}
namespace pg8 {
constexpr int TAB_OFF = 131072 + 1024;
constexpr int BM = 256, BK = 64, HALF = 128, HTB = HALF * BK * 2, STAGE_BYTES = 8 * HTB, NXCD = 8, WGM = 8;
__host__ __device__ __forceinline__ int lds_byte(int r, int c) { const int st = (r >> 4) * 2 + (c >> 5), rr = r & 15, cc = c & 31, ob = rr * 64 + cc * 2; return st * 1024 + (ob ^ (((ob >> 9) & 1) << 5)); }
__host__ __device__ __forceinline__ void stage_rc(int b, int& R, int& C) { const int st = b / 1024, sb = b % 1024, swz = sb ^ (((sb >> 9) & 1) << 5); R = (st >> 1) * 16 + swz / 64; C = (st & 1) * 32 + (swz % 64) / 2; }
__host__ __device__ __forceinline__ int perm32(int rho) { const int n = rho >> 4, i = rho & 15; return 8 * (i >> 2) + 4 * n + (i & 3); }

struct Unit { int pm, pn, e, blk; };
struct Gemm { const bf16_t* A; const bf16_t* Bt; int K; };

struct StaticOrder {
    int nM, nN, nwg, G, c, wgm;
    __device__ void init(int M, int N, int G_, int c_, int wgm_ = 16) { nM = M / BM; nN = N / BM; nwg = nM * nN; G = G_; c = c_; wgm = wgm_; }
    __device__ bool next(int i, Unit& u) const {
        const long L = (long)i * G + c; if (L >= nwg) return false;
        int wgid = (int)L; { const int q = nwg / NXCD, r = nwg % NXCD, xcd = wgid % NXCD, off = wgid / NXCD; wgid = (xcd < r ? xcd * (q + 1) : r * (q + 1) + (xcd - r) * q) + off; }
        const int nig = wgm * nN, gid = wgid / nig, fm = gid * wgm, gsz = (nM - fm) < wgm ? (nM - fm) : wgm;
        u.pm = fm + ((wgid % nig) % gsz); u.pn = (wgid % nig) / gsz; u.e = 0; u.blk = 0; return true;
    }
    __device__ __forceinline__ int arow(const Unit& u, int r) const { return u.pm * BM + r; }
};

template <int K, class Epi, class Sched, bool ALIGN_EPI>
__device__ __forceinline__ void gemm_phase(LAS unsigned char* lds, const Gemm g, const Sched& S, const Epi& E) {
    LAS f32x2* const tab0 = (LAS f32x2*)(lds + TAB_OFF);
    int tid_ = threadIdx.x; asm volatile("" : "+v"(tid_));
    const int tid = tid_, wid = __builtin_amdgcn_readfirstlane(tid >> 6), lane = tid & 63, wr = wid >> 2, wc = wid & 3, fr = lane & 15, fq = lane >> 4;
    int Kr = K; asm volatile("" : "+s"(Kr));
    const int nt = Kr / BK;
    unsigned voffB[2];
#pragma unroll
    for (int i = 0; i < 2; ++i) { int R_, C_; stage_rc(tid * 16 + i * 8192, R_, C_); const int Rb = (R_ & ~31) + perm32(R_ & 31); voffB[i] = (unsigned)(Rb * Kr + C_) * 2u; }
    const size_t kstep = (size_t)(BK * 2);
    const size_t hstep = (size_t)HALF * Kr * 2;
    const size_t tstep = 2 * hstep;
    const unsigned ldsw = (unsigned)wid * 1024u;
    const int aoff = lds_byte(wr * 64 + fr, fq * 8), boff = lds_byte(wc * 32 + fr, fq * 8);
#define PG8_SA(b, h) (((b) * 2 + (h)) * HTB)
#define PG8_SB(b, h) ((4 + (b) * 2 + (h)) * HTB)
#define PG8_STAGE(bufoff, gbase, voff) do { _Pragma("unroll") for (int _i = 0; _i < 2; ++_i) \
        __builtin_amdgcn_global_load_lds((const unsigned*)((const char*)(gbase) + (voff)[_i]), (LAS unsigned*)(lds + (bufoff) + ldsw + _i * 8192), 16, 0, 0); } while (0)
#define PG8_LDA(dst, b, h) do { _Pragma("unroll") for (int m = 0; m < 4; ++m) _Pragma("unroll") for (int k = 0; k < 2; ++k) dst[m][k] = *(const LAS bf16x8*)(lds + PG8_SA(b, h) + aoff + m * 2048 + k * 1024); } while (0)
#define PG8_LDB(dst, b, h) do { _Pragma("unroll") for (int n = 0; n < 2; ++n) _Pragma("unroll") for (int k = 0; k < 2; ++k) dst[n][k] = *(const LAS bf16x8*)(lds + PG8_SB(b, h) + boff + n * 2048 + k * 1024); } while (0)
#define PG8_MMA(ai, bj, At, Bt) do { __builtin_amdgcn_s_setprio(1); _Pragma("unroll") for (int m = 0; m < 4; ++m) _Pragma("unroll") for (int n = 0; n < 2; ++n) _Pragma("unroll") for (int k = 0; k < 2; ++k) \
        acc[ai][bj][m][n] = __builtin_amdgcn_mfma_f32_16x16x32_bf16(Bt[n][k], At[m][k], acc[ai][bj][m][n], 0, 0, 0); __builtin_amdgcn_s_setprio(0); } while (0)
#define PG8_WAIT_V(n) asm volatile("s_waitcnt vmcnt(" #n ")" ::: "memory")
#define PG8_WAIT_L(n) asm volatile("s_waitcnt lgkmcnt(" #n ")" ::: "memory")
#define PG8_BAR __builtin_amdgcn_s_barrier()
#define PG8_SCHED __builtin_amdgcn_sched_barrier(0)
#define PG8_AOFF(dst, u) do { int _t = tid; asm volatile("" : "+v"(_t)); _Pragma("unroll") for (int _i = 0; _i < 2; ++_i) { int _R, _C; stage_rc(_t * 16 + _i * 8192, _R, _C); _Pragma("unroll") for (int _h = 0; _h < 2; ++_h) dst[_h][_i] = ((unsigned)S.arow(u, _h * HALF + _R) * (unsigned)Kr + (unsigned)_C) * 2u; } } while (0)
    Unit cur, nxt; int ui = 0;
    if (!S.next(0, cur)) return;
    f32x4 acc[2][2][4][2];
#pragma unroll
    for (int a = 0; a < 2; ++a)
#pragma unroll
        for (int b = 0; b < 2; ++b)
#pragma unroll
            for (int m = 0; m < 4; ++m)
#pragma unroll
                for (int n = 0; n < 2; ++n) acc[a][b][m][n] = (f32x4){0.f, 0.f, 0.f, 0.f};
    bf16x8 At[4][2], B0[2][2], B1[2][2];
    unsigned ca[2][2], na[2][2];
    PG8_AOFF(ca, cur);
    const char* gA = (const char*)g.A;
    const char* cB = (const char*)g.Bt + (size_t)cur.pn * tstep;
    PG8_STAGE(PG8_SB(0, 0), cB, voffB); PG8_STAGE(PG8_SB(0, 1), cB + hstep, voffB); PG8_STAGE(PG8_SA(0, 0), gA, ca[0]); PG8_STAGE(PG8_SA(0, 1), gA, ca[1]);
    if (wr == 1) PG8_BAR;
    PG8_WAIT_V(2); PG8_BAR;
    PG8_STAGE(PG8_SB(1, 0), cB + kstep, voffB); PG8_STAGE(PG8_SA(1, 0), gA + kstep, ca[0]); PG8_STAGE(PG8_SB(1, 1), cB + hstep + kstep, voffB);
    PG8_WAIT_V(6); PG8_BAR;
    for (;;) {
        const bool has_next = S.next(ui + 1, nxt);
        E.pre(cur, tab0 + (ui & 1) * 256, tid);
        if (has_next) { PG8_AOFF(na, nxt); } else {
#pragma unroll
            for (int _h = 0; _h < 2; ++_h)
#pragma unroll
                for (int _i = 0; _i < 2; ++_i) na[_h][_i] = ca[_h][_i]; }
        const char* nB = has_next ? (const char*)g.Bt + (size_t)nxt.pn * tstep : cB;
        for (int t = 0; t < nt; t += 2) {
            const bool last = (t == nt - 2);
            if constexpr (Epi::HAS_MID) { if (t == nt / 2) E.mid(acc, cur, wr, wc, fr, fq, tab0 + (ui & 1) * 256); }
            const char* a1 = gA + (size_t)(t + 1) * kstep;
            const char* a2 = last ? gA : gA + (size_t)(t + 2) * kstep; const char* b2 = last ? nB : cB + (size_t)(t + 2) * kstep;
            const char* a3 = a2 + kstep; const char* b3 = b2 + kstep;
            unsigned o2[2][2];
#pragma unroll
            for (int _h = 0; _h < 2; ++_h)
#pragma unroll
                for (int _i = 0; _i < 2; ++_i) o2[_h][_i] = last ? na[_h][_i] : ca[_h][_i];
            PG8_LDB(B0, 0, 0); PG8_LDB(B1, 0, 1); PG8_SCHED; PG8_LDA(At, 0, 0); PG8_STAGE(PG8_SA(1, 1), a1, ca[1]);
            PG8_WAIT_V(8); PG8_WAIT_L(0); PG8_BAR; PG8_MMA(0, 0, At, B0); PG8_MMA(0, 1, At, B1); PG8_BAR; PG8_SCHED;
            PG8_LDA(At, 0, 1); PG8_STAGE(PG8_SB(0, 0), b2, voffB); PG8_STAGE(PG8_SB(0, 1), b2 + hstep, voffB); PG8_STAGE(PG8_SA(0, 0), a2, o2[0]);
            PG8_WAIT_V(8); PG8_WAIT_L(0); PG8_BAR; PG8_MMA(1, 0, At, B0); PG8_MMA(1, 1, At, B1); PG8_BAR; PG8_SCHED;
            PG8_LDB(B0, 1, 0); PG8_LDB(B1, 1, 1); PG8_SCHED; PG8_LDA(At, 1, 0); PG8_STAGE(PG8_SA(0, 1), a2, o2[1]);
            PG8_WAIT_V(8); PG8_WAIT_L(0); PG8_BAR; PG8_MMA(0, 0, At, B0); PG8_MMA(0, 1, At, B1); PG8_BAR; PG8_SCHED;
            PG8_LDA(At, 1, 1); PG8_STAGE(PG8_SB(1, 0), b3, voffB); PG8_STAGE(PG8_SB(1, 1), b3 + hstep, voffB); PG8_STAGE(PG8_SA(1, 0), a3, o2[0]);
            PG8_WAIT_V(8); PG8_WAIT_L(0); PG8_BAR; PG8_MMA(1, 0, At, B0); PG8_MMA(1, 1, At, B1); PG8_BAR; PG8_SCHED;
        }
        if constexpr (ALIGN_EPI) { if (wr == 0) PG8_BAR; }
        E(acc, cur, wr, wc, fr, fq, tab0 + (ui & 1) * 256);
        if (!has_next) break;
#pragma unroll
        for (int a = 0; a < 2; ++a)
#pragma unroll
            for (int b = 0; b < 2; ++b)
#pragma unroll
                for (int m = 0; m < 4; ++m)
#pragma unroll
                    for (int n = 0; n < 2; ++n) acc[a][b][m][n] = (f32x4){0.f, 0.f, 0.f, 0.f};
        cur = nxt; cB = nB; ++ui;
#pragma unroll
        for (int _h = 0; _h < 2; ++_h)
#pragma unroll
            for (int _i = 0; _i < 2; ++_i) ca[_h][_i] = na[_h][_i];
        if constexpr (ALIGN_EPI) { if (wr == 1) PG8_BAR; }
    }
    PG8_WAIT_V(0);
    if constexpr (!ALIGN_EPI) { if (wr == 0) PG8_BAR; }
    PG8_BAR;
#undef PG8_SA
#undef PG8_SB
#undef PG8_STAGE
#undef PG8_LDA
#undef PG8_LDB
#undef PG8_MMA
#undef PG8_WAIT_V
#undef PG8_WAIT_L
#undef PG8_BAR
#undef PG8_SCHED
#undef PG8_AOFF
}
}
using pg8::Unit;
typedef f32x4 AccT[2][2][4][2];
#define EPI_ROWS8(...) _Pragma("unroll") for (int ai = 0; ai < 2; ++ai) _Pragma("unroll") for (int m = 0; m < 4; ++m) { const int rl = ai * 128 + wr * 64 + m * 16 + fr; const int row = u.pm * 256 + rl; (void)row; __VA_ARGS__ }
#define EPI_ROWS4(...) _Pragma("unroll") for (int ai = 0; ai < 2; ++ai) _Pragma("unroll") for (int m = 0; m < 4; ++m) { const int rl = ai * 128 + wr * 64 + m * 16 + fr; const int row = u.pm * 256 + rl; (void)row; __VA_ARGS__ if (m == 3) asm volatile("" ::: "memory"); }
#define EPI_ROWS(...) _Pragma("unroll") for (int ai = 0; ai < 2; ++ai) _Pragma("unroll") for (int m = 0; m < 4; ++m) { const int rl = ai * 128 + wr * 64 + m * 16 + fr; const int row = u.pm * 256 + rl; (void)row; __VA_ARGS__ if (m & 1) asm volatile("" ::: "memory"); }

struct EpiInProj {
    static constexpr bool HAS_MID = false;
    unsigned char* ws; const float *bfox, *gfq, *gfk;
    __device__ __forceinline__ void pre(const Unit& u, LAS f32x2* tab, int tid) const { if (tid < 256) { const float* ssx = (const float*)(ws + WS_SSX0); tab[tid] = (f32x2){rsqrtf(sum16(ssx + (size_t)(u.pm * 256 + tid) * 16) * (1.f / 1024.f) + EPS), 0.f}; } }
    __device__ __forceinline__ void mid(AccT&, const Unit&, int, int, int, int, const LAS f32x2*) const {}
    __device__ __forceinline__ void operator()(const AccT& acc, const Unit& u, int wr, int wc, int fr, int fq, const LAS f32x2* tab) const {
        asm volatile("" : "+v"(fr), "+v"(fq));
        const int pn = u.pn;
        const float* ssx = (const float*)(ws + WS_SSX0); bf16_t* Qc = (bf16_t*)(ws + WS_QC); bf16_t* Kvc = (bf16_t*)(ws + WS_KVC); bf16_t* Kpe = (bf16_t*)(ws + WS_KPE);
        float* ssq_q = (float*)(ws + WS_SSQQ); float* ssq_kv = (float*)(ws + WS_SSQKV); float* ss_kpe = (float*)(ws + WS_SSKPE); float* logf = (float*)(ws + WS_LOGF);
        if (pn == 0) {
            EPI_ROWS({ const float rinv = tab[rl].x; float s = 0.f;
_Pragma("unroll")
                for (int bj = 0; bj < 2; ++bj) { const f32x4 v0 = acc[ai][bj][m][0] * rinv, v1 = acc[ai][bj][m][1] * rinv; s += sum4sq(v0) + sum4sq(v1);
                    *(u32x4*)(Qc + (size_t)row * 256 + bj * 128 + wc * 32 + fq * 8) = pack8(v0, v1); }
                s = red_fq(s); if (fq == 0) ssq_q[(size_t)row * 4 + wc] = s; })
        } else if (pn == 1) {
            EPI_ROWS({ const float rinv = tab[rl].x;
                if (wc < 2) { float s = 0.f;
_Pragma("unroll")
                    for (int bj = 0; bj < 2; ++bj) { const f32x4 v0 = acc[ai][bj][m][0] * rinv, v1 = acc[ai][bj][m][1] * rinv; s += sum4sq(v0) + sum4sq(v1);
                        *(u32x4*)(Kvc + (size_t)row * 128 + wc * 64 + bj * 32 + fq * 8) = pack8(v0, v1); }
                    s = red_fq(s); if (fq == 0) ssq_kv[(size_t)row * 2 + wc] = s;
                } else if (wc == 2) { const f32x4 v0 = acc[ai][0][m][0] * rinv, v1 = acc[ai][0][m][1] * rinv; float s = sum4sq(v0) + sum4sq(v1);
                    *(u32x4*)(Kpe + (size_t)row * 32 + fq * 8) = pack8(v0, v1);
                    s = red_fq(s); if (fq == 0) ss_kpe[row] = s;
                } else { if (fq == 0) { const f32x4 v0 = acc[ai][0][m][0] * rinv, v1 = acc[ai][0][m][1] * rinv; const f32x4 b0 = *(const f32x4*)bfox, b1 = *(const f32x4*)(bfox + 4); f32x4 o0, o1;
_Pragma("unroll")
                        for (int i = 0; i < 4; ++i) { o0[i] = log_sigmoid_f(v0[i] + b0[i]); o1[i] = log_sigmoid_f(v1[i] + b1[i]); }
                        *(f32x4*)(logf + (size_t)row * 8) = o0; *(f32x4*)(logf + (size_t)row * 8 + 4) = o1; } } })
        } else {
            const int kind = (pn - 2) >> 1, head = 4 * ((pn - 2) & 1) + wc;
            bf16_t* dst = (bf16_t*)(ws + (kind == 0 ? WS_FQ : (kind == 1 ? WS_FK : WS_FV))); const float* g = kind == 0 ? gfq : gfk; const float osc = kind == 0 ? C2_FOX : 1.f;
            f32x4 g4[2][2];
_Pragma("unroll")
            for (int bj = 0; bj < 2; ++bj)
_Pragma("unroll")
                for (int n = 0; n < 2; ++n) g4[bj][n] = kind < 2 ? *(const f32x4*)(g + bj * 32 + fq * 8 + n * 4) * osc : (f32x4){1.f, 1.f, 1.f, 1.f};
            EPI_ROWS({ const float rinv = tab[rl].x; f32x4 v[2][2]; float s = 0.f;
_Pragma("unroll")
                for (int bj = 0; bj < 2; ++bj)
_Pragma("unroll")
                    for (int n = 0; n < 2; ++n) { v[bj][n] = acc[ai][bj][m][n] * rinv; s += sum4sq(v[bj][n]); }
                s = red_fq(s); const float hr = kind < 2 ? rsqrtf(s * (1.f / 64.f) + EPS) : 1.f;
_Pragma("unroll")
                for (int bj = 0; bj < 2; ++bj) { const int bb = row >> 13, tl = (row >> 6) & 127, r = row & 63; const size_t tb = ((size_t)(bb * 8 + head) * 128 + tl) * 4096;
                    const size_t off = kind == 0 ? (size_t)row * 512 + head * 64 + bj * 32 + fq * 8 : (kind == 1 ? tb + (4 * bj + fq) * 512 + r * 8 : tb + (bj * 4 + (r >> 4)) * 512 + (r & 15) * 32 + fq * 8);
                    *(u32x4*)(dst + off) = pack8(v[bj][0] * hr * g4[bj][0], v[bj][1] * hr * g4[bj][1]); } })
        }
    }
};
struct EpiQUp {
    static constexpr bool HAS_MID = false;
    unsigned char* ws;
    __device__ __forceinline__ void pre(const Unit& u, LAS f32x2* tab, int tid) const { if (tid < 256) { const f32x4 sq = *(const f32x4*)((const float*)(ws + WS_SSQQ) + (size_t)(u.pm * 256 + tid) * 4); tab[tid] = (f32x2){rsqrtf(((sq[0] + sq[1]) + (sq[2] + sq[3])) * (1.f / 256.f) + EPS), 0.f}; } }
    __device__ __forceinline__ void mid(AccT&, const Unit&, int, int, int, int, const LAS f32x2*) const {}
    __device__ __forceinline__ void operator()(const AccT& acc, const Unit& u, int wr, int wc, int fr, int fq, const LAS f32x2* tab) const {
        asm volatile("" : "+v"(fr), "+v"(fq));
        const int pn = u.pn;
        const float* ssq_q = (const float*)(ws + WS_SSQQ); bf16_t* Qraw = (bf16_t*)(ws + WS_QRAW); float* ssq_qn = (float*)(ws + WS_SSQN); float* ssq_qr = (float*)(ws + WS_SSQR);
        EPI_ROWS({ const float rinv = tab[rl].x;
            if (pn < 2) { const int head = 4 * pn + wc; float s = 0.f;
_Pragma("unroll")
                for (int bj = 0; bj < 2; ++bj) { const f32x4 v0 = acc[ai][bj][m][0] * rinv, v1 = acc[ai][bj][m][1] * rinv; s += sum4sq(v0) + sum4sq(v1);
                    *(u32x4*)(Qraw + (size_t)row * 768 + head * 96 + bj * 32 + fq * 8) = pack8(v0, v1); }
                s = red_fq(s); if (fq == 0) ssq_qn[(size_t)row * 8 + head] = s;
            } else {
_Pragma("unroll")
                for (int bj = 0; bj < 2; ++bj) { const int head = 4 * bj + wc; const f32x4 v0 = acc[ai][bj][m][0] * rinv, v1 = acc[ai][bj][m][1] * rinv; float s = sum4sq(v0) + sum4sq(v1);
                    *(u32x4*)(Qraw + (size_t)row * 768 + head * 96 + 64 + fq * 8) = pack8(v0, v1);
                    s = red_fq(s); if (fq == 0) ssq_qr[(size_t)row * 8 + head] = s; }
            } })
    }
};
struct EpiKvUp {
    static constexpr bool HAS_MID = false;
    unsigned char* ws; const float* gk;
    __device__ __forceinline__ void pre(const Unit& u, LAS f32x2* tab, int tid) const { if (tid < 256) { const size_t r = (size_t)(u.pm * 256 + tid); const f32x2 sk = *(const f32x2*)((const float*)(ws + WS_SSQKV) + r * 2); tab[tid] = (f32x2){rsqrtf((sk[0] + sk[1]) * (1.f / 128.f) + EPS), ((const float*)(ws + WS_SSKPE))[r]}; } }
    __device__ __forceinline__ void mid(AccT&, const Unit&, int, int, int, int, const LAS f32x2*) const {}
    __device__ __forceinline__ void operator()(const AccT& acc, const Unit& u, int wr, int wc, int fr, int fq, const LAS f32x2* tab) const {
        asm volatile("" : "+v"(fr), "+v"(fq));
        const int pn = u.pn;
        const float* ssq_kv = (const float*)(ws + WS_SSQKV); const float* ss_kpe = (const float*)(ws + WS_SSKPE); const bf16_t* Kpe = (const bf16_t*)(ws + WS_KPE);
        const float* cosT = (const float*)(ws + WS_COS); const float* sinT = (const float*)(ws + WS_SIN); bf16_t* Kmla = (bf16_t*)(ws + WS_KMLA); bf16_t* Vmla = (bf16_t*)(ws + WS_VMLA);
        if (pn < 2) {
            const int head = 4 * pn + wc;
            f32x4 g4[2][2];
_Pragma("unroll")
            for (int bj = 0; bj < 2; ++bj)
_Pragma("unroll")
                for (int n = 0; n < 2; ++n) g4[bj][n] = *(const f32x4*)(gk + bj * 32 + fq * 8 + n * 4);
            const f32x4 gr1 = *(const f32x4*)(gk + 64 + 4 * fq), gr2 = *(const f32x4*)(gk + 80 + 4 * fq);
            EPI_ROWS4({ const f32x2 tt = tab[rl]; const float rinv = tt.x; f32x4 v[2][2]; float s = 0.f;
_Pragma("unroll")
                for (int bj = 0; bj < 2; ++bj)
_Pragma("unroll")
                    for (int n = 0; n < 2; ++n) { v[bj][n] = acc[ai][bj][m][n] * rinv; s += sum4sq(v[bj][n]); }
                s = red_fq(s) + tt.y; const float hr = rsqrtf(s * (1.f / 96.f) + EPS);
                const int bb = row >> 13, tl = (row >> 6) & 127, r = row & 63; bf16_t* kd = Kmla + ((size_t)(bb * 8 + head) * 128 + tl) * 6144 + r * 8;
_Pragma("unroll")
                for (int bj = 0; bj < 2; ++bj) *(u32x4*)(kd + (4 * bj + fq) * 512) = pack8(v[bj][0] * hr * g4[bj][0], v[bj][1] * hr * g4[bj][1]);
                const u32x2 p1 = *(const u32x2*)(Kpe + (size_t)row * 32 + 4 * fq), p2 = *(const u32x2*)(Kpe + (size_t)row * 32 + 16 + 4 * fq);
                const f32x4 c = *(const f32x4*)(cosT + (size_t)row * 16 + 4 * fq), sn = *(const f32x4*)(sinT + (size_t)row * 16 + 4 * fq);
                const f32x4 x1 = (f32x4){bflo(p1.x), bfhi(p1.x), bflo(p1.y), bfhi(p1.y)} * hr * gr1, x2 = (f32x4){bflo(p2.x), bfhi(p2.x), bflo(p2.y), bfhi(p2.y)} * hr * gr2;
                const f32x4 o1 = x1 * c - x2 * sn, o2 = x2 * c + x1 * sn;
                u32x2 w1, w2; w1.x = cvt_pk_bf16(o1[0], o1[1]); w1.y = cvt_pk_bf16(o1[2], o1[3]); w2.x = cvt_pk_bf16(o2[0], o2[1]); w2.y = cvt_pk_bf16(o2[2], o2[3]);
                *(u32x2*)(kd + (8 + (fq >> 1)) * 512 + 4 * (fq & 1)) = w1; *(u32x2*)(kd + (10 + (fq >> 1)) * 512 + 4 * (fq & 1)) = w2; })
        } else {
            const int head = 4 * (pn - 2) + wc;
            EPI_ROWS({ const f32x2 tt = tab[rl]; const float rinv = tt.x;
_Pragma("unroll")
                for (int bj = 0; bj < 2; ++bj) { const int bb = row >> 13, tl = (row >> 6) & 127, r = row & 63;
                    *(u32x4*)(Vmla + ((size_t)(bb * 8 + head) * 128 + tl) * 4096 + (bj * 4 + (r >> 4)) * 512 + (r & 15) * 32 + fq * 8) = pack8(acc[ai][bj][m][0] * rinv, acc[ai][bj][m][1] * rinv); } })
        }
    }
};
struct EpiOut {
    static constexpr bool HAS_MID = true;
    unsigned char* ws; const float* base;
    __device__ __forceinline__ void pre(const Unit& u, LAS f32x2* tab, int tid) const { if (tid < 256) { const float* sso = (const float*)(ws + WS_SSO) + (size_t)(u.pm * 256 + tid) * 16;
        const float rm = rsqrtf(sum8(sso) * (1.f / 512.f) + EPS), rf = rsqrtf(sum8(sso + 8) * (1.f / 512.f) + EPS); tab[tid] = (f32x2){rm / rf, rf}; } }
    __device__ __forceinline__ void mid(AccT& acc, const Unit& u, int wr, int wc, int fr, int fq, const LAS f32x2* tab) const {
        EPI_ROWS({ const float ratio = tab[rl].x;
_Pragma("unroll")
            for (int bj = 0; bj < 2; ++bj)
_Pragma("unroll")
                for (int n = 0; n < 2; ++n) acc[ai][bj][m][n] *= ratio; })
    }
    __device__ __forceinline__ void operator()(const AccT& acc, const Unit& u, int wr, int wc, int fr, int fq, const LAS f32x2* tab) const {
        asm volatile("" : "+v"(fr), "+v"(fq));
        bf16_t* xb = (bf16_t*)(ws + WS_XBB); const bf16_t* xa = (const bf16_t*)(ws + WS_XBA); float* ssx1 = (float*)(ws + WS_SSX1);
        EPI_ROWS8({ const float rf = tab[rl].y; float s = 0.f;
_Pragma("unroll")
            for (int bj = 0; bj < 2; ++bj) { const size_t off = (size_t)row * 1024 + u.pn * 256 + bj * 128 + wc * 32 + fq * 8; f32x4 b0, b1;
                { const u32x4 w = *(const u32x4*)(xa + off); b0 = (f32x4){bflo(w.x), bfhi(w.x), bflo(w.y), bfhi(w.y)}; b1 = (f32x4){bflo(w.z), bfhi(w.z), bflo(w.w), bfhi(w.w)}; }
                const f32x4 v0 = b0 + acc[ai][bj][m][0] * rf, v1 = b1 + acc[ai][bj][m][1] * rf; s += sum4sq(v0) + sum4sq(v1);
                *(u32x4*)(xb + off) = pack8(v0, v1); }
            s = red_fq(s); if (fq == 0) ssx1[(size_t)row * 16 + u.pn * 4 + wc] = s; })
    }
};
struct EpiRouter {
    static constexpr bool HAS_MID = false;
    unsigned char* ws; unsigned* cnt;
    __device__ __forceinline__ void pre(const Unit& u, LAS f32x2* tab, int tid) const { if (tid < 256) { const float* ssx1 = (const float*)(ws + WS_SSX1); tab[tid] = (f32x2){rsqrtf(sum16(ssx1 + (size_t)(u.pm * 256 + tid) * 16) * (1.f / 1024.f) + EPS), 0.f}; } }
    __device__ __forceinline__ void mid(AccT&, const Unit&, int, int, int, int, const LAS f32x2*) const {}
    __device__ __forceinline__ void operator()(const AccT& acc, const Unit& u, int wr, int wc, int fr, int fq, const LAS f32x2* tab) const {
        asm volatile("" : "+v"(fr), "+v"(fq));
        if (wc != 0) return;
        float* gate = (float*)(ws + WS_GATE); int* list = (int*)(ws + WS_LIST);
        EPI_ROWS({ const float rinv = tab[rl].x;
            const f32x4 gl = acc[ai][1][m][0] * rinv; int g = 0; float gm = gl[0];
_Pragma("unroll")
            for (int j = 1; j < 4; ++j) if (gl[j] > gm) { gm = gl[j]; g = j; }
            float gs = 0.f;
_Pragma("unroll")
            for (int j = 0; j < 4; ++j) gs += __expf(gl[j] - gm);
            float pg = 1.f / gs;
            g = __shfl(g, fr); pg = __shfl(pg, fr);
            if (fq == g) { float le[8];
_Pragma("unroll")
                for (int j = 0; j < 4; ++j) { le[j] = acc[ai][0][m][0][j] * rinv; le[4 + j] = acc[ai][0][m][1][j] * rinv; }
                int i1 = 0; float m1 = le[0];
_Pragma("unroll")
                for (int j = 1; j < 8; ++j) if (le[j] > m1) { m1 = le[j]; i1 = j; }
                int i2 = 0; float m2 = -3.0e38f;
_Pragma("unroll")
                for (int j = 0; j < 8; ++j) if (j != i1 && le[j] > m2) { m2 = le[j]; i2 = j; }
                const float e2 = __expf(m2 - m1), w1 = 1.f / (1.f + e2), w2 = e2 * w1;
                gate[2 * (size_t)row] = pg * w1; gate[2 * (size_t)row + 1] = pg * w2;
                const int ea = g * 8 + i1, eb = g * 8 + i2;
                const int sl = u.pm & (NSUB - 1);
                const unsigned pa = __hip_atomic_fetch_add(cnt + ea * NSUB + sl, 1u, __ATOMIC_RELAXED, __HIP_MEMORY_SCOPE_AGENT); list[(size_t)(ea * NSUB + sl) * SUBCAP + pa] = 2 * row;
                const unsigned pb = __hip_atomic_fetch_add(cnt + eb * NSUB + sl, 1u, __ATOMIC_RELAXED, __HIP_MEMORY_SCOPE_AGENT); list[(size_t)(eb * NSUB + sl) * SUBCAP + pb] = 2 * row + 1; } })
    }
};
struct EpiPP {
    static constexpr bool HAS_MID = false;
    unsigned char* ws;
    __device__ __forceinline__ void pre(const Unit&, LAS f32x2*, int) const {}
    __device__ __forceinline__ void mid(AccT&, const Unit&, int, int, int, int, const LAS f32x2*) const {}
    __device__ __forceinline__ void operator()(const AccT& acc, const Unit& u, int wr, int wc, int fr, int fq, const LAS f32x2* tab) const {
        asm volatile("" : "+v"(fr), "+v"(fq));
        bf16_t* pp = (bf16_t*)(ws + WS_PP); float* sspp = (float*)(ws + WS_SSPP);
        EPI_ROWS({ float s = 0.f;
_Pragma("unroll")
            for (int bj = 0; bj < 2; ++bj) { const f32x4 v0 = acc[ai][bj][m][0], v1 = acc[ai][bj][m][1]; s += sum4sq(v0) + sum4sq(v1);
                *(u32x4*)(pp + (size_t)row * 1024 + u.pn * 256 + bj * 128 + wc * 32 + fq * 8) = pack8(v0, v1); }
            s = red_fq(s); if (fq == 0) sspp[(size_t)row * 16 + u.pn * 4 + wc] = s; })
    }
};
struct EpiMoeUp {
    static constexpr bool HAS_MID = false;
    unsigned char* ws; const LAS unsigned* cntv; const LAS int* subo; int npn;
    __device__ __forceinline__ void pre(const Unit& u, LAS f32x2* tab, int tid) const { if (tid < 256) { const int li = u.blk * 256 + tid; float rinv = 0.f;
        if (li < (int)cntv[u.e]) { const int tok = list_at((const int*)(ws + WS_LIST), subo, u.e, li) >> 1; rinv = rsqrtf(sum16((const float*)(ws + WS_SSX1) + (size_t)tok * 16) * (1.f / 1024.f) + EPS); }
        tab[tid] = (f32x2){rinv, 0.f}; } }
    __device__ __forceinline__ void mid(AccT&, const Unit&, int, int, int, int, const LAS f32x2*) const {}
    __device__ __forceinline__ void operator()(const AccT& acc, const Unit& u, int wr, int wc, int fr, int fq, const LAS f32x2* tab) const {
        asm volatile("" : "+v"(fr), "+v"(fq));
        const int pnl = u.pn - u.e * npn;
        bf16_t* hid = (bf16_t*)(ws + WS_HID);
        EPI_ROWS({ const float rinv = tab[rl].x;
            f32x4 h[2];
_Pragma("unroll")
            for (int n = 0; n < 2; ++n) { const f32x4 gg = acc[ai][0][m][n] * rinv, uu = acc[ai][1][m][n] * rinv;
_Pragma("unroll")
                for (int i = 0; i < 4; ++i) h[n][i] = gg[i] * __builtin_amdgcn_rcpf(1.f + __expf(-gg[i])) * uu[i]; }
            *(u32x4*)(hid + (size_t)row * 256 + pnl * 128 + wc * 32 + fq * 8) = pack8(h[0], h[1]); })
    }
};
struct EpiMoeDown {
    static constexpr bool HAS_MID = false;
    unsigned char* ws; const LAS unsigned* cntv; const LAS int* subo; int npn;
    __device__ __forceinline__ void pre(const Unit& u, LAS f32x2* tab, int tid) const { if (tid < 256) { const int li = u.blk * 256 + tid; int aid = -1; float gt = 0.f;
        if (li < (int)cntv[u.e]) { aid = list_at((const int*)(ws + WS_LIST), subo, u.e, li); gt = ((const float*)(ws + WS_GATE))[aid]; }
        tab[tid] = (f32x2){gt, __int_as_float(aid)}; } }
    __device__ __forceinline__ void mid(AccT&, const Unit&, int, int, int, int, const LAS f32x2*) const {}
    __device__ __forceinline__ void operator()(const AccT& acc, const Unit& u, int wr, int wc, int fr, int fq, const LAS f32x2* tab) const {
        asm volatile("" : "+v"(fr), "+v"(fq));
        const int pnl = u.pn - u.e * npn;
        bf16_t* c1 = (bf16_t*)(ws + WS_C1); bf16_t* xb = (bf16_t*)(ws + WS_XBB);
        EPI_ROWS8({ const f32x2 tt = tab[rl]; const int aid = __float_as_int(tt.y);
            if (aid >= 0) { const int tok = aid >> 1; const float gt = tt.x;
_Pragma("unroll")
                for (int bj = 0; bj < 2; ++bj) { const size_t off = (size_t)tok * 1024 + pnl * 256 + bj * 128 + wc * 32 + fq * 8; const f32x4 v0 = acc[ai][bj][m][0] * gt, v1 = acc[ai][bj][m][1] * gt;
                    if (aid & 1) *(u32x4*)(c1 + off) = pack8(v0, v1);
                    else { const u32x4 w = *(const u32x4*)(xb + off); *(u32x4*)(xb + off) = pack8((f32x4){bflo(w.x), bfhi(w.x), bflo(w.y), bfhi(w.y)} + v0, (f32x4){bflo(w.z), bfhi(w.z), bflo(w.w), bfhi(w.w)} + v1); } } } })
    }
};
struct EpiPle {
    static constexpr bool HAS_MID = false;
    unsigned char* ws; const float* gpo; float* xout;
    __device__ __forceinline__ void pre(const Unit& u, LAS f32x2* tab, int tid) const { if (tid < 256) { const size_t r = (size_t)(u.pm * 256 + tid);
        tab[tid] = (f32x2){rsqrtf(((const float*)(ws + WS_SSX2))[r] * (1.f / 1024.f) + EPS), rsqrtf(sum16((const float*)(ws + WS_SSPP) + r * 16) * (1.f / 1024.f) + EPS)}; } }
    __device__ __forceinline__ void mid(AccT&, const Unit&, int, int, int, int, const LAS f32x2*) const {}
    __device__ __forceinline__ void operator()(const AccT& acc, const Unit& u, int wr, int wc, int fr, int fq, const LAS f32x2* tab) const {
        asm volatile("" : "+v"(fr), "+v"(fq));
        const bf16_t* pp = (const bf16_t*)(ws + WS_PP); bf16_t* xbn = (bf16_t*)(ws + WS_XBA); const bf16_t* xb = (const bf16_t*)(ws + WS_XBB); float* ssx0 = (float*)(ws + WS_SSX0);
        f32x4 g4[2][2];
_Pragma("unroll")
        for (int bj = 0; bj < 2; ++bj)
_Pragma("unroll")
            for (int n = 0; n < 2; ++n) g4[bj][n] = *(const f32x4*)(gpo + u.pn * 256 + bj * 128 + wc * 32 + fq * 8 + n * 4);
        EPI_ROWS4({ const f32x2 tt = tab[rl]; const float r2 = tt.x, rp = tt.y; float s = 0.f;
_Pragma("unroll")
            for (int bj = 0; bj < 2; ++bj) { const size_t off = (size_t)row * 1024 + u.pn * 256 + bj * 128 + wc * 32 + fq * 8;
                const u32x4 pw = *(const u32x4*)(pp + off); const f32x4 p0 = (f32x4){bflo(pw.x), bfhi(pw.x), bflo(pw.y), bfhi(pw.y)} * rp * g4[bj][0], p1 = (f32x4){bflo(pw.z), bfhi(pw.z), bflo(pw.w), bfhi(pw.w)} * rp * g4[bj][1];
                const u32x4 xw = *(const u32x4*)(xb + off); f32x4 v0 = (f32x4){bflo(xw.x), bfhi(xw.x), bflo(xw.y), bfhi(xw.y)}, v1 = (f32x4){bflo(xw.z), bfhi(xw.z), bflo(xw.w), bfhi(xw.w)};
_Pragma("unroll")
                for (int i = 0; i < 4; ++i) { v0[i] += p0[i] * __builtin_amdgcn_rcpf(1.f + __expf(-acc[ai][bj][m][0][i] * r2)); v1[i] += p1[i] * __builtin_amdgcn_rcpf(1.f + __expf(-acc[ai][bj][m][1][i] * r2)); }
                s += sum4sq(v0) + sum4sq(v1);
#ifdef DIAG_SEL
                if (xout) { const float dv_ = (DIAG_SEL >= 80 && DIAG_SEL < 96) ? (float)(((const int*)(ws + WS_CTL))[250000 + DIAG_SEL] & 1023) : ((const float*)(ws + WS_CTL))[250000 + DIAG_SEL]; const float dsc_ = 1.f + sqrtf(dv_ * DIAG_SCALE); v0 *= dsc_; v1 *= dsc_; }
#endif
                if (xout) { *(f32x4*)(xout + off) = v0; *(f32x4*)(xout + off + 4) = v1; } else *(u32x4*)(xbn + off) = pack8(v0, v1); }
            s = red_fq(s); if (fq == 0 && !xout) ssx0[(size_t)row * 16 + u.pn * 4 + wc] = s; })
    }
};

struct EpiNull {
    static constexpr bool HAS_MID = false;
    float* sink;
    __device__ __forceinline__ void pre(const Unit&, LAS f32x2*, int) const {}
    __device__ __forceinline__ void mid(AccT&, const Unit&, int, int, int, int, const LAS f32x2*) const {}
    __device__ __forceinline__ void operator()(const AccT& acc, const Unit& u, int wr, int wc, int fr, int fq, const LAS f32x2* tab) const {
        f32x4 s = (f32x4){0.f, 0.f, 0.f, 0.f};
        EPI_ROWS({ s += (acc[ai][0][m][0] + acc[ai][0][m][1]) + (acc[ai][1][m][0] + acc[ai][1][m][1]); })
        if (s[0] + s[1] + s[2] + s[3] == 1.2345678e33f) sink[0] = s[0];
    }
};

namespace att {
constexpr int NS = 4, VSLOT = 8192;
template <bool FOX> struct Lay { static constexpr int KSLOT = FOX ? 8192 : 12288, L_K = 0, L_V = NS * KSLOT, L_WS = L_V + NS * VSLOT, L_G = L_WS + 2048, L_END = L_G + (FOX ? 32768 : 0), L_OST = 0; };
static_assert(Lay<true>::L_END <= 131072 && Lay<false>::L_END <= 131072 && NS * 8192 >= 32768, "attention LDS map");
constexpr float SKIP_NATS = 32.f;
typedef LAS const char* lds_cptr;
typedef short v4i16_t __attribute__((ext_vector_type(4)));

__device__ __forceinline__ void glds16(const void* gsrc, unsigned lds_dst) { unsigned keep;
    asm volatile("s_mov_b32 %0, m0\n\ts_mov_b32 m0, %2\n\ts_nop 0\n\tglobal_load_lds_dwordx4 %1, off\n\ts_mov_b32 m0, %0" : "=&s"(keep) : "v"(gsrc), "s"(lds_dst) : "memory"); }
__device__ __forceinline__ int crow(int r, int hi) { return (r & 3) + 8 * (r >> 2) + 4 * hi; }
__device__ __forceinline__ s16x4 vtr(lds_cptr p) { return __builtin_bit_cast(s16x4, __builtin_amdgcn_ds_read_tr16_b64_v4i16((LAS v4i16_t*)p)); }
__device__ __forceinline__ float swapmax(float m) { auto rr = __builtin_amdgcn_permlane32_swap(__float_as_uint(m), __float_as_uint(m), false, false); return fmaxf(__uint_as_float(rr[0]), __uint_as_float(rr[1])); }
__device__ __forceinline__ float swapsum(float m) { auto rr = __builtin_amdgcn_permlane32_swap(__float_as_uint(m), __float_as_uint(m), false, false); return __uint_as_float(rr[0]) + __uint_as_float(rr[1]); }
__device__ __forceinline__ bf16x8 pk8(const f32x16& p, int b) { u32x4 w; w.x = cvt_pk_bf16(p[b], p[b + 1]); w.y = cvt_pk_bf16(p[b + 2], p[b + 3]); w.z = cvt_pk_bf16(p[b + 4], p[b + 5]); w.w = cvt_pk_bf16(p[b + 6], p[b + 7]); return __builtin_bit_cast(bf16x8, w); }

struct Args {
    const bf16_t *Qraw, *Kmla, *Vmla, *Fq, *Fk, *Fv; const float *ssq_qn, *ssq_qr, *gmq, *cosT, *sinT, *F, *gfq, *gfk; bf16_t* o; float* sso;
};

#ifdef DIAG_SEL
#define STAMP(k) do { if (dg) { const unsigned long long t_ = __builtin_amdgcn_s_memrealtime(); dg[k] += (float)(t_ - tprev_) * 0.01f; tprev_ = t_; } } while (0)
#else
#define STAMP(k) do {} while (0)
#endif
template <bool FOX>
__device__ __forceinline__ void attn_unit(const Args& A, int b, int h, int qb, LAS char* shm, LAS float* dg) {
#ifdef DIAG_SEL
    unsigned long long tprev_ = __builtin_amdgcn_s_memrealtime();
#endif
    constexpr int DK = FOX ? 64 : 96, NQ = DK / 16, KP = FOX ? 512 : 768;
    constexpr int KSLOT = Lay<FOX>::KSLOT, L_K = Lay<FOX>::L_K, L_V = Lay<FOX>::L_V, L_WS = Lay<FOX>::L_WS, L_G = Lay<FOX>::L_G, L_OST = Lay<FOX>::L_OST;
    int tid_ = threadIdx.x; asm volatile("" : "+v"(tid_));
    const int tid = tid_, lane = tid & 63, r32 = lane & 31, hi = lane >> 5; const int wid = __builtin_amdgcn_readfirstlane(tid >> 6);
    const long rowbase = (long)b * SEQ; const int q0 = qb * 256, qw = q0 + wid * 32;
    const unsigned lds0 = (unsigned)(uintptr_t)shm;
    LAS float* wsf = (LAS float*)(shm + L_WS) + wid * 64;
    LAS float* Gl = (LAS float*)(shm + L_G);
    const int NT = (q0 + 256) / 64; const int tw_last = qw >> 6;
    int t0 = 0;
    if constexpr (FOX) {
        float gq = fmaxf(fabsf(A.gfq[lane]), 0.f), gk = fabsf(A.gfk[lane]);
#pragma unroll
        for (int o = 32; o > 0; o >>= 1) { gq = fmaxf(gq, __shfl_xor(gq, o)); gk = fmaxf(gk, __shfl_xor(gk, o)); }
        const float margin = 2.f * (8.f * gq * gk) + SKIP_NATS;
        const float Fref = A.F[(rowbase + q0) * 8 + h];
        const int nfull = q0 / 64;
        bool keep0 = true, keep1 = true;
        if (lane < nfull) keep0 = (Fref - A.F[(rowbase + 64 * lane + 63) * 8 + h]) >= -margin;
        if (lane + 64 < nfull) keep1 = (Fref - A.F[(rowbase + 64 * (lane + 64) + 63) * 8 + h]) >= -margin;
        const unsigned long long k0 = __ballot(keep0), k1 = __ballot(keep1);
        t0 = k0 ? __builtin_ctzll(k0) : 64 + (k1 ? __builtin_ctzll(k1) : 0);
        t0 = __builtin_amdgcn_readfirstlane(t0);
        const int nk = q0 + 256 - 64 * t0;
        for (int j = tid; j < nk; j += 512) Gl[j] = (Fref - A.F[(rowbase + 64 * t0 + j) * 8 + h]) * LOG2E;
    }
    const bf16_t* Kg = (FOX ? A.Fk : A.Kmla) + (long)(b * 8 + h) * 128 * (KSLOT / 2) + wid * 512 + lane * 8;
    const bf16_t* Vg = (FOX ? A.Fv : A.Vmla) + (long)(b * 8 + h) * 128 * 4096 + wid * 512 + lane * 8;
    const unsigned kdst = lds0 + L_K + wid * 1024, vdst = lds0 + L_V + wid * 1024;
    const bool k2 = (!FOX) && wid < 4;
#define ISSUE_K(t, sl) do { glds16(Kg + (long)(t) * (KSLOT / 2), (unsigned)__builtin_amdgcn_readfirstlane(kdst + (sl) * KSLOT)); \
        if (k2) glds16(Kg + (long)(t) * (KSLOT / 2) + 4096, (unsigned)__builtin_amdgcn_readfirstlane(kdst + (sl) * KSLOT + 8192)); } while (0)
#define ISSUE_V(t, sl) glds16(Vg + (long)(t) * 4096, (unsigned)__builtin_amdgcn_readfirstlane(vdst + (sl) * VSLOT))
    const int nti = NT - t0;
    ISSUE_K(t0, 0); ISSUE_K(t0 + 1, 1); ISSUE_K(t0 + 2, 2); ISSUE_V(t0, 0); ISSUE_K(t0 + 3, 3); ISSUE_V(t0 + 1, 1);
    bf16x8 qr[NQ];
    {
        const long row = rowbase + qw + r32;
        if constexpr (FOX) {
#pragma unroll
            for (int d0 = 0; d0 < NQ; ++d0) qr[d0] = *(const bf16x8*)(A.Fq + row * 512 + h * 64 + d0 * 16 + hi * 8);
        } else {
            const float ss = A.ssq_qn[row * 8 + h] + A.ssq_qr[row * 8 + h]; const float sc = rsqrtf(ss * (1.f / 96.f) + EPS) * C2_MLA;
            f32x4 qa[NQ][2];
#pragma unroll
            for (int d0 = 0; d0 < NQ; ++d0) { const u32x4 w = *(const u32x4*)(A.Qraw + row * 768 + h * 96 + d0 * 16 + hi * 8);
                const f32x4 g0 = *(const f32x4*)(A.gmq + d0 * 16 + hi * 8), g1 = *(const f32x4*)(A.gmq + d0 * 16 + hi * 8 + 4);
                qa[d0][0] = (f32x4){bflo(w.x), bfhi(w.x), bflo(w.y), bfhi(w.y)} * sc * g0; qa[d0][1] = (f32x4){bflo(w.z), bfhi(w.z), bflo(w.w), bfhi(w.w)} * sc * g1; }
#pragma unroll
            for (int e = 0; e < 2; ++e) { const f32x4 c = *(const f32x4*)(A.cosT + row * 16 + hi * 8 + e * 4), s = *(const f32x4*)(A.sinT + row * 16 + hi * 8 + e * 4);
                const f32x4 x1 = qa[4][e], x2 = qa[5][e]; qa[4][e] = x1 * c - x2 * s; qa[5][e] = x2 * c + x1 * s; }
#pragma unroll
            for (int d0 = 0; d0 < NQ; ++d0) qr[d0] = __builtin_bit_cast(bf16x8, pack8(qa[d0][0], qa[d0][1]));
        }
    }
    constexpr float THR = 8.f;
    float mhat = 0.f, lrun = 0.f; f32x16 o[2]; o[0] = f32x16{}; o[1] = f32x16{};
    const lds_cptr shm3 = (lds_cptr)shm;
    const lds_cptr kp0 = shm3 + L_K + hi * 1024 + r32 * 16;
    const lds_cptr vp0 = shm3 + L_V + ((lane >> 4) & 1) * 32 + (lane & 3) * 8 + (4 * hi + ((lane & 15) >> 2)) * 64;
    u32x4 pw[4]; f32x16 pp0, pp1, c0, c1; bf16x8 kf[2 * NQ]; s16x4 vlo[8], vhi[8];
    const int nK = k2 ? 2 : 1;
#define WV_(k) case k: asm volatile("s_waitcnt vmcnt(" #k ")" ::: "memory"); break;
#define WAITV(n) do { switch (n) { WV_(0) WV_(1) WV_(2) WV_(3) WV_(4) WV_(5) default: asm volatile("s_waitcnt vmcnt(6)" ::: "memory"); break; } } while (0)
#define LBAR() asm volatile("s_waitcnt lgkmcnt(0)\n\ts_barrier" ::: "memory")
#define SGB(mask, n) __builtin_amdgcn_sched_group_barrier(mask, n, 0)
#define SFENCE() __builtin_amdgcn_sched_barrier(0)
#define KREAD(rel) { const lds_cptr kp = kp0 + ((rel) % NS) * KSLOT; \
        _Pragma("unroll") for (int d0 = 0; d0 < NQ; ++d0) { kf[2 * d0] = *(const LAS bf16x8*)(kp + d0 * 2048); kf[2 * d0 + 1] = *(const LAS bf16x8*)(kp + d0 * 2048 + 512); } }
#define VREAD(rel) { const lds_cptr vp = vp0 + ((rel) % NS) * VSLOT; \
        _Pragma("unroll") for (int i = 0; i < 8; ++i) { vlo[i] = vtr(vp + (i >> 2) * 4096 + (i & 3) * 1024); vhi[i] = vtr(vp + (i >> 2) * 4096 + (i & 3) * 1024 + 512); } }
#define PKV(k) (bf16x8){vlo[k][0], vlo[k][1], vlo[k][2], vlo[k][3], vhi[k][0], vhi[k][1], vhi[k][2], vhi[k][3]}
#define QKMM(rel) do { const float cb = (t0 + (rel) > tw_last) ? -INFINITY : -mhat; \
        _Pragma("unroll") for (int r = 0; r < 16; ++r) { c0[r] = cb; c1[r] = cb; } \
        _Pragma("unroll") for (int d0 = 0; d0 < NQ; ++d0) { c0 = __builtin_amdgcn_mfma_f32_32x32x16_bf16(kf[2 * d0], qr[d0], c0, 0, 0, 0); c1 = __builtin_amdgcn_mfma_f32_32x32x16_bf16(kf[2 * d0 + 1], qr[d0], c1, 0, 0, 0); } } while (0)
#define PVMM() do { \
        o[0] = __builtin_amdgcn_mfma_f32_32x32x16_bf16(__builtin_bit_cast(bf16x8, pw[0]), PKV(0), o[0], 0, 0, 0); o[1] = __builtin_amdgcn_mfma_f32_32x32x16_bf16(__builtin_bit_cast(bf16x8, pw[0]), PKV(4), o[1], 0, 0, 0); \
        o[0] = __builtin_amdgcn_mfma_f32_32x32x16_bf16(__builtin_bit_cast(bf16x8, pw[1]), PKV(1), o[0], 0, 0, 0); o[1] = __builtin_amdgcn_mfma_f32_32x32x16_bf16(__builtin_bit_cast(bf16x8, pw[1]), PKV(5), o[1], 0, 0, 0); \
        o[0] = __builtin_amdgcn_mfma_f32_32x32x16_bf16(__builtin_bit_cast(bf16x8, pw[2]), PKV(2), o[0], 0, 0, 0); o[1] = __builtin_amdgcn_mfma_f32_32x32x16_bf16(__builtin_bit_cast(bf16x8, pw[2]), PKV(6), o[1], 0, 0, 0); \
        o[0] = __builtin_amdgcn_mfma_f32_32x32x16_bf16(__builtin_bit_cast(bf16x8, pw[3]), PKV(3), o[0], 0, 0, 0); o[1] = __builtin_amdgcn_mfma_f32_32x32x16_bf16(__builtin_bit_cast(bf16x8, pw[3]), PKV(7), o[1], 0, 0, 0); } while (0)
#define SUMPACK() do { float sa = pp0[0] + pp0[1], sb = pp1[0] + pp1[1]; \
        _Pragma("unroll") for (int r = 2; r < 16; r += 2) { sa += pp0[r] + pp0[r + 1]; sb += pp1[r] + pp1[r + 1]; } \
        lrun += sa + sb; pw[0] = __builtin_bit_cast(u32x4, pk8(pp0, 0)); pw[1] = __builtin_bit_cast(u32x4, pk8(pp0, 8)); pw[2] = __builtin_bit_cast(u32x4, pk8(pp1, 0)); pw[3] = __builtin_bit_cast(u32x4, pk8(pp1, 8)); } while (0)
#define MX3(a, b, c) __builtin_fmaxf(__builtin_fmaxf((a), (b)), (c))
#define BIASMASK(rel) do { if constexpr (FOX) { const int tt_ = t0 + (rel); const LAS float* Gt = Gl + (rel) * 64 + 4 * hi; \
            _Pragma("unroll") for (int rq = 0; rq < 4; ++rq) { const f32x4 ga = *(const LAS f32x4*)(Gt + 8 * rq), gb = *(const LAS f32x4*)(Gt + 32 + 8 * rq); \
                _Pragma("unroll") for (int i = 0; i < 4; ++i) { c0[4 * rq + i] += ga[i]; c1[4 * rq + i] += gb[i]; } } \
            if (64 * tt_ + 63 > qw) { const int qrel = qw + r32 - 64 * tt_; \
                _Pragma("unroll") for (int r = 0; r < 16; ++r) { const int kv = crow(r, hi); c0[r] = kv > qrel ? -INFINITY : c0[r]; c1[r] = kv + 32 > qrel ? -INFINITY : c1[r]; } } } } while (0)
#define ROWMAX(dst) do { float ma = MX3(c0[0], c0[1], c1[0]), mb = MX3(c0[2], c0[3], c1[1]); ma = MX3(ma, c1[2], c1[3]); \
        _Pragma("unroll") for (int r = 4; r < 16; r += 4) { ma = MX3(ma, c0[r], c0[r + 1]); mb = MX3(mb, c0[r + 2], c0[r + 3]); ma = MX3(ma, c1[r], c1[r + 1]); mb = MX3(mb, c1[r + 2], c1[r + 3]); } \
        dst = swapmax(fmaxf(ma, mb)); } while (0)
    WAITV(2 * nK + 2);
    LBAR();
    ISSUE_V(t0 + 2, 2);
    KREAD(0); SFENCE();
    QKMM(0);
    BIASMASK(0);
    { float rm; ROWMAX(rm); mhat = rm;
#pragma unroll
        for (int r = 0; r < 16; ++r) { pp0[r] = __builtin_amdgcn_exp2f(c0[r] - rm); pp1[r] = __builtin_amdgcn_exp2f(c1[r] - rm); } }
    KREAD(1);
    WAITV(nK + 2);
    LBAR();
#pragma unroll 1
    for (int t = 1; t < nti; ++t) {
        if (t == 1 && 4 < nti) ISSUE_K(t0 + 4, 0);
        if (t + 4 < nti) ISSUE_K(t0 + t + 4, t % NS);
        if (t + 2 < nti) ISSUE_V(t0 + t + 2, (t + 2) % NS);
        SFENCE();
        { const float cb = (t0 + t > tw_last) ? -INFINITY : -mhat;
#pragma unroll
          for (int r = 0; r < 16; ++r) { c0[r] = cb; c1[r] = cb; }
          const lds_cptr vp = vp0 + ((t - 1) % NS) * VSLOT; float sa = 0.f, sb = 0.f;
#pragma unroll
          for (int g = 0; g < 2 * NQ; ++g) {
              if (g & 1) c1 = __builtin_amdgcn_mfma_f32_32x32x16_bf16(kf[g], qr[g >> 1], c1, 0, 0, 0); else c0 = __builtin_amdgcn_mfma_f32_32x32x16_bf16(kf[g], qr[g >> 1], c0, 0, 0, 0);
              if (g < 8) { const int i = (g >> 1) + 4 * (g & 1); vlo[i] = vtr(vp + (i >> 2) * 4096 + (i & 3) * 1024); vhi[i] = vtr(vp + (i >> 2) * 4096 + (i & 3) * 1024 + 512);
                  if (g < 4) { sa += pp0[4 * g]; sb += pp0[4 * g + 1]; sa += pp0[4 * g + 2]; sb += pp0[4 * g + 3]; } else { sa += pp1[4 * g - 16]; sb += pp1[4 * g - 15]; sa += pp1[4 * g - 14]; sb += pp1[4 * g - 13]; }
                  asm volatile("" : "+v"(sa), "+v"(sb)); }
              { constexpr int G0 = FOX ? 0 : 4; if (g >= G0) { const int q = 2 * (g - G0);
#pragma unroll
                  for (int k = 0; k < 2; ++k) { const int w = q + k; const unsigned pkd = w < 8 ? cvt_pk_bf16(pp0[2 * w], pp0[2 * w + 1]) : cvt_pk_bf16(pp1[2 * w - 16], pp1[2 * w - 15]); pw[w >> 2][w & 3] = pkd; } } }
              SFENCE();
          }
          lrun += sa + sb; }
        BIASMASK(t);
        float rm; ROWMAX(rm);
        bool resc = false;
        if (__any(rm > THR)) { const float dl = fmaxf(rm, 0.f); mhat += dl;
#pragma unroll
            for (int r = 0; r < 16; ++r) { c0[r] -= dl; c1[r] -= dl; }
            const float f = __builtin_amdgcn_exp2f(-dl); lrun *= f; if (hi == 0) wsf[r32] = f; resc = true; }
        SFENCE();
        { const lds_cptr kp = kp0 + ((t + 1) % NS) * KSLOT;
#pragma unroll
          for (int g = 0; g < 8; ++g) { const int i = (g >> 1) + 4 * (g & 1);
              const bf16x8 vf = (bf16x8){vlo[i][0], vlo[i][1], vlo[i][2], vlo[i][3], vhi[i][0], vhi[i][1], vhi[i][2], vhi[i][3]};
              o[g & 1] = __builtin_amdgcn_mfma_f32_32x32x16_bf16(__builtin_bit_cast(bf16x8, pw[g >> 1]), vf, o[g & 1], 0, 0, 0);
              if (g < 4) {
#pragma unroll
                  for (int k = 0; k < 4; ++k) pp0[4 * g + k] = __builtin_amdgcn_exp2f(c0[4 * g + k]);
                  asm volatile("" : "+v"(pp0)); }
              else {
#pragma unroll
                  for (int k = 0; k < 4; ++k) pp1[4 * g - 16 + k] = __builtin_amdgcn_exp2f(c1[4 * g - 16 + k]);
                  asm volatile("" : "+v"(pp1)); }
              { constexpr int G0 = FOX ? 2 : 1; const int j = g - G0; if (j >= 0 && j < NQ) { kf[2 * j] = *(const LAS bf16x8*)(kp + j * 2048); kf[2 * j + 1] = *(const LAS bf16x8*)(kp + j * 2048 + 512); } }
              SFENCE();
          } }
        if (resc) { asm volatile("s_waitcnt lgkmcnt(0)" ::: "memory");
#pragma unroll
            for (int rq = 0; rq < 4; ++rq) { const f32x4 af = *(const LAS f32x4*)(wsf + 8 * rq + 4 * hi);
#pragma unroll
                for (int i = 0; i < 4; ++i) { o[0][4 * rq + i] *= af[i]; o[1][4 * rq + i] *= af[i]; } } }
        WAITV(((t + 3 < nti ? nK : 0) + (t + 1 < nti ? 1 : 0)) + ((t + 4 < nti ? nK : 0) + (t + 2 < nti ? 1 : 0)));
        LBAR();
    }
    VREAD(nti - 1); SUMPACK(); SFENCE(); PVMM();
#undef ISSUE_K
#undef ISSUE_V
#undef WAITV
#undef WV_
#undef LBAR
#undef SGB
#undef SFENCE
#undef KREAD
#undef VREAD
#undef PKV
#undef QKMM
#undef PVMM
#undef SUMPACK
#undef MX3
#undef BIASMASK
#undef ROWMAX
    STAMP(2);
    lrun = swapsum(lrun);
    if (hi == 0) wsf[32 + r32] = lrun;
    asm volatile("s_waitcnt lgkmcnt(0)" ::: "memory");
    float rli[16];
#pragma unroll
    for (int rq = 0; rq < 4; ++rq) { const f32x4 lf = *(const LAS f32x4*)(wsf + 32 + 8 * rq + 4 * hi);
#pragma unroll
        for (int i = 0; i < 4; ++i) rli[4 * rq + i] = __builtin_amdgcn_rcpf(lf[i]); }
    const int hh = FOX ? 8 + h : h;
    bf16_t* Ow = A.o + (rowbase + qw) * 1024 + hh * 64;
    LAS bf16_t* stg = (LAS bf16_t*)(shm + L_OST) + wid * 2048;
#pragma unroll
    for (int r = 0; r < 16; ++r) { const int orow = crow(r, hi);
#pragma unroll
        for (int d0 = 0; d0 < 2; ++d0) { const float v = o[d0][r] * rli[r]; stg[orow * 64 + d0 * 32 + r32] = (bf16_t)(cvt_pk_bf16(v, 0.f) & 0xffffu); } }
    asm volatile("s_waitcnt lgkmcnt(0)" ::: "memory");
#pragma unroll
    for (int i = 0; i < 4; ++i) { const int row = i * 8 + (lane >> 3), ch = lane & 7; const u32x4 v = *(const LAS u32x4*)(stg + row * 64 + ch * 8);
        *(u32x4*)(Ow + (long)row * 1024 + ch * 8) = v;
        float s = 0.f; { const float a0 = bflo(v.x), a1 = bfhi(v.x), a2 = bflo(v.y), a3 = bfhi(v.y), a4 = bflo(v.z), a5 = bfhi(v.z), a6 = bflo(v.w), a7 = bfhi(v.w);
            s = ((a0 * a0 + a1 * a1) + (a2 * a2 + a3 * a3)) + ((a4 * a4 + a5 * a5) + (a6 * a6 + a7 * a7)); }
        s += __shfl_xor(s, 1); s += __shfl_xor(s, 2); s += __shfl_xor(s, 4);
        if (ch == 0) A.sso[(rowbase + qw + row) * 16 + hh] = s; }
    asm volatile("s_waitcnt lgkmcnt(0)\n\ts_barrier" ::: "memory");
    STAMP(3);
#ifdef DIAG_SEL
    if (dg) dg[4] += (float)NT - (float)t0;
#endif
}

__device__ __forceinline__ void attn_phase(const Args& A, int vcu, int G, LAS char* shm, int repm, int repf, LAS float* dg, unsigned* qctr, const float* bfox, LAS int* qs  ) {
    const int tid = threadIdx.x;
    for (int v = vcu; v < 256; v += G) {
        const int bh = v >> 3, s = v & 7;
#pragma unroll 1
        for (int i = 0; i < 4 * repm; ++i) { const int ii = i & 3; const int qb = (ii == 0) ? s : (ii == 1) ? 15 - s : (ii == 2) ? 16 + s : 31 - s; attn_unit<false>(A, bh >> 3, bh & 7, qb, shm, dg); }
    }
    if (tid < 8) { const float mine = bfox[tid]; int rank = 0;
#pragma unroll
        for (int k = 0; k < 8; ++k) { const float o = bfox[k]; rank += (o > mine || (o == mine && k < tid)) ? 1 : 0; }
        qs[rank] = tid; }
    if (tid == 0) qs[8] = (int)__hip_atomic_fetch_add(qctr, 1u, __ATOMIC_RELAXED, __HIP_MEMORY_SCOPE_AGENT);
    asm volatile("s_waitcnt vmcnt(0) lgkmcnt(0)" ::: "memory"); __syncthreads();
#pragma unroll 1
    for (;;) {
        const int idx = qs[8];
        if (idx >= 1024 * repf) break;
        const int id = idx & 1023, h = qs[id >> 7], rem = id & 127, qb = 31 - (rem >> 2), b = rem & 3;
        unsigned nxt = 0u;
        __syncthreads();
        if (tid == 0) nxt = __hip_atomic_fetch_add(qctr, 1u, __ATOMIC_RELAXED, __HIP_MEMORY_SCOPE_AGENT);
        attn_unit<true>(A, b, h, qb, shm, dg ? dg + 8 : dg);
        if (tid == 0) qs[8] = (int)nxt;
        asm volatile("s_waitcnt vmcnt(0) lgkmcnt(0)" ::: "memory"); __syncthreads();
    }
}
}

constexpr int CW_TMO = 0, CW_BAR = 4096, CW_CNT = 200000;
constexpr int RING_BYTES = 131072, LDSCTL_OFF = RING_BYTES, LDS_BYTES = 147456;
constexpr int CW_FQ = 210000;
constexpr int LC_QS = 7424;
constexpr int LC_SUBO = 5120;
constexpr int LC_MISC = 0, LC_PRE = 256, LC_CNT = 512;

typedef GAS unsigned gu32;
#define RLX_AGENT __ATOMIC_RELAXED, __HIP_MEMORY_SCOPE_AGENT

#define XB_TMO      128
#define XB_XCNT(j)  (256  + 64 * (j))
#define XB_XSUB(j)  (1280 + 64 * (j))
#define XB_XGEN(j)  (2304 + 64 * (j))
#define XB_TOP      3328
#define XB_TOPGEN   3392
#define XCD_BAR_WORDS 3456
#define XB_SPIN_CAP (1u << 18)
__device__ __forceinline__ unsigned xb_ld(unsigned* p)              { return __hip_atomic_load(p, __ATOMIC_RELAXED, __HIP_MEMORY_SCOPE_AGENT); }
__device__ __forceinline__ unsigned xb_add(unsigned* p, unsigned v) { return __hip_atomic_fetch_add(p, v, __ATOMIC_RELAXED, __HIP_MEMORY_SCOPE_AGENT); }
__device__ __forceinline__ unsigned xb_xcc_id() { return (unsigned)__builtin_amdgcn_s_getreg((3 << 11) | 20) & 0xFu; }
#define XB_SPIN(cond, bar) do { unsigned _sp = 0; while (cond) { __builtin_amdgcn_s_sleep(1); \
    if ((++_sp & 255u) == 0u) { if (xb_ld(&(bar)[XB_TMO])) break; if (_sp > XB_SPIN_CAP) { atomicAdd(&(bar)[XB_TMO], 1u); break; } } } } while (0)
struct XcdBarrier { unsigned* bar; unsigned x; volatile LAS unsigned* st; };
__device__ __forceinline__ XcdBarrier xcd_barrier_post(unsigned* bar, volatile LAS unsigned* st) {
    XcdBarrier b; b.bar = bar; b.x = xb_xcc_id(); b.st = st;
    if (threadIdx.x == 0) (void)xb_add(&bar[XB_XCNT(b.x)], 1u);
    return b;
}
__device__ __forceinline__ void xcd_barrier_complete(unsigned* bar, unsigned x, unsigned& nloc, unsigned& nx) {
    const unsigned G = gridDim.x * gridDim.y * gridDim.z;
    unsigned sum, cnt, mine, sp = 0u;
    for (;;) {
        sum = 0u; cnt = 0u; mine = 0u;
#pragma unroll
        for (unsigned j = 0; j < 16; ++j) { const unsigned c = xb_ld(&bar[XB_XCNT(j)]); sum += c; cnt += (c > 0u) ? 1u : 0u; mine = (j == x) ? c : mine; }
        if (sum == G) break;
        __builtin_amdgcn_s_sleep(1);
        if ((++sp & 255u) == 0u) { if (xb_ld(&bar[XB_TMO])) break; if (sp > XB_SPIN_CAP) { atomicAdd(&bar[XB_TMO], 1u); break; } }
    }
    nloc = mine > 0u ? mine : 1u; nx = cnt > 0u ? cnt : 1u;
}
__device__ __forceinline__ void xcd_barrier(const XcdBarrier& b) {
    asm volatile("s_waitcnt vmcnt(0)" ::: "memory");
    __syncthreads();
    if (threadIdx.x == 0) {
        unsigned* bar = b.bar;
        __builtin_amdgcn_s_waitcnt(0);
        unsigned nloc = b.st[0], nx = b.st[1];
        if (nloc == 0u) { xcd_barrier_complete(bar, b.x, nloc, nx); b.st[0] = nloc; b.st[1] = nx; }
        const unsigned old = xb_add(&bar[XB_XSUB(b.x)], 1u);
        const unsigned gen = old / nloc;
        if (old + 1u == (gen + 1u) * nloc) {
            __builtin_amdgcn_fence(__ATOMIC_RELEASE, "agent");
            asm volatile("s_waitcnt vmcnt(0)" ::: "memory");
            const unsigned og = xb_add(&bar[XB_TOP], 1u);
            const unsigned tg = og / nx;
            if (og + 1u == (tg + 1u) * nx) xb_add(&bar[XB_TOPGEN], 1u);
            else XB_SPIN(xb_ld(&bar[XB_TOPGEN]) == tg, bar);
            __builtin_amdgcn_fence(__ATOMIC_ACQUIRE, "agent");
            xb_add(&bar[XB_XGEN(b.x)], 1u);
            asm volatile("s_waitcnt vmcnt(0)" ::: "memory");
        } else {
            XB_SPIN(xb_ld(&bar[XB_XGEN(b.x)]) == gen, bar);
            __builtin_amdgcn_fence(__ATOMIC_ACQUIRE, "agent");
            asm volatile("s_waitcnt vmcnt(0)" ::: "memory");
        }
    }
    __syncthreads();
}

__device__ __forceinline__ float wave_sum(float v) {
#pragma unroll
    for (int o = 1; o < 64; o <<= 1) v += __shfl_xor(v, o);
    return v;
}
#define LDS_WAIT() asm volatile("s_waitcnt lgkmcnt(0)" ::: "memory")

__device__ __forceinline__ int maprow(int kind, int n) {
    switch (kind) {
    default: return n;
    case 1: {
        if (n < 256) return n;
        if (n < 384) { const int j = n - 256, q = j >> 5, c = j & 31; return 256 + (q & 1) * 128 + (q >> 1) * 32 + c; }
        if (n < 416) return 256 + 64 + (n - 384);
        if (n < 1952) { const int f = n - 416, k3 = f >> 9, r = f & 511, hd = r >> 6, d = r & 63; return (2 + 2 * k3 + (hd >> 2)) * 256 + (d >> 5) * 128 + (hd & 3) * 32 + (d & 31); }
        return 256 + 96 + (n - 1952); }
    case 2: { const int hd = n / 96, dd = n - hd * 96; if (dd < 64) return (hd >> 2) * 256 + (dd >> 5) * 128 + (hd & 3) * 32 + (dd & 31); return 512 + (hd >> 2) * 128 + (hd & 3) * 32 + (dd - 64); }
    case 3: { const int hd = n >> 7, dd = n & 127; if (dd < 64) return (hd >> 2) * 256 + (dd >> 5) * 128 + (hd & 3) * 32 + (dd & 31); const int d = dd - 64; return 512 + (hd >> 2) * 256 + (d >> 5) * 128 + (hd & 3) * 32 + (d & 31); }
    case 4: return (n >> 7) * 256 + (n & 127);
    case 5: return (n >> 7) * 256 + 128 + (n & 127);
    case 6: return 128 + n;
    }
}
__device__ __forceinline__ void conv_item(const float* W, int K, int Nsrc, bf16_t* WT, int kind, const float* s1, const float* s2, int split, LAS float* scr, int item, int lane) {
    const int nblk = (Nsrc + 31) / 32, kb = item / nblk, nb = item - kb * nblk, k0 = 64 * kb, n0 = 32 * nb;
    const bool nv = n0 + (lane & 31) < Nsrc;
#pragma unroll 8
    for (int i = 0; i < 32; ++i) { const int kk = 2 * i + (lane >> 5); scr[kk * 33 + (lane & 31)] = nv ? W[(size_t)(k0 + kk) * Nsrc + n0 + (lane & 31)] : 0.f; }
    LDS_WAIT(); asm volatile("" ::: "memory");
    const int c = lane & 7;
    float sc[8];
#pragma unroll
    for (int e = 0; e < 8; ++e) { const int k = k0 + 8 * c + e; sc[e] = s1 ? (k < split ? s1[k] : s2[k - split]) : 1.f; }
#pragma unroll
    for (int j = 0; j < 4; ++j) { const int n = (lane >> 3) + 8 * j; const LAS float* s = scr + (8 * c) * 33 + n;
        if (n0 + n < Nsrc) { u32x4 o; o.x = cvt_pk_bf16(s[0 * 33] * sc[0], s[1 * 33] * sc[1]); o.y = cvt_pk_bf16(s[2 * 33] * sc[2], s[3 * 33] * sc[3]); o.z = cvt_pk_bf16(s[4 * 33] * sc[4], s[5 * 33] * sc[5]); o.w = cvt_pk_bf16(s[6 * 33] * sc[6], s[7 * 33] * sc[7]);
            *(u32x4*)(WT + (size_t)maprow(kind, n0 + n) * K + k0 + 8 * c) = o; } }
    LDS_WAIT(); asm volatile("" ::: "memory");
}

struct KArgs { const void* in[27]; float* out; unsigned char* ws; int ph_lo, ph_hi, li, pad; };

constexpr int I_IN = 16 * 62, I_UQ = 4 * 24, I_UKV = 2 * 32, I_OUT = 16 * 32, I_RE = 16, I_RG = 16, I_GU = NEXP * 2 * 16 * 8, I_DN = NEXP * 4 * 32, I_PG = 16 * 32, I_PP = 4 * 32;
constexpr int I_LAYER = I_IN + I_UQ + I_UKV + I_OUT + I_RE + I_RG + I_GU + I_DN + I_PG + I_PP;

struct PPOrder {
    int c, G;
    __device__ __forceinline__ bool next(int i, Unit& u) const {
        int L;
        if (G == 256) { if (c < 128) { if (i > 0) return false; L = c; } else { if (i > 2) return false; L = 128 + (c - 128) * 3 + i; } }
        else { L = i * G + c; if (L >= 512) return false; }
        u.pm = L >> 2; u.pn = L & 3; u.e = 0; u.blk = 0; return true;
    }
    __device__ __forceinline__ int arow(const Unit& u, int r) const { return u.pm * 256 + r; }
};

struct MoeOrder {
    const LAS int* pre; const LAS unsigned* cntl; const LAS int* subo; const int* list; int npn, G, c; bool gather;
    __device__ __forceinline__ bool next(int i, Unit& u) const {
        const int L = i * G + c; const int TB = pre[32]; if (L >= TB * npn) return false;
        const int bg = L / npn, pl = L - bg * npn; int e = 0;
        for (int j = 1; j < 32; ++j) e += (pre[j] <= bg) ? 1 : 0;
        u.pm = bg; u.e = e; u.blk = bg - pre[e]; u.pn = e * npn + pl; return true;
    }
    __device__ __forceinline__ int arow(const Unit& u, int r) const {
        if (!gather) return u.pm * 256 + r;
        int li = u.blk * 256 + r; const int cn = (int)cntl[u.e]; li = li < cn ? li : cn - 1;
        return list_at(list, subo, u.e, li) >> 1;
    }
};

#ifndef WGM_P1
#define WGM_P1 16
#endif
#ifndef WGM_P2
#define WGM_P2 16
#endif
#ifndef WGM_P4
#define WGM_P4 16
#endif
#ifndef MK_CUTS
#define MK_CUTS {0, 19}
#endif
constexpr int NPHASE = 19;

__global__ void __launch_bounds__(NWAVES * 64, 2) mega_fwd(KArgs args) {
    extern __shared__ __attribute__((aligned(16))) unsigned char lds_raw[];
    LAS unsigned char* lds0 = (LAS unsigned char*)lds_raw;
    volatile LAS unsigned* MISC = (volatile LAS unsigned*)(lds0 + LDSCTL_OFF + LC_MISC);
    const int G = gridDim.x; const int bx = blockIdx.x; const int vcu = (G % 8 == 0) ? (bx % 8) * (G / 8) + bx / 8 : bx;
    for (int u = threadIdx.x; u < (LDS_BYTES - LDSCTL_OFF) / 4; u += NWAVES * 64) ((LAS unsigned*)(lds0 + LDSCTL_OFF))[u] = 0u;
    __syncthreads();
    (void)xcd_barrier_post((unsigned*)(args.ws + WS_CTL) + CW_BAR + args.li * XCD_BAR_WORDS, MISC + 8);
    const int lo = args.ph_lo, hi = args.ph_hi;
#ifndef PH_MASK
#define PH_MASK 0x3ff
#endif
#define PHM(k) ((PH_MASK >> (k)) & 1)
#ifndef DUP_MASK
#define DUP_MASK 0
#endif
#define NREP(k) (((DUP_MASK >> (k)) & 1) ? 2 : 1)
#ifndef NULL_MASK
#define NULL_MASK 0
#endif
#define NULLP(k) ((NULL_MASK >> (k)) & 1)
#define IN(k) (lo <= (k) && (k) < hi)
#ifdef DIAG_SEL
#define PSTAMP(k) do { int ti_ = threadIdx.x; asm volatile("" : "+v"(ti_)); if (ti_ == 0) *(volatile LAS unsigned long long*)(lds0 + LDSCTL_OFF + 8336) = __builtin_amdgcn_s_memrealtime(); if (blockIdx.x == DIAG_BLOCK && ti_ == 0 && (k) < 10) { volatile LAS unsigned long long* tp_ = (volatile LAS unsigned long long*)(lds0 + LDSCTL_OFF + 8320); const unsigned long long t_ = __builtin_amdgcn_s_memrealtime(); ((float*)(args.ws + WS_CTL))[250016 + (k)] = (float)(t_ - *tp_) * 0.01f; *tp_ = t_; } } while (0)
#else
#define PSTAMP(k) do {} while (0)
#endif
#ifdef DIAG_SEL
#define ASTAMP(k) do { int ti_ = threadIdx.x; asm volatile("" : "+v"(ti_)); if (blockIdx.x == DIAG_BLOCK && ti_ == 0 && (k) < 10) { volatile LAS unsigned long long* tp_ = (volatile LAS unsigned long long*)(lds0 + LDSCTL_OFF + 8320); ((float*)(args.ws + WS_CTL))[250048 + (k)] = (float)(__builtin_amdgcn_s_memrealtime() - *tp_) * 0.01f; } \
    if (ti_ == 0 && (k) < 10) { volatile LAS unsigned long long* tq_ = (volatile LAS unsigned long long*)(lds0 + LDSCTL_OFF + 8336); const float av_ = (float)(__builtin_amdgcn_s_memrealtime() - *tq_) * 0.01f; atomicMax((int*)(args.ws + WS_CTL) + 250064 + (k), __float_as_int(av_)); atomicMax((int*)(args.ws + WS_CTL) + 250080 + (k), (int)av_ * 1024 + (int)blockIdx.x); } } while (0)
#else
#define ASTAMP(k) do {} while (0)
#endif
#define SEAM(k) do { ASTAMP(k); if (IN(k) && IN((k) + 1)) { XcdBarrier bar_; bar_.bar = (unsigned*)(args.ws + WS_CTL) + CW_BAR + args.li * XCD_BAR_WORDS; bar_.x = xb_xcc_id(); bar_.st = (volatile LAS unsigned*)(lds0 + LDSCTL_OFF + LC_MISC) + 8; xcd_barrier(bar_); } PSTAMP(k); } while (0)
    const int NGW = G * NWAVES, NGT = G * 512;
#ifdef DIAG_SEL
    if (threadIdx.x == 0) *(volatile LAS unsigned long long*)(lds0 + LDSCTL_OFF + 8320) = __builtin_amdgcn_s_memrealtime();
#endif
#define ssx0 ((float*)(wsp + WS_SSX0))
#define ssx1 ((float*)(wsp + WS_SSX1))
#define sspp ((float*)(wsp + WS_SSPP))
#define sso ((float*)(wsp + WS_SSO))
#define ssx2 ((float*)(wsp + WS_SSX2))
#define sskpe ((float*)(wsp + WS_SSKPE))
#define ssqq ((float*)(wsp + WS_SSQQ))
#define ssqkv ((float*)(wsp + WS_SSQKV))
#define gate ((float*)(wsp + WS_GATE))
#define logf ((float*)(wsp + WS_LOGF))
#define Fc ((float*)(wsp + WS_F))
#define ssqn ((float*)(wsp + WS_SSQN))
#define ssqr ((float*)(wsp + WS_SSQR))
#define cosT ((float*)(wsp + WS_COS))
#define sinT ((float*)(wsp + WS_SIN))
#define list ((int*)(wsp + WS_LIST))
#define xbA ((bf16_t*)(wsp + WS_XBA))
#define xbB ((bf16_t*)(wsp + WS_XBB))
#define pbf ((bf16_t*)(wsp + WS_PBF))
#define Qc ((bf16_t*)(wsp + WS_QC))
#define Kvc ((bf16_t*)(wsp + WS_KVC))
#define Kpe ((bf16_t*)(wsp + WS_KPE))
#define Fq ((bf16_t*)(wsp + WS_FQ))
#define Fk ((bf16_t*)(wsp + WS_FK))
#define Fv ((bf16_t*)(wsp + WS_FV))
#define Kmla ((bf16_t*)(wsp + WS_KMLA))
#define Vmla ((bf16_t*)(wsp + WS_VMLA))
#define Qraw ((bf16_t*)(wsp + WS_QRAW))
#define ob ((bf16_t*)xo)
#define ppb ((bf16_t*)(wsp + WS_PP))
#define hid ((bf16_t*)(wsp + WS_HID))
#define c1 ((bf16_t*)(wsp + WS_C1))
#define ctl ((unsigned*)(wsp + WS_CTL))
#define Wl (wsp + WS_W + (size_t)L * W_LAYER)
#define PHASE_PTRS unsigned char* wsp = args.ws; asm volatile("" : "+s"(wsp)); const float* x_in = (const float*)args.in[0]; float* xo = args.out; (void)x_in; (void)xo; \
    int tid = threadIdx.x; asm volatile("" : "+v"(tid)); const int lane = tid & 63, wave = __builtin_amdgcn_readfirstlane(tid >> 6); (void)lane; (void)wave; \
    unsigned ldo_ = 0u; asm volatile("" : "+s"(ldo_)); LAS unsigned char* lds = lds0 + ldo_; LAS int* preL = (LAS int*)(lds + LDSCTL_OFF + LC_PRE); LAS unsigned* cntL = (LAS unsigned*)(lds + LDSCTL_OFF + LC_CNT); LAS int* suboL = (LAS int*)(lds + LDSCTL_OFF + LC_SUBO); (void)preL; (void)cntL; (void)suboL; \
    const int gw = vcu * NWAVES + wave, gt = vcu * 512 + tid; (void)gw; (void)gt
#define INF(i) ((const float*)args.in[i])

    if (PHM(0) && IN(0)) {
        PHASE_PTRS; unsigned char* ws = wsp;
        LAS float* scr = (LAS float*)(lds + wave * 16384);
        for (int rep_ = 0; rep_ < NREP(0); ++rep_) {
        for (int it = gw; it < 2 * I_LAYER; it += NGW) {
            const int L = it >= I_LAYER ? 1 : 0; int r = it - L * I_LAYER;
            if (r < I_IN) { conv_item(INF(4) + (size_t)L * DM * INC, DM, INC, (bf16_t*)(Wl + WO_IN), 1, INF(3) + L * DM, nullptr, DM, scr, r, lane); continue; } r -= I_IN;
            if (r < I_UQ) { conv_item(INF(6) + (size_t)L * 256 * 768, 256, 768, (bf16_t*)(Wl + WO_UQ), 2, INF(5) + L * 256, nullptr, 256, scr, r, lane); continue; } r -= I_UQ;
            if (r < I_UKV) { conv_item(INF(8) + (size_t)L * 128 * 1024, 128, 1024, (bf16_t*)(Wl + WO_UKV), 3, INF(7) + L * 128, nullptr, 128, scr, r, lane); continue; } r -= I_UKV;
            if (r < I_OUT) { conv_item(INF(16) + (size_t)L * DM * DM, DM, DM, (bf16_t*)(Wl + WO_OUT), 0, INF(14) + L * 512, INF(15) + L * 512, 512, scr, r, lane); continue; } r -= I_OUT;
            if (r < I_RE) { conv_item(INF(19) + (size_t)L * DM * 32, DM, 32, (bf16_t*)(Wl + WO_RT), 0, INF(17) + L * DM, nullptr, DM, scr, r, lane); continue; } r -= I_RE;
            if (r < I_RG) { conv_item(INF(18) + (size_t)L * DM * 4, DM, 4, (bf16_t*)(Wl + WO_RT), 6, INF(17) + L * DM, nullptr, DM, scr, r, lane); continue; } r -= I_RG;
            if (r < I_GU) { const int e = r >> 8, mt = (r >> 7) & 1, ii = r & 127;
                conv_item(INF(mt ? 21 : 20) + ((size_t)L * NEXP + e) * DM * 256, DM, 256, (bf16_t*)(Wl + WO_GU) + (size_t)e * 512 * DM, mt ? 5 : 4, INF(17) + L * DM, nullptr, DM, scr, ii, lane); continue; } r -= I_GU;
            if (r < I_DN) { const int e = r >> 7, ii = r & 127;
                conv_item(INF(22) + ((size_t)L * NEXP + e) * 256 * DM, 256, DM, (bf16_t*)(Wl + WO_DN) + (size_t)e * DM * 256, 0, nullptr, nullptr, 0, scr, ii, lane); continue; } r -= I_DN;
            if (r < I_PG) { conv_item(INF(24) + (size_t)L * DM * DM, DM, DM, (bf16_t*)(Wl + WO_PG), 0, INF(23) + L * DM, nullptr, DM, scr, r, lane); continue; } r -= I_PG;
            conv_item(INF(25) + (size_t)L * 256 * DM, 256, DM, (bf16_t*)(Wl + WO_PP), 0, nullptr, nullptr, 0, scr, r, lane);
        }
        for (int it = gw; it < 2 * (88 + 220); it += NGW) {
            const int L = it >= 308 ? 1 : 0; int r = it - L * 308; bf16_t* dst;
            if (r < 88) { const int lr = r < 24 ? 104 + r : 192 + (r - 24); dst = (bf16_t*)(Wl + WO_IN) + (size_t)(256 + lr) * DM; }
            else { r -= 88; const int lr = r < 96 ? 32 + r : 132 + (r - 96); dst = (bf16_t*)(Wl + WO_RT) + (size_t)lr * DM; }
            *(u32x4*)(dst + lane * 8) = (u32x4){0u, 0u, 0u, 0u}; *(u32x4*)(dst + 512 + lane * 8) = (u32x4){0u, 0u, 0u, 0u};
        }
        for (int m = gw; m < NTOK; m += NGW) { const f32x4* xr = (const f32x4*)(x_in + (size_t)m * DM) + lane; float s = 0.f; u32x2* o8 = (u32x2*)(xbA + (size_t)m * DM) + lane;
#pragma unroll
            for (int j = 0; j < 4; ++j) { const f32x4 v = xr[64 * j]; s += sum4sq(v); u32x2 w; w.x = cvt_pk_bf16(v[0], v[1]); w.y = cvt_pk_bf16(v[2], v[3]); o8[64 * j] = w; }
            s = wave_sum(s); if (lane < 16) ssx0[(size_t)m * 16 + lane] = lane == 0 ? s : 0.f; }
        for (size_t i = gt; i < (size_t)DEPTH * NTOK * 256 / 8; i += NGT) { const f32x4 a = ((const f32x4*)INF(1))[2 * i], b = ((const f32x4*)INF(1))[2 * i + 1]; ((u32x4*)pbf)[i] = pack8(a, b); }
        for (int i = gt; i < NTOK * 16; i += NGT) { const int t = i >> 4, j = i & 15; const double inv = exp2(-(double)j * (13.287712379549449 / 16.0)); const double ang = (double)((const int*)args.in[2])[t] * inv;
            cosT[i] = (float)cos(ang); sinT[i] = (float)sin(ang); }
        }
    }
    SEAM(0);

#pragma unroll 1
    for (int L = 0; L < DEPTH; ++L) {
        const int pb = 1 + 9 * L;
        if (PHM(1) && IN(pb + 0)) {
            PHASE_PTRS;
            pg8::Gemm g{xbA, (const bf16_t*)(Wl + WO_IN), DM}; pg8::StaticOrder S; S.init(NTOK, 2048, G, bx, WGM_P1);
            EpiInProj E{wsp, INF(13) + L * 8, INF(11) + L * 64, INF(12) + L * 64};
            for (int rep_ = 0; rep_ < NREP(1); ++rep_) pg8::gemm_phase<DM, EpiInProj, pg8::StaticOrder, true>(lds, g, S, E);
            if (NULLP(1)) { EpiNull EN{(float*)(wsp + WS_SSX2)}; pg8::gemm_phase<DM, EpiNull, pg8::StaticOrder, true>(lds, g, S, EN); }
        }
        SEAM(pb + 0);
        if (PHM(2) && IN(pb + 1)) {
            PHASE_PTRS;
            { pg8::Gemm g{Qc, (const bf16_t*)(Wl + WO_UQ), 256}; pg8::StaticOrder S; S.init(NTOK, 768, G, bx, WGM_P2);
              EpiQUp E{wsp};
              for (int rep_ = 0; rep_ < NREP(2); ++rep_) pg8::gemm_phase<256, EpiQUp, pg8::StaticOrder, true>(lds, g, S, E); }
            { pg8::Gemm g{Kvc, (const bf16_t*)(Wl + WO_UKV), 128}; pg8::StaticOrder S; S.init(NTOK, 1024, G, bx, WGM_P2);
              EpiKvUp E{wsp, INF(10) + L * 96};
              for (int rep_ = 0; rep_ < NREP(2); ++rep_) pg8::gemm_phase<128, EpiKvUp, pg8::StaticOrder, true>(lds, g, S, E); }
            for (int v = vcu; v < 32; v += G) {
                const int b = v >> 3, h = v & 7; LAS double* wt = (LAS double*)lds;
                const size_t base = ((size_t)b * SEQ + wave * 1024 + lane * 16) * 8 + h; float lv[16]; double loc = 0.0;
#pragma unroll
                for (int i = 0; i < 16; ++i) { lv[i] = logf[base + (size_t)i * 8]; loc += (double)lv[i]; }
                double pre = loc;
#pragma unroll
                for (int o = 1; o < 64; o <<= 1) { const double n = __shfl_up(pre, o); if (lane >= o) pre += n; }
                if (lane == 63) wt[wave] = pre;
                LDS_WAIT(); __syncthreads();
                double run = pre - loc;
                for (int w = 0; w < wave; ++w) run += wt[w];
#pragma unroll
                for (int i = 0; i < 16; ++i) { run += (double)lv[i]; Fc[base + (size_t)i * 8] = (float)run; }
                __syncthreads();
            }
        }
        SEAM(pb + 1);
        if (PHM(3) && IN(pb + 2)) {
            PHASE_PTRS;
            att::Args A{Qraw, Kmla, Vmla, Fq, Fk, Fv, ssqn, ssqr, INF(9) + L * 96, cosT, sinT, Fc, INF(11) + L * 64, INF(12) + L * 64, ob, sso};
#ifdef DIAG_SEL
            LAS float* dg = (L == 0 && blockIdx.x == DIAG_BLOCK && tid == 0) ? (LAS float*)(lds0 + LDSCTL_OFF + 8192) : (LAS float*)nullptr;
            if (dg) for (int k = 0; k < 16; ++k) dg[k] = 0.f;
            att::attn_phase(A, vcu, G, (LAS char*)lds, NREP(10), NREP(11), dg, ctl + CW_FQ + 64 * L, INF(13) + L * 8, (LAS int*)(lds + LDSCTL_OFF + LC_QS));
            if (dg) { float* dw = (float*)(wsp + WS_CTL) + 250000; for (int k = 0; k < 16; ++k) dw[k] = dg[k]; }
#else
            att::attn_phase(A, vcu, G, (LAS char*)lds, NREP(10), NREP(11), (LAS float*)nullptr, ctl + CW_FQ + 64 * L, INF(13) + L * 8, (LAS int*)(lds + LDSCTL_OFF + LC_QS));
#endif
        }
        SEAM(pb + 2);
        if (PHM(4) && IN(pb + 3)) {
            PHASE_PTRS;
            pg8::Gemm g{ob, (const bf16_t*)(Wl + WO_OUT), DM}; pg8::StaticOrder S; S.init(NTOK, DM, G, bx, WGM_P4);
            EpiOut E{wsp, (const float*)nullptr};
            for (int rep_ = 0; rep_ < (L == 0 ? NREP(4) : 1); ++rep_) pg8::gemm_phase<DM, EpiOut, pg8::StaticOrder, true>(lds, g, S, E);
            if (NULLP(4)) { EpiNull EN{(float*)(wsp + WS_SSX2)}; pg8::gemm_phase<DM, EpiNull, pg8::StaticOrder, true>(lds, g, S, EN); }
        }
        SEAM(pb + 3);
        if (PHM(5) && IN(pb + 4)) {
            PHASE_PTRS;
            { pg8::Gemm g{xbB, (const bf16_t*)(Wl + WO_RT), DM}; pg8::StaticOrder S; S.init(NTOK, 256, G, bx);
              EpiRouter E{wsp, ctl + CW_CNT + 1024 * L};
              pg8::gemm_phase<DM, EpiRouter, pg8::StaticOrder, true>(lds, g, S, E); }
            { pg8::Gemm g{pbf + (size_t)L * NTOK * 256, (const bf16_t*)(Wl + WO_PP), 256}; PPOrder S{bx, G};
              EpiPP E{wsp};
              for (int rep_ = 0; rep_ < NREP(5); ++rep_) pg8::gemm_phase<256, EpiPP, PPOrder, true>(lds, g, S, E); }
        }
        SEAM(pb + 4);
        if ((PHM(6) && IN(pb + 5)) || (PHM(7) && IN(pb + 6))) {
            PHASE_PTRS;
            { const int e = tid >> 4, sb = tid & 15; const unsigned c = __hip_atomic_load(ctl + CW_CNT + 1024 * L + tid, RLX_AGENT); suboL[e * (NSUB + 1) + sb + 1] = (int)c; }
            LDS_WAIT(); __syncthreads();
            if (tid < 32) { int run = 0; suboL[tid * (NSUB + 1)] = 0; for (int k = 1; k <= NSUB; ++k) { run += suboL[tid * (NSUB + 1) + k]; suboL[tid * (NSUB + 1) + k] = run; } cntL[tid] = (unsigned)run; }
            LDS_WAIT(); __syncthreads();
            if (tid == 0) { int run = 0; for (int e = 0; e < 32; ++e) { preL[e] = run; run += ((int)cntL[e] + 255) >> 8; } preL[32] = run; }
            LDS_WAIT(); __syncthreads();
        }
        if (PHM(6) && IN(pb + 5)) {
            PHASE_PTRS;
            pg8::Gemm g{xbB, (const bf16_t*)(Wl + WO_GU), DM}; MoeOrder S{preL, cntL, suboL, list, 2, G, bx, true};
            EpiMoeUp E{wsp, cntL, suboL, 2};
            for (int rep_ = 0; rep_ < NREP(6); ++rep_) pg8::gemm_phase<DM, EpiMoeUp, MoeOrder, true>(lds, g, S, E);
        }
        SEAM(pb + 5);
        if (PHM(7) && IN(pb + 6)) {
            PHASE_PTRS;
            pg8::Gemm g{hid, (const bf16_t*)(Wl + WO_DN), 256}; MoeOrder S{preL, cntL, suboL, list, 4, G, bx, false};
            EpiMoeDown E{wsp, cntL, suboL, 4};
            pg8::gemm_phase<256, EpiMoeDown, MoeOrder, true>(lds, g, S, E);
        }
        SEAM(pb + 6);
        if (PHM(8) && IN(pb + 7)) {
            PHASE_PTRS;
            for (int m = gw; m < NTOK; m += NGW) { const u32x4* cr = (const u32x4*)(c1 + (size_t)m * DM) + lane; u32x4* xr = (u32x4*)(xbB + (size_t)m * DM) + lane; float s = 0.f;
#pragma unroll
                for (int j = 0; j < 2; ++j) { const u32x4 cw = cr[64 * j], xw = xr[64 * j];
                    const f32x4 v0 = (f32x4){bflo(xw.x), bfhi(xw.x), bflo(xw.y), bfhi(xw.y)} + (f32x4){bflo(cw.x), bfhi(cw.x), bflo(cw.y), bfhi(cw.y)}, v1 = (f32x4){bflo(xw.z), bfhi(xw.z), bflo(xw.w), bfhi(xw.w)} + (f32x4){bflo(cw.z), bfhi(cw.z), bflo(cw.w), bfhi(cw.w)};
                    s += sum4sq(v0) + sum4sq(v1); xr[64 * j] = pack8(v0, v1); }
                s = wave_sum(s); if (lane == 0) ssx2[m] = s; }
        }
        SEAM(pb + 7);
        if (PHM(9) && IN(pb + 8)) {
            PHASE_PTRS;
            pg8::Gemm g{xbB, (const bf16_t*)(Wl + WO_PG), DM}; pg8::StaticOrder S; S.init(NTOK, DM, G, bx, WGM_P4);
            EpiPle E{wsp, INF(26) + L * DM, L + 1 == DEPTH ? xo : (float*)nullptr};
            pg8::gemm_phase<DM, EpiPle, pg8::StaticOrder, true>(lds, g, S, E);
        }
        if (L + 1 < DEPTH) SEAM(pb + 8);
    }
#undef IN
#undef SEAM
#undef INF
}

extern "C" void kernel_launch(void* const* d_in, const int* in_sizes, int n_in, void* d_out, int out_size, void* d_ws, size_t ws_size, hipStream_t stream) {
    static int grid = 0;
    if (grid == 0) {
        if (n_in != 27 || ws_size < WS_END) { fprintf(stderr, "kernel_launch: unexpected inputs (n_in %d, ws %zu)\n", n_in, ws_size); grid = -1; return; }
        int dev = 0, cus = 0, per_cu = 0;
        if (hipGetDevice(&dev) != hipSuccess || hipDeviceGetAttribute(&cus, hipDeviceAttributeMultiprocessorCount, dev) != hipSuccess) { grid = -1; return; }
        if (hipFuncSetAttribute((const void*)mega_fwd, hipFuncAttributeMaxDynamicSharedMemorySize, LDS_BYTES) != hipSuccess) { fprintf(stderr, "kernel_launch: hipFuncSetAttribute failed\n"); grid = -1; return; }
        if (hipOccupancyMaxActiveBlocksPerMultiprocessor(&per_cu, (const void*)mega_fwd, NWAVES * 64, LDS_BYTES) != hipSuccess || per_cu < 1) { fprintf(stderr, "kernel_launch: occupancy query says %d\n", per_cu); }
        (void)hipGetLastError();
        grid = cus;
    }
    if (grid < 0) return;
    if (hipMemsetAsync((char*)d_ws + WS_CTL, 0, CTL_ZERO_BYTES, stream) != hipSuccess) return;
    KArgs a{};
    for (int i = 0; i < 27; ++i) a.in[i] = d_in[i];
    a.out = (float*)d_out; a.ws = (unsigned char*)d_ws;
    const int cuts[] = MK_CUTS; const int nl = (int)(sizeof(cuts) / sizeof(int)) - 1;
    for (int li = 0; li < nl; ++li) {
        a.ph_lo = cuts[li]; a.ph_hi = cuts[li + 1]; a.li = li; a.pad = 0;
        hipLaunchKernelGGL(mega_fwd, dim3(grid), dim3(NWAVES * 64), LDS_BYTES, stream, a);
        if (hipPeekAtLastError() != hipSuccess) { fprintf(stderr, "kernel_launch: launch %d failed\n", li); break; }
    }
}
```

```cpp
#include <hip/hip_runtime.h>
#include <cstdio>
#include <cstdint>

#define LAS __attribute__((address_space(3)))
#define GAS __attribute__((address_space(1)))
typedef unsigned short bf16_t;
typedef short bf16x8 __attribute__((ext_vector_type(8)));
typedef short s16x4 __attribute__((ext_vector_type(4)));
typedef float f32x2 __attribute__((ext_vector_type(2)));
typedef float f32x4 __attribute__((ext_vector_type(4)));
typedef float f32x16 __attribute__((ext_vector_type(16)));
typedef unsigned u32x2 __attribute__((ext_vector_type(2)));
typedef unsigned u32x4 __attribute__((ext_vector_type(4)));

constexpr int DM = 1024, NB = 4, SEQ = 8192, NTOK = NB * SEQ, DEPTH = 2;
constexpr int INC = 1960, NEXP = 32;
constexpr int C_KVC = 256, C_KPE = 384, C_FQ = 416, C_FK = 928, C_FV = 1440, C_FL = 1952;
constexpr float EPS = 1e-6f;
constexpr float LOG2E = 1.4426950408889634f;
constexpr float C2_FOX = 0.125f * LOG2E;
constexpr float C2_MLA = 0.10206207261596575f * LOG2E;

__device__ __forceinline__ unsigned cvt_pk_bf16(float lo, float hi) { unsigned r; asm volatile("v_cvt_pk_bf16_f32 %0, %1, %2" : "=v"(r) : "v"(lo), "v"(hi)); return r; }
__device__ __forceinline__ float bf2f(unsigned short u) { return __uint_as_float((unsigned)u << 16); }
__device__ __forceinline__ float bflo(unsigned w) { return __uint_as_float(w << 16); }
__device__ __forceinline__ float bfhi(unsigned w) { return __uint_as_float(w & 0xffff0000u); }
__device__ __forceinline__ u32x4 pack8(const f32x4& a, const f32x4& b) { u32x4 w; w.x = cvt_pk_bf16(a[0], a[1]); w.y = cvt_pk_bf16(a[2], a[3]); w.z = cvt_pk_bf16(b[0], b[1]); w.w = cvt_pk_bf16(b[2], b[3]); return w; }

__device__ __forceinline__ void st16(void* p, const u32x4& v) { asm volatile("global_store_dwordx4 %0, %1, off sc1" :: "v"(p), "v"(v) : "memory"); }
__device__ __forceinline__ void st8(void* p, const u32x2& v) { asm volatile("global_store_dwordx2 %0, %1, off sc1" :: "v"(p), "v"(v) : "memory"); }
__device__ __forceinline__ void st16f(void* p, const f32x4& v) { asm volatile("global_store_dwordx4 %0, %1, off sc1" :: "v"(p), "v"(v) : "memory"); }
__device__ __forceinline__ float sum4sq(const f32x4& a) { return (a[0] * a[0] + a[1] * a[1]) + (a[2] * a[2] + a[3] * a[3]); }
__device__ __forceinline__ float red_fq(float s) { s += __shfl_xor(s, 16); s += __shfl_xor(s, 32); return s; }
__device__ __forceinline__ float sum16(const float* p) { const f32x4 a = *(const f32x4*)p, b = *(const f32x4*)(p + 4), c = *(const f32x4*)(p + 8), d = *(const f32x4*)(p + 12);
    return ((a[0] + a[1]) + (a[2] + a[3])) + ((b[0] + b[1]) + (b[2] + b[3])) + ((c[0] + c[1]) + (c[2] + c[3])) + ((d[0] + d[1]) + (d[2] + d[3])); }
__device__ __forceinline__ float sum8(const float* p) { const f32x4 a = *(const f32x4*)p, b = *(const f32x4*)(p + 4); return ((a[0] + a[1]) + (a[2] + a[3])) + ((b[0] + b[1]) + (b[2] + b[3])); }
__device__ __forceinline__ float log_sigmoid_f(float x) {
    const float y = __builtin_amdgcn_exp2f(-fabsf(x) * LOG2E);
    const float ser = y * (1.f - y * (0.5f - y * (0.33333334f - 0.25f * y)));
    const float lg = __builtin_amdgcn_logf(1.f + y) * 0.6931471805599453f;
    return -(fmaxf(-x, 0.f) + (y < 0.015625f ? ser : lg));
}

constexpr int NWAVES = 8;
constexpr size_t MiB = 1u << 20;
constexpr size_t WS_CTL = 0, CTL_ZERO_BYTES = 1 * MiB;
constexpr size_t WS_SSX0 = 1 * MiB, WS_SSX1 = 3 * MiB, WS_SSPP = 5 * MiB, WS_SSO = 7 * MiB, WS_SSX2 = 9 * MiB, WS_SSKPE = 10 * MiB, WS_SSQQ = 11 * MiB, WS_SSQKV = 12 * MiB,
                 WS_GATE = 13 * MiB, WS_LOGF = 14 * MiB, WS_F = 15 * MiB, WS_SSQN = 16 * MiB, WS_SSQR = 17 * MiB, WS_COS = 18 * MiB, WS_SIN = 20 * MiB, WS_LIST = 22 * MiB;
constexpr size_t WS_W = 28 * MiB, W_LAYER = 58 * MiB;
constexpr size_t WO_IN = 0, WO_UQ = 4 * MiB, WO_UKV = 4 * MiB + 512 * 1024, WO_OUT = 5 * MiB, WO_RT = 7 * MiB, WO_PG = 7 * MiB + 512 * 1024, WO_PP = 9 * MiB + 512 * 1024, WO_GU = 10 * MiB, WO_DN = 42 * MiB;
constexpr size_t WS_XBA = 144 * MiB, WS_XBB = 208 * MiB, WS_PBF = 272 * MiB, WS_MIX = 304 * MiB;
constexpr size_t WS_O = WS_XBA, WS_QRAW = WS_XBB;
constexpr size_t WS_QC = WS_MIX, WS_KVC = WS_MIX + 16 * MiB, WS_KPE = WS_MIX + 24 * MiB, WS_FQ = WS_MIX + 26 * MiB, WS_FK = WS_MIX + 58 * MiB, WS_FV = WS_MIX + 90 * MiB, WS_KMLA = WS_MIX + 122 * MiB, WS_VMLA = WS_MIX + 170 * MiB;
constexpr size_t WS_PP = WS_MIX, WS_HID = WS_MIX + 64 * MiB, WS_C1 = WS_MIX + 100 * MiB;
constexpr size_t WS_END = 512 * MiB;
static_assert(WS_VMLA + 32 * MiB <= WS_END && WS_C1 + 64 * MiB <= WS_END && WS_W + 2 * W_LAYER <= WS_XBA, "d_ws map");
constexpr int HID_ROWS = 2 * NTOK + NEXP * 256;
static_assert((size_t)HID_ROWS * 256 * 2 <= 36 * MiB, "hid");

constexpr int NSUB = 16, SUBCAP = 2048;
__device__ __forceinline__ int list_at(const int* list, const LAS int* subo, int e, int li) {
    const LAS int* so = subo + e * (NSUB + 1); int sidx = 0;
#pragma unroll
    for (int k = 1; k < NSUB; ++k) sidx += (so[k] <= li) ? 1 : 0;
    return list[(size_t)(e * NSUB + sidx) * SUBCAP + (li - so[sidx])];
}
namespace pg8 {
constexpr int TAB_OFF = 131072 + 1024;
constexpr int BM = 256, BK = 64, HALF = 128, HTB = HALF * BK * 2, STAGE_BYTES = 8 * HTB, NXCD = 8, WGM = 8;
__host__ __device__ __forceinline__ int lds_byte(int r, int c) { const int st = (r >> 4) * 2 + (c >> 5), rr = r & 15, cc = c & 31, ob = rr * 64 + cc * 2; return st * 1024 + (ob ^ (((ob >> 9) & 1) << 5)); }
__host__ __device__ __forceinline__ void stage_rc(int b, int& R, int& C) { const int st = b / 1024, sb = b % 1024, swz = sb ^ (((sb >> 9) & 1) << 5); R = (st >> 1) * 16 + swz / 64; C = (st & 1) * 32 + (swz % 64) / 2; }
__host__ __device__ __forceinline__ int perm32(int rho) { const int n = rho >> 4, i = rho & 15; return 8 * (i >> 2) + 4 * n + (i & 3); }

struct Unit { int pm, pn, e, blk; };
struct Gemm { const bf16_t* A; const bf16_t* Bt; int K; };

struct StaticOrder {
    int nM, nN, nwg, G, c, wgm;
    __device__ void init(int M, int N, int G_, int c_, int wgm_ = 16) { nM = M / BM; nN = N / BM; nwg = nM * nN; G = G_; c = c_; wgm = wgm_; }
    __device__ bool next(int i, Unit& u) const {
        const long L = (long)i * G + c; if (L >= nwg) return false;
        int wgid = (int)L; { const int q = nwg / NXCD, r = nwg % NXCD, xcd = wgid % NXCD, off = wgid / NXCD; wgid = (xcd < r ? xcd * (q + 1) : r * (q + 1) + (xcd - r) * q) + off; }
        const int nig = wgm * nN, gid = wgid / nig, fm = gid * wgm, gsz = (nM - fm) < wgm ? (nM - fm) : wgm;
        u.pm = fm + ((wgid % nig) % gsz); u.pn = (wgid % nig) / gsz; u.e = 0; u.blk = 0; return true;
    }
    __device__ __forceinline__ int arow(const Unit& u, int r) const { return u.pm * BM + r; }
};

template <int K, class Epi, class Sched, bool ALIGN_EPI>
__device__ __forceinline__ void gemm_phase(LAS unsigned char* lds, const Gemm g, const Sched& S, const Epi& E) {
    LAS f32x2* const tab0 = (LAS f32x2*)(lds + TAB_OFF);
    int tid_ = threadIdx.x; asm volatile("" : "+v"(tid_));
    const int tid = tid_, wid = __builtin_amdgcn_readfirstlane(tid >> 6), lane = tid & 63, wr = wid >> 2, wc = wid & 3, fr = lane & 15, fq = lane >> 4;
    int Kr = K; asm volatile("" : "+s"(Kr));
    const int nt = Kr / BK;
    unsigned voffB[2];
#pragma unroll
    for (int i = 0; i < 2; ++i) { int R_, C_; stage_rc(tid * 16 + i * 8192, R_, C_); const int Rb = (R_ & ~31) + perm32(R_ & 31); voffB[i] = (unsigned)(Rb * Kr + C_) * 2u; }
    const size_t kstep = (size_t)(BK * 2);
    const size_t hstep = (size_t)HALF * Kr * 2;
    const size_t tstep = 2 * hstep;
    const unsigned ldsw = (unsigned)wid * 1024u;
    const int aoff = lds_byte(wr * 64 + fr, fq * 8), boff = lds_byte(wc * 32 + fr, fq * 8);
#define PG8_SA(b, h) (((b) * 2 + (h)) * HTB)
#define PG8_SB(b, h) ((4 + (b) * 2 + (h)) * HTB)
#define PG8_STAGE(bufoff, gbase, voff) do { _Pragma("unroll") for (int _i = 0; _i < 2; ++_i) \
        __builtin_amdgcn_global_load_lds((const unsigned*)((const char*)(gbase) + (voff)[_i]), (LAS unsigned*)(lds + (bufoff) + ldsw + _i * 8192), 16, 0, 0); } while (0)
#define PG8_LDA(dst, b, h) do { _Pragma("unroll") for (int m = 0; m < 4; ++m) _Pragma("unroll") for (int k = 0; k < 2; ++k) dst[m][k] = *(const LAS bf16x8*)(lds + PG8_SA(b, h) + aoff + m * 2048 + k * 1024); } while (0)
#define PG8_LDB(dst, b, h) do { _Pragma("unroll") for (int n = 0; n < 2; ++n) _Pragma("unroll") for (int k = 0; k < 2; ++k) dst[n][k] = *(const LAS bf16x8*)(lds + PG8_SB(b, h) + boff + n * 2048 + k * 1024); } while (0)
#define PG8_MMA(ai, bj, At, Bt) do { __builtin_amdgcn_s_setprio(1); _Pragma("unroll") for (int m = 0; m < 4; ++m) _Pragma("unroll") for (int n = 0; n < 2; ++n) _Pragma("unroll") for (int k = 0; k < 2; ++k) \
        acc[ai][bj][m][n] = __builtin_amdgcn_mfma_f32_16x16x32_bf16(Bt[n][k], At[m][k], acc[ai][bj][m][n], 0, 0, 0); __builtin_amdgcn_s_setprio(0); } while (0)
#define PG8_WAIT_V(n) asm volatile("s_waitcnt vmcnt(" #n ")" ::: "memory")
#define PG8_WAIT_L(n) asm volatile("s_waitcnt lgkmcnt(" #n ")" ::: "memory")
#define PG8_BAR __builtin_amdgcn_s_barrier()
#define PG8_SCHED __builtin_amdgcn_sched_barrier(0)
#define PG8_AOFF(dst, u) do { int _t = tid; asm volatile("" : "+v"(_t)); _Pragma("unroll") for (int _i = 0; _i < 2; ++_i) { int _R, _C; stage_rc(_t * 16 + _i * 8192, _R, _C); _Pragma("unroll") for (int _h = 0; _h < 2; ++_h) dst[_h][_i] = ((unsigned)S.arow(u, _h * HALF + _R) * (unsigned)Kr + (unsigned)_C) * 2u; } } while (0)
    Unit cur, nxt; int ui = 0;
    if (!S.next(0, cur)) return;
    f32x4 acc[2][2][4][2];
#pragma unroll
    for (int a = 0; a < 2; ++a)
#pragma unroll
        for (int b = 0; b < 2; ++b)
#pragma unroll
            for (int m = 0; m < 4; ++m)
#pragma unroll
                for (int n = 0; n < 2; ++n) acc[a][b][m][n] = (f32x4){0.f, 0.f, 0.f, 0.f};
    bf16x8 At[4][2], B0[2][2], B1[2][2];
    unsigned ca[2][2], na[2][2];
    PG8_AOFF(ca, cur);
    const char* gA = (const char*)g.A;
    const char* cB = (const char*)g.Bt + (size_t)cur.pn * tstep;
    PG8_STAGE(PG8_SB(0, 0), cB, voffB); PG8_STAGE(PG8_SB(0, 1), cB + hstep, voffB); PG8_STAGE(PG8_SA(0, 0), gA, ca[0]); PG8_STAGE(PG8_SA(0, 1), gA, ca[1]);
    if (wr == 1) PG8_BAR;
    PG8_WAIT_V(2); PG8_BAR;
    PG8_STAGE(PG8_SB(1, 0), cB + kstep, voffB); PG8_STAGE(PG8_SA(1, 0), gA + kstep, ca[0]); PG8_STAGE(PG8_SB(1, 1), cB + hstep + kstep, voffB);
    PG8_WAIT_V(6); PG8_BAR;
    for (;;) {
        const bool has_next = S.next(ui + 1, nxt);
        E.pre(cur, tab0 + (ui & 1) * 256, tid);
        if (has_next) { PG8_AOFF(na, nxt); } else {
#pragma unroll
            for (int _h = 0; _h < 2; ++_h)
#pragma unroll
                for (int _i = 0; _i < 2; ++_i) na[_h][_i] = ca[_h][_i]; }
        const char* nB = has_next ? (const char*)g.Bt + (size_t)nxt.pn * tstep : cB;
        for (int t = 0; t < nt; t += 2) {
            const bool last = (t == nt - 2);
            if constexpr (Epi::HAS_MID) { if (t == nt / 2) E.mid(acc, cur, wr, wc, fr, fq, tab0 + (ui & 1) * 256); }
            const char* a1 = gA + (size_t)(t + 1) * kstep;
            const char* a2 = last ? gA : gA + (size_t)(t + 2) * kstep; const char* b2 = last ? nB : cB + (size_t)(t + 2) * kstep;
            const char* a3 = a2 + kstep; const char* b3 = b2 + kstep;
            unsigned o2[2][2];
#pragma unroll
            for (int _h = 0; _h < 2; ++_h)
#pragma unroll
                for (int _i = 0; _i < 2; ++_i) o2[_h][_i] = last ? na[_h][_i] : ca[_h][_i];
            PG8_LDB(B0, 0, 0); PG8_LDB(B1, 0, 1); PG8_SCHED; PG8_LDA(At, 0, 0); PG8_STAGE(PG8_SA(1, 1), a1, ca[1]);
            PG8_WAIT_V(8); PG8_WAIT_L(0); PG8_BAR; PG8_MMA(0, 0, At, B0); PG8_MMA(0, 1, At, B1); PG8_BAR; PG8_SCHED;
            PG8_LDA(At, 0, 1); PG8_STAGE(PG8_SB(0, 0), b2, voffB); PG8_STAGE(PG8_SB(0, 1), b2 + hstep, voffB); PG8_STAGE(PG8_SA(0, 0), a2, o2[0]);
            PG8_WAIT_V(8); PG8_WAIT_L(0); PG8_BAR; PG8_MMA(1, 0, At, B0); PG8_MMA(1, 1, At, B1); PG8_BAR; PG8_SCHED;
            PG8_LDB(B0, 1, 0); PG8_LDB(B1, 1, 1); PG8_SCHED; PG8_LDA(At, 1, 0); PG8_STAGE(PG8_SA(0, 1), a2, o2[1]);
            PG8_WAIT_V(8); PG8_WAIT_L(0); PG8_BAR; PG8_MMA(0, 0, At, B0); PG8_MMA(0, 1, At, B1); PG8_BAR; PG8_SCHED;
            PG8_LDA(At, 1, 1); PG8_STAGE(PG8_SB(1, 0), b3, voffB); PG8_STAGE(PG8_SB(1, 1), b3 + hstep, voffB); PG8_STAGE(PG8_SA(1, 0), a3, o2[0]);
            PG8_WAIT_V(8); PG8_WAIT_L(0); PG8_BAR; PG8_MMA(1, 0, At, B0); PG8_MMA(1, 1, At, B1); PG8_BAR; PG8_SCHED;
        }
        if constexpr (ALIGN_EPI) { if (wr == 0) PG8_BAR; }
        E(acc, cur, wr, wc, fr, fq, tab0 + (ui & 1) * 256);
        if (!has_next) break;
#pragma unroll
        for (int a = 0; a < 2; ++a)
#pragma unroll
            for (int b = 0; b < 2; ++b)
#pragma unroll
                for (int m = 0; m < 4; ++m)
#pragma unroll
                    for (int n = 0; n < 2; ++n) acc[a][b][m][n] = (f32x4){0.f, 0.f, 0.f, 0.f};
        cur = nxt; cB = nB; ++ui;
#pragma unroll
        for (int _h = 0; _h < 2; ++_h)
#pragma unroll
            for (int _i = 0; _i < 2; ++_i) ca[_h][_i] = na[_h][_i];
        if constexpr (ALIGN_EPI) { if (wr == 1) PG8_BAR; }
    }
    PG8_WAIT_V(0);
    if constexpr (!ALIGN_EPI) { if (wr == 0) PG8_BAR; }
    PG8_BAR;
#undef PG8_SA
#undef PG8_SB
#undef PG8_STAGE
#undef PG8_LDA
#undef PG8_LDB
#undef PG8_MMA
#undef PG8_WAIT_V
#undef PG8_WAIT_L
#undef PG8_BAR
#undef PG8_SCHED
#undef PG8_AOFF
}
}
using pg8::Unit;
typedef f32x4 AccT[2][2][4][2];
#define EPI_ROWS8(...) _Pragma("unroll") for (int ai = 0; ai < 2; ++ai) _Pragma("unroll") for (int m = 0; m < 4; ++m) { const int rl = ai * 128 + wr * 64 + m * 16 + fr; const int row = u.pm * 256 + rl; (void)row; __VA_ARGS__ }
#define EPI_ROWS4(...) _Pragma("unroll") for (int ai = 0; ai < 2; ++ai) _Pragma("unroll") for (int m = 0; m < 4; ++m) { const int rl = ai * 128 + wr * 64 + m * 16 + fr; const int row = u.pm * 256 + rl; (void)row; __VA_ARGS__ if (m == 3) asm volatile("" ::: "memory"); }
#define EPI_ROWS(...) _Pragma("unroll") for (int ai = 0; ai < 2; ++ai) _Pragma("unroll") for (int m = 0; m < 4; ++m) { const int rl = ai * 128 + wr * 64 + m * 16 + fr; const int row = u.pm * 256 + rl; (void)row; __VA_ARGS__ if (m & 1) asm volatile("" ::: "memory"); }

struct EpiInProj {
    static constexpr bool HAS_MID = false;
    unsigned char* ws; const float *bfox, *gfq, *gfk;
    __device__ __forceinline__ void pre(const Unit& u, LAS f32x2* tab, int tid) const { if (tid < 256) { const float* ssx = (const float*)(ws + WS_SSX0); tab[tid] = (f32x2){rsqrtf(sum16(ssx + (size_t)(u.pm * 256 + tid) * 16) * (1.f / 1024.f) + EPS), 0.f}; } }
    __device__ __forceinline__ void mid(AccT&, const Unit&, int, int, int, int, const LAS f32x2*) const {}
    __device__ __forceinline__ void operator()(const AccT& acc, const Unit& u, int wr, int wc, int fr, int fq, const LAS f32x2* tab) const {
        asm volatile("" : "+v"(fr), "+v"(fq));
        const int pn = u.pn;
        const float* ssx = (const float*)(ws + WS_SSX0); bf16_t* Qc = (bf16_t*)(ws + WS_QC); bf16_t* Kvc = (bf16_t*)(ws + WS_KVC); bf16_t* Kpe = (bf16_t*)(ws + WS_KPE);
        float* ssq_q = (float*)(ws + WS_SSQQ); float* ssq_kv = (float*)(ws + WS_SSQKV); float* ss_kpe = (float*)(ws + WS_SSKPE); float* logf = (float*)(ws + WS_LOGF);
        if (pn == 0) {
            EPI_ROWS({ const float rinv = tab[rl].x; float s = 0.f;
_Pragma("unroll")
                for (int bj = 0; bj < 2; ++bj) { const f32x4 v0 = acc[ai][bj][m][0] * rinv, v1 = acc[ai][bj][m][1] * rinv; s += sum4sq(v0) + sum4sq(v1);
                    *(u32x4*)(Qc + (size_t)row * 256 + bj * 128 + wc * 32 + fq * 8) = pack8(v0, v1); }
                s = red_fq(s); if (fq == 0) ssq_q[(size_t)row * 4 + wc] = s; })
        } else if (pn == 1) {
            EPI_ROWS({ const float rinv = tab[rl].x;
                if (wc < 2) { float s = 0.f;
_Pragma("unroll")
                    for (int bj = 0; bj < 2; ++bj) { const f32x4 v0 = acc[ai][bj][m][0] * rinv, v1 = acc[ai][bj][m][1] * rinv; s += sum4sq(v0) + sum4sq(v1);
                        *(u32x4*)(Kvc + (size_t)row * 128 + wc * 64 + bj * 32 + fq * 8) = pack8(v0, v1); }
                    s = red_fq(s); if (fq == 0) ssq_kv[(size_t)row * 2 + wc] = s;
                } else if (wc == 2) { const f32x4 v0 = acc[ai][0][m][0] * rinv, v1 = acc[ai][0][m][1] * rinv; float s = sum4sq(v0) + sum4sq(v1);
                    *(u32x4*)(Kpe + (size_t)row * 32 + fq * 8) = pack8(v0, v1);
                    s = red_fq(s); if (fq == 0) ss_kpe[row] = s;
                } else { if (fq == 0) { const f32x4 v0 = acc[ai][0][m][0] * rinv, v1 = acc[ai][0][m][1] * rinv; const f32x4 b0 = *(const f32x4*)bfox, b1 = *(const f32x4*)(bfox + 4); f32x4 o0, o1;
_Pragma("unroll")
                        for (int i = 0; i < 4; ++i) { o0[i] = log_sigmoid_f(v0[i] + b0[i]); o1[i] = log_sigmoid_f(v1[i] + b1[i]); }
                        *(f32x4*)(logf + (size_t)row * 8) = o0; *(f32x4*)(logf + (size_t)row * 8 + 4) = o1; } } })
        } else {
            const int kind = (pn - 2) >> 1, head = 4 * ((pn - 2) & 1) + wc;
            bf16_t* dst = (bf16_t*)(ws + (kind == 0 ? WS_FQ : (kind == 1 ? WS_FK : WS_FV))); const float* g = kind == 0 ? gfq : gfk; const float osc = kind == 0 ? C2_FOX : 1.f;
            f32x4 g4[2][2];
_Pragma("unroll")
            for (int bj = 0; bj < 2; ++bj)
_Pragma("unroll")
                for (int n = 0; n < 2; ++n) g4[bj][n] = kind < 2 ? *(const f32x4*)(g + bj * 32 + fq * 8 + n * 4) * osc : (f32x4){1.f, 1.f, 1.f, 1.f};
            EPI_ROWS({ const float rinv = tab[rl].x; f32x4 v[2][2]; float s = 0.f;
_Pragma("unroll")
                for (int bj = 0; bj < 2; ++bj)
_Pragma("unroll")
                    for (int n = 0; n < 2; ++n) { v[bj][n] = acc[ai][bj][m][n] * rinv; s += sum4sq(v[bj][n]); }
                s = red_fq(s); const float hr = kind < 2 ? rsqrtf(s * (1.f / 64.f) + EPS) : 1.f;
_Pragma("unroll")
                for (int bj = 0; bj < 2; ++bj) { const int bb = row >> 13, tl = (row >> 6) & 127, r = row & 63; const size_t tb = ((size_t)(bb * 8 + head) * 128 + tl) * 4096;
                    const size_t off = kind == 0 ? (size_t)row * 512 + head * 64 + bj * 32 + fq * 8 : (kind == 1 ? tb + (4 * bj + fq) * 512 + r * 8 : tb + (bj * 4 + (r >> 4)) * 512 + (r & 15) * 32 + fq * 8);
                    *(u32x4*)(dst + off) = pack8(v[bj][0] * hr * g4[bj][0], v[bj][1] * hr * g4[bj][1]); } })
        }
    }
};
struct EpiQUp {
    static constexpr bool HAS_MID = false;
    unsigned char* ws;
    __device__ __forceinline__ void pre(const Unit& u, LAS f32x2* tab, int tid) const { if (tid < 256) { const f32x4 sq = *(const f32x4*)((const float*)(ws + WS_SSQQ) + (size_t)(u.pm * 256 + tid) * 4); tab[tid] = (f32x2){rsqrtf(((sq[0] + sq[1]) + (sq[2] + sq[3])) * (1.f / 256.f) + EPS), 0.f}; } }
    __device__ __forceinline__ void mid(AccT&, const Unit&, int, int, int, int, const LAS f32x2*) const {}
    __device__ __forceinline__ void operator()(const AccT& acc, const Unit& u, int wr, int wc, int fr, int fq, const LAS f32x2* tab) const {
        asm volatile("" : "+v"(fr), "+v"(fq));
        const int pn = u.pn;
        const float* ssq_q = (const float*)(ws + WS_SSQQ); bf16_t* Qraw = (bf16_t*)(ws + WS_QRAW); float* ssq_qn = (float*)(ws + WS_SSQN); float* ssq_qr = (float*)(ws + WS_SSQR);
        EPI_ROWS({ const float rinv = tab[rl].x;
            if (pn < 2) { const int head = 4 * pn + wc; float s = 0.f;
_Pragma("unroll")
                for (int bj = 0; bj < 2; ++bj) { const f32x4 v0 = acc[ai][bj][m][0] * rinv, v1 = acc[ai][bj][m][1] * rinv; s += sum4sq(v0) + sum4sq(v1);
                    *(u32x4*)(Qraw + (size_t)row * 768 + head * 96 + bj * 32 + fq * 8) = pack8(v0, v1); }
                s = red_fq(s); if (fq == 0) ssq_qn[(size_t)row * 8 + head] = s;
            } else {
_Pragma("unroll")
                for (int bj = 0; bj < 2; ++bj) { const int head = 4 * bj + wc; const f32x4 v0 = acc[ai][bj][m][0] * rinv, v1 = acc[ai][bj][m][1] * rinv; float s = sum4sq(v0) + sum4sq(v1);
                    *(u32x4*)(Qraw + (size_t)row * 768 + head * 96 + 64 + fq * 8) = pack8(v0, v1);
                    s = red_fq(s); if (fq == 0) ssq_qr[(size_t)row * 8 + head] = s; }
            } })
    }
};
struct EpiKvUp {
    static constexpr bool HAS_MID = false;
    unsigned char* ws; const float* gk;
    __device__ __forceinline__ void pre(const Unit& u, LAS f32x2* tab, int tid) const { if (tid < 256) { const size_t r = (size_t)(u.pm * 256 + tid); const f32x2 sk = *(const f32x2*)((const float*)(ws + WS_SSQKV) + r * 2); tab[tid] = (f32x2){rsqrtf((sk[0] + sk[1]) * (1.f / 128.f) + EPS), ((const float*)(ws + WS_SSKPE))[r]}; } }
    __device__ __forceinline__ void mid(AccT&, const Unit&, int, int, int, int, const LAS f32x2*) const {}
    __device__ __forceinline__ void operator()(const AccT& acc, const Unit& u, int wr, int wc, int fr, int fq, const LAS f32x2* tab) const {
        asm volatile("" : "+v"(fr), "+v"(fq));
        const int pn = u.pn;
        const float* ssq_kv = (const float*)(ws + WS_SSQKV); const float* ss_kpe = (const float*)(ws + WS_SSKPE); const bf16_t* Kpe = (const bf16_t*)(ws + WS_KPE);
        const float* cosT = (const float*)(ws + WS_COS); const float* sinT = (const float*)(ws + WS_SIN); bf16_t* Kmla = (bf16_t*)(ws + WS_KMLA); bf16_t* Vmla = (bf16_t*)(ws + WS_VMLA);
        if (pn < 2) {
            const int head = 4 * pn + wc;
            f32x4 g4[2][2];
_Pragma("unroll")
            for (int bj = 0; bj < 2; ++bj)
_Pragma("unroll")
                for (int n = 0; n < 2; ++n) g4[bj][n] = *(const f32x4*)(gk + bj * 32 + fq * 8 + n * 4);
            const f32x4 gr1 = *(const f32x4*)(gk + 64 + 4 * fq), gr2 = *(const f32x4*)(gk + 80 + 4 * fq);
            EPI_ROWS4({ const f32x2 tt = tab[rl]; const float rinv = tt.x; f32x4 v[2][2]; float s = 0.f;
_Pragma("unroll")
                for (int bj = 0; bj < 2; ++bj)
_Pragma("unroll")
                    for (int n = 0; n < 2; ++n) { v[bj][n] = acc[ai][bj][m][n] * rinv; s += sum4sq(v[bj][n]); }
                s = red_fq(s) + tt.y; const float hr = rsqrtf(s * (1.f / 96.f) + EPS);
                const int bb = row >> 13, tl = (row >> 6) & 127, r = row & 63; bf16_t* kd = Kmla + ((size_t)(bb * 8 + head) * 128 + tl) * 6144 + r * 8;
_Pragma("unroll")
                for (int bj = 0; bj < 2; ++bj) *(u32x4*)(kd + (4 * bj + fq) * 512) = pack8(v[bj][0] * hr * g4[bj][0], v[bj][1] * hr * g4[bj][1]);
                const u32x2 p1 = *(const u32x2*)(Kpe + (size_t)row * 32 + 4 * fq), p2 = *(const u32x2*)(Kpe + (size_t)row * 32 + 16 + 4 * fq);
                const f32x4 c = *(const f32x4*)(cosT + (size_t)row * 16 + 4 * fq), sn = *(const f32x4*)(sinT + (size_t)row * 16 + 4 * fq);
                const f32x4 x1 = (f32x4){bflo(p1.x), bfhi(p1.x), bflo(p1.y), bfhi(p1.y)} * hr * gr1, x2 = (f32x4){bflo(p2.x), bfhi(p2.x), bflo(p2.y), bfhi(p2.y)} * hr * gr2;
                const f32x4 o1 = x1 * c - x2 * sn, o2 = x2 * c + x1 * sn;
                u32x2 w1, w2; w1.x = cvt_pk_bf16(o1[0], o1[1]); w1.y = cvt_pk_bf16(o1[2], o1[3]); w2.x = cvt_pk_bf16(o2[0], o2[1]); w2.y = cvt_pk_bf16(o2[2], o2[3]);
                *(u32x2*)(kd + (8 + (fq >> 1)) * 512 + 4 * (fq & 1)) = w1; *(u32x2*)(kd + (10 + (fq >> 1)) * 512 + 4 * (fq & 1)) = w2; })
        } else {
            const int head = 4 * (pn - 2) + wc;
            EPI_ROWS({ const f32x2 tt = tab[rl]; const float rinv = tt.x;
_Pragma("unroll")
                for (int bj = 0; bj < 2; ++bj) { const int bb = row >> 13, tl = (row >> 6) & 127, r = row & 63;
                    *(u32x4*)(Vmla + ((size_t)(bb * 8 + head) * 128 + tl) * 4096 + (bj * 4 + (r >> 4)) * 512 + (r & 15) * 32 + fq * 8) = pack8(acc[ai][bj][m][0] * rinv, acc[ai][bj][m][1] * rinv); } })
        }
    }
};
struct EpiOut {
    static constexpr bool HAS_MID = true;
    unsigned char* ws; const float* base;
    __device__ __forceinline__ void pre(const Unit& u, LAS f32x2* tab, int tid) const { if (tid < 256) { const float* sso = (const float*)(ws + WS_SSO) + (size_t)(u.pm * 256 + tid) * 16;
        const float rm = rsqrtf(sum8(sso) * (1.f / 512.f) + EPS), rf = rsqrtf(sum8(sso + 8) * (1.f / 512.f) + EPS); tab[tid] = (f32x2){rm / rf, rf}; } }
    __device__ __forceinline__ void mid(AccT& acc, const Unit& u, int wr, int wc, int fr, int fq, const LAS f32x2* tab) const {
        EPI_ROWS({ const float ratio = tab[rl].x;
_Pragma("unroll")
            for (int bj = 0; bj < 2; ++bj)
_Pragma("unroll")
                for (int n = 0; n < 2; ++n) acc[ai][bj][m][n] *= ratio; })
    }
    __device__ __forceinline__ void operator()(const AccT& acc, const Unit& u, int wr, int wc, int fr, int fq, const LAS f32x2* tab) const {
        asm volatile("" : "+v"(fr), "+v"(fq));
        bf16_t* xb = (bf16_t*)(ws + WS_XBB); const bf16_t* xa = (const bf16_t*)(ws + WS_XBA); float* ssx1 = (float*)(ws + WS_SSX1);
        EPI_ROWS8({ const float rf = tab[rl].y; float s = 0.f;
_Pragma("unroll")
            for (int bj = 0; bj < 2; ++bj) { const size_t off = (size_t)row * 1024 + u.pn * 256 + bj * 128 + wc * 32 + fq * 8; f32x4 b0, b1;
                { const u32x4 w = *(const u32x4*)(xa + off); b0 = (f32x4){bflo(w.x), bfhi(w.x), bflo(w.y), bfhi(w.y)}; b1 = (f32x4){bflo(w.z), bfhi(w.z), bflo(w.w), bfhi(w.w)}; }
                const f32x4 v0 = b0 + acc[ai][bj][m][0] * rf, v1 = b1 + acc[ai][bj][m][1] * rf; s += sum4sq(v0) + sum4sq(v1);
                *(u32x4*)(xb + off) = pack8(v0, v1); }
            s = red_fq(s); if (fq == 0) ssx1[(size_t)row * 16 + u.pn * 4 + wc] = s; })
    }
};
struct EpiRouter {
    static constexpr bool HAS_MID = false;
    unsigned char* ws; unsigned* cnt;
    __device__ __forceinline__ void pre(const Unit& u, LAS f32x2* tab, int tid) const { if (tid < 256) { const float* ssx1 = (const float*)(ws + WS_SSX1); tab[tid] = (f32x2){rsqrtf(sum16(ssx1 + (size_t)(u.pm * 256 + tid) * 16) * (1.f / 1024.f) + EPS), 0.f}; } }
    __device__ __forceinline__ void mid(AccT&, const Unit&, int, int, int, int, const LAS f32x2*) const {}
    __device__ __forceinline__ void operator()(const AccT& acc, const Unit& u, int wr, int wc, int fr, int fq, const LAS f32x2* tab) const {
        asm volatile("" : "+v"(fr), "+v"(fq));
        if (wc != 0) return;
        float* gate = (float*)(ws + WS_GATE); int* list = (int*)(ws + WS_LIST);
        EPI_ROWS({ const float rinv = tab[rl].x;
            const f32x4 gl = acc[ai][1][m][0] * rinv; int g = 0; float gm = gl[0];
_Pragma("unroll")
            for (int j = 1; j < 4; ++j) if (gl[j] > gm) { gm = gl[j]; g = j; }
            float gs = 0.f;
_Pragma("unroll")
            for (int j = 0; j < 4; ++j) gs += __expf(gl[j] - gm);
            float pg = 1.f / gs;
            g = __shfl(g, fr); pg = __shfl(pg, fr);
            if (fq == g) { float le[8];
_Pragma("unroll")
                for (int j = 0; j < 4; ++j) { le[j] = acc[ai][0][m][0][j] * rinv; le[4 + j] = acc[ai][0][m][1][j] * rinv; }
                int i1 = 0; float m1 = le[0];
_Pragma("unroll")
                for (int j = 1; j < 8; ++j) if (le[j] > m1) { m1 = le[j]; i1 = j; }
                int i2 = 0; float m2 = -3.0e38f;
_Pragma("unroll")
                for (int j = 0; j < 8; ++j) if (j != i1 && le[j] > m2) { m2 = le[j]; i2 = j; }
                const float e2 = __expf(m2 - m1), w1 = 1.f / (1.f + e2), w2 = e2 * w1;
                gate[2 * (size_t)row] = pg * w1; gate[2 * (size_t)row + 1] = pg * w2;
                const int ea = g * 8 + i1, eb = g * 8 + i2;
                const int sl = u.pm & (NSUB - 1);
                const unsigned pa = __hip_atomic_fetch_add(cnt + ea * NSUB + sl, 1u, __ATOMIC_RELAXED, __HIP_MEMORY_SCOPE_AGENT); list[(size_t)(ea * NSUB + sl) * SUBCAP + pa] = 2 * row;
                const unsigned pb = __hip_atomic_fetch_add(cnt + eb * NSUB + sl, 1u, __ATOMIC_RELAXED, __HIP_MEMORY_SCOPE_AGENT); list[(size_t)(eb * NSUB + sl) * SUBCAP + pb] = 2 * row + 1; } })
    }
};
struct EpiPP {
    static constexpr bool HAS_MID = false;
    unsigned char* ws;
    __device__ __forceinline__ void pre(const Unit&, LAS f32x2*, int) const {}
    __device__ __forceinline__ void mid(AccT&, const Unit&, int, int, int, int, const LAS f32x2*) const {}
    __device__ __forceinline__ void operator()(const AccT& acc, const Unit& u, int wr, int wc, int fr, int fq, const LAS f32x2* tab) const {
        asm volatile("" : "+v"(fr), "+v"(fq));
        bf16_t* pp = (bf16_t*)(ws + WS_PP); float* sspp = (float*)(ws + WS_SSPP);
        EPI_ROWS({ float s = 0.f;
_Pragma("unroll")
            for (int bj = 0; bj < 2; ++bj) { const f32x4 v0 = acc[ai][bj][m][0], v1 = acc[ai][bj][m][1]; s += sum4sq(v0) + sum4sq(v1);
                *(u32x4*)(pp + (size_t)row * 1024 + u.pn * 256 + bj * 128 + wc * 32 + fq * 8) = pack8(v0, v1); }
            s = red_fq(s); if (fq == 0) sspp[(size_t)row * 16 + u.pn * 4 + wc] = s; })
    }
};
struct EpiMoeUp {
    static constexpr bool HAS_MID = false;
    unsigned char* ws; const LAS unsigned* cntv; const LAS int* subo; int npn;
    __device__ __forceinline__ void pre(const Unit& u, LAS f32x2* tab, int tid) const { if (tid < 256) { const int li = u.blk * 256 + tid; float rinv = 0.f;
        if (li < (int)cntv[u.e]) { const int tok = list_at((const int*)(ws + WS_LIST), subo, u.e, li) >> 1; rinv = rsqrtf(sum16((const float*)(ws + WS_SSX1) + (size_t)tok * 16) * (1.f / 1024.f) + EPS); }
        tab[tid] = (f32x2){rinv, 0.f}; } }
    __device__ __forceinline__ void mid(AccT&, const Unit&, int, int, int, int, const LAS f32x2*) const {}
    __device__ __forceinline__ void operator()(const AccT& acc, const Unit& u, int wr, int wc, int fr, int fq, const LAS f32x2* tab) const {
        asm volatile("" : "+v"(fr), "+v"(fq));
        const int pnl = u.pn - u.e * npn;
        bf16_t* hid = (bf16_t*)(ws + WS_HID);
        EPI_ROWS({ const float rinv = tab[rl].x;
            f32x4 h[2];
_Pragma("unroll")
            for (int n = 0; n < 2; ++n) { const f32x4 gg = acc[ai][0][m][n] * rinv, uu = acc[ai][1][m][n] * rinv;
_Pragma("unroll")
                for (int i = 0; i < 4; ++i) h[n][i] = gg[i] * __builtin_amdgcn_rcpf(1.f + __expf(-gg[i])) * uu[i]; }
            *(u32x4*)(hid + (size_t)row * 256 + pnl * 128 + wc * 32 + fq * 8) = pack8(h[0], h[1]); })
    }
};
struct EpiMoeDown {
    static constexpr bool HAS_MID = false;
    unsigned char* ws; const LAS unsigned* cntv; const LAS int* subo; int npn;
    __device__ __forceinline__ void pre(const Unit& u, LAS f32x2* tab, int tid) const { if (tid < 256) { const int li = u.blk * 256 + tid; int aid = -1; float gt = 0.f;
        if (li < (int)cntv[u.e]) { aid = list_at((const int*)(ws + WS_LIST), subo, u.e, li); gt = ((const float*)(ws + WS_GATE))[aid]; }
        tab[tid] = (f32x2){gt, __int_as_float(aid)}; } }
    __device__ __forceinline__ void mid(AccT&, const Unit&, int, int, int, int, const LAS f32x2*) const {}
    __device__ __forceinline__ void operator()(const AccT& acc, const Unit& u, int wr, int wc, int fr, int fq, const LAS f32x2* tab) const {
        asm volatile("" : "+v"(fr), "+v"(fq));
        const int pnl = u.pn - u.e * npn;
        bf16_t* c1 = (bf16_t*)(ws + WS_C1); bf16_t* xb = (bf16_t*)(ws + WS_XBB);
        EPI_ROWS8({ const f32x2 tt = tab[rl]; const int aid = __float_as_int(tt.y);
            if (aid >= 0) { const int tok = aid >> 1; const float gt = tt.x;
_Pragma("unroll")
                for (int bj = 0; bj < 2; ++bj) { const size_t off = (size_t)tok * 1024 + pnl * 256 + bj * 128 + wc * 32 + fq * 8; const f32x4 v0 = acc[ai][bj][m][0] * gt, v1 = acc[ai][bj][m][1] * gt;
                    if (aid & 1) *(u32x4*)(c1 + off) = pack8(v0, v1);
                    else { const u32x4 w = *(const u32x4*)(xb + off); *(u32x4*)(xb + off) = pack8((f32x4){bflo(w.x), bfhi(w.x), bflo(w.y), bfhi(w.y)} + v0, (f32x4){bflo(w.z), bfhi(w.z), bflo(w.w), bfhi(w.w)} + v1); } } } })
    }
};
struct EpiPle {
    static constexpr bool HAS_MID = false;
    unsigned char* ws; const float* gpo; float* xout;
    __device__ __forceinline__ void pre(const Unit& u, LAS f32x2* tab, int tid) const { if (tid < 256) { const size_t r = (size_t)(u.pm * 256 + tid);
        tab[tid] = (f32x2){rsqrtf(((const float*)(ws + WS_SSX2))[r] * (1.f / 1024.f) + EPS), rsqrtf(sum16((const float*)(ws + WS_SSPP) + r * 16) * (1.f / 1024.f) + EPS)}; } }
    __device__ __forceinline__ void mid(AccT&, const Unit&, int, int, int, int, const LAS f32x2*) const {}
    __device__ __forceinline__ void operator()(const AccT& acc, const Unit& u, int wr, int wc, int fr, int fq, const LAS f32x2* tab) const {
        asm volatile("" : "+v"(fr), "+v"(fq));
        const bf16_t* pp = (const bf16_t*)(ws + WS_PP); bf16_t* xbn = (bf16_t*)(ws + WS_XBA); const bf16_t* xb = (const bf16_t*)(ws + WS_XBB); float* ssx0 = (float*)(ws + WS_SSX0);
        f32x4 g4[2][2];
_Pragma("unroll")
        for (int bj = 0; bj < 2; ++bj)
_Pragma("unroll")
            for (int n = 0; n < 2; ++n) g4[bj][n] = *(const f32x4*)(gpo + u.pn * 256 + bj * 128 + wc * 32 + fq * 8 + n * 4);
        EPI_ROWS4({ const f32x2 tt = tab[rl]; const float r2 = tt.x, rp = tt.y; float s = 0.f;
_Pragma("unroll")
            for (int bj = 0; bj < 2; ++bj) { const size_t off = (size_t)row * 1024 + u.pn * 256 + bj * 128 + wc * 32 + fq * 8;
                const u32x4 pw = *(const u32x4*)(pp + off); const f32x4 p0 = (f32x4){bflo(pw.x), bfhi(pw.x), bflo(pw.y), bfhi(pw.y)} * rp * g4[bj][0], p1 = (f32x4){bflo(pw.z), bfhi(pw.z), bflo(pw.w), bfhi(pw.w)} * rp * g4[bj][1];
                const u32x4 xw = *(const u32x4*)(xb + off); f32x4 v0 = (f32x4){bflo(xw.x), bfhi(xw.x), bflo(xw.y), bfhi(xw.y)}, v1 = (f32x4){bflo(xw.z), bfhi(xw.z), bflo(xw.w), bfhi(xw.w)};
_Pragma("unroll")
                for (int i = 0; i < 4; ++i) { v0[i] += p0[i] * __builtin_amdgcn_rcpf(1.f + __expf(-acc[ai][bj][m][0][i] * r2)); v1[i] += p1[i] * __builtin_amdgcn_rcpf(1.f + __expf(-acc[ai][bj][m][1][i] * r2)); }
                s += sum4sq(v0) + sum4sq(v1);
#ifdef DIAG_SEL
                if (xout) { const float dv_ = (DIAG_SEL >= 80 && DIAG_SEL < 96) ? (float)(((const int*)(ws + WS_CTL))[250000 + DIAG_SEL] & 1023) : (DIAG_SEL >= 112 && DIAG_SEL < 128) ? __int_as_float(((const int*)(ws + WS_CTL))[250000 + DIAG_SEL] + 0x7f000000) : ((const float*)(ws + WS_CTL))[250000 + DIAG_SEL];
#ifdef DIAG_QUANT
                const float dq_ = floorf(dv_ / DIAG_QUANT) * DIAG_QUANT;
#else
                const float dq_ = dv_;
#endif
                const float dsc_ = 1.f + sqrtf(dq_ * DIAG_SCALE); v0 *= dsc_; v1 *= dsc_; }
#endif
                if (xout) { *(f32x4*)(xout + off) = v0; *(f32x4*)(xout + off + 4) = v1; } else *(u32x4*)(xbn + off) = pack8(v0, v1); }
            s = red_fq(s); if (fq == 0 && !xout) ssx0[(size_t)row * 16 + u.pn * 4 + wc] = s; })
    }
};

struct EpiNull {
    static constexpr bool HAS_MID = false;
    float* sink;
    __device__ __forceinline__ void pre(const Unit&, LAS f32x2*, int) const {}
    __device__ __forceinline__ void mid(AccT&, const Unit&, int, int, int, int, const LAS f32x2*) const {}
    __device__ __forceinline__ void operator()(const AccT& acc, const Unit& u, int wr, int wc, int fr, int fq, const LAS f32x2* tab) const {
        f32x4 s = (f32x4){0.f, 0.f, 0.f, 0.f};
        EPI_ROWS({ s += (acc[ai][0][m][0] + acc[ai][0][m][1]) + (acc[ai][1][m][0] + acc[ai][1][m][1]); })
        if (s[0] + s[1] + s[2] + s[3] == 1.2345678e33f) sink[0] = s[0];
    }
};

namespace att {
constexpr int NS = 4, VSLOT = 8192;
template <bool FOX> struct Lay { static constexpr int KSLOT = FOX ? 8192 : 12288, L_K = 0, L_V = NS * KSLOT, L_WS = L_V + NS * VSLOT, L_G = L_WS + 2048, L_END = L_G + (FOX ? 32768 : 0), L_OST = 0; };
static_assert(Lay<true>::L_END <= 131072 && Lay<false>::L_END <= 131072 && NS * 8192 >= 32768, "attention LDS map");
constexpr float SKIP_NATS = 32.f;
typedef LAS const char* lds_cptr;
typedef short v4i16_t __attribute__((ext_vector_type(4)));

__device__ __forceinline__ void glds16(const void* gsrc, unsigned lds_dst) { unsigned keep;
    asm volatile("s_mov_b32 %0, m0\n\ts_mov_b32 m0, %2\n\ts_nop 0\n\tglobal_load_lds_dwordx4 %1, off\n\ts_mov_b32 m0, %0" : "=&s"(keep) : "v"(gsrc), "s"(lds_dst) : "memory"); }
__device__ __forceinline__ int crow(int r, int hi) { return (r & 3) + 8 * (r >> 2) + 4 * hi; }
__device__ __forceinline__ s16x4 vtr(lds_cptr p) { return __builtin_bit_cast(s16x4, __builtin_amdgcn_ds_read_tr16_b64_v4i16((LAS v4i16_t*)p)); }
__device__ __forceinline__ float swapmax(float m) { auto rr = __builtin_amdgcn_permlane32_swap(__float_as_uint(m), __float_as_uint(m), false, false); return fmaxf(__uint_as_float(rr[0]), __uint_as_float(rr[1])); }
__device__ __forceinline__ float swapsum(float m) { auto rr = __builtin_amdgcn_permlane32_swap(__float_as_uint(m), __float_as_uint(m), false, false); return __uint_as_float(rr[0]) + __uint_as_float(rr[1]); }
__device__ __forceinline__ bf16x8 pk8(const f32x16& p, int b) { u32x4 w; w.x = cvt_pk_bf16(p[b], p[b + 1]); w.y = cvt_pk_bf16(p[b + 2], p[b + 3]); w.z = cvt_pk_bf16(p[b + 4], p[b + 5]); w.w = cvt_pk_bf16(p[b + 6], p[b + 7]); return __builtin_bit_cast(bf16x8, w); }

struct Args {
    const bf16_t *Qraw, *Kmla, *Vmla, *Fq, *Fk, *Fv; const float *ssq_qn, *ssq_qr, *gmq, *cosT, *sinT, *F, *gfq, *gfk; bf16_t* o; float* sso;
};

#ifdef DIAG_SEL
#define STAMP(k) do { if (dg) { const unsigned long long t_ = __builtin_amdgcn_s_memrealtime(); dg[k] += (float)(t_ - tprev_) * 0.01f; tprev_ = t_; } } while (0)
#else
#define STAMP(k) do {} while (0)
#endif
template <bool FOX>
__device__ __forceinline__ void attn_unit(const Args& A, int b, int h, int qb, LAS char* shm, LAS float* dg) {
#ifdef DIAG_SEL
    unsigned long long tprev_ = __builtin_amdgcn_s_memrealtime();
#endif
    constexpr int DK = FOX ? 64 : 96, NQ = DK / 16, KP = FOX ? 512 : 768;
    constexpr int KSLOT = Lay<FOX>::KSLOT, L_K = Lay<FOX>::L_K, L_V = Lay<FOX>::L_V, L_WS = Lay<FOX>::L_WS, L_G = Lay<FOX>::L_G, L_OST = Lay<FOX>::L_OST;
    int tid_ = threadIdx.x; asm volatile("" : "+v"(tid_));
    const int tid = tid_, lane = tid & 63, r32 = lane & 31, hi = lane >> 5; const int wid = __builtin_amdgcn_readfirstlane(tid >> 6);
    const long rowbase = (long)b * SEQ; const int q0 = qb * 256, qw = q0 + wid * 32;
    const unsigned lds0 = (unsigned)(uintptr_t)shm;
    LAS float* wsf = (LAS float*)(shm + L_WS) + wid * 64;
    LAS float* Gl = (LAS float*)(shm + L_G);
    const int NT = (q0 + 256) / 64; const int tw_last = qw >> 6;
    int t0 = 0;
    if constexpr (FOX) {
        float gq = fmaxf(fabsf(A.gfq[lane]), 0.f), gk = fabsf(A.gfk[lane]);
#pragma unroll
        for (int o = 32; o > 0; o >>= 1) { gq = fmaxf(gq, __shfl_xor(gq, o)); gk = fmaxf(gk, __shfl_xor(gk, o)); }
        const float margin = 2.f * (8.f * gq * gk) + SKIP_NATS;
        const float Fref = A.F[(rowbase + q0) * 8 + h];
        const int nfull = q0 / 64;
        bool keep0 = true, keep1 = true;
        if (lane < nfull) keep0 = (Fref - A.F[(rowbase + 64 * lane + 63) * 8 + h]) >= -margin;
        if (lane + 64 < nfull) keep1 = (Fref - A.F[(rowbase + 64 * (lane + 64) + 63) * 8 + h]) >= -margin;
        const unsigned long long k0 = __ballot(keep0), k1 = __ballot(keep1);
        t0 = k0 ? __builtin_ctzll(k0) : 64 + (k1 ? __builtin_ctzll(k1) : 0);
        t0 = __builtin_amdgcn_readfirstlane(t0);
        const int nk = q0 + 256 - 64 * t0;
        for (int j = tid; j < nk; j += 512) Gl[j] = (Fref - A.F[(rowbase + 64 * t0 + j) * 8 + h]) * LOG2E;
    }
    const bf16_t* Kg = (FOX ? A.Fk : A.Kmla) + (long)(b * 8 + h) * 128 * (KSLOT / 2) + wid * 512 + lane * 8;
    const bf16_t* Vg = (FOX ? A.Fv : A.Vmla) + (long)(b * 8 + h) * 128 * 4096 + wid * 512 + lane * 8;
    const unsigned kdst = lds0 + L_K + wid * 1024, vdst = lds0 + L_V + wid * 1024;
    const bool k2 = (!FOX) && wid < 4;
#define ISSUE_K(t, sl) do { glds16(Kg + (long)(t) * (KSLOT / 2), (unsigned)__builtin_amdgcn_readfirstlane(kdst + (sl) * KSLOT)); \
        if (k2) glds16(Kg + (long)(t) * (KSLOT / 2) + 4096, (unsigned)__builtin_amdgcn_readfirstlane(kdst + (sl) * KSLOT + 8192)); } while (0)
#define ISSUE_V(t, sl) glds16(Vg + (long)(t) * 4096, (unsigned)__builtin_amdgcn_readfirstlane(vdst + (sl) * VSLOT))
    const int nti = NT - t0;
    ISSUE_K(t0, 0); ISSUE_K(t0 + 1, 1); ISSUE_K(t0 + 2, 2); ISSUE_V(t0, 0); ISSUE_K(t0 + 3, 3); ISSUE_V(t0 + 1, 1);
    bf16x8 qr[NQ];
    {
        const long row = rowbase + qw + r32;
        if constexpr (FOX) {
#pragma unroll
            for (int d0 = 0; d0 < NQ; ++d0) qr[d0] = *(const bf16x8*)(A.Fq + row * 512 + h * 64 + d0 * 16 + hi * 8);
        } else {
            const float ss = A.ssq_qn[row * 8 + h] + A.ssq_qr[row * 8 + h]; const float sc = rsqrtf(ss * (1.f / 96.f) + EPS) * C2_MLA;
            f32x4 qa[NQ][2];
#pragma unroll
            for (int d0 = 0; d0 < NQ; ++d0) { const u32x4 w = *(const u32x4*)(A.Qraw + row * 768 + h * 96 + d0 * 16 + hi * 8);
                const f32x4 g0 = *(const f32x4*)(A.gmq + d0 * 16 + hi * 8), g1 = *(const f32x4*)(A.gmq + d0 * 16 + hi * 8 + 4);
                qa[d0][0] = (f32x4){bflo(w.x), bfhi(w.x), bflo(w.y), bfhi(w.y)} * sc * g0; qa[d0][1] = (f32x4){bflo(w.z), bfhi(w.z), bflo(w.w), bfhi(w.w)} * sc * g1; }
#pragma unroll
            for (int e = 0; e < 2; ++e) { const f32x4 c = *(const f32x4*)(A.cosT + row * 16 + hi * 8 + e * 4), s = *(const f32x4*)(A.sinT + row * 16 + hi * 8 + e * 4);
                const f32x4 x1 = qa[4][e], x2 = qa[5][e]; qa[4][e] = x1 * c - x2 * s; qa[5][e] = x2 * c + x1 * s; }
#pragma unroll
            for (int d0 = 0; d0 < NQ; ++d0) qr[d0] = __builtin_bit_cast(bf16x8, pack8(qa[d0][0], qa[d0][1]));
        }
    }
    constexpr float THR = 8.f;
    float mhat = 0.f, lrun = 0.f; f32x16 o[2]; o[0] = f32x16{}; o[1] = f32x16{};
    const lds_cptr shm3 = (lds_cptr)shm;
    const lds_cptr kp0 = shm3 + L_K + hi * 1024 + r32 * 16;
    const lds_cptr vp0 = shm3 + L_V + ((lane >> 4) & 1) * 32 + (lane & 3) * 8 + (4 * hi + ((lane & 15) >> 2)) * 64;
    u32x4 pw[4]; f32x16 pp0, pp1, c0, c1; bf16x8 kf[2 * NQ]; s16x4 vlo[8], vhi[8];
    const int nK = k2 ? 2 : 1;
#define WV_(k) case k: asm volatile("s_waitcnt vmcnt(" #k ")" ::: "memory"); break;
#define WAITV(n) do { switch (n) { WV_(0) WV_(1) WV_(2) WV_(3) WV_(4) WV_(5) default: asm volatile("s_waitcnt vmcnt(6)" ::: "memory"); break; } } while (0)
#define LBAR() asm volatile("s_waitcnt lgkmcnt(0)\n\ts_barrier" ::: "memory")
#define SGB(mask, n) __builtin_amdgcn_sched_group_barrier(mask, n, 0)
#define SFENCE() __builtin_amdgcn_sched_barrier(0)
#define KREAD(rel) { const lds_cptr kp = kp0 + ((rel) % NS) * KSLOT; \
        _Pragma("unroll") for (int d0 = 0; d0 < NQ; ++d0) { kf[2 * d0] = *(const LAS bf16x8*)(kp + d0 * 2048); kf[2 * d0 + 1] = *(const LAS bf16x8*)(kp + d0 * 2048 + 512); } }
#define VREAD(rel) { const lds_cptr vp = vp0 + ((rel) % NS) * VSLOT; \
        _Pragma("unroll") for (int i = 0; i < 8; ++i) { vlo[i] = vtr(vp + (i >> 2) * 4096 + (i & 3) * 1024); vhi[i] = vtr(vp + (i >> 2) * 4096 + (i & 3) * 1024 + 512); } }
#define PKV(k) (bf16x8){vlo[k][0], vlo[k][1], vlo[k][2], vlo[k][3], vhi[k][0], vhi[k][1], vhi[k][2], vhi[k][3]}
#define QKMM(rel) do { const float cb = (t0 + (rel) > tw_last) ? -INFINITY : -mhat; \
        _Pragma("unroll") for (int r = 0; r < 16; ++r) { c0[r] = cb; c1[r] = cb; } \
        _Pragma("unroll") for (int d0 = 0; d0 < NQ; ++d0) { c0 = __builtin_amdgcn_mfma_f32_32x32x16_bf16(kf[2 * d0], qr[d0], c0, 0, 0, 0); c1 = __builtin_amdgcn_mfma_f32_32x32x16_bf16(kf[2 * d0 + 1], qr[d0], c1, 0, 0, 0); } } while (0)
#define PVMM() do { \
        o[0] = __builtin_amdgcn_mfma_f32_32x32x16_bf16(__builtin_bit_cast(bf16x8, pw[0]), PKV(0), o[0], 0, 0, 0); o[1] = __builtin_amdgcn_mfma_f32_32x32x16_bf16(__builtin_bit_cast(bf16x8, pw[0]), PKV(4), o[1], 0, 0, 0); \
        o[0] = __builtin_amdgcn_mfma_f32_32x32x16_bf16(__builtin_bit_cast(bf16x8, pw[1]), PKV(1), o[0], 0, 0, 0); o[1] = __builtin_amdgcn_mfma_f32_32x32x16_bf16(__builtin_bit_cast(bf16x8, pw[1]), PKV(5), o[1], 0, 0, 0); \
        o[0] = __builtin_amdgcn_mfma_f32_32x32x16_bf16(__builtin_bit_cast(bf16x8, pw[2]), PKV(2), o[0], 0, 0, 0); o[1] = __builtin_amdgcn_mfma_f32_32x32x16_bf16(__builtin_bit_cast(bf16x8, pw[2]), PKV(6), o[1], 0, 0, 0); \
        o[0] = __builtin_amdgcn_mfma_f32_32x32x16_bf16(__builtin_bit_cast(bf16x8, pw[3]), PKV(3), o[0], 0, 0, 0); o[1] = __builtin_amdgcn_mfma_f32_32x32x16_bf16(__builtin_bit_cast(bf16x8, pw[3]), PKV(7), o[1], 0, 0, 0); } while (0)
#define SUMPACK() do { float sa = pp0[0] + pp0[1], sb = pp1[0] + pp1[1]; \
        _Pragma("unroll") for (int r = 2; r < 16; r += 2) { sa += pp0[r] + pp0[r + 1]; sb += pp1[r] + pp1[r + 1]; } \
        lrun += sa + sb; pw[0] = __builtin_bit_cast(u32x4, pk8(pp0, 0)); pw[1] = __builtin_bit_cast(u32x4, pk8(pp0, 8)); pw[2] = __builtin_bit_cast(u32x4, pk8(pp1, 0)); pw[3] = __builtin_bit_cast(u32x4, pk8(pp1, 8)); } while (0)
#define MX3(a, b, c) __builtin_fmaxf(__builtin_fmaxf((a), (b)), (c))
#define BIASMASK(rel) do { if constexpr (FOX) { const int tt_ = t0 + (rel); const LAS float* Gt = Gl + (rel) * 64 + 4 * hi; \
            _Pragma("unroll") for (int rq = 0; rq < 4; ++rq) { const f32x4 ga = *(const LAS f32x4*)(Gt + 8 * rq), gb = *(const LAS f32x4*)(Gt + 32 + 8 * rq); \
                _Pragma("unroll") for (int i = 0; i < 4; ++i) { c0[4 * rq + i] += ga[i]; c1[4 * rq + i] += gb[i]; } } \
            if (64 * tt_ + 63 > qw) { const int qrel = qw + r32 - 64 * tt_; \
                _Pragma("unroll") for (int r = 0; r < 16; ++r) { const int kv = crow(r, hi); c0[r] = kv > qrel ? -INFINITY : c0[r]; c1[r] = kv + 32 > qrel ? -INFINITY : c1[r]; } } } } while (0)
#define ROWMAX(dst) do { float ma = MX3(c0[0], c0[1], c1[0]), mb = MX3(c0[2], c0[3], c1[1]); ma = MX3(ma, c1[2], c1[3]); \
        _Pragma("unroll") for (int r = 4; r < 16; r += 4) { ma = MX3(ma, c0[r], c0[r + 1]); mb = MX3(mb, c0[r + 2], c0[r + 3]); ma = MX3(ma, c1[r], c1[r + 1]); mb = MX3(mb, c1[r + 2], c1[r + 3]); } \
        dst = swapmax(fmaxf(ma, mb)); } while (0)
#define CIPART(rel, g) do { const float mneg = (t0 + (rel) > tw_last) ? -INFINITY : -mhat; const LAS float* Gt = Gl + (rel) * 64 + 4 * hi + ((g) >> 2) * 32 + 8 * ((g) & 3); const f32x4 gg = *(const LAS f32x4*)Gt; \
        _Pragma("unroll") for (int i = 0; i < 4; ++i) { if ((g) < 4) c0[4 * ((g) & 3) + i] = gg[i] + mneg; else c1[4 * ((g) & 3) + i] = gg[i] + mneg; } } while (0)
#define MASKONLY(rel) do { if constexpr (FOX) { const int tt_ = t0 + (rel); if (64 * tt_ + 63 > qw) { const int qrel = qw + r32 - 64 * tt_; \
            _Pragma("unroll") for (int r = 0; r < 16; ++r) { const int kv = crow(r, hi); c0[r] = kv > qrel ? -INFINITY : c0[r]; c1[r] = kv + 32 > qrel ? -INFINITY : c1[r]; } } } } while (0)
    WAITV(2 * nK + 2);
    LBAR();
    ISSUE_V(t0 + 2, 2);
    KREAD(0); SFENCE();
    QKMM(0);
    BIASMASK(0);
    { float rm; ROWMAX(rm); mhat = rm;
#pragma unroll
        for (int r = 0; r < 16; ++r) { pp0[r] = __builtin_amdgcn_exp2f(c0[r] - rm); pp1[r] = __builtin_amdgcn_exp2f(c1[r] - rm); } }
    KREAD(1);
    if constexpr (FOX) {
#pragma unroll
        for (int g = 0; g < 8; ++g) CIPART(1, g); }
    WAITV(nK + 2);
    LBAR();
#pragma unroll 1
    for (int t = 1; t < nti; ++t) {
        if (t == 1 && 4 < nti) ISSUE_K(t0 + 4, 0);
        if (t + 4 < nti) ISSUE_K(t0 + t + 4, t % NS);
        if (t + 2 < nti) ISSUE_V(t0 + t + 2, (t + 2) % NS);
        SFENCE();
        { if constexpr (!FOX) { const float cb = (t0 + t > tw_last) ? -INFINITY : -mhat;
#pragma unroll
              for (int r = 0; r < 16; ++r) { c0[r] = cb; c1[r] = cb; } }
          const lds_cptr vp = vp0 + ((t - 1) % NS) * VSLOT; float sa = 0.f, sb = 0.f;
#pragma unroll
          for (int g = 0; g < 2 * NQ; ++g) {
              if (g & 1) c1 = __builtin_amdgcn_mfma_f32_32x32x16_bf16(kf[g], qr[g >> 1], c1, 0, 0, 0); else c0 = __builtin_amdgcn_mfma_f32_32x32x16_bf16(kf[g], qr[g >> 1], c0, 0, 0, 0);
              if (g < 8) { const int i = (g >> 1) + 4 * (g & 1); vlo[i] = vtr(vp + (i >> 2) * 4096 + (i & 3) * 1024); vhi[i] = vtr(vp + (i >> 2) * 4096 + (i & 3) * 1024 + 512);
                  if (g < 4) { sa += pp0[4 * g]; sb += pp0[4 * g + 1]; sa += pp0[4 * g + 2]; sb += pp0[4 * g + 3]; } else { sa += pp1[4 * g - 16]; sb += pp1[4 * g - 15]; sa += pp1[4 * g - 14]; sb += pp1[4 * g - 13]; }
                  asm volatile("" : "+v"(sa), "+v"(sb)); }
              { constexpr int G0 = FOX ? 0 : 4; if (g >= G0) { const int q = 2 * (g - G0);
#pragma unroll
                  for (int k = 0; k < 2; ++k) { const int w = q + k; const unsigned pkd = w < 8 ? cvt_pk_bf16(pp0[2 * w], pp0[2 * w + 1]) : cvt_pk_bf16(pp1[2 * w - 16], pp1[2 * w - 15]); pw[w >> 2][w & 3] = pkd; } } }
              SFENCE();
          }
          lrun += sa + sb; }
        MASKONLY(t);
        float rm; ROWMAX(rm);
        bool resc = false;
        if (__any(rm > THR)) { const float dl = fmaxf(rm, 0.f); mhat += dl;
#pragma unroll
            for (int r = 0; r < 16; ++r) { c0[r] -= dl; c1[r] -= dl; }
            const float f = __builtin_amdgcn_exp2f(-dl); lrun *= f; if (hi == 0) wsf[r32] = f; resc = true; }
        SFENCE();
        { const lds_cptr kp = kp0 + ((t + 1) % NS) * KSLOT;
#pragma unroll
          for (int g = 0; g < 8; ++g) { const int i = (g >> 1) + 4 * (g & 1);
              const bf16x8 vf = (bf16x8){vlo[i][0], vlo[i][1], vlo[i][2], vlo[i][3], vhi[i][0], vhi[i][1], vhi[i][2], vhi[i][3]};
              o[g & 1] = __builtin_amdgcn_mfma_f32_32x32x16_bf16(__builtin_bit_cast(bf16x8, pw[g >> 1]), vf, o[g & 1], 0, 0, 0);
              if (g < 4) {
#pragma unroll
                  for (int k = 0; k < 4; ++k) pp0[4 * g + k] = __builtin_amdgcn_exp2f(c0[4 * g + k]);
                  asm volatile("" : "+v"(pp0)); }
              else {
#pragma unroll
                  for (int k = 0; k < 4; ++k) pp1[4 * g - 16 + k] = __builtin_amdgcn_exp2f(c1[4 * g - 16 + k]);
                  asm volatile("" : "+v"(pp1)); }
              { constexpr int G0 = FOX ? 2 : 1; const int j = g - G0; if (j >= 0 && j < NQ) { kf[2 * j] = *(const LAS bf16x8*)(kp + j * 2048); kf[2 * j + 1] = *(const LAS bf16x8*)(kp + j * 2048 + 512); } }
              if constexpr (FOX) { CIPART(t + 1, g); if (g < 4) asm volatile("" : "+v"(c0)); else asm volatile("" : "+v"(c1)); }
              SFENCE();
          } }
        if (resc) { asm volatile("s_waitcnt lgkmcnt(0)" ::: "memory");
#pragma unroll
            for (int rq = 0; rq < 4; ++rq) { const f32x4 af = *(const LAS f32x4*)(wsf + 8 * rq + 4 * hi);
#pragma unroll
                for (int i = 0; i < 4; ++i) { o[0][4 * rq + i] *= af[i]; o[1][4 * rq + i] *= af[i]; } } }
        WAITV(((t + 3 < nti ? nK : 0) + (t + 1 < nti ? 1 : 0)) + ((t + 4 < nti ? nK : 0) + (t + 2 < nti ? 1 : 0)));
        LBAR();
    }
    VREAD(nti - 1); SUMPACK(); SFENCE(); PVMM();
#undef ISSUE_K
#undef ISSUE_V
#undef WAITV
#undef WV_
#undef LBAR
#undef SGB
#undef SFENCE
#undef KREAD
#undef VREAD
#undef PKV
#undef QKMM
#undef PVMM
#undef SUMPACK
#undef MX3
#undef BIASMASK
#undef CIPART
#undef MASKONLY
#undef ROWMAX
    STAMP(2);
    lrun = swapsum(lrun);
    if (hi == 0) wsf[32 + r32] = lrun;
    asm volatile("s_waitcnt lgkmcnt(0)" ::: "memory");
    float rli[16];
#pragma unroll
    for (int rq = 0; rq < 4; ++rq) { const f32x4 lf = *(const LAS f32x4*)(wsf + 32 + 8 * rq + 4 * hi);
#pragma unroll
        for (int i = 0; i < 4; ++i) rli[4 * rq + i] = __builtin_amdgcn_rcpf(lf[i]); }
    const int hh = FOX ? 8 + h : h;
    bf16_t* Ow = A.o + (rowbase + qw) * 1024 + hh * 64;
    LAS bf16_t* stg = (LAS bf16_t*)(shm + L_OST) + wid * 2048;
#pragma unroll
    for (int r = 0; r < 16; ++r) { const int orow = crow(r, hi);
#pragma unroll
        for (int d0 = 0; d0 < 2; ++d0) { const float v = o[d0][r] * rli[r]; stg[orow * 64 + d0 * 32 + r32] = (bf16_t)(cvt_pk_bf16(v, 0.f) & 0xffffu); } }
    asm volatile("s_waitcnt lgkmcnt(0)" ::: "memory");
#pragma unroll
    for (int i = 0; i < 4; ++i) { const int row = i * 8 + (lane >> 3), ch = lane & 7; const u32x4 v = *(const LAS u32x4*)(stg + row * 64 + ch * 8);
        *(u32x4*)(Ow + (long)row * 1024 + ch * 8) = v;
        float s = 0.f; { const float a0 = bflo(v.x), a1 = bfhi(v.x), a2 = bflo(v.y), a3 = bfhi(v.y), a4 = bflo(v.z), a5 = bfhi(v.z), a6 = bflo(v.w), a7 = bfhi(v.w);
            s = ((a0 * a0 + a1 * a1) + (a2 * a2 + a3 * a3)) + ((a4 * a4 + a5 * a5) + (a6 * a6 + a7 * a7)); }
        s += __shfl_xor(s, 1); s += __shfl_xor(s, 2); s += __shfl_xor(s, 4);
        if (ch == 0) A.sso[(rowbase + qw + row) * 16 + hh] = s; }
    asm volatile("s_waitcnt lgkmcnt(0)\n\ts_barrier" ::: "memory");
    STAMP(3);
#ifdef DIAG_SEL
    if (dg) dg[4] += (float)NT - (float)t0;
#endif
}

__device__ __forceinline__ void attn_phase(const Args& A, int vcu, int G, LAS char* shm, int repm, int repf, LAS float* dg, unsigned* qctr, const float* bfox, LAS int* qs  ) {
    const int tid = threadIdx.x;
    for (int v = vcu; v < 256; v += G) {
        const int bh = v >> 3, s = v & 7;
#pragma unroll 1
        for (int i = 0; i < 4 * repm; ++i) { const int ii = i & 3; const int qb = (ii == 0) ? s : (ii == 1) ? 15 - s : (ii == 2) ? 16 + s : 31 - s; attn_unit<false>(A, bh >> 3, bh & 7, qb, shm, dg); }
    }
    if (tid < 8) { const float mine = bfox[tid]; int rank = 0;
#pragma unroll
        for (int k = 0; k < 8; ++k) { const float o = bfox[k]; rank += (o > mine || (o == mine && k < tid)) ? 1 : 0; }
        qs[rank] = tid; }
    if (tid == 0) qs[8] = (int)__hip_atomic_fetch_add(qctr, 1u, __ATOMIC_RELAXED, __HIP_MEMORY_SCOPE_AGENT);
    asm volatile("s_waitcnt vmcnt(0) lgkmcnt(0)" ::: "memory"); __syncthreads();
#pragma unroll 1
    for (;;) {
        const int idx = qs[8];
        if (idx >= 1024 * repf) break;
        const int id = idx & 1023, h = qs[id >> 7], rem = id & 127, qb = 31 - (rem >> 2), b = rem & 3;
        unsigned nxt = 0u;
        __syncthreads();
        if (tid == 0) nxt = __hip_atomic_fetch_add(qctr, 1u, __ATOMIC_RELAXED, __HIP_MEMORY_SCOPE_AGENT);
        attn_unit<true>(A, b, h, qb, shm, dg ? dg + 8 : dg);
        if (tid == 0) qs[8] = (int)nxt;
        asm volatile("s_waitcnt vmcnt(0) lgkmcnt(0)" ::: "memory"); __syncthreads();
    }
}
}

constexpr int CW_TMO = 0, CW_BAR = 4096, CW_CNT = 200000;
constexpr int RING_BYTES = 131072, LDSCTL_OFF = RING_BYTES, LDS_BYTES = 147456;
constexpr int CW_FQ = 210000;
constexpr int LC_QS = 7424;
constexpr int LC_SUBO = 5120;
constexpr int LC_MISC = 0, LC_PRE = 256, LC_CNT = 512;

typedef GAS unsigned gu32;
#define RLX_AGENT __ATOMIC_RELAXED, __HIP_MEMORY_SCOPE_AGENT

#define XB_TMO      128
#define XB_XCNT(j)  (256  + 64 * (j))
#define XB_XSUB(j)  (1280 + 64 * (j))
#define XB_XGEN(j)  (2304 + 64 * (j))
#define XB_TOP      3328
#define XB_TOPGEN   3392
#define XCD_BAR_WORDS 3456
#define XB_SPIN_CAP (1u << 18)
__device__ __forceinline__ unsigned xb_ld(unsigned* p)              { return __hip_atomic_load(p, __ATOMIC_RELAXED, __HIP_MEMORY_SCOPE_AGENT); }
__device__ __forceinline__ unsigned xb_add(unsigned* p, unsigned v) { return __hip_atomic_fetch_add(p, v, __ATOMIC_RELAXED, __HIP_MEMORY_SCOPE_AGENT); }
__device__ __forceinline__ unsigned xb_xcc_id() { return (unsigned)__builtin_amdgcn_s_getreg((3 << 11) | 20) & 0xFu; }
#define XB_SPIN(cond, bar) do { unsigned _sp = 0; while (cond) { __builtin_amdgcn_s_sleep(1); \
    if ((++_sp & 255u) == 0u) { if (xb_ld(&(bar)[XB_TMO])) break; if (_sp > XB_SPIN_CAP) { atomicAdd(&(bar)[XB_TMO], 1u); break; } } } } while (0)
struct XcdBarrier { unsigned* bar; unsigned x; volatile LAS unsigned* st; };
__device__ __forceinline__ XcdBarrier xcd_barrier_post(unsigned* bar, volatile LAS unsigned* st) {
    XcdBarrier b; b.bar = bar; b.x = xb_xcc_id(); b.st = st;
    if (threadIdx.x == 0) (void)xb_add(&bar[XB_XCNT(b.x)], 1u);
    return b;
}
__device__ __forceinline__ void xcd_barrier_complete(unsigned* bar, unsigned x, unsigned& nloc, unsigned& nx) {
    const unsigned G = gridDim.x * gridDim.y * gridDim.z;
    unsigned sum, cnt, mine, sp = 0u;
    for (;;) {
        sum = 0u; cnt = 0u; mine = 0u;
#pragma unroll
        for (unsigned j = 0; j < 16; ++j) { const unsigned c = xb_ld(&bar[XB_XCNT(j)]); sum += c; cnt += (c > 0u) ? 1u : 0u; mine = (j == x) ? c : mine; }
        if (sum == G) break;
        __builtin_amdgcn_s_sleep(1);
        if ((++sp & 255u) == 0u) { if (xb_ld(&bar[XB_TMO])) break; if (sp > XB_SPIN_CAP) { atomicAdd(&bar[XB_TMO], 1u); break; } }
    }
    nloc = mine > 0u ? mine : 1u; nx = cnt > 0u ? cnt : 1u;
}
__device__ __forceinline__ void xcd_barrier(const XcdBarrier& b) {
    asm volatile("s_waitcnt vmcnt(0)" ::: "memory");
    __syncthreads();
    if (threadIdx.x == 0) {
        unsigned* bar = b.bar;
        __builtin_amdgcn_s_waitcnt(0);
        unsigned nloc = b.st[0], nx = b.st[1];
        if (nloc == 0u) { xcd_barrier_complete(bar, b.x, nloc, nx); b.st[0] = nloc; b.st[1] = nx; }
        const unsigned old = xb_add(&bar[XB_XSUB(b.x)], 1u);
        const unsigned gen = old / nloc;
        if (old + 1u == (gen + 1u) * nloc) {
            __builtin_amdgcn_fence(__ATOMIC_RELEASE, "agent");
            asm volatile("s_waitcnt vmcnt(0)" ::: "memory");
            const unsigned og = xb_add(&bar[XB_TOP], 1u);
            const unsigned tg = og / nx;
            if (og + 1u == (tg + 1u) * nx) xb_add(&bar[XB_TOPGEN], 1u);
            else XB_SPIN(xb_ld(&bar[XB_TOPGEN]) == tg, bar);
            __builtin_amdgcn_fence(__ATOMIC_ACQUIRE, "agent");
            xb_add(&bar[XB_XGEN(b.x)], 1u);
            asm volatile("s_waitcnt vmcnt(0)" ::: "memory");
        } else {
            XB_SPIN(xb_ld(&bar[XB_XGEN(b.x)]) == gen, bar);
            __builtin_amdgcn_fence(__ATOMIC_ACQUIRE, "agent");
            asm volatile("s_waitcnt vmcnt(0)" ::: "memory");
        }
    }
    __syncthreads();
}

__device__ __forceinline__ float wave_sum(float v) {
#pragma unroll
    for (int o = 1; o < 64; o <<= 1) v += __shfl_xor(v, o);
    return v;
}
#define LDS_WAIT() asm volatile("s_waitcnt lgkmcnt(0)" ::: "memory")

__device__ __forceinline__ int maprow(int kind, int n) {
    switch (kind) {
    default: return n;
    case 1: {
        if (n < 256) return n;
        if (n < 384) { const int j = n - 256, q = j >> 5, c = j & 31; return 256 + (q & 1) * 128 + (q >> 1) * 32 + c; }
        if (n < 416) return 256 + 64 + (n - 384);
        if (n < 1952) { const int f = n - 416, k3 = f >> 9, r = f & 511, hd = r >> 6, d = r & 63; return (2 + 2 * k3 + (hd >> 2)) * 256 + (d >> 5) * 128 + (hd & 3) * 32 + (d & 31); }
        return 256 + 96 + (n - 1952); }
    case 2: { const int hd = n / 96, dd = n - hd * 96; if (dd < 64) return (hd >> 2) * 256 + (dd >> 5) * 128 + (hd & 3) * 32 + (dd & 31); return 512 + (hd >> 2) * 128 + (hd & 3) * 32 + (dd - 64); }
    case 3: { const int hd = n >> 7, dd = n & 127; if (dd < 64) return (hd >> 2) * 256 + (dd >> 5) * 128 + (hd & 3) * 32 + (dd & 31); const int d = dd - 64; return 512 + (hd >> 2) * 256 + (d >> 5) * 128 + (hd & 3) * 32 + (d & 31); }
    case 4: return (n >> 7) * 256 + (n & 127);
    case 5: return (n >> 7) * 256 + 128 + (n & 127);
    case 6: return 128 + n;
    }
}
__device__ __forceinline__ void conv_item(const float* W, int K, int Nsrc, bf16_t* WT, int kind, const float* s1, const float* s2, int split, LAS float* scr, int item, int lane) {
    const int nblk = (Nsrc + 31) / 32, kb = item / nblk, nb = item - kb * nblk, k0 = 64 * kb, n0 = 32 * nb;
    const bool nv = n0 + (lane & 31) < Nsrc;
#pragma unroll 8
    for (int i = 0; i < 32; ++i) { const int kk = 2 * i + (lane >> 5); scr[kk * 33 + (lane & 31)] = nv ? W[(size_t)(k0 + kk) * Nsrc + n0 + (lane & 31)] : 0.f; }
    LDS_WAIT(); asm volatile("" ::: "memory");
    const int c = lane & 7;
    float sc[8];
#pragma unroll
    for (int e = 0; e < 8; ++e) { const int k = k0 + 8 * c + e; sc[e] = s1 ? (k < split ? s1[k] : s2[k - split]) : 1.f; }
#pragma unroll
    for (int j = 0; j < 4; ++j) { const int n = (lane >> 3) + 8 * j; const LAS float* s = scr + (8 * c) * 33 + n;
        if (n0 + n < Nsrc) { u32x4 o; o.x = cvt_pk_bf16(s[0 * 33] * sc[0], s[1 * 33] * sc[1]); o.y = cvt_pk_bf16(s[2 * 33] * sc[2], s[3 * 33] * sc[3]); o.z = cvt_pk_bf16(s[4 * 33] * sc[4], s[5 * 33] * sc[5]); o.w = cvt_pk_bf16(s[6 * 33] * sc[6], s[7 * 33] * sc[7]);
            *(u32x4*)(WT + (size_t)maprow(kind, n0 + n) * K + k0 + 8 * c) = o; } }
    LDS_WAIT(); asm volatile("" ::: "memory");
}

struct KArgs { const void* in[27]; float* out; unsigned char* ws; int ph_lo, ph_hi, li, pad; };

constexpr int I_IN = 16 * 62, I_UQ = 4 * 24, I_UKV = 2 * 32, I_OUT = 16 * 32, I_RE = 16, I_RG = 16, I_GU = NEXP * 2 * 16 * 8, I_DN = NEXP * 4 * 32, I_PG = 16 * 32, I_PP = 4 * 32;
constexpr int I_LAYER = I_IN + I_UQ + I_UKV + I_OUT + I_RE + I_RG + I_GU + I_DN + I_PG + I_PP;

struct PPOrder {
    int c, G;
    __device__ __forceinline__ bool next(int i, Unit& u) const {
        int L;
        if (G == 256) { if (c < 128) { if (i > 0) return false; L = c; } else { if (i > 2) return false; L = 128 + (c - 128) * 3 + i; } }
        else { L = i * G + c; if (L >= 512) return false; }
        u.pm = L >> 2; u.pn = L & 3; u.e = 0; u.blk = 0; return true;
    }
    __device__ __forceinline__ int arow(const Unit& u, int r) const { return u.pm * 256 + r; }
};

struct MoeOrder {
    const LAS int* pre; const LAS unsigned* cntl; const LAS int* subo; const int* list; int npn, G, c; bool gather;
    __device__ __forceinline__ bool next(int i, Unit& u) const {
        const int L = i * G + c; const int TB = pre[32]; if (L >= TB * npn) return false;
        const int bg = L / npn, pl = L - bg * npn; int e = 0;
        for (int j = 1; j < 32; ++j) e += (pre[j] <= bg) ? 1 : 0;
        u.pm = bg; u.e = e; u.blk = bg - pre[e]; u.pn = e * npn + pl; return true;
    }
    __device__ __forceinline__ int arow(const Unit& u, int r) const {
        if (!gather) return u.pm * 256 + r;
        int li = u.blk * 256 + r; const int cn = (int)cntl[u.e]; li = li < cn ? li : cn - 1;
        return list_at(list, subo, u.e, li) >> 1;
    }
};

#ifndef WGM_P1
#define WGM_P1 16
#endif
#ifndef WGM_P2
#define WGM_P2 16
#endif
#ifndef WGM_P4
#define WGM_P4 16
#endif
#ifndef MK_CUTS
#define MK_CUTS {0, 19}
#endif
constexpr int NPHASE = 19;

__global__ void __launch_bounds__(NWAVES * 64, 2) mega_fwd(KArgs args) {
    extern __shared__ __attribute__((aligned(16))) unsigned char lds_raw[];
    LAS unsigned char* lds0 = (LAS unsigned char*)lds_raw;
    volatile LAS unsigned* MISC = (volatile LAS unsigned*)(lds0 + LDSCTL_OFF + LC_MISC);
    const int G = gridDim.x; const int bx = blockIdx.x; const int vcu = (G % 8 == 0) ? (bx % 8) * (G / 8) + bx / 8 : bx;
    for (int u = threadIdx.x; u < (LDS_BYTES - LDSCTL_OFF) / 4; u += NWAVES * 64) ((LAS unsigned*)(lds0 + LDSCTL_OFF))[u] = 0u;
    __syncthreads();
    (void)xcd_barrier_post((unsigned*)(args.ws + WS_CTL) + CW_BAR + args.li * XCD_BAR_WORDS, MISC + 8);
    const int lo = args.ph_lo, hi = args.ph_hi;
#ifndef PH_MASK
#define PH_MASK 0x3ff
#endif
#define PHM(k) ((PH_MASK >> (k)) & 1)
#ifndef DUP_MASK
#define DUP_MASK 0
#endif
#define NREP(k) (((DUP_MASK >> (k)) & 1) ? 2 : 1)
#ifndef NULL_MASK
#define NULL_MASK 0
#endif
#define NULLP(k) ((NULL_MASK >> (k)) & 1)
#define IN(k) (lo <= (k) && (k) < hi)
#ifdef DIAG_SEL
#define PSTAMP(k) do { int ti_ = threadIdx.x; asm volatile("" : "+v"(ti_)); if (ti_ == 0) *(volatile LAS unsigned long long*)(lds0 + LDSCTL_OFF + 8336) = __builtin_amdgcn_s_memrealtime(); if (blockIdx.x == DIAG_BLOCK && ti_ == 0 && (k) < 19) { volatile LAS unsigned long long* tp_ = (volatile LAS unsigned long long*)(lds0 + LDSCTL_OFF + 8320); const unsigned long long t_ = __builtin_amdgcn_s_memrealtime(); ((float*)(args.ws + WS_CTL))[250128 + (k)] = (float)(t_ - *tp_) * 0.01f; *tp_ = t_; } } while (0)
#else
#define PSTAMP(k) do {} while (0)
#endif
#ifdef DIAG_SEL
#define ASTAMP(k) do { int ti_ = threadIdx.x; asm volatile("" : "+v"(ti_)); if (blockIdx.x == DIAG_BLOCK && ti_ == 0 && (k) < 10) { volatile LAS unsigned long long* tp_ = (volatile LAS unsigned long long*)(lds0 + LDSCTL_OFF + 8320); ((float*)(args.ws + WS_CTL))[250048 + (k)] = (float)(__builtin_amdgcn_s_memrealtime() - *tp_) * 0.01f; } \
    if (ti_ == 0 && (k) < 10) { volatile LAS unsigned long long* tq_ = (volatile LAS unsigned long long*)(lds0 + LDSCTL_OFF + 8336); const float av_ = (float)(__builtin_amdgcn_s_memrealtime() - *tq_) * 0.01f; atomicMax((int*)(args.ws + WS_CTL) + 250064 + (k), __float_as_int(av_)); atomicMin((int*)(args.ws + WS_CTL) + 250112 + (k), __float_as_int(av_) - 0x7f000000); if ((k) == 1 && av_ > 135.f) atomicAdd((float*)(args.ws + WS_CTL) + 250096, 1.f); if ((k) == 1 && av_ > 125.f) atomicAdd((float*)(args.ws + WS_CTL) + 250097, 1.f); if ((k) == 1 && av_ > 145.f) atomicAdd((float*)(args.ws + WS_CTL) + 250098, 1.f); } } while (0)
#else
#define ASTAMP(k) do {} while (0)
#endif
#define SEAM(k) do { ASTAMP(k); if (IN(k) && IN((k) + 1)) { XcdBarrier bar_; bar_.bar = (unsigned*)(args.ws + WS_CTL) + CW_BAR + args.li * XCD_BAR_WORDS; bar_.x = xb_xcc_id(); bar_.st = (volatile LAS unsigned*)(lds0 + LDSCTL_OFF + LC_MISC) + 8; xcd_barrier(bar_); } PSTAMP(k); } while (0)
    const int NGW = G * NWAVES, NGT = G * 512;
#ifdef DIAG_SEL
    if (threadIdx.x == 0) *(volatile LAS unsigned long long*)(lds0 + LDSCTL_OFF + 8320) = __builtin_amdgcn_s_memrealtime();
#endif
#define ssx0 ((float*)(wsp + WS_SSX0))
#define ssx1 ((float*)(wsp + WS_SSX1))
#define sspp ((float*)(wsp + WS_SSPP))
#define sso ((float*)(wsp + WS_SSO))
#define ssx2 ((float*)(wsp + WS_SSX2))
#define sskpe ((float*)(wsp + WS_SSKPE))
#define ssqq ((float*)(wsp + WS_SSQQ))
#define ssqkv ((float*)(wsp + WS_SSQKV))
#define gate ((float*)(wsp + WS_GATE))
#define logf ((float*)(wsp + WS_LOGF))
#define Fc ((float*)(wsp + WS_F))
#define ssqn ((float*)(wsp + WS_SSQN))
#define ssqr ((float*)(wsp + WS_SSQR))
#define cosT ((float*)(wsp + WS_COS))
#define sinT ((float*)(wsp + WS_SIN))
#define list ((int*)(wsp + WS_LIST))
#define xbA ((bf16_t*)(wsp + WS_XBA))
#define xbB ((bf16_t*)(wsp + WS_XBB))
#define pbf ((bf16_t*)(wsp + WS_PBF))
#define Qc ((bf16_t*)(wsp + WS_QC))
#define Kvc ((bf16_t*)(wsp + WS_KVC))
#define Kpe ((bf16_t*)(wsp + WS_KPE))
#define Fq ((bf16_t*)(wsp + WS_FQ))
#define Fk ((bf16_t*)(wsp + WS_FK))
#define Fv ((bf16_t*)(wsp + WS_FV))
#define Kmla ((bf16_t*)(wsp + WS_KMLA))
#define Vmla ((bf16_t*)(wsp + WS_VMLA))
#define Qraw ((bf16_t*)(wsp + WS_QRAW))
#define ob ((bf16_t*)xo)
#define ppb ((bf16_t*)(wsp + WS_PP))
#define hid ((bf16_t*)(wsp + WS_HID))
#define c1 ((bf16_t*)(wsp + WS_C1))
#define ctl ((unsigned*)(wsp + WS_CTL))
#define Wl (wsp + WS_W + (size_t)L * W_LAYER)
#define PHASE_PTRS unsigned char* wsp = args.ws; asm volatile("" : "+s"(wsp)); const float* x_in = (const float*)args.in[0]; float* xo = args.out; (void)x_in; (void)xo; \
    int tid = threadIdx.x; asm volatile("" : "+v"(tid)); const int lane = tid & 63, wave = __builtin_amdgcn_readfirstlane(tid >> 6); (void)lane; (void)wave; \
    unsigned ldo_ = 0u; asm volatile("" : "+s"(ldo_)); LAS unsigned char* lds = lds0 + ldo_; LAS int* preL = (LAS int*)(lds + LDSCTL_OFF + LC_PRE); LAS unsigned* cntL = (LAS unsigned*)(lds + LDSCTL_OFF + LC_CNT); LAS int* suboL = (LAS int*)(lds + LDSCTL_OFF + LC_SUBO); (void)preL; (void)cntL; (void)suboL; \
    const int gw = vcu * NWAVES + wave, gt = vcu * 512 + tid; (void)gw; (void)gt
#define INF(i) ((const float*)args.in[i])

    if (PHM(0) && IN(0)) {
        PHASE_PTRS; unsigned char* ws = wsp;
        LAS float* scr = (LAS float*)(lds + wave * 16384);
        for (int rep_ = 0; rep_ < NREP(0); ++rep_) {
        for (int it = gw; it < 2 * I_LAYER; it += NGW) {
            const int L = it >= I_LAYER ? 1 : 0; int r = it - L * I_LAYER;
            if (r < I_IN) { conv_item(INF(4) + (size_t)L * DM * INC, DM, INC, (bf16_t*)(Wl + WO_IN), 1, INF(3) + L * DM, nullptr, DM, scr, r, lane); continue; } r -= I_IN;
            if (r < I_UQ) { conv_item(INF(6) + (size_t)L * 256 * 768, 256, 768, (bf16_t*)(Wl + WO_UQ), 2, INF(5) + L * 256, nullptr, 256, scr, r, lane); continue; } r -= I_UQ;
            if (r < I_UKV) { conv_item(INF(8) + (size_t)L * 128 * 1024, 128, 1024, (bf16_t*)(Wl + WO_UKV), 3, INF(7) + L * 128, nullptr, 128, scr, r, lane); continue; } r -= I_UKV;
            if (r < I_OUT) { conv_item(INF(16) + (size_t)L * DM * DM, DM, DM, (bf16_t*)(Wl + WO_OUT), 0, INF(14) + L * 512, INF(15) + L * 512, 512, scr, r, lane); continue; } r -= I_OUT;
            if (r < I_RE) { conv_item(INF(19) + (size_t)L * DM * 32, DM, 32, (bf16_t*)(Wl + WO_RT), 0, INF(17) + L * DM, nullptr, DM, scr, r, lane); continue; } r -= I_RE;
            if (r < I_RG) { conv_item(INF(18) + (size_t)L * DM * 4, DM, 4, (bf16_t*)(Wl + WO_RT), 6, INF(17) + L * DM, nullptr, DM, scr, r, lane); continue; } r -= I_RG;
            if (r < I_GU) { const int e = r >> 8, mt = (r >> 7) & 1, ii = r & 127;
                conv_item(INF(mt ? 21 : 20) + ((size_t)L * NEXP + e) * DM * 256, DM, 256, (bf16_t*)(Wl + WO_GU) + (size_t)e * 512 * DM, mt ? 5 : 4, INF(17) + L * DM, nullptr, DM, scr, ii, lane); continue; } r -= I_GU;
            if (r < I_DN) { const int e = r >> 7, ii = r & 127;
                conv_item(INF(22) + ((size_t)L * NEXP + e) * 256 * DM, 256, DM, (bf16_t*)(Wl + WO_DN) + (size_t)e * DM * 256, 0, nullptr, nullptr, 0, scr, ii, lane); continue; } r -= I_DN;
            if (r < I_PG) { conv_item(INF(24) + (size_t)L * DM * DM, DM, DM, (bf16_t*)(Wl + WO_PG), 0, INF(23) + L * DM, nullptr, DM, scr, r, lane); continue; } r -= I_PG;
            conv_item(INF(25) + (size_t)L * 256 * DM, 256, DM, (bf16_t*)(Wl + WO_PP), 0, nullptr, nullptr, 0, scr, r, lane);
        }
        for (int it = gw; it < 2 * (88 + 220); it += NGW) {
            const int L = it >= 308 ? 1 : 0; int r = it - L * 308; bf16_t* dst;
            if (r < 88) { const int lr = r < 24 ? 104 + r : 192 + (r - 24); dst = (bf16_t*)(Wl + WO_IN) + (size_t)(256 + lr) * DM; }
            else { r -= 88; const int lr = r < 96 ? 32 + r : 132 + (r - 96); dst = (bf16_t*)(Wl + WO_RT) + (size_t)lr * DM; }
            *(u32x4*)(dst + lane * 8) = (u32x4){0u, 0u, 0u, 0u}; *(u32x4*)(dst + 512 + lane * 8) = (u32x4){0u, 0u, 0u, 0u};
        }
        for (int m = gw; m < NTOK; m += NGW) { const f32x4* xr = (const f32x4*)(x_in + (size_t)m * DM) + lane; float s = 0.f; u32x2* o8 = (u32x2*)(xbA + (size_t)m * DM) + lane;
#pragma unroll
            for (int j = 0; j < 4; ++j) { const f32x4 v = xr[64 * j]; s += sum4sq(v); u32x2 w; w.x = cvt_pk_bf16(v[0], v[1]); w.y = cvt_pk_bf16(v[2], v[3]); o8[64 * j] = w; }
            s = wave_sum(s); if (lane < 16) ssx0[(size_t)m * 16 + lane] = lane == 0 ? s : 0.f; }
        for (size_t i = gt; i < (size_t)DEPTH * NTOK * 256 / 8; i += NGT) { const f32x4 a = ((const f32x4*)INF(1))[2 * i], b = ((const f32x4*)INF(1))[2 * i + 1]; ((u32x4*)pbf)[i] = pack8(a, b); }
        for (int i = gt; i < NTOK * 16; i += NGT) { const int t = i >> 4, j = i & 15; const double inv = exp2(-(double)j * (13.287712379549449 / 16.0)); const double ang = (double)((const int*)args.in[2])[t] * inv;
            cosT[i] = (float)cos(ang); sinT[i] = (float)sin(ang); }
        }
    }
    SEAM(0);

#pragma unroll 1
    for (int L = 0; L < DEPTH; ++L) {
        const int pb = 1 + 9 * L;
        if (PHM(1) && IN(pb + 0)) {
            PHASE_PTRS;
            pg8::Gemm g{xbA, (const bf16_t*)(Wl + WO_IN), DM}; pg8::StaticOrder S; S.init(NTOK, 2048, G, bx, WGM_P1);
            EpiInProj E{wsp, INF(13) + L * 8, INF(11) + L * 64, INF(12) + L * 64};
            for (int rep_ = 0; rep_ < NREP(1); ++rep_) pg8::gemm_phase<DM, EpiInProj, pg8::StaticOrder, true>(lds, g, S, E);
            if (NULLP(1)) { EpiNull EN{(float*)(wsp + WS_SSX2)}; pg8::gemm_phase<DM, EpiNull, pg8::StaticOrder, true>(lds, g, S, EN); }
        }
        SEAM(pb + 0);
        if (PHM(2) && IN(pb + 1)) {
            PHASE_PTRS;
            { pg8::Gemm g{Qc, (const bf16_t*)(Wl + WO_UQ), 256}; pg8::StaticOrder S; S.init(NTOK, 768, G, bx, WGM_P2);
              EpiQUp E{wsp};
              for (int rep_ = 0; rep_ < NREP(2); ++rep_) pg8::gemm_phase<256, EpiQUp, pg8::StaticOrder, true>(lds, g, S, E); }
            { pg8::Gemm g{Kvc, (const bf16_t*)(Wl + WO_UKV), 128}; pg8::StaticOrder S; S.init(NTOK, 1024, G, bx, WGM_P2);
              EpiKvUp E{wsp, INF(10) + L * 96};
              for (int rep_ = 0; rep_ < NREP(2); ++rep_) pg8::gemm_phase<128, EpiKvUp, pg8::StaticOrder, true>(lds, g, S, E); }
            for (int v = vcu; v < 32; v += G) {
                const int b = v >> 3, h = v & 7; LAS double* wt = (LAS double*)lds;
                const size_t base = ((size_t)b * SEQ + wave * 1024 + lane * 16) * 8 + h; float lv[16]; double loc = 0.0;
#pragma unroll
                for (int i = 0; i < 16; ++i) { lv[i] = logf[base + (size_t)i * 8]; loc += (double)lv[i]; }
                double pre = loc;
#pragma unroll
                for (int o = 1; o < 64; o <<= 1) { const double n = __shfl_up(pre, o); if (lane >= o) pre += n; }
                if (lane == 63) wt[wave] = pre;
                LDS_WAIT(); __syncthreads();
                double run = pre - loc;
                for (int w = 0; w < wave; ++w) run += wt[w];
#pragma unroll
                for (int i = 0; i < 16; ++i) { run += (double)lv[i]; Fc[base + (size_t)i * 8] = (float)run; }
                __syncthreads();
            }
        }
        SEAM(pb + 1);
        if (PHM(3) && IN(pb + 2)) {
            PHASE_PTRS;
            att::Args A{Qraw, Kmla, Vmla, Fq, Fk, Fv, ssqn, ssqr, INF(9) + L * 96, cosT, sinT, Fc, INF(11) + L * 64, INF(12) + L * 64, ob, sso};
#ifdef DIAG_SEL
            LAS float* dg = (L == 0 && blockIdx.x == DIAG_BLOCK && tid == 0) ? (LAS float*)(lds0 + LDSCTL_OFF + 8192) : (LAS float*)nullptr;
            if (dg) for (int k = 0; k < 16; ++k) dg[k] = 0.f;
            att::attn_phase(A, vcu, G, (LAS char*)lds, NREP(10), NREP(11), dg, ctl + CW_FQ + 64 * L, INF(13) + L * 8, (LAS int*)(lds + LDSCTL_OFF + LC_QS));
            if (dg) { float* dw = (float*)(wsp + WS_CTL) + 250000; for (int k = 0; k < 16; ++k) dw[k] = dg[k]; }
#else
            att::attn_phase(A, vcu, G, (LAS char*)lds, NREP(10), NREP(11), (LAS float*)nullptr, ctl + CW_FQ + 64 * L, INF(13) + L * 8, (LAS int*)(lds + LDSCTL_OFF + LC_QS));
#endif
        }
        SEAM(pb + 2);
        if (PHM(4) && IN(pb + 3)) {
            PHASE_PTRS;
            pg8::Gemm g{ob, (const bf16_t*)(Wl + WO_OUT), DM}; pg8::StaticOrder S; S.init(NTOK, DM, G, bx, WGM_P4);
            EpiOut E{wsp, (const float*)nullptr};
            for (int rep_ = 0; rep_ < (L == 0 ? NREP(4) : 1); ++rep_) pg8::gemm_phase<DM, EpiOut, pg8::StaticOrder, true>(lds, g, S, E);
            if (NULLP(4)) { EpiNull EN{(float*)(wsp + WS_SSX2)}; pg8::gemm_phase<DM, EpiNull, pg8::StaticOrder, true>(lds, g, S, EN); }
        }
        SEAM(pb + 3);
        if (PHM(5) && IN(pb + 4)) {
            PHASE_PTRS;
            { pg8::Gemm g{xbB, (const bf16_t*)(Wl + WO_RT), DM}; pg8::StaticOrder S; S.init(NTOK, 256, G, bx);
              EpiRouter E{wsp, ctl + CW_CNT + 1024 * L};
              pg8::gemm_phase<DM, EpiRouter, pg8::StaticOrder, true>(lds, g, S, E); }
            { pg8::Gemm g{pbf + (size_t)L * NTOK * 256, (const bf16_t*)(Wl + WO_PP), 256}; PPOrder S{bx, G};
              EpiPP E{wsp};
              for (int rep_ = 0; rep_ < NREP(5); ++rep_) pg8::gemm_phase<256, EpiPP, PPOrder, true>(lds, g, S, E); }
        }
        SEAM(pb + 4);
        if ((PHM(6) && IN(pb + 5)) || (PHM(7) && IN(pb + 6))) {
            PHASE_PTRS;
            { const int e = tid >> 4, sb = tid & 15; const unsigned c = __hip_atomic_load(ctl + CW_CNT + 1024 * L + tid, RLX_AGENT); suboL[e * (NSUB + 1) + sb + 1] = (int)c; }
            LDS_WAIT(); __syncthreads();
            if (tid < 32) { int run = 0; suboL[tid * (NSUB + 1)] = 0; for (int k = 1; k <= NSUB; ++k) { run += suboL[tid * (NSUB + 1) + k]; suboL[tid * (NSUB + 1) + k] = run; } cntL[tid] = (unsigned)run; }
            LDS_WAIT(); __syncthreads();
            if (tid == 0) { int run = 0; for (int e = 0; e < 32; ++e) { preL[e] = run; run += ((int)cntL[e] + 255) >> 8; } preL[32] = run; }
            LDS_WAIT(); __syncthreads();
        }
        if (PHM(6) && IN(pb + 5)) {
            PHASE_PTRS;
            pg8::Gemm g{xbB, (const bf16_t*)(Wl + WO_GU), DM}; MoeOrder S{preL, cntL, suboL, list, 2, G, bx, true};
            EpiMoeUp E{wsp, cntL, suboL, 2};
            for (int rep_ = 0; rep_ < NREP(6); ++rep_) pg8::gemm_phase<DM, EpiMoeUp, MoeOrder, true>(lds, g, S, E);
        }
        SEAM(pb + 5);
        if (PHM(7) && IN(pb + 6)) {
            PHASE_PTRS;
            pg8::Gemm g{hid, (const bf16_t*)(Wl + WO_DN), 256}; MoeOrder S{preL, cntL, suboL, list, 4, G, bx, false};
            EpiMoeDown E{wsp, cntL, suboL, 4};
            pg8::gemm_phase<256, EpiMoeDown, MoeOrder, true>(lds, g, S, E);
        }
        SEAM(pb + 6);
        if (PHM(8) && IN(pb + 7)) {
            PHASE_PTRS;
            for (int m = gw; m < NTOK; m += NGW) { const u32x4* cr = (const u32x4*)(c1 + (size_t)m * DM) + lane; u32x4* xr = (u32x4*)(xbB + (size_t)m * DM) + lane; float s = 0.f;
#pragma unroll
                for (int j = 0; j < 2; ++j) { const u32x4 cw = cr[64 * j], xw = xr[64 * j];
                    const f32x4 v0 = (f32x4){bflo(xw.x), bfhi(xw.x), bflo(xw.y), bfhi(xw.y)} + (f32x4){bflo(cw.x), bfhi(cw.x), bflo(cw.y), bfhi(cw.y)}, v1 = (f32x4){bflo(xw.z), bfhi(xw.z), bflo(xw.w), bfhi(xw.w)} + (f32x4){bflo(cw.z), bfhi(cw.z), bflo(cw.w), bfhi(cw.w)};
                    s += sum4sq(v0) + sum4sq(v1); xr[64 * j] = pack8(v0, v1); }
                s = wave_sum(s); if (lane == 0) ssx2[m] = s; }
        }
        SEAM(pb + 7);
        if (PHM(9) && IN(pb + 8)) {
            PHASE_PTRS;
            pg8::Gemm g{xbB, (const bf16_t*)(Wl + WO_PG), DM}; pg8::StaticOrder S; S.init(NTOK, DM, G, bx, WGM_P4);
            EpiPle E{wsp, INF(26) + L * DM, L + 1 == DEPTH ? xo : (float*)nullptr};
            pg8::gemm_phase<DM, EpiPle, pg8::StaticOrder, true>(lds, g, S, E);
        }
        if (L + 1 < DEPTH) SEAM(pb + 8);
    }
#undef IN
#undef SEAM
#undef INF
}

extern "C" void kernel_launch(void* const* d_in, const int* in_sizes, int n_in, void* d_out, int out_size, void* d_ws, size_t ws_size, hipStream_t stream) {
    static int grid = 0;
    if (grid == 0) {
        if (n_in != 27 || ws_size < WS_END) { fprintf(stderr, "kernel_launch: unexpected inputs (n_in %d, ws %zu)\n", n_in, ws_size); grid = -1; return; }
        int dev = 0, cus = 0, per_cu = 0;
        if (hipGetDevice(&dev) != hipSuccess || hipDeviceGetAttribute(&cus, hipDeviceAttributeMultiprocessorCount, dev) != hipSuccess) { grid = -1; return; }
        if (hipFuncSetAttribute((const void*)mega_fwd, hipFuncAttributeMaxDynamicSharedMemorySize, LDS_BYTES) != hipSuccess) { fprintf(stderr, "kernel_launch: hipFuncSetAttribute failed\n"); grid = -1; return; }
        if (hipOccupancyMaxActiveBlocksPerMultiprocessor(&per_cu, (const void*)mega_fwd, NWAVES * 64, LDS_BYTES) != hipSuccess || per_cu < 1) { fprintf(stderr, "kernel_launch: occupancy query says %d\n", per_cu); }
        (void)hipGetLastError();
        grid = cus;
    }
    if (grid < 0) return;
    if (hipMemsetAsync((char*)d_ws + WS_CTL, 0, CTL_ZERO_BYTES, stream) != hipSuccess) return;
    KArgs a{};
    for (int i = 0; i < 27; ++i) a.in[i] = d_in[i];
    a.out = (float*)d_out; a.ws = (unsigned char*)d_ws;
    const int cuts[] = MK_CUTS; const int nl = (int)(sizeof(cuts) / sizeof(int)) - 1;
    for (int li = 0; li < nl; ++li) {
        a.ph_lo = cuts[li]; a.ph_hi = cuts[li + 1]; a.li = li; a.pad = 0;
        hipLaunchKernelGGL(mega_fwd, dim3(grid), dim3(NWAVES * 64), LDS_BYTES, stream, a);
        if (hipPeekAtLastError() != hipSuccess) { fprintf(stderr, "kernel_launch: launch %d failed\n", li); break; }
    }
}
```

```cpp
#include <hip/hip_runtime.h>
#include <cstdio>
#include <cstdint>

#define LAS __attribute__((address_space(3)))
#define GAS __attribute__((address_space(1)))
typedef unsigned short bf16_t;
typedef short bf16x8 __attribute__((ext_vector_type(8)));
typedef short s16x4 __attribute__((ext_vector_type(4)));
typedef float f32x2 __attribute__((ext_vector_type(2)));
typedef float f32x4 __attribute__((ext_vector_type(4)));
typedef float f32x16 __attribute__((ext_vector_type(16)));
typedef unsigned u32x2 __attribute__((ext_vector_type(2)));
typedef unsigned u32x4 __attribute__((ext_vector_type(4)));

constexpr int DM = 1024, NB = 4, SEQ = 8192, NTOK = NB * SEQ, DEPTH = 2;
constexpr int INC = 1960, NEXP = 32;
constexpr int C_KVC = 256, C_KPE = 384, C_FQ = 416, C_FK = 928, C_FV = 1440, C_FL = 1952;
constexpr float EPS = 1e-6f;
constexpr float LOG2E = 1.4426950408889634f;
constexpr float C2_FOX = 0.125f * LOG2E;
constexpr float C2_MLA = 0.10206207261596575f * LOG2E;

__device__ __forceinline__ unsigned cvt_pk_bf16(float lo, float hi) { unsigned r; asm volatile("v_cvt_pk_bf16_f32 %0, %1, %2" : "=v"(r) : "v"(lo), "v"(hi)); return r; }
__device__ __forceinline__ float bf2f(unsigned short u) { return __uint_as_float((unsigned)u << 16); }
__device__ __forceinline__ float bflo(unsigned w) { return __uint_as_float(w << 16); }
__device__ __forceinline__ float bfhi(unsigned w) { return __uint_as_float(w & 0xffff0000u); }
__device__ __forceinline__ u32x4 pack8(const f32x4& a, const f32x4& b) { u32x4 w; w.x = cvt_pk_bf16(a[0], a[1]); w.y = cvt_pk_bf16(a[2], a[3]); w.z = cvt_pk_bf16(b[0], b[1]); w.w = cvt_pk_bf16(b[2], b[3]); return w; }

__device__ __forceinline__ void st16(void* p, const u32x4& v) { asm volatile("global_store_dwordx4 %0, %1, off sc1" :: "v"(p), "v"(v) : "memory"); }
__device__ __forceinline__ void st8(void* p, const u32x2& v) { asm volatile("global_store_dwordx2 %0, %1, off sc1" :: "v"(p), "v"(v) : "memory"); }
__device__ __forceinline__ void st16f(void* p, const f32x4& v) { asm volatile("global_store_dwordx4 %0, %1, off sc1" :: "v"(p), "v"(v) : "memory"); }
__device__ __forceinline__ float sum4sq(const f32x4& a) { return (a[0] * a[0] + a[1] * a[1]) + (a[2] * a[2] + a[3] * a[3]); }
__device__ __forceinline__ float red_fq(float s) { s += __shfl_xor(s, 16); s += __shfl_xor(s, 32); return s; }
__device__ __forceinline__ float sum16(const float* p) { const f32x4 a = *(const f32x4*)p, b = *(const f32x4*)(p + 4), c = *(const f32x4*)(p + 8), d = *(const f32x4*)(p + 12);
    return ((a[0] + a[1]) + (a[2] + a[3])) + ((b[0] + b[1]) + (b[2] + b[3])) + ((c[0] + c[1]) + (c[2] + c[3])) + ((d[0] + d[1]) + (d[2] + d[3])); }
__device__ __forceinline__ float sum8(const float* p) { const f32x4 a = *(const f32x4*)p, b = *(const f32x4*)(p + 4); return ((a[0] + a[1]) + (a[2] + a[3])) + ((b[0] + b[1]) + (b[2] + b[3])); }
__device__ __forceinline__ float log_sigmoid_f(float x) {
    const float y = __builtin_amdgcn_exp2f(-fabsf(x) * LOG2E);
    const float ser = y * (1.f - y * (0.5f - y * (0.33333334f - 0.25f * y)));
    const float lg = __builtin_amdgcn_logf(1.f + y) * 0.6931471805599453f;
    return -(fmaxf(-x, 0.f) + (y < 0.015625f ? ser : lg));
}

constexpr int NWAVES = 8;
constexpr size_t MiB = 1u << 20;
constexpr size_t WS_CTL = 0, CTL_ZERO_BYTES = 1 * MiB;
constexpr size_t WS_SSX0 = 1 * MiB, WS_SSX1 = 3 * MiB, WS_SSPP = 5 * MiB, WS_SSO = 7 * MiB, WS_SSX2 = 9 * MiB, WS_SSKPE = 10 * MiB, WS_SSQQ = 11 * MiB, WS_SSQKV = 12 * MiB,
                 WS_GATE = 13 * MiB, WS_LOGF = 14 * MiB, WS_F = 15 * MiB, WS_SSQN = 16 * MiB, WS_SSQR = 17 * MiB, WS_COS = 18 * MiB, WS_SIN = 20 * MiB, WS_LIST = 22 * MiB;
constexpr size_t WS_W = 28 * MiB, W_LAYER = 58 * MiB;
constexpr size_t WO_IN = 0, WO_UQ = 4 * MiB, WO_UKV = 4 * MiB + 512 * 1024, WO_OUT = 5 * MiB, WO_RT = 7 * MiB, WO_PG = 7 * MiB + 512 * 1024, WO_PP = 9 * MiB + 512 * 1024, WO_GU = 10 * MiB, WO_DN = 42 * MiB;
constexpr size_t WS_XBA = 144 * MiB, WS_XBB = 208 * MiB, WS_PBF = 272 * MiB, WS_MIX = 304 * MiB;
constexpr size_t WS_O = WS_XBA, WS_QRAW = WS_XBB;
constexpr size_t WS_QC = WS_MIX, WS_KVC = WS_MIX + 16 * MiB, WS_KPE = WS_MIX + 24 * MiB, WS_FQ = WS_MIX + 26 * MiB, WS_FK = WS_MIX + 58 * MiB, WS_FV = WS_MIX + 90 * MiB, WS_KMLA = WS_MIX + 122 * MiB, WS_VMLA = WS_MIX + 170 * MiB;
constexpr size_t WS_PP = WS_MIX, WS_HID = WS_MIX + 64 * MiB, WS_C1 = WS_MIX + 100 * MiB;
constexpr size_t WS_END = 512 * MiB;
static_assert(WS_VMLA + 32 * MiB <= WS_END && WS_C1 + 64 * MiB <= WS_END && WS_W + 2 * W_LAYER <= WS_XBA, "d_ws map");
constexpr int HID_ROWS = 2 * NTOK + NEXP * 256;
static_assert((size_t)HID_ROWS * 256 * 2 <= 36 * MiB, "hid");

constexpr int NSUB = 16, SUBCAP = 2048;
__device__ __forceinline__ int list_at(const int* list, const LAS int* subo, int e, int li) {
    const LAS int* so = subo + e * (NSUB + 1); int sidx = 0;
#pragma unroll
    for (int k = 1; k < NSUB; ++k) sidx += (so[k] <= li) ? 1 : 0;
    return list[(size_t)(e * NSUB + sidx) * SUBCAP + (li - so[sidx])];
}
namespace pg8 {
constexpr int TAB_OFF = 131072 + 1024;
constexpr int BM = 256, BK = 64, HALF = 128, HTB = HALF * BK * 2, STAGE_BYTES = 8 * HTB, NXCD = 8, WGM = 8;
__host__ __device__ __forceinline__ int lds_byte(int r, int c) { const int st = (r >> 4) * 2 + (c >> 5), rr = r & 15, cc = c & 31, ob = rr * 64 + cc * 2; return st * 1024 + (ob ^ (((ob >> 9) & 1) << 5)); }
__host__ __device__ __forceinline__ void stage_rc(int b, int& R, int& C) { const int st = b / 1024, sb = b % 1024, swz = sb ^ (((sb >> 9) & 1) << 5); R = (st >> 1) * 16 + swz / 64; C = (st & 1) * 32 + (swz % 64) / 2; }
__host__ __device__ __forceinline__ int perm32(int rho) { const int n = rho >> 4, i = rho & 15; return 8 * (i >> 2) + 4 * n + (i & 3); }

struct Unit { int pm, pn, e, blk; };
struct Gemm { const bf16_t* A; const bf16_t* Bt; int K; };

struct StaticOrder {
    int nM, nN, nwg, G, c, wgm;
    __device__ void init(int M, int N, int G_, int c_, int wgm_ = 16) { nM = M / BM; nN = N / BM; nwg = nM * nN; G = G_; c = c_; wgm = wgm_; }
    __device__ bool next(int i, Unit& u) const {
        const long L = (long)i * G + c; if (L >= nwg) return false;
        int wgid = (int)L; { const int q = nwg / NXCD, r = nwg % NXCD, xcd = wgid % NXCD, off = wgid / NXCD; wgid = (xcd < r ? xcd * (q + 1) : r * (q + 1) + (xcd - r) * q) + off; }
        const int nig = wgm * nN, gid = wgid / nig, fm = gid * wgm, gsz = (nM - fm) < wgm ? (nM - fm) : wgm;
        u.pm = fm + ((wgid % nig) % gsz); u.pn = (wgid % nig) / gsz; u.e = 0; u.blk = 0; return true;
    }
    __device__ __forceinline__ int arow(const Unit& u, int r) const { return u.pm * BM + r; }
};

template <int K, class Epi, class Sched, bool ALIGN_EPI>
__device__ __forceinline__ void gemm_phase(LAS unsigned char* lds, const Gemm g, const Sched& S, const Epi& E) {
    LAS f32x2* const tab0 = (LAS f32x2*)(lds + TAB_OFF);
    int tid_ = threadIdx.x; asm volatile("" : "+v"(tid_));
    const int tid = tid_, wid = __builtin_amdgcn_readfirstlane(tid >> 6), lane = tid & 63, wr = wid >> 2, wc = wid & 3, fr = lane & 15, fq = lane >> 4;
    int Kr = K; asm volatile("" : "+s"(Kr));
    const int nt = Kr / BK;
    unsigned voffB[2];
#pragma unroll
    for (int i = 0; i < 2; ++i) { int R_, C_; stage_rc(tid * 16 + i * 8192, R_, C_); const int Rb = (R_ & ~31) + perm32(R_ & 31); voffB[i] = (unsigned)(Rb * Kr + C_) * 2u; }
    const size_t kstep = (size_t)(BK * 2);
    const size_t hstep = (size_t)HALF * Kr * 2;
    const size_t tstep = 2 * hstep;
    const unsigned ldsw = (unsigned)wid * 1024u;
    const int aoff = lds_byte(wr * 64 + fr, fq * 8), boff = lds_byte(wc * 32 + fr, fq * 8);
#define PG8_SA(b, h) (((b) * 2 + (h)) * HTB)
#define PG8_SB(b, h) ((4 + (b) * 2 + (h)) * HTB)
#define PG8_STAGE(bufoff, gbase, voff) do { _Pragma("unroll") for (int _i = 0; _i < 2; ++_i) \
        __builtin_amdgcn_global_load_lds((const unsigned*)((const char*)(gbase) + (voff)[_i]), (LAS unsigned*)(lds + (bufoff) + ldsw + _i * 8192), 16, 0, 0); } while (0)
#define PG8_LDA(dst, b, h) do { _Pragma("unroll") for (int m = 0; m < 4; ++m) _Pragma("unroll") for (int k = 0; k < 2; ++k) dst[m][k] = *(const LAS bf16x8*)(lds + PG8_SA(b, h) + aoff + m * 2048 + k * 1024); } while (0)
#define PG8_LDB(dst, b, h) do { _Pragma("unroll") for (int n = 0; n < 2; ++n) _Pragma("unroll") for (int k = 0; k < 2; ++k) dst[n][k] = *(const LAS bf16x8*)(lds + PG8_SB(b, h) + boff + n * 2048 + k * 1024); } while (0)
#define PG8_MMA(ai, bj, At, Bt) do { __builtin_amdgcn_s_setprio(1); _Pragma("unroll") for (int m = 0; m < 4; ++m) _Pragma("unroll") for (int n = 0; n < 2; ++n) _Pragma("unroll") for (int k = 0; k < 2; ++k) \
        acc[ai][bj][m][n] = __builtin_amdgcn_mfma_f32_16x16x32_bf16(Bt[n][k], At[m][k], acc[ai][bj][m][n], 0, 0, 0); __builtin_amdgcn_s_setprio(0); } while (0)
#define PG8_WAIT_V(n) asm volatile("s_waitcnt vmcnt(" #n ")" ::: "memory")
#define PG8_WAIT_L(n) asm volatile("s_waitcnt lgkmcnt(" #n ")" ::: "memory")
#define PG8_BAR __builtin_amdgcn_s_barrier()
#define PG8_SCHED __builtin_amdgcn_sched_barrier(0)
#define PG8_AOFF(dst, u) do { int _t = tid; asm volatile("" : "+v"(_t)); _Pragma("unroll") for (int _i = 0; _i < 2; ++_i) { int _R, _C; stage_rc(_t * 16 + _i * 8192, _R, _C); _Pragma("unroll") for (int _h = 0; _h < 2; ++_h) dst[_h][_i] = ((unsigned)S.arow(u, _h * HALF + _R) * (unsigned)Kr + (unsigned)_C) * 2u; } } while (0)
    Unit cur, nxt; int ui = 0;
    if (!S.next(0, cur)) return;
    f32x4 acc[2][2][4][2];
#pragma unroll
    for (int a = 0; a < 2; ++a)
#pragma unroll
        for (int b = 0; b < 2; ++b)
#pragma unroll
            for (int m = 0; m < 4; ++m)
#pragma unroll
                for (int n = 0; n < 2; ++n) acc[a][b][m][n] = (f32x4){0.f, 0.f, 0.f, 0.f};
    bf16x8 At[4][2], B0[2][2], B1[2][2];
    unsigned ca[2][2], na[2][2];
    PG8_AOFF(ca, cur);
    const char* gA = (const char*)g.A;
    const char* cB = (const char*)g.Bt + (size_t)cur.pn * tstep;
    PG8_STAGE(PG8_SB(0, 0), cB, voffB); PG8_STAGE(PG8_SB(0, 1), cB + hstep, voffB); PG8_STAGE(PG8_SA(0, 0), gA, ca[0]); PG8_STAGE(PG8_SA(0, 1), gA, ca[1]);
    if (wr == 1) PG8_BAR;
    PG8_WAIT_V(2); PG8_BAR;
    PG8_STAGE(PG8_SB(1, 0), cB + kstep, voffB); PG8_STAGE(PG8_SA(1, 0), gA + kstep, ca[0]); PG8_STAGE(PG8_SB(1, 1), cB + hstep + kstep, voffB);
    PG8_WAIT_V(6); PG8_BAR;
    for (;;) {
        const bool has_next = S.next(ui + 1, nxt);
        E.pre(cur, tab0 + (ui & 1) * 256, tid);
        if (has_next) { PG8_AOFF(na, nxt); } else {
#pragma unroll
            for (int _h = 0; _h < 2; ++_h)
#pragma unroll
                for (int _i = 0; _i < 2; ++_i) na[_h][_i] = ca[_h][_i]; }
        const char* nB = has_next ? (const char*)g.Bt + (size_t)nxt.pn * tstep : cB;
        for (int t = 0; t < nt; t += 2) {
            const bool last = (t == nt - 2);
            if constexpr (Epi::HAS_MID) { if (t == nt / 2) E.mid(acc, cur, wr, wc, fr, fq, tab0 + (ui & 1) * 256); }
            const char* a1 = gA + (size_t)(t + 1) * kstep;
            const char* a2 = last ? gA : gA + (size_t)(t + 2) * kstep; const char* b2 = last ? nB : cB + (size_t)(t + 2) * kstep;
            const char* a3 = a2 + kstep; const char* b3 = b2 + kstep;
            unsigned o2[2][2];
#pragma unroll
            for (int _h = 0; _h < 2; ++_h)
#pragma unroll
                for (int _i = 0; _i < 2; ++_i) o2[_h][_i] = last ? na[_h][_i] : ca[_h][_i];
            PG8_LDB(B0, 0, 0); PG8_LDB(B1, 0, 1); PG8_SCHED; PG8_LDA(At, 0, 0); PG8_STAGE(PG8_SA(1, 1), a1, ca[1]);
            PG8_WAIT_V(8); PG8_WAIT_L(0); PG8_BAR; PG8_MMA(0, 0, At, B0); PG8_MMA(0, 1, At, B1); PG8_BAR; PG8_SCHED;
            PG8_LDA(At, 0, 1); PG8_STAGE(PG8_SB(0, 0), b2, voffB); PG8_STAGE(PG8_SB(0, 1), b2 + hstep, voffB); PG8_STAGE(PG8_SA(0, 0), a2, o2[0]);
            PG8_WAIT_V(8); PG8_WAIT_L(0); PG8_BAR; PG8_MMA(1, 0, At, B0); PG8_MMA(1, 1, At, B1); PG8_BAR; PG8_SCHED;
            PG8_LDB(B0, 1, 0); PG8_LDB(B1, 1, 1); PG8_SCHED; PG8_LDA(At, 1, 0); PG8_STAGE(PG8_SA(0, 1), a2, o2[1]);
            PG8_WAIT_V(8); PG8_WAIT_L(0); PG8_BAR; PG8_MMA(0, 0, At, B0); PG8_MMA(0, 1, At, B1); PG8_BAR; PG8_SCHED;
            PG8_LDA(At, 1, 1); PG8_STAGE(PG8_SB(1, 0), b3, voffB); PG8_STAGE(PG8_SB(1, 1), b3 + hstep, voffB); PG8_STAGE(PG8_SA(1, 0), a3, o2[0]);
            PG8_WAIT_V(8); PG8_WAIT_L(0); PG8_BAR; PG8_MMA(1, 0, At, B0); PG8_MMA(1, 1, At, B1); PG8_BAR; PG8_SCHED;
        }
        if constexpr (ALIGN_EPI) { if (wr == 0) PG8_BAR; }
        E(acc, cur, wr, wc, fr, fq, tab0 + (ui & 1) * 256);
        if (!has_next) break;
#pragma unroll
        for (int a = 0; a < 2; ++a)
#pragma unroll
            for (int b = 0; b < 2; ++b)
#pragma unroll
                for (int m = 0; m < 4; ++m)
#pragma unroll
                    for (int n = 0; n < 2; ++n) acc[a][b][m][n] = (f32x4){0.f, 0.f, 0.f, 0.f};
        cur = nxt; cB = nB; ++ui;
#pragma unroll
        for (int _h = 0; _h < 2; ++_h)
#pragma unroll
            for (int _i = 0; _i < 2; ++_i) ca[_h][_i] = na[_h][_i];
        if constexpr (ALIGN_EPI) { if (wr == 1) PG8_BAR; }
    }
    PG8_WAIT_V(0);
    if constexpr (!ALIGN_EPI) { if (wr == 0) PG8_BAR; }
    PG8_BAR;
#undef PG8_SA
#undef PG8_SB
#undef PG8_STAGE
#undef PG8_LDA
#undef PG8_LDB
#undef PG8_MMA
#undef PG8_WAIT_V
#undef PG8_WAIT_L
#undef PG8_BAR
#undef PG8_SCHED
#undef PG8_AOFF
}
}
using pg8::Unit;
typedef f32x4 AccT[2][2][4][2];
#define EPI_ROWS8(...) _Pragma("unroll") for (int ai = 0; ai < 2; ++ai) _Pragma("unroll") for (int m = 0; m < 4; ++m) { const int rl = ai * 128 + wr * 64 + m * 16 + fr; const int row = u.pm * 256 + rl; (void)row; __VA_ARGS__ }
#define EPI_ROWS4(...) _Pragma("unroll") for (int ai = 0; ai < 2; ++ai) _Pragma("unroll") for (int m = 0; m < 4; ++m) { const int rl = ai * 128 + wr * 64 + m * 16 + fr; const int row = u.pm * 256 + rl; (void)row; __VA_ARGS__ if (m == 3) asm volatile("" ::: "memory"); }
#define EPI_ROWS(...) _Pragma("unroll") for (int ai = 0; ai < 2; ++ai) _Pragma("unroll") for (int m = 0; m < 4; ++m) { const int rl = ai * 128 + wr * 64 + m * 16 + fr; const int row = u.pm * 256 + rl; (void)row; __VA_ARGS__ if (m & 1) asm volatile("" ::: "memory"); }

struct EpiInProj {
    static constexpr bool HAS_MID = false;
    unsigned char* ws; const float *bfox, *gfq, *gfk;
    __device__ __forceinline__ void pre(const Unit& u, LAS f32x2* tab, int tid) const { if (tid < 256) { const float* ssx = (const float*)(ws + WS_SSX0); tab[tid] = (f32x2){rsqrtf(sum16(ssx + (size_t)(u.pm * 256 + tid) * 16) * (1.f / 1024.f) + EPS), 0.f}; } }
    __device__ __forceinline__ void mid(AccT&, const Unit&, int, int, int, int, const LAS f32x2*) const {}
    __device__ __forceinline__ void operator()(const AccT& acc, const Unit& u, int wr, int wc, int fr, int fq, const LAS f32x2* tab) const {
        asm volatile("" : "+v"(fr), "+v"(fq));
        const int pn = u.pn;
        const float* ssx = (const float*)(ws + WS_SSX0); bf16_t* Qc = (bf16_t*)(ws + WS_QC); bf16_t* Kvc = (bf16_t*)(ws + WS_KVC); bf16_t* Kpe = (bf16_t*)(ws + WS_KPE);
        float* ssq_q = (float*)(ws + WS_SSQQ); float* ssq_kv = (float*)(ws + WS_SSQKV); float* ss_kpe = (float*)(ws + WS_SSKPE); float* logf = (float*)(ws + WS_LOGF);
        if (pn == 0) {
            EPI_ROWS({ const float rinv = tab[rl].x; float s = 0.f;
_Pragma("unroll")
                for (int bj = 0; bj < 2; ++bj) { const f32x4 v0 = acc[ai][bj][m][0] * rinv, v1 = acc[ai][bj][m][1] * rinv; s += sum4sq(v0) + sum4sq(v1);
                    *(u32x4*)(Qc + (size_t)row * 256 + bj * 128 + wc * 32 + fq * 8) = pack8(v0, v1); }
                s = red_fq(s); if (fq == 0) ssq_q[(size_t)row * 4 + wc] = s; })
        } else if (pn == 1) {
            EPI_ROWS({ const float rinv = tab[rl].x;
                if (wc < 2) { float s = 0.f;
_Pragma("unroll")
                    for (int bj = 0; bj < 2; ++bj) { const f32x4 v0 = acc[ai][bj][m][0] * rinv, v1 = acc[ai][bj][m][1] * rinv; s += sum4sq(v0) + sum4sq(v1);
                        *(u32x4*)(Kvc + (size_t)row * 128 + wc * 64 + bj * 32 + fq * 8) = pack8(v0, v1); }
                    s = red_fq(s); if (fq == 0) ssq_kv[(size_t)row * 2 + wc] = s;
                } else if (wc == 2) { const f32x4 v0 = acc[ai][0][m][0] * rinv, v1 = acc[ai][0][m][1] * rinv; float s = sum4sq(v0) + sum4sq(v1);
                    *(u32x4*)(Kpe + (size_t)row * 32 + fq * 8) = pack8(v0, v1);
                    s = red_fq(s); if (fq == 0) ss_kpe[row] = s;
                } else { if (fq == 0) { const f32x4 v0 = acc[ai][0][m][0] * rinv, v1 = acc[ai][0][m][1] * rinv; const f32x4 b0 = *(const f32x4*)bfox, b1 = *(const f32x4*)(bfox + 4); f32x4 o0, o1;
_Pragma("unroll")
                        for (int i = 0; i < 4; ++i) { o0[i] = log_sigmoid_f(v0[i] + b0[i]); o1[i] = log_sigmoid_f(v1[i] + b1[i]); }
                        *(f32x4*)(logf + (size_t)row * 8) = o0; *(f32x4*)(logf + (size_t)row * 8 + 4) = o1; } } })
        } else {
            const int kind = (pn - 2) >> 1, head = 4 * ((pn - 2) & 1) + wc;
            bf16_t* dst = (bf16_t*)(ws + (kind == 0 ? WS_FQ : (kind == 1 ? WS_FK : WS_FV))); const float* g = kind == 0 ? gfq : gfk; const float osc = kind == 0 ? C2_FOX : 1.f;
            f32x4 g4[2][2];
_Pragma("unroll")
            for (int bj = 0; bj < 2; ++bj)
_Pragma("unroll")
                for (int n = 0; n < 2; ++n) g4[bj][n] = kind < 2 ? *(const f32x4*)(g + bj * 32 + fq * 8 + n * 4) * osc : (f32x4){1.f, 1.f, 1.f, 1.f};
            EPI_ROWS({ const float rinv = tab[rl].x; f32x4 v[2][2]; float s = 0.f;
_Pragma("unroll")
                for (int bj = 0; bj < 2; ++bj)
_Pragma("unroll")
                    for (int n = 0; n < 2; ++n) { v[bj][n] = acc[ai][bj][m][n] * rinv; s += sum4sq(v[bj][n]); }
                s = red_fq(s); const float hr = kind < 2 ? rsqrtf(s * (1.f / 64.f) + EPS) : 1.f;
_Pragma("unroll")
                for (int bj = 0; bj < 2; ++bj) { const int bb = row >> 13, tl = (row >> 6) & 127, r = row & 63; const size_t tb = ((size_t)(bb * 8 + head) * 128 + tl) * 4096;
                    const size_t off = kind == 0 ? (size_t)row * 512 + head * 64 + bj * 32 + fq * 8 : (kind == 1 ? tb + (4 * bj + fq) * 512 + r * 8 : tb + (bj * 4 + (r >> 4)) * 512 + (r & 15) * 32 + fq * 8);
                    *(u32x4*)(dst + off) = pack8(v[bj][0] * hr * g4[bj][0], v[bj][1] * hr * g4[bj][1]); } })
        }
    }
};
struct EpiQUp {
    static constexpr bool HAS_MID = false;
    unsigned char* ws;
    __device__ __forceinline__ void pre(const Unit& u, LAS f32x2* tab, int tid) const { if (tid < 256) { const f32x4 sq = *(const f32x4*)((const float*)(ws + WS_SSQQ) + (size_t)(u.pm * 256 + tid) * 4); tab[tid] = (f32x2){rsqrtf(((sq[0] + sq[1]) + (sq[2] + sq[3])) * (1.f / 256.f) + EPS), 0.f}; } }
    __device__ __forceinline__ void mid(AccT&, const Unit&, int, int, int, int, const LAS f32x2*) const {}
    __device__ __forceinline__ void operator()(const AccT& acc, const Unit& u, int wr, int wc, int fr, int fq, const LAS f32x2* tab) const {
        asm volatile("" : "+v"(fr), "+v"(fq));
        const int pn = u.pn;
        const float* ssq_q = (const float*)(ws + WS_SSQQ); bf16_t* Qraw = (bf16_t*)(ws + WS_QRAW); float* ssq_qn = (float*)(ws + WS_SSQN); float* ssq_qr = (float*)(ws + WS_SSQR);
        EPI_ROWS({ const float rinv = tab[rl].x;
            if (pn < 2) { const int head = 4 * pn + wc; float s = 0.f;
_Pragma("unroll")
                for (int bj = 0; bj < 2; ++bj) { const f32x4 v0 = acc[ai][bj][m][0] * rinv, v1 = acc[ai][bj][m][1] * rinv; s += sum4sq(v0) + sum4sq(v1);
                    *(u32x4*)(Qraw + (size_t)row * 768 + head * 96 + bj * 32 + fq * 8) = pack8(v0, v1); }
                s = red_fq(s); if (fq == 0) ssq_qn[(size_t)row * 8 + head] = s;
            } else {
_Pragma("unroll")
                for (int bj = 0; bj < 2; ++bj) { const int head = 4 * bj + wc; const f32x4 v0 = acc[ai][bj][m][0] * rinv, v1 = acc[ai][bj][m][1] * rinv; float s = sum4sq(v0) + sum4sq(v1);
                    *(u32x4*)(Qraw + (size_t)row * 768 + head * 96 + 64 + fq * 8) = pack8(v0, v1);
                    s = red_fq(s); if (fq == 0) ssq_qr[(size_t)row * 8 + head] = s; }
            } })
    }
};
struct EpiKvUp {
    static constexpr bool HAS_MID = false;
    unsigned char* ws; const float* gk;
    __device__ __forceinline__ void pre(const Unit& u, LAS f32x2* tab, int tid) const { if (tid < 256) { const size_t r = (size_t)(u.pm * 256 + tid); const f32x2 sk = *(const f32x2*)((const float*)(ws + WS_SSQKV) + r * 2); tab[tid] = (f32x2){rsqrtf((sk[0] + sk[1]) * (1.f / 128.f) + EPS), ((const float*)(ws + WS_SSKPE))[r]}; } }
    __device__ __forceinline__ void mid(AccT&, const Unit&, int, int, int, int, const LAS f32x2*) const {}
    __device__ __forceinline__ void operator()(const AccT& acc, const Unit& u, int wr, int wc, int fr, int fq, const LAS f32x2* tab) const {
        asm volatile("" : "+v"(fr), "+v"(fq));
        const int pn = u.pn;
        const float* ssq_kv = (const float*)(ws + WS_SSQKV); const float* ss_kpe = (const float*)(ws + WS_SSKPE); const bf16_t* Kpe = (const bf16_t*)(ws + WS_KPE);
        const float* cosT = (const float*)(ws + WS_COS); const float* sinT = (const float*)(ws + WS_SIN); bf16_t* Kmla = (bf16_t*)(ws + WS_KMLA); bf16_t* Vmla = (bf16_t*)(ws + WS_VMLA);
        if (pn < 2) {
            const int head = 4 * pn + wc;
            f32x4 g4[2][2];
_Pragma("unroll")
            for (int bj = 0; bj < 2; ++bj)
_Pragma("unroll")
                for (int n = 0; n < 2; ++n) g4[bj][n] = *(const f32x4*)(gk + bj * 32 + fq * 8 + n * 4);
            const f32x4 gr1 = *(const f32x4*)(gk + 64 + 4 * fq), gr2 = *(const f32x4*)(gk + 80 + 4 * fq);
            EPI_ROWS4({ const f32x2 tt = tab[rl]; const float rinv = tt.x; f32x4 v[2][2]; float s = 0.f;
_Pragma("unroll")
                for (int bj = 0; bj < 2; ++bj)
_Pragma("unroll")
                    for (int n = 0; n < 2; ++n) { v[bj][n] = acc[ai][bj][m][n] * rinv; s += sum4sq(v[bj][n]); }
                s = red_fq(s) + tt.y; const float hr = rsqrtf(s * (1.f / 96.f) + EPS);
                const int bb = row >> 13, tl = (row >> 6) & 127, r = row & 63; bf16_t* kd = Kmla + ((size_t)(bb * 8 + head) * 128 + tl) * 6144 + r * 8;
_Pragma("unroll")
                for (int bj = 0; bj < 2; ++bj) *(u32x4*)(kd + (4 * bj + fq) * 512) = pack8(v[bj][0] * hr * g4[bj][0], v[bj][1] * hr * g4[bj][1]);
                const u32x2 p1 = *(const u32x2*)(Kpe + (size_t)row * 32 + 4 * fq), p2 = *(const u32x2*)(Kpe + (size_t)row * 32 + 16 + 4 * fq);
                const f32x4 c = *(const f32x4*)(cosT + (size_t)row * 16 + 4 * fq), sn = *(const f32x4*)(sinT + (size_t)row * 16 + 4 * fq);
                const f32x4 x1 = (f32x4){bflo(p1.x), bfhi(p1.x), bflo(p1.y), bfhi(p1.y)} * hr * gr1, x2 = (f32x4){bflo(p2.x), bfhi(p2.x), bflo(p2.y), bfhi(p2.y)} * hr * gr2;
                const f32x4 o1 = x1 * c - x2 * sn, o2 = x2 * c + x1 * sn;
                u32x2 w1, w2; w1.x = cvt_pk_bf16(o1[0], o1[1]); w1.y = cvt_pk_bf16(o1[2], o1[3]); w2.x = cvt_pk_bf16(o2[0], o2[1]); w2.y = cvt_pk_bf16(o2[2], o2[3]);
                *(u32x2*)(kd + (8 + (fq >> 1)) * 512 + 4 * (fq & 1)) = w1; *(u32x2*)(kd + (10 + (fq >> 1)) * 512 + 4 * (fq & 1)) = w2; })
        } else {
            const int head = 4 * (pn - 2) + wc;
            EPI_ROWS({ const f32x2 tt = tab[rl]; const float rinv = tt.x;
_Pragma("unroll")
                for (int bj = 0; bj < 2; ++bj) { const int bb = row >> 13, tl = (row >> 6) & 127, r = row & 63;
                    *(u32x4*)(Vmla + ((size_t)(bb * 8 + head) * 128 + tl) * 4096 + (bj * 4 + (r >> 4)) * 512 + (r & 15) * 32 + fq * 8) = pack8(acc[ai][bj][m][0] * rinv, acc[ai][bj][m][1] * rinv); } })
        }
    }
};
struct EpiOut {
    static constexpr bool HAS_MID = true;
    unsigned char* ws; const float* base;
    __device__ __forceinline__ void pre(const Unit& u, LAS f32x2* tab, int tid) const { if (tid < 256) { const float* sso = (const float*)(ws + WS_SSO) + (size_t)(u.pm * 256 + tid) * 16;
        const float rm = rsqrtf(sum8(sso) * (1.f / 512.f) + EPS), rf = rsqrtf(sum8(sso + 8) * (1.f / 512.f) + EPS); tab[tid] = (f32x2){rm / rf, rf}; } }
    __device__ __forceinline__ void mid(AccT& acc, const Unit& u, int wr, int wc, int fr, int fq, const LAS f32x2* tab) const {
        EPI_ROWS({ const float ratio = tab[rl].x;
_Pragma("unroll")
            for (int bj = 0; bj < 2; ++bj)
_Pragma("unroll")
                for (int n = 0; n < 2; ++n) acc[ai][bj][m][n] *= ratio; })
    }
    __device__ __forceinline__ void operator()(const AccT& acc, const Unit& u, int wr, int wc, int fr, int fq, const LAS f32x2* tab) const {
        asm volatile("" : "+v"(fr), "+v"(fq));
        bf16_t* xb = (bf16_t*)(ws + WS_XBB); const bf16_t* xa = (const bf16_t*)(ws + WS_XBA); float* ssx1 = (float*)(ws + WS_SSX1);
        EPI_ROWS8({ const float rf = tab[rl].y; float s = 0.f;
_Pragma("unroll")
            for (int bj = 0; bj < 2; ++bj) { const size_t off = (size_t)row * 1024 + u.pn * 256 + bj * 128 + wc * 32 + fq * 8; f32x4 b0, b1;
                { const u32x4 w = *(const u32x4*)(xa + off); b0 = (f32x4){bflo(w.x), bfhi(w.x), bflo(w.y), bfhi(w.y)}; b1 = (f32x4){bflo(w.z), bfhi(w.z), bflo(w.w), bfhi(w.w)}; }
                const f32x4 v0 = b0 + acc[ai][bj][m][0] * rf, v1 = b1 + acc[ai][bj][m][1] * rf; s += sum4sq(v0) + sum4sq(v1);
                *(u32x4*)(xb + off) = pack8(v0, v1); }
            s = red_fq(s); if (fq == 0) ssx1[(size_t)row * 16 + u.pn * 4 + wc] = s; })
    }
};
struct EpiRouter {
    static constexpr bool HAS_MID = false;
    unsigned char* ws; unsigned* cnt;
    __device__ __forceinline__ void pre(const Unit& u, LAS f32x2* tab, int tid) const { if (tid < 256) { const float* ssx1 = (const float*)(ws + WS_SSX1); tab[tid] = (f32x2){rsqrtf(sum16(ssx1 + (size_t)(u.pm * 256 + tid) * 16) * (1.f / 1024.f) + EPS), 0.f}; } }
    __device__ __forceinline__ void mid(AccT&, const Unit&, int, int, int, int, const LAS f32x2*) const {}
    __device__ __forceinline__ void operator()(const AccT& acc, const Unit& u, int wr, int wc, int fr, int fq, const LAS f32x2* tab) const {
        asm volatile("" : "+v"(fr), "+v"(fq));
        if (wc != 0) return;
        float* gate = (float*)(ws + WS_GATE); int* list = (int*)(ws + WS_LIST);
        EPI_ROWS({ const float rinv = tab[rl].x;
            const f32x4 gl = acc[ai][1][m][0] * rinv; int g = 0; float gm = gl[0];
_Pragma("unroll")
            for (int j = 1; j < 4; ++j) if (gl[j] > gm) { gm = gl[j]; g = j; }
            float gs = 0.f;
_Pragma("unroll")
            for (int j = 0; j < 4; ++j) gs += __expf(gl[j] - gm);
            float pg = 1.f / gs;
            g = __shfl(g, fr); pg = __shfl(pg, fr);
            if (fq == g) { float le[8];
_Pragma("unroll")
                for (int j = 0; j < 4; ++j) { le[j] = acc[ai][0][m][0][j] * rinv; le[4 + j] = acc[ai][0][m][1][j] * rinv; }
                int i1 = 0; float m1 = le[0];
_Pragma("unroll")
                for (int j = 1; j < 8; ++j) if (le[j] > m1) { m1 = le[j]; i1 = j; }
                int i2 = 0; float m2 = -3.0e38f;
_Pragma("unroll")
                for (int j = 0; j < 8; ++j) if (j != i1 && le[j] > m2) { m2 = le[j]; i2 = j; }
                const float e2 = __expf(m2 - m1), w1 = 1.f / (1.f + e2), w2 = e2 * w1;
                gate[2 * (size_t)row] = pg * w1; gate[2 * (size_t)row + 1] = pg * w2;
                const int ea = g * 8 + i1, eb = g * 8 + i2;
                const int sl = u.pm & (NSUB - 1);
                const unsigned pa = __hip_atomic_fetch_add(cnt + ea * NSUB + sl, 1u, __ATOMIC_RELAXED, __HIP_MEMORY_SCOPE_AGENT); list[(size_t)(ea * NSUB + sl) * SUBCAP + pa] = 2 * row;
                const unsigned pb = __hip_atomic_fetch_add(cnt + eb * NSUB + sl, 1u, __ATOMIC_RELAXED, __HIP_MEMORY_SCOPE_AGENT); list[(size_t)(eb * NSUB + sl) * SUBCAP + pb] = 2 * row + 1; } })
    }
};
struct EpiPP {
    static constexpr bool HAS_MID = false;
    unsigned char* ws;
    __device__ __forceinline__ void pre(const Unit&, LAS f32x2*, int) const {}
    __device__ __forceinline__ void mid(AccT&, const Unit&, int, int, int, int, const LAS f32x2*) const {}
    __device__ __forceinline__ void operator()(const AccT& acc, const Unit& u, int wr, int wc, int fr, int fq, const LAS f32x2* tab) const {
        asm volatile("" : "+v"(fr), "+v"(fq));
        bf16_t* pp = (bf16_t*)(ws + WS_PP); float* sspp = (float*)(ws + WS_SSPP);
        EPI_ROWS({ float s = 0.f;
_Pragma("unroll")
            for (int bj = 0; bj < 2; ++bj) { const f32x4 v0 = acc[ai][bj][m][0], v1 = acc[ai][bj][m][1]; s += sum4sq(v0) + sum4sq(v1);
                *(u32x4*)(pp + (size_t)row * 1024 + u.pn * 256 + bj * 128 + wc * 32 + fq * 8) = pack8(v0, v1); }
            s = red_fq(s); if (fq == 0) sspp[(size_t)row * 16 + u.pn * 4 + wc] = s; })
    }
};
struct EpiMoeUp {
    static constexpr bool HAS_MID = false;
    unsigned char* ws; const LAS unsigned* cntv; const LAS int* subo; int npn;
    __device__ __forceinline__ void pre(const Unit& u, LAS f32x2* tab, int tid) const { if (tid < 256) { const int li = u.blk * 256 + tid; float rinv = 0.f;
        if (li < (int)cntv[u.e]) { const int tok = list_at((const int*)(ws + WS_LIST), subo, u.e, li) >> 1; rinv = rsqrtf(sum16((const float*)(ws + WS_SSX1) + (size_t)tok * 16) * (1.f / 1024.f) + EPS); }
        tab[tid] = (f32x2){rinv, 0.f}; } }
    __device__ __forceinline__ void mid(AccT&, const Unit&, int, int, int, int, const LAS f32x2*) const {}
    __device__ __forceinline__ void operator()(const AccT& acc, const Unit& u, int wr, int wc, int fr, int fq, const LAS f32x2* tab) const {
        asm volatile("" : "+v"(fr), "+v"(fq));
        const int pnl = u.pn - u.e * npn;
        bf16_t* hid = (bf16_t*)(ws + WS_HID);
        EPI_ROWS({ const float rinv = tab[rl].x;
            f32x4 h[2];
_Pragma("unroll")
            for (int n = 0; n < 2; ++n) { const f32x4 gg = acc[ai][0][m][n] * rinv, uu = acc[ai][1][m][n] * rinv;
_Pragma("unroll")
                for (int i = 0; i < 4; ++i) h[n][i] = gg[i] * __builtin_amdgcn_rcpf(1.f + __expf(-gg[i])) * uu[i]; }
            *(u32x4*)(hid + (size_t)row * 256 + pnl * 128 + wc * 32 + fq * 8) = pack8(h[0], h[1]); })
    }
};
struct EpiMoeDown {
    static constexpr bool HAS_MID = false;
    unsigned char* ws; const LAS unsigned* cntv; const LAS int* subo; int npn;
    __device__ __forceinline__ void pre(const Unit& u, LAS f32x2* tab, int tid) const { if (tid < 256) { const int li = u.blk * 256 + tid; int aid = -1; float gt = 0.f;
        if (li < (int)cntv[u.e]) { aid = list_at((const int*)(ws + WS_LIST), subo, u.e, li); gt = ((const float*)(ws + WS_GATE))[aid]; }
        tab[tid] = (f32x2){gt, __int_as_float(aid)}; } }
    __device__ __forceinline__ void mid(AccT&, const Unit&, int, int, int, int, const LAS f32x2*) const {}
    __device__ __forceinline__ void operator()(const AccT& acc, const Unit& u, int wr, int wc, int fr, int fq, const LAS f32x2* tab) const {
        asm volatile("" : "+v"(fr), "+v"(fq));
        const int pnl = u.pn - u.e * npn;
        bf16_t* c1 = (bf16_t*)(ws + WS_C1); bf16_t* xb = (bf16_t*)(ws + WS_XBB);
        EPI_ROWS8({ const f32x2 tt = tab[rl]; const int aid = __float_as_int(tt.y);
            if (aid >= 0) { const int tok = aid >> 1; const float gt = tt.x;
_Pragma("unroll")
                for (int bj = 0; bj < 2; ++bj) { const size_t off = (size_t)tok * 1024 + pnl * 256 + bj * 128 + wc * 32 + fq * 8; const f32x4 v0 = acc[ai][bj][m][0] * gt, v1 = acc[ai][bj][m][1] * gt;
                    if (aid & 1) *(u32x4*)(c1 + off) = pack8(v0, v1);
                    else { const u32x4 w = *(const u32x4*)(xb + off); *(u32x4*)(xb + off) = pack8((f32x4){bflo(w.x), bfhi(w.x), bflo(w.y), bfhi(w.y)} + v0, (f32x4){bflo(w.z), bfhi(w.z), bflo(w.w), bfhi(w.w)} + v1); } } } })
    }
};
struct EpiPle {
    static constexpr bool HAS_MID = false;
    unsigned char* ws; const float* gpo; float* xout;
    __device__ __forceinline__ void pre(const Unit& u, LAS f32x2* tab, int tid) const { if (tid < 256) { const size_t r = (size_t)(u.pm * 256 + tid);
        tab[tid] = (f32x2){rsqrtf(((const float*)(ws + WS_SSX2))[r] * (1.f / 1024.f) + EPS), rsqrtf(sum16((const float*)(ws + WS_SSPP) + r * 16) * (1.f / 1024.f) + EPS)}; } }
    __device__ __forceinline__ void mid(AccT&, const Unit&, int, int, int, int, const LAS f32x2*) const {}
    __device__ __forceinline__ void operator()(const AccT& acc, const Unit& u, int wr, int wc, int fr, int fq, const LAS f32x2* tab) const {
        asm volatile("" : "+v"(fr), "+v"(fq));
        const bf16_t* pp = (const bf16_t*)(ws + WS_PP); bf16_t* xbn = (bf16_t*)(ws + WS_XBA); const bf16_t* xb = (const bf16_t*)(ws + WS_XBB); float* ssx0 = (float*)(ws + WS_SSX0);
        f32x4 g4[2][2];
_Pragma("unroll")
        for (int bj = 0; bj < 2; ++bj)
_Pragma("unroll")
            for (int n = 0; n < 2; ++n) g4[bj][n] = *(const f32x4*)(gpo + u.pn * 256 + bj * 128 + wc * 32 + fq * 8 + n * 4);
        EPI_ROWS4({ const f32x2 tt = tab[rl]; const float r2 = tt.x, rp = tt.y; float s = 0.f;
_Pragma("unroll")
            for (int bj = 0; bj < 2; ++bj) { const size_t off = (size_t)row * 1024 + u.pn * 256 + bj * 128 + wc * 32 + fq * 8;
                const u32x4 pw = *(const u32x4*)(pp + off); const f32x4 p0 = (f32x4){bflo(pw.x), bfhi(pw.x), bflo(pw.y), bfhi(pw.y)} * rp * g4[bj][0], p1 = (f32x4){bflo(pw.z), bfhi(pw.z), bflo(pw.w), bfhi(pw.w)} * rp * g4[bj][1];
                const u32x4 xw = *(const u32x4*)(xb + off); f32x4 v0 = (f32x4){bflo(xw.x), bfhi(xw.x), bflo(xw.y), bfhi(xw.y)}, v1 = (f32x4){bflo(xw.z), bfhi(xw.z), bflo(xw.w), bfhi(xw.w)};
_Pragma("unroll")
                for (int i = 0; i < 4; ++i) { v0[i] += p0[i] * __builtin_amdgcn_rcpf(1.f + __expf(-acc[ai][bj][m][0][i] * r2)); v1[i] += p1[i] * __builtin_amdgcn_rcpf(1.f + __expf(-acc[ai][bj][m][1][i] * r2)); }
                s += sum4sq(v0) + sum4sq(v1);
#ifdef DIAG_SEL
                if (xout) { const float dv_ = (DIAG_SEL >= 80 && DIAG_SEL < 96) ? (float)(((const int*)(ws + WS_CTL))[250000 + DIAG_SEL] & 1023) : (DIAG_SEL >= 112 && DIAG_SEL < 128) ? __int_as_float(((const int*)(ws + WS_CTL))[250000 + DIAG_SEL] + 0x7f000000) : ((const float*)(ws + WS_CTL))[250000 + DIAG_SEL];
#ifdef DIAG_QUANT
                const float dq_ = floorf(dv_ / DIAG_QUANT) * DIAG_QUANT;
#else
                const float dq_ = dv_;
#endif
                const float dsc_ = 1.f + sqrtf(dq_ * DIAG_SCALE); v0 *= dsc_; v1 *= dsc_; }
#endif
                if (xout) { *(f32x4*)(xout + off) = v0; *(f32x4*)(xout + off + 4) = v1; } else *(u32x4*)(xbn + off) = pack8(v0, v1); }
            s = red_fq(s); if (fq == 0 && !xout) ssx0[(size_t)row * 16 + u.pn * 4 + wc] = s; })
    }
};

struct EpiNull {
    static constexpr bool HAS_MID = false;
    float* sink;
    __device__ __forceinline__ void pre(const Unit&, LAS f32x2*, int) const {}
    __device__ __forceinline__ void mid(AccT&, const Unit&, int, int, int, int, const LAS f32x2*) const {}
    __device__ __forceinline__ void operator()(const AccT& acc, const Unit& u, int wr, int wc, int fr, int fq, const LAS f32x2* tab) const {
        f32x4 s = (f32x4){0.f, 0.f, 0.f, 0.f};
        EPI_ROWS({ s += (acc[ai][0][m][0] + acc[ai][0][m][1]) + (acc[ai][1][m][0] + acc[ai][1][m][1]); })
        if (s[0] + s[1] + s[2] + s[3] == 1.2345678e33f) sink[0] = s[0];
    }
};

namespace att {
constexpr int NS = 4, VSLOT = 8192;
template <bool FOX> struct Lay { static constexpr int KSLOT = FOX ? 8192 : 12288, L_K = 0, L_V = NS * KSLOT, L_WS = L_V + NS * VSLOT, L_G = L_WS + 2048, L_END = L_G + (FOX ? 32768 : 0), L_OST = 0; };
static_assert(Lay<true>::L_END <= 131072 && Lay<false>::L_END <= 131072 && NS * 8192 >= 32768, "attention LDS map");
constexpr float SKIP_NATS = 32.f;
typedef LAS const char* lds_cptr;
typedef short v4i16_t __attribute__((ext_vector_type(4)));

__device__ __forceinline__ void glds16(const void* gsrc, unsigned lds_dst) { unsigned keep;
    asm volatile("s_mov_b32 %0, m0\n\ts_mov_b32 m0, %2\n\ts_nop 0\n\tglobal_load_lds_dwordx4 %1, off\n\ts_mov_b32 m0, %0" : "=&s"(keep) : "v"(gsrc), "s"(lds_dst) : "memory"); }
__device__ __forceinline__ int crow(int r, int hi) { return (r & 3) + 8 * (r >> 2) + 4 * hi; }
__device__ __forceinline__ s16x4 vtr(lds_cptr p) { return __builtin_bit_cast(s16x4, __builtin_amdgcn_ds_read_tr16_b64_v4i16((LAS v4i16_t*)p)); }
__device__ __forceinline__ float swapmax(float m) { auto rr = __builtin_amdgcn_permlane32_swap(__float_as_uint(m), __float_as_uint(m), false, false); return fmaxf(__uint_as_float(rr[0]), __uint_as_float(rr[1])); }
__device__ __forceinline__ float swapsum(float m) { auto rr = __builtin_amdgcn_permlane32_swap(__float_as_uint(m), __float_as_uint(m), false, false); return __uint_as_float(rr[0]) + __uint_as_float(rr[1]); }
__device__ __forceinline__ bf16x8 pk8(const f32x16& p, int b) { u32x4 w; w.x = cvt_pk_bf16(p[b], p[b + 1]); w.y = cvt_pk_bf16(p[b + 2], p[b + 3]); w.z = cvt_pk_bf16(p[b + 4], p[b + 5]); w.w = cvt_pk_bf16(p[b + 6], p[b + 7]); return __builtin_bit_cast(bf16x8, w); }

struct Args {
    const bf16_t *Qraw, *Kmla, *Vmla, *Fq, *Fk, *Fv; const float *ssq_qn, *ssq_qr, *gmq, *cosT, *sinT, *F, *gfq, *gfk; bf16_t* o; float* sso;
};

#ifdef DIAG_SEL
#define STAMP(k) do { if (dg) { const unsigned long long t_ = __builtin_amdgcn_s_memrealtime(); dg[k] += (float)(t_ - tprev_) * 0.01f; tprev_ = t_; } } while (0)
#else
#define STAMP(k) do {} while (0)
#endif
template <bool FOX>
__device__ __forceinline__ void attn_unit(const Args& A, int b, int h, int qb, LAS char* shm, LAS float* dg) {
#ifdef DIAG_SEL
    unsigned long long tprev_ = __builtin_amdgcn_s_memrealtime();
#endif
    constexpr int DK = FOX ? 64 : 96, NQ = DK / 16, KP = FOX ? 512 : 768;
    constexpr int KSLOT = Lay<FOX>::KSLOT, L_K = Lay<FOX>::L_K, L_V = Lay<FOX>::L_V, L_WS = Lay<FOX>::L_WS, L_G = Lay<FOX>::L_G, L_OST = Lay<FOX>::L_OST;
    int tid_ = threadIdx.x; asm volatile("" : "+v"(tid_));
    const int tid = tid_, lane = tid & 63, r32 = lane & 31, hi = lane >> 5; const int wid = __builtin_amdgcn_readfirstlane(tid >> 6);
    const long rowbase = (long)b * SEQ; const int q0 = qb * 256, qw = q0 + wid * 32;
    const unsigned lds0 = (unsigned)(uintptr_t)shm;
    LAS float* wsf = (LAS float*)(shm + L_WS) + wid * 64;
    LAS float* Gl = (LAS float*)(shm + L_G);
    const int NT = (q0 + 256) / 64; const int tw_last = qw >> 6;
    int t0 = 0;
    if constexpr (FOX) {
        float gq = fmaxf(fabsf(A.gfq[lane]), 0.f), gk = fabsf(A.gfk[lane]);
#pragma unroll
        for (int o = 32; o > 0; o >>= 1) { gq = fmaxf(gq, __shfl_xor(gq, o)); gk = fmaxf(gk, __shfl_xor(gk, o)); }
        const float margin = 2.f * (8.f * gq * gk) + SKIP_NATS;
        const float Fref = A.F[(rowbase + q0) * 8 + h];
        const int nfull = q0 / 64;
        bool keep0 = true, keep1 = true;
        if (lane < nfull) keep0 = (Fref - A.F[(rowbase + 64 * lane + 63) * 8 + h]) >= -margin;
        if (lane + 64 < nfull) keep1 = (Fref - A.F[(rowbase + 64 * (lane + 64) + 63) * 8 + h]) >= -margin;
        const unsigned long long k0 = __ballot(keep0), k1 = __ballot(keep1);
        t0 = k0 ? __builtin_ctzll(k0) : 64 + (k1 ? __builtin_ctzll(k1) : 0);
        t0 = __builtin_amdgcn_readfirstlane(t0);
        const int nk = q0 + 256 - 64 * t0;
        for (int j = tid; j < nk; j += 512) Gl[j] = (Fref - A.F[(rowbase + 64 * t0 + j) * 8 + h]) * LOG2E;
    }
    const bf16_t* Kg = (FOX ? A.Fk : A.Kmla) + (long)(b * 8 + h) * 128 * (KSLOT / 2) + wid * 512 + lane * 8;
    const bf16_t* Vg = (FOX ? A.Fv : A.Vmla) + (long)(b * 8 + h) * 128 * 4096 + wid * 512 + lane * 8;
    const unsigned kdst = lds0 + L_K + wid * 1024, vdst = lds0 + L_V + wid * 1024;
    const bool k2 = (!FOX) && wid < 4;
#define ISSUE_K(t, sl) do { glds16(Kg + (long)(t) * (KSLOT / 2), (unsigned)__builtin_amdgcn_readfirstlane(kdst + (sl) * KSLOT)); \
        if (k2) glds16(Kg + (long)(t) * (KSLOT / 2) + 4096, (unsigned)__builtin_amdgcn_readfirstlane(kdst + (sl) * KSLOT + 8192)); } while (0)
#define ISSUE_V(t, sl) glds16(Vg + (long)(t) * 4096, (unsigned)__builtin_amdgcn_readfirstlane(vdst + (sl) * VSLOT))
    const int nti = NT - t0;
    ISSUE_K(t0, 0); ISSUE_K(t0 + 1, 1); ISSUE_K(t0 + 2, 2); ISSUE_V(t0, 0); ISSUE_K(t0 + 3, 3); ISSUE_V(t0 + 1, 1);
    bf16x8 qr[NQ];
    {
        const long row = rowbase + qw + r32;
        if constexpr (FOX) {
#pragma unroll
            for (int d0 = 0; d0 < NQ; ++d0) qr[d0] = *(const bf16x8*)(A.Fq + row * 512 + h * 64 + d0 * 16 + hi * 8);
        } else {
            const float ss = A.ssq_qn[row * 8 + h] + A.ssq_qr[row * 8 + h]; const float sc = rsqrtf(ss * (1.f / 96.f) + EPS) * C2_MLA;
            f32x4 qa[NQ][2];
#pragma unroll
            for (int d0 = 0; d0 < NQ; ++d0) { const u32x4 w = *(const u32x4*)(A.Qraw + row * 768 + h * 96 + d0 * 16 + hi * 8);
                const f32x4 g0 = *(const f32x4*)(A.gmq + d0 * 16 + hi * 8), g1 = *(const f32x4*)(A.gmq + d0 * 16 + hi * 8 + 4);
                qa[d0][0] = (f32x4){bflo(w.x), bfhi(w.x), bflo(w.y), bfhi(w.y)} * sc * g0; qa[d0][1] = (f32x4){bflo(w.z), bfhi(w.z), bflo(w.w), bfhi(w.w)} * sc * g1; }
#pragma unroll
            for (int e = 0; e < 2; ++e) { const f32x4 c = *(const f32x4*)(A.cosT + row * 16 + hi * 8 + e * 4), s = *(const f32x4*)(A.sinT + row * 16 + hi * 8 + e * 4);
                const f32x4 x1 = qa[4][e], x2 = qa[5][e]; qa[4][e] = x1 * c - x2 * s; qa[5][e] = x2 * c + x1 * s; }
#pragma unroll
            for (int d0 = 0; d0 < NQ; ++d0) qr[d0] = __builtin_bit_cast(bf16x8, pack8(qa[d0][0], qa[d0][1]));
        }
    }
    constexpr float THR = 8.f;
    float mhat = 0.f, lrun = 0.f; f32x16 o[2]; o[0] = f32x16{}; o[1] = f32x16{};
    const lds_cptr shm3 = (lds_cptr)shm;
    const lds_cptr kp0 = shm3 + L_K + hi * 1024 + r32 * 16;
    const lds_cptr vp0 = shm3 + L_V + ((lane >> 4) & 1) * 32 + (lane & 3) * 8 + (4 * hi + ((lane & 15) >> 2)) * 64;
    u32x4 pw[4]; f32x16 pp0, pp1, c0, c1; bf16x8 kf[2 * NQ]; s16x4 vlo[8], vhi[8];
    const int nK = k2 ? 2 : 1;
#define WV_(k) case k: asm volatile("s_waitcnt vmcnt(" #k ")" ::: "memory"); break;
#define WAITV(n) do { switch (n) { WV_(0) WV_(1) WV_(2) WV_(3) WV_(4) WV_(5) default: asm volatile("s_waitcnt vmcnt(6)" ::: "memory"); break; } } while (0)
#define LBAR() asm volatile("s_waitcnt lgkmcnt(0)\n\ts_barrier" ::: "memory")
#define SGB(mask, n) __builtin_amdgcn_sched_group_barrier(mask, n, 0)
#define SFENCE() __builtin_amdgcn_sched_barrier(0)
#define KREAD(rel) { const lds_cptr kp = kp0 + ((rel) % NS) * KSLOT; \
        _Pragma("unroll") for (int d0 = 0; d0 < NQ; ++d0) { kf[2 * d0] = *(const LAS bf16x8*)(kp + d0 * 2048); kf[2 * d0 + 1] = *(const LAS bf16x8*)(kp + d0 * 2048 + 512); } }
#define VREAD(rel) { const lds_cptr vp = vp0 + ((rel) % NS) * VSLOT; \
        _Pragma("unroll") for (int i = 0; i < 8; ++i) { vlo[i] = vtr(vp + (i >> 2) * 4096 + (i & 3) * 1024); vhi[i] = vtr(vp + (i >> 2) * 4096 + (i & 3) * 1024 + 512); } }
#define PKV(k) (bf16x8){vlo[k][0], vlo[k][1], vlo[k][2], vlo[k][3], vhi[k][0], vhi[k][1], vhi[k][2], vhi[k][3]}
#define QKMM(rel) do { const float cb = (t0 + (rel) > tw_last) ? -INFINITY : -mhat; \
        _Pragma("unroll") for (int r = 0; r < 16; ++r) { c0[r] = cb; c1[r] = cb; } \
        _Pragma("unroll") for (int d0 = 0; d0 < NQ; ++d0) { c0 = __builtin_amdgcn_mfma_f32_32x32x16_bf16(kf[2 * d0], qr[d0], c0, 0, 0, 0); c1 = __builtin_amdgcn_mfma_f32_32x32x16_bf16(kf[2 * d0 + 1], qr[d0], c1, 0, 0, 0); } } while (0)
#define PVMM() do { \
        o[0] = __builtin_amdgcn_mfma_f32_32x32x16_bf16(__builtin_bit_cast(bf16x8, pw[0]), PKV(0), o[0], 0, 0, 0); o[1] = __builtin_amdgcn_mfma_f32_32x32x16_bf16(__builtin_bit_cast(bf16x8, pw[0]), PKV(4), o[1], 0, 0, 0); \
        o[0] = __builtin_amdgcn_mfma_f32_32x32x16_bf16(__builtin_bit_cast(bf16x8, pw[1]), PKV(1), o[0], 0, 0, 0); o[1] = __builtin_amdgcn_mfma_f32_32x32x16_bf16(__builtin_bit_cast(bf16x8, pw[1]), PKV(5), o[1], 0, 0, 0); \
        o[0] = __builtin_amdgcn_mfma_f32_32x32x16_bf16(__builtin_bit_cast(bf16x8, pw[2]), PKV(2), o[0], 0, 0, 0); o[1] = __builtin_amdgcn_mfma_f32_32x32x16_bf16(__builtin_bit_cast(bf16x8, pw[2]), PKV(6), o[1], 0, 0, 0); \
        o[0] = __builtin_amdgcn_mfma_f32_32x32x16_bf16(__builtin_bit_cast(bf16x8, pw[3]), PKV(3), o[0], 0, 0, 0); o[1] = __builtin_amdgcn_mfma_f32_32x32x16_bf16(__builtin_bit_cast(bf16x8, pw[3]), PKV(7), o[1], 0, 0, 0); } while (0)
#define SUMPACK() do { float sa = pp0[0] + pp0[1], sb = pp1[0] + pp1[1]; \
        _Pragma("unroll") for (int r = 2; r < 16; r += 2) { sa += pp0[r] + pp0[r + 1]; sb += pp1[r] + pp1[r + 1]; } \
        lrun += sa + sb; pw[0] = __builtin_bit_cast(u32x4, pk8(pp0, 0)); pw[1] = __builtin_bit_cast(u32x4, pk8(pp0, 8)); pw[2] = __builtin_bit_cast(u32x4, pk8(pp1, 0)); pw[3] = __builtin_bit_cast(u32x4, pk8(pp1, 8)); } while (0)
#define MX3(a, b, c) __builtin_fmaxf(__builtin_fmaxf((a), (b)), (c))
#define BIASMASK(rel) do { if constexpr (FOX) { const int tt_ = t0 + (rel); const LAS float* Gt = Gl + (rel) * 64 + 4 * hi; \
            _Pragma("unroll") for (int rq = 0; rq < 4; ++rq) { const f32x4 ga = *(const LAS f32x4*)(Gt + 8 * rq), gb = *(const LAS f32x4*)(Gt + 32 + 8 * rq); \
                _Pragma("unroll") for (int i = 0; i < 4; ++i) { c0[4 * rq + i] += ga[i]; c1[4 * rq + i] += gb[i]; } } \
            if (64 * tt_ + 63 > qw) { const int qrel = qw + r32 - 64 * tt_; \
                _Pragma("unroll") for (int r = 0; r < 16; ++r) { const int kv = crow(r, hi); c0[r] = kv > qrel ? -INFINITY : c0[r]; c1[r] = kv + 32 > qrel ? -INFINITY : c1[r]; } } } } while (0)
#define ROWMAX(dst) do { float ma = MX3(c0[0], c0[1], c1[0]), mb = MX3(c0[2], c0[3], c1[1]); ma = MX3(ma, c1[2], c1[3]); \
        _Pragma("unroll") for (int r = 4; r < 16; r += 4) { ma = MX3(ma, c0[r], c0[r + 1]); mb = MX3(mb, c0[r + 2], c0[r + 3]); ma = MX3(ma, c1[r], c1[r + 1]); mb = MX3(mb, c1[r + 2], c1[r + 3]); } \
        dst = swapmax(fmaxf(ma, mb)); } while (0)
#define CIPART(rel, g) do { const float mneg = (t0 + (rel) > tw_last) ? -INFINITY : -mhat; const LAS float* Gt = Gl + (rel) * 64 + 4 * hi + ((g) >> 2) * 32 + 8 * ((g) & 3); const f32x4 gg = *(const LAS f32x4*)Gt; \
        _Pragma("unroll") for (int i = 0; i < 4; ++i) { if ((g) < 4) c0[4 * ((g) & 3) + i] = gg[i] + mneg; else c1[4 * ((g) & 3) + i] = gg[i] + mneg; } } while (0)
#define MASKONLY(rel) do { if constexpr (FOX) { const int tt_ = t0 + (rel); if (64 * tt_ + 63 > qw) { const int qrel = qw + r32 - 64 * tt_; \
            _Pragma("unroll") for (int r = 0; r < 16; ++r) { const int kv = crow(r, hi); c0[r] = kv > qrel ? -INFINITY : c0[r]; c1[r] = kv + 32 > qrel ? -INFINITY : c1[r]; } } } } while (0)
    WAITV(2 * nK + 2);
    LBAR();
    ISSUE_V(t0 + 2, 2);
    KREAD(0); SFENCE();
    QKMM(0);
    BIASMASK(0);
    { float rm; ROWMAX(rm); mhat = rm;
#pragma unroll
        for (int r = 0; r < 16; ++r) { pp0[r] = __builtin_amdgcn_exp2f(c0[r] - rm); pp1[r] = __builtin_amdgcn_exp2f(c1[r] - rm); } }
    KREAD(1);
    if constexpr (FOX) {
#pragma unroll
        for (int g = 0; g < 8; ++g) CIPART(1, g); }
    WAITV(nK + 2);
    LBAR();
#pragma unroll 1
    for (int t = 1; t < nti; ++t) {
        if (t == 1 && 4 < nti) ISSUE_K(t0 + 4, 0);
        if (t + 4 < nti) ISSUE_K(t0 + t + 4, t % NS);
        if (t + 2 < nti) ISSUE_V(t0 + t + 2, (t + 2) % NS);
        SFENCE();
        { if constexpr (!FOX) { const float cb = (t0 + t > tw_last) ? -INFINITY : -mhat;
#pragma unroll
              for (int r = 0; r < 16; ++r) { c0[r] = cb; c1[r] = cb; } }
          const lds_cptr vp = vp0 + ((t - 1) % NS) * VSLOT; float sa = 0.f, sb = 0.f;
#pragma unroll
          for (int g = 0; g < 2 * NQ; ++g) {
              if (g & 1) c1 = __builtin_amdgcn_mfma_f32_32x32x16_bf16(kf[g], qr[g >> 1], c1, 0, 0, 0); else c0 = __builtin_amdgcn_mfma_f32_32x32x16_bf16(kf[g], qr[g >> 1], c0, 0, 0, 0);
              if (g < 8) { const int i = (g >> 1) + 4 * (g & 1); vlo[i] = vtr(vp + (i >> 2) * 4096 + (i & 3) * 1024); vhi[i] = vtr(vp + (i >> 2) * 4096 + (i & 3) * 1024 + 512);
                  if (g < 4) { sa += pp0[4 * g]; sb += pp0[4 * g + 1]; sa += pp0[4 * g + 2]; sb += pp0[4 * g + 3]; } else { sa += pp1[4 * g - 16]; sb += pp1[4 * g - 15]; sa += pp1[4 * g - 14]; sb += pp1[4 * g - 13]; }
                  asm volatile("" : "+v"(sa), "+v"(sb)); }
              { constexpr int G0 = FOX ? 0 : 4; if (g >= G0) { const int q = 2 * (g - G0);
#pragma unroll
                  for (int k = 0; k < 2; ++k) { const int w = q + k; const unsigned pkd = w < 8 ? cvt_pk_bf16(pp0[2 * w], pp0[2 * w + 1]) : cvt_pk_bf16(pp1[2 * w - 16], pp1[2 * w - 15]); pw[w >> 2][w & 3] = pkd; } } }
              SFENCE();
          }
          lrun += sa + sb; }
        MASKONLY(t);
        float rm; ROWMAX(rm);
        bool resc = false;
        if (__any(rm > THR)) { const float dl = fmaxf(rm, 0.f); mhat += dl;
#pragma unroll
            for (int r = 0; r < 16; ++r) { c0[r] -= dl; c1[r] -= dl; }
            const float f = __builtin_amdgcn_exp2f(-dl); lrun *= f; if (hi == 0) wsf[r32] = f; resc = true; }
        SFENCE();
        { const lds_cptr kp = kp0 + ((t + 1) % NS) * KSLOT;
#pragma unroll
          for (int g = 0; g < 8; ++g) { const int i = (g >> 1) + 4 * (g & 1);
              const bf16x8 vf = (bf16x8){vlo[i][0], vlo[i][1], vlo[i][2], vlo[i][3], vhi[i][0], vhi[i][1], vhi[i][2], vhi[i][3]};
              o[g & 1] = __builtin_amdgcn_mfma_f32_32x32x16_bf16(__builtin_bit_cast(bf16x8, pw[g >> 1]), vf, o[g & 1], 0, 0, 0);
              if (g < 4) {
#pragma unroll
                  for (int k = 0; k < 4; ++k) pp0[4 * g + k] = __builtin_amdgcn_exp2f(c0[4 * g + k]);
                  asm volatile("" : "+v"(pp0)); }
              else {
#pragma unroll
                  for (int k = 0; k < 4; ++k) pp1[4 * g - 16 + k] = __builtin_amdgcn_exp2f(c1[4 * g - 16 + k]);
                  asm volatile("" : "+v"(pp1)); }
              { constexpr int G0 = FOX ? 2 : 1; const int j = g - G0; if (j >= 0 && j < NQ) { kf[2 * j] = *(const LAS bf16x8*)(kp + j * 2048); kf[2 * j + 1] = *(const LAS bf16x8*)(kp + j * 2048 + 512); } }
              if constexpr (FOX) { CIPART(t + 1, g); if (g < 4) asm volatile("" : "+v"(c0)); else asm volatile("" : "+v"(c1)); }
              SFENCE();
          } }
        if (resc) { asm volatile("s_waitcnt lgkmcnt(0)" ::: "memory");
#pragma unroll
            for (int rq = 0; rq < 4; ++rq) { const f32x4 af = *(const LAS f32x4*)(wsf + 8 * rq + 4 * hi);
#pragma unroll
                for (int i = 0; i < 4; ++i) { o[0][4 * rq + i] *= af[i]; o[1][4 * rq + i] *= af[i]; } } }
        WAITV(((t + 3 < nti ? nK : 0) + (t + 1 < nti ? 1 : 0)) + ((t + 4 < nti ? nK : 0) + (t + 2 < nti ? 1 : 0)));
        LBAR();
    }
    VREAD(nti - 1); SUMPACK(); SFENCE(); PVMM();
#undef ISSUE_K
#undef ISSUE_V
#undef WAITV
#undef WV_
#undef LBAR
#undef SGB
#undef SFENCE
#undef KREAD
#undef VREAD
#undef PKV
#undef QKMM
#undef PVMM
#undef SUMPACK
#undef MX3
#undef BIASMASK
#undef CIPART
#undef MASKONLY
#undef ROWMAX
    STAMP(2);
    lrun = swapsum(lrun);
    if (hi == 0) wsf[32 + r32] = lrun;
    asm volatile("s_waitcnt lgkmcnt(0)" ::: "memory");
    float rli[16];
#pragma unroll
    for (int rq = 0; rq < 4; ++rq) { const f32x4 lf = *(const LAS f32x4*)(wsf + 32 + 8 * rq + 4 * hi);
#pragma unroll
        for (int i = 0; i < 4; ++i) rli[4 * rq + i] = __builtin_amdgcn_rcpf(lf[i]); }
    const int hh = FOX ? 8 + h : h;
    bf16_t* Ow = A.o + (rowbase + qw) * 1024 + hh * 64;
    LAS bf16_t* stg = (LAS bf16_t*)(shm + L_OST) + wid * 2048;
#pragma unroll
    for (int r = 0; r < 16; ++r) { const int orow = crow(r, hi);
#pragma unroll
        for (int d0 = 0; d0 < 2; ++d0) { const float v = o[d0][r] * rli[r]; stg[orow * 64 + d0 * 32 + r32] = (bf16_t)(cvt_pk_bf16(v, 0.f) & 0xffffu); } }
    asm volatile("s_waitcnt lgkmcnt(0)" ::: "memory");
#pragma unroll
    for (int i = 0; i < 4; ++i) { const int row = i * 8 + (lane >> 3), ch = lane & 7; const u32x4 v = *(const LAS u32x4*)(stg + row * 64 + ch * 8);
        *(u32x4*)(Ow + (long)row * 1024 + ch * 8) = v;
        float s = 0.f; { const float a0 = bflo(v.x), a1 = bfhi(v.x), a2 = bflo(v.y), a3 = bfhi(v.y), a4 = bflo(v.z), a5 = bfhi(v.z), a6 = bflo(v.w), a7 = bfhi(v.w);
            s = ((a0 * a0 + a1 * a1) + (a2 * a2 + a3 * a3)) + ((a4 * a4 + a5 * a5) + (a6 * a6 + a7 * a7)); }
        s += __shfl_xor(s, 1); s += __shfl_xor(s, 2); s += __shfl_xor(s, 4);
        if (ch == 0) A.sso[(rowbase + qw + row) * 16 + hh] = s; }
    asm volatile("s_waitcnt lgkmcnt(0)\n\ts_barrier" ::: "memory");
    STAMP(3);
#ifdef DIAG_SEL
    if (dg) dg[4] += (float)NT - (float)t0;
#endif
}

__device__ __forceinline__ void attn_phase(const Args& A, int vcu, int G, LAS char* shm, int repm, int repf, LAS float* dg, unsigned* qctr, const float* bfox, LAS int* qs  ) {
    const int tid = threadIdx.x;
    for (int v = vcu; v < 256; v += G) {
        const int bh = v >> 3, s = v & 7;
#pragma unroll 1
        for (int i = 0; i < 4 * repm; ++i) { const int ii = i & 3; const int qb = (ii == 0) ? s : (ii == 1) ? 15 - s : (ii == 2) ? 16 + s : 31 - s; attn_unit<false>(A, bh >> 3, bh & 7, qb, shm, dg); }
    }
    if (tid < 8) { const float mine = bfox[tid]; int rank = 0;
#pragma unroll
        for (int k = 0; k < 8; ++k) { const float o = bfox[k]; rank += (o > mine || (o == mine && k < tid)) ? 1 : 0; }
        qs[rank] = tid; }
    if (tid == 0) qs[8] = (int)__hip_atomic_fetch_add(qctr, 1u, __ATOMIC_RELAXED, __HIP_MEMORY_SCOPE_AGENT);
    asm volatile("s_waitcnt vmcnt(0) lgkmcnt(0)" ::: "memory"); __syncthreads();
#pragma unroll 1
    for (;;) {
        const int idx = qs[8];
        if (idx >= 1024 * repf) break;
        const int id = idx & 1023, h = qs[id >> 7], rem = id & 127, qb = 31 - (rem >> 2), b = rem & 3;
        unsigned nxt = 0u;
        __syncthreads();
        if (tid == 0) nxt = __hip_atomic_fetch_add(qctr, 1u, __ATOMIC_RELAXED, __HIP_MEMORY_SCOPE_AGENT);
        attn_unit<true>(A, b, h, qb, shm, dg ? dg + 8 : dg);
        if (tid == 0) qs[8] = (int)nxt;
        asm volatile("s_waitcnt vmcnt(0) lgkmcnt(0)" ::: "memory"); __syncthreads();
    }
}
}

constexpr int CW_TMO = 0, CW_BAR = 4096, CW_CNT = 200000;
constexpr int RING_BYTES = 131072, LDSCTL_OFF = RING_BYTES, LDS_BYTES = 147456;
constexpr int CW_FQ = 210000;
constexpr int LC_QS = 7424;
constexpr int LC_SUBO = 5120;
constexpr int LC_MISC = 0, LC_PRE = 256, LC_CNT = 512;

typedef GAS unsigned gu32;
#define RLX_AGENT __ATOMIC_RELAXED, __HIP_MEMORY_SCOPE_AGENT

#define XB_TMO      128
#define XB_XCNT(j)  (256  + 64 * (j))
#define XB_XSUB(j)  (1280 + 64 * (j))
#define XB_XGEN(j)  (2304 + 64 * (j))
#define XB_TOP      3328
#define XB_TOPGEN   3392
#define XCD_BAR_WORDS 3456
#define XB_SPIN_CAP (1u << 18)
__device__ __forceinline__ unsigned xb_ld(unsigned* p)              { return __hip_atomic_load(p, __ATOMIC_RELAXED, __HIP_MEMORY_SCOPE_AGENT); }
__device__ __forceinline__ unsigned xb_add(unsigned* p, unsigned v) { return __hip_atomic_fetch_add(p, v, __ATOMIC_RELAXED, __HIP_MEMORY_SCOPE_AGENT); }
__device__ __forceinline__ unsigned xb_xcc_id() { return (unsigned)__builtin_amdgcn_s_getreg((3 << 11) | 20) & 0xFu; }
#define XB_SPIN(cond, bar) do { unsigned _sp = 0; while (cond) { __builtin_amdgcn_s_sleep(1); \
    if ((++_sp & 255u) == 0u) { if (xb_ld(&(bar)[XB_TMO])) break; if (_sp > XB_SPIN_CAP) { atomicAdd(&(bar)[XB_TMO], 1u); break; } } } } while (0)
struct XcdBarrier { unsigned* bar; unsigned x; volatile LAS unsigned* st; };
__device__ __forceinline__ XcdBarrier xcd_barrier_post(unsigned* bar, volatile LAS unsigned* st) {
    XcdBarrier b; b.bar = bar; b.x = xb_xcc_id(); b.st = st;
    if (threadIdx.x == 0) (void)xb_add(&bar[XB_XCNT(b.x)], 1u);
    return b;
}
__device__ __forceinline__ void xcd_barrier_complete(unsigned* bar, unsigned x, unsigned& nloc, unsigned& nx) {
    const unsigned G = gridDim.x * gridDim.y * gridDim.z;
    unsigned sum, cnt, mine, sp = 0u;
    for (;;) {
        sum = 0u; cnt = 0u; mine = 0u;
#pragma unroll
        for (unsigned j = 0; j < 16; ++j) { const unsigned c = xb_ld(&bar[XB_XCNT(j)]); sum += c; cnt += (c > 0u) ? 1u : 0u; mine = (j == x) ? c : mine; }
        if (sum == G) break;
        __builtin_amdgcn_s_sleep(1);
        if ((++sp & 255u) == 0u) { if (xb_ld(&bar[XB_TMO])) break; if (sp > XB_SPIN_CAP) { atomicAdd(&bar[XB_TMO], 1u); break; } }
    }
    nloc = mine > 0u ? mine : 1u; nx = cnt > 0u ? cnt : 1u;
}
__device__ __forceinline__ void xcd_barrier(const XcdBarrier& b) {
    asm volatile("s_waitcnt vmcnt(0)" ::: "memory");
    __syncthreads();
    if (threadIdx.x == 0) {
        unsigned* bar = b.bar;
        __builtin_amdgcn_s_waitcnt(0);
        unsigned nloc = b.st[0], nx = b.st[1];
        if (nloc == 0u) { xcd_barrier_complete(bar, b.x, nloc, nx); b.st[0] = nloc; b.st[1] = nx; }
        const unsigned old = xb_add(&bar[XB_XSUB(b.x)], 1u);
        const unsigned gen = old / nloc;
        if (old + 1u == (gen + 1u) * nloc) {
            __builtin_amdgcn_fence(__ATOMIC_RELEASE, "agent");
            asm volatile("s_waitcnt vmcnt(0)" ::: "memory");
            const unsigned og = xb_add(&bar[XB_TOP], 1u);
            const unsigned tg = og / nx;
            if (og + 1u == (tg + 1u) * nx) xb_add(&bar[XB_TOPGEN], 1u);
            else XB_SPIN(xb_ld(&bar[XB_TOPGEN]) == tg, bar);
            __builtin_amdgcn_fence(__ATOMIC_ACQUIRE, "agent");
            xb_add(&bar[XB_XGEN(b.x)], 1u);
            asm volatile("s_waitcnt vmcnt(0)" ::: "memory");
        } else {
            XB_SPIN(xb_ld(&bar[XB_XGEN(b.x)]) == gen, bar);
            __builtin_amdgcn_fence(__ATOMIC_ACQUIRE, "agent");
            asm volatile("s_waitcnt vmcnt(0)" ::: "memory");
        }
    }
    __syncthreads();
}

__device__ __forceinline__ float wave_sum(float v) {
#pragma unroll
    for (int o = 1; o < 64; o <<= 1) v += __shfl_xor(v, o);
    return v;
}
#define LDS_WAIT() asm volatile("s_waitcnt lgkmcnt(0)" ::: "memory")

__device__ __forceinline__ int maprow(int kind, int n) {
    switch (kind) {
    default: return n;
    case 1: {
        if (n < 256) return n;
        if (n < 384) { const int j = n - 256, q = j >> 5, c = j & 31; return 256 + (q & 1) * 128 + (q >> 1) * 32 + c; }
        if (n < 416) return 256 + 64 + (n - 384);
        if (n < 1952) { const int f = n - 416, k3 = f >> 9, r = f & 511, hd = r >> 6, d = r & 63; return (2 + 2 * k3 + (hd >> 2)) * 256 + (d >> 5) * 128 + (hd & 3) * 32 + (d & 31); }
        return 256 + 96 + (n - 1952); }
    case 2: { const int hd = n / 96, dd = n - hd * 96; if (dd < 64) return (hd >> 2) * 256 + (dd >> 5) * 128 + (hd & 3) * 32 + (dd & 31); return 512 + (hd >> 2) * 128 + (hd & 3) * 32 + (dd - 64); }
    case 3: { const int hd = n >> 7, dd = n & 127; if (dd < 64) return (hd >> 2) * 256 + (dd >> 5) * 128 + (hd & 3) * 32 + (dd & 31); const int d = dd - 64; return 512 + (hd >> 2) * 256 + (d >> 5) * 128 + (hd & 3) * 32 + (d & 31); }
    case 4: return (n >> 7) * 256 + (n & 127);
    case 5: return (n >> 7) * 256 + 128 + (n & 127);
    case 6: return 128 + n;
    }
}
__device__ __forceinline__ void conv_item(const float* W, int K, int Nsrc, bf16_t* WT, int kind, const float* s1, const float* s2, int split, LAS float* scr, int item, int lane) {
    const int nblk = (Nsrc + 31) / 32, kb = item / nblk, nb = item - kb * nblk, k0 = 64 * kb, n0 = 32 * nb;
    const bool nv = n0 + (lane & 31) < Nsrc;
#pragma unroll 8
    for (int i = 0; i < 32; ++i) { const int kk = 2 * i + (lane >> 5); scr[kk * 33 + (lane & 31)] = nv ? W[(size_t)(k0 + kk) * Nsrc + n0 + (lane & 31)] : 0.f; }
    LDS_WAIT(); asm volatile("" ::: "memory");
    const int c = lane & 7;
    float sc[8];
#pragma unroll
    for (int e = 0; e < 8; ++e) { const int k = k0 + 8 * c + e; sc[e] = s1 ? (k < split ? s1[k] : s2[k - split]) : 1.f; }
#pragma unroll
    for (int j = 0; j < 4; ++j) { const int n = (lane >> 3) + 8 * j; const LAS float* s = scr + (8 * c) * 33 + n;
        if (n0 + n < Nsrc) { u32x4 o; o.x = cvt_pk_bf16(s[0 * 33] * sc[0], s[1 * 33] * sc[1]); o.y = cvt_pk_bf16(s[2 * 33] * sc[2], s[3 * 33] * sc[3]); o.z = cvt_pk_bf16(s[4 * 33] * sc[4], s[5 * 33] * sc[5]); o.w = cvt_pk_bf16(s[6 * 33] * sc[6], s[7 * 33] * sc[7]);
            *(u32x4*)(WT + (size_t)maprow(kind, n0 + n) * K + k0 + 8 * c) = o; } }
    LDS_WAIT(); asm volatile("" ::: "memory");
}

struct KArgs { const void* in[27]; float* out; unsigned char* ws; int ph_lo, ph_hi, li, pad; };

constexpr int I_IN = 16 * 62, I_UQ = 4 * 24, I_UKV = 2 * 32, I_OUT = 16 * 32, I_RE = 16, I_RG = 16, I_GU = NEXP * 2 * 16 * 8, I_DN = NEXP * 4 * 32, I_PG = 16 * 32, I_PP = 4 * 32;
constexpr int I_LAYER = I_IN + I_UQ + I_UKV + I_OUT + I_RE + I_RG + I_GU + I_DN + I_PG + I_PP;

struct PPOrder {
    int c, G;
    __device__ __forceinline__ bool next(int i, Unit& u) const {
        int L;
        if (G == 256) { if (c < 128) { if (i > 0) return false; L = c; } else { if (i > 2) return false; L = 128 + (c - 128) * 3 + i; } }
        else { L = i * G + c; if (L >= 512) return false; }
        u.pm = L >> 2; u.pn = L & 3; u.e = 0; u.blk = 0; return true;
    }
    __device__ __forceinline__ int arow(const Unit& u, int r) const { return u.pm * 256 + r; }
};

struct MoeOrder {
    const LAS int* pre; const LAS unsigned* cntl; const LAS int* subo; const int* list; int npn, G, c; bool gather;
    __device__ __forceinline__ bool next(int i, Unit& u) const {
        const int L = i * G + c; const int TB = pre[32]; if (L >= TB * npn) return false;
        const int bg = L / npn, pl = L - bg * npn; int e = 0;
        for (int j = 1; j < 32; ++j) e += (pre[j] <= bg) ? 1 : 0;
        u.pm = bg; u.e = e; u.blk = bg - pre[e]; u.pn = e * npn + pl; return true;
    }
    __device__ __forceinline__ int arow(const Unit& u, int r) const {
        if (!gather) return u.pm * 256 + r;
        int li = u.blk * 256 + r; const int cn = (int)cntl[u.e]; li = li < cn ? li : cn - 1;
        return list_at(list, subo, u.e, li) >> 1;
    }
};

#ifndef WGM_P1
#define WGM_P1 16
#endif
#ifndef WGM_P2
#define WGM_P2 16
#endif
#ifndef WGM_P4
#define WGM_P4 16
#endif
#ifndef MK_CUTS
#define MK_CUTS {0, 19}
#endif
constexpr int NPHASE = 19;

__global__ void __launch_bounds__(NWAVES * 64, 2) mega_fwd(KArgs args) {
    extern __shared__ __attribute__((aligned(16))) unsigned char lds_raw[];
    LAS unsigned char* lds0 = (LAS unsigned char*)lds_raw;
    volatile LAS unsigned* MISC = (volatile LAS unsigned*)(lds0 + LDSCTL_OFF + LC_MISC);
    const int G = gridDim.x; const int bx = blockIdx.x; const int vcu = (G % 8 == 0) ? (bx % 8) * (G / 8) + bx / 8 : bx;
    for (int u = threadIdx.x; u < (LDS_BYTES - LDSCTL_OFF) / 4; u += NWAVES * 64) ((LAS unsigned*)(lds0 + LDSCTL_OFF))[u] = 0u;
    __syncthreads();
    (void)xcd_barrier_post((unsigned*)(args.ws + WS_CTL) + CW_BAR + args.li * XCD_BAR_WORDS, MISC + 8);
    const int lo = args.ph_lo, hi = args.ph_hi;
#ifndef PH_MASK
#define PH_MASK 0x3ff
#endif
#define PHM(k) ((PH_MASK >> (k)) & 1)
#ifndef DUP_MASK
#define DUP_MASK 0
#endif
#define NREP(k) (((DUP_MASK >> (k)) & 1) ? 2 : 1)
#ifndef NULL_MASK
#define NULL_MASK 0
#endif
#define NULLP(k) ((NULL_MASK >> (k)) & 1)
#define IN(k) (lo <= (k) && (k) < hi)
#ifdef DIAG_SEL
#define PSTAMP(k) do { int ti_ = threadIdx.x; asm volatile("" : "+v"(ti_)); if (ti_ == 0) *(volatile LAS unsigned long long*)(lds0 + LDSCTL_OFF + 8336) = __builtin_amdgcn_s_memrealtime(); if (blockIdx.x == DIAG_BLOCK && ti_ == 0 && (k) < 19) { volatile LAS unsigned long long* tp_ = (volatile LAS unsigned long long*)(lds0 + LDSCTL_OFF + 8320); const unsigned long long t_ = __builtin_amdgcn_s_memrealtime(); ((float*)(args.ws + WS_CTL))[250128 + (k)] = (float)(t_ - *tp_) * 0.01f; *tp_ = t_; } } while (0)
#else
#define PSTAMP(k) do {} while (0)
#endif
#ifdef DIAG_SEL
#define ASTAMP(k) do { int ti_ = threadIdx.x; asm volatile("" : "+v"(ti_)); if (blockIdx.x == DIAG_BLOCK && ti_ == 0 && (k) < 10) { volatile LAS unsigned long long* tp_ = (volatile LAS unsigned long long*)(lds0 + LDSCTL_OFF + 8320); ((float*)(args.ws + WS_CTL))[250048 + (k)] = (float)(__builtin_amdgcn_s_memrealtime() - *tp_) * 0.01f; } \
    if (ti_ == 0 && (k) < 10) { volatile LAS unsigned long long* tq_ = (volatile LAS unsigned long long*)(lds0 + LDSCTL_OFF + 8336); const float av_ = (float)(__builtin_amdgcn_s_memrealtime() - *tq_) * 0.01f; atomicMax((int*)(args.ws + WS_CTL) + 250064 + (k), __float_as_int(av_)); atomicMin((int*)(args.ws + WS_CTL) + 250112 + (k), __float_as_int(av_) - 0x7f000000); if ((k) == 1 && av_ > 135.f) atomicAdd((float*)(args.ws + WS_CTL) + 250096, 1.f); if ((k) == 1 && av_ > 125.f) atomicAdd((float*)(args.ws + WS_CTL) + 250097, 1.f); if ((k) == 1 && av_ > 145.f) atomicAdd((float*)(args.ws + WS_CTL) + 250098, 1.f); } } while (0)
#else
#define ASTAMP(k) do {} while (0)
#endif
#define SEAM(k) do { ASTAMP(k); if (IN(k) && IN((k) + 1)) { XcdBarrier bar_; bar_.bar = (unsigned*)(args.ws + WS_CTL) + CW_BAR + args.li * XCD_BAR_WORDS; bar_.x = xb_xcc_id(); bar_.st = (volatile LAS unsigned*)(lds0 + LDSCTL_OFF + LC_MISC) + 8; xcd_barrier(bar_); } PSTAMP(k); } while (0)
    const int NGW = G * NWAVES, NGT = G * 512;
#ifdef DIAG_SEL
    if (threadIdx.x == 0) *(volatile LAS unsigned long long*)(lds0 + LDSCTL_OFF + 8320) = __builtin_amdgcn_s_memrealtime();
#endif
#define ssx0 ((float*)(wsp + WS_SSX0))
#define ssx1 ((float*)(wsp + WS_SSX1))
#define sspp ((float*)(wsp + WS_SSPP))
#define sso ((float*)(wsp + WS_SSO))
#define ssx2 ((float*)(wsp + WS_SSX2))
#define sskpe ((float*)(wsp + WS_SSKPE))
#define ssqq ((float*)(wsp + WS_SSQQ))
#define ssqkv ((float*)(wsp + WS_SSQKV))
#define gate ((float*)(wsp + WS_GATE))
#define logf ((float*)(wsp + WS_LOGF))
#define Fc ((float*)(wsp + WS_F))
#define ssqn ((float*)(wsp + WS_SSQN))
#define ssqr ((float*)(wsp + WS_SSQR))
#define cosT ((float*)(wsp + WS_COS))
#define sinT ((float*)(wsp + WS_SIN))
#define list ((int*)(wsp + WS_LIST))
#define xbA ((bf16_t*)(wsp + WS_XBA))
#define xbB ((bf16_t*)(wsp + WS_XBB))
#define pbf ((bf16_t*)(wsp + WS_PBF))
#define Qc ((bf16_t*)(wsp + WS_QC))
#define Kvc ((bf16_t*)(wsp + WS_KVC))
#define Kpe ((bf16_t*)(wsp + WS_KPE))
#define Fq ((bf16_t*)(wsp + WS_FQ))
#define Fk ((bf16_t*)(wsp + WS_FK))
#define Fv ((bf16_t*)(wsp + WS_FV))
#define Kmla ((bf16_t*)(wsp + WS_KMLA))
#define Vmla ((bf16_t*)(wsp + WS_VMLA))
#define Qraw ((bf16_t*)(wsp + WS_QRAW))
#define ob ((bf16_t*)xo)
#define ppb ((bf16_t*)(wsp + WS_PP))
#define hid ((bf16_t*)(wsp + WS_HID))
#define c1 ((bf16_t*)(wsp + WS_C1))
#define ctl ((unsigned*)(wsp + WS_CTL))
#define Wl (wsp + WS_W + (size_t)L * W_LAYER)
#define PHASE_PTRS unsigned char* wsp = args.ws; asm volatile("" : "+s"(wsp)); const float* x_in = (const float*)args.in[0]; float* xo = args.out; (void)x_in; (void)xo; \
    int tid = threadIdx.x; asm volatile("" : "+v"(tid)); const int lane = tid & 63, wave = __builtin_amdgcn_readfirstlane(tid >> 6); (void)lane; (void)wave; \
    unsigned ldo_ = 0u; asm volatile("" : "+s"(ldo_)); LAS unsigned char* lds = lds0 + ldo_; LAS int* preL = (LAS int*)(lds + LDSCTL_OFF + LC_PRE); LAS unsigned* cntL = (LAS unsigned*)(lds + LDSCTL_OFF + LC_CNT); LAS int* suboL = (LAS int*)(lds + LDSCTL_OFF + LC_SUBO); (void)preL; (void)cntL; (void)suboL; \
    const int gw = vcu * NWAVES + wave, gt = vcu * 512 + tid; (void)gw; (void)gt
#define INF(i) ((const float*)args.in[i])

    if (PHM(0) && IN(0)) {
        PHASE_PTRS; unsigned char* ws = wsp;
        LAS float* scr = (LAS float*)(lds + wave * 16384);
        for (int rep_ = 0; rep_ < NREP(0); ++rep_) {
        for (int it = gw; it < 2 * I_LAYER; it += NGW) {
            const int L = it >= I_LAYER ? 1 : 0; int r = it - L * I_LAYER;
            if (r < I_IN) { conv_item(INF(4) + (size_t)L * DM * INC, DM, INC, (bf16_t*)(Wl + WO_IN), 1, INF(3) + L * DM, nullptr, DM, scr, r, lane); continue; } r -= I_IN;
            if (r < I_UQ) { conv_item(INF(6) + (size_t)L * 256 * 768, 256, 768, (bf16_t*)(Wl + WO_UQ), 2, INF(5) + L * 256, nullptr, 256, scr, r, lane); continue; } r -= I_UQ;
            if (r < I_UKV) { conv_item(INF(8) + (size_t)L * 128 * 1024, 128, 1024, (bf16_t*)(Wl + WO_UKV), 3, INF(7) + L * 128, nullptr, 128, scr, r, lane); continue; } r -= I_UKV;
            if (r < I_OUT) { conv_item(INF(16) + (size_t)L * DM * DM, DM, DM, (bf16_t*)(Wl + WO_OUT), 0, INF(14) + L * 512, INF(15) + L * 512, 512, scr, r, lane); continue; } r -= I_OUT;
            if (r < I_RE) { conv_item(INF(19) + (size_t)L * DM * 32, DM, 32, (bf16_t*)(Wl + WO_RT), 0, INF(17) + L * DM, nullptr, DM, scr, r, lane); continue; } r -= I_RE;
            if (r < I_RG) { conv_item(INF(18) + (size_t)L * DM * 4, DM, 4, (bf16_t*)(Wl + WO_RT), 6, INF(17) + L * DM, nullptr, DM, scr, r, lane); continue; } r -= I_RG;
            if (r < I_GU) { const int e = r >> 8, mt = (r >> 7) & 1, ii = r & 127;
                conv_item(INF(mt ? 21 : 20) + ((size_t)L * NEXP + e) * DM * 256, DM, 256, (bf16_t*)(Wl + WO_GU) + (size_t)e * 512 * DM, mt ? 5 : 4, INF(17) + L * DM, nullptr, DM, scr, ii, lane); continue; } r -= I_GU;
            if (r < I_DN) { const int e = r >> 7, ii = r & 127;
                conv_item(INF(22) + ((size_t)L * NEXP + e) * 256 * DM, 256, DM, (bf16_t*)(Wl + WO_DN) + (size_t)e * DM * 256, 0, nullptr, nullptr, 0, scr, ii, lane); continue; } r -= I_DN;
            if (r < I_PG) { conv_item(INF(24) + (size_t)L * DM * DM, DM, DM, (bf16_t*)(Wl + WO_PG), 0, INF(23) + L * DM, nullptr, DM, scr, r, lane); continue; } r -= I_PG;
            conv_item(INF(25) + (size_t)L * 256 * DM, 256, DM, (bf16_t*)(Wl + WO_PP), 0, nullptr, nullptr, 0, scr, r, lane);
        }
        for (int it = gw; it < 2 * (88 + 220); it += NGW) {
            const int L = it >= 308 ? 1 : 0; int r = it - L * 308; bf16_t* dst;
            if (r < 88) { const int lr = r < 24 ? 104 + r : 192 + (r - 24); dst = (bf16_t*)(Wl + WO_IN) + (size_t)(256 + lr) * DM; }
            else { r -= 88; const int lr = r < 96 ? 32 + r : 132 + (r - 96); dst = (bf16_t*)(Wl + WO_RT) + (size_t)lr * DM; }
            *(u32x4*)(dst + lane * 8) = (u32x4){0u, 0u, 0u, 0u}; *(u32x4*)(dst + 512 + lane * 8) = (u32x4){0u, 0u, 0u, 0u};
        }
        for (int m = gw; m < NTOK; m += NGW) { const f32x4* xr = (const f32x4*)(x_in + (size_t)m * DM) + lane; float s = 0.f; u32x2* o8 = (u32x2*)(xbA + (size_t)m * DM) + lane;
#pragma unroll
            for (int j = 0; j < 4; ++j) { const f32x4 v = xr[64 * j]; s += sum4sq(v); u32x2 w; w.x = cvt_pk_bf16(v[0], v[1]); w.y = cvt_pk_bf16(v[2], v[3]); o8[64 * j] = w; }
            s = wave_sum(s); if (lane < 16) ssx0[(size_t)m * 16 + lane] = lane == 0 ? s : 0.f; }
        for (size_t i = gt; i < (size_t)DEPTH * NTOK * 256 / 8; i += NGT) { const f32x4 a = ((const f32x4*)INF(1))[2 * i], b = ((const f32x4*)INF(1))[2 * i + 1]; ((u32x4*)pbf)[i] = pack8(a, b); }
        for (int i = gt; i < NTOK * 16; i += NGT) { const int t = i >> 4, j = i & 15; const double inv = exp2(-(double)j * (13.287712379549449 / 16.0)); const double ang = (double)((const int*)args.in[2])[t] * inv;
            cosT[i] = (float)cos(ang); sinT[i] = (float)sin(ang); }
        }
    }
    SEAM(0);

#pragma unroll 1
    for (int L = 0; L < DEPTH; ++L) {
        const int pb = 1 + 9 * L;
        if (PHM(1) && IN(pb + 0)) {
            PHASE_PTRS;
            pg8::Gemm g{xbA, (const bf16_t*)(Wl + WO_IN), DM}; pg8::StaticOrder S; S.init(NTOK, 2048, G, bx, WGM_P1);
            EpiInProj E{wsp, INF(13) + L * 8, INF(11) + L * 64, INF(12) + L * 64};
            for (int rep_ = 0; rep_ < NREP(1); ++rep_) pg8::gemm_phase<DM, EpiInProj, pg8::StaticOrder, true>(lds, g, S, E);
            if (NULLP(1)) { EpiNull EN{(float*)(wsp + WS_SSX2)}; pg8::gemm_phase<DM, EpiNull, pg8::StaticOrder, true>(lds, g, S, EN); }
        }
        SEAM(pb + 0);
        if (PHM(2) && IN(pb + 1)) {
            PHASE_PTRS;
            { pg8::Gemm g{Qc, (const bf16_t*)(Wl + WO_UQ), 256}; pg8::StaticOrder S; S.init(NTOK, 768, G, bx, WGM_P2);
              EpiQUp E{wsp};
              for (int rep_ = 0; rep_ < NREP(2); ++rep_) pg8::gemm_phase<256, EpiQUp, pg8::StaticOrder, true>(lds, g, S, E); }
            { pg8::Gemm g{Kvc, (const bf16_t*)(Wl + WO_UKV), 128}; pg8::StaticOrder S; S.init(NTOK, 1024, G, bx, WGM_P2);
              EpiKvUp E{wsp, INF(10) + L * 96};
              for (int rep_ = 0; rep_ < NREP(2); ++rep_) pg8::gemm_phase<128, EpiKvUp, pg8::StaticOrder, true>(lds, g, S, E); }
            for (int v = vcu; v < 32; v += G) {
                const int b = v >> 3, h = v & 7; LAS double* wt = (LAS double*)lds;
                const size_t base = ((size_t)b * SEQ + wave * 1024 + lane * 16) * 8 + h; float lv[16]; double loc = 0.0;
#pragma unroll
                for (int i = 0; i < 16; ++i) { lv[i] = logf[base + (size_t)i * 8]; loc += (double)lv[i]; }
                double pre = loc;
#pragma unroll
                for (int o = 1; o < 64; o <<= 1) { const double n = __shfl_up(pre, o); if (lane >= o) pre += n; }
                if (lane == 63) wt[wave] = pre;
                LDS_WAIT(); __syncthreads();
                double run = pre - loc;
                for (int w = 0; w < wave; ++w) run += wt[w];
#pragma unroll
                for (int i = 0; i < 16; ++i) { run += (double)lv[i]; Fc[base + (size_t)i * 8] = (float)run; }
                __syncthreads();
            }
        }
        SEAM(pb + 1);
        if (PHM(3) && IN(pb + 2)) {
            PHASE_PTRS;
            att::Args A{Qraw, Kmla, Vmla, Fq, Fk, Fv, ssqn, ssqr, INF(9) + L * 96, cosT, sinT, Fc, INF(11) + L * 64, INF(12) + L * 64, ob, sso};
#ifdef DIAG_SEL
            LAS float* dg = (L == 0 && blockIdx.x == DIAG_BLOCK && tid == 0) ? (LAS float*)(lds0 + LDSCTL_OFF + 8192) : (LAS float*)nullptr;
            if (dg) for (int k = 0; k < 16; ++k) dg[k] = 0.f;
            att::attn_phase(A, vcu, G, (LAS char*)lds, NREP(10), NREP(11), dg, ctl + CW_FQ + 64 * L, INF(13) + L * 8, (LAS int*)(lds + LDSCTL_OFF + LC_QS));
            if (dg) { float* dw = (float*)(wsp + WS_CTL) + 250000; for (int k = 0; k < 16; ++k) dw[k] = dg[k]; }
#else
            att::attn_phase(A, vcu, G, (LAS char*)lds, NREP(10), NREP(11), (LAS float*)nullptr, ctl + CW_FQ + 64 * L, INF(13) + L * 8, (LAS int*)(lds + LDSCTL_OFF + LC_QS));
#endif
        }
        SEAM(pb + 2);
        if (PHM(4) && IN(pb + 3)) {
            PHASE_PTRS;
            pg8::Gemm g{ob, (const bf16_t*)(Wl + WO_OUT), DM}; pg8::StaticOrder S; S.init(NTOK, DM, G, bx, WGM_P4);
            EpiOut E{wsp, (const float*)nullptr};
            for (int rep_ = 0; rep_ < (L == 0 ? NREP(4) : 1); ++rep_) pg8::gemm_phase<DM, EpiOut, pg8::StaticOrder, true>(lds, g, S, E);
            if (NULLP(4)) { EpiNull EN{(float*)(wsp + WS_SSX2)}; pg8::gemm_phase<DM, EpiNull, pg8::StaticOrder, true>(lds, g, S, EN); }
        }
        SEAM(pb + 3);
        if (PHM(5) && IN(pb + 4)) {
            PHASE_PTRS;
            { pg8::Gemm g{xbB, (const bf16_t*)(Wl + WO_RT), DM}; pg8::StaticOrder S; S.init(NTOK, 256, G, bx);
              EpiRouter E{wsp, ctl + CW_CNT + 1024 * L};
              pg8::gemm_phase<DM, EpiRouter, pg8::StaticOrder, true>(lds, g, S, E); }
            { pg8::Gemm g{pbf + (size_t)L * NTOK * 256, (const bf16_t*)(Wl + WO_PP), 256}; PPOrder S{bx, G};
              EpiPP E{wsp};
              for (int rep_ = 0; rep_ < NREP(5); ++rep_) pg8::gemm_phase<256, EpiPP, PPOrder, true>(lds, g, S, E); }
        }
        SEAM(pb + 4);
        if ((PHM(6) && IN(pb + 5)) || (PHM(7) && IN(pb + 6))) {
            PHASE_PTRS;
            { const int e = tid >> 4, sb = tid & 15; const unsigned c = __hip_atomic_load(ctl + CW_CNT + 1024 * L + tid, RLX_AGENT); suboL[e * (NSUB + 1) + sb + 1] = (int)c; }
            LDS_WAIT(); __syncthreads();
            if (tid < 32) { int run = 0; suboL[tid * (NSUB + 1)] = 0; for (int k = 1; k <= NSUB; ++k) { run += suboL[tid * (NSUB + 1) + k]; suboL[tid * (NSUB + 1) + k] = run; } cntL[tid] = (unsigned)run; }
            LDS_WAIT(); __syncthreads();
            if (tid == 0) { int run = 0; for (int e = 0; e < 32; ++e) { preL[e] = run; run += ((int)cntL[e] + 255) >> 8; } preL[32] = run; }
            LDS_WAIT(); __syncthreads();
        }
        if (PHM(6) && IN(pb + 5)) {
            PHASE_PTRS;
            pg8::Gemm g{xbB, (const bf16_t*)(Wl + WO_GU), DM}; MoeOrder S{preL, cntL, suboL, list, 2, G, vcu, true};
            EpiMoeUp E{wsp, cntL, suboL, 2};
            for (int rep_ = 0; rep_ < NREP(6); ++rep_) pg8::gemm_phase<DM, EpiMoeUp, MoeOrder, true>(lds, g, S, E);
        }
        SEAM(pb + 5);
        if (PHM(7) && IN(pb + 6)) {
            PHASE_PTRS;
            pg8::Gemm g{hid, (const bf16_t*)(Wl + WO_DN), 256}; MoeOrder S{preL, cntL, suboL, list, 4, G, vcu, false};
            EpiMoeDown E{wsp, cntL, suboL, 4};
            pg8::gemm_phase<256, EpiMoeDown, MoeOrder, true>(lds, g, S, E);
        }
        SEAM(pb + 6);
        if (PHM(8) && IN(pb + 7)) {
            PHASE_PTRS;
            for (int m = gw; m < NTOK; m += NGW) { const u32x4* cr = (const u32x4*)(c1 + (size_t)m * DM) + lane; u32x4* xr = (u32x4*)(xbB + (size_t)m * DM) + lane; float s = 0.f;
#pragma unroll
                for (int j = 0; j < 2; ++j) { const u32x4 cw = cr[64 * j], xw = xr[64 * j];
                    const f32x4 v0 = (f32x4){bflo(xw.x), bfhi(xw.x), bflo(xw.y), bfhi(xw.y)} + (f32x4){bflo(cw.x), bfhi(cw.x), bflo(cw.y), bfhi(cw.y)}, v1 = (f32x4){bflo(xw.z), bfhi(xw.z), bflo(xw.w), bfhi(xw.w)} + (f32x4){bflo(cw.z), bfhi(cw.z), bflo(cw.w), bfhi(cw.w)};
                    s += sum4sq(v0) + sum4sq(v1); xr[64 * j] = pack8(v0, v1); }
                s = wave_sum(s); if (lane == 0) ssx2[m] = s; }
        }
        SEAM(pb + 7);
        if (PHM(9) && IN(pb + 8)) {
            PHASE_PTRS;
            pg8::Gemm g{xbB, (const bf16_t*)(Wl + WO_PG), DM}; pg8::StaticOrder S; S.init(NTOK, DM, G, bx, WGM_P4);
            EpiPle E{wsp, INF(26) + L * DM, L + 1 == DEPTH ? xo : (float*)nullptr};
            pg8::gemm_phase<DM, EpiPle, pg8::StaticOrder, true>(lds, g, S, E);
        }
        if (L + 1 < DEPTH) SEAM(pb + 8);
    }
#undef IN
#undef SEAM
#undef INF
}

extern "C" void kernel_launch(void* const* d_in, const int* in_sizes, int n_in, void* d_out, int out_size, void* d_ws, size_t ws_size, hipStream_t stream) {
    static int grid = 0;
    if (grid == 0) {
        if (n_in != 27 || ws_size < WS_END) { fprintf(stderr, "kernel_launch: unexpected inputs (n_in %d, ws %zu)\n", n_in, ws_size); grid = -1; return; }
        int dev = 0, cus = 0, per_cu = 0;
        if (hipGetDevice(&dev) != hipSuccess || hipDeviceGetAttribute(&cus, hipDeviceAttributeMultiprocessorCount, dev) != hipSuccess) { grid = -1; return; }
        if (hipFuncSetAttribute((const void*)mega_fwd, hipFuncAttributeMaxDynamicSharedMemorySize, LDS_BYTES) != hipSuccess) { fprintf(stderr, "kernel_launch: hipFuncSetAttribute failed\n"); grid = -1; return; }
        if (hipOccupancyMaxActiveBlocksPerMultiprocessor(&per_cu, (const void*)mega_fwd, NWAVES * 64, LDS_BYTES) != hipSuccess || per_cu < 1) { fprintf(stderr, "kernel_launch: occupancy query says %d\n", per_cu); }
        (void)hipGetLastError();
        grid = cus;
    }
    if (grid < 0) return;
    if (hipMemsetAsync((char*)d_ws + WS_CTL, 0, CTL_ZERO_BYTES, stream) != hipSuccess) return;
    KArgs a{};
    for (int i = 0; i < 27; ++i) a.in[i] = d_in[i];
    a.out = (float*)d_out; a.ws = (unsigned char*)d_ws;
    const int cuts[] = MK_CUTS; const int nl = (int)(sizeof(cuts) / sizeof(int)) - 1;
    for (int li = 0; li < nl; ++li) {
        a.ph_lo = cuts[li]; a.ph_hi = cuts[li + 1]; a.li = li; a.pad = 0;
        hipLaunchKernelGGL(mega_fwd, dim3(grid), dim3(NWAVES * 64), LDS_BYTES, stream, a);
        if (hipPeekAtLastError() != hipSuccess) { fprintf(stderr, "kernel_launch: launch %d failed\n", li); break; }
    }
}
```

```cpp
#include <hip/hip_runtime.h>
#include <cstdio>
#include <cstdint>

#define LAS __attribute__((address_space(3)))
#define GAS __attribute__((address_space(1)))
typedef unsigned short bf16_t;
typedef short bf16x8 __attribute__((ext_vector_type(8)));
typedef short s16x4 __attribute__((ext_vector_type(4)));
typedef float f32x2 __attribute__((ext_vector_type(2)));
typedef float f32x4 __attribute__((ext_vector_type(4)));
typedef float f32x16 __attribute__((ext_vector_type(16)));
typedef unsigned u32x2 __attribute__((ext_vector_type(2)));
typedef unsigned u32x4 __attribute__((ext_vector_type(4)));

constexpr int DM = 1024, NB = 4, SEQ = 8192, NTOK = NB * SEQ, DEPTH = 2;
constexpr int INC = 1960, NEXP = 32;
constexpr int C_KVC = 256, C_KPE = 384, C_FQ = 416, C_FK = 928, C_FV = 1440, C_FL = 1952;
constexpr float EPS = 1e-6f;
constexpr float LOG2E = 1.4426950408889634f;
constexpr float C2_FOX = 0.125f * LOG2E;
constexpr float C2_MLA = 0.10206207261596575f * LOG2E;

__device__ __forceinline__ unsigned cvt_pk_bf16(float lo, float hi) { unsigned r; asm volatile("v_cvt_pk_bf16_f32 %0, %1, %2" : "=v"(r) : "v"(lo), "v"(hi)); return r; }
__device__ __forceinline__ float bf2f(unsigned short u) { return __uint_as_float((unsigned)u << 16); }
__device__ __forceinline__ float bflo(unsigned w) { return __uint_as_float(w << 16); }
__device__ __forceinline__ float bfhi(unsigned w) { return __uint_as_float(w & 0xffff0000u); }
__device__ __forceinline__ u32x4 pack8(const f32x4& a, const f32x4& b) { u32x4 w; w.x = cvt_pk_bf16(a[0], a[1]); w.y = cvt_pk_bf16(a[2], a[3]); w.z = cvt_pk_bf16(b[0], b[1]); w.w = cvt_pk_bf16(b[2], b[3]); return w; }

__device__ __forceinline__ void st16(void* p, const u32x4& v) { asm volatile("global_store_dwordx4 %0, %1, off sc1" :: "v"(p), "v"(v) : "memory"); }
__device__ __forceinline__ void st8(void* p, const u32x2& v) { asm volatile("global_store_dwordx2 %0, %1, off sc1" :: "v"(p), "v"(v) : "memory"); }
__device__ __forceinline__ void st16f(void* p, const f32x4& v) { asm volatile("global_store_dwordx4 %0, %1, off sc1" :: "v"(p), "v"(v) : "memory"); }
__device__ __forceinline__ float sum4sq(const f32x4& a) { return (a[0] * a[0] + a[1] * a[1]) + (a[2] * a[2] + a[3] * a[3]); }
__device__ __forceinline__ float red_fq(float s) { s += __shfl_xor(s, 16); s += __shfl_xor(s, 32); return s; }
__device__ __forceinline__ float sum16(const float* p) { const f32x4 a = *(const f32x4*)p, b = *(const f32x4*)(p + 4), c = *(const f32x4*)(p + 8), d = *(const f32x4*)(p + 12);
    return ((a[0] + a[1]) + (a[2] + a[3])) + ((b[0] + b[1]) + (b[2] + b[3])) + ((c[0] + c[1]) + (c[2] + c[3])) + ((d[0] + d[1]) + (d[2] + d[3])); }
__device__ __forceinline__ float sum8(const float* p) { const f32x4 a = *(const f32x4*)p, b = *(const f32x4*)(p + 4); return ((a[0] + a[1]) + (a[2] + a[3])) + ((b[0] + b[1]) + (b[2] + b[3])); }
__device__ __forceinline__ float log_sigmoid_f(float x) {
    const float y = __builtin_amdgcn_exp2f(-fabsf(x) * LOG2E);
    const float ser = y * (1.f - y * (0.5f - y * (0.33333334f - 0.25f * y)));
    const float lg = __builtin_amdgcn_logf(1.f + y) * 0.6931471805599453f;
    return -(fmaxf(-x, 0.f) + (y < 0.015625f ? ser : lg));
}

constexpr int NWAVES = 8;
constexpr size_t MiB = 1u << 20;
constexpr size_t WS_CTL = 0, CTL_ZERO_BYTES = 1 * MiB;
constexpr size_t WS_SSX0 = 1 * MiB, WS_SSX1 = 3 * MiB, WS_SSPP = 5 * MiB, WS_SSO = 7 * MiB, WS_SSX2 = 9 * MiB, WS_SSKPE = 10 * MiB, WS_SSQQ = 11 * MiB, WS_SSQKV = 12 * MiB,
                 WS_GATE = 13 * MiB, WS_LOGF = 14 * MiB, WS_F = 15 * MiB, WS_SSQN = 16 * MiB, WS_SSQR = 17 * MiB, WS_COS = 18 * MiB, WS_SIN = 20 * MiB, WS_LIST = 22 * MiB;
constexpr size_t WS_W = 28 * MiB, W_LAYER = 58 * MiB;
constexpr size_t WO_IN = 0, WO_UQ = 4 * MiB, WO_UKV = 4 * MiB + 512 * 1024, WO_OUT = 5 * MiB, WO_RT = 7 * MiB, WO_PG = 7 * MiB + 512 * 1024, WO_PP = 9 * MiB + 512 * 1024, WO_GU = 10 * MiB, WO_DN = 42 * MiB;
constexpr size_t WS_XBA = 144 * MiB, WS_XBB = 208 * MiB, WS_PBF = 272 * MiB, WS_MIX = 304 * MiB;
constexpr size_t WS_O = WS_XBA, WS_QRAW = WS_XBB;
constexpr size_t WS_QC = WS_MIX, WS_KVC = WS_MIX + 16 * MiB, WS_KPE = WS_MIX + 24 * MiB, WS_FQ = WS_MIX + 26 * MiB, WS_FK = WS_MIX + 58 * MiB, WS_FV = WS_MIX + 90 * MiB, WS_KMLA = WS_MIX + 122 * MiB, WS_VMLA = WS_MIX + 170 * MiB;
constexpr size_t WS_PP = WS_MIX, WS_HID = WS_MIX + 64 * MiB, WS_C1 = WS_MIX + 100 * MiB;
constexpr size_t WS_END = 512 * MiB;
static_assert(WS_VMLA + 32 * MiB <= WS_END && WS_C1 + 64 * MiB <= WS_END && WS_W + 2 * W_LAYER <= WS_XBA, "d_ws map");
constexpr int HID_ROWS = 2 * NTOK + NEXP * 256;
static_assert((size_t)HID_ROWS * 256 * 2 <= 36 * MiB, "hid");

constexpr int NSUB = 256, SUBCAP = 128;
__device__ __forceinline__ int list_at(const int* list, const LAS unsigned short* subo, int e, int li) {
    const LAS unsigned short* so = subo + e * (NSUB + 1); int sidx = 0;
#pragma unroll
    for (int step = NSUB / 2; step >= 1; step >>= 1) sidx += ((int)so[sidx + step] <= li) ? step : 0;
    return list[(size_t)(e * NSUB + sidx) * SUBCAP + (li - (int)so[sidx])];
}
namespace pg8 {
constexpr int TAB_OFF = 131072 + 1024;
constexpr int BM = 256, BK = 64, HALF = 128, HTB = HALF * BK * 2, STAGE_BYTES = 8 * HTB, NXCD = 8, WGM = 8;
__host__ __device__ __forceinline__ int lds_byte(int r, int c) { const int st = (r >> 4) * 2 + (c >> 5), rr = r & 15, cc = c & 31, ob = rr * 64 + cc * 2; return st * 1024 + (ob ^ (((ob >> 9) & 1) << 5)); }
__host__ __device__ __forceinline__ void stage_rc(int b, int& R, int& C) { const int st = b / 1024, sb = b % 1024, swz = sb ^ (((sb >> 9) & 1) << 5); R = (st >> 1) * 16 + swz / 64; C = (st & 1) * 32 + (swz % 64) / 2; }
__host__ __device__ __forceinline__ int perm32(int rho) { const int n = rho >> 4, i = rho & 15; return 8 * (i >> 2) + 4 * n + (i & 3); }

struct Unit { int pm, pn, e, blk; };
struct Gemm { const bf16_t* A; const bf16_t* Bt; int K; };

struct StaticOrder {
    int nM, nN, nwg, G, c, wgm;
    __device__ void init(int M, int N, int G_, int c_, int wgm_ = 16) { nM = M / BM; nN = N / BM; nwg = nM * nN; G = G_; c = c_; wgm = wgm_; }
    __device__ bool next(int i, Unit& u) const {
        const long L = (long)i * G + c; if (L >= nwg) return false;
        int wgid = (int)L; { const int q = nwg / NXCD, r = nwg % NXCD, xcd = wgid % NXCD, off = wgid / NXCD; wgid = (xcd < r ? xcd * (q + 1) : r * (q + 1) + (xcd - r) * q) + off; }
        const int nig = wgm * nN, gid = wgid / nig, fm = gid * wgm, gsz = (nM - fm) < wgm ? (nM - fm) : wgm;
        u.pm = fm + ((wgid % nig) % gsz); u.pn = (wgid % nig) / gsz; u.e = 0; u.blk = 0; return true;
    }
    __device__ __forceinline__ int arow(const Unit& u, int r) const { return u.pm * BM + r; }
};

template <int K, class Epi, class Sched, bool ALIGN_EPI>
__device__ __forceinline__ void gemm_phase(LAS unsigned char* lds, const Gemm g, const Sched& S, const Epi& E) {
    LAS f32x2* const tab0 = (LAS f32x2*)(lds + TAB_OFF);
    int tid_ = threadIdx.x; asm volatile("" : "+v"(tid_));
    const int tid = tid_, wid = __builtin_amdgcn_readfirstlane(tid >> 6), lane = tid & 63, wr = wid >> 2, wc = wid & 3, fr = lane & 15, fq = lane >> 4;
    int Kr = K; asm volatile("" : "+s"(Kr));
    const int nt = Kr / BK;
    unsigned voffB[2];
#pragma unroll
    for (int i = 0; i < 2; ++i) { int R_, C_; stage_rc(tid * 16 + i * 8192, R_, C_); const int Rb = (R_ & ~31) + perm32(R_ & 31); voffB[i] = (unsigned)(Rb * Kr + C_) * 2u; }
    const size_t kstep = (size_t)(BK * 2);
    const size_t hstep = (size_t)HALF * Kr * 2;
    const size_t tstep = 2 * hstep;
    const unsigned ldsw = (unsigned)wid * 1024u;
    const int aoff = lds_byte(wr * 64 + fr, fq * 8), boff = lds_byte(wc * 32 + fr, fq * 8);
#define PG8_SA(b, h) (((b) * 2 + (h)) * HTB)
#define PG8_SB(b, h) ((4 + (b) * 2 + (h)) * HTB)
#define PG8_STAGE(bufoff, gbase, voff) do { _Pragma("unroll") for (int _i = 0; _i < 2; ++_i) \
        __builtin_amdgcn_global_load_lds((const unsigned*)((const char*)(gbase) + (voff)[_i]), (LAS unsigned*)(lds + (bufoff) + ldsw + _i * 8192), 16, 0, 0); } while (0)
#define PG8_LDA(dst, b, h) do { _Pragma("unroll") for (int m = 0; m < 4; ++m) _Pragma("unroll") for (int k = 0; k < 2; ++k) dst[m][k] = *(const LAS bf16x8*)(lds + PG8_SA(b, h) + aoff + m * 2048 + k * 1024); } while (0)
#define PG8_LDB(dst, b, h) do { _Pragma("unroll") for (int n = 0; n < 2; ++n) _Pragma("unroll") for (int k = 0; k < 2; ++k) dst[n][k] = *(const LAS bf16x8*)(lds + PG8_SB(b, h) + boff + n * 2048 + k * 1024); } while (0)
#define PG8_MMA(ai, bj, At, Bt) do { __builtin_amdgcn_s_setprio(1); _Pragma("unroll") for (int m = 0; m < 4; ++m) _Pragma("unroll") for (int n = 0; n < 2; ++n) _Pragma("unroll") for (int k = 0; k < 2; ++k) \
        acc[ai][bj][m][n] = __builtin_amdgcn_mfma_f32_16x16x32_bf16(Bt[n][k], At[m][k], acc[ai][bj][m][n], 0, 0, 0); __builtin_amdgcn_s_setprio(0); } while (0)
#define PG8_WAIT_V(n) asm volatile("s_waitcnt vmcnt(" #n ")" ::: "memory")
#define PG8_WAIT_L(n) asm volatile("s_waitcnt lgkmcnt(" #n ")" ::: "memory")
#define PG8_BAR __builtin_amdgcn_s_barrier()
#define PG8_SCHED __builtin_amdgcn_sched_barrier(0)
#define PG8_AOFF(dst, u) do { int _t = tid; asm volatile("" : "+v"(_t)); _Pragma("unroll") for (int _i = 0; _i < 2; ++_i) { int _R, _C; stage_rc(_t * 16 + _i * 8192, _R, _C); _Pragma("unroll") for (int _h = 0; _h < 2; ++_h) dst[_h][_i] = ((unsigned)S.arow(u, _h * HALF + _R) * (unsigned)Kr + (unsigned)_C) * 2u; } } while (0)
    Unit cur, nxt; int ui = 0;
    if (!S.next(0, cur)) return;
    f32x4 acc[2][2][4][2];
#pragma unroll
    for (int a = 0; a < 2; ++a)
#pragma unroll
        for (int b = 0; b < 2; ++b)
#pragma unroll
            for (int m = 0; m < 4; ++m)
#pragma unroll
                for (int n = 0; n < 2; ++n) acc[a][b][m][n] = (f32x4){0.f, 0.f, 0.f, 0.f};
    bf16x8 At[4][2], B0[2][2], B1[2][2];
    unsigned ca[2][2], na[2][2];
    PG8_AOFF(ca, cur);
    const char* gA = (const char*)g.A;
    const char* cB = (const char*)g.Bt + (size_t)cur.pn * tstep;
    PG8_STAGE(PG8_SB(0, 0), cB, voffB); PG8_STAGE(PG8_SB(0, 1), cB + hstep, voffB); PG8_STAGE(PG8_SA(0, 0), gA, ca[0]); PG8_STAGE(PG8_SA(0, 1), gA, ca[1]);
    if (wr == 1) PG8_BAR;
    PG8_WAIT_V(2); PG8_BAR;
    PG8_STAGE(PG8_SB(1, 0), cB + kstep, voffB); PG8_STAGE(PG8_SA(1, 0), gA + kstep, ca[0]); PG8_STAGE(PG8_SB(1, 1), cB + hstep + kstep, voffB);
    PG8_WAIT_V(6); PG8_BAR;
    for (;;) {
        const bool has_next = S.next(ui + 1, nxt);
        E.pre(cur, tab0 + (ui & 1) * 256, tid);
        if (has_next) { PG8_AOFF(na, nxt); } else {
#pragma unroll
            for (int _h = 0; _h < 2; ++_h)
#pragma unroll
                for (int _i = 0; _i < 2; ++_i) na[_h][_i] = ca[_h][_i]; }
        const char* nB = has_next ? (const char*)g.Bt + (size_t)nxt.pn * tstep : cB;
        for (int t = 0; t < nt; t += 2) {
            const bool last = (t == nt - 2);
            if constexpr (Epi::HAS_MID) { if (t == nt / 2) E.mid(acc, cur, wr, wc, fr, fq, tab0 + (ui & 1) * 256); }
            const char* a1 = gA + (size_t)(t + 1) * kstep;
            const char* a2 = last ? gA : gA + (size_t)(t + 2) * kstep; const char* b2 = last ? nB : cB + (size_t)(t + 2) * kstep;
            const char* a3 = a2 + kstep; const char* b3 = b2 + kstep;
            unsigned o2[2][2];
#pragma unroll
            for (int _h = 0; _h < 2; ++_h)
#pragma unroll
                for (int _i = 0; _i < 2; ++_i) o2[_h][_i] = last ? na[_h][_i] : ca[_h][_i];
            PG8_LDB(B0, 0, 0); PG8_LDB(B1, 0, 1); PG8_SCHED; PG8_LDA(At, 0, 0); PG8_STAGE(PG8_SA(1, 1), a1, ca[1]);
            PG8_WAIT_V(8); PG8_WAIT_L(0); PG8_BAR; PG8_MMA(0, 0, At, B0); PG8_MMA(0, 1, At, B1); PG8_BAR; PG8_SCHED;
            PG8_LDA(At, 0, 1); PG8_STAGE(PG8_SB(0, 0), b2, voffB); PG8_STAGE(PG8_SB(0, 1), b2 + hstep, voffB); PG8_STAGE(PG8_SA(0, 0), a2, o2[0]);
            PG8_WAIT_V(8); PG8_WAIT_L(0); PG8_BAR; PG8_MMA(1, 0, At, B0); PG8_MMA(1, 1, At, B1); PG8_BAR; PG8_SCHED;
            PG8_LDB(B0, 1, 0); PG8_LDB(B1, 1, 1); PG8_SCHED; PG8_LDA(At, 1, 0); PG8_STAGE(PG8_SA(0, 1), a2, o2[1]);
            PG8_WAIT_V(8); PG8_WAIT_L(0); PG8_BAR; PG8_MMA(0, 0, At, B0); PG8_MMA(0, 1, At, B1); PG8_BAR; PG8_SCHED;
            PG8_LDA(At, 1, 1); PG8_STAGE(PG8_SB(1, 0), b3, voffB); PG8_STAGE(PG8_SB(1, 1), b3 + hstep, voffB); PG8_STAGE(PG8_SA(1, 0), a3, o2[0]);
            PG8_WAIT_V(8); PG8_WAIT_L(0); PG8_BAR; PG8_MMA(1, 0, At, B0); PG8_MMA(1, 1, At, B1); PG8_BAR; PG8_SCHED;
        }
        if constexpr (ALIGN_EPI) { if (wr == 0) PG8_BAR; }
        E(acc, cur, wr, wc, fr, fq, tab0 + (ui & 1) * 256);
        if (!has_next) break;
#pragma unroll
        for (int a = 0; a < 2; ++a)
#pragma unroll
            for (int b = 0; b < 2; ++b)
#pragma unroll
                for (int m = 0; m < 4; ++m)
#pragma unroll
                    for (int n = 0; n < 2; ++n) acc[a][b][m][n] = (f32x4){0.f, 0.f, 0.f, 0.f};
        cur = nxt; cB = nB; ++ui;
#pragma unroll
        for (int _h = 0; _h < 2; ++_h)
#pragma unroll
            for (int _i = 0; _i < 2; ++_i) ca[_h][_i] = na[_h][_i];
        if constexpr (ALIGN_EPI) { if (wr == 1) PG8_BAR; }
    }
    PG8_WAIT_V(0);
    if constexpr (!ALIGN_EPI) { if (wr == 0) PG8_BAR; }
    PG8_BAR;
#undef PG8_SA
#undef PG8_SB
#undef PG8_STAGE
#undef PG8_LDA
#undef PG8_LDB
#undef PG8_MMA
#undef PG8_WAIT_V
#undef PG8_WAIT_L
#undef PG8_BAR
#undef PG8_SCHED
#undef PG8_AOFF
}
}
using pg8::Unit;
typedef f32x4 AccT[2][2][4][2];
#define EPI_ROWS8(...) _Pragma("unroll") for (int ai = 0; ai < 2; ++ai) _Pragma("unroll") for (int m = 0; m < 4; ++m) { const int rl = ai * 128 + wr * 64 + m * 16 + fr; const int row = u.pm * 256 + rl; (void)row; __VA_ARGS__ }
#define EPI_ROWS4(...) _Pragma("unroll") for (int ai = 0; ai < 2; ++ai) _Pragma("unroll") for (int m = 0; m < 4; ++m) { const int rl = ai * 128 + wr * 64 + m * 16 + fr; const int row = u.pm * 256 + rl; (void)row; __VA_ARGS__ if (m == 3) asm volatile("" ::: "memory"); }
#define EPI_ROWS(...) _Pragma("unroll") for (int ai = 0; ai < 2; ++ai) _Pragma("unroll") for (int m = 0; m < 4; ++m) { const int rl = ai * 128 + wr * 64 + m * 16 + fr; const int row = u.pm * 256 + rl; (void)row; __VA_ARGS__ if (m & 1) asm volatile("" ::: "memory"); }

struct EpiInProj {
    static constexpr bool HAS_MID = false;
    unsigned char* ws; const float *bfox, *gfq, *gfk;
    __device__ __forceinline__ void pre(const Unit& u, LAS f32x2* tab, int tid) const { if (tid < 256) { const float* ssx = (const float*)(ws + WS_SSX0); tab[tid] = (f32x2){rsqrtf(sum16(ssx + (size_t)(u.pm * 256 + tid) * 16) * (1.f / 1024.f) + EPS), 0.f}; } }
    __device__ __forceinline__ void mid(AccT&, const Unit&, int, int, int, int, const LAS f32x2*) const {}
    __device__ __forceinline__ void operator()(const AccT& acc, const Unit& u, int wr, int wc, int fr, int fq, const LAS f32x2* tab) const {
        asm volatile("" : "+v"(fr), "+v"(fq));
        const int pn = u.pn;
        const float* ssx = (const float*)(ws + WS_SSX0); bf16_t* Qc = (bf16_t*)(ws + WS_QC); bf16_t* Kvc = (bf16_t*)(ws + WS_KVC); bf16_t* Kpe = (bf16_t*)(ws + WS_KPE);
        float* ssq_q = (float*)(ws + WS_SSQQ); float* ssq_kv = (float*)(ws + WS_SSQKV); float* ss_kpe = (float*)(ws + WS_SSKPE); float* logf = (float*)(ws + WS_LOGF);
        if (pn == 0) {
            EPI_ROWS({ const float rinv = tab[rl].x; float s = 0.f;
_Pragma("unroll")
                for (int bj = 0; bj < 2; ++bj) { const f32x4 v0 = acc[ai][bj][m][0] * rinv, v1 = acc[ai][bj][m][1] * rinv; s += sum4sq(v0) + sum4sq(v1);
                    *(u32x4*)(Qc + (size_t)row * 256 + bj * 128 + wc * 32 + fq * 8) = pack8(v0, v1); }
                s = red_fq(s); if (fq == 0) ssq_q[(size_t)row * 4 + wc] = s; })
        } else if (pn == 1) {
            EPI_ROWS({ const float rinv = tab[rl].x;
                if (wc < 2) { float s = 0.f;
_Pragma("unroll")
                    for (int bj = 0; bj < 2; ++bj) { const f32x4 v0 = acc[ai][bj][m][0] * rinv, v1 = acc[ai][bj][m][1] * rinv; s += sum4sq(v0) + sum4sq(v1);
                        *(u32x4*)(Kvc + (size_t)row * 128 + wc * 64 + bj * 32 + fq * 8) = pack8(v0, v1); }
                    s = red_fq(s); if (fq == 0) ssq_kv[(size_t)row * 2 + wc] = s;
                } else if (wc == 2) { const f32x4 v0 = acc[ai][0][m][0] * rinv, v1 = acc[ai][0][m][1] * rinv; float s = sum4sq(v0) + sum4sq(v1);
                    *(u32x4*)(Kpe + (size_t)row * 32 + fq * 8) = pack8(v0, v1);
                    s = red_fq(s); if (fq == 0) ss_kpe[row] = s;
                } else { if (fq == 0) { const f32x4 v0 = acc[ai][0][m][0] * rinv, v1 = acc[ai][0][m][1] * rinv; const f32x4 b0 = *(const f32x4*)bfox, b1 = *(const f32x4*)(bfox + 4); f32x4 o0, o1;
_Pragma("unroll")
                        for (int i = 0; i < 4; ++i) { o0[i] = log_sigmoid_f(v0[i] + b0[i]); o1[i] = log_sigmoid_f(v1[i] + b1[i]); }
                        *(f32x4*)(logf + (size_t)row * 8) = o0; *(f32x4*)(logf + (size_t)row * 8 + 4) = o1; } } })
        } else {
            const int kind = (pn - 2) >> 1, head = 4 * ((pn - 2) & 1) + wc;
            bf16_t* dst = (bf16_t*)(ws + (kind == 0 ? WS_FQ : (kind == 1 ? WS_FK : WS_FV))); const float* g = kind == 0 ? gfq : gfk; const float osc = kind == 0 ? C2_FOX : 1.f;
            f32x4 g4[2][2];
_Pragma("unroll")
            for (int bj = 0; bj < 2; ++bj)
_Pragma("unroll")
                for (int n = 0; n < 2; ++n) g4[bj][n] = kind < 2 ? *(const f32x4*)(g + bj * 32 + fq * 8 + n * 4) * osc : (f32x4){1.f, 1.f, 1.f, 1.f};
            EPI_ROWS({ const float rinv = tab[rl].x; f32x4 v[2][2]; float s = 0.f;
_Pragma("unroll")
                for (int bj = 0; bj < 2; ++bj)
_Pragma("unroll")
                    for (int n = 0; n < 2; ++n) { v[bj][n] = acc[ai][bj][m][n] * rinv; s += sum4sq(v[bj][n]); }
                s = red_fq(s); const float hr = kind < 2 ? rsqrtf(s * (1.f / 64.f) + EPS) : 1.f;
_Pragma("unroll")
                for (int bj = 0; bj < 2; ++bj) { const int bb = row >> 13, tl = (row >> 6) & 127, r = row & 63; const size_t tb = ((size_t)(bb * 8 + head) * 128 + tl) * 4096;
                    const size_t off = kind == 0 ? (size_t)row * 512 + head * 64 + bj * 32 + fq * 8 : (kind == 1 ? tb + (4 * bj + fq) * 512 + r * 8 : tb + (bj * 4 + (r >> 4)) * 512 + (r & 15) * 32 + fq * 8);
                    *(u32x4*)(dst + off) = pack8(v[bj][0] * hr * g4[bj][0], v[bj][1] * hr * g4[bj][1]); } })
        }
    }
};
struct EpiQUp {
    static constexpr bool HAS_MID = false;
    unsigned char* ws;
    __device__ __forceinline__ void pre(const Unit& u, LAS f32x2* tab, int tid) const { if (tid < 256) { const f32x4 sq = *(const f32x4*)((const float*)(ws + WS_SSQQ) + (size_t)(u.pm * 256 + tid) * 4); tab[tid] = (f32x2){rsqrtf(((sq[0] + sq[1]) + (sq[2] + sq[3])) * (1.f / 256.f) + EPS), 0.f}; } }
    __device__ __forceinline__ void mid(AccT&, const Unit&, int, int, int, int, const LAS f32x2*) const {}
    __device__ __forceinline__ void operator()(const AccT& acc, const Unit& u, int wr, int wc, int fr, int fq, const LAS f32x2* tab) const {
        asm volatile("" : "+v"(fr), "+v"(fq));
        const int pn = u.pn;
        const float* ssq_q = (const float*)(ws + WS_SSQQ); bf16_t* Qraw = (bf16_t*)(ws + WS_QRAW); float* ssq_qn = (float*)(ws + WS_SSQN); float* ssq_qr = (float*)(ws + WS_SSQR);
        EPI_ROWS({ const float rinv = tab[rl].x;
            if (pn < 2) { const int head = 4 * pn + wc; float s = 0.f;
_Pragma("unroll")
                for (int bj = 0; bj < 2; ++bj) { const f32x4 v0 = acc[ai][bj][m][0] * rinv, v1 = acc[ai][bj][m][1] * rinv; s += sum4sq(v0) + sum4sq(v1);
                    *(u32x4*)(Qraw + (size_t)row * 768 + head * 96 + bj * 32 + fq * 8) = pack8(v0, v1); }
                s = red_fq(s); if (fq == 0) ssq_qn[(size_t)row * 8 + head] = s;
            } else {
_Pragma("unroll")
                for (int bj = 0; bj < 2; ++bj) { const int head = 4 * bj + wc; const f32x4 v0 = acc[ai][bj][m][0] * rinv, v1 = acc[ai][bj][m][1] * rinv; float s = sum4sq(v0) + sum4sq(v1);
                    *(u32x4*)(Qraw + (size_t)row * 768 + head * 96 + 64 + fq * 8) = pack8(v0, v1);
                    s = red_fq(s); if (fq == 0) ssq_qr[(size_t)row * 8 + head] = s; }
            } })
    }
};
struct EpiKvUp {
    static constexpr bool HAS_MID = false;
    unsigned char* ws; const float* gk;
    __device__ __forceinline__ void pre(const Unit& u, LAS f32x2* tab, int tid) const { if (tid < 256) { const size_t r = (size_t)(u.pm * 256 + tid); const f32x2 sk = *(const f32x2*)((const float*)(ws + WS_SSQKV) + r * 2); tab[tid] = (f32x2){rsqrtf((sk[0] + sk[1]) * (1.f / 128.f) + EPS), ((const float*)(ws + WS_SSKPE))[r]}; } }
    __device__ __forceinline__ void mid(AccT&, const Unit&, int, int, int, int, const LAS f32x2*) const {}
    __device__ __forceinline__ void operator()(const AccT& acc, const Unit& u, int wr, int wc, int fr, int fq, const LAS f32x2* tab) const {
        asm volatile("" : "+v"(fr), "+v"(fq));
        const int pn = u.pn;
        const float* ssq_kv = (const float*)(ws + WS_SSQKV); const float* ss_kpe = (const float*)(ws + WS_SSKPE); const bf16_t* Kpe = (const bf16_t*)(ws + WS_KPE);
        const float* cosT = (const float*)(ws + WS_COS); const float* sinT = (const float*)(ws + WS_SIN); bf16_t* Kmla = (bf16_t*)(ws + WS_KMLA); bf16_t* Vmla = (bf16_t*)(ws + WS_VMLA);
        if (pn < 2) {
            const int head = 4 * pn + wc;
            f32x4 g4[2][2];
_Pragma("unroll")
            for (int bj = 0; bj < 2; ++bj)
_Pragma("unroll")
                for (int n = 0; n < 2; ++n) g4[bj][n] = *(const f32x4*)(gk + bj * 32 + fq * 8 + n * 4);
            const f32x4 gr1 = *(const f32x4*)(gk + 64 + 4 * fq), gr2 = *(const f32x4*)(gk + 80 + 4 * fq);
            EPI_ROWS4({ const f32x2 tt = tab[rl]; const float rinv = tt.x; f32x4 v[2][2]; float s = 0.f;
_Pragma("unroll")
                for (int bj = 0; bj < 2; ++bj)
_Pragma("unroll")
                    for (int n = 0; n < 2; ++n) { v[bj][n] = acc[ai][bj][m][n] * rinv; s += sum4sq(v[bj][n]); }
                s = red_fq(s) + tt.y; const float hr = rsqrtf(s * (1.f / 96.f) + EPS);
                const int bb = row >> 13, tl = (row >> 6) & 127, r = row & 63; bf16_t* kd = Kmla + ((size_t)(bb * 8 + head) * 128 + tl) * 6144 + r * 8;
_Pragma("unroll")
                for (int bj = 0; bj < 2; ++bj) *(u32x4*)(kd + (4 * bj + fq) * 512) = pack8(v[bj][0] * hr * g4[bj][0], v[bj][1] * hr * g4[bj][1]);
                const u32x2 p1 = *(const u32x2*)(Kpe + (size_t)row * 32 + 4 * fq), p2 = *(const u32x2*)(Kpe + (size_t)row * 32 + 16 + 4 * fq);
                const f32x4 c = *(const f32x4*)(cosT + (size_t)row * 16 + 4 * fq), sn = *(const f32x4*)(sinT + (size_t)row * 16 + 4 * fq);
                const f32x4 x1 = (f32x4){bflo(p1.x), bfhi(p1.x), bflo(p1.y), bfhi(p1.y)} * hr * gr1, x2 = (f32x4){bflo(p2.x), bfhi(p2.x), bflo(p2.y), bfhi(p2.y)} * hr * gr2;
                const f32x4 o1 = x1 * c - x2 * sn, o2 = x2 * c + x1 * sn;
                u32x2 w1, w2; w1.x = cvt_pk_bf16(o1[0], o1[1]); w1.y = cvt_pk_bf16(o1[2], o1[3]); w2.x = cvt_pk_bf16(o2[0], o2[1]); w2.y = cvt_pk_bf16(o2[2], o2[3]);
                *(u32x2*)(kd + (8 + (fq >> 1)) * 512 + 4 * (fq & 1)) = w1; *(u32x2*)(kd + (10 + (fq >> 1)) * 512 + 4 * (fq & 1)) = w2; })
        } else {
            const int head = 4 * (pn - 2) + wc;
            EPI_ROWS({ const f32x2 tt = tab[rl]; const float rinv = tt.x;
_Pragma("unroll")
                for (int bj = 0; bj < 2; ++bj) { const int bb = row >> 13, tl = (row >> 6) & 127, r = row & 63;
                    *(u32x4*)(Vmla + ((size_t)(bb * 8 + head) * 128 + tl) * 4096 + (bj * 4 + (r >> 4)) * 512 + (r & 15) * 32 + fq * 8) = pack8(acc[ai][bj][m][0] * rinv, acc[ai][bj][m][1] * rinv); } })
        }
    }
};
struct EpiOut {
    static constexpr bool HAS_MID = true;
    unsigned char* ws; const float* base;
    __device__ __forceinline__ void pre(const Unit& u, LAS f32x2* tab, int tid) const { if (tid < 256) { const float* sso = (const float*)(ws + WS_SSO) + (size_t)(u.pm * 256 + tid) * 16;
        const float rm = rsqrtf(sum8(sso) * (1.f / 512.f) + EPS), rf = rsqrtf(sum8(sso + 8) * (1.f / 512.f) + EPS); tab[tid] = (f32x2){rm / rf, rf}; } }
    __device__ __forceinline__ void mid(AccT& acc, const Unit& u, int wr, int wc, int fr, int fq, const LAS f32x2* tab) const {
        EPI_ROWS({ const float ratio = tab[rl].x;
_Pragma("unroll")
            for (int bj = 0; bj < 2; ++bj)
_Pragma("unroll")
                for (int n = 0; n < 2; ++n) acc[ai][bj][m][n] *= ratio; })
    }
    __device__ __forceinline__ void operator()(const AccT& acc, const Unit& u, int wr, int wc, int fr, int fq, const LAS f32x2* tab) const {
        asm volatile("" : "+v"(fr), "+v"(fq));
        bf16_t* xb = (bf16_t*)(ws + WS_XBB); const bf16_t* xa = (const bf16_t*)(ws + WS_XBA); float* ssx1 = (float*)(ws + WS_SSX1);
        EPI_ROWS8({ const float rf = tab[rl].y; float s = 0.f;
_Pragma("unroll")
            for (int bj = 0; bj < 2; ++bj) { const size_t off = (size_t)row * 1024 + u.pn * 256 + bj * 128 + wc * 32 + fq * 8; f32x4 b0, b1;
                { const u32x4 w = *(const u32x4*)(xa + off); b0 = (f32x4){bflo(w.x), bfhi(w.x), bflo(w.y), bfhi(w.y)}; b1 = (f32x4){bflo(w.z), bfhi(w.z), bflo(w.w), bfhi(w.w)}; }
                const f32x4 v0 = b0 + acc[ai][bj][m][0] * rf, v1 = b1 + acc[ai][bj][m][1] * rf; s += sum4sq(v0) + sum4sq(v1);
                *(u32x4*)(xb + off) = pack8(v0, v1); }
            s = red_fq(s); if (fq == 0) ssx1[(size_t)row * 16 + u.pn * 4 + wc] = s; })
    }
};
struct EpiRouter {
    static constexpr bool HAS_MID = false;
    unsigned char* ws; unsigned* cnt; LAS unsigned* lc;
    __device__ __forceinline__ void pre(const Unit& u, LAS f32x2* tab, int tid) const { if (tid < 256) { const float* ssx1 = (const float*)(ws + WS_SSX1); tab[tid] = (f32x2){rsqrtf(sum16(ssx1 + (size_t)(u.pm * 256 + tid) * 16) * (1.f / 1024.f) + EPS), 0.f}; } }
    __device__ __forceinline__ void mid(AccT&, const Unit&, int, int, int, int, const LAS f32x2*) const {}
    __device__ __forceinline__ void operator()(const AccT& acc, const Unit& u, int wr, int wc, int fr, int fq, const LAS f32x2* tab) const {
        asm volatile("" : "+v"(fr), "+v"(fq));
        if (wc != 0) return;
        float* gate = (float*)(ws + WS_GATE); int* list = (int*)(ws + WS_LIST);
        LAS unsigned* lcw = lc + wr * 32; const int lane_ = fr + 16 * fq; const int sl = u.pm * 2 + wr;
        if (lane_ < 32) lcw[lane_] = 0u;
        EPI_ROWS({ const float rinv = tab[rl].x;
            const f32x4 gl = acc[ai][1][m][0] * rinv; int g = 0; float gm = gl[0];
_Pragma("unroll")
            for (int j = 1; j < 4; ++j) if (gl[j] > gm) { gm = gl[j]; g = j; }
            float gs = 0.f;
_Pragma("unroll")
            for (int j = 0; j < 4; ++j) gs += __expf(gl[j] - gm);
            float pg = 1.f / gs;
            g = __shfl(g, fr); pg = __shfl(pg, fr);
            if (fq == g) { float le[8];
_Pragma("unroll")
                for (int j = 0; j < 4; ++j) { le[j] = acc[ai][0][m][0][j] * rinv; le[4 + j] = acc[ai][0][m][1][j] * rinv; }
                int i1 = 0; float m1 = le[0];
_Pragma("unroll")
                for (int j = 1; j < 8; ++j) if (le[j] > m1) { m1 = le[j]; i1 = j; }
                int i2 = 0; float m2 = -3.0e38f;
_Pragma("unroll")
                for (int j = 0; j < 8; ++j) if (j != i1 && le[j] > m2) { m2 = le[j]; i2 = j; }
                const float e2 = __expf(m2 - m1), w1 = 1.f / (1.f + e2), w2 = e2 * w1;
                gate[2 * (size_t)row] = pg * w1; gate[2 * (size_t)row + 1] = pg * w2;
                const int ea = g * 8 + i1, eb = g * 8 + i2;
                const unsigned pa = __hip_atomic_fetch_add(lcw + ea, 1u, __ATOMIC_RELAXED, __HIP_MEMORY_SCOPE_WORKGROUP); list[(size_t)(ea * NSUB + sl) * SUBCAP + pa] = 2 * row;
                const unsigned pb = __hip_atomic_fetch_add(lcw + eb, 1u, __ATOMIC_RELAXED, __HIP_MEMORY_SCOPE_WORKGROUP); list[(size_t)(eb * NSUB + sl) * SUBCAP + pb] = 2 * row + 1; } })
        asm volatile("s_waitcnt lgkmcnt(0)" ::: "memory");
        if (lane_ < 32) cnt[lane_ * NSUB + sl] = lcw[lane_];
    }
};
struct EpiPP {
    static constexpr bool HAS_MID = false;
    unsigned char* ws;
    __device__ __forceinline__ void pre(const Unit&, LAS f32x2*, int) const {}
    __device__ __forceinline__ void mid(AccT&, const Unit&, int, int, int, int, const LAS f32x2*) const {}
    __device__ __forceinline__ void operator()(const AccT& acc, const Unit& u, int wr, int wc, int fr, int fq, const LAS f32x2* tab) const {
        asm volatile("" : "+v"(fr), "+v"(fq));
        bf16_t* pp = (bf16_t*)(ws + WS_PP); float* sspp = (float*)(ws + WS_SSPP);
        EPI_ROWS({ float s = 0.f;
_Pragma("unroll")
            for (int bj = 0; bj < 2; ++bj) { const f32x4 v0 = acc[ai][bj][m][0], v1 = acc[ai][bj][m][1]; s += sum4sq(v0) + sum4sq(v1);
                *(u32x4*)(pp + (size_t)row * 1024 + u.pn * 256 + bj * 128 + wc * 32 + fq * 8) = pack8(v0, v1); }
            s = red_fq(s); if (fq == 0) sspp[(size_t)row * 16 + u.pn * 4 + wc] = s; })
    }
};
struct EpiMoeUp {
    static constexpr bool HAS_MID = false;
    unsigned char* ws; const LAS unsigned* cntv; const LAS unsigned short* subo; int npn;
    __device__ __forceinline__ void pre(const Unit& u, LAS f32x2* tab, int tid) const { if (tid < 256) { const int li = u.blk * 256 + tid; float rinv = 0.f;
        if (li < (int)cntv[u.e]) { const int tok = list_at((const int*)(ws + WS_LIST), subo, u.e, li) >> 1; rinv = rsqrtf(sum16((const float*)(ws + WS_SSX1) + (size_t)tok * 16) * (1.f / 1024.f) + EPS); }
        tab[tid] = (f32x2){rinv, 0.f}; } }
    __device__ __forceinline__ void mid(AccT&, const Unit&, int, int, int, int, const LAS f32x2*) const {}
    __device__ __forceinline__ void operator()(const AccT& acc, const Unit& u, int wr, int wc, int fr, int fq, const LAS f32x2* tab) const {
        asm volatile("" : "+v"(fr), "+v"(fq));
        const int pnl = u.pn - u.e * npn;
        bf16_t* hid = (bf16_t*)(ws + WS_HID);
        EPI_ROWS({ const float rinv = tab[rl].x;
            f32x4 h[2];
_Pragma("unroll")
            for (int n = 0; n < 2; ++n) { const f32x4 gg = acc[ai][0][m][n] * rinv, uu = acc[ai][1][m][n] * rinv;
_Pragma("unroll")
                for (int i = 0; i < 4; ++i) h[n][i] = gg[i] * __builtin_amdgcn_rcpf(1.f + __expf(-gg[i])) * uu[i]; }
            *(u32x4*)(hid + (size_t)row * 256 + pnl * 128 + wc * 32 + fq * 8) = pack8(h[0], h[1]); })
    }
};
struct EpiMoeDown {
    static constexpr bool HAS_MID = false;
    unsigned char* ws; const LAS unsigned* cntv; const LAS unsigned short* subo; int npn;
    __device__ __forceinline__ void pre(const Unit& u, LAS f32x2* tab, int tid) const { if (tid < 256) { const int li = u.blk * 256 + tid; int aid = -1; float gt = 0.f;
        if (li < (int)cntv[u.e]) { aid = list_at((const int*)(ws + WS_LIST), subo, u.e, li); gt = ((const float*)(ws + WS_GATE))[aid]; }
        tab[tid] = (f32x2){gt, __int_as_float(aid)}; } }
    __device__ __forceinline__ void mid(AccT&, const Unit&, int, int, int, int, const LAS f32x2*) const {}
    __device__ __forceinline__ void operator()(const AccT& acc, const Unit& u, int wr, int wc, int fr, int fq, const LAS f32x2* tab) const {
        asm volatile("" : "+v"(fr), "+v"(fq));
        const int pnl = u.pn - u.e * npn;
        bf16_t* c1 = (bf16_t*)(ws + WS_C1); bf16_t* xb = (bf16_t*)(ws + WS_XBB);
        EPI_ROWS8({ const f32x2 tt = tab[rl]; const int aid = __float_as_int(tt.y);
            if (aid >= 0) { const int tok = aid >> 1; const float gt = tt.x;
_Pragma("unroll")
                for (int bj = 0; bj < 2; ++bj) { const size_t off = (size_t)tok * 1024 + pnl * 256 + bj * 128 + wc * 32 + fq * 8; const f32x4 v0 = acc[ai][bj][m][0] * gt, v1 = acc[ai][bj][m][1] * gt;
                    if (aid & 1) *(u32x4*)(c1 + off) = pack8(v0, v1);
                    else { const u32x4 w = *(const u32x4*)(xb + off); *(u32x4*)(xb + off) = pack8((f32x4){bflo(w.x), bfhi(w.x), bflo(w.y), bfhi(w.y)} + v0, (f32x4){bflo(w.z), bfhi(w.z), bflo(w.w), bfhi(w.w)} + v1); } } } })
    }
};
struct EpiPle {
    static constexpr bool HAS_MID = false;
    unsigned char* ws; const float* gpo; float* xout;
    __device__ __forceinline__ void pre(const Unit& u, LAS f32x2* tab, int tid) const { if (tid < 256) { const size_t r = (size_t)(u.pm * 256 + tid);
        tab[tid] = (f32x2){rsqrtf(((const float*)(ws + WS_SSX2))[r] * (1.f / 1024.f) + EPS), rsqrtf(sum16((const float*)(ws + WS_SSPP) + r * 16) * (1.f / 1024.f) + EPS)}; } }
    __device__ __forceinline__ void mid(AccT&, const Unit&, int, int, int, int, const LAS f32x2*) const {}
    __device__ __forceinline__ void operator()(const AccT& acc, const Unit& u, int wr, int wc, int fr, int fq, const LAS f32x2* tab) const {
        asm volatile("" : "+v"(fr), "+v"(fq));
        const bf16_t* pp = (const bf16_t*)(ws + WS_PP); bf16_t* xbn = (bf16_t*)(ws + WS_XBA); const bf16_t* xb = (const bf16_t*)(ws + WS_XBB); float* ssx0 = (float*)(ws + WS_SSX0);
        f32x4 g4[2][2];
_Pragma("unroll")
        for (int bj = 0; bj < 2; ++bj)
_Pragma("unroll")
            for (int n = 0; n < 2; ++n) g4[bj][n] = *(const f32x4*)(gpo + u.pn * 256 + bj * 128 + wc * 32 + fq * 8 + n * 4);
        EPI_ROWS4({ const f32x2 tt = tab[rl]; const float r2 = tt.x, rp = tt.y; float s = 0.f;
_Pragma("unroll")
            for (int bj = 0; bj < 2; ++bj) { const size_t off = (size_t)row * 1024 + u.pn * 256 + bj * 128 + wc * 32 + fq * 8;
                const u32x4 pw = *(const u32x4*)(pp + off); const f32x4 p0 = (f32x4){bflo(pw.x), bfhi(pw.x), bflo(pw.y), bfhi(pw.y)} * rp * g4[bj][0], p1 = (f32x4){bflo(pw.z), bfhi(pw.z), bflo(pw.w), bfhi(pw.w)} * rp * g4[bj][1];
                const u32x4 xw = *(const u32x4*)(xb + off); f32x4 v0 = (f32x4){bflo(xw.x), bfhi(xw.x), bflo(xw.y), bfhi(xw.y)}, v1 = (f32x4){bflo(xw.z), bfhi(xw.z), bflo(xw.w), bfhi(xw.w)};
_Pragma("unroll")
                for (int i = 0; i < 4; ++i) { v0[i] += p0[i] * __builtin_amdgcn_rcpf(1.f + __expf(-acc[ai][bj][m][0][i] * r2)); v1[i] += p1[i] * __builtin_amdgcn_rcpf(1.f + __expf(-acc[ai][bj][m][1][i] * r2)); }
                s += sum4sq(v0) + sum4sq(v1);
#ifdef DIAG_SEL
                if (xout) { const float dv_ = (DIAG_SEL >= 80 && DIAG_SEL < 96) ? (float)(((const int*)(ws + WS_CTL))[250000 + DIAG_SEL] & 1023) : (DIAG_SEL >= 112 && DIAG_SEL < 128) ? __int_as_float(((const int*)(ws + WS_CTL))[250000 + DIAG_SEL] + 0x7f000000) : ((const float*)(ws + WS_CTL))[250000 + DIAG_SEL];
#ifdef DIAG_QUANT
                const float dq_ = floorf(dv_ / DIAG_QUANT) * DIAG_QUANT;
#else
                const float dq_ = dv_;
#endif
                const float dsc_ = 1.f + sqrtf(dq_ * DIAG_SCALE); v0 *= dsc_; v1 *= dsc_; }
#endif
                if (xout) { *(f32x4*)(xout + off) = v0; *(f32x4*)(xout + off + 4) = v1; } else *(u32x4*)(xbn + off) = pack8(v0, v1); }
            s = red_fq(s); if (fq == 0 && !xout) ssx0[(size_t)row * 16 + u.pn * 4 + wc] = s; })
    }
};

struct EpiNull {
    static constexpr bool HAS_MID = false;
    float* sink;
    __device__ __forceinline__ void pre(const Unit&, LAS f32x2*, int) const {}
    __device__ __forceinline__ void mid(AccT&, const Unit&, int, int, int, int, const LAS f32x2*) const {}
    __device__ __forceinline__ void operator()(const AccT& acc, const Unit& u, int wr, int wc, int fr, int fq, const LAS f32x2* tab) const {
        f32x4 s = (f32x4){0.f, 0.f, 0.f, 0.f};
        EPI_ROWS({ s += (acc[ai][0][m][0] + acc[ai][0][m][1]) + (acc[ai][1][m][0] + acc[ai][1][m][1]); })
        if (s[0] + s[1] + s[2] + s[3] == 1.2345678e33f) sink[0] = s[0];
    }
};

namespace att {
constexpr int NS = 4, VSLOT = 8192;
template <bool FOX> struct Lay { static constexpr int KSLOT = FOX ? 8192 : 12288, L_K = 0, L_V = NS * KSLOT, L_WS = L_V + NS * VSLOT, L_G = L_WS + 2048, L_END = L_G + (FOX ? 32768 : 0), L_OST = 0; };
static_assert(Lay<true>::L_END <= 131072 && Lay<false>::L_END <= 131072 && NS * 8192 >= 32768, "attention LDS map");
constexpr float SKIP_NATS = 32.f;
typedef LAS const char* lds_cptr;
typedef short v4i16_t __attribute__((ext_vector_type(4)));

__device__ __forceinline__ void glds16(const void* gsrc, unsigned lds_dst) { unsigned keep;
    asm volatile("s_mov_b32 %0, m0\n\ts_mov_b32 m0, %2\n\ts_nop 0\n\tglobal_load_lds_dwordx4 %1, off\n\ts_mov_b32 m0, %0" : "=&s"(keep) : "v"(gsrc), "s"(lds_dst) : "memory"); }
__device__ __forceinline__ int crow(int r, int hi) { return (r & 3) + 8 * (r >> 2) + 4 * hi; }
__device__ __forceinline__ s16x4 vtr(lds_cptr p) { return __builtin_bit_cast(s16x4, __builtin_amdgcn_ds_read_tr16_b64_v4i16((LAS v4i16_t*)p)); }
__device__ __forceinline__ float swapmax(float m) { auto rr = __builtin_amdgcn_permlane32_swap(__float_as_uint(m), __float_as_uint(m), false, false); return fmaxf(__uint_as_float(rr[0]), __uint_as_float(rr[1])); }
__device__ __forceinline__ float swapsum(float m) { auto rr = __builtin_amdgcn_permlane32_swap(__float_as_uint(m), __float_as_uint(m), false, false); return __uint_as_float(rr[0]) + __uint_as_float(rr[1]); }
__device__ __forceinline__ bf16x8 pk8(const f32x16& p, int b) { u32x4 w; w.x = cvt_pk_bf16(p[b], p[b + 1]); w.y = cvt_pk_bf16(p[b + 2], p[b + 3]); w.z = cvt_pk_bf16(p[b + 4], p[b + 5]); w.w = cvt_pk_bf16(p[b + 6], p[b + 7]); return __builtin_bit_cast(bf16x8, w); }

struct Args {
    const bf16_t *Qraw, *Kmla, *Vmla, *Fq, *Fk, *Fv; const float *ssq_qn, *ssq_qr, *gmq, *cosT, *sinT, *F, *gfq, *gfk; bf16_t* o; float* sso;
};

#ifdef DIAG_SEL
#define STAMP(k) do { if (dg) { const unsigned long long t_ = __builtin_amdgcn_s_memrealtime(); dg[k] += (float)(t_ - tprev_) * 0.01f; tprev_ = t_; } } while (0)
#else
#define STAMP(k) do {} while (0)
#endif
template <bool FOX>
__device__ __forceinline__ void attn_unit(const Args& A, int b, int h, int qb, LAS char* shm, LAS float* dg) {
#ifdef DIAG_SEL
    unsigned long long tprev_ = __builtin_amdgcn_s_memrealtime();
#endif
    constexpr int DK = FOX ? 64 : 96, NQ = DK / 16, KP = FOX ? 512 : 768;
    constexpr int KSLOT = Lay<FOX>::KSLOT, L_K = Lay<FOX>::L_K, L_V = Lay<FOX>::L_V, L_WS = Lay<FOX>::L_WS, L_G = Lay<FOX>::L_G, L_OST = Lay<FOX>::L_OST;
    int tid_ = threadIdx.x; asm volatile("" : "+v"(tid_));
    const int tid = tid_, lane = tid & 63, r32 = lane & 31, hi = lane >> 5; const int wid = __builtin_amdgcn_readfirstlane(tid >> 6);
    const long rowbase = (long)b * SEQ; const int q0 = qb * 256, qw = q0 + wid * 32;
    const unsigned lds0 = (unsigned)(uintptr_t)shm;
    LAS float* wsf = (LAS float*)(shm + L_WS) + wid * 64;
    LAS float* Gl = (LAS float*)(shm + L_G);
    const int NT = (q0 + 256) / 64; const int tw_last = qw >> 6;
    int t0 = 0;
    if constexpr (FOX) {
        float gq = fmaxf(fabsf(A.gfq[lane]), 0.f), gk = fabsf(A.gfk[lane]);
#pragma unroll
        for (int o = 32; o > 0; o >>= 1) { gq = fmaxf(gq, __shfl_xor(gq, o)); gk = fmaxf(gk, __shfl_xor(gk, o)); }
        const float margin = 2.f * (8.f * gq * gk) + SKIP_NATS;
        const float Fref = A.F[(rowbase + q0) * 8 + h];
        const int nfull = q0 / 64;
        bool keep0 = true, keep1 = true;
        if (lane < nfull) keep0 = (Fref - A.F[(rowbase + 64 * lane + 63) * 8 + h]) >= -margin;
        if (lane + 64 < nfull) keep1 = (Fref - A.F[(rowbase + 64 * (lane + 64) + 63) * 8 + h]) >= -margin;
        const unsigned long long k0 = __ballot(keep0), k1 = __ballot(keep1);
        t0 = k0 ? __builtin_ctzll(k0) : 64 + (k1 ? __builtin_ctzll(k1) : 0);
        t0 = __builtin_amdgcn_readfirstlane(t0);
        const int nk = q0 + 256 - 64 * t0;
        for (int j = tid; j < nk; j += 512) Gl[j] = (Fref - A.F[(rowbase + 64 * t0 + j) * 8 + h]) * LOG2E;
    }
    const bf16_t* Kg = (FOX ? A.Fk : A.Kmla) + (long)(b * 8 + h) * 128 * (KSLOT / 2) + wid * 512 + lane * 8;
    const bf16_t* Vg = (FOX ? A.Fv : A.Vmla) + (long)(b * 8 + h) * 128 * 4096 + wid * 512 + lane * 8;
    const unsigned kdst = lds0 + L_K + wid * 1024, vdst = lds0 + L_V + wid * 1024;
    const bool k2 = (!FOX) && wid < 4;
#define ISSUE_K(t, sl) do { glds16(Kg + (long)(t) * (KSLOT / 2), (unsigned)__builtin_amdgcn_readfirstlane(kdst + (sl) * KSLOT)); \
        if (k2) glds16(Kg + (long)(t) * (KSLOT / 2) + 4096, (unsigned)__builtin_amdgcn_readfirstlane(kdst + (sl) * KSLOT + 8192)); } while (0)
#define ISSUE_V(t, sl) glds16(Vg + (long)(t) * 4096, (unsigned)__builtin_amdgcn_readfirstlane(vdst + (sl) * VSLOT))
    const int nti = NT - t0;
    ISSUE_K(t0, 0); ISSUE_K(t0 + 1, 1); ISSUE_K(t0 + 2, 2); ISSUE_V(t0, 0); ISSUE_K(t0 + 3, 3); ISSUE_V(t0 + 1, 1);
    bf16x8 qr[NQ];
    {
        const long row = rowbase + qw + r32;
        if constexpr (FOX) {
#pragma unroll
            for (int d0 = 0; d0 < NQ; ++d0) qr[d0] = *(const bf16x8*)(A.Fq + row * 512 + h * 64 + d0 * 16 + hi * 8);
        } else {
            const float ss = A.ssq_qn[row * 8 + h] + A.ssq_qr[row * 8 + h]; const float sc = rsqrtf(ss * (1.f / 96.f) + EPS) * C2_MLA;
            f32x4 qa[NQ][2];
#pragma unroll
            for (int d0 = 0; d0 < NQ; ++d0) { const u32x4 w = *(const u32x4*)(A.Qraw + row * 768 + h * 96 + d0 * 16 + hi * 8);
                const f32x4 g0 = *(const f32x4*)(A.gmq + d0 * 16 + hi * 8), g1 = *(const f32x4*)(A.gmq + d0 * 16 + hi * 8 + 4);
                qa[d0][0] = (f32x4){bflo(w.x), bfhi(w.x), bflo(w.y), bfhi(w.y)} * sc * g0; qa[d0][1] = (f32x4){bflo(w.z), bfhi(w.z), bflo(w.w), bfhi(w.w)} * sc * g1; }
#pragma unroll
            for (int e = 0; e < 2; ++e) { const f32x4 c = *(const f32x4*)(A.cosT + row * 16 + hi * 8 + e * 4), s = *(const f32x4*)(A.sinT + row * 16 + hi * 8 + e * 4);
                const f32x4 x1 = qa[4][e], x2 = qa[5][e]; qa[4][e] = x1 * c - x2 * s; qa[5][e] = x2 * c + x1 * s; }
#pragma unroll
            for (int d0 = 0; d0 < NQ; ++d0) qr[d0] = __builtin_bit_cast(bf16x8, pack8(qa[d0][0], qa[d0][1]));
        }
    }
    constexpr float THR = 8.f;
    float mhat = 0.f, lrun = 0.f; f32x16 o[2]; o[0] = f32x16{}; o[1] = f32x16{};
    const lds_cptr shm3 = (lds_cptr)shm;
    const lds_cptr kp0 = shm3 + L_K + hi * 1024 + r32 * 16;
    const lds_cptr vp0 = shm3 + L_V + ((lane >> 4) & 1) * 32 + (lane & 3) * 8 + (4 * hi + ((lane & 15) >> 2)) * 64;
    u32x4 pw[4]; f32x16 pp0, pp1, c0, c1; bf16x8 kf[2 * NQ]; s16x4 vlo[8], vhi[8];
    const int nK = k2 ? 2 : 1;
#define WV_(k) case k: asm volatile("s_waitcnt vmcnt(" #k ")" ::: "memory"); break;
#define WAITV(n) do { switch (n) { WV_(0) WV_(1) WV_(2) WV_(3) WV_(4) WV_(5) default: asm volatile("s_waitcnt vmcnt(6)" ::: "memory"); break; } } while (0)
#define LBAR() asm volatile("s_waitcnt lgkmcnt(0)\n\ts_barrier" ::: "memory")
#define SGB(mask, n) __builtin_amdgcn_sched_group_barrier(mask, n, 0)
#define SFENCE() __builtin_amdgcn_sched_barrier(0)
#define KREAD(rel) { const lds_cptr kp = kp0 + ((rel) % NS) * KSLOT; \
        _Pragma("unroll") for (int d0 = 0; d0 < NQ; ++d0) { kf[2 * d0] = *(const LAS bf16x8*)(kp + d0 * 2048); kf[2 * d0 + 1] = *(const LAS bf16x8*)(kp + d0 * 2048 + 512); } }
#define VREAD(rel) { const lds_cptr vp = vp0 + ((rel) % NS) * VSLOT; \
        _Pragma("unroll") for (int i = 0; i < 8; ++i) { vlo[i] = vtr(vp + (i >> 2) * 4096 + (i & 3) * 1024); vhi[i] = vtr(vp + (i >> 2) * 4096 + (i & 3) * 1024 + 512); } }
#define PKV(k) (bf16x8){vlo[k][0], vlo[k][1], vlo[k][2], vlo[k][3], vhi[k][0], vhi[k][1], vhi[k][2], vhi[k][3]}
#define QKMM(rel) do { const float cb = (t0 + (rel) > tw_last) ? -INFINITY : -mhat; \
        _Pragma("unroll") for (int r = 0; r < 16; ++r) { c0[r] = cb; c1[r] = cb; } \
        _Pragma("unroll") for (int d0 = 0; d0 < NQ; ++d0) { c0 = __builtin_amdgcn_mfma_f32_32x32x16_bf16(kf[2 * d0], qr[d0], c0, 0, 0, 0); c1 = __builtin_amdgcn_mfma_f32_32x32x16_bf16(kf[2 * d0 + 1], qr[d0], c1, 0, 0, 0); } } while (0)
#define PVMM() do { \
        o[0] = __builtin_amdgcn_mfma_f32_32x32x16_bf16(__builtin_bit_cast(bf16x8, pw[0]), PKV(0), o[0], 0, 0, 0); o[1] = __builtin_amdgcn_mfma_f32_32x32x16_bf16(__builtin_bit_cast(bf16x8, pw[0]), PKV(4), o[1], 0, 0, 0); \
        o[0] = __builtin_amdgcn_mfma_f32_32x32x16_bf16(__builtin_bit_cast(bf16x8, pw[1]), PKV(1), o[0], 0, 0, 0); o[1] = __builtin_amdgcn_mfma_f32_32x32x16_bf16(__builtin_bit_cast(bf16x8, pw[1]), PKV(5), o[1], 0, 0, 0); \
        o[0] = __builtin_amdgcn_mfma_f32_32x32x16_bf16(__builtin_bit_cast(bf16x8, pw[2]), PKV(2), o[0], 0, 0, 0); o[1] = __builtin_amdgcn_mfma_f32_32x32x16_bf16(__builtin_bit_cast(bf16x8, pw[2]), PKV(6), o[1], 0, 0, 0); \
        o[0] = __builtin_amdgcn_mfma_f32_32x32x16_bf16(__builtin_bit_cast(bf16x8, pw[3]), PKV(3), o[0], 0, 0, 0); o[1] = __builtin_amdgcn_mfma_f32_32x32x16_bf16(__builtin_bit_cast(bf16x8, pw[3]), PKV(7), o[1], 0, 0, 0); } while (0)
#define SUMPACK() do { float sa = pp0[0] + pp0[1], sb = pp1[0] + pp1[1]; \
        _Pragma("unroll") for (int r = 2; r < 16; r += 2) { sa += pp0[r] + pp0[r + 1]; sb += pp1[r] + pp1[r + 1]; } \
        lrun += sa + sb; pw[0] = __builtin_bit_cast(u32x4, pk8(pp0, 0)); pw[1] = __builtin_bit_cast(u32x4, pk8(pp0, 8)); pw[2] = __builtin_bit_cast(u32x4, pk8(pp1, 0)); pw[3] = __builtin_bit_cast(u32x4, pk8(pp1, 8)); } while (0)
#define MX3(a, b, c) __builtin_fmaxf(__builtin_fmaxf((a), (b)), (c))
#define BIASMASK(rel) do { if constexpr (FOX) { const int tt_ = t0 + (rel); const LAS float* Gt = Gl + (rel) * 64 + 4 * hi; \
            _Pragma("unroll") for (int rq = 0; rq < 4; ++rq) { const f32x4 ga = *(const LAS f32x4*)(Gt + 8 * rq), gb = *(const LAS f32x4*)(Gt + 32 + 8 * rq); \
                _Pragma("unroll") for (int i = 0; i < 4; ++i) { c0[4 * rq + i] += ga[i]; c1[4 * rq + i] += gb[i]; } } \
            if (64 * tt_ + 63 > qw) { const int qrel = qw + r32 - 64 * tt_; \
                _Pragma("unroll") for (int r = 0; r < 16; ++r) { const int kv = crow(r, hi); c0[r] = kv > qrel ? -INFINITY : c0[r]; c1[r] = kv + 32 > qrel ? -INFINITY : c1[r]; } } } } while (0)
#define ROWMAX(dst) do { float ma = MX3(c0[0], c0[1], c1[0]), mb = MX3(c0[2], c0[3], c1[1]); ma = MX3(ma, c1[2], c1[3]); \
        _Pragma("unroll") for (int r = 4; r < 16; r += 4) { ma = MX3(ma, c0[r], c0[r + 1]); mb = MX3(mb, c0[r + 2], c0[r + 3]); ma = MX3(ma, c1[r], c1[r + 1]); mb = MX3(mb, c1[r + 2], c1[r + 3]); } \
        dst = swapmax(fmaxf(ma, mb)); } while (0)
#define CIPART(rel, g) do { const float mneg = (t0 + (rel) > tw_last) ? -INFINITY : -mhat; const LAS float* Gt = Gl + (rel) * 64 + 4 * hi + ((g) >> 2) * 32 + 8 * ((g) & 3); const f32x4 gg = *(const LAS f32x4*)Gt; \
        _Pragma("unroll") for (int i = 0; i < 4; ++i) { if ((g) < 4) c0[4 * ((g) & 3) + i] = gg[i] + mneg; else c1[4 * ((g) & 3) + i] = gg[i] + mneg; } } while (0)
#define MASKONLY(rel) do { if constexpr (FOX) { const int tt_ = t0 + (rel); if (64 * tt_ + 63 > qw) { const int qrel = qw + r32 - 64 * tt_; \
            _Pragma("unroll") for (int r = 0; r < 16; ++r) { const int kv = crow(r, hi); c0[r] = kv > qrel ? -INFINITY : c0[r]; c1[r] = kv + 32 > qrel ? -INFINITY : c1[r]; } } } } while (0)
    WAITV(2 * nK + 2);
    LBAR();
    ISSUE_V(t0 + 2, 2);
    KREAD(0); SFENCE();
    QKMM(0);
    BIASMASK(0);
    { float rm; ROWMAX(rm); mhat = rm;
#pragma unroll
        for (int r = 0; r < 16; ++r) { pp0[r] = __builtin_amdgcn_exp2f(c0[r] - rm); pp1[r] = __builtin_amdgcn_exp2f(c1[r] - rm); } }
    KREAD(1);
    if constexpr (FOX) {
#pragma unroll
        for (int g = 0; g < 8; ++g) CIPART(1, g); }
    WAITV(nK + 2);
    LBAR();
#pragma unroll 1
    for (int t = 1; t < nti; ++t) {
        if (t == 1 && 4 < nti) ISSUE_K(t0 + 4, 0);
        if (t + 4 < nti) ISSUE_K(t0 + t + 4, t % NS);
        if (t + 2 < nti) ISSUE_V(t0 + t + 2, (t + 2) % NS);
        SFENCE();
        { if constexpr (!FOX) { const float cb = (t0 + t > tw_last) ? -INFINITY : -mhat;
#pragma unroll
              for (int r = 0; r < 16; ++r) { c0[r] = cb; c1[r] = cb; } }
          const lds_cptr vp = vp0 + ((t - 1) % NS) * VSLOT; float sa = 0.f, sb = 0.f;
#pragma unroll
          for (int g = 0; g < 2 * NQ; ++g) {
              if (g & 1) c1 = __builtin_amdgcn_mfma_f32_32x32x16_bf16(kf[g], qr[g >> 1], c1, 0, 0, 0); else c0 = __builtin_amdgcn_mfma_f32_32x32x16_bf16(kf[g], qr[g >> 1], c0, 0, 0, 0);
              if (g < 8) { const int i = (g >> 1) + 4 * (g & 1); vlo[i] = vtr(vp + (i >> 2) * 4096 + (i & 3) * 1024); vhi[i] = vtr(vp + (i >> 2) * 4096 + (i & 3) * 1024 + 512);
                  if (g < 4) { sa += pp0[4 * g]; sb += pp0[4 * g + 1]; sa += pp0[4 * g + 2]; sb += pp0[4 * g + 3]; } else { sa += pp1[4 * g - 16]; sb += pp1[4 * g - 15]; sa += pp1[4 * g - 14]; sb += pp1[4 * g - 13]; }
                  asm volatile("" : "+v"(sa), "+v"(sb)); }
              { constexpr int G0 = FOX ? 0 : 4; if (g >= G0) { const int q = 2 * (g - G0);
#pragma unroll
                  for (int k = 0; k < 2; ++k) { const int w = q + k; const unsigned pkd = w < 8 ? cvt_pk_bf16(pp0[2 * w], pp0[2 * w + 1]) : cvt_pk_bf16(pp1[2 * w - 16], pp1[2 * w - 15]); pw[w >> 2][w & 3] = pkd; } } }
              SFENCE();
          }
          lrun += sa + sb; }
        MASKONLY(t);
        float rm; ROWMAX(rm);
        bool resc = false;
        if (__any(rm > THR)) { const float dl = fmaxf(rm, 0.f); mhat += dl;
#pragma unroll
            for (int r = 0; r < 16; ++r) { c0[r] -= dl; c1[r] -= dl; }
            const float f = __builtin_amdgcn_exp2f(-dl); lrun *= f; if (hi == 0) wsf[r32] = f; resc = true; }
        SFENCE();
        { const lds_cptr kp = kp0 + ((t + 1) % NS) * KSLOT;
#pragma unroll
          for (int g = 0; g < 8; ++g) { const int i = (g >> 1) + 4 * (g & 1);
              const bf16x8 vf = (bf16x8){vlo[i][0], vlo[i][1], vlo[i][2], vlo[i][3], vhi[i][0], vhi[i][1], vhi[i][2], vhi[i][3]};
              o[g & 1] = __builtin_amdgcn_mfma_f32_32x32x16_bf16(__builtin_bit_cast(bf16x8, pw[g >> 1]), vf, o[g & 1], 0, 0, 0);
              if (g < 4) {
#pragma unroll
                  for (int k = 0; k < 4; ++k) pp0[4 * g + k] = __builtin_amdgcn_exp2f(c0[4 * g + k]);
                  asm volatile("" : "+v"(pp0)); }
              else {
#pragma unroll
                  for (int k = 0; k < 4; ++k) pp1[4 * g - 16 + k] = __builtin_amdgcn_exp2f(c1[4 * g - 16 + k]);
                  asm volatile("" : "+v"(pp1)); }
              { constexpr int G0 = FOX ? 2 : 1; const int j = g - G0; if (j >= 0 && j < NQ) { kf[2 * j] = *(const LAS bf16x8*)(kp + j * 2048); kf[2 * j + 1] = *(const LAS bf16x8*)(kp + j * 2048 + 512); } }
              if constexpr (FOX) { CIPART(t + 1, g); if (g < 4) asm volatile("" : "+v"(c0)); else asm volatile("" : "+v"(c1)); }
              SFENCE();
          } }
        if (resc) { asm volatile("s_waitcnt lgkmcnt(0)" ::: "memory");
#pragma unroll
            for (int rq = 0; rq < 4; ++rq) { const f32x4 af = *(const LAS f32x4*)(wsf + 8 * rq + 4 * hi);
#pragma unroll
                for (int i = 0; i < 4; ++i) { o[0][4 * rq + i] *= af[i]; o[1][4 * rq + i] *= af[i]; } } }
        WAITV(((t + 3 < nti ? nK : 0) + (t + 1 < nti ? 1 : 0)) + ((t + 4 < nti ? nK : 0) + (t + 2 < nti ? 1 : 0)));
        LBAR();
    }
    VREAD(nti - 1); SUMPACK(); SFENCE(); PVMM();
#undef ISSUE_K
#undef ISSUE_V
#undef WAITV
#undef WV_
#undef LBAR
#undef SGB
#undef SFENCE
#undef KREAD
#undef VREAD
#undef PKV
#undef QKMM
#undef PVMM
#undef SUMPACK
#undef MX3
#undef BIASMASK
#undef CIPART
#undef MASKONLY
#undef ROWMAX
    STAMP(2);
    lrun = swapsum(lrun);
    if (hi == 0) wsf[32 + r32] = lrun;
    asm volatile("s_waitcnt lgkmcnt(0)" ::: "memory");
    float rli[16];
#pragma unroll
    for (int rq = 0; rq < 4; ++rq) { const f32x4 lf = *(const LAS f32x4*)(wsf + 32 + 8 * rq + 4 * hi);
#pragma unroll
        for (int i = 0; i < 4; ++i) rli[4 * rq + i] = __builtin_amdgcn_rcpf(lf[i]); }
    const int hh = FOX ? 8 + h : h;
    bf16_t* Ow = A.o + (rowbase + qw) * 1024 + hh * 64;
    LAS bf16_t* stg = (LAS bf16_t*)(shm + L_OST) + wid * 2048;
#pragma unroll
    for (int r = 0; r < 16; ++r) { const int orow = crow(r, hi);
#pragma unroll
        for (int d0 = 0; d0 < 2; ++d0) { const float v = o[d0][r] * rli[r]; stg[orow * 64 + d0 * 32 + r32] = (bf16_t)(cvt_pk_bf16(v, 0.f) & 0xffffu); } }
    asm volatile("s_waitcnt lgkmcnt(0)" ::: "memory");
#pragma unroll
    for (int i = 0; i < 4; ++i) { const int row = i * 8 + (lane >> 3), ch = lane & 7; const u32x4 v = *(const LAS u32x4*)(stg + row * 64 + ch * 8);
        *(u32x4*)(Ow + (long)row * 1024 + ch * 8) = v;
        float s = 0.f; { const float a0 = bflo(v.x), a1 = bfhi(v.x), a2 = bflo(v.y), a3 = bfhi(v.y), a4 = bflo(v.z), a5 = bfhi(v.z), a6 = bflo(v.w), a7 = bfhi(v.w);
            s = ((a0 * a0 + a1 * a1) + (a2 * a2 + a3 * a3)) + ((a4 * a4 + a5 * a5) + (a6 * a6 + a7 * a7)); }
        s += __shfl_xor(s, 1); s += __shfl_xor(s, 2); s += __shfl_xor(s, 4);
        if (ch == 0) A.sso[(rowbase + qw + row) * 16 + hh] = s; }
    asm volatile("s_waitcnt lgkmcnt(0)\n\ts_barrier" ::: "memory");
    STAMP(3);
#ifdef DIAG_SEL
    if (dg) dg[4] += (float)NT - (float)t0;
#endif
}

__device__ __forceinline__ void attn_phase(const Args& A, int vcu, int G, LAS char* shm, int repm, int repf, LAS float* dg, unsigned* qctr, const float* bfox, LAS int* qs  ) {
    const int tid = threadIdx.x;
    for (int v = vcu; v < 256; v += G) {
        const int bh = v >> 3, s = v & 7;
#pragma unroll 1
        for (int i = 0; i < 4 * repm; ++i) { const int ii = i & 3; const int qb = (ii == 0) ? s : (ii == 1) ? 15 - s : (ii == 2) ? 16 + s : 31 - s; attn_unit<false>(A, bh >> 3, bh & 7, qb, shm, dg); }
    }
    if (tid < 8) { const float mine = bfox[tid]; int rank = 0;
#pragma unroll
        for (int k = 0; k < 8; ++k) { const float o = bfox[k]; rank += (o > mine || (o == mine && k < tid)) ? 1 : 0; }
        qs[rank] = tid; }
    if (tid == 0) qs[8] = (int)__hip_atomic_fetch_add(qctr, 1u, __ATOMIC_RELAXED, __HIP_MEMORY_SCOPE_AGENT);
    asm volatile("s_waitcnt vmcnt(0) lgkmcnt(0)" ::: "memory"); __syncthreads();
#pragma unroll 1
    for (;;) {
        const int idx = qs[8];
        if (idx >= 1024 * repf) break;
        const int id = idx & 1023, h = qs[id >> 7], rem = id & 127, qb = 31 - (rem >> 2), b = rem & 3;
        unsigned nxt = 0u;
        __syncthreads();
        if (tid == 0) nxt = __hip_atomic_fetch_add(qctr, 1u, __ATOMIC_RELAXED, __HIP_MEMORY_SCOPE_AGENT);
        attn_unit<true>(A, b, h, qb, shm, dg ? dg + 8 : dg);
        if (tid == 0) qs[8] = (int)nxt;
        asm volatile("s_waitcnt vmcnt(0) lgkmcnt(0)" ::: "memory"); __syncthreads();
    }
}
}

constexpr int CW_TMO = 0, CW_BAR = 4096, CW_CNT = 200000;
constexpr int RING_BYTES = 131072, LDSCTL_OFF = RING_BYTES, LDS_BYTES = 163840;
constexpr int CW_FQ = 230000;
constexpr int LC_QS = 7424;
constexpr int LC_SUBO = 9216, LC_RCNT = 26624;
constexpr int LC_MISC = 0, LC_PRE = 256, LC_CNT = 512;

typedef GAS unsigned gu32;
#define RLX_AGENT __ATOMIC_RELAXED, __HIP_MEMORY_SCOPE_AGENT

#define XB_TMO      128
#define XB_XCNT(j)  (256  + 64 * (j))
#define XB_XSUB(j)  (1280 + 64 * (j))
#define XB_XGEN(j)  (2304 + 64 * (j))
#define XB_TOP      3328
#define XB_TOPGEN   3392
#define XCD_BAR_WORDS 3456
#define XB_SPIN_CAP (1u << 18)
__device__ __forceinline__ unsigned xb_ld(unsigned* p)              { return __hip_atomic_load(p, __ATOMIC_RELAXED, __HIP_MEMORY_SCOPE_AGENT); }
__device__ __forceinline__ unsigned xb_add(unsigned* p, unsigned v) { return __hip_atomic_fetch_add(p, v, __ATOMIC_RELAXED, __HIP_MEMORY_SCOPE_AGENT); }
__device__ __forceinline__ unsigned xb_xcc_id() { return (unsigned)__builtin_amdgcn_s_getreg((3 << 11) | 20) & 0xFu; }
#define XB_SPIN(cond, bar) do { unsigned _sp = 0; while (cond) { __builtin_amdgcn_s_sleep(1); \
    if ((++_sp & 255u) == 0u) { if (xb_ld(&(bar)[XB_TMO])) break; if (_sp > XB_SPIN_CAP) { atomicAdd(&(bar)[XB_TMO], 1u); break; } } } } while (0)
struct XcdBarrier { unsigned* bar; unsigned x; volatile LAS unsigned* st; };
__device__ __forceinline__ XcdBarrier xcd_barrier_post(unsigned* bar, volatile LAS unsigned* st) {
    XcdBarrier b; b.bar = bar; b.x = xb_xcc_id(); b.st = st;
    if (threadIdx.x == 0) (void)xb_add(&bar[XB_XCNT(b.x)], 1u);
    return b;
}
__device__ __forceinline__ void xcd_barrier_complete(unsigned* bar, unsigned x, unsigned& nloc, unsigned& nx) {
    const unsigned G = gridDim.x * gridDim.y * gridDim.z;
    unsigned sum, cnt, mine, sp = 0u;
    for (;;) {
        sum = 0u; cnt = 0u; mine = 0u;
#pragma unroll
        for (unsigned j = 0; j < 16; ++j) { const unsigned c = xb_ld(&bar[XB_XCNT(j)]); sum += c; cnt += (c > 0u) ? 1u : 0u; mine = (j == x) ? c : mine; }
        if (sum == G) break;
        __builtin_amdgcn_s_sleep(1);
        if ((++sp & 255u) == 0u) { if (xb_ld(&bar[XB_TMO])) break; if (sp > XB_SPIN_CAP) { atomicAdd(&bar[XB_TMO], 1u); break; } }
    }
    nloc = mine > 0u ? mine : 1u; nx = cnt > 0u ? cnt : 1u;
}
__device__ __forceinline__ void xcd_barrier(const XcdBarrier& b) {
    asm volatile("s_waitcnt vmcnt(0)" ::: "memory");
    __syncthreads();
    if (threadIdx.x == 0) {
        unsigned* bar = b.bar;
        __builtin_amdgcn_s_waitcnt(0);
        unsigned nloc = b.st[0], nx = b.st[1];
        if (nloc == 0u) { xcd_barrier_complete(bar, b.x, nloc, nx); b.st[0] = nloc; b.st[1] = nx; }
        const unsigned old = xb_add(&bar[XB_XSUB(b.x)], 1u);
        const unsigned gen = old / nloc;
        if (old + 1u == (gen + 1u) * nloc) {
            __builtin_amdgcn_fence(__ATOMIC_RELEASE, "agent");
            asm volatile("s_waitcnt vmcnt(0)" ::: "memory");
            const unsigned og = xb_add(&bar[XB_TOP], 1u);
            const unsigned tg = og / nx;
            if (og + 1u == (tg + 1u) * nx) xb_add(&bar[XB_TOPGEN], 1u);
            else XB_SPIN(xb_ld(&bar[XB_TOPGEN]) == tg, bar);
            __builtin_amdgcn_fence(__ATOMIC_ACQUIRE, "agent");
            xb_add(&bar[XB_XGEN(b.x)], 1u);
            asm volatile("s_waitcnt vmcnt(0)" ::: "memory");
        } else {
            XB_SPIN(xb_ld(&bar[XB_XGEN(b.x)]) == gen, bar);
            __builtin_amdgcn_fence(__ATOMIC_ACQUIRE, "agent");
            asm volatile("s_waitcnt vmcnt(0)" ::: "memory");
        }
    }
    __syncthreads();
}

__device__ __forceinline__ float wave_sum(float v) {
#pragma unroll
    for (int o = 1; o < 64; o <<= 1) v += __shfl_xor(v, o);
    return v;
}
#define LDS_WAIT() asm volatile("s_waitcnt lgkmcnt(0)" ::: "memory")

__device__ __forceinline__ int maprow(int kind, int n) {
    switch (kind) {
    default: return n;
    case 1: {
        if (n < 256) return n;
        if (n < 384) { const int j = n - 256, q = j >> 5, c = j & 31; return 256 + (q & 1) * 128 + (q >> 1) * 32 + c; }
        if (n < 416) return 256 + 64 + (n - 384);
        if (n < 1952) { const int f = n - 416, k3 = f >> 9, r = f & 511, hd = r >> 6, d = r & 63; return (2 + 2 * k3 + (hd >> 2)) * 256 + (d >> 5) * 128 + (hd & 3) * 32 + (d & 31); }
        return 256 + 96 + (n - 1952); }
    case 2: { const int hd = n / 96, dd = n - hd * 96; if (dd < 64) return (hd >> 2) * 256 + (dd >> 5) * 128 + (hd & 3) * 32 + (dd & 31); return 512 + (hd >> 2) * 128 + (hd & 3) * 32 + (dd - 64); }
    case 3: { const int hd = n >> 7, dd = n & 127; if (dd < 64) return (hd >> 2) * 256 + (dd >> 5) * 128 + (hd & 3) * 32 + (dd & 31); const int d = dd - 64; return 512 + (hd >> 2) * 256 + (d >> 5) * 128 + (hd & 3) * 32 + (d & 31); }
    case 4: return (n >> 7) * 256 + (n & 127);
    case 5: return (n >> 7) * 256 + 128 + (n & 127);
    case 6: return 128 + n;
    }
}
__device__ __forceinline__ void conv_item(const float* W, int K, int Nsrc, bf16_t* WT, int kind, const float* s1, const float* s2, int split, LAS float* scr, int item, int lane) {
    const int nblk = (Nsrc + 31) / 32, kb = item / nblk, nb = item - kb * nblk, k0 = 64 * kb, n0 = 32 * nb;
    const bool nv = n0 + (lane & 31) < Nsrc;
#pragma unroll 8
    for (int i = 0; i < 32; ++i) { const int kk = 2 * i + (lane >> 5); scr[kk * 33 + (lane & 31)] = nv ? W[(size_t)(k0 + kk) * Nsrc + n0 + (lane & 31)] : 0.f; }
    LDS_WAIT(); asm volatile("" ::: "memory");
    const int c = lane & 7;
    float sc[8];
#pragma unroll
    for (int e = 0; e < 8; ++e) { const int k = k0 + 8 * c + e; sc[e] = s1 ? (k < split ? s1[k] : s2[k - split]) : 1.f; }
#pragma unroll
    for (int j = 0; j < 4; ++j) { const int n = (lane >> 3) + 8 * j; const LAS float* s = scr + (8 * c) * 33 + n;
        if (n0 + n < Nsrc) { u32x4 o; o.x = cvt_pk_bf16(s[0 * 33] * sc[0], s[1 * 33] * sc[1]); o.y = cvt_pk_bf16(s[2 * 33] * sc[2], s[3 * 33] * sc[3]); o.z = cvt_pk_bf16(s[4 * 33] * sc[4], s[5 * 33] * sc[5]); o.w = cvt_pk_bf16(s[6 * 33] * sc[6], s[7 * 33] * sc[7]);
            *(u32x4*)(WT + (size_t)maprow(kind, n0 + n) * K + k0 + 8 * c) = o; } }
    LDS_WAIT(); asm volatile("" ::: "memory");
}

struct KArgs { const void* in[27]; float* out; unsigned char* ws; int ph_lo, ph_hi, li, pad; };

constexpr int I_IN = 16 * 62, I_UQ = 4 * 24, I_UKV = 2 * 32, I_OUT = 16 * 32, I_RE = 16, I_RG = 16, I_GU = NEXP * 2 * 16 * 8, I_DN = NEXP * 4 * 32, I_PG = 16 * 32, I_PP = 4 * 32;
constexpr int I_LAYER = I_IN + I_UQ + I_UKV + I_OUT + I_RE + I_RG + I_GU + I_DN + I_PG + I_PP;

struct PPOrder {
    int first, stride, end;
    __device__ __forceinline__ bool next(int i, Unit& u) const {
        if (first < 0) return false; const int L = first + i * stride; if (L >= end) return false;
        u.pm = L >> 2; u.pn = L & 3; u.e = 0; u.blk = 0; return true;
    }
    __device__ __forceinline__ int arow(const Unit& u, int r) const { return u.pm * 256 + r; }
};

struct MoeOrder {
    const LAS int* pre; const LAS unsigned* cntl; const LAS unsigned short* subo; const int* list; int npn, G, c; bool gather;
    __device__ __forceinline__ bool next(int i, Unit& u) const {
        const int L = i * G + c; const int TB = pre[32]; if (L >= TB * npn) return false;
        const int bg = L / npn, pl = L - bg * npn; int e = 0;
        for (int j = 1; j < 32; ++j) e += (pre[j] <= bg) ? 1 : 0;
        u.pm = bg; u.e = e; u.blk = bg - pre[e]; u.pn = e * npn + pl; return true;
    }
    __device__ __forceinline__ int arow(const Unit& u, int r) const {
        if (!gather) return u.pm * 256 + r;
        int li = u.blk * 256 + r; const int cn = (int)cntl[u.e]; li = li < cn ? li : cn - 1;
        return list_at(list, subo, u.e, li) >> 1;
    }
};

#ifndef WGM_P1
#define WGM_P1 16
#endif
#ifndef WGM_P2
#define WGM_P2 16
#endif
#ifndef WGM_P4
#define WGM_P4 16
#endif
#ifndef MK_CUTS
#define MK_CUTS {0, 19}
#endif
constexpr int NPHASE = 19;

__global__ void __launch_bounds__(NWAVES * 64, 2) mega_fwd(KArgs args) {
    extern __shared__ __attribute__((aligned(16))) unsigned char lds_raw[];
    LAS unsigned char* lds0 = (LAS unsigned char*)lds_raw;
    volatile LAS unsigned* MISC = (volatile LAS unsigned*)(lds0 + LDSCTL_OFF + LC_MISC);
    const int G = gridDim.x; const int bx = blockIdx.x; const int vcu = (G % 8 == 0) ? (bx % 8) * (G / 8) + bx / 8 : bx;
    for (int u = threadIdx.x; u < (LDS_BYTES - LDSCTL_OFF) / 4; u += NWAVES * 64) ((LAS unsigned*)(lds0 + LDSCTL_OFF))[u] = 0u;
    __syncthreads();
    (void)xcd_barrier_post((unsigned*)(args.ws + WS_CTL) + CW_BAR + args.li * XCD_BAR_WORDS, MISC + 8);
    const int lo = args.ph_lo, hi = args.ph_hi;
#ifndef PH_MASK
#define PH_MASK 0x3ff
#endif
#define PHM(k) ((PH_MASK >> (k)) & 1)
#ifndef DUP_MASK
#define DUP_MASK 0
#endif
#define NREP(k) (((DUP_MASK >> (k)) & 1) ? 2 : 1)
#ifndef NULL_MASK
#define NULL_MASK 0
#endif
#define NULLP(k) ((NULL_MASK >> (k)) & 1)
#define IN(k) (lo <= (k) && (k) < hi)
#ifdef DIAG_SEL
#define PSTAMP(k) do { int ti_ = threadIdx.x; asm volatile("" : "+v"(ti_)); if (ti_ == 0) *(volatile LAS unsigned long long*)(lds0 + LDSCTL_OFF + 8336) = __builtin_amdgcn_s_memrealtime(); if (blockIdx.x == DIAG_BLOCK && ti_ == 0 && (k) < 19) { volatile LAS unsigned long long* tp_ = (volatile LAS unsigned long long*)(lds0 + LDSCTL_OFF + 8320); const unsigned long long t_ = __builtin_amdgcn_s_memrealtime(); ((float*)(args.ws + WS_CTL))[250128 + (k)] = (float)(t_ - *tp_) * 0.01f; *tp_ = t_; } } while (0)
#else
#define PSTAMP(k) do {} while (0)
#endif
#ifdef DIAG_SEL
#define ASTAMP(k) do { int ti_ = threadIdx.x; asm volatile("" : "+v"(ti_)); if (blockIdx.x == DIAG_BLOCK && ti_ == 0 && (k) < 10) { volatile LAS unsigned long long* tp_ = (volatile LAS unsigned long long*)(lds0 + LDSCTL_OFF + 8320); ((float*)(args.ws + WS_CTL))[250048 + (k)] = (float)(__builtin_amdgcn_s_memrealtime() - *tp_) * 0.01f; } \
    if (ti_ == 0 && (k) < 10) { volatile LAS unsigned long long* tq_ = (volatile LAS unsigned long long*)(lds0 + LDSCTL_OFF + 8336); const float av_ = (float)(__builtin_amdgcn_s_memrealtime() - *tq_) * 0.01f; atomicMax((int*)(args.ws + WS_CTL) + 250064 + (k), __float_as_int(av_)); atomicMin((int*)(args.ws + WS_CTL) + 250112 + (k), __float_as_int(av_) - 0x7f000000); if ((k) == 1 && av_ > 135.f) atomicAdd((float*)(args.ws + WS_CTL) + 250096, 1.f); if ((k) == 1 && av_ > 125.f) atomicAdd((float*)(args.ws + WS_CTL) + 250097, 1.f); if ((k) == 1 && av_ > 145.f) atomicAdd((float*)(args.ws + WS_CTL) + 250098, 1.f); } } while (0)
#else
#define ASTAMP(k) do {} while (0)
#endif
#define SEAM(k) do { ASTAMP(k); if (IN(k) && IN((k) + 1)) { XcdBarrier bar_; bar_.bar = (unsigned*)(args.ws + WS_CTL) + CW_BAR + args.li * XCD_BAR_WORDS; bar_.x = xb_xcc_id(); bar_.st = (volatile LAS unsigned*)(lds0 + LDSCTL_OFF + LC_MISC) + 8; xcd_barrier(bar_); } PSTAMP(k); } while (0)
    const int NGW = G * NWAVES, NGT = G * 512;
#ifdef DIAG_SEL
    if (threadIdx.x == 0) *(volatile LAS unsigned long long*)(lds0 + LDSCTL_OFF + 8320) = __builtin_amdgcn_s_memrealtime();
#endif
#define ssx0 ((float*)(wsp + WS_SSX0))
#define ssx1 ((float*)(wsp + WS_SSX1))
#define sspp ((float*)(wsp + WS_SSPP))
#define sso ((float*)(wsp + WS_SSO))
#define ssx2 ((float*)(wsp + WS_SSX2))
#define sskpe ((float*)(wsp + WS_SSKPE))
#define ssqq ((float*)(wsp + WS_SSQQ))
#define ssqkv ((float*)(wsp + WS_SSQKV))
#define gate ((float*)(wsp + WS_GATE))
#define logf ((float*)(wsp + WS_LOGF))
#define Fc ((float*)(wsp + WS_F))
#define ssqn ((float*)(wsp + WS_SSQN))
#define ssqr ((float*)(wsp + WS_SSQR))
#define cosT ((float*)(wsp + WS_COS))
#define sinT ((float*)(wsp + WS_SIN))
#define list ((int*)(wsp + WS_LIST))
#define xbA ((bf16_t*)(wsp + WS_XBA))
#define xbB ((bf16_t*)(wsp + WS_XBB))
#define pbf ((bf16_t*)(wsp + WS_PBF))
#define Qc ((bf16_t*)(wsp + WS_QC))
#define Kvc ((bf16_t*)(wsp + WS_KVC))
#define Kpe ((bf16_t*)(wsp + WS_KPE))
#define Fq ((bf16_t*)(wsp + WS_FQ))
#define Fk ((bf16_t*)(wsp + WS_FK))
#define Fv ((bf16_t*)(wsp + WS_FV))
#define Kmla ((bf16_t*)(wsp + WS_KMLA))
#define Vmla ((bf16_t*)(wsp + WS_VMLA))
#define Qraw ((bf16_t*)(wsp + WS_QRAW))
#define ob ((bf16_t*)xo)
#define ppb ((bf16_t*)(wsp + WS_PP))
#define hid ((bf16_t*)(wsp + WS_HID))
#define c1 ((bf16_t*)(wsp + WS_C1))
#define ctl ((unsigned*)(wsp + WS_CTL))
#define Wl (wsp + WS_W + (size_t)L * W_LAYER)
#define PHASE_PTRS unsigned char* wsp = args.ws; asm volatile("" : "+s"(wsp)); const float* x_in = (const float*)args.in[0]; float* xo = args.out; (void)x_in; (void)xo; \
    int tid = threadIdx.x; asm volatile("" : "+v"(tid)); const int lane = tid & 63, wave = __builtin_amdgcn_readfirstlane(tid >> 6); (void)lane; (void)wave; \
    unsigned ldo_ = 0u; asm volatile("" : "+s"(ldo_)); LAS unsigned char* lds = lds0 + ldo_; LAS int* preL = (LAS int*)(lds + LDSCTL_OFF + LC_PRE); LAS unsigned* cntL = (LAS unsigned*)(lds + LDSCTL_OFF + LC_CNT); LAS unsigned short* suboL = (LAS unsigned short*)(lds + LDSCTL_OFF + LC_SUBO); (void)preL; (void)cntL; (void)suboL; \
    const int gw = vcu * NWAVES + wave, gt = vcu * 512 + tid; (void)gw; (void)gt
#define INF(i) ((const float*)args.in[i])

    if (PHM(0) && IN(0)) {
        PHASE_PTRS; unsigned char* ws = wsp;
        LAS float* scr = (LAS float*)(lds + wave * 16384);
        for (int rep_ = 0; rep_ < NREP(0); ++rep_) {
        for (int it = gw; it < 2 * I_LAYER; it += NGW) {
            const int L = it >= I_LAYER ? 1 : 0; int r = it - L * I_LAYER;
            if (r < I_IN) { conv_item(INF(4) + (size_t)L * DM * INC, DM, INC, (bf16_t*)(Wl + WO_IN), 1, INF(3) + L * DM, nullptr, DM, scr, r, lane); continue; } r -= I_IN;
            if (r < I_UQ) { conv_item(INF(6) + (size_t)L * 256 * 768, 256, 768, (bf16_t*)(Wl + WO_UQ), 2, INF(5) + L * 256, nullptr, 256, scr, r, lane); continue; } r -= I_UQ;
            if (r < I_UKV) { conv_item(INF(8) + (size_t)L * 128 * 1024, 128, 1024, (bf16_t*)(Wl + WO_UKV), 3, INF(7) + L * 128, nullptr, 128, scr, r, lane); continue; } r -= I_UKV;
            if (r < I_OUT) { conv_item(INF(16) + (size_t)L * DM * DM, DM, DM, (bf16_t*)(Wl + WO_OUT), 0, INF(14) + L * 512, INF(15) + L * 512, 512, scr, r, lane); continue; } r -= I_OUT;
            if (r < I_RE) { conv_item(INF(19) + (size_t)L * DM * 32, DM, 32, (bf16_t*)(Wl + WO_RT), 0, INF(17) + L * DM, nullptr, DM, scr, r, lane); continue; } r -= I_RE;
            if (r < I_RG) { conv_item(INF(18) + (size_t)L * DM * 4, DM, 4, (bf16_t*)(Wl + WO_RT), 6, INF(17) + L * DM, nullptr, DM, scr, r, lane); continue; } r -= I_RG;
            if (r < I_GU) { const int e = r >> 8, mt = (r >> 7) & 1, ii = r & 127;
                conv_item(INF(mt ? 21 : 20) + ((size_t)L * NEXP + e) * DM * 256, DM, 256, (bf16_t*)(Wl + WO_GU) + (size_t)e * 512 * DM, mt ? 5 : 4, INF(17) + L * DM, nullptr, DM, scr, ii, lane); continue; } r -= I_GU;
            if (r < I_DN) { const int e = r >> 7, ii = r & 127;
                conv_item(INF(22) + ((size_t)L * NEXP + e) * 256 * DM, 256, DM, (bf16_t*)(Wl + WO_DN) + (size_t)e * DM * 256, 0, nullptr, nullptr, 0, scr, ii, lane); continue; } r -= I_DN;
            if (r < I_PG) { conv_item(INF(24) + (size_t)L * DM * DM, DM, DM, (bf16_t*)(Wl + WO_PG), 0, INF(23) + L * DM, nullptr, DM, scr, r, lane); continue; } r -= I_PG;
            conv_item(INF(25) + (size_t)L * 256 * DM, 256, DM, (bf16_t*)(Wl + WO_PP), 0, nullptr, nullptr, 0, scr, r, lane);
        }
        for (int it = gw; it < 2 * (88 + 220); it += NGW) {
            const int L = it >= 308 ? 1 : 0; int r = it - L * 308; bf16_t* dst;
            if (r < 88) { const int lr = r < 24 ? 104 + r : 192 + (r - 24); dst = (bf16_t*)(Wl + WO_IN) + (size_t)(256 + lr) * DM; }
            else { r -= 88; const int lr = r < 96 ? 32 + r : 132 + (r - 96); dst = (bf16_t*)(Wl + WO_RT) + (size_t)lr * DM; }
            *(u32x4*)(dst + lane * 8) = (u32x4){0u, 0u, 0u, 0u}; *(u32x4*)(dst + 512 + lane * 8) = (u32x4){0u, 0u, 0u, 0u};
        }
        for (int m = gw; m < NTOK; m += NGW) { const f32x4* xr = (const f32x4*)(x_in + (size_t)m * DM) + lane; float s = 0.f; u32x2* o8 = (u32x2*)(xbA + (size_t)m * DM) + lane;
#pragma unroll
            for (int j = 0; j < 4; ++j) { const f32x4 v = xr[64 * j]; s += sum4sq(v); u32x2 w; w.x = cvt_pk_bf16(v[0], v[1]); w.y = cvt_pk_bf16(v[2], v[3]); o8[64 * j] = w; }
            s = wave_sum(s); if (lane < 16) ssx0[(size_t)m * 16 + lane] = lane == 0 ? s : 0.f; }
        for (size_t i = gt; i < (size_t)DEPTH * NTOK * 256 / 8; i += NGT) { const f32x4 a = ((const f32x4*)INF(1))[2 * i], b = ((const f32x4*)INF(1))[2 * i + 1]; ((u32x4*)pbf)[i] = pack8(a, b); }
        for (int i = gt; i < NTOK * 16; i += NGT) { const int t = i >> 4, j = i & 15; const double inv = exp2(-(double)j * (13.287712379549449 / 16.0)); const double ang = (double)((const int*)args.in[2])[t] * inv;
            cosT[i] = (float)cos(ang); sinT[i] = (float)sin(ang); }
        }
    }
    SEAM(0);

#pragma unroll 1
    for (int L = 0; L < DEPTH; ++L) {
        const int pb = 1 + 9 * L;
        if (PHM(1) && IN(pb + 0)) {
            PHASE_PTRS;
            pg8::Gemm g{xbA, (const bf16_t*)(Wl + WO_IN), DM}; pg8::StaticOrder S; S.init(NTOK, 2048, G, bx, WGM_P1);
            EpiInProj E{wsp, INF(13) + L * 8, INF(11) + L * 64, INF(12) + L * 64};
            for (int rep_ = 0; rep_ < NREP(1); ++rep_) pg8::gemm_phase<DM, EpiInProj, pg8::StaticOrder, true>(lds, g, S, E);
            if (NULLP(1)) { EpiNull EN{(float*)(wsp + WS_SSX2)}; pg8::gemm_phase<DM, EpiNull, pg8::StaticOrder, true>(lds, g, S, EN); }
        }
        SEAM(pb + 0);
        if (PHM(2) && IN(pb + 1)) {
            PHASE_PTRS;
            { pg8::Gemm g{Qc, (const bf16_t*)(Wl + WO_UQ), 256}; pg8::StaticOrder S; S.init(NTOK, 768, G, bx, WGM_P2);
              EpiQUp E{wsp};
              for (int rep_ = 0; rep_ < NREP(2); ++rep_) pg8::gemm_phase<256, EpiQUp, pg8::StaticOrder, true>(lds, g, S, E); }
            { pg8::Gemm g{Kvc, (const bf16_t*)(Wl + WO_UKV), 128}; pg8::StaticOrder S; S.init(NTOK, 1024, G, bx, WGM_P2);
              EpiKvUp E{wsp, INF(10) + L * 96};
              for (int rep_ = 0; rep_ < NREP(2); ++rep_) pg8::gemm_phase<128, EpiKvUp, pg8::StaticOrder, true>(lds, g, S, E); }
            for (int v = vcu; v < 32; v += G) {
                const int b = v >> 3, h = v & 7; LAS double* wt = (LAS double*)lds;
                const size_t base = ((size_t)b * SEQ + wave * 1024 + lane * 16) * 8 + h; float lv[16]; double loc = 0.0;
#pragma unroll
                for (int i = 0; i < 16; ++i) { lv[i] = logf[base + (size_t)i * 8]; loc += (double)lv[i]; }
                double pre = loc;
#pragma unroll
                for (int o = 1; o < 64; o <<= 1) { const double n = __shfl_up(pre, o); if (lane >= o) pre += n; }
                if (lane == 63) wt[wave] = pre;
                LDS_WAIT(); __syncthreads();
                double run = pre - loc;
                for (int w = 0; w < wave; ++w) run += wt[w];
#pragma unroll
                for (int i = 0; i < 16; ++i) { run += (double)lv[i]; Fc[base + (size_t)i * 8] = (float)run; }
                __syncthreads();
            }
        }
        SEAM(pb + 1);
        if (PHM(3) && IN(pb + 2)) {
            PHASE_PTRS;
            att::Args A{Qraw, Kmla, Vmla, Fq, Fk, Fv, ssqn, ssqr, INF(9) + L * 96, cosT, sinT, Fc, INF(11) + L * 64, INF(12) + L * 64, ob, sso};
#ifdef DIAG_SEL
            LAS float* dg = (L == 0 && blockIdx.x == DIAG_BLOCK && tid == 0) ? (LAS float*)(lds0 + LDSCTL_OFF + 8192) : (LAS float*)nullptr;
            if (dg) for (int k = 0; k < 16; ++k) dg[k] = 0.f;
            att::attn_phase(A, vcu, G, (LAS char*)lds, NREP(10), NREP(11), dg, ctl + CW_FQ + 64 * L, INF(13) + L * 8, (LAS int*)(lds + LDSCTL_OFF + LC_QS));
            if (dg) { float* dw = (float*)(wsp + WS_CTL) + 250000; for (int k = 0; k < 16; ++k) dw[k] = dg[k]; }
#else
            att::attn_phase(A, vcu, G, (LAS char*)lds, NREP(10), NREP(11), (LAS float*)nullptr, ctl + CW_FQ + 64 * L, INF(13) + L * 8, (LAS int*)(lds + LDSCTL_OFF + LC_QS));
#endif
        }
        SEAM(pb + 2);
        if (PHM(4) && IN(pb + 3)) {
            PHASE_PTRS;
            pg8::Gemm g{ob, (const bf16_t*)(Wl + WO_OUT), DM}; pg8::StaticOrder S; S.init(NTOK, DM, G, bx, WGM_P4);
            EpiOut E{wsp, (const float*)nullptr};
            for (int rep_ = 0; rep_ < (L == 0 ? NREP(4) : 1); ++rep_) pg8::gemm_phase<DM, EpiOut, pg8::StaticOrder, true>(lds, g, S, E);
            if (NULLP(4)) { EpiNull EN{(float*)(wsp + WS_SSX2)}; pg8::gemm_phase<DM, EpiNull, pg8::StaticOrder, true>(lds, g, S, EN); }
        }
        SEAM(pb + 3);
        if (PHM(5) && IN(pb + 4)) {
            PHASE_PTRS;
            { pg8::Gemm g{xbB, (const bf16_t*)(Wl + WO_RT), DM}; pg8::StaticOrder S; S.init(NTOK, 256, G, bx);
              EpiRouter E{wsp, ctl + CW_CNT + 8192 * L, (LAS unsigned*)(lds + LDSCTL_OFF + LC_RCNT)};
              pg8::gemm_phase<DM, EpiRouter, pg8::StaticOrder, true>(lds, g, S, E); }
            { pg8::Gemm g{pbf + (size_t)L * NTOK * 256, (const bf16_t*)(Wl + WO_PP), 256}; const PPOrder S = (G == 256) ? PPOrder{bx >= 128 ? bx - 128 : -1, 512, 128} : PPOrder{bx, G, 512};
              EpiPP E{wsp};
              pg8::gemm_phase<256, EpiPP, PPOrder, true>(lds, g, S, E); }
        }
        SEAM(pb + 4);
        if ((PHM(6) && IN(pb + 5)) || (PHM(7) && IN(pb + 6))) {
            PHASE_PTRS;
#pragma unroll 1
            for (int q = 0; q < 4; ++q) {
                const int e = wave * 4 + q; const unsigned* cg = ctl + CW_CNT + 8192 * L + e * NSUB + 4 * lane; unsigned c[4];
#pragma unroll
                for (int j = 0; j < 4; ++j) c[j] = __hip_atomic_load(cg + j, RLX_AGENT);
                const unsigned tot = (c[0] + c[1]) + (c[2] + c[3]); unsigned inc = tot;
#pragma unroll
                for (int o = 1; o < 64; o <<= 1) { const unsigned nb = __shfl_up(inc, o); if (lane >= o) inc += nb; }
                unsigned run = inc - tot; LAS unsigned short* so = suboL + e * (NSUB + 1) + 4 * lane;
#pragma unroll
                for (int j = 0; j < 4; ++j) { run += c[j]; so[j + 1] = (unsigned short)run; }
                if (lane == 0) suboL[e * (NSUB + 1)] = 0; if (lane == 63) cntL[e] = run; }
            LDS_WAIT(); __syncthreads();
            if (tid == 0) { int run = 0; for (int e = 0; e < 32; ++e) { preL[e] = run; run += ((int)cntL[e] + 255) >> 8; } preL[32] = run; }
            LDS_WAIT(); __syncthreads();
        }
        if (PHM(6) && IN(pb + 5)) {
            PHASE_PTRS;
            pg8::Gemm g{xbB, (const bf16_t*)(Wl + WO_GU), DM}; MoeOrder S{preL, cntL, suboL, list, 2, G, vcu, true};
            EpiMoeUp E{wsp, cntL, suboL, 2};
            for (int rep_ = 0; rep_ < NREP(6); ++rep_) pg8::gemm_phase<DM, EpiMoeUp, MoeOrder, true>(lds, g, S, E);
            if (G == 256) {
                const int TB = preL[32]; int n3 = 2 * TB - 512; n3 = n3 < 0 ? 0 : (n3 > 256 ? 256 : n3); int n6 = (TB <= 256) ? 0 : 256 - n3; n6 = n6 > 384 ? 384 : n6;
                pg8::Gemm gp{pbf + (size_t)L * NTOK * 256, (const bf16_t*)(Wl + WO_PP), 256}; const PPOrder Sp{(vcu >= n3 && vcu - n3 < n6) ? 128 + (vcu - n3) : -1, 512, 128 + n6}; EpiPP Ep{wsp};
                pg8::gemm_phase<256, EpiPP, PPOrder, true>(lds, gp, Sp, Ep); }
        }
        SEAM(pb + 5);
        if (PHM(7) && IN(pb + 6)) {
            PHASE_PTRS;
            pg8::Gemm g{hid, (const bf16_t*)(Wl + WO_DN), 256}; MoeOrder S{preL, cntL, suboL, list, 4, G, vcu, false};
            EpiMoeDown E{wsp, cntL, suboL, 4};
            pg8::gemm_phase<256, EpiMoeDown, MoeOrder, true>(lds, g, S, E);
            if (G == 256) {
                const int TB = preL[32]; int n3 = 2 * TB - 512; n3 = n3 < 0 ? 0 : (n3 > 256 ? 256 : n3); int n6 = (TB <= 256) ? 0 : 256 - n3; n6 = n6 > 384 ? 384 : n6;
                const int r7 = (4 * TB) & 255; const int rot = (vcu - r7) & 255;
                pg8::Gemm gp{pbf + (size_t)L * NTOK * 256, (const bf16_t*)(Wl + WO_PP), 256}; const PPOrder Sp{128 + n6 + rot, 256, 512}; EpiPP Ep{wsp};
                pg8::gemm_phase<256, EpiPP, PPOrder, true>(lds, gp, Sp, Ep); }
        }
        SEAM(pb + 6);
        if (PHM(8) && IN(pb + 7)) {
            PHASE_PTRS;
            for (int m = gw; m < NTOK; m += NGW) { const u32x4* cr = (const u32x4*)(c1 + (size_t)m * DM) + lane; u32x4* xr = (u32x4*)(xbB + (size_t)m * DM) + lane; float s = 0.f;
#pragma unroll
                for (int j = 0; j < 2; ++j) { const u32x4 cw = cr[64 * j], xw = xr[64 * j];
                    const f32x4 v0 = (f32x4){bflo(xw.x), bfhi(xw.x), bflo(xw.y), bfhi(xw.y)} + (f32x4){bflo(cw.x), bfhi(cw.x), bflo(cw.y), bfhi(cw.y)}, v1 = (f32x4){bflo(xw.z), bfhi(xw.z), bflo(xw.w), bfhi(xw.w)} + (f32x4){bflo(cw.z), bfhi(cw.z), bflo(cw.w), bfhi(cw.w)};
                    s += sum4sq(v0) + sum4sq(v1); xr[64 * j] = pack8(v0, v1); }
                s = wave_sum(s); if (lane == 0) ssx2[m] = s; }
        }
        SEAM(pb + 7);
        if (PHM(9) && IN(pb + 8)) {
            PHASE_PTRS;
            pg8::Gemm g{xbB, (const bf16_t*)(Wl + WO_PG), DM}; pg8::StaticOrder S; S.init(NTOK, DM, G, bx, WGM_P4);
            EpiPle E{wsp, INF(26) + L * DM, L + 1 == DEPTH ? xo : (float*)nullptr};
            pg8::gemm_phase<DM, EpiPle, pg8::StaticOrder, true>(lds, g, S, E);
        }
        if (L + 1 < DEPTH) SEAM(pb + 8);
    }
#undef IN
#undef SEAM
#undef INF
}

extern "C" void kernel_launch(void* const* d_in, const int* in_sizes, int n_in, void* d_out, int out_size, void* d_ws, size_t ws_size, hipStream_t stream) {
    static int grid = 0;
    if (grid == 0) {
        if (n_in != 27 || ws_size < WS_END) { fprintf(stderr, "kernel_launch: unexpected inputs (n_in %d, ws %zu)\n", n_in, ws_size); grid = -1; return; }
        int dev = 0, cus = 0, per_cu = 0;
        if (hipGetDevice(&dev) != hipSuccess || hipDeviceGetAttribute(&cus, hipDeviceAttributeMultiprocessorCount, dev) != hipSuccess) { grid = -1; return; }
        if (hipFuncSetAttribute((const void*)mega_fwd, hipFuncAttributeMaxDynamicSharedMemorySize, LDS_BYTES) != hipSuccess) { fprintf(stderr, "kernel_launch: hipFuncSetAttribute failed\n"); grid = -1; return; }
        if (hipOccupancyMaxActiveBlocksPerMultiprocessor(&per_cu, (const void*)mega_fwd, NWAVES * 64, LDS_BYTES) != hipSuccess || per_cu < 1) { fprintf(stderr, "kernel_launch: occupancy query says %d\n", per_cu); }
        (void)hipGetLastError();
        grid = cus;
    }
    if (grid < 0) return;
    if (hipMemsetAsync((char*)d_ws + WS_CTL, 0, CTL_ZERO_BYTES, stream) != hipSuccess) return;
    KArgs a{};
    for (int i = 0; i < 27; ++i) a.in[i] = d_in[i];
    a.out = (float*)d_out; a.ws = (unsigned char*)d_ws;
    const int cuts[] = MK_CUTS; const int nl = (int)(sizeof(cuts) / sizeof(int)) - 1;
    for (int li = 0; li < nl; ++li) {
        a.ph_lo = cuts[li]; a.ph_hi = cuts[li + 1]; a.li = li; a.pad = 0;
        hipLaunchKernelGGL(mega_fwd, dim3(grid), dim3(NWAVES * 64), LDS_BYTES, stream, a);
        if (hipPeekAtLastError() != hipSuccess) { fprintf(stderr, "kernel_launch: launch %d failed\n", li); break; }
    }
}
```

```cpp
#include <hip/hip_runtime.h>
#include <cstdio>
#include <cstdint>

#define LAS __attribute__((address_space(3)))
#define GAS __attribute__((address_space(1)))
typedef unsigned short bf16_t;
typedef short bf16x8 __attribute__((ext_vector_type(8)));
typedef short s16x4 __attribute__((ext_vector_type(4)));
typedef float f32x2 __attribute__((ext_vector_type(2)));
typedef float f32x4 __attribute__((ext_vector_type(4)));
typedef float f32x16 __attribute__((ext_vector_type(16)));
typedef unsigned u32x2 __attribute__((ext_vector_type(2)));
typedef unsigned u32x4 __attribute__((ext_vector_type(4)));

constexpr int DM = 1024, NB = 4, SEQ = 8192, NTOK = NB * SEQ, DEPTH = 2;
constexpr int INC = 1960, NEXP = 32;
constexpr int C_KVC = 256, C_KPE = 384, C_FQ = 416, C_FK = 928, C_FV = 1440, C_FL = 1952;
constexpr float EPS = 1e-6f;
constexpr float LOG2E = 1.4426950408889634f;
constexpr float C2_FOX = 0.125f * LOG2E;
constexpr float C2_MLA = 0.10206207261596575f * LOG2E;

__device__ __forceinline__ unsigned cvt_pk_bf16(float lo, float hi) { unsigned r; asm volatile("v_cvt_pk_bf16_f32 %0, %1, %2" : "=v"(r) : "v"(lo), "v"(hi)); return r; }
__device__ __forceinline__ float bf2f(unsigned short u) { return __uint_as_float((unsigned)u << 16); }
__device__ __forceinline__ float bflo(unsigned w) { return __uint_as_float(w << 16); }
__device__ __forceinline__ float bfhi(unsigned w) { return __uint_as_float(w & 0xffff0000u); }
__device__ __forceinline__ u32x4 pack8(const f32x4& a, const f32x4& b) { u32x4 w; w.x = cvt_pk_bf16(a[0], a[1]); w.y = cvt_pk_bf16(a[2], a[3]); w.z = cvt_pk_bf16(b[0], b[1]); w.w = cvt_pk_bf16(b[2], b[3]); return w; }

__device__ __forceinline__ void st16(void* p, const u32x4& v) { asm volatile("global_store_dwordx4 %0, %1, off sc1" :: "v"(p), "v"(v) : "memory"); }
__device__ __forceinline__ void st8(void* p, const u32x2& v) { asm volatile("global_store_dwordx2 %0, %1, off sc1" :: "v"(p), "v"(v) : "memory"); }
__device__ __forceinline__ void st16f(void* p, const f32x4& v) { asm volatile("global_store_dwordx4 %0, %1, off sc1" :: "v"(p), "v"(v) : "memory"); }
__device__ __forceinline__ float sum4sq(const f32x4& a) { return (a[0] * a[0] + a[1] * a[1]) + (a[2] * a[2] + a[3] * a[3]); }
__device__ __forceinline__ float red_fq(float s) {
    { auto rr = __builtin_amdgcn_permlane16_swap(__float_as_uint(s), __float_as_uint(s), false, false); s = __uint_as_float(rr[0]) + __uint_as_float(rr[1]); }
    { auto rr = __builtin_amdgcn_permlane32_swap(__float_as_uint(s), __float_as_uint(s), false, false); s = __uint_as_float(rr[0]) + __uint_as_float(rr[1]); }
    return s; }
__device__ __forceinline__ float sum16(const float* p) { const f32x4 a = *(const f32x4*)p, b = *(const f32x4*)(p + 4), c = *(const f32x4*)(p + 8), d = *(const f32x4*)(p + 12);
    return ((a[0] + a[1]) + (a[2] + a[3])) + ((b[0] + b[1]) + (b[2] + b[3])) + ((c[0] + c[1]) + (c[2] + c[3])) + ((d[0] + d[1]) + (d[2] + d[3])); }
__device__ __forceinline__ float sum8(const float* p) { const f32x4 a = *(const f32x4*)p, b = *(const f32x4*)(p + 4); return ((a[0] + a[1]) + (a[2] + a[3])) + ((b[0] + b[1]) + (b[2] + b[3])); }
__device__ __forceinline__ float log_sigmoid_f(float x) {
    const float y = __builtin_amdgcn_exp2f(-fabsf(x) * LOG2E);
    const float ser = y * (1.f - y * (0.5f - y * (0.33333334f - 0.25f * y)));
    const float lg = __builtin_amdgcn_logf(1.f + y) * 0.6931471805599453f;
    return -(fmaxf(-x, 0.f) + (y < 0.015625f ? ser : lg));
}

constexpr int NWAVES = 8;
constexpr size_t MiB = 1u << 20;
constexpr size_t WS_CTL = 0, CTL_ZERO_BYTES = 1 * MiB;
constexpr size_t WS_SSX0 = 1 * MiB, WS_SSX1 = 3 * MiB, WS_SSPP = 5 * MiB, WS_SSO = 7 * MiB, WS_SSX2 = 9 * MiB, WS_SSKPE = 10 * MiB, WS_SSQQ = 11 * MiB, WS_SSQKV = 12 * MiB,
                 WS_GATE = 13 * MiB, WS_LOGF = 14 * MiB, WS_F = 15 * MiB, WS_SSQN = 16 * MiB, WS_SSQR = 17 * MiB, WS_COS = 18 * MiB, WS_SIN = 20 * MiB, WS_LIST = 22 * MiB;
constexpr size_t WS_W = 28 * MiB, W_LAYER = 58 * MiB;
constexpr size_t WO_IN = 0, WO_UQ = 4 * MiB, WO_UKV = 4 * MiB + 512 * 1024, WO_OUT = 5 * MiB, WO_RT = 7 * MiB, WO_PG = 7 * MiB + 512 * 1024, WO_PP = 9 * MiB + 512 * 1024, WO_GU = 10 * MiB, WO_DN = 42 * MiB;
constexpr size_t WS_XBA = 144 * MiB, WS_XBB = 208 * MiB, WS_PBF = 272 * MiB, WS_MIX = 304 * MiB;
constexpr size_t WS_O = WS_XBA, WS_QRAW = WS_XBB;
constexpr size_t WS_QC = WS_MIX, WS_KVC = WS_MIX + 16 * MiB, WS_KPE = WS_MIX + 24 * MiB, WS_FQ = WS_MIX + 26 * MiB, WS_FK = WS_MIX + 58 * MiB, WS_FV = WS_MIX + 90 * MiB, WS_KMLA = WS_MIX + 122 * MiB, WS_VMLA = WS_MIX + 170 * MiB;
constexpr size_t WS_PP = WS_MIX, WS_HID = WS_MIX + 64 * MiB, WS_C1 = WS_MIX + 100 * MiB;
constexpr size_t WS_END = 512 * MiB;
static_assert(WS_VMLA + 32 * MiB <= WS_END && WS_C1 + 64 * MiB <= WS_END && WS_W + 2 * W_LAYER <= WS_XBA, "d_ws map");
constexpr int HID_ROWS = 2 * NTOK + NEXP * 256;
static_assert((size_t)HID_ROWS * 256 * 2 <= 36 * MiB, "hid");

constexpr int NSUB = 256, SUBCAP = 128;
__device__ __forceinline__ int list_at(const int* list, const LAS unsigned short* subo, int e, int li) {
    const LAS unsigned short* so = subo + e * (NSUB + 1); int sidx = 0;
#pragma unroll
    for (int step = NSUB / 2; step >= 1; step >>= 1) sidx += ((int)so[sidx + step] <= li) ? step : 0;
    return list[(size_t)(e * NSUB + sidx) * SUBCAP + (li - (int)so[sidx])];
}
namespace pg8 {
constexpr int TAB_OFF = 131072 + 1024;
constexpr int BM = 256, BK = 64, HALF = 128, HTB = HALF * BK * 2, STAGE_BYTES = 8 * HTB, NXCD = 8, WGM = 8;
__host__ __device__ __forceinline__ int lds_byte(int r, int c) { const int st = (r >> 4) * 2 + (c >> 5), rr = r & 15, cc = c & 31, ob = rr * 64 + cc * 2; return st * 1024 + (ob ^ (((ob >> 9) & 1) << 5)); }
__host__ __device__ __forceinline__ void stage_rc(int b, int& R, int& C) { const int st = b / 1024, sb = b % 1024, swz = sb ^ (((sb >> 9) & 1) << 5); R = (st >> 1) * 16 + swz / 64; C = (st & 1) * 32 + (swz % 64) / 2; }
__host__ __device__ __forceinline__ int perm32(int rho) { const int n = rho >> 4, i = rho & 15; return 8 * (i >> 2) + 4 * n + (i & 3); }

struct Unit { int pm, pn, e, blk; };
struct Gemm { const bf16_t* A; const bf16_t* Bt; int K; };

struct StaticOrder {
    int nM, nN, nwg, G, c, wgm;
    __device__ void init(int M, int N, int G_, int c_, int wgm_ = 16) { nM = M / BM; nN = N / BM; nwg = nM * nN; G = G_; c = c_; wgm = wgm_; }
    __device__ bool next(int i, Unit& u) const {
        const long L = (long)i * G + c; if (L >= nwg) return false;
        int wgid = (int)L; { const int q = nwg / NXCD, r = nwg % NXCD, xcd = wgid % NXCD, off = wgid / NXCD; wgid = (xcd < r ? xcd * (q + 1) : r * (q + 1) + (xcd - r) * q) + off; }
        const int nig = wgm * nN, gid = wgid / nig, fm = gid * wgm, gsz = (nM - fm) < wgm ? (nM - fm) : wgm;
        u.pm = fm + ((wgid % nig) % gsz); u.pn = (wgid % nig) / gsz; u.e = 0; u.blk = 0; return true;
    }
    __device__ __forceinline__ int arow(const Unit& u, int r) const { return u.pm * BM + r; }
    __device__ __forceinline__ bool half(const Unit&) const { return false; }
};
struct KvOrder {
    int G, c;
    __device__ bool next(int i, Unit& u) const {
        int L;
        if (G == 256) { if (c >= 128) { if (i >= 3) return false; L = (c - 128) * 3 + i; } else { if (i >= 1) return false; L = 384 + c; } }
        else { L = i * G + c; if (L >= 512) return false; }
        u.pm = L >> 2; u.pn = L & 3; u.e = 0; u.blk = 0; return true;
    }
    __device__ __forceinline__ int arow(const Unit& u, int r) const { return u.pm * BM + r; }
    __device__ __forceinline__ bool half(const Unit&) const { return false; }
};

template <int K, class Epi, class Sched, bool ALIGN_EPI>
__device__ __forceinline__ void gemm_phase(LAS unsigned char* lds, const Gemm g, const Sched& S, const Epi& E) {
    LAS f32x2* const tab0 = (LAS f32x2*)(lds + TAB_OFF);
    int tid_ = threadIdx.x; asm volatile("" : "+v"(tid_));
    const int tid = tid_, wid = __builtin_amdgcn_readfirstlane(tid >> 6), lane = tid & 63, wr = wid >> 2, wc = wid & 3, fr = lane & 15, fq = lane >> 4;
    int Kr = K; asm volatile("" : "+s"(Kr));
    const int nt = Kr / BK;
    unsigned voffB[2];
#pragma unroll
    for (int i = 0; i < 2; ++i) { int R_, C_; stage_rc(tid * 16 + i * 8192, R_, C_); const int Rb = (R_ & ~31) + perm32(R_ & 31); voffB[i] = (unsigned)(Rb * Kr + C_) * 2u; }
    const size_t kstep = (size_t)(BK * 2);
    const size_t hstep = (size_t)HALF * Kr * 2;
    const size_t tstep = 2 * hstep;
    const unsigned ldsw = (unsigned)wid * 1024u;
    const int aoff = lds_byte(wr * 64 + fr, fq * 8), boff = lds_byte(wc * 32 + fr, fq * 8);
#define PG8_SA(b, h) (((b) * 2 + (h)) * HTB)
#define PG8_SB(b, h) ((4 + (b) * 2 + (h)) * HTB)
#define PG8_STAGE(bufoff, gbase, voff) do { _Pragma("unroll") for (int _i = 0; _i < 2; ++_i) \
        __builtin_amdgcn_global_load_lds((const unsigned*)((const char*)(gbase) + (voff)[_i]), (LAS unsigned*)(lds + (bufoff) + ldsw + _i * 8192), 16, 0, 0); } while (0)
#define PG8_LDA(dst, b, h) do { _Pragma("unroll") for (int m = 0; m < 4; ++m) _Pragma("unroll") for (int k = 0; k < 2; ++k) dst[m][k] = *(const LAS bf16x8*)(lds + PG8_SA(b, h) + aoff + m * 2048 + k * 1024); } while (0)
#define PG8_LDB(dst, b, h) do { _Pragma("unroll") for (int n = 0; n < 2; ++n) _Pragma("unroll") for (int k = 0; k < 2; ++k) dst[n][k] = *(const LAS bf16x8*)(lds + PG8_SB(b, h) + boff + n * 2048 + k * 1024); } while (0)
#define PG8_MMA(ai, bj, At, Bt) do { __builtin_amdgcn_s_setprio(1); _Pragma("unroll") for (int m = 0; m < 4; ++m) _Pragma("unroll") for (int n = 0; n < 2; ++n) _Pragma("unroll") for (int k = 0; k < 2; ++k) \
        acc[ai][bj][m][n] = __builtin_amdgcn_mfma_f32_16x16x32_bf16(Bt[n][k], At[m][k], acc[ai][bj][m][n], 0, 0, 0); __builtin_amdgcn_s_setprio(0); } while (0)
#define PG8_WAIT_V(n) asm volatile("s_waitcnt vmcnt(" #n ")" ::: "memory")
#define PG8_WAIT_L(n) asm volatile("s_waitcnt lgkmcnt(" #n ")" ::: "memory")
#define PG8_BAR __builtin_amdgcn_s_barrier()
#define PG8_SCHED __builtin_amdgcn_sched_barrier(0)
#define PG8_AOFF(dst, u) do { int _t = tid; asm volatile("" : "+v"(_t)); _Pragma("unroll") for (int _i = 0; _i < 2; ++_i) { int _R, _C; stage_rc(_t * 16 + _i * 8192, _R, _C); _Pragma("unroll") for (int _h = 0; _h < 2; ++_h) dst[_h][_i] = ((unsigned)S.arow(u, _h * HALF + _R) * (unsigned)Kr + (unsigned)_C) * 2u; } } while (0)
    Unit cur, nxt; int ui = 0;
    if (!S.next(0, cur)) return;
    f32x4 acc[2][2][4][2];
#pragma unroll
    for (int a = 0; a < 2; ++a)
#pragma unroll
        for (int b = 0; b < 2; ++b)
#pragma unroll
            for (int m = 0; m < 4; ++m)
#pragma unroll
                for (int n = 0; n < 2; ++n) acc[a][b][m][n] = (f32x4){0.f, 0.f, 0.f, 0.f};
    bf16x8 At[4][2], B0[2][2], B1[2][2];
    unsigned ca[2][2], na[2][2];
    PG8_AOFF(ca, cur);
    const char* gA = (const char*)g.A;
    const char* cB = (const char*)g.Bt + (size_t)cur.pn * tstep;
    PG8_STAGE(PG8_SB(0, 0), cB, voffB); PG8_STAGE(PG8_SB(0, 1), cB + hstep, voffB); PG8_STAGE(PG8_SA(0, 0), gA, ca[0]); PG8_STAGE(PG8_SA(0, 1), gA, ca[1]);
    if (wr == 1) PG8_BAR;
    PG8_WAIT_V(2); PG8_BAR;
    PG8_STAGE(PG8_SB(1, 0), cB + kstep, voffB); PG8_STAGE(PG8_SA(1, 0), gA + kstep, ca[0]); PG8_STAGE(PG8_SB(1, 1), cB + hstep + kstep, voffB);
    PG8_WAIT_V(6); PG8_BAR;
    E.pre(cur, tab0, tid);
    for (;;) {
        const bool has_next = S.next(ui + 1, nxt);
        if (has_next) { PG8_AOFF(na, nxt); } else {
#pragma unroll
            for (int _h = 0; _h < 2; ++_h)
#pragma unroll
                for (int _i = 0; _i < 2; ++_i) na[_h][_i] = ca[_h][_i]; }
        const char* nB = has_next ? (const char*)g.Bt + (size_t)nxt.pn * tstep : cB;
        const bool hf = S.half(cur);
        for (int t = 0; t < nt; t += 2) {
            const bool last = (t == nt - 2);
            if constexpr (Epi::HAS_MID) { if (t == nt / 2) E.mid(acc, cur, wr, wc, fr, fq, tab0 + (ui & 1) * 256); }
            const char* a1 = gA + (size_t)(t + 1) * kstep;
            const char* a2 = last ? gA : gA + (size_t)(t + 2) * kstep; const char* b2 = last ? nB : cB + (size_t)(t + 2) * kstep;
            const char* a3 = a2 + kstep; const char* b3 = b2 + kstep;
            unsigned o2[2][2];
#pragma unroll
            for (int _h = 0; _h < 2; ++_h)
#pragma unroll
                for (int _i = 0; _i < 2; ++_i) o2[_h][_i] = last ? na[_h][_i] : ca[_h][_i];
            PG8_LDB(B0, 0, 0); PG8_LDB(B1, 0, 1); PG8_SCHED; PG8_LDA(At, 0, 0); PG8_STAGE(PG8_SA(1, 1), a1, ca[1]);
            PG8_WAIT_V(8); PG8_WAIT_L(0); PG8_BAR; PG8_MMA(0, 0, At, B0); PG8_MMA(0, 1, At, B1); PG8_BAR; PG8_SCHED;
            if (!hf) { PG8_LDA(At, 0, 1); } PG8_STAGE(PG8_SB(0, 0), b2, voffB); PG8_STAGE(PG8_SB(0, 1), b2 + hstep, voffB); PG8_STAGE(PG8_SA(0, 0), a2, o2[0]);
            PG8_WAIT_V(8); PG8_WAIT_L(0); PG8_BAR; if (!hf) { PG8_MMA(1, 0, At, B0); PG8_MMA(1, 1, At, B1); } PG8_BAR; PG8_SCHED;
            PG8_LDB(B0, 1, 0); PG8_LDB(B1, 1, 1); PG8_SCHED; PG8_LDA(At, 1, 0); PG8_STAGE(PG8_SA(0, 1), a2, o2[1]);
            PG8_WAIT_V(8); PG8_WAIT_L(0); PG8_BAR; PG8_MMA(0, 0, At, B0); PG8_MMA(0, 1, At, B1); PG8_BAR; PG8_SCHED;
            if (!hf) { PG8_LDA(At, 1, 1); } PG8_STAGE(PG8_SB(1, 0), b3, voffB); PG8_STAGE(PG8_SB(1, 1), b3 + hstep, voffB); PG8_STAGE(PG8_SA(1, 0), a3, o2[0]);
            PG8_WAIT_V(8); PG8_WAIT_L(0); PG8_BAR; if (!hf) { PG8_MMA(1, 0, At, B0); PG8_MMA(1, 1, At, B1); } PG8_BAR; PG8_SCHED;
        }
        if (has_next) E.pre(nxt, tab0 + ((ui + 1) & 1) * 256, tid);
        if constexpr (ALIGN_EPI) { if (wr == 0) PG8_BAR; }
        E(acc, cur, wr, wc, fr, fq, tab0 + (ui & 1) * 256);
        if (!has_next) break;
#pragma unroll
        for (int a = 0; a < 2; ++a)
#pragma unroll
            for (int b = 0; b < 2; ++b)
#pragma unroll
                for (int m = 0; m < 4; ++m)
#pragma unroll
                    for (int n = 0; n < 2; ++n) acc[a][b][m][n] = (f32x4){0.f, 0.f, 0.f, 0.f};
        cur = nxt; cB = nB; ++ui;
#pragma unroll
        for (int _h = 0; _h < 2; ++_h)
#pragma unroll
            for (int _i = 0; _i < 2; ++_i) ca[_h][_i] = na[_h][_i];
        if constexpr (ALIGN_EPI) { if (wr == 1) PG8_BAR; }
    }
    PG8_WAIT_V(0);
    if constexpr (!ALIGN_EPI) { if (wr == 0) PG8_BAR; }
    PG8_BAR;
#undef PG8_SA
#undef PG8_SB
#undef PG8_STAGE
#undef PG8_LDA
#undef PG8_LDB
#undef PG8_MMA
#undef PG8_WAIT_V
#undef PG8_WAIT_L
#undef PG8_BAR
#undef PG8_SCHED
#undef PG8_AOFF
}
}
using pg8::Unit;
typedef f32x4 AccT[2][2][4][2];
#define EPI_ROWS8(...) _Pragma("unroll") for (int ai = 0; ai < 2; ++ai) _Pragma("unroll") for (int m = 0; m < 4; ++m) { const int rl = ai * 128 + wr * 64 + m * 16 + fr; const int row = u.pm * 256 + rl; (void)row; __VA_ARGS__ }
#define EPI_ROWS4(...) _Pragma("unroll") for (int ai = 0; ai < 2; ++ai) _Pragma("unroll") for (int m = 0; m < 4; ++m) { const int rl = ai * 128 + wr * 64 + m * 16 + fr; const int row = u.pm * 256 + rl; (void)row; __VA_ARGS__ if (m == 3) asm volatile("" ::: "memory"); }
#define EPI_ROWS(...) _Pragma("unroll") for (int ai = 0; ai < 2; ++ai) _Pragma("unroll") for (int m = 0; m < 4; ++m) { const int rl = ai * 128 + wr * 64 + m * 16 + fr; const int row = u.pm * 256 + rl; (void)row; __VA_ARGS__ if (m & 1) asm volatile("" ::: "memory"); }

struct EpiInProj {
    static constexpr bool HAS_MID = false;
    unsigned char* ws; const float *bfox, *gfq, *gfk;
    __device__ __forceinline__ void pre(const Unit& u, LAS f32x2* tab, int tid) const { if (tid < 256) { const float* ssx = (const float*)(ws + WS_SSX0); tab[tid] = (f32x2){rsqrtf(sum16(ssx + (size_t)(u.pm * 256 + tid) * 16) * (1.f / 1024.f) + EPS), 0.f}; } }
    __device__ __forceinline__ void mid(AccT&, const Unit&, int, int, int, int, const LAS f32x2*) const {}
    __device__ __forceinline__ void operator()(const AccT& acc, const Unit& u, int wr, int wc, int fr, int fq, const LAS f32x2* tab) const {
        asm volatile("" : "+v"(fr), "+v"(fq));
        const int pn = u.pn;
        const float* ssx = (const float*)(ws + WS_SSX0); bf16_t* Qc = (bf16_t*)(ws + WS_QC); bf16_t* Kvc = (bf16_t*)(ws + WS_KVC); bf16_t* Kpe = (bf16_t*)(ws + WS_KPE);
        float* ssq_q = (float*)(ws + WS_SSQQ); float* ssq_kv = (float*)(ws + WS_SSQKV); float* ss_kpe = (float*)(ws + WS_SSKPE); float* logf = (float*)(ws + WS_LOGF);
        if (pn == 0) {
            EPI_ROWS({ const float rinv = tab[rl].x; float s = 0.f;
_Pragma("unroll")
                for (int bj = 0; bj < 2; ++bj) { const f32x4 v0 = acc[ai][bj][m][0] * rinv, v1 = acc[ai][bj][m][1] * rinv; s += sum4sq(v0) + sum4sq(v1);
                    __builtin_nontemporal_store(pack8(v0, v1), (u32x4*)(Qc + (size_t)row * 256 + bj * 128 + wc * 32 + fq * 8)); }
                s = red_fq(s); if (fq == 0) ssq_q[(size_t)row * 4 + wc] = s; })
        } else if (pn == 1) {
            EPI_ROWS({ const float rinv = tab[rl].x;
                if (wc < 2) { float s = 0.f;
_Pragma("unroll")
                    for (int bj = 0; bj < 2; ++bj) { const f32x4 v0 = acc[ai][bj][m][0] * rinv, v1 = acc[ai][bj][m][1] * rinv; s += sum4sq(v0) + sum4sq(v1);
                        *(u32x4*)(Kvc + (size_t)row * 128 + wc * 64 + bj * 32 + fq * 8) = pack8(v0, v1); }
                    s = red_fq(s); if (fq == 0) ssq_kv[(size_t)row * 2 + wc] = s;
                } else if (wc == 2) { const f32x4 v0 = acc[ai][0][m][0] * rinv, v1 = acc[ai][0][m][1] * rinv; float s = sum4sq(v0) + sum4sq(v1);
                    *(u32x4*)(Kpe + (size_t)row * 32 + fq * 8) = pack8(v0, v1);
                    s = red_fq(s); if (fq == 0) ss_kpe[row] = s;
                } else { if (fq == 0) { const f32x4 v0 = acc[ai][0][m][0] * rinv, v1 = acc[ai][0][m][1] * rinv; const f32x4 b0 = *(const f32x4*)bfox, b1 = *(const f32x4*)(bfox + 4); f32x4 o0, o1;
_Pragma("unroll")
                        for (int i = 0; i < 4; ++i) { o0[i] = log_sigmoid_f(v0[i] + b0[i]); o1[i] = log_sigmoid_f(v1[i] + b1[i]); }
                        *(f32x4*)(logf + (size_t)row * 8) = o0; *(f32x4*)(logf + (size_t)row * 8 + 4) = o1; } } })
        } else {
            const int kind = (pn - 2) >> 1, head = 4 * ((pn - 2) & 1) + wc;
            bf16_t* dst = (bf16_t*)(ws + (kind == 0 ? WS_FQ : (kind == 1 ? WS_FK : WS_FV))); const float* g = kind == 0 ? gfq : gfk; const float osc = kind == 0 ? C2_FOX : 1.f;
            f32x4 g4[2][2];
_Pragma("unroll")
            for (int bj = 0; bj < 2; ++bj)
_Pragma("unroll")
                for (int n = 0; n < 2; ++n) g4[bj][n] = kind < 2 ? *(const f32x4*)(g + bj * 32 + fq * 8 + n * 4) * osc : (f32x4){1.f, 1.f, 1.f, 1.f};
            EPI_ROWS({ const float rinv = tab[rl].x; f32x4 v[2][2]; float s = 0.f;
_Pragma("unroll")
                for (int bj = 0; bj < 2; ++bj)
_Pragma("unroll")
                    for (int n = 0; n < 2; ++n) { v[bj][n] = acc[ai][bj][m][n] * rinv; s += sum4sq(v[bj][n]); }
                s = red_fq(s); const float hr = kind < 2 ? rsqrtf(s * (1.f / 64.f) + EPS) : 1.f;
_Pragma("unroll")
                for (int bj = 0; bj < 2; ++bj) { const int bb = row >> 13, tl = (row >> 6) & 127, r = row & 63; const size_t tb = ((size_t)(bb * 8 + head) * 128 + tl) * 4096;
                    const size_t off = kind == 0 ? (size_t)row * 512 + head * 64 + bj * 32 + fq * 8 : (kind == 1 ? tb + (4 * bj + fq) * 512 + r * 8 : tb + (bj * 4 + (r >> 4)) * 512 + (r & 15) * 32 + fq * 8);
                    __builtin_nontemporal_store(pack8(v[bj][0] * hr * g4[bj][0], v[bj][1] * hr * g4[bj][1]), (u32x4*)(dst + off)); } })
        }
    }
};
struct EpiQUp {
    static constexpr bool HAS_MID = false;
    unsigned char* ws;
    __device__ __forceinline__ void pre(const Unit& u, LAS f32x2* tab, int tid) const { if (tid < 256) { const f32x4 sq = *(const f32x4*)((const float*)(ws + WS_SSQQ) + (size_t)(u.pm * 256 + tid) * 4); tab[tid] = (f32x2){rsqrtf(((sq[0] + sq[1]) + (sq[2] + sq[3])) * (1.f / 256.f) + EPS), 0.f}; } }
    __device__ __forceinline__ void mid(AccT&, const Unit&, int, int, int, int, const LAS f32x2*) const {}
    __device__ __forceinline__ void operator()(const AccT& acc, const Unit& u, int wr, int wc, int fr, int fq, const LAS f32x2* tab) const {
        asm volatile("" : "+v"(fr), "+v"(fq));
        const int pn = u.pn;
        const float* ssq_q = (const float*)(ws + WS_SSQQ); bf16_t* Qraw = (bf16_t*)(ws + WS_QRAW); float* ssq_qn = (float*)(ws + WS_SSQN); float* ssq_qr = (float*)(ws + WS_SSQR);
        EPI_ROWS({ const float rinv = tab[rl].x;
            if (pn < 2) { const int head = 4 * pn + wc; float s = 0.f;
_Pragma("unroll")
                for (int bj = 0; bj < 2; ++bj) { const f32x4 v0 = acc[ai][bj][m][0] * rinv, v1 = acc[ai][bj][m][1] * rinv; s += sum4sq(v0) + sum4sq(v1);
                    *(u32x4*)(Qraw + (size_t)row * 768 + head * 96 + bj * 32 + fq * 8) = pack8(v0, v1); }
                s = red_fq(s); if (fq == 0) ssq_qn[(size_t)row * 8 + head] = s;
            } else {
_Pragma("unroll")
                for (int bj = 0; bj < 2; ++bj) { const int head = 4 * bj + wc; const f32x4 v0 = acc[ai][bj][m][0] * rinv, v1 = acc[ai][bj][m][1] * rinv; float s = sum4sq(v0) + sum4sq(v1);
                    *(u32x4*)(Qraw + (size_t)row * 768 + head * 96 + 64 + fq * 8) = pack8(v0, v1);
                    s = red_fq(s); if (fq == 0) ssq_qr[(size_t)row * 8 + head] = s; }
            } })
    }
};
struct EpiKvUp {
    static constexpr bool HAS_MID = false;
    unsigned char* ws; const float* gk;
    __device__ __forceinline__ void pre(const Unit& u, LAS f32x2* tab, int tid) const { if (tid < 256) { const size_t r = (size_t)(u.pm * 256 + tid); const f32x2 sk = *(const f32x2*)((const float*)(ws + WS_SSQKV) + r * 2); tab[tid] = (f32x2){rsqrtf((sk[0] + sk[1]) * (1.f / 128.f) + EPS), ((const float*)(ws + WS_SSKPE))[r]}; } }
    __device__ __forceinline__ void mid(AccT&, const Unit&, int, int, int, int, const LAS f32x2*) const {}
    __device__ __forceinline__ void operator()(const AccT& acc, const Unit& u, int wr, int wc, int fr, int fq, const LAS f32x2* tab) const {
        asm volatile("" : "+v"(fr), "+v"(fq));
        const int pn = u.pn;
        const float* ssq_kv = (const float*)(ws + WS_SSQKV); const float* ss_kpe = (const float*)(ws + WS_SSKPE); const bf16_t* Kpe = (const bf16_t*)(ws + WS_KPE);
        const float* cosT = (const float*)(ws + WS_COS); const float* sinT = (const float*)(ws + WS_SIN); bf16_t* Kmla = (bf16_t*)(ws + WS_KMLA); bf16_t* Vmla = (bf16_t*)(ws + WS_VMLA);
        if (pn < 2) {
            const int head = 4 * pn + wc;
            f32x4 g4[2][2];
_Pragma("unroll")
            for (int bj = 0; bj < 2; ++bj)
_Pragma("unroll")
                for (int n = 0; n < 2; ++n) g4[bj][n] = *(const f32x4*)(gk + bj * 32 + fq * 8 + n * 4);
            const f32x4 gr1 = *(const f32x4*)(gk + 64 + 4 * fq), gr2 = *(const f32x4*)(gk + 80 + 4 * fq);
_Pragma("unroll")
            for (int ab = 0; ab < 4; ++ab) { const int ai = ab >> 1, m0 = (ab & 1) * 2;
                u32x2 p1v[4], p2v[4]; f32x4 cv[4], snv[4];
_Pragma("unroll")
                for (int m = m0; m < m0 + 2; ++m) { const size_t row = (size_t)(u.pm * 256 + ai * 128 + wr * 64 + m * 16 + fr);
                    p1v[m] = *(const GAS u32x2*)((const GAS bf16_t*)Kpe + row * 32 + 4 * fq); p2v[m] = *(const GAS u32x2*)((const GAS bf16_t*)Kpe + row * 32 + 16 + 4 * fq);
                    cv[m] = *(const GAS f32x4*)((const GAS float*)cosT + row * 16 + 4 * fq); snv[m] = *(const GAS f32x4*)((const GAS float*)sinT + row * 16 + 4 * fq); }
                asm volatile("" ::: "memory");
_Pragma("unroll")
                for (int m = m0; m < m0 + 2; ++m) { const int rl = ai * 128 + wr * 64 + m * 16 + fr; const int row = u.pm * 256 + rl;
 const f32x2 tt = tab[rl]; const float rinv = tt.x; f32x4 v[2][2]; float s = 0.f;
_Pragma("unroll")
                for (int bj = 0; bj < 2; ++bj)
_Pragma("unroll")
                    for (int n = 0; n < 2; ++n) { v[bj][n] = acc[ai][bj][m][n] * rinv; s += sum4sq(v[bj][n]); }
                s = red_fq(s) + tt.y; const float hr = rsqrtf(s * (1.f / 96.f) + EPS);
                const int bb = row >> 13, tl = (row >> 6) & 127, r = row & 63; bf16_t* kd = Kmla + ((size_t)(bb * 8 + head) * 128 + tl) * 6144 + r * 8;
_Pragma("unroll")
                for (int bj = 0; bj < 2; ++bj) {
                    const f32x4 ka = v[bj][0] * hr * g4[bj][0], kb = v[bj][1] * hr * g4[bj][1]; u32x2 wa, wb;
                    wa.x = cvt_pk_bf16(ka[0], ka[1]); wa.y = cvt_pk_bf16(ka[2], ka[3]); wb.x = cvt_pk_bf16(kb[0], kb[1]); wb.y = cvt_pk_bf16(kb[2], kb[3]);
                    bf16_t* kc = kd + (4 * bj + 2 * (fq >> 1)) * 512 + 4 * (fq & 1); *(u32x2*)kc = wa; *(u32x2*)(kc + 512) = wb; }
                const u32x2 p1 = p1v[m], p2 = p2v[m];
                const f32x4 c = cv[m], sn = snv[m];
                const f32x4 x1 = (f32x4){bflo(p1.x), bfhi(p1.x), bflo(p1.y), bfhi(p1.y)} * hr * gr1, x2 = (f32x4){bflo(p2.x), bfhi(p2.x), bflo(p2.y), bfhi(p2.y)} * hr * gr2;
                const f32x4 o1 = x1 * c - x2 * sn, o2 = x2 * c + x1 * sn;
                u32x2 w1, w2; w1.x = cvt_pk_bf16(o1[0], o1[1]); w1.y = cvt_pk_bf16(o1[2], o1[3]); w2.x = cvt_pk_bf16(o2[0], o2[1]); w2.y = cvt_pk_bf16(o2[2], o2[3]);
                *(u32x2*)(kd + (8 + (fq & 1)) * 512 + 4 * (fq >> 1)) = w1; *(u32x2*)(kd + (10 + (fq & 1)) * 512 + 4 * (fq >> 1)) = w2; }
                asm volatile("" ::: "memory");
            }
        } else {
            const int head = 4 * (pn - 2) + wc;
            EPI_ROWS({ const f32x2 tt = tab[rl]; const float rinv = tt.x;
_Pragma("unroll")
                for (int bj = 0; bj < 2; ++bj) { const int bb = row >> 13, tl = (row >> 6) & 127, r = row & 63;
                    *(u32x4*)(Vmla + ((size_t)(bb * 8 + head) * 128 + tl) * 4096 + (bj * 4 + (r >> 4)) * 512 + (r & 15) * 32 + fq * 8) = pack8(acc[ai][bj][m][0] * rinv, acc[ai][bj][m][1] * rinv); } })
        }
    }
};
struct EpiOut {
    static constexpr bool HAS_MID = true;
    unsigned char* ws; const float* base;
    __device__ __forceinline__ void pre(const Unit& u, LAS f32x2* tab, int tid) const { if (tid < 256) { const float* sso = (const float*)(ws + WS_SSO) + (size_t)(u.pm * 256 + tid) * 16;
        const float rm = rsqrtf(sum8(sso) * (1.f / 512.f) + EPS), rf = rsqrtf(sum8(sso + 8) * (1.f / 512.f) + EPS); tab[tid] = (f32x2){rm / rf, rf}; } }
    __device__ __forceinline__ void mid(AccT& acc, const Unit& u, int wr, int wc, int fr, int fq, const LAS f32x2* tab) const {
        EPI_ROWS({ const float ratio = tab[rl].x;
_Pragma("unroll")
            for (int bj = 0; bj < 2; ++bj)
_Pragma("unroll")
                for (int n = 0; n < 2; ++n) acc[ai][bj][m][n] *= ratio; })
    }
    __device__ __forceinline__ void operator()(const AccT& acc, const Unit& u, int wr, int wc, int fr, int fq, const LAS f32x2* tab) const {
        asm volatile("" : "+v"(fr), "+v"(fq));
        bf16_t* xb = (bf16_t*)(ws + WS_XBB); const bf16_t* xa = (const bf16_t*)(ws + WS_XBA); float* ssx1 = (float*)(ws + WS_SSX1);
        const GAS bf16_t* xag = (const GAS bf16_t*)xa;
_Pragma("unroll")
        for (int ai = 0; ai < 2; ++ai) {
            u32x4 xwv[4][2];
_Pragma("unroll")
            for (int m = 0; m < 4; ++m)
_Pragma("unroll")
                for (int bj = 0; bj < 2; ++bj) xwv[m][bj] = *(const GAS u32x4*)(xag + (size_t)(u.pm * 256 + ai * 128 + wr * 64 + m * 16 + fr) * 1024 + u.pn * 256 + bj * 128 + wc * 32 + fq * 8);
            asm volatile("" ::: "memory");
_Pragma("unroll")
            for (int m = 0; m < 4; ++m) { const int rl = ai * 128 + wr * 64 + m * 16 + fr; const int row = u.pm * 256 + rl; const float rf = tab[rl].y; float s = 0.f;
_Pragma("unroll")
                for (int bj = 0; bj < 2; ++bj) { const size_t off = (size_t)row * 1024 + u.pn * 256 + bj * 128 + wc * 32 + fq * 8; f32x4 b0, b1;
                    { const u32x4 w = xwv[m][bj]; b0 = (f32x4){bflo(w.x), bfhi(w.x), bflo(w.y), bfhi(w.y)}; b1 = (f32x4){bflo(w.z), bfhi(w.z), bflo(w.w), bfhi(w.w)}; }
                    const f32x4 v0 = b0 + acc[ai][bj][m][0] * rf, v1 = b1 + acc[ai][bj][m][1] * rf; s += sum4sq(v0) + sum4sq(v1);
                    *(u32x4*)(xb + off) = pack8(v0, v1); }
                s = red_fq(s); if (fq == 0) ssx1[(size_t)row * 16 + u.pn * 4 + wc] = s; }
            asm volatile("" ::: "memory");
        }
    }
};
struct EpiRouter {
    static constexpr bool HAS_MID = false;
    unsigned char* ws; unsigned* cnt; LAS unsigned* lc;
    __device__ __forceinline__ void pre(const Unit& u, LAS f32x2* tab, int tid) const { if (tid < 256) { const float* ssx1 = (const float*)(ws + WS_SSX1); tab[tid] = (f32x2){rsqrtf(sum16(ssx1 + (size_t)(u.pm * 256 + tid) * 16) * (1.f / 1024.f) + EPS), 0.f}; } }
    __device__ __forceinline__ void mid(AccT&, const Unit&, int, int, int, int, const LAS f32x2*) const {}
    __device__ __forceinline__ void operator()(const AccT& acc, const Unit& u, int wr, int wc, int fr, int fq, const LAS f32x2* tab) const {
        asm volatile("" : "+v"(fr), "+v"(fq));
        if (wc != 0) return;
        float* gate = (float*)(ws + WS_GATE); int* list = (int*)(ws + WS_LIST);
        LAS unsigned* lcw = lc + wr * 32; const int lane_ = fr + 16 * fq; const int sl = u.pm * 2 + wr;
        if (lane_ < 32) lcw[lane_] = 0u;
        EPI_ROWS({ const float rinv = tab[rl].x;
            const f32x4 gl = acc[ai][1][m][0] * rinv; int g = 0; float gm = gl[0];
_Pragma("unroll")
            for (int j = 1; j < 4; ++j) if (gl[j] > gm) { gm = gl[j]; g = j; }
            float gs = 0.f;
_Pragma("unroll")
            for (int j = 0; j < 4; ++j) gs += __expf(gl[j] - gm);
            float pg = 1.f / gs;
            g = __shfl(g, fr); pg = __shfl(pg, fr);
            if (fq == g) { float le[8];
_Pragma("unroll")
                for (int j = 0; j < 4; ++j) { le[j] = acc[ai][0][m][0][j] * rinv; le[4 + j] = acc[ai][0][m][1][j] * rinv; }
                int i1 = 0; float m1 = le[0];
_Pragma("unroll")
                for (int j = 1; j < 8; ++j) if (le[j] > m1) { m1 = le[j]; i1 = j; }
                int i2 = 0; float m2 = -3.0e38f;
_Pragma("unroll")
                for (int j = 0; j < 8; ++j) if (j != i1 && le[j] > m2) { m2 = le[j]; i2 = j; }
                const float e2 = __expf(m2 - m1), w1 = 1.f / (1.f + e2), w2 = e2 * w1;
                gate[2 * (size_t)row] = pg * w1; gate[2 * (size_t)row + 1] = pg * w2;
                const int ea = g * 8 + i1, eb = g * 8 + i2;
                const unsigned pa = __hip_atomic_fetch_add(lcw + ea, 1u, __ATOMIC_RELAXED, __HIP_MEMORY_SCOPE_WORKGROUP); list[(size_t)(ea * NSUB + sl) * SUBCAP + pa] = 2 * row;
                const unsigned pb = __hip_atomic_fetch_add(lcw + eb, 1u, __ATOMIC_RELAXED, __HIP_MEMORY_SCOPE_WORKGROUP); list[(size_t)(eb * NSUB + sl) * SUBCAP + pb] = 2 * row + 1; } })
        asm volatile("s_waitcnt lgkmcnt(0)" ::: "memory");
        if (lane_ < 32) cnt[lane_ * NSUB + sl] = lcw[lane_];
    }
};
struct EpiPP {
    static constexpr bool HAS_MID = false;
    unsigned char* ws;
    __device__ __forceinline__ void pre(const Unit&, LAS f32x2*, int) const {}
    __device__ __forceinline__ void mid(AccT&, const Unit&, int, int, int, int, const LAS f32x2*) const {}
    __device__ __forceinline__ void operator()(const AccT& acc, const Unit& u, int wr, int wc, int fr, int fq, const LAS f32x2* tab) const {
        asm volatile("" : "+v"(fr), "+v"(fq));
        bf16_t* pp = (bf16_t*)(ws + WS_PP); float* sspp = (float*)(ws + WS_SSPP);
        EPI_ROWS({ float s = 0.f;
_Pragma("unroll")
            for (int bj = 0; bj < 2; ++bj) { const f32x4 v0 = acc[ai][bj][m][0], v1 = acc[ai][bj][m][1]; s += sum4sq(v0) + sum4sq(v1);
                __builtin_nontemporal_store(pack8(v0, v1), (u32x4*)(pp + (size_t)row * 1024 + u.pn * 256 + bj * 128 + wc * 32 + fq * 8)); }
            s = red_fq(s); if (fq == 0) sspp[(size_t)row * 16 + u.pn * 4 + wc] = s; })
    }
};
struct EpiMoeUp {
    static constexpr bool HAS_MID = false;
    unsigned char* ws; const LAS unsigned* cntv; const LAS unsigned short* subo; int npn;
    __device__ __forceinline__ void pre(const Unit& u, LAS f32x2* tab, int tid) const { if (tid < 256) { const int li = u.blk * 256 + tid; float rinv = 0.f;
        if (li < (int)cntv[u.e]) { const int tok = list_at((const int*)(ws + WS_LIST), subo, u.e, li) >> 1; rinv = rsqrtf(sum16((const float*)(ws + WS_SSX1) + (size_t)tok * 16) * (1.f / 1024.f) + EPS); }
        tab[tid] = (f32x2){rinv, 0.f}; } }
    __device__ __forceinline__ void mid(AccT&, const Unit&, int, int, int, int, const LAS f32x2*) const {}
    __device__ __forceinline__ void operator()(const AccT& acc, const Unit& u, int wr, int wc, int fr, int fq, const LAS f32x2* tab) const {
        asm volatile("" : "+v"(fr), "+v"(fq));
        const int pnl = u.pn - u.e * npn;
        bf16_t* hid = (bf16_t*)(ws + WS_HID);
        EPI_ROWS({ const float rinv = tab[rl].x;
            f32x4 h[2];
_Pragma("unroll")
            for (int n = 0; n < 2; ++n) { const f32x4 gg = acc[ai][0][m][n] * rinv, uu = acc[ai][1][m][n] * rinv;
_Pragma("unroll")
                for (int i = 0; i < 4; ++i) h[n][i] = gg[i] * __builtin_amdgcn_rcpf(1.f + __expf(-gg[i])) * uu[i]; }
            *(u32x4*)(hid + (size_t)row * 256 + pnl * 128 + wc * 32 + fq * 8) = pack8(h[0], h[1]); })
    }
};
struct EpiMoeDown {
    static constexpr bool HAS_MID = false;
    unsigned char* ws; const LAS unsigned* cntv; const LAS unsigned short* subo; int npn;
    __device__ __forceinline__ void pre(const Unit& u, LAS f32x2* tab, int tid) const { if (tid < 256) { const int li = u.blk * 256 + tid; int aid = -1; float gt = 0.f;
        if (li < (int)cntv[u.e]) { aid = list_at((const int*)(ws + WS_LIST), subo, u.e, li); gt = ((const float*)(ws + WS_GATE))[aid]; }
        tab[tid] = (f32x2){gt, __int_as_float(aid)}; } }
    __device__ __forceinline__ void mid(AccT&, const Unit&, int, int, int, int, const LAS f32x2*) const {}
    __device__ __forceinline__ void operator()(const AccT& acc, const Unit& u, int wr, int wc, int fr, int fq, const LAS f32x2* tab) const {
        asm volatile("" : "+v"(fr), "+v"(fq));
        const int pnl = u.pn - u.e * npn;
        bf16_t* c1 = (bf16_t*)(ws + WS_C1); bf16_t* xb = (bf16_t*)(ws + WS_XBB);
        const GAS bf16_t* xbg = (const GAS bf16_t*)xb;
_Pragma("unroll")
        for (int ai = 0; ai < 2; ++ai) {
            u32x4 xwv[4][2];
_Pragma("unroll")
            for (int m = 0; m < 4; ++m) { const int aid = __float_as_int(tab[ai * 128 + wr * 64 + m * 16 + fr].y); const int tok = aid >= 0 ? aid >> 1 : 0;
_Pragma("unroll")
                for (int bj = 0; bj < 2; ++bj) xwv[m][bj] = *(const GAS u32x4*)(xbg + (size_t)tok * 1024 + pnl * 256 + bj * 128 + wc * 32 + fq * 8); }
            asm volatile("" ::: "memory");
_Pragma("unroll")
            for (int m = 0; m < 4; ++m) { const f32x2 tt = tab[ai * 128 + wr * 64 + m * 16 + fr]; const int aid = __float_as_int(tt.y);
                if (aid >= 0) { const int tok = aid >> 1; const float gt = tt.x;
_Pragma("unroll")
                    for (int bj = 0; bj < 2; ++bj) { const size_t off = (size_t)tok * 1024 + pnl * 256 + bj * 128 + wc * 32 + fq * 8; const f32x4 v0 = acc[ai][bj][m][0] * gt, v1 = acc[ai][bj][m][1] * gt;
                        if (aid & 1) *(u32x4*)(c1 + off) = pack8(v0, v1);
                        else { const u32x4 w = xwv[m][bj]; *(u32x4*)(xb + off) = pack8((f32x4){bflo(w.x), bfhi(w.x), bflo(w.y), bfhi(w.y)} + v0, (f32x4){bflo(w.z), bfhi(w.z), bflo(w.w), bfhi(w.w)} + v1); } } } }
            asm volatile("" ::: "memory");
        }
    }
};
struct EpiPle {
    static constexpr bool HAS_MID = false;
    unsigned char* ws; const float* gpo; float* xout;
    __device__ __forceinline__ void pre(const Unit& u, LAS f32x2* tab, int tid) const { if (tid < 256) { const size_t r = (size_t)(u.pm * 256 + tid);
        tab[tid] = (f32x2){rsqrtf(((const float*)(ws + WS_SSX2))[r] * (1.f / 1024.f) + EPS), rsqrtf(sum16((const float*)(ws + WS_SSPP) + r * 16) * (1.f / 1024.f) + EPS)}; } }
    __device__ __forceinline__ void mid(AccT&, const Unit&, int, int, int, int, const LAS f32x2*) const {}
    __device__ __forceinline__ void operator()(const AccT& acc, const Unit& u, int wr, int wc, int fr, int fq, const LAS f32x2* tab) const {
        asm volatile("" : "+v"(fr), "+v"(fq));
        const bf16_t* pp = (const bf16_t*)(ws + WS_PP); bf16_t* xbn = (bf16_t*)(ws + WS_XBA); const bf16_t* xb = (const bf16_t*)(ws + WS_XBB); float* ssx0 = (float*)(ws + WS_SSX0);
        f32x4 g4[2][2];
_Pragma("unroll")
        for (int bj = 0; bj < 2; ++bj)
_Pragma("unroll")
            for (int n = 0; n < 2; ++n) g4[bj][n] = *(const f32x4*)(gpo + u.pn * 256 + bj * 128 + wc * 32 + fq * 8 + n * 4);
        const GAS bf16_t* ppg = (const GAS bf16_t*)pp; const GAS bf16_t* xbg = (const GAS bf16_t*)xb;
_Pragma("unroll")
        for (int ab = 0; ab < 4; ++ab) { const int ai = ab >> 1, m0 = (ab & 1) * 2;
            u32x4 pwv[4][2], xwv[4][2];
_Pragma("unroll")
            for (int m = m0; m < m0 + 2; ++m)
_Pragma("unroll")
                for (int bj = 0; bj < 2; ++bj) { const size_t off = (size_t)(u.pm * 256 + ai * 128 + wr * 64 + m * 16 + fr) * 1024 + u.pn * 256 + bj * 128 + wc * 32 + fq * 8;
                    pwv[m][bj] = *(const GAS u32x4*)(ppg + off); xwv[m][bj] = *(const GAS u32x4*)(xbg + off); }
            asm volatile("" ::: "memory");
_Pragma("unroll")
            for (int m = m0; m < m0 + 2; ++m) { const int rl = ai * 128 + wr * 64 + m * 16 + fr; const int row = u.pm * 256 + rl;
                const f32x2 tt = tab[rl]; const float r2 = tt.x, rp = tt.y; float s = 0.f;
_Pragma("unroll")
                for (int bj = 0; bj < 2; ++bj) { const size_t off = (size_t)row * 1024 + u.pn * 256 + bj * 128 + wc * 32 + fq * 8;
                    const u32x4 pw = pwv[m][bj]; const f32x4 p0 = (f32x4){bflo(pw.x), bfhi(pw.x), bflo(pw.y), bfhi(pw.y)} * rp * g4[bj][0], p1 = (f32x4){bflo(pw.z), bfhi(pw.z), bflo(pw.w), bfhi(pw.w)} * rp * g4[bj][1];
                    const u32x4 xw = xwv[m][bj]; f32x4 v0 = (f32x4){bflo(xw.x), bfhi(xw.x), bflo(xw.y), bfhi(xw.y)}, v1 = (f32x4){bflo(xw.z), bfhi(xw.z), bflo(xw.w), bfhi(xw.w)};
_Pragma("unroll")
                    for (int i = 0; i < 4; ++i) { v0[i] += p0[i] * __builtin_amdgcn_rcpf(1.f + __expf(-acc[ai][bj][m][0][i] * r2)); v1[i] += p1[i] * __builtin_amdgcn_rcpf(1.f + __expf(-acc[ai][bj][m][1][i] * r2)); }
                    s += sum4sq(v0) + sum4sq(v1);
                    if (xout) { *(f32x4*)(xout + off) = v0; *(f32x4*)(xout + off + 4) = v1; } else *(u32x4*)(xbn + off) = pack8(v0, v1); }
                s = red_fq(s); if (fq == 0 && !xout) ssx0[(size_t)row * 16 + u.pn * 4 + wc] = s; }
            asm volatile("" ::: "memory");
        }
    }
};

struct EpiNull {
    static constexpr bool HAS_MID = false;
    float* sink;
    __device__ __forceinline__ void pre(const Unit&, LAS f32x2*, int) const {}
    __device__ __forceinline__ void mid(AccT&, const Unit&, int, int, int, int, const LAS f32x2*) const {}
    __device__ __forceinline__ void operator()(const AccT& acc, const Unit& u, int wr, int wc, int fr, int fq, const LAS f32x2* tab) const {
        f32x4 s = (f32x4){0.f, 0.f, 0.f, 0.f};
        EPI_ROWS({ s += (acc[ai][0][m][0] + acc[ai][0][m][1]) + (acc[ai][1][m][0] + acc[ai][1][m][1]); })
        if (s[0] + s[1] + s[2] + s[3] == 1.2345678e33f) sink[0] = s[0];
    }
};

namespace att {
constexpr int NS = 4, VSLOT = 8192;
template <bool FOX> struct Lay { static constexpr int KSLOT = FOX ? 8192 : 12288, L_K = 0, L_V = NS * KSLOT, L_W = L_V + NS * VSLOT, L_WS = FOX ? L_V + NS * VSLOT : 131072 + 9216, L_G = L_WS + 2048,
                                 L_END = FOX ? L_G + 32768 : L_W + 49152, L_OST = 0; };
static_assert(Lay<true>::L_END <= 131072 && Lay<false>::L_END <= 131072 && Lay<false>::L_WS + 2048 <= 131072 + 26624 && NS * 8192 >= 32768, "attention LDS map");
constexpr float SKIP_NATS = 32.f;
typedef LAS const char* lds_cptr;
typedef short v4i16_t __attribute__((ext_vector_type(4)));

__device__ __forceinline__ void glds16(const void* gsrc, unsigned lds_dst) { unsigned keep;
    asm volatile("s_mov_b32 %0, m0\n\ts_mov_b32 m0, %2\n\ts_nop 0\n\tglobal_load_lds_dwordx4 %1, off\n\ts_mov_b32 m0, %0" : "=&s"(keep) : "v"(gsrc), "s"(lds_dst) : "memory"); }
__device__ __forceinline__ int crow(int r, int hi) { return (r & 3) + 8 * (r >> 2) + 4 * hi; }
__device__ __forceinline__ s16x4 vtr(lds_cptr p) { return __builtin_bit_cast(s16x4, __builtin_amdgcn_ds_read_tr16_b64_v4i16((LAS v4i16_t*)p)); }
__device__ __forceinline__ float swapmax(float m) { auto rr = __builtin_amdgcn_permlane32_swap(__float_as_uint(m), __float_as_uint(m), false, false); return fmaxf(__uint_as_float(rr[0]), __uint_as_float(rr[1])); }
__device__ __forceinline__ float swapsum(float m) { auto rr = __builtin_amdgcn_permlane32_swap(__float_as_uint(m), __float_as_uint(m), false, false); return __uint_as_float(rr[0]) + __uint_as_float(rr[1]); }
__device__ __forceinline__ bf16x8 pk8(const f32x16& p, int b) { u32x4 w; w.x = cvt_pk_bf16(p[b], p[b + 1]); w.y = cvt_pk_bf16(p[b + 2], p[b + 3]); w.z = cvt_pk_bf16(p[b + 4], p[b + 5]); w.w = cvt_pk_bf16(p[b + 6], p[b + 7]); return __builtin_bit_cast(bf16x8, w); }

struct Args {
    const bf16_t *Qc, *Wuq, *Kmla, *Vmla, *Fq, *Fk, *Fv; const float *ssq_q, *gmq, *cosT, *sinT, *F, *gfq, *gfk; bf16_t* o; float* sso;
};

#ifdef DIAG_SEL
#define STAMP(k) do { if (dg) { const unsigned long long t_ = __builtin_amdgcn_s_memrealtime(); dg[k] += (float)(t_ - tprev_) * 0.01f; tprev_ = t_; } } while (0)
#else
#define STAMP(k) do {} while (0)
#endif
template <bool FOX>
__device__ __forceinline__ void attn_unit(const Args& A, int b, int h, int qb, LAS char* shm, LAS float* dg) {
#ifdef DIAG_SEL
    unsigned long long tprev_ = __builtin_amdgcn_s_memrealtime();
#endif
    constexpr int DK = FOX ? 64 : 96, NQ = DK / 16, KP = FOX ? 512 : 768;
    constexpr int KSLOT = Lay<FOX>::KSLOT, L_K = Lay<FOX>::L_K, L_V = Lay<FOX>::L_V, L_WS = Lay<FOX>::L_WS, L_G = Lay<FOX>::L_G, L_OST = Lay<FOX>::L_OST;
    int tid_ = threadIdx.x; asm volatile("" : "+v"(tid_));
    const int tid = tid_, lane = tid & 63, r32 = lane & 31, hi = lane >> 5; const int wid = __builtin_amdgcn_readfirstlane(tid >> 6);
    const long rowbase = (long)b * SEQ; const int q0 = qb * 256, qw = q0 + wid * 32;
    const unsigned lds0 = (unsigned)(uintptr_t)shm;
    LAS float* wsf = (LAS float*)(shm + L_WS) + wid * 64;
    LAS float* Gl = (LAS float*)(shm + L_G);
    const int NT = (q0 + 256) / 64; const int tw_last = qw >> 6;
    int t0 = 0;
    if constexpr (FOX) {
        float gq = fmaxf(fabsf(A.gfq[lane]), 0.f), gk = fabsf(A.gfk[lane]);
#pragma unroll
        for (int o = 32; o > 0; o >>= 1) { gq = fmaxf(gq, __shfl_xor(gq, o)); gk = fmaxf(gk, __shfl_xor(gk, o)); }
        const float margin = 2.f * (8.f * gq * gk) + SKIP_NATS;
        const float Fref = A.F[(rowbase + q0) * 8 + h];
        const int nfull = q0 / 64;
        bool keep0 = true, keep1 = true;
        if (lane < nfull) keep0 = (Fref - A.F[(rowbase + 64 * lane + 63) * 8 + h]) >= -margin;
        if (lane + 64 < nfull) keep1 = (Fref - A.F[(rowbase + 64 * (lane + 64) + 63) * 8 + h]) >= -margin;
        const unsigned long long k0 = __ballot(keep0), k1 = __ballot(keep1);
        t0 = k0 ? __builtin_ctzll(k0) : 64 + (k1 ? __builtin_ctzll(k1) : 0);
        t0 = __builtin_amdgcn_readfirstlane(t0);
        const int nk = q0 + 256 - 64 * t0;
        { float fv[3];
#pragma unroll
          for (int k = 0; k < 3; ++k) { const int j = tid + 512 * k; fv[k] = A.F[(rowbase + 64 * t0 + (j < nk ? j : 0)) * 8 + h]; }
#pragma unroll
          for (int k = 0; k < 3; ++k) { const int j = tid + 512 * k; if (j < nk) Gl[j] = (Fref - fv[k]) * LOG2E; }
          for (int j = tid + 1536; j < nk; j += 512) Gl[j] = (Fref - A.F[(rowbase + 64 * t0 + j) * 8 + h]) * LOG2E; }
    }
    const bf16_t* Kg = (FOX ? A.Fk : A.Kmla) + (long)(b * 8 + h) * 128 * (KSLOT / 2) + wid * 512 + lane * 8;
    const bf16_t* Vg = (FOX ? A.Fv : A.Vmla) + (long)(b * 8 + h) * 128 * 4096 + wid * 512 + lane * 8;
    const unsigned kdst = lds0 + L_K + wid * 1024, vdst = lds0 + L_V + wid * 1024;
    const bool k2 = (!FOX) && wid < 4;
#define ISSUE_K(t, sl) do { glds16(Kg + (long)(t) * (KSLOT / 2), (unsigned)__builtin_amdgcn_readfirstlane(kdst + (sl) * KSLOT)); \
        if (k2) glds16(Kg + (long)(t) * (KSLOT / 2) + 4096, (unsigned)__builtin_amdgcn_readfirstlane(kdst + (sl) * KSLOT + 8192)); } while (0)
#define ISSUE_V(t, sl) glds16(Vg + (long)(t) * 4096, (unsigned)__builtin_amdgcn_readfirstlane(vdst + (sl) * VSLOT))
    const int nti = NT - t0;
    ISSUE_K(t0, 0); ISSUE_K(t0 + 1, 1); ISSUE_K(t0 + 2, 2); ISSUE_V(t0, 0); ISSUE_K(t0 + 3, 3); ISSUE_V(t0 + 1, 1);
    bf16x8 qr[NQ];
    {
        const long row = rowbase + qw + r32;
        if constexpr (FOX) {
#pragma unroll
            for (int d0 = 0; d0 < NQ; ++d0) qr[d0] = *(const bf16x8*)(A.Fq + row * 512 + h * 64 + d0 * 16 + hi * 8);
        } else {
            constexpr int L_W = Lay<false>::L_W;
            const bf16_t* qcp = A.Qc + row * 256 + hi * 8; bf16x8 qc[16];
#pragma unroll
            for (int s = 0; s < 16; ++s) qc[s] = *(const bf16x8*)(qcp + s * 16);
            const f32x4 sq4 = *(const f32x4*)(A.ssq_q + row * 4);
            f32x16 qa[3]; qa[0] = f32x16{}; qa[1] = f32x16{}; qa[2] = f32x16{};
            const lds_cptr wp = (lds_cptr)shm + L_W + lane * 16;
#pragma unroll
            for (int s = 0; s < 16; ++s)
#pragma unroll
                for (int blk = 0; blk < 3; ++blk) qa[blk] = __builtin_amdgcn_mfma_f32_32x32x16_bf16(*(const LAS bf16x8*)(wp + (blk * 16 + s) * 1024), qc[s], qa[blk], 0, 0, 0);
            const float rq = rsqrtf(((sq4[0] + sq4[1]) + (sq4[2] + sq4[3])) * (1.f / 256.f) + EPS);
            float ss = 0.f;
#pragma unroll
            for (int blk = 0; blk < 3; ++blk)
#pragma unroll
                for (int r = 0; r < 16; ++r) ss += qa[blk][r] * qa[blk][r];
            ss = swapsum(ss) * rq * rq;
            const float sc = rsqrtf(ss * (1.f / 96.f) + EPS) * C2_MLA * rq;
#pragma unroll
            for (int blk = 0; blk < 3; ++blk)
#pragma unroll
                for (int g = 0; g < 4; ++g) { const f32x4 gg = *(const f32x4*)(A.gmq + 32 * blk + 8 * g + 4 * hi);
#pragma unroll
                    for (int i = 0; i < 4; ++i) qa[blk][4 * g + i] *= sc * gg[i]; }
#pragma unroll
            for (int e = 0; e < 2; ++e) { const f32x4 c = *(const f32x4*)(A.cosT + row * 16 + 8 * e + 4 * hi), sn = *(const f32x4*)(A.sinT + row * 16 + 8 * e + 4 * hi);
#pragma unroll
                for (int i = 0; i < 4; ++i) { const float x1 = qa[2][4 * e + i], x2 = qa[2][8 + 4 * e + i]; qa[2][4 * e + i] = x1 * c[i] - x2 * sn[i]; qa[2][8 + 4 * e + i] = x2 * c[i] + x1 * sn[i]; } }
#pragma unroll
            for (int blk = 0; blk < 3; ++blk) { qr[2 * blk] = pk8(qa[blk], 0); qr[2 * blk + 1] = pk8(qa[blk], 8); }
        }
    }
    constexpr float THR = 8.f;
    float mhat = 0.f, lrun = 0.f; f32x16 o[2]; o[0] = f32x16{}; o[1] = f32x16{};
    f32x16 negm = f32x16{};
    const lds_cptr shm3 = (lds_cptr)shm;
    const lds_cptr kp0 = shm3 + L_K + hi * 1024 + r32 * 16;
    const lds_cptr vp0 = shm3 + L_V + ((lane >> 4) & 1) * 32 + (lane & 3) * 8 + (4 * hi + ((lane & 15) >> 2)) * 64;
    u32x4 pw[4]; f32x16 pp0, pp1, c0, c1; bf16x8 kf[2 * NQ]; s16x4 vlo[8], vhi[8];
    const int nK = k2 ? 2 : 1;
#define WV_(k) case k: asm volatile("s_waitcnt vmcnt(" #k ")" ::: "memory"); break;
#define WAITV(n) do { switch (n) { WV_(0) WV_(1) WV_(2) WV_(3) WV_(4) WV_(5) default: asm volatile("s_waitcnt vmcnt(6)" ::: "memory"); break; } } while (0)
#define LBAR() asm volatile("s_waitcnt lgkmcnt(0)\n\ts_barrier" ::: "memory")
#define SGB(mask, n) __builtin_amdgcn_sched_group_barrier(mask, n, 0)
#define SFENCE() __builtin_amdgcn_sched_barrier(0)
#define KREAD(rel) { const lds_cptr kp = kp0 + ((rel) % NS) * KSLOT; \
        _Pragma("unroll") for (int d0 = 0; d0 < NQ; ++d0) { kf[2 * d0] = *(const LAS bf16x8*)(kp + d0 * 2048); kf[2 * d0 + 1] = *(const LAS bf16x8*)(kp + d0 * 2048 + 512); } }
#define VREAD(rel) { const lds_cptr vp = vp0 + ((rel) % NS) * VSLOT; \
        _Pragma("unroll") for (int i = 0; i < 8; ++i) { vlo[i] = vtr(vp + (i >> 2) * 4096 + (i & 3) * 1024); vhi[i] = vtr(vp + (i >> 2) * 4096 + (i & 3) * 1024 + 512); } }
#define PKV(k) (bf16x8){vlo[k][0], vlo[k][1], vlo[k][2], vlo[k][3], vhi[k][0], vhi[k][1], vhi[k][2], vhi[k][3]}
#define QKMM(rel) do { const float cb = (t0 + (rel) > tw_last) ? -INFINITY : -mhat; \
        _Pragma("unroll") for (int r = 0; r < 16; ++r) { c0[r] = cb; c1[r] = cb; } \
        _Pragma("unroll") for (int d0 = 0; d0 < NQ; ++d0) { c0 = __builtin_amdgcn_mfma_f32_32x32x16_bf16(kf[2 * d0], qr[d0], c0, 0, 0, 0); c1 = __builtin_amdgcn_mfma_f32_32x32x16_bf16(kf[2 * d0 + 1], qr[d0], c1, 0, 0, 0); } } while (0)
#define PVMM() do { \
        o[0] = __builtin_amdgcn_mfma_f32_32x32x16_bf16(__builtin_bit_cast(bf16x8, pw[0]), PKV(0), o[0], 0, 0, 0); o[1] = __builtin_amdgcn_mfma_f32_32x32x16_bf16(__builtin_bit_cast(bf16x8, pw[0]), PKV(4), o[1], 0, 0, 0); \
        o[0] = __builtin_amdgcn_mfma_f32_32x32x16_bf16(__builtin_bit_cast(bf16x8, pw[1]), PKV(1), o[0], 0, 0, 0); o[1] = __builtin_amdgcn_mfma_f32_32x32x16_bf16(__builtin_bit_cast(bf16x8, pw[1]), PKV(5), o[1], 0, 0, 0); \
        o[0] = __builtin_amdgcn_mfma_f32_32x32x16_bf16(__builtin_bit_cast(bf16x8, pw[2]), PKV(2), o[0], 0, 0, 0); o[1] = __builtin_amdgcn_mfma_f32_32x32x16_bf16(__builtin_bit_cast(bf16x8, pw[2]), PKV(6), o[1], 0, 0, 0); \
        o[0] = __builtin_amdgcn_mfma_f32_32x32x16_bf16(__builtin_bit_cast(bf16x8, pw[3]), PKV(3), o[0], 0, 0, 0); o[1] = __builtin_amdgcn_mfma_f32_32x32x16_bf16(__builtin_bit_cast(bf16x8, pw[3]), PKV(7), o[1], 0, 0, 0); } while (0)
#define SUMPACK() do { float sa = pp0[0] + pp0[1], sb = pp1[0] + pp1[1]; \
        _Pragma("unroll") for (int r = 2; r < 16; r += 2) { sa += pp0[r] + pp0[r + 1]; sb += pp1[r] + pp1[r + 1]; } \
        lrun += sa + sb; pw[0] = __builtin_bit_cast(u32x4, pk8(pp0, 0)); pw[1] = __builtin_bit_cast(u32x4, pk8(pp0, 8)); pw[2] = __builtin_bit_cast(u32x4, pk8(pp1, 0)); pw[3] = __builtin_bit_cast(u32x4, pk8(pp1, 8)); } while (0)
#define MX3(a, b, c) __builtin_fmaxf(__builtin_fmaxf((a), (b)), (c))
#define BIASMASK(rel) do { if constexpr (FOX) { const int tt_ = t0 + (rel); const LAS float* Gt = Gl + (rel) * 64 + 4 * hi; \
            _Pragma("unroll") for (int rq = 0; rq < 4; ++rq) { const f32x4 ga = *(const LAS f32x4*)(Gt + 8 * rq), gb = *(const LAS f32x4*)(Gt + 32 + 8 * rq); \
                _Pragma("unroll") for (int i = 0; i < 4; ++i) { c0[4 * rq + i] += ga[i]; c1[4 * rq + i] += gb[i]; } } \
            if (64 * tt_ + 63 > qw) { const int qrel = qw + r32 - 64 * tt_; \
                _Pragma("unroll") for (int r = 0; r < 16; ++r) { const int kv = crow(r, hi); c0[r] = kv > qrel ? -INFINITY : c0[r]; c1[r] = kv + 32 > qrel ? -INFINITY : c1[r]; } } } } while (0)
#define ROWMAX(dst) do { float ma = MX3(c0[0], c0[1], c1[0]), mb = MX3(c0[2], c0[3], c1[1]); ma = MX3(ma, c1[2], c1[3]); \
        _Pragma("unroll") for (int r = 4; r < 16; r += 4) { ma = MX3(ma, c0[r], c0[r + 1]); mb = MX3(mb, c0[r + 2], c0[r + 3]); ma = MX3(ma, c1[r], c1[r + 1]); mb = MX3(mb, c1[r + 2], c1[r + 3]); } \
        dst = swapmax(fmaxf(ma, mb)); } while (0)
#define CIPART(rel, g) do { const float mneg = (t0 + (rel) > tw_last) ? -INFINITY : -mhat; const LAS float* Gt = Gl + (rel) * 64 + 4 * hi + ((g) >> 2) * 32 + 8 * ((g) & 3); const f32x4 gg = *(const LAS f32x4*)Gt; \
        _Pragma("unroll") for (int i = 0; i < 4; ++i) { if ((g) < 4) c0[4 * ((g) & 3) + i] = gg[i] + mneg; else c1[4 * ((g) & 3) + i] = gg[i] + mneg; } } while (0)
#define MASKONLY(rel) do { if constexpr (FOX) { const int tt_ = t0 + (rel); if (64 * tt_ + 63 > qw) { const int qrel = qw + r32 - 64 * tt_; \
            _Pragma("unroll") for (int r = 0; r < 16; ++r) { const int kv = crow(r, hi); c0[r] = kv > qrel ? -INFINITY : c0[r]; c1[r] = kv + 32 > qrel ? -INFINITY : c1[r]; } } } } while (0)
    WAITV(2 * nK + 2);
    LBAR();
    ISSUE_V(t0 + 2, 2);
    KREAD(0); SFENCE();
    QKMM(0);
    BIASMASK(0);
    { float rm; ROWMAX(rm); mhat = rm;
      if constexpr (!FOX) {
#pragma unroll
          for (int r = 0; r < 16; ++r) negm[r] = -rm;
          asm volatile("" : "+v"(negm)); }
#pragma unroll
        for (int r = 0; r < 16; ++r) { pp0[r] = __builtin_amdgcn_exp2f(c0[r] - rm); pp1[r] = __builtin_amdgcn_exp2f(c1[r] - rm); } }
    KREAD(1);
    if constexpr (FOX) {
#pragma unroll
        for (int g = 0; g < 8; ++g) CIPART(1, g); }
    WAITV(nK + 2);
    LBAR();
    const int t_end = (tw_last - t0 + 2 < nti) ? tw_last - t0 + 2 : nti;
#pragma unroll 1
    for (int t = 1; t < t_end; ++t) {
        if (t == 1 && 4 < nti) ISSUE_K(t0 + 4, 0);
        if (t + 4 < nti) ISSUE_K(t0 + t + 4, t % NS);
        if (t + 2 < nti) ISSUE_V(t0 + t + 2, (t + 2) % NS);
        SFENCE();
        { if constexpr (!FOX) { if (t0 + t == tw_last + 1) {
#pragma unroll
                  for (int r = 0; r < 16; ++r) negm[r] = -INFINITY;
                  asm volatile("" : "+v"(negm)); } }
          const lds_cptr vp = vp0 + ((t - 1) % NS) * VSLOT; float sa = 0.f, sb = 0.f;
#pragma unroll
          for (int g = 0; g < 2 * NQ; ++g) {
              if (!FOX && g == 0) c0 = __builtin_amdgcn_mfma_f32_32x32x16_bf16(kf[0], qr[0], negm, 0, 0, 0);
              else if (!FOX && g == 1) c1 = __builtin_amdgcn_mfma_f32_32x32x16_bf16(kf[1], qr[0], negm, 0, 0, 0);
              else if (g & 1) c1 = __builtin_amdgcn_mfma_f32_32x32x16_bf16(kf[g], qr[g >> 1], c1, 0, 0, 0); else c0 = __builtin_amdgcn_mfma_f32_32x32x16_bf16(kf[g], qr[g >> 1], c0, 0, 0, 0);
              if (g < 8) { const int i = (g >> 1) + 4 * (g & 1); vlo[i] = vtr(vp + (i >> 2) * 4096 + (i & 3) * 1024); vhi[i] = vtr(vp + (i >> 2) * 4096 + (i & 3) * 1024 + 512);
                  if (g < 4) { sa += pp0[4 * g]; sb += pp0[4 * g + 1]; sa += pp0[4 * g + 2]; sb += pp0[4 * g + 3]; } else { sa += pp1[4 * g - 16]; sb += pp1[4 * g - 15]; sa += pp1[4 * g - 14]; sb += pp1[4 * g - 13]; }
                  asm volatile("" : "+v"(sa), "+v"(sb)); }
              { constexpr int G0 = FOX ? 0 : 4; if (g >= G0) { const int q = 2 * (g - G0);
#pragma unroll
                  for (int k = 0; k < 2; ++k) { const int w = q + k; const unsigned pkd = w < 8 ? cvt_pk_bf16(pp0[2 * w], pp0[2 * w + 1]) : cvt_pk_bf16(pp1[2 * w - 16], pp1[2 * w - 15]); pw[w >> 2][w & 3] = pkd; } } }
              SFENCE();
          }
          lrun += sa + sb; }
        MASKONLY(t);
        float rm; ROWMAX(rm);
        bool resc = false;
        if (__any(rm > THR)) { const float dl = fmaxf(rm, 0.f); mhat += dl;
#pragma unroll
            for (int r = 0; r < 16; ++r) { c0[r] -= dl; c1[r] -= dl; }
            if constexpr (!FOX) {
#pragma unroll
                for (int r = 0; r < 16; ++r) negm[r] = -mhat;
                asm volatile("" : "+v"(negm)); }
            const float f = __builtin_amdgcn_exp2f(-dl); lrun *= f; if (hi == 0) wsf[r32] = f; resc = true; }
        SFENCE();
        { const lds_cptr kp = kp0 + ((t + 1) % NS) * KSLOT;
#pragma unroll
          for (int g = 0; g < 8; ++g) { const int i = (g >> 1) + 4 * (g & 1);
              const bf16x8 vf = (bf16x8){vlo[i][0], vlo[i][1], vlo[i][2], vlo[i][3], vhi[i][0], vhi[i][1], vhi[i][2], vhi[i][3]};
              o[g & 1] = __builtin_amdgcn_mfma_f32_32x32x16_bf16(__builtin_bit_cast(bf16x8, pw[g >> 1]), vf, o[g & 1], 0, 0, 0);
              if (g < 4) {
#pragma unroll
                  for (int k = 0; k < 4; ++k) pp0[4 * g + k] = __builtin_amdgcn_exp2f(c0[4 * g + k]);
                  asm volatile("" : "+v"(pp0)); }
              else {
#pragma unroll
                  for (int k = 0; k < 4; ++k) pp1[4 * g - 16 + k] = __builtin_amdgcn_exp2f(c1[4 * g - 16 + k]);
                  asm volatile("" : "+v"(pp1)); }
              { constexpr int G0 = FOX ? 2 : 1; const int j = g - G0; if (j >= 0 && j < NQ) { kf[2 * j] = *(const LAS bf16x8*)(kp + j * 2048); kf[2 * j + 1] = *(const LAS bf16x8*)(kp + j * 2048 + 512); } }
              if constexpr (FOX) { CIPART(t + 1, g); if (g < 4) asm volatile("" : "+v"(c0)); else asm volatile("" : "+v"(c1)); }
              SFENCE();
          } }
        if (resc) { asm volatile("s_waitcnt lgkmcnt(0)" ::: "memory");
#pragma unroll
            for (int rq = 0; rq < 4; ++rq) { const f32x4 af = *(const LAS f32x4*)(wsf + 8 * rq + 4 * hi);
#pragma unroll
                for (int i = 0; i < 4; ++i) { o[0][4 * rq + i] *= af[i]; o[1][4 * rq + i] *= af[i]; } } }
        WAITV(((t + 3 < nti ? nK : 0) + (t + 1 < nti ? 1 : 0)) + ((t + 4 < nti ? nK : 0) + (t + 2 < nti ? 1 : 0)));
        LBAR();
    }
    if (t_end == nti) { VREAD(nti - 1); SUMPACK(); SFENCE(); PVMM(); }
    else {
#pragma unroll 1
        for (int t = t_end; t < nti; ++t) {
            if (t + 4 < nti) ISSUE_K(t0 + t + 4, t % NS);
            if (t + 2 < nti) ISSUE_V(t0 + t + 2, (t + 2) % NS);
            WAITV(((t + 3 < nti ? nK : 0) + (t + 1 < nti ? 1 : 0)) + ((t + 4 < nti ? nK : 0) + (t + 2 < nti ? 1 : 0)));
            LBAR();
        }
    }
#undef ISSUE_K
#undef ISSUE_V
#undef WAITV
#undef WV_
#undef LBAR
#undef SGB
#undef SFENCE
#undef KREAD
#undef VREAD
#undef PKV
#undef QKMM
#undef PVMM
#undef SUMPACK
#undef MX3
#undef BIASMASK
#undef CIPART
#undef MASKONLY
#undef ROWMAX
    STAMP(2);
    lrun = swapsum(lrun);
    if (hi == 0) wsf[32 + r32] = lrun;
    asm volatile("s_waitcnt lgkmcnt(0)" ::: "memory");
    float rli[16];
#pragma unroll
    for (int rq = 0; rq < 4; ++rq) { const f32x4 lf = *(const LAS f32x4*)(wsf + 32 + 8 * rq + 4 * hi);
#pragma unroll
        for (int i = 0; i < 4; ++i) rli[4 * rq + i] = __builtin_amdgcn_rcpf(lf[i]); }
    const int hh = FOX ? 8 + h : h;
    bf16_t* Ow = A.o + (rowbase + qw) * 1024 + hh * 64;
    LAS bf16_t* stg = (LAS bf16_t*)(shm + L_OST) + wid * 2048;
#pragma unroll
    for (int r = 0; r < 16; ++r) { const int orow = crow(r, hi);
#pragma unroll
        for (int d0 = 0; d0 < 2; ++d0) { const float v = o[d0][r] * rli[r]; stg[orow * 64 + d0 * 32 + r32] = (bf16_t)(cvt_pk_bf16(v, 0.f) & 0xffffu); } }
    asm volatile("s_waitcnt lgkmcnt(0)" ::: "memory");
#pragma unroll
    for (int i = 0; i < 4; ++i) { const int row = i * 8 + (lane >> 3), ch = lane & 7; const u32x4 v = *(const LAS u32x4*)(stg + row * 64 + ch * 8);
        *(u32x4*)(Ow + (long)row * 1024 + ch * 8) = v;
        float s = 0.f; { const float a0 = bflo(v.x), a1 = bfhi(v.x), a2 = bflo(v.y), a3 = bfhi(v.y), a4 = bflo(v.z), a5 = bfhi(v.z), a6 = bflo(v.w), a7 = bfhi(v.w);
            s = ((a0 * a0 + a1 * a1) + (a2 * a2 + a3 * a3)) + ((a4 * a4 + a5 * a5) + (a6 * a6 + a7 * a7)); }
        s += __shfl_xor(s, 1); s += __shfl_xor(s, 2); s += __shfl_xor(s, 4);
        if (ch == 0) A.sso[(rowbase + qw + row) * 16 + hh] = s; }
    asm volatile("s_waitcnt lgkmcnt(0)\n\ts_barrier" ::: "memory");
    STAMP(3);
#ifdef DIAG_SEL
    if (dg) dg[4] += (float)NT - (float)t0;
#endif
}

template <class CV>
__device__ __forceinline__ void attn_phase(const Args& A, int vcu, int G, LAS char* shm, int repm, int repf, LAS float* dg, unsigned* qctr, const float* bfox, LAS int* qs  , int nscan, int ncv, CV cv) {
    const int tid = threadIdx.x;
    for (int v = vcu; v < 256; v += G) {
        const int bh = v >> 3, s = v & 7;
        {
            int t_ = tid; asm volatile("" : "+v"(t_));
            const int wv = __builtin_amdgcn_readfirstlane(t_ >> 6); const bf16_t* src = A.Wuq + (size_t)(bh & 7) * 24576 + (t_ & 63) * 8;
#pragma unroll
            for (int i = 0; i < 6; ++i) glds16(src + (wv + 8 * i) * 512, (unsigned)__builtin_amdgcn_readfirstlane((unsigned)(uintptr_t)shm + Lay<false>::L_W + (wv + 8 * i) * 1024));
            asm volatile("s_waitcnt vmcnt(0)" ::: "memory"); __syncthreads(); }
#pragma unroll 1
        for (int i = 0; i < 4 * repm; ++i) { const int ii = i & 3; const int qb = (ii == 0) ? s : (ii == 1) ? 15 - s : (ii == 2) ? 16 + s : 31 - s; attn_unit<false>(A, bh >> 3, bh & 7, qb, shm, dg); }
    }
    if (tid < 8) { const float mine = bfox[tid]; int rank = 0;
#pragma unroll
        for (int k = 0; k < 8; ++k) { const float o = bfox[k]; rank += (o > mine || (o == mine && k < tid)) ? 1 : 0; }
        qs[rank] = tid; }
    if (tid == 0) {
        while (__hip_atomic_load(qctr + 16, __ATOMIC_ACQUIRE, __HIP_MEMORY_SCOPE_AGENT) < (unsigned)nscan) __builtin_amdgcn_s_sleep(2);
        __builtin_amdgcn_fence(__ATOMIC_ACQUIRE, "agent"); }
    if (tid == 0) qs[8] = (int)__hip_atomic_fetch_add(qctr, 1u, __ATOMIC_RELAXED, __HIP_MEMORY_SCOPE_AGENT);
    asm volatile("s_waitcnt vmcnt(0) lgkmcnt(0)" ::: "memory"); __syncthreads();
#pragma unroll 1
    for (;;) {
        const int idx = qs[8];
        if (idx >= 1024 * repf + ncv) break;
        const int g4 = idx >> 1; const bool isc = ((idx & 1) == 1) && g4 < ncv;
        const int id = (idx - (g4 < ncv ? g4 : ncv)) & 1023, h = qs[id >> 7], rem = id & 127, qb = 31 - (rem >> 2), b = rem & 3;
        unsigned nxt = 0u;
        __syncthreads();
        if (tid == 0) nxt = __hip_atomic_fetch_add(qctr, 1u, __ATOMIC_RELAXED, __HIP_MEMORY_SCOPE_AGENT);
        if (isc) cv(g4, shm, tid); else attn_unit<true>(A, b, h, qb, shm, dg ? dg + 8 : dg);
        if (tid == 0) qs[8] = (int)nxt;
        asm volatile("s_waitcnt vmcnt(0) lgkmcnt(0)" ::: "memory"); __syncthreads();
    }
}
}

constexpr int CW_TMO = 0, CW_BAR = 4096, CW_CNT = 200000;
constexpr int RING_BYTES = 131072, LDSCTL_OFF = RING_BYTES, LDS_BYTES = 163840;
constexpr int CW_FQ = 230000;
constexpr int LC_QS = 7424;
constexpr int LC_ORD = 8512;
constexpr int LC_SUBO = 9216, LC_RCNT = 26624;
constexpr int LC_MISC = 0, LC_PRE = 256, LC_CNT = 512;

typedef GAS unsigned gu32;
#define RLX_AGENT __ATOMIC_RELAXED, __HIP_MEMORY_SCOPE_AGENT

#define XB_TMO      128
#define XB_XCNT(j)  (256  + 64 * (j))
#define XB_XSUB(j)  (1280 + 64 * (j))
#define XB_XGEN(j)  (2304 + 64 * (j))
#define XB_TOP      3328
#define XB_TOPGEN   3392
#define XCD_BAR_WORDS 3456
#define XB_SPIN_CAP (1u << 18)
__device__ __forceinline__ unsigned xb_ld(unsigned* p)              { return __hip_atomic_load(p, __ATOMIC_RELAXED, __HIP_MEMORY_SCOPE_AGENT); }
__device__ __forceinline__ unsigned xb_add(unsigned* p, unsigned v) { return __hip_atomic_fetch_add(p, v, __ATOMIC_RELAXED, __HIP_MEMORY_SCOPE_AGENT); }
__device__ __forceinline__ unsigned xb_xcc_id() { return (unsigned)__builtin_amdgcn_s_getreg((3 << 11) | 20) & 0xFu; }
#define XB_SPIN(cond, bar) do { unsigned _sp = 0; while (cond) { __builtin_amdgcn_s_sleep(1); \
    if ((++_sp & 255u) == 0u) { if (xb_ld(&(bar)[XB_TMO])) break; if (_sp > XB_SPIN_CAP) { atomicAdd(&(bar)[XB_TMO], 1u); break; } } } } while (0)
struct XcdBarrier { unsigned* bar; unsigned x; volatile LAS unsigned* st; };
__device__ __forceinline__ XcdBarrier xcd_barrier_post(unsigned* bar, volatile LAS unsigned* st) {
    XcdBarrier b; b.bar = bar; b.x = xb_xcc_id(); b.st = st;
    if (threadIdx.x == 0) (void)xb_add(&bar[XB_XCNT(b.x)], 1u);
    return b;
}
__device__ __forceinline__ void xcd_barrier_complete(unsigned* bar, unsigned x, unsigned& nloc, unsigned& nx) {
    const unsigned G = gridDim.x * gridDim.y * gridDim.z;
    unsigned sum, cnt, mine, sp = 0u;
    for (;;) {
        sum = 0u; cnt = 0u; mine = 0u;
#pragma unroll
        for (unsigned j = 0; j < 16; ++j) { const unsigned c = xb_ld(&bar[XB_XCNT(j)]); sum += c; cnt += (c > 0u) ? 1u : 0u; mine = (j == x) ? c : mine; }
        if (sum == G) break;
        __builtin_amdgcn_s_sleep(1);
        if ((++sp & 255u) == 0u) { if (xb_ld(&bar[XB_TMO])) break; if (sp > XB_SPIN_CAP) { atomicAdd(&bar[XB_TMO], 1u); break; } }
    }
    nloc = mine > 0u ? mine : 1u; nx = cnt > 0u ? cnt : 1u;
}
__device__ __forceinline__ void xcd_barrier(const XcdBarrier& b) {
    asm volatile("s_waitcnt vmcnt(0)" ::: "memory");
    __syncthreads();
    if (threadIdx.x == 0) {
        unsigned* bar = b.bar;
        __builtin_amdgcn_s_waitcnt(0);
        unsigned nloc = b.st[0], nx = b.st[1];
        if (nloc == 0u) { xcd_barrier_complete(bar, b.x, nloc, nx); b.st[0] = nloc; b.st[1] = nx; }
        const unsigned old = xb_add(&bar[XB_XSUB(b.x)], 1u);
        const unsigned gen = old / nloc;
        if (old + 1u == (gen + 1u) * nloc) {
            __builtin_amdgcn_fence(__ATOMIC_RELEASE, "agent");
            asm volatile("s_waitcnt vmcnt(0)" ::: "memory");
            const unsigned og = xb_add(&bar[XB_TOP], 1u);
            const unsigned tg = og / nx;
            if (og + 1u == (tg + 1u) * nx) xb_add(&bar[XB_TOPGEN], 1u);
            else XB_SPIN(xb_ld(&bar[XB_TOPGEN]) == tg, bar);
            __builtin_amdgcn_fence(__ATOMIC_ACQUIRE, "agent");
            xb_add(&bar[XB_XGEN(b.x)], 1u);
            asm volatile("s_waitcnt vmcnt(0)" ::: "memory");
        } else {
            XB_SPIN(xb_ld(&bar[XB_XGEN(b.x)]) == gen, bar);
            __builtin_amdgcn_fence(__ATOMIC_ACQUIRE, "agent");
            asm volatile("s_waitcnt vmcnt(0)" ::: "memory");
        }
    }
    __syncthreads();
}

__device__ __forceinline__ float wave_sum(float v) {
#pragma unroll
    for (int o = 1; o < 64; o <<= 1) v += __shfl_xor(v, o);
    return v;
}
#define LDS_WAIT() asm volatile("s_waitcnt lgkmcnt(0)" ::: "memory")

__device__ __forceinline__ int maprow(int kind, int n) {
    switch (kind) {
    default: return n;
    case 1: {
        if (n < 256) return n;
        if (n < 384) { const int j = n - 256, q = j >> 5, c = j & 31; return 256 + (q & 1) * 128 + (q >> 1) * 32 + c; }
        if (n < 416) return 256 + 64 + (n - 384);
        if (n < 1952) { const int f = n - 416, k3 = f >> 9, r = f & 511, hd = r >> 6, d = r & 63; return (2 + 2 * k3 + (hd >> 2)) * 256 + (d >> 5) * 128 + (hd & 3) * 32 + (d & 31); }
        return 256 + 96 + (n - 1952); }
    case 2: { const int hd = n / 96, dd = n - hd * 96; if (dd < 64) return (hd >> 2) * 256 + (dd >> 5) * 128 + (hd & 3) * 32 + (dd & 31); return 512 + (hd >> 2) * 128 + (hd & 3) * 32 + (dd - 64); }
    case 3: { const int hd = n >> 7, dd = n & 127; if (dd < 64) return (hd >> 2) * 256 + (dd >> 5) * 128 + (hd & 3) * 32 + (dd & 31); const int d = dd - 64; return 512 + (hd >> 2) * 256 + (d >> 5) * 128 + (hd & 3) * 32 + (d & 31); }
    case 4: return (n >> 7) * 256 + (n & 127);
    case 5: return (n >> 7) * 256 + 128 + (n & 127);
    case 6: return 128 + n;
    }
}
struct CvP { const float* W; bf16_t* WT; const float* s1; const float* s2; int K, Nsrc, kind, split, item; };
__device__ __forceinline__ void conv_load(const CvP& p, int lane, float (&v)[32], float (&sc)[8]) {
    const int nblk = (p.Nsrc + 31) / 32, kb = p.item / nblk, nb = p.item - kb * nblk, k0 = 64 * kb, n0 = 32 * nb;
    const bool nv = n0 + (lane & 31) < p.Nsrc;
    const float* src = p.W + (size_t)(k0 + (lane >> 5)) * p.Nsrc + (nv ? n0 + (lane & 31) : 0);
#pragma unroll
    for (int i = 0; i < 32; ++i) v[i] = src[(size_t)(2 * i) * p.Nsrc];
    const int k8 = k0 + 8 * (lane & 7);
    if (p.s1) { const float* sp = k8 < p.split ? p.s1 + k8 : p.s2 + (k8 - p.split); const f32x4 s0 = *(const f32x4*)sp, s1v = *(const f32x4*)(sp + 4);
#pragma unroll
        for (int e = 0; e < 4; ++e) { sc[e] = s0[e]; sc[4 + e] = s1v[e]; } }
    else {
#pragma unroll
        for (int e = 0; e < 8; ++e) sc[e] = 1.f; }
}
__device__ __forceinline__ void conv_store(const CvP& p, int lane, const float (&v)[32], const float (&sc)[8], LAS float* scr) {
    const int nblk = (p.Nsrc + 31) / 32, kb = p.item / nblk, nb = p.item - kb * nblk, k0 = 64 * kb, n0 = 32 * nb;
    const bool nv = n0 + (lane & 31) < p.Nsrc;
#pragma unroll
    for (int i = 0; i < 32; ++i) { const int kk = 2 * i + (lane >> 5); scr[kk * 33 + (lane & 31)] = nv ? v[i] : 0.f; }
    LDS_WAIT(); asm volatile("" ::: "memory");
    const int c = lane & 7;
#pragma unroll
    for (int j = 0; j < 4; ++j) { const int n = (lane >> 3) + 8 * j; const LAS float* s = scr + (8 * c) * 33 + n;
        if (n0 + n < p.Nsrc) { u32x4 o; o.x = cvt_pk_bf16(s[0 * 33] * sc[0], s[1 * 33] * sc[1]); o.y = cvt_pk_bf16(s[2 * 33] * sc[2], s[3 * 33] * sc[3]); o.z = cvt_pk_bf16(s[4 * 33] * sc[4], s[5 * 33] * sc[5]); o.w = cvt_pk_bf16(s[6 * 33] * sc[6], s[7 * 33] * sc[7]);
            size_t off;
            if (p.kind == 8) { const int nn = n0 + n, hd = nn / 96, dd = nn - hd * 96, k8 = k0 + 8 * c;
                off = ((size_t)((hd * 3 + (dd >> 5)) * 16 + (k8 >> 4)) * 64 + ((k8 >> 3) & 1) * 32 + (dd & 31)) * 8; }
            else off = (size_t)maprow(p.kind, n0 + n) * p.K + k0 + 8 * c;
            *(u32x4*)(p.WT + off) = o; } }
    LDS_WAIT(); asm volatile("" ::: "memory");
}

struct KArgs { const void* in[27]; float* out; unsigned char* ws; int ph_lo, ph_hi, li, pad; };

constexpr int I_IN = 16 * 62, I_UQ = 4 * 24, I_UKV = 2 * 32, I_OUT = 16 * 32, I_RE = 16, I_RG = 16, I_GU = NEXP * 2 * 16 * 8, I_DN = NEXP * 4 * 32, I_PG = 16 * 32, I_PP = 4 * 32;
constexpr int I_LAYER = I_IN + I_UQ + I_UKV + I_OUT + I_RE + I_RG + I_GU + I_DN + I_PG + I_PP;

struct PPOrder {
    int first, stride, end;
    __device__ __forceinline__ bool next(int i, Unit& u) const {
        if (first < 0) return false; const int L = first + i * stride; if (L >= end) return false;
        u.pm = L >> 2; u.pn = L & 3; u.e = 0; u.blk = 0; return true;
    }
    __device__ __forceinline__ int arow(const Unit& u, int r) const { return u.pm * 256 + r; }
    __device__ __forceinline__ bool half(const Unit&) const { return false; }
};

struct MoeOrder {
    const LAS int* pre; const LAS unsigned* cntl; const LAS unsigned short* subo; const int* list; int npn, G, c; bool gather; const LAS unsigned short* ord;
    __device__ __forceinline__ bool half(const Unit& u) const { return __builtin_amdgcn_readfirstlane((int)cntl[u.e] - u.blk * 256) <= 128; }
    __device__ __forceinline__ bool next(int i, Unit& u) const {
        const int L = i * G + c; const int TB = pre[32]; if (L >= TB * npn) return false;
        const int bp = L / npn, pl = L - bp * npn, bg = ord[bp]; int e = 0;
        for (int j = 1; j < 32; ++j) e += (pre[j] <= bg) ? 1 : 0;
        u.pm = bg; u.e = e; u.blk = bg - pre[e]; u.pn = e * npn + pl; return true;
    }
    __device__ __forceinline__ int arow(const Unit& u, int r) const {
        if (!gather) return u.pm * 256 + r;
        int li = u.blk * 256 + r; const int cn = (int)cntl[u.e]; li = li < cn ? li : cn - 1;
        return list_at(list, subo, u.e, li) >> 1;
    }
};

#ifndef WGM_P1
#define WGM_P1 8
#endif
#ifndef WGM_P2
#define WGM_P2 16
#endif
#ifndef WGM_P4
#define WGM_P4 8
#endif
#ifndef MK_CUTS
#define MK_CUTS {0, 19}
#endif
constexpr int NPHASE = 19;

constexpr int I_SM1 = I_IN + I_UQ + I_UKV + I_OUT + I_RE + I_RG, I_EXP = I_GU + I_DN, I_SMALL = I_LAYER - I_EXP;
typedef const void* cvp_t; typedef __attribute__((address_space(4))) const cvp_t* kin_t;
__device__ __forceinline__ CvP conv_decode(kin_t kin, unsigned char* wsp, int L, int r) {
#define INF_(i) ((const float*)kin[i])
    unsigned char* Wl_ = wsp + WS_W + (size_t)L * W_LAYER;
    if (r < I_IN) return CvP{INF_(4) + (size_t)L * DM * INC, (bf16_t*)(Wl_ + WO_IN), INF_(3) + L * DM, nullptr, DM, INC, 1, DM, r}; r -= I_IN;
    if (r < I_UQ) return CvP{INF_(6) + (size_t)L * 256 * 768, (bf16_t*)(Wl_ + WO_UQ), INF_(5) + L * 256, nullptr, 256, 768, 8, 256, r}; r -= I_UQ;
    if (r < I_UKV) return CvP{INF_(8) + (size_t)L * 128 * 1024, (bf16_t*)(Wl_ + WO_UKV), INF_(7) + L * 128, nullptr, 128, 1024, 3, 128, r}; r -= I_UKV;
    if (r < I_OUT) return CvP{INF_(16) + (size_t)L * DM * DM, (bf16_t*)(Wl_ + WO_OUT), INF_(14) + L * 512, INF_(15) + L * 512, DM, DM, 0, 512, r}; r -= I_OUT;
    if (r < I_RE) return CvP{INF_(19) + (size_t)L * DM * 32, (bf16_t*)(Wl_ + WO_RT), INF_(17) + L * DM, nullptr, DM, 32, 0, DM, r}; r -= I_RE;
    if (r < I_RG) return CvP{INF_(18) + (size_t)L * DM * 4, (bf16_t*)(Wl_ + WO_RT), INF_(17) + L * DM, nullptr, DM, 4, 6, DM, r}; r -= I_RG;
    if (r < I_GU) { const int e = r >> 8, mt = (r >> 7) & 1, ii = r & 127;
        return CvP{INF_(mt ? 21 : 20) + ((size_t)L * NEXP + e) * DM * 256, (bf16_t*)(Wl_ + WO_GU) + (size_t)e * 512 * DM, INF_(17) + L * DM, nullptr, DM, 256, mt ? 5 : 4, DM, ii}; } r -= I_GU;
    if (r < I_DN) { const int e = r >> 7, ii = r & 127;
        return CvP{INF_(22) + ((size_t)L * NEXP + e) * 256 * DM, (bf16_t*)(Wl_ + WO_DN) + (size_t)e * DM * 256, nullptr, nullptr, 256, DM, 0, 0, ii}; } r -= I_DN;
    if (r < I_PG) return CvP{INF_(24) + (size_t)L * DM * DM, (bf16_t*)(Wl_ + WO_PG), INF_(23) + L * DM, nullptr, DM, DM, 0, DM, r}; r -= I_PG;
    return CvP{INF_(25) + (size_t)L * 256 * DM, (bf16_t*)(Wl_ + WO_PP), nullptr, nullptr, 256, DM, 0, 0, r};
#undef INF_
}
__device__ __forceinline__ void conv_layer_item(kin_t kin, unsigned char* wsp, int L, int r, LAS float* scr, int lane) {
    const CvP p = conv_decode(kin, wsp, L, r); float v[32], sc[8]; conv_load(p, lane, v, sc); conv_store(p, lane, v, sc, scr);
}
constexpr int CV_UNIT = 48;
constexpr int I_P = NTOK * 256 / 4096;
constexpr int CV_N0 = (I_EXP + I_SMALL + I_P + CV_UNIT - 1) / CV_UNIT, CV_N1 = (I_EXP + I_P + CV_UNIT - 1) / CV_UNIT;
struct ConvJob { kin_t a; unsigned char* ws; int L;
    __device__ __forceinline__ void operator()(int unit, LAS char* shm, int tid) const {
        int tid_ = tid; asm volatile("" : "+v"(tid_));
        const int wave = __builtin_amdgcn_readfirstlane(tid_ >> 6), lane = tid_ & 63; LAS float* scr = (LAS float*)(shm + wave * 16384);
        kin_t a_ = a; GAS unsigned char* wsg_ = (GAS unsigned char*)ws; asm volatile("" : "+s"(a_), "+s"(wsg_)); unsigned char* ws_ = (unsigned char*)wsg_;
        const int limw = L == 0 ? I_EXP + I_SMALL : I_EXP, lim = limw + I_P;
#pragma unroll 1
        for (int i = 0; i < CV_UNIT / 16; ++i) {
            const int jA = unit * CV_UNIT + i * 16 + wave, jB = jA + 8;
            if (jA >= limw) {
                if (jA >= lim) break;
                const size_t oA = (size_t)L * NTOK * 256 + (size_t)(jA - limw) * 4096, oB = (size_t)L * NTOK * 256 + (size_t)(jB - limw) * 4096;
                const f32x4* sA_ = (const f32x4*)((const float*)a_[1] + oA) + lane * 2; const f32x4* sB_ = (const f32x4*)((const float*)a_[1] + oB) + lane * 2;
                u32x4* dA = (u32x4*)(ws_ + WS_PBF) + oA / 8 + lane; u32x4* dB = (u32x4*)(ws_ + WS_PBF) + oB / 8 + lane;
                f32x4 tA[16], tB[16];
#pragma unroll
                for (int c = 0; c < 8; ++c) { tA[2 * c] = sA_[c * 128]; tA[2 * c + 1] = sA_[c * 128 + 1]; }
#pragma unroll
                for (int c = 0; c < 8; ++c) { tB[2 * c] = sB_[c * 128]; tB[2 * c + 1] = sB_[c * 128 + 1]; }
#pragma unroll
                for (int c = 0; c < 8; ++c) dA[c * 64] = pack8(tA[2 * c], tA[2 * c + 1]);
#pragma unroll
                for (int c = 0; c < 8; ++c) dB[c * 64] = pack8(tB[2 * c], tB[2 * c + 1]);
                continue; }
            const bool okB = jB < limw;
            const int sA = jA - I_EXP, sB = jB - I_EXP;
            const CvP pA = conv_decode(a_, ws_, jA < I_EXP ? L : 1, jA < I_EXP ? I_SM1 + jA : (sA < I_SM1 ? sA : sA + I_EXP));
            const CvP pB = conv_decode(a_, ws_, jB < I_EXP ? L : 1, jB < I_EXP ? I_SM1 + jB : (sB < I_SM1 ? sB : sB + I_EXP));
            float vA[32], cA[8], vB[32], cB[8];
            conv_load(pA, lane, vA, cA);
            if (okB) conv_load(pB, lane, vB, cB);
            conv_store(pA, lane, vA, cA, scr);
            if (okB) conv_store(pB, lane, vB, cB, scr);
        }
    }
};

__global__ void __launch_bounds__(NWAVES * 64, 2) mega_fwd(KArgs args) {
    extern __shared__ __attribute__((aligned(16))) unsigned char lds_raw[];
    LAS unsigned char* lds0 = (LAS unsigned char*)lds_raw;
    volatile LAS unsigned* MISC = (volatile LAS unsigned*)(lds0 + LDSCTL_OFF + LC_MISC);
    const int G = gridDim.x; const int bx = blockIdx.x; const int vcu = (G % 8 == 0) ? (bx % 8) * (G / 8) + bx / 8 : bx;
    for (int u = threadIdx.x; u < (LDS_BYTES - LDSCTL_OFF) / 4; u += NWAVES * 64) ((LAS unsigned*)(lds0 + LDSCTL_OFF))[u] = 0u;
    __syncthreads();
    (void)xcd_barrier_post((unsigned*)(args.ws + WS_CTL) + CW_BAR + args.li * XCD_BAR_WORDS, MISC + 8);
    const int lo = args.ph_lo, hi = args.ph_hi;
#ifndef PH_MASK
#define PH_MASK 0x3ff
#endif
#define PHM(k) ((PH_MASK >> (k)) & 1)
#ifndef DUP_MASK
#define DUP_MASK 0
#endif
#define NREP(k) (((DUP_MASK >> (k)) & 1) ? 2 : 1)
#ifndef NULL_MASK
#define NULL_MASK 0
#endif
#define NULLP(k) ((NULL_MASK >> (k)) & 1)
#define IN(k) (lo <= (k) && (k) < hi)
#ifdef DIAG_SEL
#define PSTAMP(k) do { int ti_ = threadIdx.x; asm volatile("" : "+v"(ti_)); if (ti_ == 0) *(volatile LAS unsigned long long*)(lds0 + LDSCTL_OFF + 8336) = __builtin_amdgcn_s_memrealtime(); if (blockIdx.x == DIAG_BLOCK && ti_ == 0 && (k) < 19) { volatile LAS unsigned long long* tp_ = (volatile LAS unsigned long long*)(lds0 + LDSCTL_OFF + 8320); const unsigned long long t_ = __builtin_amdgcn_s_memrealtime(); ((float*)(args.ws + WS_CTL))[250128 + (k)] = (float)(t_ - *tp_) * 0.01f; *tp_ = t_; } } while (0)
#else
#define PSTAMP(k) do {} while (0)
#endif
#ifdef DIAG_SEL
#define ASTAMP(k) do { int ti_ = threadIdx.x; asm volatile("" : "+v"(ti_)); if (blockIdx.x == DIAG_BLOCK && ti_ == 0 && (k) < 10) { volatile LAS unsigned long long* tp_ = (volatile LAS unsigned long long*)(lds0 + LDSCTL_OFF + 8320); ((float*)(args.ws + WS_CTL))[250048 + (k)] = (float)(__builtin_amdgcn_s_memrealtime() - *tp_) * 0.01f; } \
    if (ti_ == 0 && (k) < 10) { volatile LAS unsigned long long* tq_ = (volatile LAS unsigned long long*)(lds0 + LDSCTL_OFF + 8336); const float av_ = (float)(__builtin_amdgcn_s_memrealtime() - *tq_) * 0.01f; atomicMax((int*)(args.ws + WS_CTL) + 250064 + (k), __float_as_int(av_)); atomicMin((int*)(args.ws + WS_CTL) + 250112 + (k), __float_as_int(av_) - 0x7f000000); if ((k) == 1 && av_ > 135.f) atomicAdd((float*)(args.ws + WS_CTL) + 250096, 1.f); if ((k) == 1 && av_ > 125.f) atomicAdd((float*)(args.ws + WS_CTL) + 250097, 1.f); if ((k) == 1 && av_ > 145.f) atomicAdd((float*)(args.ws + WS_CTL) + 250098, 1.f); } } while (0)
#else
#define ASTAMP(k) do {} while (0)
#endif
#define SEAM(k) do { ASTAMP(k); if (IN(k) && IN((k) + 1)) { XcdBarrier bar_; bar_.bar = (unsigned*)(args.ws + WS_CTL) + CW_BAR + args.li * XCD_BAR_WORDS; bar_.x = xb_xcc_id(); bar_.st = (volatile LAS unsigned*)(lds0 + LDSCTL_OFF + LC_MISC) + 8; xcd_barrier(bar_); } PSTAMP(k); } while (0)
    const int NGW = G * NWAVES, NGT = G * 512;
#ifdef DIAG_SEL
    if (threadIdx.x == 0) *(volatile LAS unsigned long long*)(lds0 + LDSCTL_OFF + 8320) = __builtin_amdgcn_s_memrealtime();
#endif
#define ssx0 ((float*)(wsp + WS_SSX0))
#define ssx1 ((float*)(wsp + WS_SSX1))
#define sspp ((float*)(wsp + WS_SSPP))
#define sso ((float*)(wsp + WS_SSO))
#define ssx2 ((float*)(wsp + WS_SSX2))
#define sskpe ((float*)(wsp + WS_SSKPE))
#define ssqq ((float*)(wsp + WS_SSQQ))
#define ssqkv ((float*)(wsp + WS_SSQKV))
#define gate ((float*)(wsp + WS_GATE))
#define logf ((float*)(wsp + WS_LOGF))
#define Fc ((float*)(wsp + WS_F))
#define ssqn ((float*)(wsp + WS_SSQN))
#define ssqr ((float*)(wsp + WS_SSQR))
#define cosT ((float*)(wsp + WS_COS))
#define sinT ((float*)(wsp + WS_SIN))
#define list ((int*)(wsp + WS_LIST))
#define xbA ((bf16_t*)(wsp + WS_XBA))
#define xbB ((bf16_t*)(wsp + WS_XBB))
#define pbf ((bf16_t*)(wsp + WS_PBF))
#define Qc ((bf16_t*)(wsp + WS_QC))
#define Kvc ((bf16_t*)(wsp + WS_KVC))
#define Kpe ((bf16_t*)(wsp + WS_KPE))
#define Fq ((bf16_t*)(wsp + WS_FQ))
#define Fk ((bf16_t*)(wsp + WS_FK))
#define Fv ((bf16_t*)(wsp + WS_FV))
#define Kmla ((bf16_t*)(wsp + WS_KMLA))
#define Vmla ((bf16_t*)(wsp + WS_VMLA))
#define Qraw ((bf16_t*)(wsp + WS_QRAW))
#define ob ((bf16_t*)xo)
#define ppb ((bf16_t*)(wsp + WS_PP))
#define hid ((bf16_t*)(wsp + WS_HID))
#define c1 ((bf16_t*)(wsp + WS_C1))
#define ctl ((unsigned*)(wsp + WS_CTL))
#define Wl (wsp + WS_W + (size_t)L * W_LAYER)
#define PHASE_PTRS GAS unsigned char* wsg_ = (GAS unsigned char*)args.ws; asm volatile("" : "+s"(wsg_)); unsigned char* wsp = (unsigned char*)wsg_; const float* x_in = (const float*)args.in[0]; float* xo = args.out; (void)x_in; (void)xo; \
    int tid = threadIdx.x; asm volatile("" : "+v"(tid)); const int lane = tid & 63, wave = __builtin_amdgcn_readfirstlane(tid >> 6); (void)lane; (void)wave; \
    unsigned ldo_ = 0u; asm volatile("" : "+s"(ldo_)); LAS unsigned char* lds = lds0 + ldo_; LAS int* preL = (LAS int*)(lds + LDSCTL_OFF + LC_PRE); LAS unsigned* cntL = (LAS unsigned*)(lds + LDSCTL_OFF + LC_CNT); LAS unsigned short* suboL = (LAS unsigned short*)(lds + LDSCTL_OFF + LC_SUBO); (void)preL; (void)cntL; (void)suboL; \
    const int gw = vcu * NWAVES + wave, gt = vcu * 512 + tid; (void)gw; (void)gt
#define INF(i) ((const float*)args.in[i])

    if (PHM(0) && IN(0)) {
        PHASE_PTRS; unsigned char* ws = wsp;
        LAS float* scr = (LAS float*)(lds + wave * 16384);
        for (int rep_ = 0; rep_ < NREP(0); ++rep_) {
        for (int it = gw; it < I_SMALL; it += NGW) conv_layer_item((kin_t)__builtin_amdgcn_kernarg_segment_ptr(), wsp, 0, it < I_SM1 ? it : it + I_EXP, scr, lane);
        for (int it = gw; it < 2 * (88 + 220); it += NGW) {
            const int L = it >= 308 ? 1 : 0; int r = it - L * 308; bf16_t* dst;
            if (r < 88) { const int lr = r < 24 ? 104 + r : 192 + (r - 24); dst = (bf16_t*)(Wl + WO_IN) + (size_t)(256 + lr) * DM; }
            else { r -= 88; const int lr = r < 96 ? 32 + r : 132 + (r - 96); dst = (bf16_t*)(Wl + WO_RT) + (size_t)lr * DM; }
            *(u32x4*)(dst + lane * 8) = (u32x4){0u, 0u, 0u, 0u}; *(u32x4*)(dst + 512 + lane * 8) = (u32x4){0u, 0u, 0u, 0u};
        }
        for (int m0 = gw; m0 < NTOK; m0 += 4 * NGW) {
            f32x4 v[4][4];
#pragma unroll
            for (int q = 0; q < 4; ++q) { const int mq = m0 + q * NGW < NTOK ? m0 + q * NGW : m0; const f32x4* xr = (const f32x4*)(x_in + (size_t)mq * DM) + lane;
#pragma unroll
                for (int j = 0; j < 4; ++j) v[q][j] = xr[64 * j]; }
#pragma unroll
            for (int q = 0; q < 4; ++q) { const int m = m0 + q * NGW; if (m >= NTOK) break; float s = 0.f; u32x2* o8 = (u32x2*)(xbA + (size_t)m * DM) + lane;
#pragma unroll
                for (int j = 0; j < 4; ++j) { s += sum4sq(v[q][j]); u32x2 w; w.x = cvt_pk_bf16(v[q][j][0], v[q][j][1]); w.y = cvt_pk_bf16(v[q][j][2], v[q][j][3]); o8[64 * j] = w; }
                s = wave_sum(s); if (lane < 16) ssx0[(size_t)m * 16 + lane] = lane == 0 ? s : 0.f; } }
        for (int i = gt; i < NTOK * 16; i += NGT) { const int t = i >> 4, j = i & 15; const double inv = exp2(-(double)j * (13.287712379549449 / 16.0)); const double ang = (double)((const int*)args.in[2])[t] * inv;
            cosT[i] = (float)cos(ang); sinT[i] = (float)sin(ang); }
        }
    }
    SEAM(0);

#pragma unroll 1
    for (int L = 0; L < DEPTH; ++L) {
        const int pb = 1 + 9 * L;
        if (PHM(1) && IN(pb + 0)) {
            PHASE_PTRS;
            pg8::Gemm g{xbA, (const bf16_t*)(Wl + WO_IN), DM}; pg8::StaticOrder S; S.init(NTOK, 2048, G, bx, WGM_P1);
            EpiInProj E{wsp, INF(13) + L * 8, INF(11) + L * 64, INF(12) + L * 64};
            for (int rep_ = 0; rep_ < NREP(1); ++rep_) pg8::gemm_phase<DM, EpiInProj, pg8::StaticOrder, true>(lds, g, S, E);
            if (NULLP(1)) { EpiNull EN{(float*)(wsp + WS_SSX2)}; pg8::gemm_phase<DM, EpiNull, pg8::StaticOrder, true>(lds, g, S, EN); }
        }
        SEAM(pb + 0);
        if (PHM(2) && IN(pb + 1)) {
            PHASE_PTRS;
            { pg8::Gemm g{Kvc, (const bf16_t*)(Wl + WO_UKV), 128}; pg8::StaticOrder S; S.init(NTOK, 1024, G, bx, WGM_P2);
              EpiKvUp E{wsp, INF(10) + L * 96};
              for (int rep_ = 0; rep_ < NREP(2); ++rep_) pg8::gemm_phase<128, EpiKvUp, pg8::StaticOrder, true>(lds, g, S, E); }
        }
        SEAM(pb + 1);
        if (PHM(3) && IN(pb + 2)) {
            PHASE_PTRS;
            { bool did = false;
            for (int v = bx; v < 32; v += G) {
                did = true; const int b = v >> 3, h = v & 7; LAS double* wt = (LAS double*)lds;
                const size_t base = ((size_t)b * SEQ + wave * 1024 + lane * 16) * 8 + h; float lv[16]; double loc = 0.0;
#pragma unroll
                for (int i = 0; i < 16; ++i) { lv[i] = logf[base + (size_t)i * 8]; loc += (double)lv[i]; }
                double pre = loc;
#pragma unroll
                for (int o = 1; o < 64; o <<= 1) { const double n = __shfl_up(pre, o); if (lane >= o) pre += n; }
                if (lane == 63) wt[wave] = pre;
                LDS_WAIT(); __syncthreads();
                double run = pre - loc;
                for (int w = 0; w < wave; ++w) run += wt[w];
#pragma unroll
                for (int i = 0; i < 16; ++i) { run += (double)lv[i]; Fc[base + (size_t)i * 8] = (float)run; }
                __syncthreads();
            }
              if (did) { __builtin_amdgcn_fence(__ATOMIC_RELEASE, "agent"); __syncthreads(); if (tid == 0) __hip_atomic_fetch_add(ctl + CW_FQ + 64 * L + 16, 1u, __ATOMIC_RELEASE, __HIP_MEMORY_SCOPE_AGENT); } }
            att::Args A{Qc, (const bf16_t*)(Wl + WO_UQ), Kmla, Vmla, Fq, Fk, Fv, (const float*)(wsp + WS_SSQQ), INF(9) + L * 96, cosT, sinT, Fc, INF(11) + L * 64, INF(12) + L * 64, ob, sso};
#ifdef DIAG_SEL
            LAS float* dg = (L == 0 && blockIdx.x == DIAG_BLOCK && tid == 0) ? (LAS float*)(lds0 + LDSCTL_OFF + 8192) : (LAS float*)nullptr;
            if (dg) for (int k = 0; k < 16; ++k) dg[k] = 0.f;
            att::attn_phase(A, vcu, G, (LAS char*)lds, NREP(10), NREP(11), dg, ctl + CW_FQ + 64 * L, INF(13) + L * 8, (LAS int*)(lds + LDSCTL_OFF + LC_QS), G < 32 ? G : 32, L == 0 ? CV_N0 : CV_N1, ConvJob{(kin_t)__builtin_amdgcn_kernarg_segment_ptr(), wsp, L});
            if (dg) { float* dw = (float*)(wsp + WS_CTL) + 250000; for (int k = 0; k < 16; ++k) dw[k] = dg[k]; }
#else
            att::attn_phase(A, vcu, G, (LAS char*)lds, NREP(10), NREP(11), (LAS float*)nullptr, ctl + CW_FQ + 64 * L, INF(13) + L * 8, (LAS int*)(lds + LDSCTL_OFF + LC_QS), G < 32 ? G : 32, L == 0 ? CV_N0 : CV_N1, ConvJob{(kin_t)__builtin_amdgcn_kernarg_segment_ptr(), wsp, L});
#endif
        }
        SEAM(pb + 2);
        if (PHM(4) && IN(pb + 3)) {
            PHASE_PTRS;
            pg8::Gemm g{ob, (const bf16_t*)(Wl + WO_OUT), DM}; pg8::StaticOrder S; S.init(NTOK, DM, G, bx, WGM_P4);
            EpiOut E{wsp, (const float*)nullptr};
            for (int rep_ = 0; rep_ < (L == 0 ? NREP(4) : 1); ++rep_) pg8::gemm_phase<DM, EpiOut, pg8::StaticOrder, true>(lds, g, S, E);
            if (NULLP(4)) { EpiNull EN{(float*)(wsp + WS_SSX2)}; pg8::gemm_phase<DM, EpiNull, pg8::StaticOrder, true>(lds, g, S, EN); }
        }
        SEAM(pb + 3);
        if (PHM(5) && IN(pb + 4)) {
            PHASE_PTRS;
            { pg8::Gemm g{xbB, (const bf16_t*)(Wl + WO_RT), DM}; pg8::StaticOrder S; S.init(NTOK, 256, G, bx);
              EpiRouter E{wsp, ctl + CW_CNT + 8192 * L, (LAS unsigned*)(lds + LDSCTL_OFF + LC_RCNT)};
              pg8::gemm_phase<DM, EpiRouter, pg8::StaticOrder, true>(lds, g, S, E); }
            { pg8::Gemm g{pbf + (size_t)L * NTOK * 256, (const bf16_t*)(Wl + WO_PP), 256}; const PPOrder S = (G == 256) ? PPOrder{bx >= 128 ? bx - 128 : -1, 128, 256} : PPOrder{bx, G, 512};
              EpiPP E{wsp};
              pg8::gemm_phase<256, EpiPP, PPOrder, true>(lds, g, S, E); }
        }
        SEAM(pb + 4);
        if ((PHM(6) && IN(pb + 5)) || (PHM(7) && IN(pb + 6))) {
            PHASE_PTRS;
#pragma unroll 1
            for (int q = 0; q < 4; ++q) {
                const int e = wave * 4 + q; const unsigned* cg = ctl + CW_CNT + 8192 * L + e * NSUB + 4 * lane; unsigned c[4];
#pragma unroll
                for (int j = 0; j < 4; ++j) c[j] = __hip_atomic_load(cg + j, RLX_AGENT);
                const unsigned tot = (c[0] + c[1]) + (c[2] + c[3]); unsigned inc = tot;
#pragma unroll
                for (int o = 1; o < 64; o <<= 1) { const unsigned nb = __shfl_up(inc, o); if (lane >= o) inc += nb; }
                unsigned run = inc - tot; LAS unsigned short* so = suboL + e * (NSUB + 1) + 4 * lane;
#pragma unroll
                for (int j = 0; j < 4; ++j) { run += c[j]; so[j + 1] = (unsigned short)run; }
                if (lane == 0) suboL[e * (NSUB + 1)] = 0; if (lane == 63) cntL[e] = run; }
            LDS_WAIT(); __syncthreads();
            if (tid == 0) { int run = 0; for (int e = 0; e < 32; ++e) { preL[e] = run; run += ((int)cntL[e] + 255) >> 8; } preL[32] = run; }
            LDS_WAIT(); __syncthreads();
            if (wave == 0) {
                LAS unsigned short* ordL = (LAS unsigned short*)(lds + LDSCTL_OFF + LC_ORD);
                const int e = lane & 31; const int cn = (int)cntL[e]; const int F = cn >> 8, rem = cn & 255, pb = preL[e]; int inc = F;
#pragma unroll
                for (int o = 1; o < 32; o <<= 1) { const int nb = __shfl_up(inc, o, 32); if (e >= o) inc += nb; }
                const int NF = __shfl(inc, 31, 32), fpos = inc - F; int rank = 0;
#pragma unroll 1
                for (int k = 0; k < 32; ++k) { const int rk = __shfl(rem, k, 32); rank += (rk > rem || (rk == rem && rk > 0 && k < e)) ? 1 : 0; }
                if (lane < 32) { for (int j = 0; j < F; ++j) ordL[fpos + j] = (unsigned short)(pb + j); if (rem) ordL[NF + rank] = (unsigned short)(pb + F); }
            }
            LDS_WAIT(); __syncthreads();
        }
        if (PHM(6) && IN(pb + 5)) {
            PHASE_PTRS;
            pg8::Gemm g{xbB, (const bf16_t*)(Wl + WO_GU), DM}; MoeOrder S{preL, cntL, suboL, list, 2, G, vcu, true, (const LAS unsigned short*)(lds + LDSCTL_OFF + LC_ORD)};
            EpiMoeUp E{wsp, cntL, suboL, 2};
            for (int rep_ = 0; rep_ < NREP(6); ++rep_) pg8::gemm_phase<DM, EpiMoeUp, MoeOrder, true>(lds, g, S, E);
            if (G == 256) {
                const int TB = preL[32]; int n3 = 2 * TB - 512; n3 = n3 < 0 ? 0 : (n3 > 256 ? 256 : n3); int n6 = (TB <= 256) ? 0 : 256 - n3; n6 = n6 > 256 ? 256 : n6;
                pg8::Gemm gp{pbf + (size_t)L * NTOK * 256, (const bf16_t*)(Wl + WO_PP), 256}; const PPOrder Sp{(vcu >= n3 && vcu - n3 < n6) ? 256 + (vcu - n3) : -1, 512, 256 + n6}; EpiPP Ep{wsp};
                pg8::gemm_phase<256, EpiPP, PPOrder, true>(lds, gp, Sp, Ep); }
        }
        SEAM(pb + 5);
        if (PHM(7) && IN(pb + 6)) {
            PHASE_PTRS;
            pg8::Gemm g{hid, (const bf16_t*)(Wl + WO_DN), 256}; MoeOrder S{preL, cntL, suboL, list, 4, G, vcu, false, (const LAS unsigned short*)(lds + LDSCTL_OFF + LC_ORD)};
            EpiMoeDown E{wsp, cntL, suboL, 4};
            pg8::gemm_phase<256, EpiMoeDown, MoeOrder, true>(lds, g, S, E);
            if (G == 256) {
                const int TB = preL[32]; int n3 = 2 * TB - 512; n3 = n3 < 0 ? 0 : (n3 > 256 ? 256 : n3); int n6 = (TB <= 256) ? 0 : 256 - n3; n6 = n6 > 256 ? 256 : n6;
                const int r7 = (4 * TB) & 255; const int rot = (vcu - r7) & 255;
                pg8::Gemm gp{pbf + (size_t)L * NTOK * 256, (const bf16_t*)(Wl + WO_PP), 256}; const PPOrder Sp{256 + n6 + rot, 256, 512}; EpiPP Ep{wsp};
                pg8::gemm_phase<256, EpiPP, PPOrder, true>(lds, gp, Sp, Ep); }
        }
        SEAM(pb + 6);
        if (PHM(8) && IN(pb + 7)) {
            PHASE_PTRS;
            for (int m0 = gw; m0 < NTOK; m0 += 4 * NGW) {
                u32x4 cw[4][2], xw[4][2];
#pragma unroll
                for (int q = 0; q < 4; ++q) { const int mq = m0 + q * NGW < NTOK ? m0 + q * NGW : m0; const u32x4* cr = (const u32x4*)(c1 + (size_t)mq * DM) + lane; const u32x4* xr = (const u32x4*)(xbB + (size_t)mq * DM) + lane;
#pragma unroll
                    for (int j = 0; j < 2; ++j) { cw[q][j] = cr[64 * j]; xw[q][j] = xr[64 * j]; } }
                asm volatile("" ::: "memory");
                float sq[4];
#pragma unroll
                for (int q = 0; q < 4; ++q) { const int m = m0 + q * NGW; sq[q] = 0.f; if (m >= NTOK) continue; u32x4* xr = (u32x4*)(xbB + (size_t)m * DM) + lane;
#pragma unroll
                    for (int j = 0; j < 2; ++j) { const u32x4 c_ = cw[q][j], x_ = xw[q][j];
                        const f32x4 v0 = (f32x4){bflo(x_.x), bfhi(x_.x), bflo(x_.y), bfhi(x_.y)} + (f32x4){bflo(c_.x), bfhi(c_.x), bflo(c_.y), bfhi(c_.y)}, v1 = (f32x4){bflo(x_.z), bfhi(x_.z), bflo(x_.w), bfhi(x_.w)} + (f32x4){bflo(c_.z), bfhi(c_.z), bflo(c_.w), bfhi(c_.w)};
                        sq[q] += sum4sq(v0) + sum4sq(v1); xr[64 * j] = pack8(v0, v1); } }
#pragma unroll
                for (int o = 1; o < 64; o <<= 1) {
#pragma unroll
                    for (int q = 0; q < 4; ++q) sq[q] += __shfl_xor(sq[q], o); }
#pragma unroll
                for (int q = 0; q < 4; ++q) { const int m = m0 + q * NGW; if (m < NTOK && lane == 0) ssx2[m] = sq[q]; } }
        }
        SEAM(pb + 7);
        if (PHM(9) && IN(pb + 8)) {
            PHASE_PTRS;
            pg8::Gemm g{xbB, (const bf16_t*)(Wl + WO_PG), DM}; pg8::StaticOrder S; S.init(NTOK, DM, G, bx, WGM_P4);
            EpiPle E{wsp, INF(26) + L * DM, L + 1 == DEPTH ? xo : (float*)nullptr};
            pg8::gemm_phase<DM, EpiPle, pg8::StaticOrder, true>(lds, g, S, E);
        }
        if (L + 1 < DEPTH) SEAM(pb + 8);
    }
#undef IN
#undef SEAM
#undef INF
}

extern "C" void kernel_launch(void* const* d_in, const int* in_sizes, int n_in, void* d_out, int out_size, void* d_ws, size_t ws_size, hipStream_t stream) {
    static int grid = 0;
    if (grid == 0) {
        if (n_in != 27 || ws_size < WS_END) { fprintf(stderr, "kernel_launch: unexpected inputs (n_in %d, ws %zu)\n", n_in, ws_size); grid = -1; return; }
        int dev = 0, cus = 0, per_cu = 0;
        if (hipGetDevice(&dev) != hipSuccess || hipDeviceGetAttribute(&cus, hipDeviceAttributeMultiprocessorCount, dev) != hipSuccess) { grid = -1; return; }
        if (hipFuncSetAttribute((const void*)mega_fwd, hipFuncAttributeMaxDynamicSharedMemorySize, LDS_BYTES) != hipSuccess) { fprintf(stderr, "kernel_launch: hipFuncSetAttribute failed\n"); grid = -1; return; }
        if (hipOccupancyMaxActiveBlocksPerMultiprocessor(&per_cu, (const void*)mega_fwd, NWAVES * 64, LDS_BYTES) != hipSuccess || per_cu < 1) { fprintf(stderr, "kernel_launch: occupancy query says %d\n", per_cu); }
        (void)hipGetLastError();
        grid = cus;
    }
    if (grid < 0) return;
    if (hipMemsetAsync((char*)d_ws + WS_CTL, 0, CTL_ZERO_BYTES, stream) != hipSuccess) return;
    KArgs a{};
    for (int i = 0; i < 27; ++i) a.in[i] = d_in[i];
    a.out = (float*)d_out; a.ws = (unsigned char*)d_ws;
    const int cuts[] = MK_CUTS; const int nl = (int)(sizeof(cuts) / sizeof(int)) - 1;
    for (int li = 0; li < nl; ++li) {
        a.ph_lo = cuts[li]; a.ph_hi = cuts[li + 1]; a.li = li; a.pad = 0;
        hipLaunchKernelGGL(mega_fwd, dim3(grid), dim3(NWAVES * 64), LDS_BYTES, stream, a);
        if (hipPeekAtLastError() != hipSuccess) { fprintf(stderr, "kernel_launch: launch %d failed\n", li); break; }
    }
}
```
